# Optimizing an MI355X kernel written in HIP

```python
import math
import jax
import jax.numpy as jnp
from jax import lax
import numpy as np

D_MODEL = 1024
BATCH = 2
SEQ = 8192
DEPTH = 4
DEC_BATCH = 128
DEC_SEQ = 1
PAST_LEN = 8192
PAGE_SIZE = 128

M_HEADDIM = 64
M_HEADS = D_MODEL // M_HEADDIM
M_INNER = M_HEADS * M_HEADDIM
M_GROUPS = 4
M_STATE = 128
CONV_W = 4
CONV_DIM = M_INNER + 2 * M_GROUPS * M_STATE
CHUNK = 128
DT_MIN = 0.001
DT_MAX = 0.1
S5_WIDTH = D_MODEL
S5_GSIZE = 16
S5_GROUPS = S5_WIDTH // S5_GSIZE
S5_STATE = 64
HEAD_DIM = 64
A_HEADS = D_MODEL // HEAD_DIM
KV_HEADS = 4
Q_PER_KV = A_HEADS // KV_HEADS
ROT_DIM = HEAD_DIM // 4
ROPE_THETA = 500000.0
WINDOW = 128
D_FF = 4 * D_MODEL
N_BRANCH = 3
EPS = 1e-6
WIN_BUF = min(WINDOW, PAST_LEN)

OFF_Z = 0
OFF_XBC = OFF_Z + M_INNER
OFF_DT = OFF_XBC + CONV_DIM
OFF_U = OFF_DT + M_HEADS
OFF_Q = OFF_U + S5_WIDTH
OFF_K = OFF_Q + A_HEADS * HEAD_DIM
OFF_V = OFF_K + KV_HEADS * HEAD_DIM
OFF_G = OFF_V + KV_HEADS * HEAD_DIM
IN_COLS = OFF_G + N_BRANCH * D_MODEL

kernel_name = 'hybrid_ssd_s5_swa_decoder_step'


def _rmsnorm(x, w):
    xf = x.astype(jnp.float32)
    y = xf * lax.rsqrt(jnp.mean(xf * xf, axis=-1, keepdims=True) + EPS)
    return (y * w.astype(jnp.float32)).astype(x.dtype)


def _rope(x, pos):
    half = ROT_DIM // 2
    inv_freq = jnp.exp(-(2.0 * jnp.arange(half, dtype=jnp.float32) / ROT_DIM) * math.log(ROPE_THETA))
    ang = pos.astype(jnp.float32)[:, None] * inv_freq[None, :]
    cos = jnp.cos(ang)[None, :, None, :]
    sin = jnp.sin(ang)[None, :, None, :]
    xf = x.astype(jnp.float32)
    x1 = xf[..., :half]
    x2 = xf[..., half:ROT_DIM]
    out = jnp.concatenate([x1 * cos - x2 * sin, x2 * cos + x1 * sin, xf[..., ROT_DIM:]], axis=-1)
    return out.astype(x.dtype)


def _causal_conv(xbc, buf, conv_w, conv_b):
    full = jnp.concatenate([buf.astype(xbc.dtype), xbc], axis=1)
    out = lax.conv_general_dilated(full, conv_w[:, None, :].astype(xbc.dtype), window_strides=(1,),
                                   padding='VALID', dimension_numbers=('NWC', 'WIO', 'NWC'),
                                   feature_group_count=CONV_DIM)
    return jax.nn.silu(out + conv_b.astype(xbc.dtype)), full[:, -(CONV_W - 1):]


def _ssd(x, dt, a_log, bm, cm, d_skip, h0):
    bsz, L = x.shape[0], x.shape[1]
    q = CHUNK if L % CHUNK == 0 else L
    nc = L // q
    hpg = M_HEADS // M_GROUPS
    A = -jnp.exp(a_log).reshape(M_GROUPS, hpg)
    xc = x.reshape(bsz, nc, q, M_GROUPS, hpg, M_HEADDIM)
    dtc = dt.reshape(bsz, nc, q, M_GROUPS, hpg)
    bc = bm.reshape(bsz, nc, q, M_GROUPS, M_STATE)
    cc = cm.reshape(bsz, nc, q, M_GROUPS, M_STATE)
    acum = jnp.cumsum(dtc * A, axis=2)
    acum_h = jnp.moveaxis(acum, 2, -1)
    seg = acum_h[..., :, None] - acum_h[..., None, :]
    causal = jnp.tril(jnp.ones((q, q), dtype=bool))
    decay = jnp.exp(jnp.where(causal, seg, -jnp.inf))
    cb = jnp.einsum('bctgn,bcsgn->bcgts', cc, bc)
    xdt = xc * dtc[..., None]
    y_diag = jnp.einsum('bcghts,bcsghp->bctghp', cb[:, :, :, None] * decay, xdt)
    decay_end = jnp.exp(acum[:, :, -1:] - acum)
    states = jnp.einsum('bcsgn,bcsgh,bcsghp->bcghpn', bc, decay_end * dtc, xc)
    chunk_decay = jnp.exp(acum[:, :, -1])

    def step(h, inp):
        st, dec = inp
        return h * dec[..., None, None] + st, h

    h0g = h0.reshape(bsz, M_GROUPS, hpg, M_HEADDIM, M_STATE)
    h_last, h_prev = lax.scan(step, h0g, (jnp.moveaxis(states, 1, 0), jnp.moveaxis(chunk_decay, 1, 0)))
    h_prev = jnp.moveaxis(h_prev, 0, 1)
    y_off = jnp.einsum('bctgn,bcghpn,bctgh->bctghp', cc, h_prev, jnp.exp(acum))
    y = y_diag + y_off + xc * d_skip.reshape(M_GROUPS, hpg)[:, :, None]
    return y.reshape(bsz, L, M_HEADS, M_HEADDIM), h_last.reshape(bsz, M_HEADS, M_HEADDIM, M_STATE)


def _mamba2(z, xbc, dt_raw, conv_buf, h0, conv_w, conv_b, dt_bias, a_log, m_d, m_norm_w):
    f32 = jnp.float32
    bsz, L = z.shape[0], z.shape[1]
    xbc_c, conv_new = _causal_conv(xbc, conv_buf, conv_w, conv_b)
    xbc_c = xbc_c.astype(f32)
    gn = M_GROUPS * M_STATE
    xs = xbc_c[..., :M_INNER].reshape(bsz, L, M_HEADS, M_HEADDIM)
    bm = xbc_c[..., M_INNER:M_INNER + gn].reshape(bsz, L, M_GROUPS, M_STATE)
    cm = xbc_c[..., M_INNER + gn:].reshape(bsz, L, M_GROUPS, M_STATE)
    dt = jax.nn.softplus(dt_raw.astype(f32) + dt_bias.astype(f32))
    y, h_last = _ssd(xs, dt, a_log.astype(f32), bm, cm, m_d.astype(f32), h0.astype(f32))
    y = y.reshape(bsz, L, M_INNER) * jax.nn.silu(z.astype(f32))
    yg = y.reshape(bsz, L, M_GROUPS, M_INNER // M_GROUPS)
    yg = yg * lax.rsqrt(jnp.mean(yg * yg, axis=-1, keepdims=True) + EPS)
    y = yg.reshape(bsz, L, M_INNER) * m_norm_w.astype(f32)
    return y.astype(z.dtype), conv_new, h_last.astype(h0.dtype)


def _s5(u, h0_re, h0_im, lam_re, lam_im, log_step, b_re, b_im, c_re, c_im, d_skip):
    f32 = jnp.float32
    bsz, L = u.shape[0], u.shape[1]
    uf = u.astype(f32).reshape(bsz, L, S5_GROUPS, S5_GSIZE)
    step = jnp.exp(log_step.astype(f32))[:, None]
    lr = lam_re.astype(f32)
    li = lam_im.astype(f32)
    mag = jnp.exp(lr * step)
    ab_re = mag * jnp.cos(li * step)
    ab_im = mag * jnp.sin(li * step)
    den = lr * lr + li * li
    nr = ab_re - 1.0
    ni = ab_im
    f_re = (nr * lr + ni * li) / den
    f_im = (ni * lr - nr * li) / den
    br = b_re.astype(f32)
    bi = b_im.astype(f32)
    bb_re = f_re[..., None] * br - f_im[..., None] * bi
    bb_im = f_re[..., None] * bi + f_im[..., None] * br
    bu_re = jnp.einsum('blgi,gni->blgn', uf, bb_re)
    bu_im = jnp.einsum('blgi,gni->blgn', uf, bb_im)
    a_re = jnp.broadcast_to(ab_re[None, None], (1, L, S5_GROUPS, S5_STATE))
    a_im = jnp.broadcast_to(ab_im[None, None], (1, L, S5_GROUPS, S5_STATE))

    def combine(left, right):
        ar1, ai1, br1, bi1 = left
        ar2, ai2, br2, bi2 = right
        return (ar2 * ar1 - ai2 * ai1, ar2 * ai1 + ai2 * ar1,
                ar2 * br1 - ai2 * bi1 + br2, ar2 * bi1 + ai2 * br1 + bi2)

    p_re, p_im, s_re, s_im = lax.associative_scan(combine, (a_re, a_im, bu_re, bu_im), axis=1)
    hr0 = h0_re.astype(f32)[:, None]
    hi0 = h0_im.astype(f32)[:, None]
    h_re = p_re * hr0 - p_im * hi0 + s_re
    h_im = p_re * hi0 + p_im * hr0 + s_im
    y = (jnp.einsum('gon,blgn->blgo', c_re.astype(f32), h_re)
         - jnp.einsum('gon,blgn->blgo', c_im.astype(f32), h_im))
    y = y + d_skip.astype(f32).reshape(S5_GROUPS, S5_GSIZE) * uf
    y = jax.nn.gelu(y).reshape(bsz, L, S5_WIDTH)
    return y.astype(u.dtype), h_re[:, -1].astype(h0_re.dtype), h_im[:, -1].astype(h0_im.dtype)


def _sink_attend(q, k, v, q_pos, k_pos, sinks):
    s = jnp.einsum('bntkgd,bnskd->bnkgts', q.astype(jnp.float32), k.astype(jnp.float32)) * (HEAD_DIM ** -0.5)
    dpos = q_pos[:, :, None] - k_pos[:, None, :]
    valid = (dpos >= 0) & (dpos <= WINDOW) & (k_pos[:, None, :] >= 0)
    s = jnp.where(valid[None, :, None, None], s, -jnp.inf)
    sink = sinks.astype(jnp.float32).reshape(KV_HEADS, Q_PER_KV)[None, None, :, :, None, None]
    m = jnp.maximum(jnp.max(s, axis=-1, keepdims=True), sink)
    p = jnp.exp(s - m)
    denom = jnp.sum(p, axis=-1, keepdims=True) + jnp.exp(sink - m)
    return jnp.einsum('bnkgts,bnskd->bntkgd', p / denom, v.astype(jnp.float32))


def _attn_prompt(q, k, v, sinks):
    bsz, L = q.shape[0], q.shape[1]
    nb = L // WINDOW
    qb = q.reshape(bsz, nb, WINDOW, KV_HEADS, Q_PER_KV, HEAD_DIM)
    kb = k.reshape(bsz, nb, WINDOW, KV_HEADS, HEAD_DIM)
    vb = v.reshape(bsz, nb, WINDOW, KV_HEADS, HEAD_DIM)
    pad = jnp.zeros_like(kb[:, :1])
    k_ctx = jnp.concatenate([jnp.concatenate([pad, kb[:, :-1]], axis=1), kb], axis=2)
    v_ctx = jnp.concatenate([jnp.concatenate([pad, vb[:, :-1]], axis=1), vb], axis=2)
    q_pos = jnp.arange(L, dtype=jnp.int32).reshape(nb, WINDOW)
    k_pos = (jnp.arange(nb, dtype=jnp.int32)[:, None] - 1) * WINDOW + jnp.arange(2 * WINDOW, dtype=jnp.int32)[None, :]
    o = _sink_attend(qb, k_ctx, v_ctx, q_pos, k_pos, sinks)
    return o.reshape(bsz, L, A_HEADS * HEAD_DIM).astype(q.dtype)


def _attn_sample(q, k, v, k_buf, v_buf, sinks, pos0):
    bsz, T = q.shape[0], q.shape[1]
    k_all = jnp.concatenate([k_buf.astype(k.dtype), k], axis=1)
    v_all = jnp.concatenate([v_buf.astype(v.dtype), v], axis=1)
    qb = q.reshape(bsz, 1, T, KV_HEADS, Q_PER_KV, HEAD_DIM)
    q_pos = (pos0 + jnp.arange(T, dtype=jnp.int32))[None]
    k_pos = (pos0 - WIN_BUF + jnp.arange(WIN_BUF + T, dtype=jnp.int32))[None]
    o = _sink_attend(qb, k_all[:, None], v_all[:, None], q_pos, k_pos, sinks)
    return (o.reshape(bsz, T, A_HEADS * HEAD_DIM).astype(q.dtype),
            k_all[:, -WIN_BUF:], v_all[:, -WIN_BUF:])


def _layer(x, pos0, conv_buf, ssm_h0, s5_h0r, s5_h0i, k_buf, v_buf,
           norm1_w, w_in, conv_w, conv_b, dt_bias, a_log, m_d, m_norm_w, m_proj,
           s5_lam_re, s5_lam_im, s5_log_step, s5_b_re, s5_b_im, s5_c_re, s5_c_im, s5_d, s5_glu_w,
           attn_sinks, attn_o, w_out, norm2_w, mlp_up, mlp_down):
    bsz, L, _ = x.shape
    dty = x.dtype
    h = _rmsnorm(x, norm1_w)
    proj = h @ w_in.astype(dty)
    z = proj[..., OFF_Z:OFF_XBC]
    xbc = proj[..., OFF_XBC:OFF_DT]
    dt_raw = proj[..., OFF_DT:OFF_U]
    u = proj[..., OFF_U:OFF_Q]
    q_raw = proj[..., OFF_Q:OFF_K]
    k_raw = proj[..., OFF_K:OFF_V]
    v_raw = proj[..., OFF_V:OFF_G]
    g_pre = proj[..., OFF_G:]

    y_m, conv_new, ssm_new = _mamba2(z, xbc, dt_raw, conv_buf, ssm_h0, conv_w, conv_b,
                                     dt_bias, a_log, m_d, m_norm_w)
    y_m = y_m @ m_proj.astype(dty)

    y_s, s5r_new, s5i_new = _s5(u, s5_h0r, s5_h0i, s5_lam_re, s5_lam_im, s5_log_step,
                                s5_b_re, s5_b_im, s5_c_re, s5_c_im, s5_d)
    glu = y_s @ s5_glu_w.astype(dty)
    y_s = glu[..., :D_MODEL] * jax.nn.sigmoid(glu[..., D_MODEL:])

    pos = pos0 + jnp.arange(L, dtype=jnp.int32)
    q = _rope(q_raw.reshape(bsz, L, A_HEADS, HEAD_DIM), pos)
    k = _rope(k_raw.reshape(bsz, L, KV_HEADS, HEAD_DIM), pos)
    v = v_raw.reshape(bsz, L, KV_HEADS, HEAD_DIM)
    if k_buf is None:
        o = _attn_prompt(q, k, v, attn_sinks)
        k_new = k[:, -WIN_BUF:]
        v_new = v[:, -WIN_BUF:]
    else:
        o, k_new, v_new = _attn_sample(q, k, v, k_buf, v_buf, attn_sinks, pos0)
    y_a = o @ attn_o.astype(dty)

    gates = jax.nn.sigmoid(g_pre.astype(jnp.float32)).astype(dty).reshape(bsz, L, N_BRANCH, D_MODEL)
    merged = gates[..., 0, :] * y_m + gates[..., 1, :] * y_s + gates[..., 2, :] * y_a
    x = x + merged @ w_out.astype(dty)

    h2 = _rmsnorm(x, norm2_w)
    x = x + jnp.square(jax.nn.relu(h2 @ mlp_up.astype(dty))) @ mlp_down.astype(dty)
    return x, conv_new, ssm_new, s5r_new, s5i_new, k_new, v_new


def setup_inputs(seed: int = 0) -> dict:
    key = jax.random.key(seed)
    ks = jax.random.split(key, 40)
    f32 = jnp.float32

    def nrm(k, shape, scale):
        return jax.random.normal(k, shape, f32) * scale

    x_prompt = nrm(ks[0], (BATCH, SEQ, D_MODEL), 1.0)
    x_sample = nrm(ks[1], (DEC_BATCH, DEC_SEQ, D_MODEL), 1.0)
    state_ssm = nrm(ks[2], (DEPTH, DEC_BATCH, M_HEADS, M_HEADDIM, M_STATE), 0.5)
    state_conv = nrm(ks[3], (DEPTH, DEC_BATCH, CONV_W - 1, CONV_DIM), 1.0)
    state_s5_re = nrm(ks[4], (DEPTH, DEC_BATCH, S5_GROUPS, S5_STATE), 0.1)
    state_s5_im = nrm(ks[5], (DEPTH, DEC_BATCH, S5_GROUPS, S5_STATE), 0.1)
    cache_k = nrm(ks[6], (DEPTH, DEC_BATCH, WIN_BUF, KV_HEADS, HEAD_DIM), 1.0)
    cache_v = nrm(ks[7], (DEPTH, DEC_BATCH, WIN_BUF, KV_HEADS, HEAD_DIM), 1.0)

    norm1_w = 1.0 + nrm(ks[8], (DEPTH, D_MODEL), 0.01)
    w_in = nrm(ks[9], (DEPTH, D_MODEL, IN_COLS), D_MODEL ** -0.5)
    conv_w = nrm(ks[10], (DEPTH, CONV_W, CONV_DIM), CONV_W ** -0.5)
    conv_b = nrm(ks[11], (DEPTH, CONV_DIM), 0.01)
    dt0 = jnp.exp(jax.random.uniform(ks[12], (DEPTH, M_HEADS), f32, math.log(DT_MIN), math.log(DT_MAX)))
    dt_bias = dt0 + jnp.log(-jnp.expm1(-dt0))
    a_log = jnp.log(jax.random.uniform(ks[13], (DEPTH, M_HEADS), f32, 1.0, 16.0))
    m_d = 1.0 + nrm(ks[14], (DEPTH, M_HEADS), 0.01)
    m_norm_w = 1.0 + nrm(ks[15], (DEPTH, M_INNER), 0.01)
    m_proj = nrm(ks[16], (DEPTH, M_INNER, D_MODEL), M_INNER ** -0.5)

    s5_lam_re = -0.5 + nrm(ks[17], (DEPTH, S5_GROUPS, S5_STATE), 0.01)
    s5_lam_im = math.pi * jnp.arange(S5_STATE, dtype=f32) + nrm(ks[18], (DEPTH, S5_GROUPS, S5_STATE), 0.01)
    s5_log_step = jax.random.uniform(ks[19], (DEPTH, S5_GROUPS), f32, math.log(DT_MIN), math.log(DT_MAX))
    s5_b_re = nrm(ks[20], (DEPTH, S5_GROUPS, S5_STATE, S5_GSIZE), (2 * S5_GSIZE) ** -0.5)
    s5_b_im = nrm(ks[21], (DEPTH, S5_GROUPS, S5_STATE, S5_GSIZE), (2 * S5_GSIZE) ** -0.5)
    s5_c_re = nrm(ks[22], (DEPTH, S5_GROUPS, S5_GSIZE, S5_STATE), S5_STATE ** -0.5)
    s5_c_im = nrm(ks[23], (DEPTH, S5_GROUPS, S5_GSIZE, S5_STATE), S5_STATE ** -0.5)
    s5_d = nrm(ks[24], (DEPTH, S5_WIDTH), 1.0)
    s5_glu_w = nrm(ks[25], (DEPTH, S5_WIDTH, 2 * D_MODEL), S5_WIDTH ** -0.5)

    attn_sinks = nrm(ks[26], (DEPTH, A_HEADS), 1.0)
    attn_o = nrm(ks[27], (DEPTH, A_HEADS * HEAD_DIM, D_MODEL), (A_HEADS * HEAD_DIM) ** -0.5)
    w_out = nrm(ks[28], (DEPTH, D_MODEL, D_MODEL), D_MODEL ** -0.5)
    norm2_w = 1.0 + nrm(ks[29], (DEPTH, D_MODEL), 0.01)
    mlp_up = nrm(ks[30], (DEPTH, D_MODEL, D_FF), D_MODEL ** -0.5)
    mlp_down = nrm(ks[31], (DEPTH, D_FF, D_MODEL), D_FF ** -0.5)
    final_norm_w = 1.0 + nrm(ks[32], (D_MODEL,), 0.01)

    return {
        'x_prompt': x_prompt, 'x_sample': x_sample,
        'state_ssm': state_ssm, 'state_conv': state_conv,
        'state_s5_re': state_s5_re, 'state_s5_im': state_s5_im,
        'cache_k': cache_k, 'cache_v': cache_v,
        'norm1_w': norm1_w, 'w_in': w_in, 'conv_w': conv_w, 'conv_b': conv_b,
        'dt_bias': dt_bias, 'a_log': a_log, 'm_d': m_d, 'm_norm_w': m_norm_w, 'm_proj': m_proj,
        's5_lam_re': s5_lam_re, 's5_lam_im': s5_lam_im, 's5_log_step': s5_log_step,
        's5_b_re': s5_b_re, 's5_b_im': s5_b_im, 's5_c_re': s5_c_re, 's5_c_im': s5_c_im,
        's5_d': s5_d, 's5_glu_w': s5_glu_w,
        'attn_sinks': attn_sinks, 'attn_o': attn_o, 'w_out': w_out,
        'norm2_w': norm2_w, 'mlp_up': mlp_up, 'mlp_down': mlp_down,
        'final_norm_w': final_norm_w,
    }


def reference(x_prompt, x_sample, state_ssm, state_conv, state_s5_re, state_s5_im, cache_k, cache_v,
              norm1_w, w_in, conv_w, conv_b, dt_bias, a_log, m_d, m_norm_w, m_proj,
              s5_lam_re, s5_lam_im, s5_log_step, s5_b_re, s5_b_im, s5_c_re, s5_c_im, s5_d, s5_glu_w,
              attn_sinks, attn_o, w_out, norm2_w, mlp_up, mlp_down, final_norm_w):
    xp = x_prompt
    xs = x_sample
    bp = xp.shape[0]
    dty = xp.dtype
    conv0 = jnp.zeros((bp, CONV_W - 1, CONV_DIM), dty)
    ssm0 = jnp.zeros((bp, M_HEADS, M_HEADDIM, M_STATE), dty)
    s50 = jnp.zeros((bp, S5_GROUPS, S5_STATE), dty)
    conv_p, conv_s, ssm_p, ssm_s = [], [], [], []
    s5re_p, s5re_s, s5im_p, s5im_s = [], [], [], []
    k_p, k_s, v_p, v_s = [], [], [], []
    for l in range(DEPTH):
        lp = (norm1_w[l], w_in[l], conv_w[l], conv_b[l], dt_bias[l], a_log[l], m_d[l], m_norm_w[l], m_proj[l],
              s5_lam_re[l], s5_lam_im[l], s5_log_step[l], s5_b_re[l], s5_b_im[l], s5_c_re[l], s5_c_im[l],
              s5_d[l], s5_glu_w[l], attn_sinks[l], attn_o[l], w_out[l], norm2_w[l], mlp_up[l], mlp_down[l])
        xp, c_n, h_n, r_n, i_n, kk, vv = _layer(xp, 0, conv0, ssm0, s50, s50, None, None, *lp)
        conv_p.append(c_n)
        ssm_p.append(h_n)
        s5re_p.append(r_n)
        s5im_p.append(i_n)
        k_p.append(kk)
        v_p.append(vv)
        xs, c_n, h_n, r_n, i_n, kk, vv = _layer(xs, PAST_LEN, state_conv[l], state_ssm[l], state_s5_re[l],
                                                state_s5_im[l], cache_k[l], cache_v[l], *lp)
        conv_s.append(c_n)
        ssm_s.append(h_n)
        s5re_s.append(r_n)
        s5im_s.append(i_n)
        k_s.append(kk)
        v_s.append(vv)
    y_prompt = _rmsnorm(xp, final_norm_w)
    y_sample = _rmsnorm(xs, final_norm_w)
    return (y_prompt, y_sample,
            jnp.stack(ssm_p), jnp.stack(ssm_s), jnp.stack(conv_p), jnp.stack(conv_s),
            jnp.stack(s5re_p), jnp.stack(s5re_s), jnp.stack(s5im_p), jnp.stack(s5im_s),
            jnp.stack(k_p), jnp.stack(k_s), jnp.stack(v_p), jnp.stack(v_s))
```

```cpp
#include <hip/hip_runtime.h>
#include <hip/hip_cooperative_groups.h>
#include <cstdio>
#include <cstdint>
namespace cg = cooperative_groups;

#define DI __device__ __forceinline__
typedef unsigned short bf16_t;
typedef short bf16x8 __attribute__((ext_vector_type(8)));
typedef float f32x16 __attribute__((ext_vector_type(16)));
typedef float f32x4 __attribute__((ext_vector_type(4)));
#define MFMA32(a, b, c) __builtin_amdgcn_mfma_f32_32x32x16_bf16((a), (b), (c), 0, 0, 0)
#define MFMA16(a, b, c) __builtin_amdgcn_mfma_f32_16x16x32_bf16((a), (b), (c), 0, 0, 0)

#ifndef COOP_MODE
#define COOP_MODE 1
#endif

constexpr int TP = 16384, TS = 128, T = TP + TS, SEQ = 8192;
constexpr int NIN = 8720, NINP = 8832;
constexpr int SMEM_BYTES = 73728;
constexpr float EPS = 1e-6f;

constexpr size_t OFF_YP = 0;
constexpr size_t OFF_YS = OFF_YP + (size_t)TP * 1024;
constexpr size_t OFF_SSMP = OFF_YS + (size_t)TS * 1024;
constexpr size_t OFF_SSMS = OFF_SSMP + (size_t)4 * 2 * 16 * 64 * 128;
constexpr size_t OFF_CONVP = OFF_SSMS + (size_t)4 * 128 * 16 * 64 * 128;
constexpr size_t OFF_CONVS = OFF_CONVP + (size_t)4 * 2 * 3 * 2048;
constexpr size_t OFF_S5RP = OFF_CONVS + (size_t)4 * 128 * 3 * 2048;
constexpr size_t OFF_S5RS = OFF_S5RP + (size_t)4 * 2 * 64 * 64;
constexpr size_t OFF_S5IP = OFF_S5RS + (size_t)4 * 128 * 64 * 64;
constexpr size_t OFF_S5IS = OFF_S5IP + (size_t)4 * 2 * 64 * 64;
constexpr size_t OFF_KP = OFF_S5IS + (size_t)4 * 128 * 64 * 64;
constexpr size_t OFF_KS = OFF_KP + (size_t)4 * 2 * 128 * 256;
constexpr size_t OFF_VP = OFF_KS + (size_t)4 * 128 * 128 * 256;
constexpr size_t OFF_VS = OFF_VP + (size_t)4 * 2 * 128 * 256;

constexpr size_t WO_IN = 0;
constexpr size_t WO_MPROJ = WO_IN + (size_t)NINP * 1024;
constexpr size_t WO_GLU = WO_MPROJ + (size_t)1024 * 1024;
constexpr size_t WO_ATTNO = WO_GLU + (size_t)2048 * 1024;
constexpr size_t WO_WOUT = WO_ATTNO + (size_t)1024 * 1024;
constexpr size_t WO_UP = WO_WOUT + (size_t)1024 * 1024;
constexpr size_t WO_DOWN = WO_UP + (size_t)4096 * 1024;
constexpr size_t W_LAYER = WO_DOWN + (size_t)4096 * 1024;

struct P {
  const float *x_prompt, *x_sample, *state_ssm, *state_conv, *s5_sre, *s5_sim, *cache_k, *cache_v;
  const float *norm1_w, *w_in, *conv_w, *conv_b, *dt_bias, *a_log, *m_d, *m_norm_w, *m_proj;
  const float *lam_re, *lam_im, *log_step, *b_re, *b_im, *c_re, *c_im, *s5_d, *glu_w;
  const float *sinks, *attn_o, *w_out, *norm2_w, *mlp_up, *mlp_down, *final_w;
  float* out;
  float* X;
  bf16_t *H, *Z, *XBC, *U, *Q, *K, *VT, *G, *YM, *YS, *O, *MG, *A2, *XBT, *BC, *Wt;
  float *DT, *ST, *CDEC, *S5S, *S5P;
  float2* ROPE;
};

DI bf16_t f2bf(float x) { unsigned u = __float_as_uint(x); u += 0x7fffu + ((u >> 16) & 1u); return (bf16_t)(u >> 16); }
DI float bf2f(bf16_t b) { return __uint_as_float(((unsigned)b) << 16); }
DI unsigned pack2(float a, float b) { return (unsigned)f2bf(a) | ((unsigned)f2bf(b) << 16); }
DI float bflo(unsigned u) { return __uint_as_float(u << 16); }
DI float bfhi(unsigned u) { return __uint_as_float(u & 0xffff0000u); }
DI float silu_f(float x) { return x / (1.f + __expf(-x)); }
DI float sigm_f(float x) { return 1.f / (1.f + __expf(-x)); }
DI float softplus_f(float x) { return x > 20.f ? x : log1pf(expf(x)); }
DI float gelu_tanh(float x) { float y = 0.7978845608028654f * (x + 0.044715f * x * x * x); float t = 1.f - 2.f / (__expf(2.f * y) + 1.f); return 0.5f * x * (1.f + t); }
DI int crow(int i, int lh) { return (i & 3) + 8 * (i >> 2) + 4 * lh; }
DI int launder(int x) { asm volatile("" : "+v"(x)); return x; }
DI int tidx() { int t = __builtin_amdgcn_workitem_id_x(); asm volatile("" : "+v"(t)); return t; }
DI int launder_s(int x) { asm volatile("" : "+s"(x)); return x; }
DI float wave_sum(float v) {
#pragma unroll
  for (int o = 32; o >= 1; o >>= 1) v += __shfl_xor(v, o);
  return v;
}
DI float wave_max(float v) {
#pragma unroll
  for (int o = 32; o >= 1; o >>= 1) v = fmaxf(v, __shfl_xor(v, o));
  return v;
}
DI bf16x8 u4_to_bf8(uint4 v) { return __builtin_bit_cast(bf16x8, v); }
DI void zero16(f32x16& a) {
#pragma unroll
  for (int i = 0; i < 16; ++i) a[i] = 0.f;
}

constexpr int LDT = 72;
DI void gemm_mainloop(const bf16_t* __restrict__ A, int lda, const bf16_t* __restrict__ B, int ldb, int K,
                      f32x16 (&acc)[2][2], char* smem) {
  bf16_t* sa = (bf16_t*)smem;
  bf16_t* sb = sa + 2 * 128 * LDT;
  const int tid = tidx(), lane = tid & 63, w = __builtin_amdgcn_readfirstlane(tid >> 6), wm = w & 1, wn = w >> 1, lr = lane & 31, lh = lane >> 5;
  const int r0 = tid >> 3, ch = (tid & 7) * 8;
  const bf16_t* ap = A + (size_t)r0 * lda + ch;
  const bf16_t* bp = B + (size_t)r0 * ldb + ch;
  uint4 ra0, ra1, ra2, ra3, rb0, rb1, rb2, rb3;
#define GLOADS(k0)                                                                                   \
  ra0 = *(const uint4*)(ap + (k0)); ra1 = *(const uint4*)(ap + (size_t)32 * lda + (k0));            \
  ra2 = *(const uint4*)(ap + (size_t)64 * lda + (k0)); ra3 = *(const uint4*)(ap + (size_t)96 * lda + (k0)); \
  rb0 = *(const uint4*)(bp + (k0)); rb1 = *(const uint4*)(bp + (size_t)32 * ldb + (k0));            \
  rb2 = *(const uint4*)(bp + (size_t)64 * ldb + (k0)); rb3 = *(const uint4*)(bp + (size_t)96 * ldb + (k0));
#define SSTORES(da, db)                                                                              \
  *(uint4*)((da) + (r0)*LDT + ch) = ra0; *(uint4*)((da) + (r0 + 32) * LDT + ch) = ra1;               \
  *(uint4*)((da) + (r0 + 64) * LDT + ch) = ra2; *(uint4*)((da) + (r0 + 96) * LDT + ch) = ra3;        \
  *(uint4*)((db) + (r0)*LDT + ch) = rb0; *(uint4*)((db) + (r0 + 32) * LDT + ch) = rb1;               \
  *(uint4*)((db) + (r0 + 64) * LDT + ch) = rb2; *(uint4*)((db) + (r0 + 96) * LDT + ch) = rb3;
  GLOADS(0)
  __syncthreads();
  SSTORES(sa, sb)
  __syncthreads();
  const int nk = K >> 6;
  for (int kt = 0; kt < nk; ++kt) {
    const int buf = kt & 1;
    const int k0 = (kt + 1 < nk) ? (kt + 1) * 64 : kt * 64;
    GLOADS(k0)
    const bf16_t* ca = sa + buf * 128 * LDT + (wm * 64 + lr) * LDT + lh * 8;
    const bf16_t* cb = sb + buf * 128 * LDT + (wn * 64 + lr) * LDT + lh * 8;
#pragma unroll
    for (int kk = 0; kk < 4; ++kk) {
      const bf16x8 af0 = *(const bf16x8*)(ca + kk * 16), af1 = *(const bf16x8*)(ca + 32 * LDT + kk * 16);
      const bf16x8 bf0 = *(const bf16x8*)(cb + kk * 16), bf1 = *(const bf16x8*)(cb + 32 * LDT + kk * 16);
      acc[0][0] = MFMA32(af0, bf0, acc[0][0]);
      acc[0][1] = MFMA32(af0, bf1, acc[0][1]);
      acc[1][0] = MFMA32(af1, bf0, acc[1][0]);
      acc[1][1] = MFMA32(af1, bf1, acc[1][1]);
    }
    bf16_t* da = sa + (buf ^ 1) * 128 * LDT;
    bf16_t* db = sb + (buf ^ 1) * 128 * LDT;
    SSTORES(da, db)
    __syncthreads();
  }
#undef GLOADS
#undef SSTORES
}

DI int win_map(int n) {
  if (n < 3072) return n;
  if (n < 8704) return n + 16;
  if (n < 8720) return n - 8704 + 3072;
  return -1;
}
DI void wtrans_tile(const float* __restrict__ src, int N, int K, bf16_t* __restrict__ dst, int kt, int nt, bool inmap, char* smem) {
  float* s = (float*)smem;
  const int tid = tidx();
  __syncthreads();
  const int nn = tid & 63;
  int sc = nt * 64 + nn;
  if (inmap) sc = win_map(sc);
#pragma unroll
  for (int it = 0; it < 16; ++it) {
    const int kk = it * 4 + (tid >> 6);
    s[kk * 65 + nn] = (sc >= 0) ? src[(size_t)(kt * 64 + kk) * N + sc] : 0.f;
  }
  __syncthreads();
#pragma unroll
  for (int it = 0; it < 16; ++it) {
    const int n2 = it * 4 + (tid >> 6), k2 = tid & 63;
    dst[(size_t)(nt * 64 + n2) * K + kt * 64 + k2] = f2bf(s[k2 * 65 + n2]);
  }
}
DI void prep_weight_job(const P& p, int j, char* smem) {
  const int l = j / 5536; int r = j % 5536;
  bf16_t* wl = p.Wt + (size_t)l * W_LAYER;
  if (r < 2208) { wtrans_tile(p.w_in + (size_t)l * 1024 * NIN, NIN, 1024, wl + WO_IN, r / 138, r % 138, true, smem); return; }
  r -= 2208;
  if (r < 256) { wtrans_tile(p.m_proj + (size_t)l * 1024 * 1024, 1024, 1024, wl + WO_MPROJ, r / 16, r % 16, false, smem); return; }
  r -= 256;
  if (r < 512) { wtrans_tile(p.glu_w + (size_t)l * 1024 * 2048, 2048, 1024, wl + WO_GLU, r / 32, r % 32, false, smem); return; }
  r -= 512;
  if (r < 256) { wtrans_tile(p.attn_o + (size_t)l * 1024 * 1024, 1024, 1024, wl + WO_ATTNO, r / 16, r % 16, false, smem); return; }
  r -= 256;
  if (r < 256) { wtrans_tile(p.w_out + (size_t)l * 1024 * 1024, 1024, 1024, wl + WO_WOUT, r / 16, r % 16, false, smem); return; }
  r -= 256;
  if (r < 1024) { wtrans_tile(p.mlp_up + (size_t)l * 1024 * 4096, 4096, 1024, wl + WO_UP, r / 64, r % 64, false, smem); return; }
  r -= 1024;
  wtrans_tile(p.mlp_down + (size_t)l * 4096 * 1024, 1024, 4096, wl + WO_DOWN, r / 16, r % 16, false, smem);
}
DI void prep_s5_job(const P& p, int j) {
  const int idx = j * 256 + tidx();
  const int n = idx & 63, g = (idx >> 6) & 63, l = idx >> 12;
  const double step = exp((double)p.log_step[l * 64 + g]);
  const double lr_ = p.lam_re[(l * 64 + g) * 64 + n], li = p.lam_im[(l * 64 + g) * 64 + n];
  const double mag = exp(lr_ * step);
  const double abr = mag * cos(li * step), abi = mag * sin(li * step);
  const double magq = exp(lr_ * step * 64.0);
  const double aqr = magq * cos(li * step * 64.0), aqi = magq * sin(li * step * 64.0);
  const double den = lr_ * lr_ + li * li;
  const double nr = abr - 1.0, ni = abi;
  const double fre = (nr * lr_ + ni * li) / den, fim = (ni * lr_ - nr * li) / den;
  float* o = p.S5P + ((size_t)(l * 64 + g) * 36) * 64 + n;
  o[0] = (float)abr; o[64] = (float)abi; o[128] = (float)aqr; o[192] = (float)aqi;
  const float* br = p.b_re + ((size_t)(l * 64 + g) * 64 + n) * 16;
  const float* bi = p.b_im + ((size_t)(l * 64 + g) * 64 + n) * 16;
#pragma unroll
  for (int i = 0; i < 16; ++i) {
    const double b_r = br[i], b_i = bi[i];
    o[(4 + i) * 64] = (float)(fre * b_r - fim * b_i);
    o[(20 + i) * 64] = (float)(fre * b_i + fim * b_r);
  }
}
DI void prep_rope_job(const P& p, int j) {
  const int idx = j * 256 + tidx();
  if (idx >= 8193 * 8) return;
  const int pos = idx >> 3, f = idx & 7;
  const float invf = expf(-(2.0f * (float)f / 16.0f) * logf(500000.0f));
  const float ang = (float)pos * invf;
  p.ROPE[idx] = make_float2((float)cos((double)ang), (float)sin((double)ang));
}

DI void norm_job(const P& p, int job, const float* wgt, bool layer0, bool final_) {
  const int w = __builtin_amdgcn_readfirstlane(tidx() >> 6), lane = tidx() & 63;
  const int r = job * 4 + w;
  const float* src = layer0 ? (r < TP ? p.x_prompt + (size_t)r * 1024 : p.x_sample + (size_t)(r - TP) * 1024) : p.X + (size_t)r * 1024;
  float4 v[4];
  float ss = 0.f;
#pragma unroll
  for (int q = 0; q < 4; ++q) { v[q] = ((const float4*)src)[lane + 64 * q]; ss += v[q].x * v[q].x + v[q].y * v[q].y + v[q].z * v[q].z + v[q].w * v[q].w; }
  ss = wave_sum(ss);
  const float sc = rsqrtf(ss * (1.f / 1024.f) + EPS);
#pragma unroll
  for (int q = 0; q < 4; ++q) {
    const float4 wv = ((const float4*)wgt)[lane + 64 * q];
    float4 y = make_float4(v[q].x * sc * wv.x, v[q].y * sc * wv.y, v[q].z * sc * wv.z, v[q].w * sc * wv.w);
    if (final_) ((float4*)(p.out + OFF_YP + (size_t)r * 1024))[lane + 64 * q] = y;
    else *(uint2*)(p.H + (size_t)r * 1024 + (lane + 64 * q) * 4) = make_uint2(pack2(y.x, y.y), pack2(y.z, y.w));
    if (layer0) ((float4*)(p.X + (size_t)r * 1024))[lane + 64 * q] = v[q];
  }
}

DI void inproj_job(const P& p, int l, int job, char* smem) {
  const int mt = job / 69, nt = job % 69;
  const int m0 = mt * 128, n0 = nt * 128;
  f32x16 acc[2][2];
#pragma unroll
  for (int a = 0; a < 2; ++a)
#pragma unroll
    for (int b = 0; b < 2; ++b) zero16(acc[a][b]);
  gemm_mainloop(p.H + (size_t)m0 * 1024, 1024, p.Wt + (size_t)l * W_LAYER + WO_IN + (size_t)n0 * 1024, 1024, 1024, acc, smem);
  const int tid = tidx(), lane = tid & 63, w = __builtin_amdgcn_readfirstlane(tid >> 6), wm = w & 1, wn = w >> 1, lr = lane & 31, lh = lane >> 5;
#pragma unroll
  for (int ni = 0; ni < 2; ++ni) {
    const int cb = n0 + wn * 64 + ni * 32;
    if (cb >= NIN) continue;
    const int c = cb + lr;
#pragma unroll
    for (int mi = 0; mi < 2; ++mi) {
      const int rbase = m0 + wm * 64 + mi * 32 + 4 * lh;
      if (cb < 1024) {
#pragma unroll
        for (int i = 0; i < 16; ++i) { const int r = rbase + (i & 3) + 8 * (i >> 2); p.Z[(size_t)r * 1024 + c] = f2bf(acc[mi][ni][i]); }
      } else if (cb < 3072) {
        const int ch = c - 1024;
#pragma unroll
        for (int i = 0; i < 16; ++i) {
          const int r = rbase + (i & 3) + 8 * (i >> 2);
          const float v = acc[mi][ni][i];
          p.XBC[(size_t)r * 2048 + ch] = f2bf(v);
          if (r >= TP) p.out[OFF_CONVS + ((size_t)(l * 128 + (r - TP)) * 3 + 2) * 2048 + ch] = v;
          else { const int t = r & 8191; if (t >= 8189) p.out[OFF_CONVP + ((size_t)(l * 2 + (r >> 13)) * 3 + (t - 8189)) * 2048 + ch] = v; }
        }
      } else if (cb < 4096) {
#pragma unroll
        for (int i = 0; i < 16; ++i) { const int r = rbase + (i & 3) + 8 * (i >> 2); p.U[(size_t)r * 1024 + (c - 3072)] = f2bf(acc[mi][ni][i]); }
      } else if (cb < 5376) {
        const bool isq = cb < 5120;
        const int cc = isq ? c - 4096 : c - 5120;
        const bool ropeblk = ((cb & 63) == 0);
#pragma unroll
        for (int i = 0; i < 16; ++i) {
          const int r = rbase + (i & 3) + 8 * (i >> 2);
          float v = acc[mi][ni][i];
          if (ropeblk) {
            const float pv = __shfl_xor(v, 8);
            if (lr < 16) {
              const int pos = (r >= TP) ? 8192 : (r & 8191);
              const float2 cs = p.ROPE[pos * 8 + (lr & 7)];
              v = (lr < 8) ? v * cs.x - pv * cs.y : v * cs.x + pv * cs.y;
            }
          }
          if (isq) p.Q[(size_t)r * 1024 + cc] = f2bf(v);
          else {
            p.K[(size_t)r * 256 + cc] = f2bf(v);
            if (r >= TP) p.out[OFF_KS + ((size_t)(l * 128 + (r - TP)) * 128 + 127) * 256 + cc] = v;
            else { const int t = r & 8191; if (t >= 8064) p.out[OFF_KP + ((size_t)(l * 2 + (r >> 13)) * 128 + (t - 8064)) * 256 + cc] = v; }
          }
        }
      } else if (cb < 5632) {
        const int cc = c - 5376;
#pragma unroll
        for (int ig = 0; ig < 4; ++ig) {
          const int r0 = rbase + 8 * ig;
          const float v0 = acc[mi][ni][4 * ig], v1 = acc[mi][ni][4 * ig + 1], v2 = acc[mi][ni][4 * ig + 2], v3 = acc[mi][ni][4 * ig + 3];
          *(uint2*)(p.VT + (size_t)cc * T + r0) = make_uint2(pack2(v0, v1), pack2(v2, v3));
#pragma unroll
          for (int jj = 0; jj < 4; ++jj) {
            const int r = r0 + jj;
            const float v = acc[mi][ni][4 * ig + jj];
            if (r >= TP) p.out[OFF_VS + ((size_t)(l * 128 + (r - TP)) * 128 + 127) * 256 + cc] = v;
            else { const int t = r & 8191; if (t >= 8064) p.out[OFF_VP + ((size_t)(l * 2 + (r >> 13)) * 128 + (t - 8064)) * 256 + cc] = v; }
          }
        }
      } else if (cb < 8704) {
#pragma unroll
        for (int i = 0; i < 16; ++i) { const int r = rbase + (i & 3) + 8 * (i >> 2); p.G[(size_t)r * 3072 + (c - 5632)] = f2bf(sigm_f(acc[mi][ni][i])); }
      } else {
        if (lr < 16) {
          const float bias = p.dt_bias[l * 16 + lr];
#pragma unroll
          for (int i = 0; i < 16; ++i) { const int r = rbase + (i & 3) + 8 * (i >> 2); p.DT[(size_t)r * 16 + lr] = softplus_f(acc[mi][ni][i] + bias); }
        }
      }
    }
  }
}

DI void conv_job(const P& p, int l, int job, char* smem) {
  const int ct = job & 31, tt = job >> 5;
  const int ch0 = ct * 64, tokb = tt * 128;
  bf16_t* sT = (bf16_t*)smem;
  const int tid = tidx();
  const float* cw = p.conv_w + (size_t)l * 4 * 2048;
  __syncthreads();
#pragma unroll
  for (int it = 0; it < 4; ++it) {
    const int item = tid + 256 * it, tl = item >> 3, chk = item & 7, ch = ch0 + chk * 8, row = tokb + tl, t = row & 8191;
    float a[8];
    {
      const float4 b0 = *(const float4*)(p.conv_b + l * 2048 + ch), b1 = *(const float4*)(p.conv_b + l * 2048 + ch + 4);
      a[0] = b0.x; a[1] = b0.y; a[2] = b0.z; a[3] = b0.w; a[4] = b1.x; a[5] = b1.y; a[6] = b1.z; a[7] = b1.w;
    }
#pragma unroll
    for (int j = 0; j < 4; ++j) {
      if (t - 3 + j >= 0) {
        const uint4 rv = *(const uint4*)(p.XBC + (size_t)(row - 3 + j) * 2048 + ch);
        const float4 w0 = *(const float4*)(cw + j * 2048 + ch), w1 = *(const float4*)(cw + j * 2048 + ch + 4);
        a[0] += bflo(rv.x) * w0.x; a[1] += bfhi(rv.x) * w0.y; a[2] += bflo(rv.y) * w0.z; a[3] += bfhi(rv.y) * w0.w;
        a[4] += bflo(rv.z) * w1.x; a[5] += bfhi(rv.z) * w1.y; a[6] += bflo(rv.w) * w1.z; a[7] += bfhi(rv.w) * w1.w;
      }
    }
#pragma unroll
    for (int j = 0; j < 8; ++j) a[j] = silu_f(a[j]);
    if (ct >= 16) *(uint4*)(p.BC + (size_t)row * 1024 + (ch - 1024)) = make_uint4(pack2(a[0], a[1]), pack2(a[2], a[3]), pack2(a[4], a[5]), pack2(a[6], a[7]));
    if (ct < 24) {
#pragma unroll
      for (int j = 0; j < 8; ++j) sT[(chk * 8 + j) * 136 + tl] = f2bf(a[j]);
    }
  }
  if (ct < 24) {
    __syncthreads();
#pragma unroll
    for (int it = 0; it < 4; ++it) {
      const int item = tid + 256 * it, r = item >> 4, chk = item & 15;
      *(uint4*)(p.XBT + (size_t)(ch0 + r) * TP + tokb + chk * 8) = *(const uint4*)(sT + r * 136 + chk * 8);
    }
  }
}

DI void chunk_acum(const P& p, int l, int head, int tok0, float* sAc, float* sDt, float& alast) {
  const int lane = tidx() & 63;
  const float Ah = -expf(p.a_log[l * 16 + head]);
  const float d0 = p.DT[(size_t)(tok0 + 2 * lane) * 16 + head], d1 = p.DT[(size_t)(tok0 + 2 * lane + 1) * 16 + head];
  const float a0 = d0 * Ah, a1 = d1 * Ah;
  float s = a0 + a1;
#pragma unroll
  for (int off = 1; off < 64; off <<= 1) { const float tv = __shfl_up(s, off); if (lane >= off) s += tv; }
  const float excl = s - (a0 + a1);
  sAc[2 * lane] = excl + a0; sAc[2 * lane + 1] = s;
  sDt[2 * lane] = d0; sDt[2 * lane + 1] = d1;
  alast = __shfl(s, 63);
}

DI void ssd_a_job(const P& p, int l, int job, char* smem) {
  const int head = job & 15, c = (job >> 4) & 63, b = job >> 10, g = head >> 2;
  const int tok0 = b * SEQ + c * 128;
  bf16_t* sXT = (bf16_t*)smem;
  bf16_t* sBT = sXT + 64 * 136;
  float* sW = (float*)(sBT + 128 * 136);
  float* sAc = sW + 128;
  float* sDt = sAc + 128;
  const int tid = tidx(), lane = tid & 63, w = __builtin_amdgcn_readfirstlane(tid >> 6), lr = lane & 31, lh = lane >> 5;
  __syncthreads();
  if (w == 0) {
    float alast;
    chunk_acum(p, l, head, tok0, sAc, sDt, alast);
    sW[2 * lane] = sDt[2 * lane] * __expf(alast - sAc[2 * lane]);
    sW[2 * lane + 1] = sDt[2 * lane + 1] * __expf(alast - sAc[2 * lane + 1]);
    if (lane == 0) p.CDEC[(b * 64 + c) * 16 + head] = __expf(alast);
  }
  __syncthreads();
#pragma unroll
  for (int it = 0; it < 4; ++it) {
    const int item = tid + 256 * it, pr = item >> 4, s0 = (item & 15) * 8;
    const uint4 v = *(const uint4*)(p.XBT + (size_t)(head * 64 + pr) * TP + tok0 + s0);
    const float4 w0 = *(const float4*)(sW + s0), w1 = *(const float4*)(sW + s0 + 4);
    *(uint4*)(sXT + pr * 136 + s0) = make_uint4(pack2(bflo(v.x) * w0.x, bfhi(v.x) * w0.y), pack2(bflo(v.y) * w0.z, bfhi(v.y) * w0.w),
                                                pack2(bflo(v.z) * w1.x, bfhi(v.z) * w1.y), pack2(bflo(v.w) * w1.z, bfhi(v.w) * w1.w));
  }
#pragma unroll
  for (int it = 0; it < 8; ++it) {
    const int item = tid + 256 * it, n = item >> 4, s0 = (item & 15) * 8;
    *(uint4*)(sBT + n * 136 + s0) = *(const uint4*)(p.XBT + (size_t)(1024 + g * 128 + n) * TP + tok0 + s0);
  }
  __syncthreads();
  const int wp = w & 1, wn = w >> 1;
  f32x16 acc[2];
  zero16(acc[0]); zero16(acc[1]);
#pragma unroll
  for (int kk = 0; kk < 8; ++kk) {
    const bf16x8 af = *(const bf16x8*)(sXT + (wp * 32 + lr) * 136 + kk * 16 + lh * 8);
#pragma unroll
    for (int ni = 0; ni < 2; ++ni) {
      const bf16x8 bfr = *(const bf16x8*)(sBT + (wn * 64 + ni * 32 + lr) * 136 + kk * 16 + lh * 8);
      acc[ni] = MFMA32(af, bfr, acc[ni]);
    }
  }
  float* st = p.ST + ((size_t)((b * 64 + c) * 16 + head) * 64) * 128;
#pragma unroll
  for (int ni = 0; ni < 2; ++ni)
#pragma unroll
    for (int i = 0; i < 16; ++i) st[(wp * 32 + crow(i, lh)) * 128 + wn * 64 + ni * 32 + lr] = acc[ni][i];
}

DI void ssd_scan_job(const P& p, int l, int job) {
  const int gid = job * 256 + tidx();
  const int b = gid >> 15, rem = gid & 32767, head = rem >> 11;
  float4 h = make_float4(0.f, 0.f, 0.f, 0.f);
  for (int c = 0; c < 64; ++c) {
    float4* sp = (float4*)(p.ST + (size_t)(b * 64 + c) * 131072) + rem;
    const float4 s = *sp;
    const float dec = p.CDEC[(b * 64 + c) * 16 + head];
    *sp = h;
    h.x = h.x * dec + s.x; h.y = h.y * dec + s.y; h.z = h.z * dec + s.z; h.w = h.w * dec + s.w;
  }
  ((float4*)(p.out + OFF_SSMP + (size_t)(l * 2 + b) * 131072))[rem] = h;
}

DI void ssd_c_job(const P& p, int l, int job, char* smem) {
  const int g = job & 3, c = (job >> 2) & 63, b = job >> 8;
  const int tok0 = b * SEQ + c * 128;
  bf16_t* sC = (bf16_t*)smem;
  bf16_t* sB = sC + 128 * 136;
  float* sAc = (float*)(sB + 128 * 136);
  float* sDt = sAc + 512;
  const int tid = tidx(), lane = tid & 63, w = __builtin_amdgcn_readfirstlane(tid >> 6), lr = lane & 31, lh = lane >> 5, wm = w & 1, wn = w >> 1;
  __syncthreads();
  { float alast; chunk_acum(p, l, g * 4 + w, tok0, sAc + w * 128, sDt + w * 128, alast); }
#pragma unroll
  for (int it = 0; it < 8; ++it) {
    const int item = tid + 256 * it, r = item >> 4, s0 = (item & 15) * 8;
    *(uint4*)(sC + r * 136 + s0) = *(const uint4*)(p.BC + (size_t)(tok0 + r) * 1024 + 512 + g * 128 + s0);
    *(uint4*)(sB + r * 136 + s0) = *(const uint4*)(p.BC + (size_t)(tok0 + r) * 1024 + g * 128 + s0);
  }
  __syncthreads();
  f32x16 cb[2][2];
#pragma unroll
  for (int a = 0; a < 2; ++a)
#pragma unroll
    for (int bb = 0; bb < 2; ++bb) zero16(cb[a][bb]);
  if (!(wm == 0 && wn == 1)) {
#pragma unroll
    for (int kk = 0; kk < 8; ++kk) {
      bf16x8 af[2], bfr[2];
#pragma unroll
      for (int mi = 0; mi < 2; ++mi) af[mi] = *(const bf16x8*)(sC + (wm * 64 + mi * 32 + lr) * 136 + kk * 16 + lh * 8);
#pragma unroll
      for (int ni = 0; ni < 2; ++ni) bfr[ni] = *(const bf16x8*)(sB + (wn * 64 + ni * 32 + lr) * 136 + kk * 16 + lh * 8);
#pragma unroll
      for (int mi = 0; mi < 2; ++mi)
#pragma unroll
        for (int ni = 0; ni < 2; ++ni) cb[mi][ni] = MFMA32(af[mi], bfr[ni], cb[mi][ni]);
    }
  }
  __syncthreads();
  bf16_t* sM = sB;
  unsigned cbp[2][2][8];
#pragma unroll
  for (int a = 0; a < 2; ++a)
#pragma unroll
    for (int bb = 0; bb < 2; ++bb)
#pragma unroll
      for (int k = 0; k < 8; ++k) cbp[a][bb][k] = pack2(cb[a][bb][2 * k], cb[a][bb][2 * k + 1]);
  float ss[16];
#pragma unroll
  for (int i = 0; i < 16; ++i) ss[i] = 0.f;
#pragma unroll 1
  for (int hd = 0; hd < 4; ++hd) {
    const int head = g * 4 + hd;
    const float* ac = sAc + hd * 128;
    const float* dtv = sDt + hd * 128;
    const int lrq = launder(lr), lhq = launder(lh);
#pragma unroll
    for (int mi = 0; mi < 2; ++mi)
#pragma unroll
      for (int ni = 0; ni < 2; ++ni) {
        const int s = wn * 64 + ni * 32 + lrq;
        const float as = ac[s], ds = dtv[s];
#pragma unroll
        for (int i = 0; i < 16; ++i) {
          const int t = wm * 64 + mi * 32 + crow(i, lhq);
          const float cv = (i & 1) ? bfhi(cbp[mi][ni][i >> 1]) : bflo(cbp[mi][ni][i >> 1]);
          const float v = (s <= t) ? cv * __expf(ac[t] - as) * ds : 0.f;
          sM[t * 136 + s] = f2bf(v);
        }
        __builtin_amdgcn_sched_barrier(0);
      }
    __syncthreads();
    f32x16 yd[2];
    zero16(yd[0]); zero16(yd[1]);
#pragma unroll 1
    for (int kk = 0; kk < 8; ++kk) {
      const bf16x8 af = *(const bf16x8*)(sC + (32 * w + lr) * 136 + kk * 16 + lh * 8);
#pragma unroll
      for (int pb = 0; pb < 2; ++pb) {
        const float* hp = p.ST + (((size_t)((b * 64 + c) * 16 + head) * 64 + pb * 32 + lr) * 128 + kk * 16 + lh * 8);
        const float4 h0 = ((const float4*)hp)[0], h1 = ((const float4*)hp)[1];
        const uint4 hv = make_uint4(pack2(h0.x, h0.y), pack2(h0.z, h0.w), pack2(h1.x, h1.y), pack2(h1.z, h1.w));
        yd[pb] = MFMA32(af, u4_to_bf8(hv), yd[pb]);
      }
    }
#pragma unroll
    for (int i = 0; i < 16; ++i) {
      const float e = __expf(ac[32 * w + crow(i, lh)]);
      yd[0][i] *= e; yd[1][i] *= e;
    }
    const int nkk = 2 * (w + 1);
    for (int kk = 0; kk < nkk; ++kk) {
      const bf16x8 af = *(const bf16x8*)(sM + (32 * w + lr) * 136 + kk * 16 + lh * 8);
#pragma unroll
      for (int pb = 0; pb < 2; ++pb) {
        const bf16x8 bfr = *(const bf16x8*)(p.XBT + (size_t)(head * 64 + pb * 32 + lr) * TP + tok0 + kk * 16 + lh * 8);
        yd[pb] = MFMA32(af, bfr, yd[pb]);
      }
    }
    const float Dh = p.m_d[l * 16 + head];
#pragma unroll
    for (int pb = 0; pb < 2; ++pb) {
      const int pch = head * 64 + pb * 32 + lr;
#pragma unroll
      for (int ig = 0; ig < 4; ++ig) {
        const int t0 = 32 * w + 8 * ig + 4 * lh;
        const uint2 xr = *(const uint2*)(p.XBT + (size_t)pch * TP + tok0 + t0);
        const float xs[4] = {bflo(xr.x), bfhi(xr.x), bflo(xr.y), bfhi(xr.y)};
#pragma unroll
        for (int jj = 0; jj < 4; ++jj) {
          const int i = 4 * ig + jj, t = t0 + jj;
          const float y = yd[pb][i] + Dh * xs[jj];
          const float z = bf2f(p.Z[(size_t)(tok0 + t) * 1024 + pch]);
          const float yg = y * silu_f(z);
          ss[i] += yg * yg;
          p.YM[(size_t)(tok0 + t) * 1024 + pch] = f2bf(yg);
        }
      }
      __builtin_amdgcn_sched_barrier(0);
    }
    __syncthreads();
  }
#pragma unroll
  for (int i = 0; i < 16; ++i) {
    float v = ss[i];
    v += __shfl_xor(v, 1); v += __shfl_xor(v, 2); v += __shfl_xor(v, 4); v += __shfl_xor(v, 8); v += __shfl_xor(v, 16);
    ss[i] = rsqrtf(v * (1.f / 256.f) + EPS);
  }
  for (int hd = 0; hd < 4; ++hd) {
#pragma unroll
    for (int pb = 0; pb < 2; ++pb) {
      const int pch = (g * 4 + hd) * 64 + pb * 32 + lr;
      const float nw = p.m_norm_w[l * 1024 + pch];
#pragma unroll
      for (int i = 0; i < 16; ++i) {
        const size_t idx = (size_t)(tok0 + 32 * w + crow(i, lh)) * 1024 + pch;
        p.YM[idx] = f2bf(bf2f(p.YM[idx]) * ss[i] * nw);
      }
      __builtin_amdgcn_sched_barrier(0);
    }
  }
}

DI void ssd_sample_job(const P& p, int l, int job, char* smem) {
  const int g = job & 3, b = job >> 2;
  float* sx = (float*)smem;
  float* sBv = sx + 256;
  float* sCv = sBv + 128;
  float* sY = sCv + 128;
  float* sRed = sY + 256;
  const int tid = tidx(), lane = tid & 63, w = __builtin_amdgcn_readfirstlane(tid >> 6);
  const int row = TP + b;
  __syncthreads();
#pragma unroll
  for (int it = 0; it < 2; ++it) {
    const int idx = tid + 256 * it;
    const int ch = idx < 256 ? g * 256 + idx : (idx < 384 ? 1024 + g * 128 + (idx - 256) : 1536 + g * 128 + (idx - 384));
    const float* sc = p.state_conv + ((size_t)(l * 128 + b) * 3) * 2048 + ch;
    const float s0 = sc[0], s1 = sc[2048], s2 = sc[4096];
    const float raw = bf2f(p.XBC[(size_t)row * 2048 + ch]);
    const float* cw = p.conv_w + (size_t)l * 4 * 2048 + ch;
    float v = p.conv_b[l * 2048 + ch] + cw[0] * s0 + cw[2048] * s1 + cw[4096] * s2 + cw[6144] * raw;
    v = silu_f(v);
    sx[idx] = v;
    float* co = p.out + OFF_CONVS + ((size_t)(l * 128 + b) * 3) * 2048 + ch;
    co[0] = s1; co[2048] = s2;
  }
  __syncthreads();
  for (int hd = 0; hd < 4; ++hd) {
    const int head = g * 4 + hd;
    const float dt = p.DT[(size_t)row * 16 + head];
    const float Ah = -expf(p.a_log[l * 16 + head]);
    const float dA = __expf(dt * Ah);
    const int pp = tid >> 2, nq = (tid & 3) * 32;
    const float xv = sx[hd * 64 + pp];
    const float coef = dt * xv;
    const size_t so = ((((size_t)l * 128 + b) * 16 + head) * 64 + pp) * 128 + nq;
    const float4* h0 = (const float4*)(p.state_ssm + so);
    float4* ho = (float4*)(p.out + OFF_SSMS + so);
    float yacc = 0.f;
#pragma unroll
    for (int q = 0; q < 8; ++q) {
      float4 hv = h0[q];
      const int n = nq + 4 * q;
      hv.x = hv.x * dA + coef * sBv[n]; hv.y = hv.y * dA + coef * sBv[n + 1]; hv.z = hv.z * dA + coef * sBv[n + 2]; hv.w = hv.w * dA + coef * sBv[n + 3];
      yacc += hv.x * sCv[n] + hv.y * sCv[n + 1] + hv.z * sCv[n + 2] + hv.w * sCv[n + 3];
      ho[q] = hv;
    }
    yacc += __shfl_xor(yacc, 1); yacc += __shfl_xor(yacc, 2);
    const float y = yacc + p.m_d[l * 16 + head] * xv;
    const float z = bf2f(p.Z[(size_t)row * 1024 + head * 64 + pp]);
    if ((tid & 3) == 0) sY[hd * 64 + pp] = y * silu_f(z);
  }
  __syncthreads();
  const float v = sY[tid];
  const float ssq = wave_sum(v * v);
  if (lane == 0) sRed[w] = ssq;
  __syncthreads();
  const float tot = sRed[0] + sRed[1] + sRed[2] + sRed[3];
  const float sc = rsqrtf(tot * (1.f / 256.f) + EPS);
  p.YM[(size_t)row * 1024 + g * 256 + tid] = f2bf(v * sc * p.m_norm_w[l * 1024 + g * 256 + tid]);
}

DI void s5_wave_job(const P& p, int l, int mode, int b, int g, int c, bf16_t* sH) {
  const int lane = tidx() & 63;
  const float* prm = p.S5P + ((size_t)(l * 64 + g) * 36) * 64 + lane;
  const float abr = prm[0], abi = prm[64];
  float bbr[16], bbi[16];
#pragma unroll
  for (int i = 0; i < 16; ++i) { bbr[i] = prm[(4 + i) * 64]; bbi[i] = prm[(20 + i) * 64]; }
  float hr = 0.f, hi = 0.f;
  int row0, Q;
  if (mode == 2) {
    row0 = TP + b; Q = 1;
    hr = p.s5_sre[((size_t)(l * 128 + b) * 64 + g) * 64 + lane];
    hi = p.s5_sim[((size_t)(l * 128 + b) * 64 + g) * 64 + lane];
  } else {
    row0 = b * SEQ + c * 64; Q = 64;
    if (mode == 1) {
      const float aqr = prm[128], aqi = prm[192];
      for (int j = 0; j < c; ++j) {
        const float2 s = *(const float2*)(p.S5S + (((size_t)(b * 128 + j) * 64 + g) * 64 + lane) * 2);
        const float nr = aqr * hr - aqi * hi + s.x, ni = aqr * hi + aqi * hr + s.y;
        hr = nr; hi = ni;
      }
    }
  }
  for (int t = 0; t < Q; ++t) {
    const uint4* up = (const uint4*)(p.U + (size_t)(row0 + t) * 1024 + g * 16);
    const uint4 u0 = up[0], u1 = up[1];
    const float uf[16] = {bflo(u0.x), bfhi(u0.x), bflo(u0.y), bfhi(u0.y), bflo(u0.z), bfhi(u0.z), bflo(u0.w), bfhi(u0.w),
                          bflo(u1.x), bfhi(u1.x), bflo(u1.y), bfhi(u1.y), bflo(u1.z), bfhi(u1.z), bflo(u1.w), bfhi(u1.w)};
    float br_ = 0.f, bi_ = 0.f;
#pragma unroll
    for (int i = 0; i < 16; ++i) { br_ += bbr[i] * uf[i]; bi_ += bbi[i] * uf[i]; }
    const float nr = abr * hr - abi * hi + br_, ni = abr * hi + abi * hr + bi_;
    hr = nr; hi = ni;
    if (mode != 0) { sH[t * 136 + lane] = f2bf(hr); sH[t * 136 + 64 + lane] = f2bf(hi); }
  }
  if (mode == 0) {
    *(float2*)(p.S5S + (((size_t)(b * 128 + c) * 64 + g) * 64 + lane) * 2) = make_float2(hr, hi);
    return;
  }
  if (mode == 1 && c == 127) {
    p.out[OFF_S5RP + ((size_t)(l * 2 + b) * 64 + g) * 64 + lane] = hr;
    p.out[OFF_S5IP + ((size_t)(l * 2 + b) * 64 + g) * 64 + lane] = hi;
  }
  if (mode == 2) {
    p.out[OFF_S5RS + ((size_t)(l * 128 + b) * 64 + g) * 64 + lane] = hr;
    p.out[OFF_S5IS + ((size_t)(l * 128 + b) * 64 + g) * 64 + lane] = hi;
  }
  const int o = lane & 15, quad = lane >> 4;
  bf16x8 cf[4];
#pragma unroll
  for (int kk = 0; kk < 4; ++kk) {
    const float* cp = ((kk < 2) ? p.c_re : p.c_im) + ((size_t)(l * 64 + g) * 16 + o) * 64 + (kk & 1) * 32 + quad * 8;
    const float4 c0 = ((const float4*)cp)[0], c1 = ((const float4*)cp)[1];
    const float sg = (kk < 2) ? 1.f : -1.f;
    cf[kk] = u4_to_bf8(make_uint4(pack2(sg * c0.x, sg * c0.y), pack2(sg * c0.z, sg * c0.w), pack2(sg * c1.x, sg * c1.y), pack2(sg * c1.z, sg * c1.w)));
  }
  const float dsk = p.s5_d[l * 1024 + g * 16 + o];
  const int nrb = (mode == 2) ? 1 : 4;
  __builtin_amdgcn_fence(__ATOMIC_RELEASE, "wavefront");
  __builtin_amdgcn_wave_barrier();
  __builtin_amdgcn_fence(__ATOMIC_ACQUIRE, "wavefront");
  for (int rb = 0; rb < nrb; ++rb) {
    f32x4 a4 = {0.f, 0.f, 0.f, 0.f};
#pragma unroll
    for (int kk = 0; kk < 4; ++kk) {
      const bf16x8 af = *(const bf16x8*)(sH + (rb * 16 + o) * 136 + kk * 32 + quad * 8);
      a4 = MFMA16(af, cf[kk], a4);
    }
#pragma unroll
    for (int jj = 0; jj < 4; ++jj) {
      const int t = rb * 16 + quad * 4 + jj;
      if (t < Q) {
        const size_t idx = (size_t)(row0 + t) * 1024 + g * 16 + o;
        const float y = a4[jj] + dsk * bf2f(p.U[idx]);
        p.YS[idx] = f2bf(gelu_tanh(y));
      }
    }
  }
}

DI void attn_prompt_job(const P& p, int l, int job, char* smem) {
  const int head = job & 15, blk = (job >> 4) & 63, b = job >> 10, kvh = head >> 2;
  bf16_t* sK = (bf16_t*)smem;
  bf16_t* sVt = sK + 256 * 72;
  const int tid = tidx(), lane = tid & 63, w = __builtin_amdgcn_readfirstlane(tid >> 6), lr = lane & 31, lh = lane >> 5;
  const int tokc0 = b * SEQ + blk * 128 - 128;
  __syncthreads();
#pragma unroll
  for (int it = 0; it < 8; ++it) {
    const int item = tid + 256 * it, row = item >> 3, chk = item & 7;
    uint4 v = make_uint4(0u, 0u, 0u, 0u);
    if (blk > 0 || row >= 128) v = *(const uint4*)(p.K + (size_t)(tokc0 + row) * 256 + kvh * 64 + chk * 8);
    *(uint4*)(sK + row * 72 + chk * 8) = v;
  }
#pragma unroll
  for (int it = 0; it < 8; ++it) {
    const int item = tid + 256 * it, d = item >> 5, chk = item & 31;
    uint4 v = make_uint4(0u, 0u, 0u, 0u);
    if (blk > 0 || chk >= 16) v = *(const uint4*)(p.VT + (size_t)(kvh * 64 + d) * T + tokc0 + chk * 8);
    *(uint4*)(sVt + d * 264 + chk * 8) = v;
  }
  __syncthreads();
  const int qtok = b * SEQ + blk * 128 + 32 * w + lr;
  bf16x8 qf[4];
#pragma unroll
  for (int kk = 0; kk < 4; ++kk) qf[kk] = *(const bf16x8*)(p.Q + (size_t)qtok * 1024 + head * 64 + kk * 16 + lh * 8);
  f32x16 st[5];
#pragma unroll
  for (int x = 0; x < 5; ++x) {
    zero16(st[x]);
#pragma unroll
    for (int kk = 0; kk < 4; ++kk) {
      const bf16x8 af = *(const bf16x8*)(sK + (32 * (w + x) + lr) * 72 + kk * 16 + lh * 8);
      st[x] = MFMA32(af, qf[kk], st[x]);
    }
  }
  const float sink = p.sinks[l * 16 + head];
  const int qi = 128 + 32 * w + lr;
  float m = sink;
#pragma unroll
  for (int x = 0; x < 5; ++x)
#pragma unroll
    for (int i = 0; i < 16; ++i) {
      const int kj = 32 * (w + x) + crow(i, lh);
      const bool valid = (kj <= qi) && (kj >= qi - 128) && (blk > 0 || kj >= 128);
      const float s = valid ? st[x][i] * 0.125f : -1e30f;
      st[x][i] = s;
      m = fmaxf(m, s);
    }
  m = fmaxf(m, __shfl_xor(m, 32));
  float sum = 0.f;
#pragma unroll
  for (int x = 0; x < 5; ++x)
#pragma unroll
    for (int i = 0; i < 16; ++i) { const float pv = __expf(st[x][i] - m); st[x][i] = pv; sum += pv; }
  sum += __shfl_xor(sum, 32);
  const float inv = 1.f / (sum + __expf(sink - m));
  f32x16 ot[2];
  zero16(ot[0]); zero16(ot[1]);
#pragma unroll
  for (int x = 0; x < 5; ++x)
#pragma unroll
    for (int s = 0; s < 2; ++s) {
      const uint4 pu = make_uint4(pack2(st[x][8 * s] * inv, st[x][8 * s + 1] * inv), pack2(st[x][8 * s + 2] * inv, st[x][8 * s + 3] * inv),
                                  pack2(st[x][8 * s + 4] * inv, st[x][8 * s + 5] * inv), pack2(st[x][8 * s + 6] * inv, st[x][8 * s + 7] * inv));
      const bf16x8 pf = u4_to_bf8(pu);
#pragma unroll
      for (int pb = 0; pb < 2; ++pb) {
        const bf16_t* vp = sVt + (pb * 32 + lr) * 264 + 32 * (w + x) + 16 * s + 4 * lh;
        const uint2 lo = *(const uint2*)vp, hi2 = *(const uint2*)(vp + 8);
        ot[pb] = MFMA32(u4_to_bf8(make_uint4(lo.x, lo.y, hi2.x, hi2.y)), pf, ot[pb]);
      }
    }
#pragma unroll
  for (int pb = 0; pb < 2; ++pb)
#pragma unroll
    for (int ig = 0; ig < 4; ++ig) {
      const int d0 = pb * 32 + 8 * ig + 4 * lh;
      *(uint2*)(p.O + (size_t)qtok * 1024 + head * 64 + d0) = make_uint2(pack2(ot[pb][4 * ig], ot[pb][4 * ig + 1]), pack2(ot[pb][4 * ig + 2], ot[pb][4 * ig + 3]));
    }
}

DI void attn_sample_job(const P& p, int l, int job, char* smem) {
  const int kvh = job & 3, b = job >> 2;
  const int tid = tidx(), lane = tid & 63, w = __builtin_amdgcn_readfirstlane(tid >> 6);
  const int head = kvh * 4 + w, row = TP + b;
  float* sP = (float*)smem + w * 192;
  __syncthreads();
  const float qd = bf2f(p.Q[(size_t)row * 1024 + head * 64 + lane]);
  const size_t cbase = ((size_t)(l * 128 + b) * 128) * 256 + kvh * 64 + lane;
  const float* kc = p.cache_k + cbase;
  const float* vc = p.cache_v + cbase;
  float* ko = p.out + OFF_KS + cbase;
  float* vo = p.out + OFF_VS + cbase;
  for (int j = 0; j < 128; ++j) {
    const float kv = kc[(size_t)j * 256];
    if (w == 0 && j >= 1) ko[(size_t)(j - 1) * 256] = kv;
    const float s = wave_sum(qd * kv) * 0.125f;
    if (lane == 0) sP[j] = s;
  }
  {
    const float kv = bf2f(p.K[(size_t)row * 256 + kvh * 64 + lane]);
    const float s = wave_sum(qd * kv) * 0.125f;
    if (lane == 0) sP[128] = s;
  }
  __syncthreads();
  const float sink = p.sinks[l * 16 + head];
  const float s0 = sP[lane], s1 = sP[lane + 64], s2 = sP[128];
  float m = fmaxf(fmaxf(s0, s1), fmaxf(s2, sink));
  m = wave_max(m);
  const float p0 = __expf(s0 - m), p1 = __expf(s1 - m), p2 = __expf(s2 - m);
  float sum = wave_sum(p0 + p1);
  const float inv = 1.f / (sum + p2 + __expf(sink - m));
  __syncthreads();
  sP[lane] = p0 * inv; sP[lane + 64] = p1 * inv;
  if (lane == 0) sP[128] = p2 * inv;
  __syncthreads();
  float o = 0.f;
  for (int j = 0; j < 128; ++j) {
    const float vv = vc[(size_t)j * 256];
    if (w == 0 && j >= 1) vo[(size_t)(j - 1) * 256] = vv;
    o += sP[j] * vv;
  }
  o += sP[128] * bf2f(p.VT[(size_t)(kvh * 64 + lane) * T + row]);
  p.O[(size_t)row * 1024 + head * 64 + lane] = f2bf(o);
}

template <int PASS>
DI void merge_pass(const P& p, const bf16_t* A, const bf16_t* Wt, int m0, int n0, char* smem) {
  m0 = launder_s(m0); n0 = launder_s(n0);
  const int tid = tidx(), lane = tid & 63, w = __builtin_amdgcn_readfirstlane(tid >> 6), wm = w & 1, wn = w >> 1, lr = lane & 31, lh = lane >> 5;
  f32x16 acc[2][2];
#pragma unroll
  for (int a = 0; a < 2; ++a)
#pragma unroll
    for (int b = 0; b < 2; ++b) zero16(acc[a][b]);
  gemm_mainloop(A + (size_t)m0 * 1024, 1024, Wt + (size_t)n0 * 1024, 1024, 1024, acc, smem);
  m0 = launder_s(m0); n0 = launder_s(n0);
#pragma unroll
  for (int mi = 0; mi < 2; ++mi)
#pragma unroll
    for (int ni = 0; ni < 2; ++ni) {
      const int c = n0 + wn * 64 + ni * 32 + lr;
#pragma unroll
      for (int i = 0; i < 16; ++i) {
        const int r = m0 + wm * 64 + mi * 32 + crow(i, lh);
        bf16_t* mp = p.MG + (size_t)r * 1024 + c;
        const float a = acc[mi][ni][i];
        if (PASS == 0) *mp = f2bf(sigm_f(a) * bf2f(p.G[(size_t)r * 3072 + 1024 + c]));
        else if (PASS == 1) *mp = f2bf(bf2f(*mp) * a);
        else if (PASS == 2) *mp = f2bf(bf2f(*mp) + a * bf2f(p.G[(size_t)r * 3072 + c]));
        else *mp = f2bf(bf2f(*mp) + a * bf2f(p.G[(size_t)r * 3072 + 2048 + c]));
      }
    }
}
DI void merge_job(const P& p, int l, int job, char* smem) {
  const int mt = job >> 3, nt = job & 7;
  const int m0 = mt * 128, n0 = nt * 128;
  const bf16_t* wl = p.Wt + (size_t)l * W_LAYER;
  merge_pass<0>(p, p.YS, wl + WO_GLU + (size_t)1024 * 1024, m0, n0, smem);
  merge_pass<1>(p, p.YS, wl + WO_GLU, m0, n0, smem);
  merge_pass<2>(p, p.YM, wl + WO_MPROJ, m0, n0, smem);
  merge_pass<3>(p, p.O, wl + WO_ATTNO, m0, n0, smem);
}
DI void resid_gemm_job(const P& p, const bf16_t* A, int lda, const bf16_t* Wt, int K, int job, char* smem) {
  const int mt = job >> 3, nt = job & 7;
  const int m0 = mt * 128, n0 = nt * 128;
  const int tid = tidx(), lane = tid & 63, w = __builtin_amdgcn_readfirstlane(tid >> 6), wm = w & 1, wn = w >> 1, lr = lane & 31, lh = lane >> 5;
  f32x16 acc[2][2];
#pragma unroll
  for (int a = 0; a < 2; ++a)
#pragma unroll
    for (int b = 0; b < 2; ++b) zero16(acc[a][b]);
  gemm_mainloop(A + (size_t)m0 * lda, lda, Wt + (size_t)n0 * K, K, K, acc, smem);
#pragma unroll
  for (int mi = 0; mi < 2; ++mi)
#pragma unroll
    for (int ni = 0; ni < 2; ++ni) {
      const int c = n0 + wn * 64 + ni * 32 + lr;
#pragma unroll
      for (int i = 0; i < 16; ++i) {
        const int r = m0 + wm * 64 + mi * 32 + crow(i, lh);
        p.X[(size_t)r * 1024 + c] += acc[mi][ni][i];
      }
    }
}
DI void up_job(const P& p, int l, int job, char* smem) {
  const int mt = job >> 5, nt = job & 31;
  const int m0 = mt * 128, n0 = nt * 128;
  const int tid = tidx(), lane = tid & 63, w = __builtin_amdgcn_readfirstlane(tid >> 6), wm = w & 1, wn = w >> 1, lr = lane & 31, lh = lane >> 5;
  f32x16 acc[2][2];
#pragma unroll
  for (int a = 0; a < 2; ++a)
#pragma unroll
    for (int b = 0; b < 2; ++b) zero16(acc[a][b]);
  gemm_mainloop(p.H + (size_t)m0 * 1024, 1024, p.Wt + (size_t)l * W_LAYER + WO_UP + (size_t)n0 * 1024, 1024, 1024, acc, smem);
#pragma unroll
  for (int mi = 0; mi < 2; ++mi)
#pragma unroll
    for (int ni = 0; ni < 2; ++ni) {
      const int c = n0 + wn * 64 + ni * 32 + lr;
#pragma unroll
      for (int i = 0; i < 16; ++i) {
        const int r = m0 + wm * 64 + mi * 32 + crow(i, lh);
        const float v = fmaxf(acc[mi][ni][i], 0.f);
        p.A2[(size_t)r * 4096 + c] = f2bf(v * v);
      }
    }
}

constexpr int NPHASE = 1 + 4 * 11;
DI int phase_jobs(int ph) {
  if (ph == 0) return 22144 + 64 + 257 + 4128;
  const int s = (ph - 1) % 11;
  switch (s) {
    case 0: return 129 * 69;
    case 1: return 2048 + 4096 + 4096 + 512 + 2048 + 512;
    case 2: return 2048 + 4096;
    case 3: return 256;
    case 4: return 512;
    case 5: return 1032;
    case 6: return 1032;
    case 7: return 4128;
    case 8: return 4128;
    case 9: return 1032;
    default: return 4128;
  }
}
DI void run_job(const P& p, int ph, int job, char* smem) {
  if (ph == 0) {
    if (job < 22144) { prep_weight_job(p, job, smem); return; }
    job -= 22144;
    if (job < 64) { prep_s5_job(p, job); return; }
    job -= 64;
    if (job < 257) { prep_rope_job(p, job); return; }
    job -= 257;
    norm_job(p, job, p.norm1_w, true, false);
    return;
  }
  const int l = (ph - 1) / 11, s = (ph - 1) % 11;
  const bf16_t* wl = p.Wt + (size_t)l * W_LAYER;
  const int w = __builtin_amdgcn_readfirstlane(tidx() >> 6);
  switch (s) {
    case 0: inproj_job(p, l, job, smem); break;
    case 1:
      if (job < 2048) { attn_prompt_job(p, l, job, smem); break; }
      job -= 2048;
      if (job < 4096) { conv_job(p, l, job, smem); break; }
      job -= 4096;
      if (job < 4096) { const int wj = job * 4 + w; s5_wave_job(p, l, 0, wj >> 13, wj & 63, (wj >> 6) & 127, nullptr); break; }
      job -= 4096;
      if (job < 512) { ssd_sample_job(p, l, job, smem); break; }
      job -= 512;
      if (job < 2048) { const int wj = job * 4 + w; __syncthreads(); s5_wave_job(p, l, 2, wj >> 6, wj & 63, 0, (bf16_t*)smem + w * 64 * 136); break; }
      job -= 2048;
      attn_sample_job(p, l, job, smem);
      break;
    case 2:
      if (job < 2048) { ssd_a_job(p, l, job, smem); break; }
      job -= 2048;
      { const int wj = job * 4 + w; __syncthreads(); s5_wave_job(p, l, 1, wj >> 13, wj & 63, (wj >> 6) & 127, (bf16_t*)smem + w * 64 * 136); }
      break;
    case 3: ssd_scan_job(p, l, job); break;
    case 4: ssd_c_job(p, l, job, smem); break;
    case 5: merge_job(p, l, job, smem); break;
    case 6: resid_gemm_job(p, p.MG, 1024, wl + WO_WOUT, 1024, job, smem); break;
    case 7: norm_job(p, job, p.norm2_w + l * 1024, false, false); break;
    case 8: up_job(p, l, job, smem); break;
    case 9: resid_gemm_job(p, p.A2, 4096, wl + WO_DOWN, 4096, job, smem); break;
    default:
      if (l == 3) norm_job(p, job, p.final_w, false, true);
      else norm_job(p, job, p.norm1_w + (l + 1) * 1024, false, false);
      break;
  }
}

template <bool COOP>
__global__ void __launch_bounds__(256, 1) mega(P p, int ph0, int ph1) {
  __shared__ __attribute__((aligned(16))) char smem[SMEM_BYTES];
  for (int ph = ph0; ph < ph1; ++ph) {
    const int nj = phase_jobs(ph);
    for (int job = blockIdx.x; job < nj; job += gridDim.x) run_job(p, ph, job, smem);
    if (COOP && ph + 1 < ph1) cg::this_grid().sync();
  }
}

static size_t carve(size_t& off, size_t bytes) { size_t o = off; off += (bytes + 255) & ~(size_t)255; return o; }

extern "C" void kernel_launch(void* const* d_in, const int* in_sizes, int n_in, void* d_out, int out_size, void* d_ws, size_t ws_size,
                              hipStream_t stream) {
  P p{};
  const float** pin = (const float**)&p;
  for (int i = 0; i < 33; ++i) pin[i] = (const float*)d_in[i];
  p.out = (float*)d_out;
  char* ws = (char*)d_ws;
  size_t off = 0;
  const size_t SZ1 = (size_t)T * 1024 * 2;
  p.X = (float*)(ws + carve(off, (size_t)T * 1024 * 4));
  p.H = (bf16_t*)(ws + carve(off, SZ1));
  p.Z = (bf16_t*)(ws + carve(off, SZ1));
  p.U = (bf16_t*)(ws + carve(off, SZ1));
  p.Q = (bf16_t*)(ws + carve(off, SZ1));
  p.YM = (bf16_t*)(ws + carve(off, SZ1));
  p.YS = (bf16_t*)(ws + carve(off, SZ1));
  p.O = (bf16_t*)(ws + carve(off, SZ1));
  p.MG = (bf16_t*)(ws + carve(off, SZ1));
  const size_t a2_off = off;
  p.XBC = (bf16_t*)(ws + carve(off, (size_t)T * 2048 * 2));
  p.XBT = (bf16_t*)(ws + carve(off, (size_t)1536 * TP * 2));
  p.BC = (bf16_t*)(ws + carve(off, (size_t)TP * 1024 * 2));
  p.A2 = (bf16_t*)(ws + a2_off);
  if (off - a2_off < (size_t)T * 4096 * 2) off = a2_off + (((size_t)T * 4096 * 2 + 255) & ~(size_t)255);
  p.K = (bf16_t*)(ws + carve(off, (size_t)T * 256 * 2));
  p.VT = (bf16_t*)(ws + carve(off, (size_t)T * 256 * 2));
  p.G = (bf16_t*)(ws + carve(off, (size_t)T * 3072 * 2));
  p.DT = (float*)(ws + carve(off, (size_t)T * 16 * 4));
  p.ST = (float*)(ws + carve(off, (size_t)2 * 64 * 16 * 64 * 128 * 4));
  p.CDEC = (float*)(ws + carve(off, (size_t)2 * 64 * 16 * 4));
  p.S5S = (float*)(ws + carve(off, (size_t)2 * 128 * 64 * 64 * 2 * 4));
  p.S5P = (float*)(ws + carve(off, (size_t)4 * 64 * 36 * 64 * 4));
  p.ROPE = (float2*)(ws + carve(off, (size_t)8193 * 8 * 8));
  p.Wt = (bf16_t*)(ws + carve(off, (size_t)4 * W_LAYER * 2));
  if (off > ws_size) { fprintf(stderr, "workspace too small: need %zu have %zu\n", off, ws_size); return; }

#if COOP_MODE
  static int grid_blocks = 0;
  if (!grid_blocks) {
    int dev = 0, cus = 0, per_cu = 0;
    hipGetDevice(&dev);
    hipDeviceGetAttribute(&cus, hipDeviceAttributeMultiprocessorCount, dev);
    hipOccupancyMaxActiveBlocksPerMultiprocessor(&per_cu, mega<true>, 256, 0);
    if (per_cu > 2) per_cu = 2;
    if (per_cu < 1) per_cu = 1;
    grid_blocks = cus * per_cu;
  }
  int ph0 = 0, ph1 = NPHASE;
  void* args[] = {&p, &ph0, &ph1};
  hipError_t e = hipLaunchCooperativeKernel((void*)mega<true>, dim3(grid_blocks), dim3(256), args, 0, stream);
  if (e != hipSuccess) fprintf(stderr, "cooperative launch failed: %s (grid %d)\n", hipGetErrorString(e), grid_blocks);
#else
  for (int ph = 0; ph < NPHASE; ++ph) mega<false><<<dim3(1024), dim3(256), 0, stream>>>(p, ph, ph + 1);
#endif
}
```

```cpp
#include <hip/hip_runtime.h>
#include <hip/hip_cooperative_groups.h>
#include <cstdio>
#include <cstdint>
namespace cg = cooperative_groups;

#define DI __device__ __forceinline__
typedef unsigned short bf16_t;
typedef short bf16x8 __attribute__((ext_vector_type(8)));
typedef float f32x16 __attribute__((ext_vector_type(16)));
typedef float f32x4 __attribute__((ext_vector_type(4)));
#define MFMA32(a, b, c) __builtin_amdgcn_mfma_f32_32x32x16_bf16((a), (b), (c), 0, 0, 0)
#define MFMA16(a, b, c) __builtin_amdgcn_mfma_f32_16x16x32_bf16((a), (b), (c), 0, 0, 0)

#ifndef COOP_MODE
#define COOP_MODE 1
#endif

constexpr int TP = 16384, TS = 128, T = TP + TS, SEQ = 8192;
constexpr int NIN = 8720, NINP = 8832;
constexpr int SMEM_BYTES = 73728;
constexpr float EPS = 1e-6f;

constexpr size_t OFF_YP = 0;
constexpr size_t OFF_YS = OFF_YP + (size_t)TP * 1024;
constexpr size_t OFF_SSMP = OFF_YS + (size_t)TS * 1024;
constexpr size_t OFF_SSMS = OFF_SSMP + (size_t)4 * 2 * 16 * 64 * 128;
constexpr size_t OFF_CONVP = OFF_SSMS + (size_t)4 * 128 * 16 * 64 * 128;
constexpr size_t OFF_CONVS = OFF_CONVP + (size_t)4 * 2 * 3 * 2048;
constexpr size_t OFF_S5RP = OFF_CONVS + (size_t)4 * 128 * 3 * 2048;
constexpr size_t OFF_S5RS = OFF_S5RP + (size_t)4 * 2 * 64 * 64;
constexpr size_t OFF_S5IP = OFF_S5RS + (size_t)4 * 128 * 64 * 64;
constexpr size_t OFF_S5IS = OFF_S5IP + (size_t)4 * 2 * 64 * 64;
constexpr size_t OFF_KP = OFF_S5IS + (size_t)4 * 128 * 64 * 64;
constexpr size_t OFF_KS = OFF_KP + (size_t)4 * 2 * 128 * 256;
constexpr size_t OFF_VP = OFF_KS + (size_t)4 * 128 * 128 * 256;
constexpr size_t OFF_VS = OFF_VP + (size_t)4 * 2 * 128 * 256;

constexpr size_t WO_IN = 0;
constexpr size_t WO_MPROJ = WO_IN + (size_t)NINP * 1024;
constexpr size_t WO_GLU = WO_MPROJ + (size_t)1024 * 1024;
constexpr size_t WO_ATTNO = WO_GLU + (size_t)2048 * 1024;
constexpr size_t WO_WOUT = WO_ATTNO + (size_t)1024 * 1024;
constexpr size_t WO_UP = WO_WOUT + (size_t)1024 * 1024;
constexpr size_t WO_DOWN = WO_UP + (size_t)4096 * 1024;
constexpr size_t W_LAYER = WO_DOWN + (size_t)4096 * 1024;

struct P {
  const float *x_prompt, *x_sample, *state_ssm, *state_conv, *s5_sre, *s5_sim, *cache_k, *cache_v;
  const float *norm1_w, *w_in, *conv_w, *conv_b, *dt_bias, *a_log, *m_d, *m_norm_w, *m_proj;
  const float *lam_re, *lam_im, *log_step, *b_re, *b_im, *c_re, *c_im, *s5_d, *glu_w;
  const float *sinks, *attn_o, *w_out, *norm2_w, *mlp_up, *mlp_down, *final_w;
  float* out;
  float* X;
  bf16_t *H, *Z, *XBC, *U, *Q, *K, *VT, *G, *YM, *YS, *O, *MG, *A2, *XBT, *BC, *Wt;
  float *DT, *ST, *CDEC, *S5S, *S5P;
  float2* ROPE;
};

DI bf16_t f2bf(float x) { unsigned u = __float_as_uint(x); u += 0x7fffu + ((u >> 16) & 1u); return (bf16_t)(u >> 16); }
DI float bf2f(bf16_t b) { return __uint_as_float(((unsigned)b) << 16); }
DI unsigned pack2(float a, float b) { return (unsigned)f2bf(a) | ((unsigned)f2bf(b) << 16); }
DI float bflo(unsigned u) { return __uint_as_float(u << 16); }
DI float bfhi(unsigned u) { return __uint_as_float(u & 0xffff0000u); }
DI float silu_f(float x) { return x / (1.f + __expf(-x)); }
DI float sigm_f(float x) { return 1.f / (1.f + __expf(-x)); }
DI float softplus_f(float x) { return x > 20.f ? x : log1pf(expf(x)); }
DI float gelu_tanh(float x) { float y = 0.7978845608028654f * (x + 0.044715f * x * x * x); float t = 1.f - 2.f / (__expf(2.f * y) + 1.f); return 0.5f * x * (1.f + t); }
DI int crow(int i, int lh) { return (i & 3) + 8 * (i >> 2) + 4 * lh; }
DI int launder(int x) { asm volatile("" : "+v"(x)); return x; }
DI int tidx() { int t = __builtin_amdgcn_workitem_id_x(); asm volatile("" : "+v"(t)); return t; }
DI int launder_s(int x) { asm volatile("" : "+s"(x)); return x; }
DI float wave_sum(float v) {
#pragma unroll
  for (int o = 32; o >= 1; o >>= 1) v += __shfl_xor(v, o);
  return v;
}
DI float wave_max(float v) {
#pragma unroll
  for (int o = 32; o >= 1; o >>= 1) v = fmaxf(v, __shfl_xor(v, o));
  return v;
}
DI bf16x8 u4_to_bf8(uint4 v) { return __builtin_bit_cast(bf16x8, v); }
DI void zero16(f32x16& a) {
#pragma unroll
  for (int i = 0; i < 16; ++i) a[i] = 0.f;
}

constexpr int LDT = 72;
DI void gemm_mainloop(const bf16_t* __restrict__ A, int lda, const bf16_t* __restrict__ B, int ldb, int K,
                      f32x16 (&acc)[2][2], char* smem) {
  bf16_t* sa = (bf16_t*)smem;
  bf16_t* sb = sa + 2 * 128 * LDT;
  const int tid = tidx(), lane = tid & 63, w = __builtin_amdgcn_readfirstlane(tid >> 6), wm = w & 1, wn = w >> 1, lr = lane & 31, lh = lane >> 5;
  const int r0 = tid >> 3, ch = (tid & 7) * 8;
  const bf16_t* ap = A + (size_t)r0 * lda + ch;
  const bf16_t* bp = B + (size_t)r0 * ldb + ch;
  uint4 ra0, ra1, ra2, ra3, rb0, rb1, rb2, rb3;
#define GLOADS(k0)                                                                                   \
  ra0 = *(const uint4*)(ap + (k0)); ra1 = *(const uint4*)(ap + (size_t)32 * lda + (k0));            \
  ra2 = *(const uint4*)(ap + (size_t)64 * lda + (k0)); ra3 = *(const uint4*)(ap + (size_t)96 * lda + (k0)); \
  rb0 = *(const uint4*)(bp + (k0)); rb1 = *(const uint4*)(bp + (size_t)32 * ldb + (k0));            \
  rb2 = *(const uint4*)(bp + (size_t)64 * ldb + (k0)); rb3 = *(const uint4*)(bp + (size_t)96 * ldb + (k0));
#define SSTORES(da, db)                                                                              \
  *(uint4*)((da) + (r0)*LDT + ch) = ra0; *(uint4*)((da) + (r0 + 32) * LDT + ch) = ra1;               \
  *(uint4*)((da) + (r0 + 64) * LDT + ch) = ra2; *(uint4*)((da) + (r0 + 96) * LDT + ch) = ra3;        \
  *(uint4*)((db) + (r0)*LDT + ch) = rb0; *(uint4*)((db) + (r0 + 32) * LDT + ch) = rb1;               \
  *(uint4*)((db) + (r0 + 64) * LDT + ch) = rb2; *(uint4*)((db) + (r0 + 96) * LDT + ch) = rb3;
  GLOADS(0)
  __syncthreads();
  SSTORES(sa, sb)
  __syncthreads();
  const int nk = K >> 6;
  for (int kt = 0; kt < nk; ++kt) {
    const int buf = kt & 1;
    const int k0 = (kt + 1 < nk) ? (kt + 1) * 64 : kt * 64;
    GLOADS(k0)
    const bf16_t* ca = sa + buf * 128 * LDT + (wm * 64 + lr) * LDT + lh * 8;
    const bf16_t* cb = sb + buf * 128 * LDT + (wn * 64 + lr) * LDT + lh * 8;
#pragma unroll
    for (int kk = 0; kk < 4; ++kk) {
      const bf16x8 af0 = *(const bf16x8*)(ca + kk * 16), af1 = *(const bf16x8*)(ca + 32 * LDT + kk * 16);
      const bf16x8 bf0 = *(const bf16x8*)(cb + kk * 16), bf1 = *(const bf16x8*)(cb + 32 * LDT + kk * 16);
      acc[0][0] = MFMA32(af0, bf0, acc[0][0]);
      acc[0][1] = MFMA32(af0, bf1, acc[0][1]);
      acc[1][0] = MFMA32(af1, bf0, acc[1][0]);
      acc[1][1] = MFMA32(af1, bf1, acc[1][1]);
    }
    bf16_t* da = sa + (buf ^ 1) * 128 * LDT;
    bf16_t* db = sb + (buf ^ 1) * 128 * LDT;
    SSTORES(da, db)
    __syncthreads();
  }
#undef GLOADS
#undef SSTORES
}

DI int win_map(int n) {
  if (n < 3072) return n;
  if (n < 8704) return n + 16;
  if (n < 8720) return n - 8704 + 3072;
  return -1;
}
DI void wtrans_tile(const float* __restrict__ src, int N, int K, bf16_t* __restrict__ dst, int kt, int nt, bool inmap, char* smem) {
  float* s = (float*)smem;
  const int tid = tidx();
  __syncthreads();
  const int nn = tid & 63;
  int sc = nt * 64 + nn;
  if (inmap) sc = win_map(sc);
#pragma unroll
  for (int it = 0; it < 16; ++it) {
    const int kk = it * 4 + (tid >> 6);
    s[kk * 65 + nn] = (sc >= 0) ? src[(size_t)(kt * 64 + kk) * N + sc] : 0.f;
  }
  __syncthreads();
#pragma unroll
  for (int it = 0; it < 16; ++it) {
    const int n2 = it * 4 + (tid >> 6), k2 = tid & 63;
    dst[(size_t)(nt * 64 + n2) * K + kt * 64 + k2] = f2bf(s[k2 * 65 + n2]);
  }
}
DI void prep_weight_job(const P& p, int j, char* smem) {
  const int l = j / 5536; int r = j % 5536;
  bf16_t* wl = p.Wt + (size_t)l * W_LAYER;
  if (r < 2208) { wtrans_tile(p.w_in + (size_t)l * 1024 * NIN, NIN, 1024, wl + WO_IN, r / 138, r % 138, true, smem); return; }
  r -= 2208;
  if (r < 256) { wtrans_tile(p.m_proj + (size_t)l * 1024 * 1024, 1024, 1024, wl + WO_MPROJ, r / 16, r % 16, false, smem); return; }
  r -= 256;
  if (r < 512) { wtrans_tile(p.glu_w + (size_t)l * 1024 * 2048, 2048, 1024, wl + WO_GLU, r / 32, r % 32, false, smem); return; }
  r -= 512;
  if (r < 256) { wtrans_tile(p.attn_o + (size_t)l * 1024 * 1024, 1024, 1024, wl + WO_ATTNO, r / 16, r % 16, false, smem); return; }
  r -= 256;
  if (r < 256) { wtrans_tile(p.w_out + (size_t)l * 1024 * 1024, 1024, 1024, wl + WO_WOUT, r / 16, r % 16, false, smem); return; }
  r -= 256;
  if (r < 1024) { wtrans_tile(p.mlp_up + (size_t)l * 1024 * 4096, 4096, 1024, wl + WO_UP, r / 64, r % 64, false, smem); return; }
  r -= 1024;
  wtrans_tile(p.mlp_down + (size_t)l * 4096 * 1024, 1024, 4096, wl + WO_DOWN, r / 16, r % 16, false, smem);
}
DI void prep_s5_job(const P& p, int j) {
  const int idx = j * 256 + tidx();
  const int n = idx & 63, g = (idx >> 6) & 63, l = idx >> 12;
  const float step = expf(p.log_step[l * 64 + g]);
  const float lr_ = p.lam_re[(l * 64 + g) * 64 + n], li = p.lam_im[(l * 64 + g) * 64 + n];
  const float mag = expf(lr_ * step);
  const float abr = mag * cosf(li * step), abi = mag * sinf(li * step);
  float aqr = abr, aqi = abi;
#pragma unroll
  for (int q = 0; q < 6; ++q) { const float nr2 = aqr * aqr - aqi * aqi, ni2 = 2.f * aqr * aqi; aqr = nr2; aqi = ni2; }
  const float den = lr_ * lr_ + li * li;
  const float nr = abr - 1.0f, ni = abi;
  const float fre = (nr * lr_ + ni * li) / den, fim = (ni * lr_ - nr * li) / den;
  float* o = p.S5P + ((size_t)(l * 64 + g) * 36) * 64 + n;
  o[0] = abr; o[64] = abi; o[128] = aqr; o[192] = aqi;
  const float* br = p.b_re + ((size_t)(l * 64 + g) * 64 + n) * 16;
  const float* bi = p.b_im + ((size_t)(l * 64 + g) * 64 + n) * 16;
#pragma unroll
  for (int i = 0; i < 16; ++i) {
    const float b_r = br[i], b_i = bi[i];
    o[(4 + i) * 64] = fre * b_r - fim * b_i;
    o[(20 + i) * 64] = fre * b_i + fim * b_r;
  }
}
DI void prep_rope_job(const P& p, int j) {
  const int idx = j * 256 + tidx();
  if (idx >= 8193 * 8) return;
  const int pos = idx >> 3, f = idx & 7;
  const float invf = expf(-(2.0f * (float)f / 16.0f) * logf(500000.0f));
  const float ang = (float)pos * invf;
  p.ROPE[idx] = make_float2(cosf(ang), sinf(ang));
}

DI void norm_job(const P& p, int job, const float* wgt, bool layer0, bool final_) {
  const int w = __builtin_amdgcn_readfirstlane(tidx() >> 6), lane = tidx() & 63;
  const int r = job * 4 + w;
  const float* src = layer0 ? (r < TP ? p.x_prompt + (size_t)r * 1024 : p.x_sample + (size_t)(r - TP) * 1024) : p.X + (size_t)r * 1024;
  float4 v[4];
  float ss = 0.f;
#pragma unroll
  for (int q = 0; q < 4; ++q) { v[q] = ((const float4*)src)[lane + 64 * q]; ss += v[q].x * v[q].x + v[q].y * v[q].y + v[q].z * v[q].z + v[q].w * v[q].w; }
  ss = wave_sum(ss);
  const float sc = rsqrtf(ss * (1.f / 1024.f) + EPS);
#pragma unroll
  for (int q = 0; q < 4; ++q) {
    const float4 wv = ((const float4*)wgt)[lane + 64 * q];
    float4 y = make_float4(v[q].x * sc * wv.x, v[q].y * sc * wv.y, v[q].z * sc * wv.z, v[q].w * sc * wv.w);
    if (final_) ((float4*)(p.out + OFF_YP + (size_t)r * 1024))[lane + 64 * q] = y;
    else *(uint2*)(p.H + (size_t)r * 1024 + (lane + 64 * q) * 4) = make_uint2(pack2(y.x, y.y), pack2(y.z, y.w));
    if (layer0) ((float4*)(p.X + (size_t)r * 1024))[lane + 64 * q] = v[q];
  }
}

DI void inproj_job(const P& p, int l, int job, char* smem) {
  const int mt = job / 69, nt = job % 69;
  const int m0 = mt * 128, n0 = nt * 128;
  f32x16 acc[2][2];
#pragma unroll
  for (int a = 0; a < 2; ++a)
#pragma unroll
    for (int b = 0; b < 2; ++b) zero16(acc[a][b]);
  gemm_mainloop(p.H + (size_t)m0 * 1024, 1024, p.Wt + (size_t)l * W_LAYER + WO_IN + (size_t)n0 * 1024, 1024, 1024, acc, smem);
  const int tid = tidx(), lane = tid & 63, w = __builtin_amdgcn_readfirstlane(tid >> 6), wm = w & 1, wn = w >> 1, lr = lane & 31, lh = lane >> 5;
#pragma unroll
  for (int ni = 0; ni < 2; ++ni) {
    const int cb = n0 + wn * 64 + ni * 32;
    if (cb >= NIN) continue;
    const int c = cb + lr;
#pragma unroll
    for (int mi = 0; mi < 2; ++mi) {
      const int rbase = m0 + wm * 64 + mi * 32 + 4 * lh;
      if (cb < 1024) {
#pragma unroll
        for (int i = 0; i < 16; ++i) { const int r = rbase + (i & 3) + 8 * (i >> 2); p.Z[(size_t)r * 1024 + c] = f2bf(acc[mi][ni][i]); }
      } else if (cb < 3072) {
        const int ch = c - 1024;
#pragma unroll
        for (int i = 0; i < 16; ++i) {
          const int r = rbase + (i & 3) + 8 * (i >> 2);
          const float v = acc[mi][ni][i];
          p.XBC[(size_t)r * 2048 + ch] = f2bf(v);
          if (r >= TP) p.out[OFF_CONVS + ((size_t)(l * 128 + (r - TP)) * 3 + 2) * 2048 + ch] = v;
          else { const int t = r & 8191; if (t >= 8189) p.out[OFF_CONVP + ((size_t)(l * 2 + (r >> 13)) * 3 + (t - 8189)) * 2048 + ch] = v; }
        }
      } else if (cb < 4096) {
#pragma unroll
        for (int i = 0; i < 16; ++i) { const int r = rbase + (i & 3) + 8 * (i >> 2); p.U[(size_t)r * 1024 + (c - 3072)] = f2bf(acc[mi][ni][i]); }
      } else if (cb < 5376) {
        const bool isq = cb < 5120;
        const int cc = isq ? c - 4096 : c - 5120;
        const bool ropeblk = ((cb & 63) == 0);
#pragma unroll
        for (int i = 0; i < 16; ++i) {
          const int r = rbase + (i & 3) + 8 * (i >> 2);
          float v = acc[mi][ni][i];
          if (ropeblk) {
            const float pv = __shfl_xor(v, 8);
            if (lr < 16) {
              const int pos = (r >= TP) ? 8192 : (r & 8191);
              const float2 cs = p.ROPE[pos * 8 + (lr & 7)];
              v = (lr < 8) ? v * cs.x - pv * cs.y : v * cs.x + pv * cs.y;
            }
          }
          if (isq) p.Q[(size_t)r * 1024 + cc] = f2bf(v);
          else {
            p.K[(size_t)r * 256 + cc] = f2bf(v);
            if (r >= TP) p.out[OFF_KS + ((size_t)(l * 128 + (r - TP)) * 128 + 127) * 256 + cc] = v;
            else { const int t = r & 8191; if (t >= 8064) p.out[OFF_KP + ((size_t)(l * 2 + (r >> 13)) * 128 + (t - 8064)) * 256 + cc] = v; }
          }
        }
      } else if (cb < 5632) {
        const int cc = c - 5376;
#pragma unroll
        for (int ig = 0; ig < 4; ++ig) {
          const int r0 = rbase + 8 * ig;
          const float v0 = acc[mi][ni][4 * ig], v1 = acc[mi][ni][4 * ig + 1], v2 = acc[mi][ni][4 * ig + 2], v3 = acc[mi][ni][4 * ig + 3];
          *(uint2*)(p.VT + (size_t)cc * T + r0) = make_uint2(pack2(v0, v1), pack2(v2, v3));
#pragma unroll
          for (int jj = 0; jj < 4; ++jj) {
            const int r = r0 + jj;
            const float v = acc[mi][ni][4 * ig + jj];
            if (r >= TP) p.out[OFF_VS + ((size_t)(l * 128 + (r - TP)) * 128 + 127) * 256 + cc] = v;
            else { const int t = r & 8191; if (t >= 8064) p.out[OFF_VP + ((size_t)(l * 2 + (r >> 13)) * 128 + (t - 8064)) * 256 + cc] = v; }
          }
        }
      } else if (cb < 8704) {
#pragma unroll
        for (int i = 0; i < 16; ++i) { const int r = rbase + (i & 3) + 8 * (i >> 2); p.G[(size_t)r * 3072 + (c - 5632)] = f2bf(sigm_f(acc[mi][ni][i])); }
      } else {
        if (lr < 16) {
          const float bias = p.dt_bias[l * 16 + lr];
#pragma unroll
          for (int i = 0; i < 16; ++i) { const int r = rbase + (i & 3) + 8 * (i >> 2); p.DT[(size_t)r * 16 + lr] = softplus_f(acc[mi][ni][i] + bias); }
        }
      }
    }
  }
}

DI void conv_job(const P& p, int l, int job, char* smem) {
  const int ct = job & 31, tt = job >> 5;
  const int ch0 = ct * 64, tokb = tt * 128;
  bf16_t* sT = (bf16_t*)smem;
  const int tid = tidx();
  const float* cw = p.conv_w + (size_t)l * 4 * 2048;
  __syncthreads();
#pragma unroll
  for (int it = 0; it < 4; ++it) {
    const int item = tid + 256 * it, tl = item >> 3, chk = item & 7, ch = ch0 + chk * 8, row = tokb + tl, t = row & 8191;
    float a[8];
    {
      const float4 b0 = *(const float4*)(p.conv_b + l * 2048 + ch), b1 = *(const float4*)(p.conv_b + l * 2048 + ch + 4);
      a[0] = b0.x; a[1] = b0.y; a[2] = b0.z; a[3] = b0.w; a[4] = b1.x; a[5] = b1.y; a[6] = b1.z; a[7] = b1.w;
    }
#pragma unroll
    for (int j = 0; j < 4; ++j) {
      if (t - 3 + j >= 0) {
        const uint4 rv = *(const uint4*)(p.XBC + (size_t)(row - 3 + j) * 2048 + ch);
        const float4 w0 = *(const float4*)(cw + j * 2048 + ch), w1 = *(const float4*)(cw + j * 2048 + ch + 4);
        a[0] += bflo(rv.x) * w0.x; a[1] += bfhi(rv.x) * w0.y; a[2] += bflo(rv.y) * w0.z; a[3] += bfhi(rv.y) * w0.w;
        a[4] += bflo(rv.z) * w1.x; a[5] += bfhi(rv.z) * w1.y; a[6] += bflo(rv.w) * w1.z; a[7] += bfhi(rv.w) * w1.w;
      }
    }
#pragma unroll
    for (int j = 0; j < 8; ++j) a[j] = silu_f(a[j]);
    if (ct >= 16) *(uint4*)(p.BC + (size_t)row * 1024 + (ch - 1024)) = make_uint4(pack2(a[0], a[1]), pack2(a[2], a[3]), pack2(a[4], a[5]), pack2(a[6], a[7]));
    if (ct < 24) {
#pragma unroll
      for (int j = 0; j < 8; ++j) sT[(chk * 8 + j) * 136 + tl] = f2bf(a[j]);
    }
  }
  if (ct < 24) {
    __syncthreads();
#pragma unroll
    for (int it = 0; it < 4; ++it) {
      const int item = tid + 256 * it, r = item >> 4, chk = item & 15;
      *(uint4*)(p.XBT + (size_t)(ch0 + r) * TP + tokb + chk * 8) = *(const uint4*)(sT + r * 136 + chk * 8);
    }
  }
}

DI void chunk_acum(const P& p, int l, int head, int tok0, float* sAc, float* sDt, float& alast) {
  const int lane = tidx() & 63;
  const float Ah = -expf(p.a_log[l * 16 + head]);
  const float d0 = p.DT[(size_t)(tok0 + 2 * lane) * 16 + head], d1 = p.DT[(size_t)(tok0 + 2 * lane + 1) * 16 + head];
  const float a0 = d0 * Ah, a1 = d1 * Ah;
  float s = a0 + a1;
#pragma unroll
  for (int off = 1; off < 64; off <<= 1) { const float tv = __shfl_up(s, off); if (lane >= off) s += tv; }
  const float excl = s - (a0 + a1);
  sAc[2 * lane] = excl + a0; sAc[2 * lane + 1] = s;
  sDt[2 * lane] = d0; sDt[2 * lane + 1] = d1;
  alast = __shfl(s, 63);
}

DI void ssd_a_job(const P& p, int l, int job, char* smem) {
  const int head = job & 15, c = (job >> 4) & 63, b = job >> 10, g = head >> 2;
  const int tok0 = b * SEQ + c * 128;
  bf16_t* sXT = (bf16_t*)smem;
  bf16_t* sBT = sXT + 64 * 136;
  float* sW = (float*)(sBT + 128 * 136);
  float* sAc = sW + 128;
  float* sDt = sAc + 128;
  const int tid = tidx(), lane = tid & 63, w = __builtin_amdgcn_readfirstlane(tid >> 6), lr = lane & 31, lh = lane >> 5;
  __syncthreads();
  if (w == 0) {
    float alast;
    chunk_acum(p, l, head, tok0, sAc, sDt, alast);
    sW[2 * lane] = sDt[2 * lane] * __expf(alast - sAc[2 * lane]);
    sW[2 * lane + 1] = sDt[2 * lane + 1] * __expf(alast - sAc[2 * lane + 1]);
    if (lane == 0) p.CDEC[(b * 64 + c) * 16 + head] = __expf(alast);
  }
  __syncthreads();
#pragma unroll
  for (int it = 0; it < 4; ++it) {
    const int item = tid + 256 * it, pr = item >> 4, s0 = (item & 15) * 8;
    const uint4 v = *(const uint4*)(p.XBT + (size_t)(head * 64 + pr) * TP + tok0 + s0);
    const float4 w0 = *(const float4*)(sW + s0), w1 = *(const float4*)(sW + s0 + 4);
    *(uint4*)(sXT + pr * 136 + s0) = make_uint4(pack2(bflo(v.x) * w0.x, bfhi(v.x) * w0.y), pack2(bflo(v.y) * w0.z, bfhi(v.y) * w0.w),
                                                pack2(bflo(v.z) * w1.x, bfhi(v.z) * w1.y), pack2(bflo(v.w) * w1.z, bfhi(v.w) * w1.w));
  }
#pragma unroll
  for (int it = 0; it < 8; ++it) {
    const int item = tid + 256 * it, n = item >> 4, s0 = (item & 15) * 8;
    *(uint4*)(sBT + n * 136 + s0) = *(const uint4*)(p.XBT + (size_t)(1024 + g * 128 + n) * TP + tok0 + s0);
  }
  __syncthreads();
  const int wp = w & 1, wn = w >> 1;
  f32x16 acc[2];
  zero16(acc[0]); zero16(acc[1]);
#pragma unroll
  for (int kk = 0; kk < 8; ++kk) {
    const bf16x8 af = *(const bf16x8*)(sXT + (wp * 32 + lr) * 136 + kk * 16 + lh * 8);
#pragma unroll
    for (int ni = 0; ni < 2; ++ni) {
      const bf16x8 bfr = *(const bf16x8*)(sBT + (wn * 64 + ni * 32 + lr) * 136 + kk * 16 + lh * 8);
      acc[ni] = MFMA32(af, bfr, acc[ni]);
    }
  }
  float* st = p.ST + ((size_t)((b * 64 + c) * 16 + head) * 64) * 128;
#pragma unroll
  for (int ni = 0; ni < 2; ++ni)
#pragma unroll
    for (int i = 0; i < 16; ++i) st[(wp * 32 + crow(i, lh)) * 128 + wn * 64 + ni * 32 + lr] = acc[ni][i];
}

DI void ssd_scan_job(const P& p, int l, int job) {
  const int gid = job * 256 + tidx();
  const int b = gid >> 15, rem = gid & 32767, head = rem >> 11;
  float4 h = make_float4(0.f, 0.f, 0.f, 0.f);
  for (int c = 0; c < 64; ++c) {
    float4* sp = (float4*)(p.ST + (size_t)(b * 64 + c) * 131072) + rem;
    const float4 s = *sp;
    const float dec = p.CDEC[(b * 64 + c) * 16 + head];
    *sp = h;
    h.x = h.x * dec + s.x; h.y = h.y * dec + s.y; h.z = h.z * dec + s.z; h.w = h.w * dec + s.w;
  }
  ((float4*)(p.out + OFF_SSMP + (size_t)(l * 2 + b) * 131072))[rem] = h;
}

DI void s5_scan_job(const P& p, int l, int job) {
  const int gid = job * 256 + tidx();
  const int n = gid & 63, g = (gid >> 6) & 63, b = gid >> 12;
  const float* prm = p.S5P + ((size_t)(l * 64 + g) * 36) * 64 + n;
  const float aqr = prm[128], aqi = prm[192];
  float hr = 0.f, hi = 0.f;
  float2* sp = (float2*)p.S5S + ((size_t)(b * 128) * 64 + g) * 64 + n;
  for (int c0 = 0; c0 < 128; c0 += 8) {
    float2 sv[8];
#pragma unroll
    for (int k = 0; k < 8; ++k) sv[k] = sp[(size_t)(c0 + k) * 4096];
#pragma unroll
    for (int k = 0; k < 8; ++k) {
      sp[(size_t)(c0 + k) * 4096] = make_float2(hr, hi);
      const float nr = aqr * hr - aqi * hi + sv[k].x, ni = aqr * hi + aqi * hr + sv[k].y;
      hr = nr; hi = ni;
    }
  }
}

DI void ssd_c_job(const P& p, int l, int job, char* smem) {
  const int g = job & 3, c = (job >> 2) & 63, b = job >> 8;
  const int tok0 = b * SEQ + c * 128;
  bf16_t* sC = (bf16_t*)smem;
  bf16_t* sB = sC + 128 * 136;
  float* sAc = (float*)(sB + 128 * 136);
  float* sDt = sAc + 512;
  const int tid = tidx(), lane = tid & 63, w = __builtin_amdgcn_readfirstlane(tid >> 6), lr = lane & 31, lh = lane >> 5, wm = w & 1, wn = w >> 1;
  __syncthreads();
  { float alast; chunk_acum(p, l, g * 4 + w, tok0, sAc + w * 128, sDt + w * 128, alast); }
#pragma unroll
  for (int it = 0; it < 8; ++it) {
    const int item = tid + 256 * it, r = item >> 4, s0 = (item & 15) * 8;
    *(uint4*)(sC + r * 136 + s0) = *(const uint4*)(p.BC + (size_t)(tok0 + r) * 1024 + 512 + g * 128 + s0);
    *(uint4*)(sB + r * 136 + s0) = *(const uint4*)(p.BC + (size_t)(tok0 + r) * 1024 + g * 128 + s0);
  }
  __syncthreads();
  f32x16 cb[2][2];
#pragma unroll
  for (int a = 0; a < 2; ++a)
#pragma unroll
    for (int bb = 0; bb < 2; ++bb) zero16(cb[a][bb]);
  if (!(wm == 0 && wn == 1)) {
#pragma unroll
    for (int kk = 0; kk < 8; ++kk) {
      bf16x8 af[2], bfr[2];
#pragma unroll
      for (int mi = 0; mi < 2; ++mi) af[mi] = *(const bf16x8*)(sC + (wm * 64 + mi * 32 + lr) * 136 + kk * 16 + lh * 8);
#pragma unroll
      for (int ni = 0; ni < 2; ++ni) bfr[ni] = *(const bf16x8*)(sB + (wn * 64 + ni * 32 + lr) * 136 + kk * 16 + lh * 8);
#pragma unroll
      for (int mi = 0; mi < 2; ++mi)
#pragma unroll
        for (int ni = 0; ni < 2; ++ni) cb[mi][ni] = MFMA32(af[mi], bfr[ni], cb[mi][ni]);
    }
  }
  __syncthreads();
  bf16_t* sM = sB;
  unsigned cbp[2][2][8];
#pragma unroll
  for (int a = 0; a < 2; ++a)
#pragma unroll
    for (int bb = 0; bb < 2; ++bb)
#pragma unroll
      for (int k = 0; k < 8; ++k) cbp[a][bb][k] = pack2(cb[a][bb][2 * k], cb[a][bb][2 * k + 1]);
  float ss[16];
#pragma unroll
  for (int i = 0; i < 16; ++i) ss[i] = 0.f;
#pragma unroll 1
  for (int hd = 0; hd < 4; ++hd) {
    const int head = g * 4 + hd;
    const float* ac = sAc + hd * 128;
    const float* dtv = sDt + hd * 128;
    const int lrq = launder(lr), lhq = launder(lh);
#pragma unroll
    for (int mi = 0; mi < 2; ++mi)
#pragma unroll
      for (int ni = 0; ni < 2; ++ni) {
        const int s = wn * 64 + ni * 32 + lrq;
        const float as = ac[s], ds = dtv[s];
#pragma unroll
        for (int i = 0; i < 16; ++i) {
          const int t = wm * 64 + mi * 32 + crow(i, lhq);
          const float cv = (i & 1) ? bfhi(cbp[mi][ni][i >> 1]) : bflo(cbp[mi][ni][i >> 1]);
          const float v = (s <= t) ? cv * __expf(ac[t] - as) * ds : 0.f;
          sM[t * 136 + s] = f2bf(v);
        }
        __builtin_amdgcn_sched_barrier(0);
      }
    __syncthreads();
    f32x16 yd[2];
    zero16(yd[0]); zero16(yd[1]);
#pragma unroll 1
    for (int kk = 0; kk < 8; ++kk) {
      const bf16x8 af = *(const bf16x8*)(sC + (32 * w + lr) * 136 + kk * 16 + lh * 8);
#pragma unroll
      for (int pb = 0; pb < 2; ++pb) {
        const float* hp = p.ST + (((size_t)((b * 64 + c) * 16 + head) * 64 + pb * 32 + lr) * 128 + kk * 16 + lh * 8);
        const float4 h0 = ((const float4*)hp)[0], h1 = ((const float4*)hp)[1];
        const uint4 hv = make_uint4(pack2(h0.x, h0.y), pack2(h0.z, h0.w), pack2(h1.x, h1.y), pack2(h1.z, h1.w));
        yd[pb] = MFMA32(af, u4_to_bf8(hv), yd[pb]);
      }
    }
#pragma unroll
    for (int i = 0; i < 16; ++i) {
      const float e = __expf(ac[32 * w + crow(i, lh)]);
      yd[0][i] *= e; yd[1][i] *= e;
    }
    const int nkk = 2 * (w + 1);
    for (int kk = 0; kk < nkk; ++kk) {
      const bf16x8 af = *(const bf16x8*)(sM + (32 * w + lr) * 136 + kk * 16 + lh * 8);
#pragma unroll
      for (int pb = 0; pb < 2; ++pb) {
        const bf16x8 bfr = *(const bf16x8*)(p.XBT + (size_t)(head * 64 + pb * 32 + lr) * TP + tok0 + kk * 16 + lh * 8);
        yd[pb] = MFMA32(af, bfr, yd[pb]);
      }
    }
    const float Dh = p.m_d[l * 16 + head];
#pragma unroll
    for (int pb = 0; pb < 2; ++pb) {
      const int pch = head * 64 + pb * 32 + lr;
#pragma unroll
      for (int ig = 0; ig < 4; ++ig) {
        const int t0 = 32 * w + 8 * ig + 4 * lh;
        const uint2 xr = *(const uint2*)(p.XBT + (size_t)pch * TP + tok0 + t0);
        const float xs[4] = {bflo(xr.x), bfhi(xr.x), bflo(xr.y), bfhi(xr.y)};
#pragma unroll
        for (int jj = 0; jj < 4; ++jj) {
          const int i = 4 * ig + jj, t = t0 + jj;
          const float y = yd[pb][i] + Dh * xs[jj];
          const float z = bf2f(p.Z[(size_t)(tok0 + t) * 1024 + pch]);
          const float yg = y * silu_f(z);
          ss[i] += yg * yg;
          p.YM[(size_t)(tok0 + t) * 1024 + pch] = f2bf(yg);
        }
      }
      __builtin_amdgcn_sched_barrier(0);
    }
    __syncthreads();
  }
#pragma unroll
  for (int i = 0; i < 16; ++i) {
    float v = ss[i];
    v += __shfl_xor(v, 1); v += __shfl_xor(v, 2); v += __shfl_xor(v, 4); v += __shfl_xor(v, 8); v += __shfl_xor(v, 16);
    ss[i] = rsqrtf(v * (1.f / 256.f) + EPS);
  }
  for (int hd = 0; hd < 4; ++hd) {
#pragma unroll
    for (int pb = 0; pb < 2; ++pb) {
      const int pch = (g * 4 + hd) * 64 + pb * 32 + lr;
      const float nw = p.m_norm_w[l * 1024 + pch];
#pragma unroll
      for (int i = 0; i < 16; ++i) {
        const size_t idx = (size_t)(tok0 + 32 * w + crow(i, lh)) * 1024 + pch;
        p.YM[idx] = f2bf(bf2f(p.YM[idx]) * ss[i] * nw);
      }
      __builtin_amdgcn_sched_barrier(0);
    }
  }
}

DI void ssd_sample_job(const P& p, int l, int job, char* smem) {
  const int g = job & 3, b = job >> 2;
  float* sx = (float*)smem;
  float* sBv = sx + 256;
  float* sCv = sBv + 128;
  float* sY = sCv + 128;
  float* sRed = sY + 256;
  const int tid = tidx(), lane = tid & 63, w = __builtin_amdgcn_readfirstlane(tid >> 6);
  const int row = TP + b;
  __syncthreads();
#pragma unroll
  for (int it = 0; it < 2; ++it) {
    const int idx = tid + 256 * it;
    const int ch = idx < 256 ? g * 256 + idx : (idx < 384 ? 1024 + g * 128 + (idx - 256) : 1536 + g * 128 + (idx - 384));
    const float* sc = p.state_conv + ((size_t)(l * 128 + b) * 3) * 2048 + ch;
    const float s0 = sc[0], s1 = sc[2048], s2 = sc[4096];
    const float raw = bf2f(p.XBC[(size_t)row * 2048 + ch]);
    const float* cw = p.conv_w + (size_t)l * 4 * 2048 + ch;
    float v = p.conv_b[l * 2048 + ch] + cw[0] * s0 + cw[2048] * s1 + cw[4096] * s2 + cw[6144] * raw;
    v = silu_f(v);
    sx[idx] = v;
    float* co = p.out + OFF_CONVS + ((size_t)(l * 128 + b) * 3) * 2048 + ch;
    co[0] = s1; co[2048] = s2;
  }
  __syncthreads();
  for (int hd = 0; hd < 4; ++hd) {
    const int head = g * 4 + hd;
    const float dt = p.DT[(size_t)row * 16 + head];
    const float Ah = -expf(p.a_log[l * 16 + head]);
    const float dA = __expf(dt * Ah);
    const int pp = tid >> 2, nq = (tid & 3) * 32;
    const float xv = sx[hd * 64 + pp];
    const float coef = dt * xv;
    const size_t so = ((((size_t)l * 128 + b) * 16 + head) * 64 + pp) * 128 + nq;
    const float4* h0 = (const float4*)(p.state_ssm + so);
    float4* ho = (float4*)(p.out + OFF_SSMS + so);
    float yacc = 0.f;
#pragma unroll
    for (int q = 0; q < 8; ++q) {
      float4 hv = h0[q];
      const int n = nq + 4 * q;
      hv.x = hv.x * dA + coef * sBv[n]; hv.y = hv.y * dA + coef * sBv[n + 1]; hv.z = hv.z * dA + coef * sBv[n + 2]; hv.w = hv.w * dA + coef * sBv[n + 3];
      yacc += hv.x * sCv[n] + hv.y * sCv[n + 1] + hv.z * sCv[n + 2] + hv.w * sCv[n + 3];
      ho[q] = hv;
    }
    yacc += __shfl_xor(yacc, 1); yacc += __shfl_xor(yacc, 2);
    const float y = yacc + p.m_d[l * 16 + head] * xv;
    const float z = bf2f(p.Z[(size_t)row * 1024 + head * 64 + pp]);
    if ((tid & 3) == 0) sY[hd * 64 + pp] = y * silu_f(z);
  }
  __syncthreads();
  const float v = sY[tid];
  const float ssq = wave_sum(v * v);
  if (lane == 0) sRed[w] = ssq;
  __syncthreads();
  const float tot = sRed[0] + sRed[1] + sRed[2] + sRed[3];
  const float sc = rsqrtf(tot * (1.f / 256.f) + EPS);
  p.YM[(size_t)row * 1024 + g * 256 + tid] = f2bf(v * sc * p.m_norm_w[l * 1024 + g * 256 + tid]);
}

DI void s5_wave_job(const P& p, int l, int mode, int b, int g, int c, bf16_t* sH) {
  const int lane = tidx() & 63;
  const float* prm = p.S5P + ((size_t)(l * 64 + g) * 36) * 64 + lane;
  const float abr = prm[0], abi = prm[64];
  float bbr[16], bbi[16];
#pragma unroll
  for (int i = 0; i < 16; ++i) { bbr[i] = prm[(4 + i) * 64]; bbi[i] = prm[(20 + i) * 64]; }
  float hr = 0.f, hi = 0.f;
  int row0, Q;
  if (mode == 2) {
    row0 = TP + b; Q = 1;
    hr = p.s5_sre[((size_t)(l * 128 + b) * 64 + g) * 64 + lane];
    hi = p.s5_sim[((size_t)(l * 128 + b) * 64 + g) * 64 + lane];
  } else {
    row0 = b * SEQ + c * 64; Q = 64;
    if (mode == 1) {
      const float2 s = *(const float2*)(p.S5S + (((size_t)(b * 128 + c) * 64 + g) * 64 + lane) * 2);
      hr = s.x; hi = s.y;
    }
  }
  for (int t = 0; t < Q; ++t) {
    const uint4* up = (const uint4*)(p.U + (size_t)(row0 + t) * 1024 + g * 16);
    const uint4 u0 = up[0], u1 = up[1];
    const float uf[16] = {bflo(u0.x), bfhi(u0.x), bflo(u0.y), bfhi(u0.y), bflo(u0.z), bfhi(u0.z), bflo(u0.w), bfhi(u0.w),
                          bflo(u1.x), bfhi(u1.x), bflo(u1.y), bfhi(u1.y), bflo(u1.z), bfhi(u1.z), bflo(u1.w), bfhi(u1.w)};
    float br_ = 0.f, bi_ = 0.f;
#pragma unroll
    for (int i = 0; i < 16; ++i) { br_ += bbr[i] * uf[i]; bi_ += bbi[i] * uf[i]; }
    const float nr = abr * hr - abi * hi + br_, ni = abr * hi + abi * hr + bi_;
    hr = nr; hi = ni;
    if (mode != 0) { sH[t * 136 + lane] = f2bf(hr); sH[t * 136 + 64 + lane] = f2bf(hi); }
  }
  if (mode == 0) {
    *(float2*)(p.S5S + (((size_t)(b * 128 + c) * 64 + g) * 64 + lane) * 2) = make_float2(hr, hi);
    return;
  }
  if (mode == 1 && c == 127) {
    p.out[OFF_S5RP + ((size_t)(l * 2 + b) * 64 + g) * 64 + lane] = hr;
    p.out[OFF_S5IP + ((size_t)(l * 2 + b) * 64 + g) * 64 + lane] = hi;
  }
  if (mode == 2) {
    p.out[OFF_S5RS + ((size_t)(l * 128 + b) * 64 + g) * 64 + lane] = hr;
    p.out[OFF_S5IS + ((size_t)(l * 128 + b) * 64 + g) * 64 + lane] = hi;
  }
  const int o = lane & 15, quad = lane >> 4;
  bf16x8 cf[4];
#pragma unroll
  for (int kk = 0; kk < 4; ++kk) {
    const float* cp = ((kk < 2) ? p.c_re : p.c_im) + ((size_t)(l * 64 + g) * 16 + o) * 64 + (kk & 1) * 32 + quad * 8;
    const float4 c0 = ((const float4*)cp)[0], c1 = ((const float4*)cp)[1];
    const float sg = (kk < 2) ? 1.f : -1.f;
    cf[kk] = u4_to_bf8(make_uint4(pack2(sg * c0.x, sg * c0.y), pack2(sg * c0.z, sg * c0.w), pack2(sg * c1.x, sg * c1.y), pack2(sg * c1.z, sg * c1.w)));
  }
  const float dsk = p.s5_d[l * 1024 + g * 16 + o];
  const int nrb = (mode == 2) ? 1 : 4;
  __builtin_amdgcn_fence(__ATOMIC_RELEASE, "wavefront");
  __builtin_amdgcn_wave_barrier();
  __builtin_amdgcn_fence(__ATOMIC_ACQUIRE, "wavefront");
  for (int rb = 0; rb < nrb; ++rb) {
    f32x4 a4 = {0.f, 0.f, 0.f, 0.f};
#pragma unroll
    for (int kk = 0; kk < 4; ++kk) {
      const bf16x8 af = *(const bf16x8*)(sH + (rb * 16 + o) * 136 + kk * 32 + quad * 8);
      a4 = MFMA16(af, cf[kk], a4);
    }
#pragma unroll
    for (int jj = 0; jj < 4; ++jj) {
      const int t = rb * 16 + quad * 4 + jj;
      if (t < Q) {
        const size_t idx = (size_t)(row0 + t) * 1024 + g * 16 + o;
        const float y = a4[jj] + dsk * bf2f(p.U[idx]);
        p.YS[idx] = f2bf(gelu_tanh(y));
      }
    }
  }
}

DI void attn_prompt_job(const P& p, int l, int job, char* smem) {
  const int head = job & 15, blk = (job >> 4) & 63, b = job >> 10, kvh = head >> 2;
  bf16_t* sK = (bf16_t*)smem;
  bf16_t* sVt = sK + 256 * 72;
  const int tid = tidx(), lane = tid & 63, w = __builtin_amdgcn_readfirstlane(tid >> 6), lr = lane & 31, lh = lane >> 5;
  const int tokc0 = b * SEQ + blk * 128 - 128;
  __syncthreads();
#pragma unroll
  for (int it = 0; it < 8; ++it) {
    const int item = tid + 256 * it, row = item >> 3, chk = item & 7;
    uint4 v = make_uint4(0u, 0u, 0u, 0u);
    if (blk > 0 || row >= 128) v = *(const uint4*)(p.K + (size_t)(tokc0 + row) * 256 + kvh * 64 + chk * 8);
    *(uint4*)(sK + row * 72 + chk * 8) = v;
  }
#pragma unroll
  for (int it = 0; it < 8; ++it) {
    const int item = tid + 256 * it, d = item >> 5, chk = item & 31;
    uint4 v = make_uint4(0u, 0u, 0u, 0u);
    if (blk > 0 || chk >= 16) v = *(const uint4*)(p.VT + (size_t)(kvh * 64 + d) * T + tokc0 + chk * 8);
    *(uint4*)(sVt + d * 264 + chk * 8) = v;
  }
  __syncthreads();
  const int qtok = b * SEQ + blk * 128 + 32 * w + lr;
  bf16x8 qf[4];
#pragma unroll
  for (int kk = 0; kk < 4; ++kk) qf[kk] = *(const bf16x8*)(p.Q + (size_t)qtok * 1024 + head * 64 + kk * 16 + lh * 8);
  f32x16 st[5];
#pragma unroll
  for (int x = 0; x < 5; ++x) {
    zero16(st[x]);
#pragma unroll
    for (int kk = 0; kk < 4; ++kk) {
      const bf16x8 af = *(const bf16x8*)(sK + (32 * (w + x) + lr) * 72 + kk * 16 + lh * 8);
      st[x] = MFMA32(af, qf[kk], st[x]);
    }
  }
  const float sink = p.sinks[l * 16 + head];
  const int qi = 128 + 32 * w + lr;
  float m = sink;
#pragma unroll
  for (int x = 0; x < 5; ++x)
#pragma unroll
    for (int i = 0; i < 16; ++i) {
      const int kj = 32 * (w + x) + crow(i, lh);
      const bool valid = (kj <= qi) && (kj >= qi - 128) && (blk > 0 || kj >= 128);
      const float s = valid ? st[x][i] * 0.125f : -1e30f;
      st[x][i] = s;
      m = fmaxf(m, s);
    }
  m = fmaxf(m, __shfl_xor(m, 32));
  float sum = 0.f;
#pragma unroll
  for (int x = 0; x < 5; ++x)
#pragma unroll
    for (int i = 0; i < 16; ++i) { const float pv = __expf(st[x][i] - m); st[x][i] = pv; sum += pv; }
  sum += __shfl_xor(sum, 32);
  const float inv = 1.f / (sum + __expf(sink - m));
  f32x16 ot[2];
  zero16(ot[0]); zero16(ot[1]);
#pragma unroll
  for (int x = 0; x < 5; ++x)
#pragma unroll
    for (int s = 0; s < 2; ++s) {
      const uint4 pu = make_uint4(pack2(st[x][8 * s] * inv, st[x][8 * s + 1] * inv), pack2(st[x][8 * s + 2] * inv, st[x][8 * s + 3] * inv),
                                  pack2(st[x][8 * s + 4] * inv, st[x][8 * s + 5] * inv), pack2(st[x][8 * s + 6] * inv, st[x][8 * s + 7] * inv));
      const bf16x8 pf = u4_to_bf8(pu);
#pragma unroll
      for (int pb = 0; pb < 2; ++pb) {
        const bf16_t* vp = sVt + (pb * 32 + lr) * 264 + 32 * (w + x) + 16 * s + 4 * lh;
        const uint2 lo = *(const uint2*)vp, hi2 = *(const uint2*)(vp + 8);
        ot[pb] = MFMA32(u4_to_bf8(make_uint4(lo.x, lo.y, hi2.x, hi2.y)), pf, ot[pb]);
      }
    }
#pragma unroll
  for (int pb = 0; pb < 2; ++pb)
#pragma unroll
    for (int ig = 0; ig < 4; ++ig) {
      const int d0 = pb * 32 + 8 * ig + 4 * lh;
      *(uint2*)(p.O + (size_t)qtok * 1024 + head * 64 + d0) = make_uint2(pack2(ot[pb][4 * ig], ot[pb][4 * ig + 1]), pack2(ot[pb][4 * ig + 2], ot[pb][4 * ig + 3]));
    }
}

DI void attn_sample_job(const P& p, int l, int job, char* smem) {
  const int kvh = job & 3, b = job >> 2;
  const int tid = tidx(), lane = tid & 63, w = __builtin_amdgcn_readfirstlane(tid >> 6);
  const int head = kvh * 4 + w, row = TP + b;
  float* sP = (float*)smem + w * 192;
  __syncthreads();
  const float qd = bf2f(p.Q[(size_t)row * 1024 + head * 64 + lane]);
  const size_t cbase = ((size_t)(l * 128 + b) * 128) * 256 + kvh * 64 + lane;
  const float* kc = p.cache_k + cbase;
  const float* vc = p.cache_v + cbase;
  float* ko = p.out + OFF_KS + cbase;
  float* vo = p.out + OFF_VS + cbase;
  for (int j = 0; j < 128; ++j) {
    const float kv = kc[(size_t)j * 256];
    if (w == 0 && j >= 1) ko[(size_t)(j - 1) * 256] = kv;
    const float s = wave_sum(qd * kv) * 0.125f;
    if (lane == 0) sP[j] = s;
  }
  {
    const float kv = bf2f(p.K[(size_t)row * 256 + kvh * 64 + lane]);
    const float s = wave_sum(qd * kv) * 0.125f;
    if (lane == 0) sP[128] = s;
  }
  __syncthreads();
  const float sink = p.sinks[l * 16 + head];
  const float s0 = sP[lane], s1 = sP[lane + 64], s2 = sP[128];
  float m = fmaxf(fmaxf(s0, s1), fmaxf(s2, sink));
  m = wave_max(m);
  const float p0 = __expf(s0 - m), p1 = __expf(s1 - m), p2 = __expf(s2 - m);
  float sum = wave_sum(p0 + p1);
  const float inv = 1.f / (sum + p2 + __expf(sink - m));
  __syncthreads();
  sP[lane] = p0 * inv; sP[lane + 64] = p1 * inv;
  if (lane == 0) sP[128] = p2 * inv;
  __syncthreads();
  float o = 0.f;
  for (int j = 0; j < 128; ++j) {
    const float vv = vc[(size_t)j * 256];
    if (w == 0 && j >= 1) vo[(size_t)(j - 1) * 256] = vv;
    o += sP[j] * vv;
  }
  o += sP[128] * bf2f(p.VT[(size_t)(kvh * 64 + lane) * T + row]);
  p.O[(size_t)row * 1024 + head * 64 + lane] = f2bf(o);
}

template <int PASS>
DI void merge_pass(const P& p, const bf16_t* A, const bf16_t* Wt, int m0, int n0, char* smem) {
  m0 = launder_s(m0); n0 = launder_s(n0);
  const int tid = tidx(), lane = tid & 63, w = __builtin_amdgcn_readfirstlane(tid >> 6), wm = w & 1, wn = w >> 1, lr = lane & 31, lh = lane >> 5;
  f32x16 acc[2][2];
#pragma unroll
  for (int a = 0; a < 2; ++a)
#pragma unroll
    for (int b = 0; b < 2; ++b) zero16(acc[a][b]);
  gemm_mainloop(A + (size_t)m0 * 1024, 1024, Wt + (size_t)n0 * 1024, 1024, 1024, acc, smem);
  m0 = launder_s(m0); n0 = launder_s(n0);
#pragma unroll
  for (int mi = 0; mi < 2; ++mi)
#pragma unroll
    for (int ni = 0; ni < 2; ++ni) {
      const int c = n0 + wn * 64 + ni * 32 + lr;
#pragma unroll
      for (int i = 0; i < 16; ++i) {
        const int r = m0 + wm * 64 + mi * 32 + crow(i, lh);
        bf16_t* mp = p.MG + (size_t)r * 1024 + c;
        const float a = acc[mi][ni][i];
        if (PASS == 0) *mp = f2bf(sigm_f(a) * bf2f(p.G[(size_t)r * 3072 + 1024 + c]));
        else if (PASS == 1) *mp = f2bf(bf2f(*mp) * a);
        else if (PASS == 2) *mp = f2bf(bf2f(*mp) + a * bf2f(p.G[(size_t)r * 3072 + c]));
        else *mp = f2bf(bf2f(*mp) + a * bf2f(p.G[(size_t)r * 3072 + 2048 + c]));
      }
    }
}
DI void merge_job(const P& p, int l, int job, char* smem) {
  const int mt = job >> 3, nt = job & 7;
  const int m0 = mt * 128, n0 = nt * 128;
  const bf16_t* wl = p.Wt + (size_t)l * W_LAYER;
  merge_pass<0>(p, p.YS, wl + WO_GLU + (size_t)1024 * 1024, m0, n0, smem);
  merge_pass<1>(p, p.YS, wl + WO_GLU, m0, n0, smem);
  merge_pass<2>(p, p.YM, wl + WO_MPROJ, m0, n0, smem);
  merge_pass<3>(p, p.O, wl + WO_ATTNO, m0, n0, smem);
}
DI void resid_gemm_job(const P& p, const bf16_t* A, int lda, const bf16_t* Wt, int K, int job, char* smem) {
  const int mt = job >> 3, nt = job & 7;
  const int m0 = mt * 128, n0 = nt * 128;
  const int tid = tidx(), lane = tid & 63, w = __builtin_amdgcn_readfirstlane(tid >> 6), wm = w & 1, wn = w >> 1, lr = lane & 31, lh = lane >> 5;
  f32x16 acc[2][2];
#pragma unroll
  for (int a = 0; a < 2; ++a)
#pragma unroll
    for (int b = 0; b < 2; ++b) zero16(acc[a][b]);
  gemm_mainloop(A + (size_t)m0 * lda, lda, Wt + (size_t)n0 * K, K, K, acc, smem);
#pragma unroll
  for (int mi = 0; mi < 2; ++mi)
#pragma unroll
    for (int ni = 0; ni < 2; ++ni) {
      const int c = n0 + wn * 64 + ni * 32 + lr;
#pragma unroll
      for (int i = 0; i < 16; ++i) {
        const int r = m0 + wm * 64 + mi * 32 + crow(i, lh);
        p.X[(size_t)r * 1024 + c] += acc[mi][ni][i];
      }
    }
}
DI void up_job(const P& p, int l, int job, char* smem) {
  const int mt = job >> 5, nt = job & 31;
  const int m0 = mt * 128, n0 = nt * 128;
  const int tid = tidx(), lane = tid & 63, w = __builtin_amdgcn_readfirstlane(tid >> 6), wm = w & 1, wn = w >> 1, lr = lane & 31, lh = lane >> 5;
  f32x16 acc[2][2];
#pragma unroll
  for (int a = 0; a < 2; ++a)
#pragma unroll
    for (int b = 0; b < 2; ++b) zero16(acc[a][b]);
  gemm_mainloop(p.H + (size_t)m0 * 1024, 1024, p.Wt + (size_t)l * W_LAYER + WO_UP + (size_t)n0 * 1024, 1024, 1024, acc, smem);
#pragma unroll
  for (int mi = 0; mi < 2; ++mi)
#pragma unroll
    for (int ni = 0; ni < 2; ++ni) {
      const int c = n0 + wn * 64 + ni * 32 + lr;
#pragma unroll
      for (int i = 0; i < 16; ++i) {
        const int r = m0 + wm * 64 + mi * 32 + crow(i, lh);
        const float v = fmaxf(acc[mi][ni][i], 0.f);
        p.A2[(size_t)r * 4096 + c] = f2bf(v * v);
      }
    }
}

constexpr int NPHASE = 1 + 4 * 11;
DI int phase_jobs(int ph) {
  if (ph == 0) return 22144 + 64 + 257 + 4128;
  const int s = (ph - 1) % 11;
  switch (s) {
    case 0: return 129 * 69;
    case 1: return 2048 + 4096 + 4096 + 512 + 2048 + 512;
    case 2: return 2048;
    case 3: return 256 + 32;
    case 4: return 512 + 4096;
    case 5: return 1032;
    case 6: return 1032;
    case 7: return 4128;
    case 8: return 4128;
    case 9: return 1032;
    default: return 4128;
  }
}
DI void run_job(const P& p, int ph, int job, char* smem) {
  if (ph == 0) {
    if (job < 22144) { prep_weight_job(p, job, smem); return; }
    job -= 22144;
    if (job < 64) { prep_s5_job(p, job); return; }
    job -= 64;
    if (job < 257) { prep_rope_job(p, job); return; }
    job -= 257;
    norm_job(p, job, p.norm1_w, true, false);
    return;
  }
  const int l = (ph - 1) / 11, s = (ph - 1) % 11;
  const bf16_t* wl = p.Wt + (size_t)l * W_LAYER;
  const int w = __builtin_amdgcn_readfirstlane(tidx() >> 6);
  switch (s) {
    case 0: inproj_job(p, l, job, smem); break;
    case 1:
      if (job < 2048) { attn_prompt_job(p, l, job, smem); break; }
      job -= 2048;
      if (job < 4096) { conv_job(p, l, job, smem); break; }
      job -= 4096;
      if (job < 4096) { const int wj = job * 4 + w; s5_wave_job(p, l, 0, wj >> 13, wj & 63, (wj >> 6) & 127, nullptr); break; }
      job -= 4096;
      if (job < 512) { ssd_sample_job(p, l, job, smem); break; }
      job -= 512;
      if (job < 2048) { const int wj = job * 4 + w; __syncthreads(); s5_wave_job(p, l, 2, wj >> 6, wj & 63, 0, (bf16_t*)smem + w * 64 * 136); break; }
      job -= 2048;
      attn_sample_job(p, l, job, smem);
      break;
    case 2: ssd_a_job(p, l, job, smem); break;
    case 3:
      if (job < 256) ssd_scan_job(p, l, job);
      else s5_scan_job(p, l, job - 256);
      break;
    case 4:
      if (job < 512) { ssd_c_job(p, l, job, smem); break; }
      job -= 512;
      { const int wj = job * 4 + w; __syncthreads(); s5_wave_job(p, l, 1, wj >> 13, wj & 63, (wj >> 6) & 127, (bf16_t*)smem + w * 64 * 136); }
      break;
    case 5: merge_job(p, l, job, smem); break;
    case 6: resid_gemm_job(p, p.MG, 1024, wl + WO_WOUT, 1024, job, smem); break;
    case 7: norm_job(p, job, p.norm2_w + l * 1024, false, false); break;
    case 8: up_job(p, l, job, smem); break;
    case 9: resid_gemm_job(p, p.A2, 4096, wl + WO_DOWN, 4096, job, smem); break;
    default:
      if (l == 3) norm_job(p, job, p.final_w, false, true);
      else norm_job(p, job, p.norm1_w + (l + 1) * 1024, false, false);
      break;
  }
}

template <bool COOP>
__global__ void __launch_bounds__(256, 2) mega(P p, int ph0, int ph1) {
  __shared__ __attribute__((aligned(16))) char smem[SMEM_BYTES];
  for (int ph = ph0; ph < ph1; ++ph) {
    const int nj = phase_jobs(ph);
    for (int job = blockIdx.x; job < nj; job += gridDim.x) run_job(p, ph, job, smem);
    if (COOP && ph + 1 < ph1) cg::this_grid().sync();
  }
}

static size_t carve(size_t& off, size_t bytes) { size_t o = off; off += (bytes + 255) & ~(size_t)255; return o; }

extern "C" void kernel_launch(void* const* d_in, const int* in_sizes, int n_in, void* d_out, int out_size, void* d_ws, size_t ws_size,
                              hipStream_t stream) {
  P p{};
  const float** pin = (const float**)&p;
  for (int i = 0; i < 33; ++i) pin[i] = (const float*)d_in[i];
  p.out = (float*)d_out;
  char* ws = (char*)d_ws;
  size_t off = 0;
  const size_t SZ1 = (size_t)T * 1024 * 2;
  p.X = (float*)(ws + carve(off, (size_t)T * 1024 * 4));
  p.H = (bf16_t*)(ws + carve(off, SZ1));
  p.Z = (bf16_t*)(ws + carve(off, SZ1));
  p.U = (bf16_t*)(ws + carve(off, SZ1));
  p.Q = (bf16_t*)(ws + carve(off, SZ1));
  p.YM = (bf16_t*)(ws + carve(off, SZ1));
  p.YS = (bf16_t*)(ws + carve(off, SZ1));
  p.O = (bf16_t*)(ws + carve(off, SZ1));
  p.MG = (bf16_t*)(ws + carve(off, SZ1));
  const size_t a2_off = off;
  p.XBC = (bf16_t*)(ws + carve(off, (size_t)T * 2048 * 2));
  p.XBT = (bf16_t*)(ws + carve(off, (size_t)1536 * TP * 2));
  p.BC = (bf16_t*)(ws + carve(off, (size_t)TP * 1024 * 2));
  p.A2 = (bf16_t*)(ws + a2_off);
  if (off - a2_off < (size_t)T * 4096 * 2) off = a2_off + (((size_t)T * 4096 * 2 + 255) & ~(size_t)255);
  p.K = (bf16_t*)(ws + carve(off, (size_t)T * 256 * 2));
  p.VT = (bf16_t*)(ws + carve(off, (size_t)T * 256 * 2));
  p.G = (bf16_t*)(ws + carve(off, (size_t)T * 3072 * 2));
  p.DT = (float*)(ws + carve(off, (size_t)T * 16 * 4));
  p.ST = (float*)(ws + carve(off, (size_t)2 * 64 * 16 * 64 * 128 * 4));
  p.CDEC = (float*)(ws + carve(off, (size_t)2 * 64 * 16 * 4));
  p.S5S = (float*)(ws + carve(off, (size_t)2 * 128 * 64 * 64 * 2 * 4));
  p.S5P = (float*)(ws + carve(off, (size_t)4 * 64 * 36 * 64 * 4));
  p.ROPE = (float2*)(ws + carve(off, (size_t)8193 * 8 * 8));
  p.Wt = (bf16_t*)(ws + carve(off, (size_t)4 * W_LAYER * 2));
  if (off > ws_size) { fprintf(stderr, "workspace too small: need %zu have %zu\n", off, ws_size); return; }

#if COOP_MODE
  static int grid_blocks = 0;
  if (!grid_blocks) {
    int dev = 0, cus = 0, per_cu = 0;
    hipGetDevice(&dev);
    hipDeviceGetAttribute(&cus, hipDeviceAttributeMultiprocessorCount, dev);
    hipOccupancyMaxActiveBlocksPerMultiprocessor(&per_cu, mega<true>, 256, 0);
    if (per_cu > 2) per_cu = 2;
    if (per_cu < 1) per_cu = 1;
    grid_blocks = cus * per_cu;
  }
  int ph0 = 0, ph1 = NPHASE;
  void* args[] = {&p, &ph0, &ph1};
  hipError_t e = hipLaunchCooperativeKernel((void*)mega<true>, dim3(grid_blocks), dim3(256), args, 0, stream);
  if (e != hipSuccess) fprintf(stderr, "cooperative launch failed: %s (grid %d)\n", hipGetErrorString(e), grid_blocks);
#else
  for (int ph = 0; ph < NPHASE; ++ph) mega<false><<<dim3(1024), dim3(256), 0, stream>>>(p, ph, ph + 1);
#endif
}
```

```cpp
#include <hip/hip_runtime.h>
#include <hip/hip_cooperative_groups.h>
#include <cstdio>
#include <cstdint>
namespace cg = cooperative_groups;

#define DI __device__ __forceinline__
typedef unsigned short bf16_t;
typedef short bf16x8 __attribute__((ext_vector_type(8)));
typedef float f32x16 __attribute__((ext_vector_type(16)));
typedef float f32x4 __attribute__((ext_vector_type(4)));
#define MFMA32(a, b, c) __builtin_amdgcn_mfma_f32_32x32x16_bf16((a), (b), (c), 0, 0, 0)
#define MFMA16(a, b, c) __builtin_amdgcn_mfma_f32_16x16x32_bf16((a), (b), (c), 0, 0, 0)

#ifndef COOP_MODE
#define COOP_MODE 1
#endif

constexpr int TP = 16384, TS = 128, T = TP + TS, SEQ = 8192;
constexpr int NIN = 8720, NINP = 8832;
constexpr int SMEM_BYTES = 73728;
constexpr float EPS = 1e-6f;

constexpr size_t OFF_YP = 0;
constexpr size_t OFF_YS = OFF_YP + (size_t)TP * 1024;
constexpr size_t OFF_SSMP = OFF_YS + (size_t)TS * 1024;
constexpr size_t OFF_SSMS = OFF_SSMP + (size_t)4 * 2 * 16 * 64 * 128;
constexpr size_t OFF_CONVP = OFF_SSMS + (size_t)4 * 128 * 16 * 64 * 128;
constexpr size_t OFF_CONVS = OFF_CONVP + (size_t)4 * 2 * 3 * 2048;
constexpr size_t OFF_S5RP = OFF_CONVS + (size_t)4 * 128 * 3 * 2048;
constexpr size_t OFF_S5RS = OFF_S5RP + (size_t)4 * 2 * 64 * 64;
constexpr size_t OFF_S5IP = OFF_S5RS + (size_t)4 * 128 * 64 * 64;
constexpr size_t OFF_S5IS = OFF_S5IP + (size_t)4 * 2 * 64 * 64;
constexpr size_t OFF_KP = OFF_S5IS + (size_t)4 * 128 * 64 * 64;
constexpr size_t OFF_KS = OFF_KP + (size_t)4 * 2 * 128 * 256;
constexpr size_t OFF_VP = OFF_KS + (size_t)4 * 128 * 128 * 256;
constexpr size_t OFF_VS = OFF_VP + (size_t)4 * 2 * 128 * 256;

constexpr size_t WO_IN = 0;
constexpr size_t WO_MPROJ = WO_IN + (size_t)NINP * 1024;
constexpr size_t WO_GLU = WO_MPROJ + (size_t)1024 * 1024;
constexpr size_t WO_ATTNO = WO_GLU + (size_t)2048 * 1024;
constexpr size_t WO_WOUT = WO_ATTNO + (size_t)1024 * 1024;
constexpr size_t WO_UP = WO_WOUT + (size_t)1024 * 1024;
constexpr size_t WO_DOWN = WO_UP + (size_t)4096 * 1024;
constexpr size_t W_LAYER = WO_DOWN + (size_t)4096 * 1024;

constexpr size_t al256(size_t x) { return (x + 255) & ~(size_t)255; }
constexpr size_t SZ1 = (size_t)T * 1024 * 2;
constexpr size_t WS_X = 0;
constexpr size_t WS_H = WS_X + al256((size_t)T * 1024 * 4);
constexpr size_t WS_Z = WS_H + al256(SZ1);
constexpr size_t WS_U = WS_Z + al256(SZ1);
constexpr size_t WS_Q = WS_U + al256(SZ1);
constexpr size_t WS_YM = WS_Q + al256(SZ1);
constexpr size_t WS_YS = WS_YM + al256(SZ1);
constexpr size_t WS_O = WS_YS + al256(SZ1);
constexpr size_t WS_MG = WS_O + al256(SZ1);
constexpr size_t WS_XBC = WS_MG + al256(SZ1);
constexpr size_t WS_XBT = WS_XBC + al256((size_t)T * 2048 * 2);
constexpr size_t WS_BC = WS_XBT + al256((size_t)1536 * TP * 2);
constexpr size_t WS_A2END = WS_XBC + al256((size_t)T * 4096 * 2);
constexpr size_t WS_BCEND = WS_BC + al256((size_t)TP * 1024 * 2);
constexpr size_t WS_K = WS_A2END > WS_BCEND ? WS_A2END : WS_BCEND;
constexpr size_t WS_VT = WS_K + al256((size_t)T * 256 * 2);
constexpr size_t WS_G = WS_VT + al256((size_t)T * 256 * 2);
constexpr size_t WS_DT = WS_G + al256((size_t)T * 3072 * 2);
constexpr size_t WS_ST = WS_DT + al256((size_t)T * 16 * 4);
constexpr size_t WS_CDEC = WS_ST + al256((size_t)2 * 64 * 16 * 64 * 128 * 4);
constexpr size_t WS_S5S = WS_CDEC + al256((size_t)2 * 64 * 16 * 4);
constexpr size_t WS_S5P = WS_S5S + al256((size_t)2 * 128 * 64 * 64 * 2 * 4);
constexpr size_t WS_ROPE = WS_S5P + al256((size_t)4 * 64 * 36 * 64 * 4);
constexpr size_t WS_WT = WS_ROPE + al256((size_t)8193 * 8 * 8);
constexpr size_t WS_TOTAL = WS_WT + al256((size_t)4 * W_LAYER * 2);

struct P {
  const float *x_prompt, *x_sample, *state_ssm, *state_conv, *s5_sre, *s5_sim, *cache_k, *cache_v;
  const float *norm1_w, *w_in, *conv_w, *conv_b, *dt_bias, *a_log, *m_d, *m_norm_w, *m_proj;
  const float *lam_re, *lam_im, *log_step, *b_re, *b_im, *c_re, *c_im, *s5_d, *glu_w;
  const float *sinks, *attn_o, *w_out, *norm2_w, *mlp_up, *mlp_down, *final_w;
  float* out;
  char* ws;
#define WSACC(name, type, off) __device__ __forceinline__ type* name() const { return (type*)(ws + (off)); }
  WSACC(X, float, WS_X) WSACC(H, bf16_t, WS_H) WSACC(Z, bf16_t, WS_Z) WSACC(U, bf16_t, WS_U) WSACC(Q, bf16_t, WS_Q)
  WSACC(YM, bf16_t, WS_YM) WSACC(YS, bf16_t, WS_YS) WSACC(O, bf16_t, WS_O) WSACC(MG, bf16_t, WS_MG)
  WSACC(XBC, bf16_t, WS_XBC) WSACC(XBT, bf16_t, WS_XBT) WSACC(BC, bf16_t, WS_BC) WSACC(A2, bf16_t, WS_XBC)
  WSACC(K, bf16_t, WS_K) WSACC(VT, bf16_t, WS_VT) WSACC(G, bf16_t, WS_G) WSACC(DT, float, WS_DT) WSACC(ST, float, WS_ST)
  WSACC(CDEC, float, WS_CDEC) WSACC(S5S, float, WS_S5S) WSACC(S5P, float, WS_S5P) WSACC(ROPE, float2, WS_ROPE) WSACC(Wt, bf16_t, WS_WT)
#undef WSACC
};

DI bf16_t f2bf(float x) { unsigned u = __float_as_uint(x); u += 0x7fffu + ((u >> 16) & 1u); return (bf16_t)(u >> 16); }
DI float bf2f(bf16_t b) { return __uint_as_float(((unsigned)b) << 16); }
DI unsigned pack2(float a, float b) { return (unsigned)f2bf(a) | ((unsigned)f2bf(b) << 16); }
DI float bflo(unsigned u) { return __uint_as_float(u << 16); }
DI float bfhi(unsigned u) { return __uint_as_float(u & 0xffff0000u); }
DI float silu_f(float x) { return x / (1.f + __expf(-x)); }
DI float sigm_f(float x) { return 1.f / (1.f + __expf(-x)); }
DI float softplus_f(float x) { return x > 20.f ? x : log1pf(expf(x)); }
DI float gelu_tanh(float x) { float y = 0.7978845608028654f * (x + 0.044715f * x * x * x); float t = 1.f - 2.f / (__expf(2.f * y) + 1.f); return 0.5f * x * (1.f + t); }
DI int crow(int i, int lh) { return (i & 3) + 8 * (i >> 2) + 4 * lh; }
DI int launder(int x) { asm volatile("" : "+v"(x)); return x; }
DI int tidx() { int t = __builtin_amdgcn_workitem_id_x(); asm volatile("" : "+v"(t)); return t; }
DI int launder_s(int x) { asm volatile("" : "+s"(x)); return x; }
DI float wave_sum(float v) {
#pragma unroll
  for (int o = 32; o >= 1; o >>= 1) v += __shfl_xor(v, o);
  return v;
}
DI float wave_max(float v) {
#pragma unroll
  for (int o = 32; o >= 1; o >>= 1) v = fmaxf(v, __shfl_xor(v, o));
  return v;
}
DI bf16x8 u4_to_bf8(uint4 v) { return __builtin_bit_cast(bf16x8, v); }
DI void zero16(f32x16& a) {
#pragma unroll
  for (int i = 0; i < 16; ++i) a[i] = 0.f;
}

constexpr int LDT = 72;
DI void gemm_mainloop(const bf16_t* __restrict__ A, int lda, const bf16_t* __restrict__ B, int ldb, int K,
                      f32x16 (&acc)[2][2], char* smem) {
  bf16_t* sa = (bf16_t*)smem;
  bf16_t* sb = sa + 2 * 128 * LDT;
  const int tid = tidx(), lane = tid & 63, w = __builtin_amdgcn_readfirstlane(tid >> 6), wm = w & 1, wn = w >> 1, lr = lane & 31, lh = lane >> 5;
  const int r0 = tid >> 3, ch = (tid & 7) * 8;
  const bf16_t* ap = A + (size_t)r0 * lda + ch;
  const bf16_t* bp = B + (size_t)r0 * ldb + ch;
  uint4 pa0, pa1, pa2, pa3, pb0, pb1, pb2, pb3;
  uint4 qa0, qa1, qa2, qa3, qb0, qb1, qb2, qb3;
#define GLOADS(R, k0)                                                                                      \
  R##a0 = *(const uint4*)(ap + (k0)); R##a1 = *(const uint4*)(ap + (size_t)32 * lda + (k0));               \
  R##a2 = *(const uint4*)(ap + (size_t)64 * lda + (k0)); R##a3 = *(const uint4*)(ap + (size_t)96 * lda + (k0)); \
  R##b0 = *(const uint4*)(bp + (k0)); R##b1 = *(const uint4*)(bp + (size_t)32 * ldb + (k0));               \
  R##b2 = *(const uint4*)(bp + (size_t)64 * ldb + (k0)); R##b3 = *(const uint4*)(bp + (size_t)96 * ldb + (k0));
#define SSTORES(R, bufi)                                                                                   \
  { bf16_t* da = sa + (bufi)*128 * LDT; bf16_t* db = sb + (bufi)*128 * LDT;                                \
    *(uint4*)(da + (r0)*LDT + ch) = R##a0; *(uint4*)(da + (r0 + 32) * LDT + ch) = R##a1;                   \
    *(uint4*)(da + (r0 + 64) * LDT + ch) = R##a2; *(uint4*)(da + (r0 + 96) * LDT + ch) = R##a3;            \
    *(uint4*)(db + (r0)*LDT + ch) = R##b0; *(uint4*)(db + (r0 + 32) * LDT + ch) = R##b1;                   \
    *(uint4*)(db + (r0 + 64) * LDT + ch) = R##b2; *(uint4*)(db + (r0 + 96) * LDT + ch) = R##b3; }
#define COMPUTE(bufi)                                                                                      \
  { const bf16_t* ca = sa + (bufi)*128 * LDT + (wm * 64 + lr) * LDT + lh * 8;                              \
    const bf16_t* cb = sb + (bufi)*128 * LDT + (wn * 64 + lr) * LDT + lh * 8;                              \
    _Pragma("unroll") for (int kk = 0; kk < 4; ++kk) {                                                     \
      const bf16x8 af0 = *(const bf16x8*)(ca + kk * 16), af1 = *(const bf16x8*)(ca + 32 * LDT + kk * 16);  \
      const bf16x8 bf0 = *(const bf16x8*)(cb + kk * 16), bf1 = *(const bf16x8*)(cb + 32 * LDT + kk * 16);  \
      acc[0][0] = MFMA32(af0, bf0, acc[0][0]); acc[0][1] = MFMA32(af0, bf1, acc[0][1]);                    \
      acc[1][0] = MFMA32(af1, bf0, acc[1][0]); acc[1][1] = MFMA32(af1, bf1, acc[1][1]); } }
  const int nk = K >> 6;
  const int klast = (nk - 1) * 64;
  GLOADS(p, 0)
  __syncthreads();
  SSTORES(p, 0)
  GLOADS(p, 64)
  __syncthreads();
  for (int kt = 0; kt < nk; kt += 2) {
    { const int k2 = (kt + 2) * 64; const int k0 = k2 < klast ? k2 : klast; GLOADS(q, k0) }
    COMPUTE(0)
    SSTORES(p, 1)
    __syncthreads();
    { const int k3 = (kt + 3) * 64; const int k0 = k3 < klast ? k3 : klast; GLOADS(p, k0) }
    COMPUTE(1)
    SSTORES(q, 0)
    __syncthreads();
  }
#undef GLOADS
#undef SSTORES
#undef COMPUTE
}
DI bool gemm_tile(int slot, int MT, int NT, int& mt, int& nt) {
  const int G = gridDim.x, nx = G >> 3;
  int J = slot;
  if ((G & 7) == 0) J = (slot / G) * G + (slot & 7) * nx + ((slot % G) >> 3);
  if (J >= MT * NT) return false;
  const int gw = 8 * NT, grp = J / gw, rem = J - grp * gw, fm = grp * 8;
  const int gsz = (MT - fm) < 8 ? (MT - fm) : 8;
  mt = fm + rem % gsz; nt = rem / gsz;
  return true;
}

DI int win_map(int n) {
  if (n < 3072) return n;
  if (n < 8704) return n + 16;
  if (n < 8720) return n - 8704 + 3072;
  return -1;
}
DI void wtrans_tile(const float* __restrict__ src, int N, int K, bf16_t* __restrict__ dst, int kt, int nt, bool inmap, char* smem) {
  float* s = (float*)smem;
  const int tid = tidx();
  __syncthreads();
  const int nn = tid & 63;
  int sc = nt * 64 + nn;
  if (inmap) sc = win_map(sc);
#pragma unroll
  for (int it = 0; it < 16; ++it) {
    const int kk = it * 4 + (tid >> 6);
    s[kk * 65 + nn] = (sc >= 0) ? src[(size_t)(kt * 64 + kk) * N + sc] : 0.f;
  }
  __syncthreads();
#pragma unroll
  for (int it = 0; it < 16; ++it) {
    const int n2 = it * 4 + (tid >> 6), k2 = tid & 63;
    dst[(size_t)(nt * 64 + n2) * K + kt * 64 + k2] = f2bf(s[k2 * 65 + n2]);
  }
}
DI void prep_weight_job(const P& p, int j, char* smem) {
  const int l = j / 5536; int r = j % 5536;
  bf16_t* wl = p.Wt() + (size_t)l * W_LAYER;
  if (r < 2208) { wtrans_tile(p.w_in + (size_t)l * 1024 * NIN, NIN, 1024, wl + WO_IN, r / 138, r % 138, true, smem); return; }
  r -= 2208;
  if (r < 256) { wtrans_tile(p.m_proj + (size_t)l * 1024 * 1024, 1024, 1024, wl + WO_MPROJ, r / 16, r % 16, false, smem); return; }
  r -= 256;
  if (r < 512) { wtrans_tile(p.glu_w + (size_t)l * 1024 * 2048, 2048, 1024, wl + WO_GLU, r / 32, r % 32, false, smem); return; }
  r -= 512;
  if (r < 256) { wtrans_tile(p.attn_o + (size_t)l * 1024 * 1024, 1024, 1024, wl + WO_ATTNO, r / 16, r % 16, false, smem); return; }
  r -= 256;
  if (r < 256) { wtrans_tile(p.w_out + (size_t)l * 1024 * 1024, 1024, 1024, wl + WO_WOUT, r / 16, r % 16, false, smem); return; }
  r -= 256;
  if (r < 1024) { wtrans_tile(p.mlp_up + (size_t)l * 1024 * 4096, 4096, 1024, wl + WO_UP, r / 64, r % 64, false, smem); return; }
  r -= 1024;
  wtrans_tile(p.mlp_down + (size_t)l * 4096 * 1024, 1024, 4096, wl + WO_DOWN, r / 16, r % 16, false, smem);
}
DI void prep_s5_job(const P& p, int j) {
  const int idx = j * 256 + tidx();
  const int n = idx & 63, g = (idx >> 6) & 63, l = idx >> 12;
  const float step = expf(p.log_step[l * 64 + g]);
  const float lr_ = p.lam_re[(l * 64 + g) * 64 + n], li = p.lam_im[(l * 64 + g) * 64 + n];
  const float mag = expf(lr_ * step);
  const float abr = mag * cosf(li * step), abi = mag * sinf(li * step);
  float aqr = abr, aqi = abi;
#pragma unroll
  for (int q = 0; q < 6; ++q) { const float nr2 = aqr * aqr - aqi * aqi, ni2 = 2.f * aqr * aqi; aqr = nr2; aqi = ni2; }
  const float den = lr_ * lr_ + li * li;
  const float nr = abr - 1.0f, ni = abi;
  const float fre = (nr * lr_ + ni * li) / den, fim = (ni * lr_ - nr * li) / den;
  float* o = p.S5P() + ((size_t)(l * 64 + g) * 36) * 64 + n;
  o[0] = abr; o[64] = abi; o[128] = aqr; o[192] = aqi;
  const float* br = p.b_re + ((size_t)(l * 64 + g) * 64 + n) * 16;
  const float* bi = p.b_im + ((size_t)(l * 64 + g) * 64 + n) * 16;
#pragma unroll
  for (int i = 0; i < 16; ++i) {
    const float b_r = br[i], b_i = bi[i];
    o[(4 + i) * 64] = fre * b_r - fim * b_i;
    o[(20 + i) * 64] = fre * b_i + fim * b_r;
  }
}
DI void prep_rope_job(const P& p, int j) {
  const int idx = j * 256 + tidx();
  if (idx >= 8193 * 8) return;
  const int pos = idx >> 3, f = idx & 7;
  const float invf = expf(-(2.0f * (float)f / 16.0f) * logf(500000.0f));
  const float ang = (float)pos * invf;
  p.ROPE()[idx] = make_float2(cosf(ang), sinf(ang));
}

DI void norm_job(const P& p, int job, const float* wgt, bool layer0, bool final_) {
  const int w = __builtin_amdgcn_readfirstlane(tidx() >> 6), lane = tidx() & 63;
  const int r = job * 4 + w;
  const float* src = layer0 ? (r < TP ? p.x_prompt + (size_t)r * 1024 : p.x_sample + (size_t)(r - TP) * 1024) : p.X() + (size_t)r * 1024;
  float4 v[4];
  float ss = 0.f;
#pragma unroll
  for (int q = 0; q < 4; ++q) { v[q] = ((const float4*)src)[lane + 64 * q]; ss += v[q].x * v[q].x + v[q].y * v[q].y + v[q].z * v[q].z + v[q].w * v[q].w; }
  ss = wave_sum(ss);
  const float sc = rsqrtf(ss * (1.f / 1024.f) + EPS);
#pragma unroll
  for (int q = 0; q < 4; ++q) {
    const float4 wv = ((const float4*)wgt)[lane + 64 * q];
    float4 y = make_float4(v[q].x * sc * wv.x, v[q].y * sc * wv.y, v[q].z * sc * wv.z, v[q].w * sc * wv.w);
    if (final_) ((float4*)(p.out + OFF_YP + (size_t)r * 1024))[lane + 64 * q] = y;
    else *(uint2*)(p.H() + (size_t)r * 1024 + (lane + 64 * q) * 4) = make_uint2(pack2(y.x, y.y), pack2(y.z, y.w));
    if (layer0) ((float4*)(p.X() + (size_t)r * 1024))[lane + 64 * q] = v[q];
  }
}

DI void inproj_job(const P& p, int l, int job, char* smem) {
  int mt, nt;
  if (!gemm_tile(job, 129, 69, mt, nt)) return;
  const int m0 = mt * 128, n0 = nt * 128;
  f32x16 acc[2][2];
#pragma unroll
  for (int a = 0; a < 2; ++a)
#pragma unroll
    for (int b = 0; b < 2; ++b) zero16(acc[a][b]);
  gemm_mainloop(p.H() + (size_t)m0 * 1024, 1024, p.Wt() + (size_t)l * W_LAYER + WO_IN + (size_t)n0 * 1024, 1024, 1024, acc, smem);
  const int tid = tidx(), lane = tid & 63, w = __builtin_amdgcn_readfirstlane(tid >> 6), wm = w & 1, wn = w >> 1, lr = lane & 31, lh = lane >> 5;
#pragma unroll
  for (int ni = 0; ni < 2; ++ni) {
    const int cb = n0 + wn * 64 + ni * 32;
    if (cb >= NIN) continue;
    const int c = cb + lr;
#pragma unroll
    for (int mi = 0; mi < 2; ++mi) {
      const int rbase = m0 + wm * 64 + mi * 32 + 4 * lh;
      if (cb < 1024) {
#pragma unroll
        for (int i = 0; i < 16; ++i) { const int r = rbase + (i & 3) + 8 * (i >> 2); p.Z()[(size_t)r * 1024 + c] = f2bf(acc[mi][ni][i]); }
      } else if (cb < 3072) {
        const int ch = c - 1024;
#pragma unroll
        for (int i = 0; i < 16; ++i) {
          const int r = rbase + (i & 3) + 8 * (i >> 2);
          const float v = acc[mi][ni][i];
          p.XBC()[(size_t)r * 2048 + ch] = f2bf(v);
          if (r >= TP) p.out[OFF_CONVS + ((size_t)(l * 128 + (r - TP)) * 3 + 2) * 2048 + ch] = v;
          else { const int t = r & 8191; if (t >= 8189) p.out[OFF_CONVP + ((size_t)(l * 2 + (r >> 13)) * 3 + (t - 8189)) * 2048 + ch] = v; }
        }
      } else if (cb < 4096) {
#pragma unroll
        for (int i = 0; i < 16; ++i) { const int r = rbase + (i & 3) + 8 * (i >> 2); p.U()[(size_t)r * 1024 + (c - 3072)] = f2bf(acc[mi][ni][i]); }
      } else if (cb < 5376) {
        const bool isq = cb < 5120;
        const int cc = isq ? c - 4096 : c - 5120;
        const bool ropeblk = ((cb & 63) == 0);
#pragma unroll
        for (int i = 0; i < 16; ++i) {
          const int r = rbase + (i & 3) + 8 * (i >> 2);
          float v = acc[mi][ni][i];
          if (ropeblk) {
            const float pv = __shfl_xor(v, 8);
            if (lr < 16) {
              const int pos = (r >= TP) ? 8192 : (r & 8191);
              const float2 cs = p.ROPE()[pos * 8 + (lr & 7)];
              v = (lr < 8) ? v * cs.x - pv * cs.y : v * cs.x + pv * cs.y;
            }
          }
          if (isq) p.Q()[(size_t)r * 1024 + cc] = f2bf(v);
          else {
            p.K()[(size_t)r * 256 + cc] = f2bf(v);
            if (r >= TP) p.out[OFF_KS + ((size_t)(l * 128 + (r - TP)) * 128 + 127) * 256 + cc] = v;
            else { const int t = r & 8191; if (t >= 8064) p.out[OFF_KP + ((size_t)(l * 2 + (r >> 13)) * 128 + (t - 8064)) * 256 + cc] = v; }
          }
        }
      } else if (cb < 5632) {
        const int cc = c - 5376;
#pragma unroll
        for (int ig = 0; ig < 4; ++ig) {
          const int r0 = rbase + 8 * ig;
          const float v0 = acc[mi][ni][4 * ig], v1 = acc[mi][ni][4 * ig + 1], v2 = acc[mi][ni][4 * ig + 2], v3 = acc[mi][ni][4 * ig + 3];
          *(uint2*)(p.VT() + (size_t)cc * T + r0) = make_uint2(pack2(v0, v1), pack2(v2, v3));
#pragma unroll
          for (int jj = 0; jj < 4; ++jj) {
            const int r = r0 + jj;
            const float v = acc[mi][ni][4 * ig + jj];
            if (r >= TP) p.out[OFF_VS + ((size_t)(l * 128 + (r - TP)) * 128 + 127) * 256 + cc] = v;
            else { const int t = r & 8191; if (t >= 8064) p.out[OFF_VP + ((size_t)(l * 2 + (r >> 13)) * 128 + (t - 8064)) * 256 + cc] = v; }
          }
        }
      } else if (cb < 8704) {
#pragma unroll
        for (int i = 0; i < 16; ++i) { const int r = rbase + (i & 3) + 8 * (i >> 2); p.G()[(size_t)r * 3072 + (c - 5632)] = f2bf(sigm_f(acc[mi][ni][i])); }
      } else {
        if (lr < 16) {
          const float bias = p.dt_bias[l * 16 + lr];
#pragma unroll
          for (int i = 0; i < 16; ++i) { const int r = rbase + (i & 3) + 8 * (i >> 2); p.DT()[(size_t)r * 16 + lr] = softplus_f(acc[mi][ni][i] + bias); }
        }
      }
    }
  }
}

DI void conv_job(const P& p, int l, int job, char* smem) {
  const int ct = job & 31, tt = job >> 5;
  const int ch0 = ct * 64, tokb = tt * 128;
  bf16_t* sT = (bf16_t*)smem;
  const int tid = tidx();
  const float* cw = p.conv_w + (size_t)l * 4 * 2048;
  __syncthreads();
#pragma unroll
  for (int it = 0; it < 4; ++it) {
    const int item = tid + 256 * it, tl = item >> 3, chk = item & 7, ch = ch0 + chk * 8, row = tokb + tl, t = row & 8191;
    float a[8];
    {
      const float4 b0 = *(const float4*)(p.conv_b + l * 2048 + ch), b1 = *(const float4*)(p.conv_b + l * 2048 + ch + 4);
      a[0] = b0.x; a[1] = b0.y; a[2] = b0.z; a[3] = b0.w; a[4] = b1.x; a[5] = b1.y; a[6] = b1.z; a[7] = b1.w;
    }
#pragma unroll
    for (int j = 0; j < 4; ++j) {
      if (t - 3 + j >= 0) {
        const uint4 rv = *(const uint4*)(p.XBC() + (size_t)(row - 3 + j) * 2048 + ch);
        const float4 w0 = *(const float4*)(cw + j * 2048 + ch), w1 = *(const float4*)(cw + j * 2048 + ch + 4);
        a[0] += bflo(rv.x) * w0.x; a[1] += bfhi(rv.x) * w0.y; a[2] += bflo(rv.y) * w0.z; a[3] += bfhi(rv.y) * w0.w;
        a[4] += bflo(rv.z) * w1.x; a[5] += bfhi(rv.z) * w1.y; a[6] += bflo(rv.w) * w1.z; a[7] += bfhi(rv.w) * w1.w;
      }
    }
#pragma unroll
    for (int j = 0; j < 8; ++j) a[j] = silu_f(a[j]);
    if (ct >= 16) *(uint4*)(p.BC() + (size_t)row * 1024 + (ch - 1024)) = make_uint4(pack2(a[0], a[1]), pack2(a[2], a[3]), pack2(a[4], a[5]), pack2(a[6], a[7]));
    if (ct < 24) {
#pragma unroll
      for (int j = 0; j < 8; ++j) sT[(chk * 8 + j) * 136 + tl] = f2bf(a[j]);
    }
  }
  if (ct < 24) {
    __syncthreads();
#pragma unroll
    for (int it = 0; it < 4; ++it) {
      const int item = tid + 256 * it, r = item >> 4, chk = item & 15;
      *(uint4*)(p.XBT() + (size_t)(ch0 + r) * TP + tokb + chk * 8) = *(const uint4*)(sT + r * 136 + chk * 8);
    }
  }
}

DI void chunk_acum(const P& p, int l, int head, int tok0, float* sAc, float* sDt, float& alast) {
  const int lane = tidx() & 63;
  const float Ah = -expf(p.a_log[l * 16 + head]);
  const float d0 = p.DT()[(size_t)(tok0 + 2 * lane) * 16 + head], d1 = p.DT()[(size_t)(tok0 + 2 * lane + 1) * 16 + head];
  const float a0 = d0 * Ah, a1 = d1 * Ah;
  float s = a0 + a1;
#pragma unroll
  for (int off = 1; off < 64; off <<= 1) { const float tv = __shfl_up(s, off); if (lane >= off) s += tv; }
  const float excl = s - (a0 + a1);
  sAc[2 * lane] = excl + a0; sAc[2 * lane + 1] = s;
  sDt[2 * lane] = d0; sDt[2 * lane + 1] = d1;
  alast = __shfl(s, 63);
}

DI void ssd_a_job(const P& p, int l, int job, char* smem) {
  const int head = job & 15, c = (job >> 4) & 63, b = job >> 10, g = head >> 2;
  const int tok0 = b * SEQ + c * 128;
  bf16_t* sXT = (bf16_t*)smem;
  bf16_t* sBT = sXT + 64 * 136;
  float* sW = (float*)(sBT + 128 * 136);
  float* sAc = sW + 128;
  float* sDt = sAc + 128;
  const int tid = tidx(), lane = tid & 63, w = __builtin_amdgcn_readfirstlane(tid >> 6), lr = lane & 31, lh = lane >> 5;
  __syncthreads();
  if (w == 0) {
    float alast;
    chunk_acum(p, l, head, tok0, sAc, sDt, alast);
    sW[2 * lane] = sDt[2 * lane] * __expf(alast - sAc[2 * lane]);
    sW[2 * lane + 1] = sDt[2 * lane + 1] * __expf(alast - sAc[2 * lane + 1]);
    if (lane == 0) p.CDEC()[(b * 64 + c) * 16 + head] = __expf(alast);
  }
  __syncthreads();
#pragma unroll
  for (int it = 0; it < 4; ++it) {
    const int item = tid + 256 * it, pr = item >> 4, s0 = (item & 15) * 8;
    const uint4 v = *(const uint4*)(p.XBT() + (size_t)(head * 64 + pr) * TP + tok0 + s0);
    const float4 w0 = *(const float4*)(sW + s0), w1 = *(const float4*)(sW + s0 + 4);
    *(uint4*)(sXT + pr * 136 + s0) = make_uint4(pack2(bflo(v.x) * w0.x, bfhi(v.x) * w0.y), pack2(bflo(v.y) * w0.z, bfhi(v.y) * w0.w),
                                                pack2(bflo(v.z) * w1.x, bfhi(v.z) * w1.y), pack2(bflo(v.w) * w1.z, bfhi(v.w) * w1.w));
  }
#pragma unroll
  for (int it = 0; it < 8; ++it) {
    const int item = tid + 256 * it, n = item >> 4, s0 = (item & 15) * 8;
    *(uint4*)(sBT + n * 136 + s0) = *(const uint4*)(p.XBT() + (size_t)(1024 + g * 128 + n) * TP + tok0 + s0);
  }
  __syncthreads();
  const int wp = w & 1, wn = w >> 1;
  f32x16 acc[2];
  zero16(acc[0]); zero16(acc[1]);
#pragma unroll
  for (int kk = 0; kk < 8; ++kk) {
    const bf16x8 af = *(const bf16x8*)(sXT + (wp * 32 + lr) * 136 + kk * 16 + lh * 8);
#pragma unroll
    for (int ni = 0; ni < 2; ++ni) {
      const bf16x8 bfr = *(const bf16x8*)(sBT + (wn * 64 + ni * 32 + lr) * 136 + kk * 16 + lh * 8);
      acc[ni] = MFMA32(af, bfr, acc[ni]);
    }
  }
  float* st = p.ST() + ((size_t)((b * 64 + c) * 16 + head) * 64) * 128;
#pragma unroll
  for (int ni = 0; ni < 2; ++ni)
#pragma unroll
    for (int i = 0; i < 16; ++i) st[(wp * 32 + crow(i, lh)) * 128 + wn * 64 + ni * 32 + lr] = acc[ni][i];
}

DI void ssd_scan_job(const P& p, int l, int job) {
  const int gid = job * 256 + tidx();
  const int b = gid >> 15, rem = gid & 32767, head = rem >> 11;
  float4 h = make_float4(0.f, 0.f, 0.f, 0.f);
  float4* sp0 = (float4*)(p.ST() + (size_t)(b * 64) * 131072) + rem;
  for (int c0 = 0; c0 < 64; c0 += 8) {
    float4 sv[8];
    float dv[8];
#pragma unroll
    for (int k = 0; k < 8; ++k) { sv[k] = sp0[(size_t)(c0 + k) * 32768]; dv[k] = p.CDEC()[(b * 64 + c0 + k) * 16 + head]; }
#pragma unroll
    for (int k = 0; k < 8; ++k) {
      sp0[(size_t)(c0 + k) * 32768] = h;
      h.x = h.x * dv[k] + sv[k].x; h.y = h.y * dv[k] + sv[k].y; h.z = h.z * dv[k] + sv[k].z; h.w = h.w * dv[k] + sv[k].w;
    }
  }
  ((float4*)(p.out + OFF_SSMP + (size_t)(l * 2 + b) * 131072))[rem] = h;
}

DI void s5_scan_job(const P& p, int l, int job) {
  const int gid = job * 256 + tidx();
  const int n = gid & 63, g = (gid >> 6) & 63, b = gid >> 12;
  const float* prm = p.S5P() + ((size_t)(l * 64 + g) * 36) * 64 + n;
  const float aqr = prm[128], aqi = prm[192];
  float hr = 0.f, hi = 0.f;
  float2* sp = (float2*)p.S5S() + ((size_t)(b * 128) * 64 + g) * 64 + n;
  for (int c0 = 0; c0 < 128; c0 += 8) {
    float2 sv[8];
#pragma unroll
    for (int k = 0; k < 8; ++k) sv[k] = sp[(size_t)(c0 + k) * 4096];
#pragma unroll
    for (int k = 0; k < 8; ++k) {
      sp[(size_t)(c0 + k) * 4096] = make_float2(hr, hi);
      const float nr = aqr * hr - aqi * hi + sv[k].x, ni = aqr * hi + aqi * hr + sv[k].y;
      hr = nr; hi = ni;
    }
  }
}

DI void ssd_c_job(const P& p, int l, int job, char* smem) {
  const int g = job & 3, c = (job >> 2) & 63, b = job >> 8;
  const int tok0 = b * SEQ + c * 128;
  bf16_t* sC = (bf16_t*)smem;
  bf16_t* sB = sC + 128 * 136;
  float* sAc = (float*)(sB + 128 * 136);
  float* sDt = sAc + 512;
  const int tid = tidx(), lane = tid & 63, w = __builtin_amdgcn_readfirstlane(tid >> 6), lr = lane & 31, lh = lane >> 5, wm = w & 1, wn = w >> 1;
  __syncthreads();
  { float alast; chunk_acum(p, l, g * 4 + w, tok0, sAc + w * 128, sDt + w * 128, alast); }
#pragma unroll
  for (int it = 0; it < 8; ++it) {
    const int item = tid + 256 * it, r = item >> 4, s0 = (item & 15) * 8;
    *(uint4*)(sC + r * 136 + s0) = *(const uint4*)(p.BC() + (size_t)(tok0 + r) * 1024 + 512 + g * 128 + s0);
    *(uint4*)(sB + r * 136 + s0) = *(const uint4*)(p.BC() + (size_t)(tok0 + r) * 1024 + g * 128 + s0);
  }
  __syncthreads();
  f32x16 cb[2][2];
#pragma unroll
  for (int a = 0; a < 2; ++a)
#pragma unroll
    for (int bb = 0; bb < 2; ++bb) zero16(cb[a][bb]);
  if (!(wm == 0 && wn == 1)) {
#pragma unroll
    for (int kk = 0; kk < 8; ++kk) {
      bf16x8 af[2], bfr[2];
#pragma unroll
      for (int mi = 0; mi < 2; ++mi) af[mi] = *(const bf16x8*)(sC + (wm * 64 + mi * 32 + lr) * 136 + kk * 16 + lh * 8);
#pragma unroll
      for (int ni = 0; ni < 2; ++ni) bfr[ni] = *(const bf16x8*)(sB + (wn * 64 + ni * 32 + lr) * 136 + kk * 16 + lh * 8);
#pragma unroll
      for (int mi = 0; mi < 2; ++mi)
#pragma unroll
        for (int ni = 0; ni < 2; ++ni) cb[mi][ni] = MFMA32(af[mi], bfr[ni], cb[mi][ni]);
    }
  }
  __syncthreads();
  bf16_t* sM = sB;
  unsigned cbp[2][2][8];
#pragma unroll
  for (int a = 0; a < 2; ++a)
#pragma unroll
    for (int bb = 0; bb < 2; ++bb)
#pragma unroll
      for (int k = 0; k < 8; ++k) cbp[a][bb][k] = pack2(cb[a][bb][2 * k], cb[a][bb][2 * k + 1]);
  float ss[16];
#pragma unroll
  for (int i = 0; i < 16; ++i) ss[i] = 0.f;
#pragma unroll 1
  for (int hd = 0; hd < 4; ++hd) {
    const int head = g * 4 + hd;
    const float* ac = sAc + hd * 128;
    const float* dtv = sDt + hd * 128;
    const int lrq = launder(lr), lhq = launder(lh);
#pragma unroll
    for (int mi = 0; mi < 2; ++mi)
#pragma unroll
      for (int ni = 0; ni < 2; ++ni) {
        const int s = wn * 64 + ni * 32 + lrq;
        const float as = ac[s], ds = dtv[s];
#pragma unroll
        for (int i = 0; i < 16; ++i) {
          const int t = wm * 64 + mi * 32 + crow(i, lhq);
          const float cv = (i & 1) ? bfhi(cbp[mi][ni][i >> 1]) : bflo(cbp[mi][ni][i >> 1]);
          const float v = (s <= t) ? cv * __expf(ac[t] - as) * ds : 0.f;
          sM[t * 136 + s] = f2bf(v);
        }
        __builtin_amdgcn_sched_barrier(0);
      }
    __syncthreads();
    f32x16 yd[2];
    zero16(yd[0]); zero16(yd[1]);
#pragma unroll 1
    for (int kk = 0; kk < 8; ++kk) {
      const bf16x8 af = *(const bf16x8*)(sC + (32 * w + lr) * 136 + kk * 16 + lh * 8);
#pragma unroll
      for (int pb = 0; pb < 2; ++pb) {
        const float* hp = p.ST() + (((size_t)((b * 64 + c) * 16 + head) * 64 + pb * 32 + lr) * 128 + kk * 16 + lh * 8);
        const float4 h0 = ((const float4*)hp)[0], h1 = ((const float4*)hp)[1];
        const uint4 hv = make_uint4(pack2(h0.x, h0.y), pack2(h0.z, h0.w), pack2(h1.x, h1.y), pack2(h1.z, h1.w));
        yd[pb] = MFMA32(af, u4_to_bf8(hv), yd[pb]);
      }
    }
#pragma unroll
    for (int i = 0; i < 16; ++i) {
      const float e = __expf(ac[32 * w + crow(i, lh)]);
      yd[0][i] *= e; yd[1][i] *= e;
    }
    const int nkk = 2 * (w + 1);
    for (int kk = 0; kk < nkk; ++kk) {
      const bf16x8 af = *(const bf16x8*)(sM + (32 * w + lr) * 136 + kk * 16 + lh * 8);
#pragma unroll
      for (int pb = 0; pb < 2; ++pb) {
        const bf16x8 bfr = *(const bf16x8*)(p.XBT() + (size_t)(head * 64 + pb * 32 + lr) * TP + tok0 + kk * 16 + lh * 8);
        yd[pb] = MFMA32(af, bfr, yd[pb]);
      }
    }
    const float Dh = p.m_d[l * 16 + head];
#pragma unroll
    for (int pb = 0; pb < 2; ++pb) {
      const int pch = head * 64 + pb * 32 + lr;
#pragma unroll
      for (int ig = 0; ig < 4; ++ig) {
        const int t0 = 32 * w + 8 * ig + 4 * lh;
        const uint2 xr = *(const uint2*)(p.XBT() + (size_t)pch * TP + tok0 + t0);
        const float xs[4] = {bflo(xr.x), bfhi(xr.x), bflo(xr.y), bfhi(xr.y)};
#pragma unroll
        for (int jj = 0; jj < 4; ++jj) {
          const int i = 4 * ig + jj, t = t0 + jj;
          const float y = yd[pb][i] + Dh * xs[jj];
          const float z = bf2f(p.Z()[(size_t)(tok0 + t) * 1024 + pch]);
          const float yg = y * silu_f(z);
          ss[i] += yg * yg;
          p.YM()[(size_t)(tok0 + t) * 1024 + pch] = f2bf(yg);
        }
      }
      __builtin_amdgcn_sched_barrier(0);
    }
    __syncthreads();
  }
#pragma unroll
  for (int i = 0; i < 16; ++i) {
    float v = ss[i];
    v += __shfl_xor(v, 1); v += __shfl_xor(v, 2); v += __shfl_xor(v, 4); v += __shfl_xor(v, 8); v += __shfl_xor(v, 16);
    ss[i] = rsqrtf(v * (1.f / 256.f) + EPS);
  }
  for (int hd = 0; hd < 4; ++hd) {
#pragma unroll
    for (int pb = 0; pb < 2; ++pb) {
      const int pch = (g * 4 + hd) * 64 + pb * 32 + lr;
      const float nw = p.m_norm_w[l * 1024 + pch];
#pragma unroll
      for (int i = 0; i < 16; ++i) {
        const size_t idx = (size_t)(tok0 + 32 * w + crow(i, lh)) * 1024 + pch;
        p.YM()[idx] = f2bf(bf2f(p.YM()[idx]) * ss[i] * nw);
      }
      __builtin_amdgcn_sched_barrier(0);
    }
  }
}

DI void ssd_sample_job(const P& p, int l, int job, char* smem) {
  const int g = job & 3, b = job >> 2;
  float* sx = (float*)smem;
  float* sBv = sx + 256;
  float* sCv = sBv + 128;
  float* sY = sCv + 128;
  float* sRed = sY + 256;
  const int tid = tidx(), lane = tid & 63, w = __builtin_amdgcn_readfirstlane(tid >> 6);
  const int row = TP + b;
  __syncthreads();
#pragma unroll
  for (int it = 0; it < 2; ++it) {
    const int idx = tid + 256 * it;
    const int ch = idx < 256 ? g * 256 + idx : (idx < 384 ? 1024 + g * 128 + (idx - 256) : 1536 + g * 128 + (idx - 384));
    const float* sc = p.state_conv + ((size_t)(l * 128 + b) * 3) * 2048 + ch;
    const float s0 = sc[0], s1 = sc[2048], s2 = sc[4096];
    const float raw = bf2f(p.XBC()[(size_t)row * 2048 + ch]);
    const float* cw = p.conv_w + (size_t)l * 4 * 2048 + ch;
    float v = p.conv_b[l * 2048 + ch] + cw[0] * s0 + cw[2048] * s1 + cw[4096] * s2 + cw[6144] * raw;
    v = silu_f(v);
    sx[idx] = v;
    float* co = p.out + OFF_CONVS + ((size_t)(l * 128 + b) * 3) * 2048 + ch;
    co[0] = s1; co[2048] = s2;
  }
  __syncthreads();
  for (int hd = 0; hd < 4; ++hd) {
    const int head = g * 4 + hd;
    const float dt = p.DT()[(size_t)row * 16 + head];
    const float Ah = -expf(p.a_log[l * 16 + head]);
    const float dA = __expf(dt * Ah);
    const int pp = tid >> 2, nq = (tid & 3) * 32;
    const float xv = sx[hd * 64 + pp];
    const float coef = dt * xv;
    const size_t so = ((((size_t)l * 128 + b) * 16 + head) * 64 + pp) * 128 + nq;
    const float4* h0 = (const float4*)(p.state_ssm + so);
    float4* ho = (float4*)(p.out + OFF_SSMS + so);
    float yacc = 0.f;
#pragma unroll
    for (int q = 0; q < 8; ++q) {
      float4 hv = h0[q];
      const int n = nq + 4 * q;
      hv.x = hv.x * dA + coef * sBv[n]; hv.y = hv.y * dA + coef * sBv[n + 1]; hv.z = hv.z * dA + coef * sBv[n + 2]; hv.w = hv.w * dA + coef * sBv[n + 3];
      yacc += hv.x * sCv[n] + hv.y * sCv[n + 1] + hv.z * sCv[n + 2] + hv.w * sCv[n + 3];
      ho[q] = hv;
    }
    yacc += __shfl_xor(yacc, 1); yacc += __shfl_xor(yacc, 2);
    const float y = yacc + p.m_d[l * 16 + head] * xv;
    const float z = bf2f(p.Z()[(size_t)row * 1024 + head * 64 + pp]);
    if ((tid & 3) == 0) sY[hd * 64 + pp] = y * silu_f(z);
  }
  __syncthreads();
  const float v = sY[tid];
  const float ssq = wave_sum(v * v);
  if (lane == 0) sRed[w] = ssq;
  __syncthreads();
  const float tot = sRed[0] + sRed[1] + sRed[2] + sRed[3];
  const float sc = rsqrtf(tot * (1.f / 256.f) + EPS);
  p.YM()[(size_t)row * 1024 + g * 256 + tid] = f2bf(v * sc * p.m_norm_w[l * 1024 + g * 256 + tid]);
}

DI void s5_wave_job(const P& p, int l, int mode, int b, int g, int c, bf16_t* sH) {
  const int lane = tidx() & 63;
  const float* prm = p.S5P() + ((size_t)(l * 64 + g) * 36) * 64 + lane;
  const float abr = prm[0], abi = prm[64];
  float bbr[16], bbi[16];
#pragma unroll
  for (int i = 0; i < 16; ++i) { bbr[i] = prm[(4 + i) * 64]; bbi[i] = prm[(20 + i) * 64]; }
  float hr = 0.f, hi = 0.f;
  int row0, Q;
  if (mode == 2) {
    row0 = TP + b; Q = 1;
    hr = p.s5_sre[((size_t)(l * 128 + b) * 64 + g) * 64 + lane];
    hi = p.s5_sim[((size_t)(l * 128 + b) * 64 + g) * 64 + lane];
  } else {
    row0 = b * SEQ + c * 64; Q = 64;
    if (mode == 1) {
      const float2 s = *(const float2*)(p.S5S() + (((size_t)(b * 128 + c) * 64 + g) * 64 + lane) * 2);
      hr = s.x; hi = s.y;
    }
  }
  unsigned uw[8];
  {
    uint4 u0 = make_uint4(0u, 0u, 0u, 0u), u1 = u0;
    if (lane < Q) { const uint4* up = (const uint4*)(p.U() + (size_t)(row0 + lane) * 1024 + g * 16); u0 = up[0]; u1 = up[1]; }
    uw[0] = u0.x; uw[1] = u0.y; uw[2] = u0.z; uw[3] = u0.w; uw[4] = u1.x; uw[5] = u1.y; uw[6] = u1.z; uw[7] = u1.w;
  }
  for (int t = 0; t < Q; ++t) {
    float br_ = 0.f, bi_ = 0.f;
#pragma unroll
    for (int k = 0; k < 8; ++k) {
      const unsigned wv = (unsigned)__builtin_amdgcn_readlane((int)uw[k], t);
      const float ua = bflo(wv), ub = bfhi(wv);
      br_ += bbr[2 * k] * ua + bbr[2 * k + 1] * ub;
      bi_ += bbi[2 * k] * ua + bbi[2 * k + 1] * ub;
    }
    const float nr = abr * hr - abi * hi + br_, ni = abr * hi + abi * hr + bi_;
    hr = nr; hi = ni;
    if (mode != 0) { sH[t * 136 + lane] = f2bf(hr); sH[t * 136 + 64 + lane] = f2bf(hi); }
  }
  if (mode == 0) {
    *(float2*)(p.S5S() + (((size_t)(b * 128 + c) * 64 + g) * 64 + lane) * 2) = make_float2(hr, hi);
    return;
  }
  if (mode == 1 && c == 127) {
    p.out[OFF_S5RP + ((size_t)(l * 2 + b) * 64 + g) * 64 + lane] = hr;
    p.out[OFF_S5IP + ((size_t)(l * 2 + b) * 64 + g) * 64 + lane] = hi;
  }
  if (mode == 2) {
    p.out[OFF_S5RS + ((size_t)(l * 128 + b) * 64 + g) * 64 + lane] = hr;
    p.out[OFF_S5IS + ((size_t)(l * 128 + b) * 64 + g) * 64 + lane] = hi;
  }
  const int o = lane & 15, quad = lane >> 4;
  bf16x8 cf[4];
#pragma unroll
  for (int kk = 0; kk < 4; ++kk) {
    const float* cp = ((kk < 2) ? p.c_re : p.c_im) + ((size_t)(l * 64 + g) * 16 + o) * 64 + (kk & 1) * 32 + quad * 8;
    const float4 c0 = ((const float4*)cp)[0], c1 = ((const float4*)cp)[1];
    const float sg = (kk < 2) ? 1.f : -1.f;
    cf[kk] = u4_to_bf8(make_uint4(pack2(sg * c0.x, sg * c0.y), pack2(sg * c0.z, sg * c0.w), pack2(sg * c1.x, sg * c1.y), pack2(sg * c1.z, sg * c1.w)));
  }
  const float dsk = p.s5_d[l * 1024 + g * 16 + o];
  const int nrb = (mode == 2) ? 1 : 4;
  __builtin_amdgcn_fence(__ATOMIC_RELEASE, "wavefront");
  __builtin_amdgcn_wave_barrier();
  __builtin_amdgcn_fence(__ATOMIC_ACQUIRE, "wavefront");
  for (int rb = 0; rb < nrb; ++rb) {
    f32x4 a4 = {0.f, 0.f, 0.f, 0.f};
#pragma unroll
    for (int kk = 0; kk < 4; ++kk) {
      const bf16x8 af = *(const bf16x8*)(sH + (rb * 16 + o) * 136 + kk * 32 + quad * 8);
      a4 = MFMA16(af, cf[kk], a4);
    }
#pragma unroll
    for (int jj = 0; jj < 4; ++jj) {
      const int t = rb * 16 + quad * 4 + jj;
      if (t < Q) {
        const size_t idx = (size_t)(row0 + t) * 1024 + g * 16 + o;
        const float y = a4[jj] + dsk * bf2f(p.U()[idx]);
        p.YS()[idx] = f2bf(gelu_tanh(y));
      }
    }
  }
}

DI void attn_prompt_job(const P& p, int l, int job, char* smem) {
  const int head = job & 15, blk = (job >> 4) & 63, b = job >> 10, kvh = head >> 2;
  bf16_t* sK = (bf16_t*)smem;
  bf16_t* sVt = sK + 256 * 72;
  const int tid = tidx(), lane = tid & 63, w = __builtin_amdgcn_readfirstlane(tid >> 6), lr = lane & 31, lh = lane >> 5;
  const int tokc0 = b * SEQ + blk * 128 - 128;
  __syncthreads();
#pragma unroll
  for (int it = 0; it < 8; ++it) {
    const int item = tid + 256 * it, row = item >> 3, chk = item & 7;
    uint4 v = make_uint4(0u, 0u, 0u, 0u);
    if (blk > 0 || row >= 128) v = *(const uint4*)(p.K() + (size_t)(tokc0 + row) * 256 + kvh * 64 + chk * 8);
    *(uint4*)(sK + row * 72 + chk * 8) = v;
  }
#pragma unroll
  for (int it = 0; it < 8; ++it) {
    const int item = tid + 256 * it, d = item >> 5, chk = item & 31;
    uint4 v = make_uint4(0u, 0u, 0u, 0u);
    if (blk > 0 || chk >= 16) v = *(const uint4*)(p.VT() + (size_t)(kvh * 64 + d) * T + tokc0 + chk * 8);
    *(uint4*)(sVt + d * 264 + chk * 8) = v;
  }
  __syncthreads();
  const int qtok = b * SEQ + blk * 128 + 32 * w + lr;
  bf16x8 qf[4];
#pragma unroll
  for (int kk = 0; kk < 4; ++kk) qf[kk] = *(const bf16x8*)(p.Q() + (size_t)qtok * 1024 + head * 64 + kk * 16 + lh * 8);
  f32x16 st[5];
#pragma unroll
  for (int x = 0; x < 5; ++x) {
    zero16(st[x]);
#pragma unroll
    for (int kk = 0; kk < 4; ++kk) {
      const bf16x8 af = *(const bf16x8*)(sK + (32 * (w + x) + lr) * 72 + kk * 16 + lh * 8);
      st[x] = MFMA32(af, qf[kk], st[x]);
    }
  }
  const float sink = p.sinks[l * 16 + head];
  const int qi = 128 + 32 * w + lr;
  float m = sink;
#pragma unroll
  for (int x = 0; x < 5; ++x)
#pragma unroll
    for (int i = 0; i < 16; ++i) {
      const int kj = 32 * (w + x) + crow(i, lh);
      const bool valid = (kj <= qi) && (kj >= qi - 128) && (blk > 0 || kj >= 128);
      const float s = valid ? st[x][i] * 0.125f : -1e30f;
      st[x][i] = s;
      m = fmaxf(m, s);
    }
  m = fmaxf(m, __shfl_xor(m, 32));
  float sum = 0.f;
#pragma unroll
  for (int x = 0; x < 5; ++x)
#pragma unroll
    for (int i = 0; i < 16; ++i) { const float pv = __expf(st[x][i] - m); st[x][i] = pv; sum += pv; }
  sum += __shfl_xor(sum, 32);
  const float inv = 1.f / (sum + __expf(sink - m));
  f32x16 ot[2];
  zero16(ot[0]); zero16(ot[1]);
#pragma unroll
  for (int x = 0; x < 5; ++x)
#pragma unroll
    for (int s = 0; s < 2; ++s) {
      const uint4 pu = make_uint4(pack2(st[x][8 * s] * inv, st[x][8 * s + 1] * inv), pack2(st[x][8 * s + 2] * inv, st[x][8 * s + 3] * inv),
                                  pack2(st[x][8 * s + 4] * inv, st[x][8 * s + 5] * inv), pack2(st[x][8 * s + 6] * inv, st[x][8 * s + 7] * inv));
      const bf16x8 pf = u4_to_bf8(pu);
#pragma unroll
      for (int pb = 0; pb < 2; ++pb) {
        const bf16_t* vp = sVt + (pb * 32 + lr) * 264 + 32 * (w + x) + 16 * s + 4 * lh;
        const uint2 lo = *(const uint2*)vp, hi2 = *(const uint2*)(vp + 8);
        ot[pb] = MFMA32(u4_to_bf8(make_uint4(lo.x, lo.y, hi2.x, hi2.y)), pf, ot[pb]);
      }
    }
#pragma unroll
  for (int pb = 0; pb < 2; ++pb)
#pragma unroll
    for (int ig = 0; ig < 4; ++ig) {
      const int d0 = pb * 32 + 8 * ig + 4 * lh;
      *(uint2*)(p.O() + (size_t)qtok * 1024 + head * 64 + d0) = make_uint2(pack2(ot[pb][4 * ig], ot[pb][4 * ig + 1]), pack2(ot[pb][4 * ig + 2], ot[pb][4 * ig + 3]));
    }
}

DI void attn_sample_job(const P& p, int l, int job, char* smem) {
  const int kvh = job & 3, b = job >> 2;
  const int tid = tidx(), lane = tid & 63, w = __builtin_amdgcn_readfirstlane(tid >> 6);
  const int head = kvh * 4 + w, row = TP + b;
  float* sP = (float*)smem + w * 192;
  __syncthreads();
  const float qd = bf2f(p.Q()[(size_t)row * 1024 + head * 64 + lane]);
  const size_t cbase = ((size_t)(l * 128 + b) * 128) * 256 + kvh * 64 + lane;
  const float* kc = p.cache_k + cbase;
  const float* vc = p.cache_v + cbase;
  float* ko = p.out + OFF_KS + cbase;
  float* vo = p.out + OFF_VS + cbase;
  for (int j = 0; j < 128; ++j) {
    const float kv = kc[(size_t)j * 256];
    if (w == 0 && j >= 1) ko[(size_t)(j - 1) * 256] = kv;
    const float s = wave_sum(qd * kv) * 0.125f;
    if (lane == 0) sP[j] = s;
  }
  {
    const float kv = bf2f(p.K()[(size_t)row * 256 + kvh * 64 + lane]);
    const float s = wave_sum(qd * kv) * 0.125f;
    if (lane == 0) sP[128] = s;
  }
  __syncthreads();
  const float sink = p.sinks[l * 16 + head];
  const float s0 = sP[lane], s1 = sP[lane + 64], s2 = sP[128];
  float m = fmaxf(fmaxf(s0, s1), fmaxf(s2, sink));
  m = wave_max(m);
  const float p0 = __expf(s0 - m), p1 = __expf(s1 - m), p2 = __expf(s2 - m);
  float sum = wave_sum(p0 + p1);
  const float inv = 1.f / (sum + p2 + __expf(sink - m));
  __syncthreads();
  sP[lane] = p0 * inv; sP[lane + 64] = p1 * inv;
  if (lane == 0) sP[128] = p2 * inv;
  __syncthreads();
  float o = 0.f;
  for (int j = 0; j < 128; ++j) {
    const float vv = vc[(size_t)j * 256];
    if (w == 0 && j >= 1) vo[(size_t)(j - 1) * 256] = vv;
    o += sP[j] * vv;
  }
  o += sP[128] * bf2f(p.VT()[(size_t)(kvh * 64 + lane) * T + row]);
  p.O()[(size_t)row * 1024 + head * 64 + lane] = f2bf(o);
}

template <int PASS>
DI void merge_pass(const P& p, const bf16_t* A, const bf16_t* Wt, int m0, int n0, char* smem) {
  m0 = launder_s(m0); n0 = launder_s(n0);
  const int tid = tidx(), lane = tid & 63, w = __builtin_amdgcn_readfirstlane(tid >> 6), wm = w & 1, wn = w >> 1, lr = lane & 31, lh = lane >> 5;
  f32x16 acc[2][2];
#pragma unroll
  for (int a = 0; a < 2; ++a)
#pragma unroll
    for (int b = 0; b < 2; ++b) zero16(acc[a][b]);
  gemm_mainloop(A + (size_t)m0 * 1024, 1024, Wt + (size_t)n0 * 1024, 1024, 1024, acc, smem);
  m0 = launder_s(m0); n0 = launder_s(n0);
#pragma unroll
  for (int mi = 0; mi < 2; ++mi)
#pragma unroll
    for (int ni = 0; ni < 2; ++ni) {
      const int c = n0 + wn * 64 + ni * 32 + lr;
#pragma unroll
      for (int i = 0; i < 16; ++i) {
        const int r = m0 + wm * 64 + mi * 32 + crow(i, lh);
        bf16_t* mp = p.MG() + (size_t)r * 1024 + c;
        const float a = acc[mi][ni][i];
        if (PASS == 0) *mp = f2bf(sigm_f(a) * bf2f(p.G()[(size_t)r * 3072 + 1024 + c]));
        else if (PASS == 1) *mp = f2bf(bf2f(*mp) * a);
        else if (PASS == 2) *mp = f2bf(bf2f(*mp) + a * bf2f(p.G()[(size_t)r * 3072 + c]));
        else *mp = f2bf(bf2f(*mp) + a * bf2f(p.G()[(size_t)r * 3072 + 2048 + c]));
      }
    }
}
DI void merge_job(const P& p, int l, int job, char* smem) {
  int mt, nt;
  if (!gemm_tile(job, 129, 8, mt, nt)) return;
  const int m0 = mt * 128, n0 = nt * 128;
  const bf16_t* wl = p.Wt() + (size_t)l * W_LAYER;
  merge_pass<0>(p, p.YS(), wl + WO_GLU + (size_t)1024 * 1024, m0, n0, smem);
  merge_pass<1>(p, p.YS(), wl + WO_GLU, m0, n0, smem);
  merge_pass<2>(p, p.YM(), wl + WO_MPROJ, m0, n0, smem);
  merge_pass<3>(p, p.O(), wl + WO_ATTNO, m0, n0, smem);
}
DI void resid_gemm_job(const P& p, const bf16_t* A, int lda, const bf16_t* Wt, int K, int job, char* smem) {
  int mt, nt;
  if (!gemm_tile(job, 129, 8, mt, nt)) return;
  const int m0 = mt * 128, n0 = nt * 128;
  const int tid = tidx(), lane = tid & 63, w = __builtin_amdgcn_readfirstlane(tid >> 6), wm = w & 1, wn = w >> 1, lr = lane & 31, lh = lane >> 5;
  f32x16 acc[2][2];
#pragma unroll
  for (int a = 0; a < 2; ++a)
#pragma unroll
    for (int b = 0; b < 2; ++b) zero16(acc[a][b]);
  gemm_mainloop(A + (size_t)m0 * lda, lda, Wt + (size_t)n0 * K, K, K, acc, smem);
#pragma unroll
  for (int mi = 0; mi < 2; ++mi)
#pragma unroll
    for (int ni = 0; ni < 2; ++ni) {
      const int c = n0 + wn * 64 + ni * 32 + lr;
#pragma unroll
      for (int i = 0; i < 16; ++i) {
        const int r = m0 + wm * 64 + mi * 32 + crow(i, lh);
        p.X()[(size_t)r * 1024 + c] += acc[mi][ni][i];
      }
    }
}
DI void up_job(const P& p, int l, int job, char* smem) {
  int mt, nt;
  if (!gemm_tile(job, 129, 32, mt, nt)) return;
  const int m0 = mt * 128, n0 = nt * 128;
  const int tid = tidx(), lane = tid & 63, w = __builtin_amdgcn_readfirstlane(tid >> 6), wm = w & 1, wn = w >> 1, lr = lane & 31, lh = lane >> 5;
  f32x16 acc[2][2];
#pragma unroll
  for (int a = 0; a < 2; ++a)
#pragma unroll
    for (int b = 0; b < 2; ++b) zero16(acc[a][b]);
  gemm_mainloop(p.H() + (size_t)m0 * 1024, 1024, p.Wt() + (size_t)l * W_LAYER + WO_UP + (size_t)n0 * 1024, 1024, 1024, acc, smem);
#pragma unroll
  for (int mi = 0; mi < 2; ++mi)
#pragma unroll
    for (int ni = 0; ni < 2; ++ni) {
      const int c = n0 + wn * 64 + ni * 32 + lr;
#pragma unroll
      for (int i = 0; i < 16; ++i) {
        const int r = m0 + wm * 64 + mi * 32 + crow(i, lh);
        const float v = fmaxf(acc[mi][ni][i], 0.f);
        p.A2()[(size_t)r * 4096 + c] = f2bf(v * v);
      }
    }
}

constexpr int NPHASE = 1 + 4 * 11;
DI int phase_jobs(int ph) {
  if (ph == 0) return 22144 + 64 + 257 + 4128;
  const int s = (ph - 1) % 11;
  switch (s) {
    case 0: return 129 * 69;
    case 1: return 2048 + 4096 + 4096 + 512 + 2048 + 512;
    case 2: return 2048;
    case 3: return 256 + 32;
    case 4: return 512 + 4096;
    case 5: return 1032;
    case 6: return 1032;
    case 7: return 4128;
    case 8: return 4128;
    case 9: return 1032;
    default: return 4128;
  }
}
DI void run_job(const P& p, int ph, int job, char* smem) {
  if (ph == 0) {
    if (job < 22144) { prep_weight_job(p, job, smem); return; }
    job -= 22144;
    if (job < 64) { prep_s5_job(p, job); return; }
    job -= 64;
    if (job < 257) { prep_rope_job(p, job); return; }
    job -= 257;
    norm_job(p, job, p.norm1_w, true, false);
    return;
  }
  const int l = (ph - 1) / 11, s = (ph - 1) % 11;
  const bf16_t* wl = p.Wt() + (size_t)l * W_LAYER;
  const int w = __builtin_amdgcn_readfirstlane(tidx() >> 6);
  switch (s) {
    case 0: inproj_job(p, l, job, smem); break;
    case 1:
      if (job < 2048) { attn_prompt_job(p, l, job, smem); break; }
      job -= 2048;
      if (job < 4096) { conv_job(p, l, job, smem); break; }
      job -= 4096;
      if (job < 4096) { const int wj = job * 4 + w; s5_wave_job(p, l, 0, wj >> 13, wj & 63, (wj >> 6) & 127, nullptr); break; }
      job -= 4096;
      if (job < 512) { ssd_sample_job(p, l, job, smem); break; }
      job -= 512;
      if (job < 2048) { const int wj = job * 4 + w; __syncthreads(); s5_wave_job(p, l, 2, wj >> 6, wj & 63, 0, (bf16_t*)smem + w * 64 * 136); break; }
      job -= 2048;
      attn_sample_job(p, l, job, smem);
      break;
    case 2: ssd_a_job(p, l, job, smem); break;
    case 3:
      if (job < 256) ssd_scan_job(p, l, job);
      else s5_scan_job(p, l, job - 256);
      break;
    case 4:
      if (job < 512) { ssd_c_job(p, l, job, smem); break; }
      job -= 512;
      { const int wj = job * 4 + w; __syncthreads(); s5_wave_job(p, l, 1, wj >> 13, wj & 63, (wj >> 6) & 127, (bf16_t*)smem + w * 64 * 136); }
      break;
    case 5: merge_job(p, l, job, smem); break;
    case 6: resid_gemm_job(p, p.MG(), 1024, wl + WO_WOUT, 1024, job, smem); break;
    case 7: norm_job(p, job, p.norm2_w + l * 1024, false, false); break;
    case 8: up_job(p, l, job, smem); break;
    case 9: resid_gemm_job(p, p.A2(), 4096, wl + WO_DOWN, 4096, job, smem); break;
    default:
      if (l == 3) norm_job(p, job, p.final_w, false, true);
      else norm_job(p, job, p.norm1_w + (l + 1) * 1024, false, false);
      break;
  }
}

template <bool COOP>
__global__ void __launch_bounds__(256, 2) mega(P p, int ph0, int ph1) {
  __shared__ __attribute__((aligned(16))) char smem[SMEM_BYTES];
  for (int ph = ph0; ph < ph1; ++ph) {
    const int nj = phase_jobs(ph);
    int reps = 1;
#ifdef PROBE_DUP
    { const int s_ = (ph == 0) ? -1 : (ph - 1) % 11;
      if (PROBE_DUP == 1 && (s_ == 0 || s_ == 5 || s_ == 8)) reps = 2;
      if (PROBE_DUP == 2 && (s_ == 1 || s_ == 2 || s_ == 4)) reps = 2;
      if (PROBE_DUP == 3 && (s_ == -1 || s_ == 7 || s_ == 10)) reps = 2; }
#endif
    const int s_ph = (ph == 0) ? -1 : (ph - 1) % 11;
    const bool is_gemm = (s_ph == 0 || s_ph == 5 || s_ph == 6 || s_ph == 8 || s_ph == 9);
    const int njr = is_gemm ? ((nj + (int)gridDim.x - 1) / (int)gridDim.x) * (int)gridDim.x : nj;
    for (int rep = 0; rep < reps; ++rep)
      for (int job = blockIdx.x; job < njr; job += gridDim.x) run_job(p, ph, job, smem);
    if (COOP && ph + 1 < ph1) cg::this_grid().sync();
  }
}


extern "C" void kernel_launch(void* const* d_in, const int* in_sizes, int n_in, void* d_out, int out_size, void* d_ws, size_t ws_size,
                              hipStream_t stream) {
  P p{};
  const float** pin = (const float**)&p;
  for (int i = 0; i < 33; ++i) pin[i] = (const float*)d_in[i];
  p.out = (float*)d_out;
  p.ws = (char*)d_ws;
  if (WS_TOTAL > ws_size) { fprintf(stderr, "workspace too small: need %zu have %zu\n", (size_t)WS_TOTAL, ws_size); return; }

#if COOP_MODE
  static int grid_blocks = 0;
  if (!grid_blocks) {
    int dev = 0, cus = 0, per_cu = 0;
    hipGetDevice(&dev);
    hipDeviceGetAttribute(&cus, hipDeviceAttributeMultiprocessorCount, dev);
    hipOccupancyMaxActiveBlocksPerMultiprocessor(&per_cu, mega<true>, 256, 0);
    if (per_cu > 2) per_cu = 2;
    if (per_cu < 1) per_cu = 1;
    grid_blocks = cus * per_cu;
  }
  int ph0 = 0, ph1 = NPHASE;
  void* args[] = {&p, &ph0, &ph1};
  hipError_t e = hipLaunchCooperativeKernel((void*)mega<true>, dim3(grid_blocks), dim3(256), args, 0, stream);
  if (e != hipSuccess) fprintf(stderr, "cooperative launch failed: %s (grid %d)\n", hipGetErrorString(e), grid_blocks);
#else
  for (int ph = 0; ph < NPHASE; ++ph) mega<false><<<dim3(1024), dim3(256), 0, stream>>>(p, ph, ph + 1);
#endif
}
```

```cpp
#include <hip/hip_runtime.h>
#include <hip/hip_cooperative_groups.h>
#include <cstdio>
#include <cstdint>
namespace cg = cooperative_groups;

#define DI __device__ __forceinline__
typedef unsigned short bf16_t;
typedef short bf16x8 __attribute__((ext_vector_type(8)));
typedef float f32x16 __attribute__((ext_vector_type(16)));
typedef float f32x4 __attribute__((ext_vector_type(4)));
#define MFMA32(a, b, c) __builtin_amdgcn_mfma_f32_32x32x16_bf16((a), (b), (c), 0, 0, 0)
#define MFMA16(a, b, c) __builtin_amdgcn_mfma_f32_16x16x32_bf16((a), (b), (c), 0, 0, 0)

#ifndef COOP_MODE
#define COOP_MODE 1
#endif

constexpr int TP = 16384, TS = 128, T = TP + TS, SEQ = 8192;
constexpr int NIN = 8720, NINP = 8832;
constexpr int SMEM_BYTES = 73728;
constexpr float EPS = 1e-6f;

constexpr size_t OFF_YP = 0;
constexpr size_t OFF_YS = OFF_YP + (size_t)TP * 1024;
constexpr size_t OFF_SSMP = OFF_YS + (size_t)TS * 1024;
constexpr size_t OFF_SSMS = OFF_SSMP + (size_t)4 * 2 * 16 * 64 * 128;
constexpr size_t OFF_CONVP = OFF_SSMS + (size_t)4 * 128 * 16 * 64 * 128;
constexpr size_t OFF_CONVS = OFF_CONVP + (size_t)4 * 2 * 3 * 2048;
constexpr size_t OFF_S5RP = OFF_CONVS + (size_t)4 * 128 * 3 * 2048;
constexpr size_t OFF_S5RS = OFF_S5RP + (size_t)4 * 2 * 64 * 64;
constexpr size_t OFF_S5IP = OFF_S5RS + (size_t)4 * 128 * 64 * 64;
constexpr size_t OFF_S5IS = OFF_S5IP + (size_t)4 * 2 * 64 * 64;
constexpr size_t OFF_KP = OFF_S5IS + (size_t)4 * 128 * 64 * 64;
constexpr size_t OFF_KS = OFF_KP + (size_t)4 * 2 * 128 * 256;
constexpr size_t OFF_VP = OFF_KS + (size_t)4 * 128 * 128 * 256;
constexpr size_t OFF_VS = OFF_VP + (size_t)4 * 2 * 128 * 256;

constexpr size_t WO_IN = 0;
constexpr size_t WO_MPROJ = WO_IN + (size_t)NINP * 1024;
constexpr size_t WO_GLU = WO_MPROJ + (size_t)1024 * 1024;
constexpr size_t WO_ATTNO = WO_GLU + (size_t)2048 * 1024;
constexpr size_t WO_WOUT = WO_ATTNO + (size_t)1024 * 1024;
constexpr size_t WO_UP = WO_WOUT + (size_t)1024 * 1024;
constexpr size_t WO_DOWN = WO_UP + (size_t)4096 * 1024;
constexpr size_t W_LAYER = WO_DOWN + (size_t)4096 * 1024;

constexpr size_t al256(size_t x) { return (x + 255) & ~(size_t)255; }
constexpr size_t SZ1 = (size_t)T * 1024 * 2;
constexpr size_t WS_X = 0;
constexpr size_t WS_H = WS_X + al256((size_t)T * 1024 * 4);
constexpr size_t WS_Z = WS_H + al256(SZ1);
constexpr size_t WS_U = WS_Z + al256(SZ1);
constexpr size_t WS_Q = WS_U + al256(SZ1);
constexpr size_t WS_YM = WS_Q + al256(SZ1);
constexpr size_t WS_YS = WS_YM + al256(SZ1);
constexpr size_t WS_O = WS_YS + al256(SZ1);
constexpr size_t WS_MG = WS_O + al256(SZ1);
constexpr size_t WS_XBC = WS_MG + al256(SZ1);
constexpr size_t WS_XBT = WS_XBC + al256((size_t)T * 2048 * 2);
constexpr size_t WS_BC = WS_XBT + al256((size_t)1536 * TP * 2);
constexpr size_t WS_A2END = WS_XBC + al256((size_t)T * 4096 * 2);
constexpr size_t WS_BCEND = WS_BC + al256((size_t)TP * 1024 * 2);
constexpr size_t WS_K = WS_A2END > WS_BCEND ? WS_A2END : WS_BCEND;
constexpr size_t WS_VT = WS_K + al256((size_t)T * 256 * 2);
constexpr size_t WS_G = WS_VT + al256((size_t)T * 256 * 2);
constexpr size_t WS_DT = WS_G + al256((size_t)T * 3072 * 2);
constexpr size_t WS_ST = WS_DT + al256((size_t)T * 16 * 4);
constexpr size_t WS_CDEC = WS_ST + al256((size_t)2 * 64 * 16 * 64 * 128 * 4);
constexpr size_t WS_S5S = WS_CDEC + al256((size_t)2 * 64 * 16 * 4);
constexpr size_t WS_S5P = WS_S5S + al256((size_t)2 * 128 * 64 * 64 * 2 * 4);
constexpr size_t WS_ROPE = WS_S5P + al256((size_t)4 * 64 * 36 * 64 * 4);
constexpr size_t WS_WT = WS_ROPE + al256((size_t)8193 * 8 * 8);
constexpr size_t WS_BAR = WS_WT + al256((size_t)4 * W_LAYER * 2);
constexpr size_t WS_TOTAL = WS_BAR + al256(4096 * 4);

struct P {
  const float *x_prompt, *x_sample, *state_ssm, *state_conv, *s5_sre, *s5_sim, *cache_k, *cache_v;
  const float *norm1_w, *w_in, *conv_w, *conv_b, *dt_bias, *a_log, *m_d, *m_norm_w, *m_proj;
  const float *lam_re, *lam_im, *log_step, *b_re, *b_im, *c_re, *c_im, *s5_d, *glu_w;
  const float *sinks, *attn_o, *w_out, *norm2_w, *mlp_up, *mlp_down, *final_w;
  float* out;
  char* ws;
#define WSACC(name, type, off) __device__ __forceinline__ type* name() const { return (type*)(ws + (off)); }
  WSACC(X, float, WS_X) WSACC(H, bf16_t, WS_H) WSACC(Z, bf16_t, WS_Z) WSACC(U, bf16_t, WS_U) WSACC(Q, bf16_t, WS_Q)
  WSACC(YM, bf16_t, WS_YM) WSACC(YS, bf16_t, WS_YS) WSACC(O, bf16_t, WS_O) WSACC(MG, bf16_t, WS_MG)
  WSACC(XBC, bf16_t, WS_XBC) WSACC(XBT, bf16_t, WS_XBT) WSACC(BC, bf16_t, WS_BC) WSACC(A2, bf16_t, WS_XBC)
  WSACC(K, bf16_t, WS_K) WSACC(VT, bf16_t, WS_VT) WSACC(G, bf16_t, WS_G) WSACC(DT, float, WS_DT) WSACC(ST, float, WS_ST)
  WSACC(CDEC, float, WS_CDEC) WSACC(S5S, float, WS_S5S) WSACC(S5P, float, WS_S5P) WSACC(ROPE, float2, WS_ROPE) WSACC(Wt, bf16_t, WS_WT)
#undef WSACC
};

DI bf16_t f2bf(float x) { unsigned u = __float_as_uint(x); u += 0x7fffu + ((u >> 16) & 1u); return (bf16_t)(u >> 16); }
DI float bf2f(bf16_t b) { return __uint_as_float(((unsigned)b) << 16); }
DI unsigned pack2(float a, float b) { return (unsigned)f2bf(a) | ((unsigned)f2bf(b) << 16); }
DI float bflo(unsigned u) { return __uint_as_float(u << 16); }
DI float bfhi(unsigned u) { return __uint_as_float(u & 0xffff0000u); }
DI float silu_f(float x) { return x / (1.f + __expf(-x)); }
DI float sigm_f(float x) { return 1.f / (1.f + __expf(-x)); }
DI float softplus_f(float x) { return x > 20.f ? x : log1pf(expf(x)); }
DI float gelu_tanh(float x) { float y = 0.7978845608028654f * (x + 0.044715f * x * x * x); float t = 1.f - 2.f / (__expf(2.f * y) + 1.f); return 0.5f * x * (1.f + t); }
DI int crow(int i, int lh) { return (i & 3) + 8 * (i >> 2) + 4 * lh; }
DI int launder(int x) { asm volatile("" : "+v"(x)); return x; }
DI int tidx() { int t = __builtin_amdgcn_workitem_id_x(); asm volatile("" : "+v"(t)); return t; }
DI int launder_s(int x) { asm volatile("" : "+s"(x)); return x; }
DI float wave_sum(float v) {
#pragma unroll
  for (int o = 32; o >= 1; o >>= 1) v += __shfl_xor(v, o);
  return v;
}
DI float wave_max(float v) {
#pragma unroll
  for (int o = 32; o >= 1; o >>= 1) v = fmaxf(v, __shfl_xor(v, o));
  return v;
}
DI bf16x8 u4_to_bf8(uint4 v) { return __builtin_bit_cast(bf16x8, v); }
DI void zero16(f32x16& a) {
#pragma unroll
  for (int i = 0; i < 16; ++i) a[i] = 0.f;
}

constexpr int LDT = 72;
DI void gemm_mainloop(const bf16_t* __restrict__ A, int lda, const bf16_t* __restrict__ B, int ldb, int K,
                      f32x16 (&acc)[2][2], char* smem) {
  bf16_t* sa = (bf16_t*)smem;
  bf16_t* sb = sa + 2 * 128 * LDT;
  const int tid = tidx(), lane = tid & 63, w = __builtin_amdgcn_readfirstlane(tid >> 6), wm = w & 1, wn = w >> 1, lr = lane & 31, lh = lane >> 5;
  const int r0 = tid >> 3, ch = (tid & 7) * 8;
  const bf16_t* ap = A + (size_t)r0 * lda + ch;
  const bf16_t* bp = B + (size_t)r0 * ldb + ch;
  uint4 pa0, pa1, pa2, pa3, pb0, pb1, pb2, pb3;
  uint4 qa0, qa1, qa2, qa3, qb0, qb1, qb2, qb3;
#define GLOADS(R, k0)                                                                                      \
  R##a0 = *(const uint4*)(ap + (k0)); R##a1 = *(const uint4*)(ap + (size_t)32 * lda + (k0));               \
  R##a2 = *(const uint4*)(ap + (size_t)64 * lda + (k0)); R##a3 = *(const uint4*)(ap + (size_t)96 * lda + (k0)); \
  R##b0 = *(const uint4*)(bp + (k0)); R##b1 = *(const uint4*)(bp + (size_t)32 * ldb + (k0));               \
  R##b2 = *(const uint4*)(bp + (size_t)64 * ldb + (k0)); R##b3 = *(const uint4*)(bp + (size_t)96 * ldb + (k0));
#define SSTORES(R, bufi)                                                                                   \
  { bf16_t* da = sa + (bufi)*128 * LDT; bf16_t* db = sb + (bufi)*128 * LDT;                                \
    *(uint4*)(da + (r0)*LDT + ch) = R##a0; *(uint4*)(da + (r0 + 32) * LDT + ch) = R##a1;                   \
    *(uint4*)(da + (r0 + 64) * LDT + ch) = R##a2; *(uint4*)(da + (r0 + 96) * LDT + ch) = R##a3;            \
    *(uint4*)(db + (r0)*LDT + ch) = R##b0; *(uint4*)(db + (r0 + 32) * LDT + ch) = R##b1;                   \
    *(uint4*)(db + (r0 + 64) * LDT + ch) = R##b2; *(uint4*)(db + (r0 + 96) * LDT + ch) = R##b3; }
#define COMPUTE(bufi)                                                                                      \
  { const bf16_t* ca = sa + (bufi)*128 * LDT + (wm * 64 + lr) * LDT + lh * 8;                              \
    const bf16_t* cb = sb + (bufi)*128 * LDT + (wn * 64 + lr) * LDT + lh * 8;                              \
    _Pragma("unroll") for (int kk = 0; kk < 4; ++kk) {                                                     \
      const bf16x8 af0 = *(const bf16x8*)(ca + kk * 16), af1 = *(const bf16x8*)(ca + 32 * LDT + kk * 16);  \
      const bf16x8 bf0 = *(const bf16x8*)(cb + kk * 16), bf1 = *(const bf16x8*)(cb + 32 * LDT + kk * 16);  \
      acc[0][0] = MFMA32(af0, bf0, acc[0][0]); acc[0][1] = MFMA32(af0, bf1, acc[0][1]);                    \
      acc[1][0] = MFMA32(af1, bf0, acc[1][0]); acc[1][1] = MFMA32(af1, bf1, acc[1][1]); } }
  const int nk = K >> 6;
  const int klast = (nk - 1) * 64;
  GLOADS(p, 0)
  __syncthreads();
  SSTORES(p, 0)
  GLOADS(p, 64)
  __syncthreads();
  for (int kt = 0; kt < nk; kt += 2) {
    { const int k2 = (kt + 2) * 64; const int k0 = k2 < klast ? k2 : klast; GLOADS(q, k0) }
    COMPUTE(0)
    SSTORES(p, 1)
    __syncthreads();
    { const int k3 = (kt + 3) * 64; const int k0 = k3 < klast ? k3 : klast; GLOADS(p, k0) }
    COMPUTE(1)
    SSTORES(q, 0)
    __syncthreads();
  }
#undef GLOADS
#undef SSTORES
#undef COMPUTE
}
DI bool gemm_tile(int slot, int MT, int NT, int& mt, int& nt) {
  const int G = gridDim.x, nx = G >> 3;
  int J = slot;
  if ((G & 7) == 0) J = (slot / G) * G + (slot & 7) * nx + ((slot % G) >> 3);
  if (J >= MT * NT) return false;
  const int gw = 8 * NT, grp = J / gw, rem = J - grp * gw, fm = grp * 8;
  const int gsz = (MT - fm) < 8 ? (MT - fm) : 8;
  mt = fm + rem % gsz; nt = rem / gsz;
  return true;
}

DI int win_map(int n) {
  if (n < 3072) return n;
  if (n < 8704) return n + 16;
  if (n < 8720) return n - 8704 + 3072;
  return -1;
}
DI void wtrans_tile(const float* __restrict__ src, int N, int K, bf16_t* __restrict__ dst, int kt, int nt, bool inmap, char* smem) {
  float* s = (float*)smem;
  const int tid = tidx();
  __syncthreads();
  const int nn = tid & 63;
  int sc = nt * 64 + nn;
  if (inmap) sc = win_map(sc);
#pragma unroll
  for (int it = 0; it < 16; ++it) {
    const int kk = it * 4 + (tid >> 6);
    s[kk * 65 + nn] = (sc >= 0) ? src[(size_t)(kt * 64 + kk) * N + sc] : 0.f;
  }
  __syncthreads();
#pragma unroll
  for (int it = 0; it < 16; ++it) {
    const int n2 = it * 4 + (tid >> 6), k2 = tid & 63;
    dst[(size_t)(nt * 64 + n2) * K + kt * 64 + k2] = f2bf(s[k2 * 65 + n2]);
  }
}
DI void prep_weight_job(const P& p, int j, char* smem) {
  const int l = j / 5536; int r = j % 5536;
  bf16_t* wl = p.Wt() + (size_t)l * W_LAYER;
  if (r < 2208) { wtrans_tile(p.w_in + (size_t)l * 1024 * NIN, NIN, 1024, wl + WO_IN, r / 138, r % 138, true, smem); return; }
  r -= 2208;
  if (r < 256) { wtrans_tile(p.m_proj + (size_t)l * 1024 * 1024, 1024, 1024, wl + WO_MPROJ, r / 16, r % 16, false, smem); return; }
  r -= 256;
  if (r < 512) { wtrans_tile(p.glu_w + (size_t)l * 1024 * 2048, 2048, 1024, wl + WO_GLU, r / 32, r % 32, false, smem); return; }
  r -= 512;
  if (r < 256) { wtrans_tile(p.attn_o + (size_t)l * 1024 * 1024, 1024, 1024, wl + WO_ATTNO, r / 16, r % 16, false, smem); return; }
  r -= 256;
  if (r < 256) { wtrans_tile(p.w_out + (size_t)l * 1024 * 1024, 1024, 1024, wl + WO_WOUT, r / 16, r % 16, false, smem); return; }
  r -= 256;
  if (r < 1024) { wtrans_tile(p.mlp_up + (size_t)l * 1024 * 4096, 4096, 1024, wl + WO_UP, r / 64, r % 64, false, smem); return; }
  r -= 1024;
  wtrans_tile(p.mlp_down + (size_t)l * 4096 * 1024, 1024, 4096, wl + WO_DOWN, r / 16, r % 16, false, smem);
}
DI void prep_s5_job(const P& p, int j) {
  const int idx = j * 256 + tidx();
  const int n = idx & 63, g = (idx >> 6) & 63, l = idx >> 12;
  const float step = expf(p.log_step[l * 64 + g]);
  const float lr_ = p.lam_re[(l * 64 + g) * 64 + n], li = p.lam_im[(l * 64 + g) * 64 + n];
  const float mag = expf(lr_ * step);
  const float abr = mag * cosf(li * step), abi = mag * sinf(li * step);
  float aqr = abr, aqi = abi;
#pragma unroll
  for (int q = 0; q < 6; ++q) { const float nr2 = aqr * aqr - aqi * aqi, ni2 = 2.f * aqr * aqi; aqr = nr2; aqi = ni2; }
  const float den = lr_ * lr_ + li * li;
  const float nr = abr - 1.0f, ni = abi;
  const float fre = (nr * lr_ + ni * li) / den, fim = (ni * lr_ - nr * li) / den;
  float* o = p.S5P() + ((size_t)(l * 64 + g) * 36) * 64 + n;
  o[0] = abr; o[64] = abi; o[128] = aqr; o[192] = aqi;
  const float* br = p.b_re + ((size_t)(l * 64 + g) * 64 + n) * 16;
  const float* bi = p.b_im + ((size_t)(l * 64 + g) * 64 + n) * 16;
#pragma unroll
  for (int i = 0; i < 16; ++i) {
    const float b_r = br[i], b_i = bi[i];
    o[(4 + i) * 64] = fre * b_r - fim * b_i;
    o[(20 + i) * 64] = fre * b_i + fim * b_r;
  }
}
DI void prep_rope_job(const P& p, int j) {
  const int idx = j * 256 + tidx();
  if (idx >= 8193 * 8) return;
  const int pos = idx >> 3, f = idx & 7;
  const float invf = expf(-(2.0f * (float)f / 16.0f) * logf(500000.0f));
  const float ang = (float)pos * invf;
  p.ROPE()[idx] = make_float2(cosf(ang), sinf(ang));
}

DI void norm_job(const P& p, int job, const float* wgt, bool layer0, bool final_) {
  const int w = __builtin_amdgcn_readfirstlane(tidx() >> 6), lane = tidx() & 63;
  const int r = job * 4 + w;
  const float* src = layer0 ? (r < TP ? p.x_prompt + (size_t)r * 1024 : p.x_sample + (size_t)(r - TP) * 1024) : p.X() + (size_t)r * 1024;
  float4 v[4];
  float ss = 0.f;
#pragma unroll
  for (int q = 0; q < 4; ++q) { v[q] = ((const float4*)src)[lane + 64 * q]; ss += v[q].x * v[q].x + v[q].y * v[q].y + v[q].z * v[q].z + v[q].w * v[q].w; }
  ss = wave_sum(ss);
  const float sc = rsqrtf(ss * (1.f / 1024.f) + EPS);
#pragma unroll
  for (int q = 0; q < 4; ++q) {
    const float4 wv = ((const float4*)wgt)[lane + 64 * q];
    float4 y = make_float4(v[q].x * sc * wv.x, v[q].y * sc * wv.y, v[q].z * sc * wv.z, v[q].w * sc * wv.w);
    if (final_) ((float4*)(p.out + OFF_YP + (size_t)r * 1024))[lane + 64 * q] = y;
    else *(uint2*)(p.H() + (size_t)r * 1024 + (lane + 64 * q) * 4) = make_uint2(pack2(y.x, y.y), pack2(y.z, y.w));
    if (layer0) ((float4*)(p.X() + (size_t)r * 1024))[lane + 64 * q] = v[q];
  }
}

DI void inproj_job(const P& p, int l, int job, char* smem) {
  int mt, nt;
  if (!gemm_tile(job, 129, 69, mt, nt)) return;
  const int m0 = mt * 128, n0 = nt * 128;
  f32x16 acc[2][2];
#pragma unroll
  for (int a = 0; a < 2; ++a)
#pragma unroll
    for (int b = 0; b < 2; ++b) zero16(acc[a][b]);
  gemm_mainloop(p.H() + (size_t)m0 * 1024, 1024, p.Wt() + (size_t)l * W_LAYER + WO_IN + (size_t)n0 * 1024, 1024, 1024, acc, smem);
  const int tid = tidx(), lane = tid & 63, w = __builtin_amdgcn_readfirstlane(tid >> 6), wm = w & 1, wn = w >> 1, lr = lane & 31, lh = lane >> 5;
#pragma unroll
  for (int ni = 0; ni < 2; ++ni) {
    const int cb = n0 + wn * 64 + ni * 32;
    if (cb >= NIN) continue;
    const int c = cb + lr;
#pragma unroll
    for (int mi = 0; mi < 2; ++mi) {
      const int rbase = m0 + wm * 64 + mi * 32 + 4 * lh;
      if (cb < 1024) {
#pragma unroll
        for (int i = 0; i < 16; ++i) { const int r = rbase + (i & 3) + 8 * (i >> 2); p.Z()[(size_t)r * 1024 + c] = f2bf(acc[mi][ni][i]); }
      } else if (cb < 3072) {
        const int ch = c - 1024;
#pragma unroll
        for (int i = 0; i < 16; ++i) {
          const int r = rbase + (i & 3) + 8 * (i >> 2);
          const float v = acc[mi][ni][i];
          p.XBC()[(size_t)r * 2048 + ch] = f2bf(v);
          if (r >= TP) p.out[OFF_CONVS + ((size_t)(l * 128 + (r - TP)) * 3 + 2) * 2048 + ch] = v;
          else { const int t = r & 8191; if (t >= 8189) p.out[OFF_CONVP + ((size_t)(l * 2 + (r >> 13)) * 3 + (t - 8189)) * 2048 + ch] = v; }
        }
      } else if (cb < 4096) {
#pragma unroll
        for (int i = 0; i < 16; ++i) { const int r = rbase + (i & 3) + 8 * (i >> 2); p.U()[(size_t)r * 1024 + (c - 3072)] = f2bf(acc[mi][ni][i]); }
      } else if (cb < 5376) {
        const bool isq = cb < 5120;
        const int cc = isq ? c - 4096 : c - 5120;
        const bool ropeblk = ((cb & 63) == 0);
#pragma unroll
        for (int i = 0; i < 16; ++i) {
          const int r = rbase + (i & 3) + 8 * (i >> 2);
          float v = acc[mi][ni][i];
          if (ropeblk) {
            const float pv = __shfl_xor(v, 8);
            if (lr < 16) {
              const int pos = (r >= TP) ? 8192 : (r & 8191);
              const float2 cs = p.ROPE()[pos * 8 + (lr & 7)];
              v = (lr < 8) ? v * cs.x - pv * cs.y : v * cs.x + pv * cs.y;
            }
          }
          if (isq) p.Q()[(size_t)r * 1024 + cc] = f2bf(v);
          else {
            p.K()[(size_t)r * 256 + cc] = f2bf(v);
            if (r >= TP) p.out[OFF_KS + ((size_t)(l * 128 + (r - TP)) * 128 + 127) * 256 + cc] = v;
            else { const int t = r & 8191; if (t >= 8064) p.out[OFF_KP + ((size_t)(l * 2 + (r >> 13)) * 128 + (t - 8064)) * 256 + cc] = v; }
          }
        }
      } else if (cb < 5632) {
        const int cc = c - 5376;
#pragma unroll
        for (int ig = 0; ig < 4; ++ig) {
          const int r0 = rbase + 8 * ig;
          const float v0 = acc[mi][ni][4 * ig], v1 = acc[mi][ni][4 * ig + 1], v2 = acc[mi][ni][4 * ig + 2], v3 = acc[mi][ni][4 * ig + 3];
          *(uint2*)(p.VT() + (size_t)cc * T + r0) = make_uint2(pack2(v0, v1), pack2(v2, v3));
#pragma unroll
          for (int jj = 0; jj < 4; ++jj) {
            const int r = r0 + jj;
            const float v = acc[mi][ni][4 * ig + jj];
            if (r >= TP) p.out[OFF_VS + ((size_t)(l * 128 + (r - TP)) * 128 + 127) * 256 + cc] = v;
            else { const int t = r & 8191; if (t >= 8064) p.out[OFF_VP + ((size_t)(l * 2 + (r >> 13)) * 128 + (t - 8064)) * 256 + cc] = v; }
          }
        }
      } else if (cb < 8704) {
#pragma unroll
        for (int i = 0; i < 16; ++i) { const int r = rbase + (i & 3) + 8 * (i >> 2); p.G()[(size_t)r * 3072 + (c - 5632)] = f2bf(sigm_f(acc[mi][ni][i])); }
      } else {
        if (lr < 16) {
          const float bias = p.dt_bias[l * 16 + lr];
#pragma unroll
          for (int i = 0; i < 16; ++i) { const int r = rbase + (i & 3) + 8 * (i >> 2); p.DT()[(size_t)r * 16 + lr] = softplus_f(acc[mi][ni][i] + bias); }
        }
      }
    }
  }
}

DI void conv_job(const P& p, int l, int job, char* smem) {
  const int ct = job & 31, tt = job >> 5;
  const int ch0 = ct * 64, tokb = tt * 128;
  bf16_t* sT = (bf16_t*)smem;
  const int tid = tidx();
  const float* cw = p.conv_w + (size_t)l * 4 * 2048;
  __syncthreads();
#pragma unroll
  for (int it = 0; it < 4; ++it) {
    const int item = tid + 256 * it, tl = item >> 3, chk = item & 7, ch = ch0 + chk * 8, row = tokb + tl, t = row & 8191;
    float a[8];
    {
      const float4 b0 = *(const float4*)(p.conv_b + l * 2048 + ch), b1 = *(const float4*)(p.conv_b + l * 2048 + ch + 4);
      a[0] = b0.x; a[1] = b0.y; a[2] = b0.z; a[3] = b0.w; a[4] = b1.x; a[5] = b1.y; a[6] = b1.z; a[7] = b1.w;
    }
#pragma unroll
    for (int j = 0; j < 4; ++j) {
      if (t - 3 + j >= 0) {
        const uint4 rv = *(const uint4*)(p.XBC() + (size_t)(row - 3 + j) * 2048 + ch);
        const float4 w0 = *(const float4*)(cw + j * 2048 + ch), w1 = *(const float4*)(cw + j * 2048 + ch + 4);
        a[0] += bflo(rv.x) * w0.x; a[1] += bfhi(rv.x) * w0.y; a[2] += bflo(rv.y) * w0.z; a[3] += bfhi(rv.y) * w0.w;
        a[4] += bflo(rv.z) * w1.x; a[5] += bfhi(rv.z) * w1.y; a[6] += bflo(rv.w) * w1.z; a[7] += bfhi(rv.w) * w1.w;
      }
    }
#pragma unroll
    for (int j = 0; j < 8; ++j) a[j] = silu_f(a[j]);
    if (ct >= 16) *(uint4*)(p.BC() + (size_t)row * 1024 + (ch - 1024)) = make_uint4(pack2(a[0], a[1]), pack2(a[2], a[3]), pack2(a[4], a[5]), pack2(a[6], a[7]));
    if (ct < 24) {
#pragma unroll
      for (int j = 0; j < 8; ++j) sT[(chk * 8 + j) * 136 + tl] = f2bf(a[j]);
    }
  }
  if (ct < 24) {
    __syncthreads();
#pragma unroll
    for (int it = 0; it < 4; ++it) {
      const int item = tid + 256 * it, r = item >> 4, chk = item & 15;
      *(uint4*)(p.XBT() + (size_t)(ch0 + r) * TP + tokb + chk * 8) = *(const uint4*)(sT + r * 136 + chk * 8);
    }
  }
}

DI void chunk_acum(const P& p, int l, int head, int tok0, float* sAc, float* sDt, float& alast) {
  const int lane = tidx() & 63;
  const float Ah = -expf(p.a_log[l * 16 + head]);
  const float d0 = p.DT()[(size_t)(tok0 + 2 * lane) * 16 + head], d1 = p.DT()[(size_t)(tok0 + 2 * lane + 1) * 16 + head];
  const float a0 = d0 * Ah, a1 = d1 * Ah;
  float s = a0 + a1;
#pragma unroll
  for (int off = 1; off < 64; off <<= 1) { const float tv = __shfl_up(s, off); if (lane >= off) s += tv; }
  const float excl = s - (a0 + a1);
  sAc[2 * lane] = excl + a0; sAc[2 * lane + 1] = s;
  sDt[2 * lane] = d0; sDt[2 * lane + 1] = d1;
  alast = __shfl(s, 63);
}

DI void ssd_a_job(const P& p, int l, int job, char* smem) {
  const int head = job & 15, c = (job >> 4) & 63, b = job >> 10, g = head >> 2;
  const int tok0 = b * SEQ + c * 128;
  bf16_t* sXT = (bf16_t*)smem;
  bf16_t* sBT = sXT + 64 * 136;
  float* sW = (float*)(sBT + 128 * 136);
  float* sAc = sW + 128;
  float* sDt = sAc + 128;
  const int tid = tidx(), lane = tid & 63, w = __builtin_amdgcn_readfirstlane(tid >> 6), lr = lane & 31, lh = lane >> 5;
  __syncthreads();
  if (w == 0) {
    float alast;
    chunk_acum(p, l, head, tok0, sAc, sDt, alast);
    sW[2 * lane] = sDt[2 * lane] * __expf(alast - sAc[2 * lane]);
    sW[2 * lane + 1] = sDt[2 * lane + 1] * __expf(alast - sAc[2 * lane + 1]);
    if (lane == 0) p.CDEC()[(b * 64 + c) * 16 + head] = __expf(alast);
  }
  __syncthreads();
#pragma unroll
  for (int it = 0; it < 4; ++it) {
    const int item = tid + 256 * it, pr = item >> 4, s0 = (item & 15) * 8;
    const uint4 v = *(const uint4*)(p.XBT() + (size_t)(head * 64 + pr) * TP + tok0 + s0);
    const float4 w0 = *(const float4*)(sW + s0), w1 = *(const float4*)(sW + s0 + 4);
    *(uint4*)(sXT + pr * 136 + s0) = make_uint4(pack2(bflo(v.x) * w0.x, bfhi(v.x) * w0.y), pack2(bflo(v.y) * w0.z, bfhi(v.y) * w0.w),
                                                pack2(bflo(v.z) * w1.x, bfhi(v.z) * w1.y), pack2(bflo(v.w) * w1.z, bfhi(v.w) * w1.w));
  }
#pragma unroll
  for (int it = 0; it < 8; ++it) {
    const int item = tid + 256 * it, n = item >> 4, s0 = (item & 15) * 8;
    *(uint4*)(sBT + n * 136 + s0) = *(const uint4*)(p.XBT() + (size_t)(1024 + g * 128 + n) * TP + tok0 + s0);
  }
  __syncthreads();
  const int wp = w & 1, wn = w >> 1;
  f32x16 acc[2];
  zero16(acc[0]); zero16(acc[1]);
#pragma unroll
  for (int kk = 0; kk < 8; ++kk) {
    const bf16x8 af = *(const bf16x8*)(sXT + (wp * 32 + lr) * 136 + kk * 16 + lh * 8);
#pragma unroll
    for (int ni = 0; ni < 2; ++ni) {
      const bf16x8 bfr = *(const bf16x8*)(sBT + (wn * 64 + ni * 32 + lr) * 136 + kk * 16 + lh * 8);
      acc[ni] = MFMA32(af, bfr, acc[ni]);
    }
  }
  float* st = p.ST() + ((size_t)((b * 64 + c) * 16 + head) * 64) * 128;
#pragma unroll
  for (int ni = 0; ni < 2; ++ni)
#pragma unroll
    for (int i = 0; i < 16; ++i) st[(wp * 32 + crow(i, lh)) * 128 + wn * 64 + ni * 32 + lr] = acc[ni][i];
}

DI void ssd_scan_job(const P& p, int l, int job) {
  const int gid = job * 256 + tidx();
  const int b = gid >> 15, rem = gid & 32767, head = rem >> 11;
  float4 h = make_float4(0.f, 0.f, 0.f, 0.f);
  float4* sp0 = (float4*)(p.ST() + (size_t)(b * 64) * 131072) + rem;
  for (int c0 = 0; c0 < 64; c0 += 8) {
    float4 sv[8];
    float dv[8];
#pragma unroll
    for (int k = 0; k < 8; ++k) { sv[k] = sp0[(size_t)(c0 + k) * 32768]; dv[k] = p.CDEC()[(b * 64 + c0 + k) * 16 + head]; }
#pragma unroll
    for (int k = 0; k < 8; ++k) {
      sp0[(size_t)(c0 + k) * 32768] = h;
      h.x = h.x * dv[k] + sv[k].x; h.y = h.y * dv[k] + sv[k].y; h.z = h.z * dv[k] + sv[k].z; h.w = h.w * dv[k] + sv[k].w;
    }
  }
  ((float4*)(p.out + OFF_SSMP + (size_t)(l * 2 + b) * 131072))[rem] = h;
}

DI void s5_scan_job(const P& p, int l, int job) {
  const int gid = job * 256 + tidx();
  const int n = gid & 63, g = (gid >> 6) & 63, b = gid >> 12;
  const float* prm = p.S5P() + ((size_t)(l * 64 + g) * 36) * 64 + n;
  const float aqr = prm[128], aqi = prm[192];
  float hr = 0.f, hi = 0.f;
  float2* sp = (float2*)p.S5S() + ((size_t)(b * 128) * 64 + g) * 64 + n;
  for (int c0 = 0; c0 < 128; c0 += 8) {
    float2 sv[8];
#pragma unroll
    for (int k = 0; k < 8; ++k) sv[k] = sp[(size_t)(c0 + k) * 4096];
#pragma unroll
    for (int k = 0; k < 8; ++k) {
      sp[(size_t)(c0 + k) * 4096] = make_float2(hr, hi);
      const float nr = aqr * hr - aqi * hi + sv[k].x, ni = aqr * hi + aqi * hr + sv[k].y;
      hr = nr; hi = ni;
    }
  }
}

DI void ssd_c_job(const P& p, int l, int job, char* smem) {
  const int g = job & 3, c = (job >> 2) & 63, b = job >> 8;
  const int tok0 = b * SEQ + c * 128;
  bf16_t* sC = (bf16_t*)smem;
  bf16_t* sB = sC + 128 * 136;
  float* sAc = (float*)(sB + 128 * 136);
  float* sDt = sAc + 512;
  const int tid = tidx(), lane = tid & 63, w = __builtin_amdgcn_readfirstlane(tid >> 6), lr = lane & 31, lh = lane >> 5, wm = w & 1, wn = w >> 1;
  __syncthreads();
  { float alast; chunk_acum(p, l, g * 4 + w, tok0, sAc + w * 128, sDt + w * 128, alast); }
#pragma unroll
  for (int it = 0; it < 8; ++it) {
    const int item = tid + 256 * it, r = item >> 4, s0 = (item & 15) * 8;
    *(uint4*)(sC + r * 136 + s0) = *(const uint4*)(p.BC() + (size_t)(tok0 + r) * 1024 + 512 + g * 128 + s0);
    *(uint4*)(sB + r * 136 + s0) = *(const uint4*)(p.BC() + (size_t)(tok0 + r) * 1024 + g * 128 + s0);
  }
  __syncthreads();
  f32x16 cb[2][2];
#pragma unroll
  for (int a = 0; a < 2; ++a)
#pragma unroll
    for (int bb = 0; bb < 2; ++bb) zero16(cb[a][bb]);
  if (!(wm == 0 && wn == 1)) {
#pragma unroll
    for (int kk = 0; kk < 8; ++kk) {
      bf16x8 af[2], bfr[2];
#pragma unroll
      for (int mi = 0; mi < 2; ++mi) af[mi] = *(const bf16x8*)(sC + (wm * 64 + mi * 32 + lr) * 136 + kk * 16 + lh * 8);
#pragma unroll
      for (int ni = 0; ni < 2; ++ni) bfr[ni] = *(const bf16x8*)(sB + (wn * 64 + ni * 32 + lr) * 136 + kk * 16 + lh * 8);
#pragma unroll
      for (int mi = 0; mi < 2; ++mi)
#pragma unroll
        for (int ni = 0; ni < 2; ++ni) cb[mi][ni] = MFMA32(af[mi], bfr[ni], cb[mi][ni]);
    }
  }
  __syncthreads();
  bf16_t* sM = sB;
  unsigned cbp[2][2][8];
#pragma unroll
  for (int a = 0; a < 2; ++a)
#pragma unroll
    for (int bb = 0; bb < 2; ++bb)
#pragma unroll
      for (int k = 0; k < 8; ++k) cbp[a][bb][k] = pack2(cb[a][bb][2 * k], cb[a][bb][2 * k + 1]);
  float ss[16];
#pragma unroll
  for (int i = 0; i < 16; ++i) ss[i] = 0.f;
#pragma unroll 1
  for (int hd = 0; hd < 4; ++hd) {
    const int head = g * 4 + hd;
    const float* ac = sAc + hd * 128;
    const float* dtv = sDt + hd * 128;
    const int lrq = launder(lr), lhq = launder(lh);
#pragma unroll
    for (int mi = 0; mi < 2; ++mi)
#pragma unroll
      for (int ni = 0; ni < 2; ++ni) {
        const int s = wn * 64 + ni * 32 + lrq;
        const float as = ac[s], ds = dtv[s];
#pragma unroll
        for (int i = 0; i < 16; ++i) {
          const int t = wm * 64 + mi * 32 + crow(i, lhq);
          const float cv = (i & 1) ? bfhi(cbp[mi][ni][i >> 1]) : bflo(cbp[mi][ni][i >> 1]);
          const float v = (s <= t) ? cv * __expf(ac[t] - as) * ds : 0.f;
          sM[t * 136 + s] = f2bf(v);
        }
        __builtin_amdgcn_sched_barrier(0);
      }
    __syncthreads();
    f32x16 yd[2];
    zero16(yd[0]); zero16(yd[1]);
#pragma unroll 1
    for (int kk = 0; kk < 8; ++kk) {
      const bf16x8 af = *(const bf16x8*)(sC + (32 * w + lr) * 136 + kk * 16 + lh * 8);
#pragma unroll
      for (int pb = 0; pb < 2; ++pb) {
        const float* hp = p.ST() + (((size_t)((b * 64 + c) * 16 + head) * 64 + pb * 32 + lr) * 128 + kk * 16 + lh * 8);
        const float4 h0 = ((const float4*)hp)[0], h1 = ((const float4*)hp)[1];
        const uint4 hv = make_uint4(pack2(h0.x, h0.y), pack2(h0.z, h0.w), pack2(h1.x, h1.y), pack2(h1.z, h1.w));
        yd[pb] = MFMA32(af, u4_to_bf8(hv), yd[pb]);
      }
    }
#pragma unroll
    for (int i = 0; i < 16; ++i) {
      const float e = __expf(ac[32 * w + crow(i, lh)]);
      yd[0][i] *= e; yd[1][i] *= e;
    }
    const int nkk = 2 * (w + 1);
    for (int kk = 0; kk < nkk; ++kk) {
      const bf16x8 af = *(const bf16x8*)(sM + (32 * w + lr) * 136 + kk * 16 + lh * 8);
#pragma unroll
      for (int pb = 0; pb < 2; ++pb) {
        const bf16x8 bfr = *(const bf16x8*)(p.XBT() + (size_t)(head * 64 + pb * 32 + lr) * TP + tok0 + kk * 16 + lh * 8);
        yd[pb] = MFMA32(af, bfr, yd[pb]);
      }
    }
    const float Dh = p.m_d[l * 16 + head];
#pragma unroll
    for (int pb = 0; pb < 2; ++pb) {
      const int pch = head * 64 + pb * 32 + lr;
#pragma unroll
      for (int ig = 0; ig < 4; ++ig) {
        const int t0 = 32 * w + 8 * ig + 4 * lh;
        const uint2 xr = *(const uint2*)(p.XBT() + (size_t)pch * TP + tok0 + t0);
        const float xs[4] = {bflo(xr.x), bfhi(xr.x), bflo(xr.y), bfhi(xr.y)};
#pragma unroll
        for (int jj = 0; jj < 4; ++jj) {
          const int i = 4 * ig + jj, t = t0 + jj;
          const float y = yd[pb][i] + Dh * xs[jj];
          const float z = bf2f(p.Z()[(size_t)(tok0 + t) * 1024 + pch]);
          const float yg = y * silu_f(z);
          ss[i] += yg * yg;
          p.YM()[(size_t)(tok0 + t) * 1024 + pch] = f2bf(yg);
        }
      }
      __builtin_amdgcn_sched_barrier(0);
    }
    __syncthreads();
  }
#pragma unroll
  for (int i = 0; i < 16; ++i) {
    float v = ss[i];
    v += __shfl_xor(v, 1); v += __shfl_xor(v, 2); v += __shfl_xor(v, 4); v += __shfl_xor(v, 8); v += __shfl_xor(v, 16);
    ss[i] = rsqrtf(v * (1.f / 256.f) + EPS);
  }
  for (int hd = 0; hd < 4; ++hd) {
#pragma unroll
    for (int pb = 0; pb < 2; ++pb) {
      const int pch = (g * 4 + hd) * 64 + pb * 32 + lr;
      const float nw = p.m_norm_w[l * 1024 + pch];
#pragma unroll
      for (int i = 0; i < 16; ++i) {
        const size_t idx = (size_t)(tok0 + 32 * w + crow(i, lh)) * 1024 + pch;
        p.YM()[idx] = f2bf(bf2f(p.YM()[idx]) * ss[i] * nw);
      }
      __builtin_amdgcn_sched_barrier(0);
    }
  }
}

DI void ssd_sample_job(const P& p, int l, int job, char* smem) {
  const int g = job & 3, b = job >> 2;
  float* sx = (float*)smem;
  float* sBv = sx + 256;
  float* sCv = sBv + 128;
  float* sY = sCv + 128;
  float* sRed = sY + 256;
  const int tid = tidx(), lane = tid & 63, w = __builtin_amdgcn_readfirstlane(tid >> 6);
  const int row = TP + b;
  __syncthreads();
#pragma unroll
  for (int it = 0; it < 2; ++it) {
    const int idx = tid + 256 * it;
    const int ch = idx < 256 ? g * 256 + idx : (idx < 384 ? 1024 + g * 128 + (idx - 256) : 1536 + g * 128 + (idx - 384));
    const float* sc = p.state_conv + ((size_t)(l * 128 + b) * 3) * 2048 + ch;
    const float s0 = sc[0], s1 = sc[2048], s2 = sc[4096];
    const float raw = bf2f(p.XBC()[(size_t)row * 2048 + ch]);
    const float* cw = p.conv_w + (size_t)l * 4 * 2048 + ch;
    float v = p.conv_b[l * 2048 + ch] + cw[0] * s0 + cw[2048] * s1 + cw[4096] * s2 + cw[6144] * raw;
    v = silu_f(v);
    sx[idx] = v;
    float* co = p.out + OFF_CONVS + ((size_t)(l * 128 + b) * 3) * 2048 + ch;
    co[0] = s1; co[2048] = s2;
  }
  __syncthreads();
  for (int hd = 0; hd < 4; ++hd) {
    const int head = g * 4 + hd;
    const float dt = p.DT()[(size_t)row * 16 + head];
    const float Ah = -expf(p.a_log[l * 16 + head]);
    const float dA = __expf(dt * Ah);
    const int pp = tid >> 2, nq = (tid & 3) * 32;
    const float xv = sx[hd * 64 + pp];
    const float coef = dt * xv;
    const size_t so = ((((size_t)l * 128 + b) * 16 + head) * 64 + pp) * 128 + nq;
    const float4* h0 = (const float4*)(p.state_ssm + so);
    float4* ho = (float4*)(p.out + OFF_SSMS + so);
    float yacc = 0.f;
#pragma unroll
    for (int q = 0; q < 8; ++q) {
      float4 hv = h0[q];
      const int n = nq + 4 * q;
      hv.x = hv.x * dA + coef * sBv[n]; hv.y = hv.y * dA + coef * sBv[n + 1]; hv.z = hv.z * dA + coef * sBv[n + 2]; hv.w = hv.w * dA + coef * sBv[n + 3];
      yacc += hv.x * sCv[n] + hv.y * sCv[n + 1] + hv.z * sCv[n + 2] + hv.w * sCv[n + 3];
      ho[q] = hv;
    }
    yacc += __shfl_xor(yacc, 1); yacc += __shfl_xor(yacc, 2);
    const float y = yacc + p.m_d[l * 16 + head] * xv;
    const float z = bf2f(p.Z()[(size_t)row * 1024 + head * 64 + pp]);
    if ((tid & 3) == 0) sY[hd * 64 + pp] = y * silu_f(z);
  }
  __syncthreads();
  const float v = sY[tid];
  const float ssq = wave_sum(v * v);
  if (lane == 0) sRed[w] = ssq;
  __syncthreads();
  const float tot = sRed[0] + sRed[1] + sRed[2] + sRed[3];
  const float sc = rsqrtf(tot * (1.f / 256.f) + EPS);
  p.YM()[(size_t)row * 1024 + g * 256 + tid] = f2bf(v * sc * p.m_norm_w[l * 1024 + g * 256 + tid]);
}

DI void s5_wave_job(const P& p, int l, int mode, int b, int g, int c, bf16_t* sH) {
  const int lane = tidx() & 63;
  const float* prm = p.S5P() + ((size_t)(l * 64 + g) * 36) * 64 + lane;
  const float abr = prm[0], abi = prm[64];
  float bbr[16], bbi[16];
#pragma unroll
  for (int i = 0; i < 16; ++i) { bbr[i] = prm[(4 + i) * 64]; bbi[i] = prm[(20 + i) * 64]; }
  float hr = 0.f, hi = 0.f;
  int row0, Q;
  if (mode == 2) {
    row0 = TP + b; Q = 1;
    hr = p.s5_sre[((size_t)(l * 128 + b) * 64 + g) * 64 + lane];
    hi = p.s5_sim[((size_t)(l * 128 + b) * 64 + g) * 64 + lane];
  } else {
    row0 = b * SEQ + c * 64; Q = 64;
    if (mode == 1) {
      const float2 s = *(const float2*)(p.S5S() + (((size_t)(b * 128 + c) * 64 + g) * 64 + lane) * 2);
      hr = s.x; hi = s.y;
    }
  }
  unsigned uw[8];
  {
    uint4 u0 = make_uint4(0u, 0u, 0u, 0u), u1 = u0;
    if (lane < Q) { const uint4* up = (const uint4*)(p.U() + (size_t)(row0 + lane) * 1024 + g * 16); u0 = up[0]; u1 = up[1]; }
    uw[0] = u0.x; uw[1] = u0.y; uw[2] = u0.z; uw[3] = u0.w; uw[4] = u1.x; uw[5] = u1.y; uw[6] = u1.z; uw[7] = u1.w;
  }
  for (int t = 0; t < Q; ++t) {
    float br_ = 0.f, bi_ = 0.f;
#pragma unroll
    for (int k = 0; k < 8; ++k) {
      const unsigned wv = (unsigned)__builtin_amdgcn_readlane((int)uw[k], t);
      const float ua = bflo(wv), ub = bfhi(wv);
      br_ += bbr[2 * k] * ua + bbr[2 * k + 1] * ub;
      bi_ += bbi[2 * k] * ua + bbi[2 * k + 1] * ub;
    }
    const float nr = abr * hr - abi * hi + br_, ni = abr * hi + abi * hr + bi_;
    hr = nr; hi = ni;
    if (mode != 0) { sH[t * 136 + lane] = f2bf(hr); sH[t * 136 + 64 + lane] = f2bf(hi); }
  }
  if (mode == 0) {
    *(float2*)(p.S5S() + (((size_t)(b * 128 + c) * 64 + g) * 64 + lane) * 2) = make_float2(hr, hi);
    return;
  }
  if (mode == 1 && c == 127) {
    p.out[OFF_S5RP + ((size_t)(l * 2 + b) * 64 + g) * 64 + lane] = hr;
    p.out[OFF_S5IP + ((size_t)(l * 2 + b) * 64 + g) * 64 + lane] = hi;
  }
  if (mode == 2) {
    p.out[OFF_S5RS + ((size_t)(l * 128 + b) * 64 + g) * 64 + lane] = hr;
    p.out[OFF_S5IS + ((size_t)(l * 128 + b) * 64 + g) * 64 + lane] = hi;
  }
  const int o = lane & 15, quad = lane >> 4;
  bf16x8 cf[4];
#pragma unroll
  for (int kk = 0; kk < 4; ++kk) {
    const float* cp = ((kk < 2) ? p.c_re : p.c_im) + ((size_t)(l * 64 + g) * 16 + o) * 64 + (kk & 1) * 32 + quad * 8;
    const float4 c0 = ((const float4*)cp)[0], c1 = ((const float4*)cp)[1];
    const float sg = (kk < 2) ? 1.f : -1.f;
    cf[kk] = u4_to_bf8(make_uint4(pack2(sg * c0.x, sg * c0.y), pack2(sg * c0.z, sg * c0.w), pack2(sg * c1.x, sg * c1.y), pack2(sg * c1.z, sg * c1.w)));
  }
  const float dsk = p.s5_d[l * 1024 + g * 16 + o];
  const int nrb = (mode == 2) ? 1 : 4;
  __builtin_amdgcn_fence(__ATOMIC_RELEASE, "wavefront");
  __builtin_amdgcn_wave_barrier();
  __builtin_amdgcn_fence(__ATOMIC_ACQUIRE, "wavefront");
  for (int rb = 0; rb < nrb; ++rb) {
    f32x4 a4 = {0.f, 0.f, 0.f, 0.f};
#pragma unroll
    for (int kk = 0; kk < 4; ++kk) {
      const bf16x8 af = *(const bf16x8*)(sH + (rb * 16 + o) * 136 + kk * 32 + quad * 8);
      a4 = MFMA16(af, cf[kk], a4);
    }
#pragma unroll
    for (int jj = 0; jj < 4; ++jj) {
      const int t = rb * 16 + quad * 4 + jj;
      if (t < Q) {
        const size_t idx = (size_t)(row0 + t) * 1024 + g * 16 + o;
        const float y = a4[jj] + dsk * bf2f(p.U()[idx]);
        p.YS()[idx] = f2bf(gelu_tanh(y));
      }
    }
  }
}

DI void attn_prompt_job(const P& p, int l, int job, char* smem) {
  const int head = job & 15, blk = (job >> 4) & 63, b = job >> 10, kvh = head >> 2;
  bf16_t* sK = (bf16_t*)smem;
  bf16_t* sVt = sK + 256 * 72;
  const int tid = tidx(), lane = tid & 63, w = __builtin_amdgcn_readfirstlane(tid >> 6), lr = lane & 31, lh = lane >> 5;
  const int tokc0 = b * SEQ + blk * 128 - 128;
  __syncthreads();
#pragma unroll
  for (int it = 0; it < 8; ++it) {
    const int item = tid + 256 * it, row = item >> 3, chk = item & 7;
    uint4 v = make_uint4(0u, 0u, 0u, 0u);
    if (blk > 0 || row >= 128) v = *(const uint4*)(p.K() + (size_t)(tokc0 + row) * 256 + kvh * 64 + chk * 8);
    *(uint4*)(sK + row * 72 + chk * 8) = v;
  }
#pragma unroll
  for (int it = 0; it < 8; ++it) {
    const int item = tid + 256 * it, d = item >> 5, chk = item & 31;
    uint4 v = make_uint4(0u, 0u, 0u, 0u);
    if (blk > 0 || chk >= 16) v = *(const uint4*)(p.VT() + (size_t)(kvh * 64 + d) * T + tokc0 + chk * 8);
    *(uint4*)(sVt + d * 264 + chk * 8) = v;
  }
  __syncthreads();
  const int qtok = b * SEQ + blk * 128 + 32 * w + lr;
  bf16x8 qf[4];
#pragma unroll
  for (int kk = 0; kk < 4; ++kk) qf[kk] = *(const bf16x8*)(p.Q() + (size_t)qtok * 1024 + head * 64 + kk * 16 + lh * 8);
  f32x16 st[5];
#pragma unroll
  for (int x = 0; x < 5; ++x) {
    zero16(st[x]);
#pragma unroll
    for (int kk = 0; kk < 4; ++kk) {
      const bf16x8 af = *(const bf16x8*)(sK + (32 * (w + x) + lr) * 72 + kk * 16 + lh * 8);
      st[x] = MFMA32(af, qf[kk], st[x]);
    }
  }
  const float sink = p.sinks[l * 16 + head];
  const int qi = 128 + 32 * w + lr;
  float m = sink;
#pragma unroll
  for (int x = 0; x < 5; ++x)
#pragma unroll
    for (int i = 0; i < 16; ++i) {
      const int kj = 32 * (w + x) + crow(i, lh);
      const bool valid = (kj <= qi) && (kj >= qi - 128) && (blk > 0 || kj >= 128);
      const float s = valid ? st[x][i] * 0.125f : -1e30f;
      st[x][i] = s;
      m = fmaxf(m, s);
    }
  m = fmaxf(m, __shfl_xor(m, 32));
  float sum = 0.f;
#pragma unroll
  for (int x = 0; x < 5; ++x)
#pragma unroll
    for (int i = 0; i < 16; ++i) { const float pv = __expf(st[x][i] - m); st[x][i] = pv; sum += pv; }
  sum += __shfl_xor(sum, 32);
  const float inv = 1.f / (sum + __expf(sink - m));
  f32x16 ot[2];
  zero16(ot[0]); zero16(ot[1]);
#pragma unroll
  for (int x = 0; x < 5; ++x)
#pragma unroll
    for (int s = 0; s < 2; ++s) {
      const uint4 pu = make_uint4(pack2(st[x][8 * s] * inv, st[x][8 * s + 1] * inv), pack2(st[x][8 * s + 2] * inv, st[x][8 * s + 3] * inv),
                                  pack2(st[x][8 * s + 4] * inv, st[x][8 * s + 5] * inv), pack2(st[x][8 * s + 6] * inv, st[x][8 * s + 7] * inv));
      const bf16x8 pf = u4_to_bf8(pu);
#pragma unroll
      for (int pb = 0; pb < 2; ++pb) {
        const bf16_t* vp = sVt + (pb * 32 + lr) * 264 + 32 * (w + x) + 16 * s + 4 * lh;
        const uint2 lo = *(const uint2*)vp, hi2 = *(const uint2*)(vp + 8);
        ot[pb] = MFMA32(u4_to_bf8(make_uint4(lo.x, lo.y, hi2.x, hi2.y)), pf, ot[pb]);
      }
    }
#pragma unroll
  for (int pb = 0; pb < 2; ++pb)
#pragma unroll
    for (int ig = 0; ig < 4; ++ig) {
      const int d0 = pb * 32 + 8 * ig + 4 * lh;
      *(uint2*)(p.O() + (size_t)qtok * 1024 + head * 64 + d0) = make_uint2(pack2(ot[pb][4 * ig], ot[pb][4 * ig + 1]), pack2(ot[pb][4 * ig + 2], ot[pb][4 * ig + 3]));
    }
}

DI void attn_sample_job(const P& p, int l, int job, char* smem) {
  const int kvh = job & 3, b = job >> 2;
  const int tid = tidx(), lane = tid & 63, w = __builtin_amdgcn_readfirstlane(tid >> 6);
  const int head = kvh * 4 + w, row = TP + b;
  float* sP = (float*)smem + w * 192;
  __syncthreads();
  const float qd = bf2f(p.Q()[(size_t)row * 1024 + head * 64 + lane]);
  const size_t cbase = ((size_t)(l * 128 + b) * 128) * 256 + kvh * 64 + lane;
  const float* kc = p.cache_k + cbase;
  const float* vc = p.cache_v + cbase;
  float* ko = p.out + OFF_KS + cbase;
  float* vo = p.out + OFF_VS + cbase;
  for (int j = 0; j < 128; ++j) {
    const float kv = kc[(size_t)j * 256];
    if (w == 0 && j >= 1) ko[(size_t)(j - 1) * 256] = kv;
    const float s = wave_sum(qd * kv) * 0.125f;
    if (lane == 0) sP[j] = s;
  }
  {
    const float kv = bf2f(p.K()[(size_t)row * 256 + kvh * 64 + lane]);
    const float s = wave_sum(qd * kv) * 0.125f;
    if (lane == 0) sP[128] = s;
  }
  __syncthreads();
  const float sink = p.sinks[l * 16 + head];
  const float s0 = sP[lane], s1 = sP[lane + 64], s2 = sP[128];
  float m = fmaxf(fmaxf(s0, s1), fmaxf(s2, sink));
  m = wave_max(m);
  const float p0 = __expf(s0 - m), p1 = __expf(s1 - m), p2 = __expf(s2 - m);
  float sum = wave_sum(p0 + p1);
  const float inv = 1.f / (sum + p2 + __expf(sink - m));
  __syncthreads();
  sP[lane] = p0 * inv; sP[lane + 64] = p1 * inv;
  if (lane == 0) sP[128] = p2 * inv;
  __syncthreads();
  float o = 0.f;
  for (int j = 0; j < 128; ++j) {
    const float vv = vc[(size_t)j * 256];
    if (w == 0 && j >= 1) vo[(size_t)(j - 1) * 256] = vv;
    o += sP[j] * vv;
  }
  o += sP[128] * bf2f(p.VT()[(size_t)(kvh * 64 + lane) * T + row]);
  p.O()[(size_t)row * 1024 + head * 64 + lane] = f2bf(o);
}

template <int PASS>
DI void merge_pass(const P& p, const bf16_t* A, const bf16_t* Wt, int m0, int n0, char* smem) {
  m0 = launder_s(m0); n0 = launder_s(n0);
  const int tid = tidx(), lane = tid & 63, w = __builtin_amdgcn_readfirstlane(tid >> 6), wm = w & 1, wn = w >> 1, lr = lane & 31, lh = lane >> 5;
  f32x16 acc[2][2];
#pragma unroll
  for (int a = 0; a < 2; ++a)
#pragma unroll
    for (int b = 0; b < 2; ++b) zero16(acc[a][b]);
  gemm_mainloop(A + (size_t)m0 * 1024, 1024, Wt + (size_t)n0 * 1024, 1024, 1024, acc, smem);
  m0 = launder_s(m0); n0 = launder_s(n0);
#pragma unroll
  for (int mi = 0; mi < 2; ++mi)
#pragma unroll
    for (int ni = 0; ni < 2; ++ni) {
      const int c = n0 + wn * 64 + ni * 32 + lr;
#pragma unroll
      for (int i = 0; i < 16; ++i) {
        const int r = m0 + wm * 64 + mi * 32 + crow(i, lh);
        bf16_t* mp = p.MG() + (size_t)r * 1024 + c;
        const float a = acc[mi][ni][i];
        if (PASS == 0) *mp = f2bf(sigm_f(a) * bf2f(p.G()[(size_t)r * 3072 + 1024 + c]));
        else if (PASS == 1) *mp = f2bf(bf2f(*mp) * a);
        else if (PASS == 2) *mp = f2bf(bf2f(*mp) + a * bf2f(p.G()[(size_t)r * 3072 + c]));
        else *mp = f2bf(bf2f(*mp) + a * bf2f(p.G()[(size_t)r * 3072 + 2048 + c]));
      }
    }
}
DI void merge_job(const P& p, int l, int job, char* smem) {
  int mt, nt;
  if (!gemm_tile(job, 128, 8, mt, nt)) return;
  const int m0 = mt * 128, n0 = nt * 128;
  const bf16_t* wl = p.Wt() + (size_t)l * W_LAYER;
  merge_pass<0>(p, p.YS(), wl + WO_GLU + (size_t)1024 * 1024, m0, n0, smem);
  merge_pass<1>(p, p.YS(), wl + WO_GLU, m0, n0, smem);
  merge_pass<2>(p, p.YM(), wl + WO_MPROJ, m0, n0, smem);
  merge_pass<3>(p, p.O(), wl + WO_ATTNO, m0, n0, smem);
}
DI void resid_gemm_job(const P& p, const bf16_t* A, int lda, const bf16_t* Wt, int K, int job, char* smem) {
  int mt, nt;
  if (!gemm_tile(job, 128, 8, mt, nt)) return;
  const int m0 = mt * 128, n0 = nt * 128;
  const int tid = tidx(), lane = tid & 63, w = __builtin_amdgcn_readfirstlane(tid >> 6), wm = w & 1, wn = w >> 1, lr = lane & 31, lh = lane >> 5;
  f32x16 acc[2][2];
#pragma unroll
  for (int a = 0; a < 2; ++a)
#pragma unroll
    for (int b = 0; b < 2; ++b) zero16(acc[a][b]);
  gemm_mainloop(A + (size_t)m0 * lda, lda, Wt + (size_t)n0 * K, K, K, acc, smem);
#pragma unroll
  for (int mi = 0; mi < 2; ++mi)
#pragma unroll
    for (int ni = 0; ni < 2; ++ni) {
      const int c = n0 + wn * 64 + ni * 32 + lr;
#pragma unroll
      for (int i = 0; i < 16; ++i) {
        const int r = m0 + wm * 64 + mi * 32 + crow(i, lh);
        p.X()[(size_t)r * 1024 + c] += acc[mi][ni][i];
      }
    }
}
DI void up_job(const P& p, int l, int job, char* smem) {
  int mt, nt;
  if (!gemm_tile(job, 128, 32, mt, nt)) return;
  const int m0 = mt * 128, n0 = nt * 128;
  const int tid = tidx(), lane = tid & 63, w = __builtin_amdgcn_readfirstlane(tid >> 6), wm = w & 1, wn = w >> 1, lr = lane & 31, lh = lane >> 5;
  f32x16 acc[2][2];
#pragma unroll
  for (int a = 0; a < 2; ++a)
#pragma unroll
    for (int b = 0; b < 2; ++b) zero16(acc[a][b]);
  gemm_mainloop(p.H() + (size_t)m0 * 1024, 1024, p.Wt() + (size_t)l * W_LAYER + WO_UP + (size_t)n0 * 1024, 1024, 1024, acc, smem);
#pragma unroll
  for (int mi = 0; mi < 2; ++mi)
#pragma unroll
    for (int ni = 0; ni < 2; ++ni) {
      const int c = n0 + wn * 64 + ni * 32 + lr;
#pragma unroll
      for (int i = 0; i < 16; ++i) {
        const int r = m0 + wm * 64 + mi * 32 + crow(i, lh);
        const float v = fmaxf(acc[mi][ni][i], 0.f);
        p.A2()[(size_t)r * 4096 + c] = f2bf(v * v);
      }
    }
}

DI float skinny_dot(const bf16_t* __restrict__ A, int lda, const bf16_t* __restrict__ Wt, int K, int r0, int c0, char* smem) {
  float* sR = (float*)smem;
  const int tid = tidx(), lane = tid & 63, w = __builtin_amdgcn_readfirstlane(tid >> 6), r = lane & 15, quad = lane >> 4;
  const int kq = K >> 2;
  const bf16_t* ap = A + (size_t)(r0 + r) * lda + w * kq + quad * 8;
  const bf16_t* bp = Wt + (size_t)(c0 + r) * K + w * kq + quad * 8;
  f32x4 acc = {0.f, 0.f, 0.f, 0.f};
#pragma unroll 4
  for (int k = 0; k < kq; k += 32) {
    const bf16x8 a = *(const bf16x8*)(ap + k), b = *(const bf16x8*)(bp + k);
    acc = MFMA16(a, b, acc);
  }
  __syncthreads();
#pragma unroll
  for (int j = 0; j < 4; ++j) sR[w * 256 + (quad * 4 + j) * 16 + r] = acc[j];
  __syncthreads();
  return sR[tid] + sR[256 + tid] + sR[512 + tid] + sR[768 + tid];
}
DI void skinny_merge_job(const P& p, int l, int job, char* smem) {
  const int rt = job & 7, ct = job >> 3;
  const int r0 = TP + rt * 16, c0 = ct * 16;
  const bf16_t* wl = p.Wt() + (size_t)l * W_LAYER;
  const float ag = skinny_dot(p.YS(), 1024, wl + WO_GLU + (size_t)1024 * 1024, 1024, r0, c0, smem);
  const float av = skinny_dot(p.YS(), 1024, wl + WO_GLU, 1024, r0, c0, smem);
  const float am = skinny_dot(p.YM(), 1024, wl + WO_MPROJ, 1024, r0, c0, smem);
  const float aa = skinny_dot(p.O(), 1024, wl + WO_ATTNO, 1024, r0, c0, smem);
  const int tid = tidx(), r = r0 + (tid >> 4), c = c0 + (tid & 15);
  const bf16_t* gp = p.G() + (size_t)r * 3072 + c;
  const float v = bf2f(gp[0]) * am + bf2f(gp[1024]) * av * sigm_f(ag) + bf2f(gp[2048]) * aa;
  p.MG()[(size_t)r * 1024 + c] = f2bf(v);
}
DI void skinny_resid_job(const P& p, const bf16_t* A, int lda, const bf16_t* Wt, int K, int job, char* smem) {
  const int rt = job & 7, ct = job >> 3;
  const int r0 = TP + rt * 16, c0 = ct * 16;
  const float v = skinny_dot(A, lda, Wt, K, r0, c0, smem);
  const int tid = tidx();
  p.X()[(size_t)(r0 + (tid >> 4)) * 1024 + c0 + (tid & 15)] += v;
}
DI void skinny_up_job(const P& p, int l, int job, char* smem) {
  const int rt = job & 7, ct = job >> 3;
  const int r0 = TP + rt * 16, c0 = ct * 16;
  const float v = fmaxf(skinny_dot(p.H(), 1024, p.Wt() + (size_t)l * W_LAYER + WO_UP, 1024, r0, c0, smem), 0.f);
  const int tid = tidx();
  p.A2()[(size_t)(r0 + (tid >> 4)) * 4096 + c0 + (tid & 15)] = f2bf(v * v);
}

#define XB_TMO      128
#define XB_XCNT(j)  (256  + 64 * (j))
#define XB_XSUB(j)  (1280 + 64 * (j))
#define XB_XGEN(j)  (2304 + 64 * (j))
#define XB_TOP      3328
#define XB_TOPGEN   3392
#define XCD_BAR_WORDS 3456
#define XB_SPIN_CAP (1u << 20)
#define LAS __attribute__((address_space(3)))
DI unsigned xb_ld(unsigned* p) { return __hip_atomic_load(p, __ATOMIC_RELAXED, __HIP_MEMORY_SCOPE_AGENT); }
DI unsigned xb_add(unsigned* p, unsigned v) { return __hip_atomic_fetch_add(p, v, __ATOMIC_RELAXED, __HIP_MEMORY_SCOPE_AGENT); }
DI unsigned xb_xcc_id() { return (unsigned)__builtin_amdgcn_s_getreg((3 << 11) | 20) & 0xFu; }
#define XB_SPIN(cond, bar) do { unsigned _sp = 0; while (cond) { __builtin_amdgcn_s_sleep(1); \
    if ((++_sp & 255u) == 0u) { if (xb_ld(&(bar)[XB_TMO])) break; if (_sp > XB_SPIN_CAP) { atomicAdd(&(bar)[XB_TMO], 1u); break; } } } } while (0)
struct XcdBarrier { unsigned* bar; unsigned x; volatile LAS unsigned* st; };
DI XcdBarrier xcd_barrier_post(unsigned* bar, volatile LAS unsigned* st) {
  XcdBarrier b; b.bar = bar; b.x = xb_xcc_id(); b.st = st;
  if (threadIdx.x == 0) (void)xb_add(&bar[XB_XCNT(b.x)], 1u);
  return b;
}
DI void xcd_barrier_complete(unsigned* bar, unsigned x, unsigned& nloc, unsigned& nx) {
  const unsigned G = gridDim.x * gridDim.y * gridDim.z;
  unsigned sum, cnt, mine, sp = 0u;
  for (;;) {
    sum = 0u; cnt = 0u; mine = 0u;
#pragma unroll
    for (unsigned j = 0; j < 16; ++j) { const unsigned c = xb_ld(&bar[XB_XCNT(j)]); sum += c; cnt += (c > 0u) ? 1u : 0u; mine = (j == x) ? c : mine; }
    if (sum == G) break;
    __builtin_amdgcn_s_sleep(1);
    if ((++sp & 255u) == 0u) { if (xb_ld(&bar[XB_TMO])) break; if (sp > XB_SPIN_CAP) { atomicAdd(&bar[XB_TMO], 1u); break; } }
  }
  nloc = mine > 0u ? mine : 1u; nx = cnt > 0u ? cnt : 1u;
}
DI void xcd_barrier(const XcdBarrier& b) {
  asm volatile("s_waitcnt vmcnt(0)" ::: "memory");
  __syncthreads();
  if (threadIdx.x == 0) {
    unsigned* bar = b.bar;
    __builtin_amdgcn_s_waitcnt(0);
    unsigned nloc = b.st[0], nx = b.st[1];
    if (nloc == 0u) { xcd_barrier_complete(bar, b.x, nloc, nx); b.st[0] = nloc; b.st[1] = nx; }
    const unsigned old = xb_add(&bar[XB_XSUB(b.x)], 1u);
    const unsigned gen = old / nloc;
    if (old + 1u == (gen + 1u) * nloc) {
      __builtin_amdgcn_fence(__ATOMIC_RELEASE, "agent");
      asm volatile("s_waitcnt vmcnt(0)" ::: "memory");
      const unsigned og = xb_add(&bar[XB_TOP], 1u);
      const unsigned tg = og / nx;
      if (og + 1u == (tg + 1u) * nx) xb_add(&bar[XB_TOPGEN], 1u);
      else XB_SPIN(xb_ld(&bar[XB_TOPGEN]) == tg, bar);
      __builtin_amdgcn_fence(__ATOMIC_ACQUIRE, "agent");
      xb_add(&bar[XB_XGEN(b.x)], 1u);
      asm volatile("s_waitcnt vmcnt(0)" ::: "memory");
    } else {
      XB_SPIN(xb_ld(&bar[XB_XGEN(b.x)]) == gen, bar);
      __builtin_amdgcn_fence(__ATOMIC_ACQUIRE, "agent");
      asm volatile("s_waitcnt vmcnt(0)" ::: "memory");
    }
  }
  __syncthreads();
}

constexpr int NPHASE = 1 + 4 * 11;
DI void phase_jobs(int ph, int& nstd, int& nother) {
  nstd = 0;
  if (ph == 0) { nother = 22144 + 64 + 257 + 4128; return; }
  const int s = (ph - 1) % 11;
  switch (s) {
    case 0: nstd = 129 * 69; nother = 0; break;
    case 1: nother = 2048 + 4096 + 4096 + 512 + 2048 + 512; break;
    case 2: nother = 2048; break;
    case 3: nother = 256 + 32; break;
    case 4: nother = 512 + 4096; break;
    case 5: nstd = 1024; nother = 512; break;
    case 6: nstd = 1024; nother = 512; break;
    case 7: nother = 4128; break;
    case 8: nstd = 4096; nother = 2048; break;
    case 9: nstd = 1024; nother = 512; break;
    default: nother = 4128; break;
  }
}
DI void run_std_job(const P& p, int ph, int job, char* smem) {
  const int l = (ph - 1) / 11, s = (ph - 1) % 11;
  const bf16_t* wl = p.Wt() + (size_t)l * W_LAYER;
  switch (s) {
    case 0: inproj_job(p, l, job, smem); break;
    case 5: merge_job(p, l, job, smem); break;
    case 6: resid_gemm_job(p, p.MG(), 1024, wl + WO_WOUT, 1024, job, smem); break;
    case 8: up_job(p, l, job, smem); break;
    default: resid_gemm_job(p, p.A2(), 4096, wl + WO_DOWN, 4096, job, smem); break;
  }
}
DI void run_job(const P& p, int ph, int job, char* smem) {
  if (ph == 0) {
    if (job < 22144) { prep_weight_job(p, job, smem); return; }
    job -= 22144;
    if (job < 64) { prep_s5_job(p, job); return; }
    job -= 64;
    if (job < 257) { prep_rope_job(p, job); return; }
    job -= 257;
    norm_job(p, job, p.norm1_w, true, false);
    return;
  }
  const int l = (ph - 1) / 11, s = (ph - 1) % 11;
  const bf16_t* wl = p.Wt() + (size_t)l * W_LAYER;
  const int w = __builtin_amdgcn_readfirstlane(tidx() >> 6);
  switch (s) {
    case 1:
      if (job < 2048) { attn_prompt_job(p, l, job, smem); break; }
      job -= 2048;
      if (job < 4096) { conv_job(p, l, job, smem); break; }
      job -= 4096;
      if (job < 4096) { const int wj = job * 4 + w; s5_wave_job(p, l, 0, wj >> 13, wj & 63, (wj >> 6) & 127, nullptr); break; }
      job -= 4096;
      if (job < 512) { ssd_sample_job(p, l, job, smem); break; }
      job -= 512;
      if (job < 2048) { const int wj = job * 4 + w; __syncthreads(); s5_wave_job(p, l, 2, wj >> 6, wj & 63, 0, (bf16_t*)smem + w * 64 * 136); break; }
      job -= 2048;
      attn_sample_job(p, l, job, smem);
      break;
    case 2: ssd_a_job(p, l, job, smem); break;
    case 3:
      if (job < 256) ssd_scan_job(p, l, job);
      else s5_scan_job(p, l, job - 256);
      break;
    case 4:
      if (job < 512) { ssd_c_job(p, l, job, smem); break; }
      job -= 512;
      { const int wj = job * 4 + w; __syncthreads(); s5_wave_job(p, l, 1, wj >> 13, wj & 63, (wj >> 6) & 127, (bf16_t*)smem + w * 64 * 136); }
      break;
    case 5: skinny_merge_job(p, l, job, smem); break;
    case 6: skinny_resid_job(p, p.MG(), 1024, wl + WO_WOUT, 1024, job, smem); break;
    case 7: norm_job(p, job, p.norm2_w + l * 1024, false, false); break;
    case 8: skinny_up_job(p, l, job, smem); break;
    case 9: skinny_resid_job(p, p.A2(), 4096, wl + WO_DOWN, 4096, job, smem); break;
    default:
      if (l == 3) norm_job(p, job, p.final_w, false, true);
      else norm_job(p, job, p.norm1_w + (l + 1) * 1024, false, false);
      break;
  }
}

template <bool COOP>
__global__ void __launch_bounds__(256, 2) mega(P p, int ph0, int ph1) {
  __shared__ __attribute__((aligned(16))) char smem[SMEM_BYTES];
  __shared__ uint4 xb_words;
  XcdBarrier xb;
  if (COOP) {
    if (threadIdx.x == 0) xb_words = make_uint4(0u, 0u, 0u, 0u);
    __syncthreads();
    xb = xcd_barrier_post((unsigned*)(p.ws + WS_BAR), (volatile LAS unsigned*)&xb_words);
  }
  const int G = (int)gridDim.x;
  for (int ph = ph0; ph < ph1; ++ph) {
    int nstd, nother;
    phase_jobs(ph, nstd, nother);
    int reps = 1;
#ifdef PROBE_DUP
    { const int s_ = (ph == 0) ? -1 : (ph - 1) % 11;
      if (PROBE_DUP == 1 && (s_ == 0 || s_ == 5 || s_ == 8)) reps = 2;
      if (PROBE_DUP == 2 && (s_ == 1 || s_ == 2 || s_ == 4)) reps = 2; }
#endif
    const int nstd_r = ((nstd + G - 1) / G) * G;
    for (int rep = 0; rep < reps; ++rep) {
      for (int job = blockIdx.x; job < nstd_r; job += G) run_std_job(p, ph, job, smem);
      for (int job = blockIdx.x; job < nother; job += G) run_job(p, ph, job, smem);
    }
    if (COOP && ph + 1 < ph1) {
      if (ph == ph0) cg::this_grid().sync();
      else xcd_barrier(xb);
    }
  }
}


extern "C" void kernel_launch(void* const* d_in, const int* in_sizes, int n_in, void* d_out, int out_size, void* d_ws, size_t ws_size,
                              hipStream_t stream) {
  P p{};
  const float** pin = (const float**)&p;
  for (int i = 0; i < 33; ++i) pin[i] = (const float*)d_in[i];
  p.out = (float*)d_out;
  p.ws = (char*)d_ws;
  if (WS_TOTAL > ws_size) { fprintf(stderr, "workspace too small: need %zu have %zu\n", (size_t)WS_TOTAL, ws_size); return; }

#if COOP_MODE
  static int grid_blocks = 0;
  if (!grid_blocks) {
    int dev = 0, cus = 0, per_cu = 0;
    hipGetDevice(&dev);
    hipDeviceGetAttribute(&cus, hipDeviceAttributeMultiprocessorCount, dev);
    hipOccupancyMaxActiveBlocksPerMultiprocessor(&per_cu, mega<true>, 256, 0);
    if (per_cu > 2) per_cu = 2;
    if (per_cu < 1) per_cu = 1;
    grid_blocks = cus * per_cu;
  }
  (void)hipMemsetAsync(p.ws + WS_BAR, 0, 4096 * 4, stream);
  int ph0 = 0, ph1 = NPHASE;
  void* args[] = {&p, &ph0, &ph1};
  hipError_t e = hipLaunchCooperativeKernel((void*)mega<true>, dim3(grid_blocks), dim3(256), args, 0, stream);
  if (e != hipSuccess) fprintf(stderr, "cooperative launch failed: %s (grid %d)\n", hipGetErrorString(e), grid_blocks);
#else
  for (int ph = 0; ph < NPHASE; ++ph) mega<false><<<dim3(1024), dim3(256), 0, stream>>>(p, ph, ph + 1);
#endif
}
```

```cpp
#include <hip/hip_runtime.h>
#include <hip/hip_cooperative_groups.h>
#include <cstdio>
#include <cstdint>
namespace cg = cooperative_groups;

#define DI __device__ __forceinline__
typedef unsigned short bf16_t;
typedef short bf16x8 __attribute__((ext_vector_type(8)));
typedef float f32x16 __attribute__((ext_vector_type(16)));
typedef float f32x4 __attribute__((ext_vector_type(4)));
#define MFMA32(a, b, c) __builtin_amdgcn_mfma_f32_32x32x16_bf16((a), (b), (c), 0, 0, 0)
#define MFMA16(a, b, c) __builtin_amdgcn_mfma_f32_16x16x32_bf16((a), (b), (c), 0, 0, 0)

#ifndef COOP_MODE
#define COOP_MODE 1
#endif
#ifndef PROBE_DUP
#define PROBE_DUP 0
#endif

constexpr int TP = 16384, TS = 128, T = TP + TS, SEQ = 8192;
constexpr int NIN = 8720, NINP = 8960;
constexpr int SMEM_BYTES = 73728;
constexpr float EPS = 1e-6f;

constexpr size_t OFF_YP = 0;
constexpr size_t OFF_YS = OFF_YP + (size_t)TP * 1024;
constexpr size_t OFF_SSMP = OFF_YS + (size_t)TS * 1024;
constexpr size_t OFF_SSMS = OFF_SSMP + (size_t)4 * 2 * 16 * 64 * 128;
constexpr size_t OFF_CONVP = OFF_SSMS + (size_t)4 * 128 * 16 * 64 * 128;
constexpr size_t OFF_CONVS = OFF_CONVP + (size_t)4 * 2 * 3 * 2048;
constexpr size_t OFF_S5RP = OFF_CONVS + (size_t)4 * 128 * 3 * 2048;
constexpr size_t OFF_S5RS = OFF_S5RP + (size_t)4 * 2 * 64 * 64;
constexpr size_t OFF_S5IP = OFF_S5RS + (size_t)4 * 128 * 64 * 64;
constexpr size_t OFF_S5IS = OFF_S5IP + (size_t)4 * 2 * 64 * 64;
constexpr size_t OFF_KP = OFF_S5IS + (size_t)4 * 128 * 64 * 64;
constexpr size_t OFF_KS = OFF_KP + (size_t)4 * 2 * 128 * 256;
constexpr size_t OFF_VP = OFF_KS + (size_t)4 * 128 * 128 * 256;
constexpr size_t OFF_VS = OFF_VP + (size_t)4 * 2 * 128 * 256;

constexpr size_t WO_IN = 0;
constexpr size_t WO_MPROJ = WO_IN + (size_t)NINP * 1024;
constexpr size_t WO_GLU = WO_MPROJ + (size_t)1024 * 1024;
constexpr size_t WO_ATTNO = WO_GLU + (size_t)2048 * 1024;
constexpr size_t WO_WOUT = WO_ATTNO + (size_t)1024 * 1024;
constexpr size_t WO_UP = WO_WOUT + (size_t)1024 * 1024;
constexpr size_t WO_DOWN = WO_UP + (size_t)4096 * 1024;
constexpr size_t W_LAYER = WO_DOWN + (size_t)4096 * 1024;

constexpr size_t al256(size_t x) { return (x + 255) & ~(size_t)255; }
constexpr size_t SZ1 = (size_t)T * 1024 * 2;
constexpr size_t WS_X = 0;
constexpr size_t WS_H = WS_X + al256((size_t)T * 1024 * 4);
constexpr size_t WS_Z = WS_H + al256(SZ1);
constexpr size_t WS_U = WS_Z + al256(SZ1);
constexpr size_t WS_Q = WS_U + al256(SZ1);
constexpr size_t WS_YM = WS_Q + al256(SZ1);
constexpr size_t WS_YS = WS_YM + al256(SZ1);
constexpr size_t WS_O = WS_YS + al256(SZ1);
constexpr size_t WS_MG = WS_O + al256(SZ1);
constexpr size_t WS_XBC = WS_MG + al256(SZ1);
constexpr size_t WS_XBT = WS_XBC + al256((size_t)T * 2048 * 2);
constexpr size_t WS_BC = WS_XBT + al256((size_t)1536 * TP * 2);
constexpr size_t WS_A2END = WS_XBC + al256((size_t)T * 4096 * 2);
constexpr size_t WS_BCEND = WS_BC + al256((size_t)TP * 1024 * 2);
constexpr size_t WS_K = WS_A2END > WS_BCEND ? WS_A2END : WS_BCEND;
constexpr size_t WS_VT = WS_K + al256((size_t)T * 256 * 2);
constexpr size_t WS_G = WS_VT + al256((size_t)T * 256 * 2);
constexpr size_t WS_DT = WS_G + al256((size_t)T * 3072 * 2);
constexpr size_t WS_ST = WS_DT + al256((size_t)T * 16 * 4);
constexpr size_t WS_CDEC = WS_ST + al256((size_t)2 * 64 * 16 * 64 * 128 * 4);
constexpr size_t WS_S5S = WS_CDEC + al256((size_t)2 * 64 * 16 * 4);
constexpr size_t WS_S5P = WS_S5S + al256((size_t)2 * 128 * 64 * 64 * 2 * 4);
constexpr size_t WS_ROPE = WS_S5P + al256((size_t)4 * 64 * 36 * 64 * 4);
constexpr size_t WS_WT = WS_ROPE + al256((size_t)8193 * 8 * 8);
constexpr size_t WS_BAR = WS_WT + al256((size_t)4 * W_LAYER * 2);
constexpr size_t WS_HP = WS_BAR + al256(4096 * 4);
constexpr size_t WS_TOTAL = WS_HP + al256((size_t)2 * 64 * 16 * 64 * 128 * 2);

struct P {
  const float *x_prompt, *x_sample, *state_ssm, *state_conv, *s5_sre, *s5_sim, *cache_k, *cache_v;
  const float *norm1_w, *w_in, *conv_w, *conv_b, *dt_bias, *a_log, *m_d, *m_norm_w, *m_proj;
  const float *lam_re, *lam_im, *log_step, *b_re, *b_im, *c_re, *c_im, *s5_d, *glu_w;
  const float *sinks, *attn_o, *w_out, *norm2_w, *mlp_up, *mlp_down, *final_w;
  float* out;
  char* ws;
#define WSACC(name, type, off) __device__ __forceinline__ type* name() const { return (type*)(ws + (off)); }
  WSACC(X, float, WS_X) WSACC(H, bf16_t, WS_H) WSACC(Z, bf16_t, WS_Z) WSACC(U, bf16_t, WS_U) WSACC(Q, bf16_t, WS_Q)
  WSACC(YM, bf16_t, WS_YM) WSACC(YS, bf16_t, WS_YS) WSACC(O, bf16_t, WS_O) WSACC(MG, bf16_t, WS_MG)
  WSACC(XBC, bf16_t, WS_XBC) WSACC(XBT, bf16_t, WS_XBT) WSACC(BC, bf16_t, WS_BC) WSACC(A2, bf16_t, WS_XBC)
  WSACC(K, bf16_t, WS_K) WSACC(VT, bf16_t, WS_VT) WSACC(G, bf16_t, WS_G) WSACC(DT, float, WS_DT) WSACC(ST, float, WS_ST)
  WSACC(CDEC, float, WS_CDEC) WSACC(HP, bf16_t, WS_HP) WSACC(S5S, float, WS_S5S) WSACC(S5P, float, WS_S5P) WSACC(ROPE, float2, WS_ROPE) WSACC(Wt, bf16_t, WS_WT)
#undef WSACC
};

DI bf16_t f2bf(float x) { unsigned u = __float_as_uint(x); u += 0x7fffu + ((u >> 16) & 1u); return (bf16_t)(u >> 16); }
DI float bf2f(bf16_t b) { return __uint_as_float(((unsigned)b) << 16); }
DI unsigned pack2(float a, float b) { return (unsigned)f2bf(a) | ((unsigned)f2bf(b) << 16); }
DI float bflo(unsigned u) { return __uint_as_float(u << 16); }
DI float bfhi(unsigned u) { return __uint_as_float(u & 0xffff0000u); }
DI float silu_f(float x) { return x / (1.f + __expf(-x)); }
DI float sigm_f(float x) { return 1.f / (1.f + __expf(-x)); }
DI float softplus_f(float x) { return x > 20.f ? x : log1pf(expf(x)); }
DI float gelu_tanh(float x) { float y = 0.7978845608028654f * (x + 0.044715f * x * x * x); float t = 1.f - 2.f / (__expf(2.f * y) + 1.f); return 0.5f * x * (1.f + t); }
DI int crow(int i, int lh) { return (i & 3) + 8 * (i >> 2) + 4 * lh; }
DI int launder(int x) { asm volatile("" : "+v"(x)); return x; }
DI int tidx() { int t = __builtin_amdgcn_workitem_id_x(); asm volatile("" : "+v"(t)); return t; }
DI int launder_s(int x) { asm volatile("" : "+s"(x)); return x; }
DI float wave_sum(float v) {
#pragma unroll
  for (int o = 32; o >= 1; o >>= 1) v += __shfl_xor(v, o);
  return v;
}
DI float wave_max(float v) {
#pragma unroll
  for (int o = 32; o >= 1; o >>= 1) v = fmaxf(v, __shfl_xor(v, o));
  return v;
}
DI bf16x8 u4_to_bf8(uint4 v) { return __builtin_bit_cast(bf16x8, v); }
DI void zero16(f32x16& a) {
#pragma unroll
  for (int i = 0; i < 16; ++i) a[i] = 0.f;
}

constexpr int LDT = 40;
constexpr int GNB = 4;
DI void gemm_mainloop(const bf16_t* __restrict__ A, int lda, const bf16_t* __restrict__ B, int ldb, int K,
                      f32x16 (&acc)[2][GNB], char* smem) {
  bf16_t* sa = (bf16_t*)smem;
  bf16_t* sb = sa + 2 * 128 * LDT;
  const int tid = tidx(), lane = tid & 63, w = __builtin_amdgcn_readfirstlane(tid >> 6), wm = w & 1, wn = w >> 1, lr = lane & 31, lh = lane >> 5;
  const int r0 = tid >> 2, ch = (tid & 3) * 8;
  const bf16_t* ap = A + (size_t)r0 * lda + ch;
  const bf16_t* bp = B + (size_t)r0 * ldb + ch;
  uint4 pa0, pa1, pb0, pb1, pb2, pb3;
  uint4 qa0, qa1, qb0, qb1, qb2, qb3;
#define GLOADS(R, k0)                                                                                      \
  R##a0 = *(const uint4*)(ap + (k0)); R##a1 = *(const uint4*)(ap + (size_t)64 * lda + (k0));               \
  R##b0 = *(const uint4*)(bp + (k0)); R##b1 = *(const uint4*)(bp + (size_t)64 * ldb + (k0));               \
  R##b2 = *(const uint4*)(bp + (size_t)128 * ldb + (k0)); R##b3 = *(const uint4*)(bp + (size_t)192 * ldb + (k0));
#define SSTORES(R, bufi)                                                                                   \
  { bf16_t* da = sa + (bufi)*128 * LDT; bf16_t* db = sb + (bufi)*256 * LDT;                                \
    *(uint4*)(da + (r0)*LDT + ch) = R##a0; *(uint4*)(da + (r0 + 64) * LDT + ch) = R##a1;                   \
    *(uint4*)(db + (r0)*LDT + ch) = R##b0; *(uint4*)(db + (r0 + 64) * LDT + ch) = R##b1;                   \
    *(uint4*)(db + (r0 + 128) * LDT + ch) = R##b2; *(uint4*)(db + (r0 + 192) * LDT + ch) = R##b3; }
#define COMPUTE(bufi)                                                                                      \
  { const bf16_t* ca = sa + (bufi)*128 * LDT + (wm * 64 + lr) * LDT + lh * 8;                              \
    const bf16_t* cb = sb + (bufi)*256 * LDT + (wn * 128 + lr) * LDT + lh * 8;                             \
    _Pragma("unroll") for (int kk = 0; kk < 2; ++kk) {                                                     \
      const bf16x8 af0 = *(const bf16x8*)(ca + kk * 16), af1 = *(const bf16x8*)(ca + 32 * LDT + kk * 16);  \
      _Pragma("unroll") for (int ni = 0; ni < GNB; ++ni) {                                                 \
        const bf16x8 bfr = *(const bf16x8*)(cb + ni * 32 * LDT + kk * 16);                                 \
        acc[0][ni] = MFMA32(af0, bfr, acc[0][ni]); acc[1][ni] = MFMA32(af1, bfr, acc[1][ni]); } } }
  const int nk = K >> 5;
  const int klast = (nk - 1) * 32;
  GLOADS(p, 0)
  __syncthreads();
  SSTORES(p, 0)
  GLOADS(p, 32)
  __syncthreads();
  for (int kt = 0; kt < nk; kt += 2) {
    { const int k2 = (kt + 2) * 32; const int k0 = k2 < klast ? k2 : klast; GLOADS(q, k0) }
    COMPUTE(0)
    SSTORES(p, 1)
    __syncthreads();
    { const int k3 = (kt + 3) * 32; const int k0 = k3 < klast ? k3 : klast; GLOADS(p, k0) }
    COMPUTE(1)
    SSTORES(q, 0)
    __syncthreads();
  }
#undef GLOADS
#undef SSTORES
#undef COMPUTE
}
DI bool gemm_tile(int slot, int MT, int NT, int& mt, int& nt) {
  const int G = gridDim.x, nx = G >> 3;
  int J = slot;
  if ((G & 7) == 0) J = (slot / G) * G + (slot & 7) * nx + ((slot % G) >> 3);
  if (J >= MT * NT) return false;
  const int gw = 8 * NT, grp = J / gw, rem = J - grp * gw, fm = grp * 8;
  const int gsz = (MT - fm) < 8 ? (MT - fm) : 8;
  mt = fm + rem % gsz; nt = rem / gsz;
  return true;
}

DI int win_map(int n) {
  if (n < 3072) return n;
  if (n < 8704) return n + 16;
  if (n < 8720) return n - 8704 + 3072;
  return -1;
}
DI void wtrans_tile(const float* __restrict__ src, int N, int K, bf16_t* __restrict__ dst, int kt, int nt, bool inmap, char* smem) {
  float* s = (float*)smem;
  const int tid = tidx();
  __syncthreads();
  const int nn = tid & 63;
  int sc = nt * 64 + nn;
  if (inmap) sc = win_map(sc);
#pragma unroll
  for (int it = 0; it < 16; ++it) {
    const int kk = it * 4 + (tid >> 6);
    s[kk * 65 + nn] = (sc >= 0) ? src[(size_t)(kt * 64 + kk) * N + sc] : 0.f;
  }
  __syncthreads();
#pragma unroll
  for (int it = 0; it < 16; ++it) {
    const int n2 = it * 4 + (tid >> 6), k2 = tid & 63;
    dst[(size_t)(nt * 64 + n2) * K + kt * 64 + k2] = f2bf(s[k2 * 65 + n2]);
  }
}
DI void prep_weight_job(const P& p, int j, char* smem) {
  const int l = j / 5568; int r = j % 5568;
  bf16_t* wl = p.Wt() + (size_t)l * W_LAYER;
  if (r < 2240) { wtrans_tile(p.w_in + (size_t)l * 1024 * NIN, NIN, 1024, wl + WO_IN, r / 140, r % 140, true, smem); return; }
  r -= 2240;
  if (r < 256) { wtrans_tile(p.m_proj + (size_t)l * 1024 * 1024, 1024, 1024, wl + WO_MPROJ, r / 16, r % 16, false, smem); return; }
  r -= 256;
  if (r < 512) { wtrans_tile(p.glu_w + (size_t)l * 1024 * 2048, 2048, 1024, wl + WO_GLU, r / 32, r % 32, false, smem); return; }
  r -= 512;
  if (r < 256) { wtrans_tile(p.attn_o + (size_t)l * 1024 * 1024, 1024, 1024, wl + WO_ATTNO, r / 16, r % 16, false, smem); return; }
  r -= 256;
  if (r < 256) { wtrans_tile(p.w_out + (size_t)l * 1024 * 1024, 1024, 1024, wl + WO_WOUT, r / 16, r % 16, false, smem); return; }
  r -= 256;
  if (r < 1024) { wtrans_tile(p.mlp_up + (size_t)l * 1024 * 4096, 4096, 1024, wl + WO_UP, r / 64, r % 64, false, smem); return; }
  r -= 1024;
  wtrans_tile(p.mlp_down + (size_t)l * 4096 * 1024, 1024, 4096, wl + WO_DOWN, r / 16, r % 16, false, smem);
}
DI void prep_s5_job(const P& p, int j) {
  const int idx = j * 256 + tidx();
  const int n = idx & 63, g = (idx >> 6) & 63, l = idx >> 12;
  const float step = expf(p.log_step[l * 64 + g]);
  const float lr_ = p.lam_re[(l * 64 + g) * 64 + n], li = p.lam_im[(l * 64 + g) * 64 + n];
  const float mag = expf(lr_ * step);
  const float abr = mag * cosf(li * step), abi = mag * sinf(li * step);
  float aqr = abr, aqi = abi;
#pragma unroll
  for (int q = 0; q < 6; ++q) { const float nr2 = aqr * aqr - aqi * aqi, ni2 = 2.f * aqr * aqi; aqr = nr2; aqi = ni2; }
  const float den = lr_ * lr_ + li * li;
  const float nr = abr - 1.0f, ni = abi;
  const float fre = (nr * lr_ + ni * li) / den, fim = (ni * lr_ - nr * li) / den;
  float* o = p.S5P() + ((size_t)(l * 64 + g) * 36) * 64 + n;
  o[0] = abr; o[64] = abi; o[128] = aqr; o[192] = aqi;
  const float* br = p.b_re + ((size_t)(l * 64 + g) * 64 + n) * 16;
  const float* bi = p.b_im + ((size_t)(l * 64 + g) * 64 + n) * 16;
#pragma unroll
  for (int i = 0; i < 16; ++i) {
    const float b_r = br[i], b_i = bi[i];
    o[(4 + i) * 64] = fre * b_r - fim * b_i;
    o[(20 + i) * 64] = fre * b_i + fim * b_r;
  }
}
DI void prep_rope_job(const P& p, int j) {
  const int idx = j * 256 + tidx();
  if (idx >= 8193 * 8) return;
  const int pos = idx >> 3, f = idx & 7;
  const float invf = expf(-(2.0f * (float)f / 16.0f) * logf(500000.0f));
  const float ang = (float)pos * invf;
  p.ROPE()[idx] = make_float2(cosf(ang), sinf(ang));
}

DI void norm_job(const P& p, int job, const float* wgt, bool layer0, bool final_) {
  const int w = __builtin_amdgcn_readfirstlane(tidx() >> 6), lane = tidx() & 63;
  const int r = job * 4 + w;
  const float* src = layer0 ? (r < TP ? p.x_prompt + (size_t)r * 1024 : p.x_sample + (size_t)(r - TP) * 1024) : p.X() + (size_t)r * 1024;
  float4 v[4];
  float ss = 0.f;
#pragma unroll
  for (int q = 0; q < 4; ++q) { v[q] = ((const float4*)src)[lane + 64 * q]; ss += v[q].x * v[q].x + v[q].y * v[q].y + v[q].z * v[q].z + v[q].w * v[q].w; }
  ss = wave_sum(ss);
  const float sc = rsqrtf(ss * (1.f / 1024.f) + EPS);
#pragma unroll
  for (int q = 0; q < 4; ++q) {
    const float4 wv = ((const float4*)wgt)[lane + 64 * q];
    float4 y = make_float4(v[q].x * sc * wv.x, v[q].y * sc * wv.y, v[q].z * sc * wv.z, v[q].w * sc * wv.w);
    if (final_) ((float4*)(p.out + OFF_YP + (size_t)r * 1024))[lane + 64 * q] = y;
    else *(uint2*)(p.H() + (size_t)r * 1024 + (lane + 64 * q) * 4) = make_uint2(pack2(y.x, y.y), pack2(y.z, y.w));
    if (layer0) ((float4*)(p.X() + (size_t)r * 1024))[lane + 64 * q] = v[q];
  }
}

DI void inproj_epi_block(const P& p, int l, int cb, int rbase, int lr, const f32x16& av) {
  if (cb >= NIN) return;
  const int c = cb + lr;
      if (cb < 1024) {
#pragma unroll
        for (int i = 0; i < 16; ++i) { const int r = rbase + (i & 3) + 8 * (i >> 2); p.Z()[(size_t)r * 1024 + c] = f2bf(av[i]); }
      } else if (cb < 3072) {
        const int ch = c - 1024;
#pragma unroll
        for (int i = 0; i < 16; ++i) {
          const int r = rbase + (i & 3) + 8 * (i >> 2);
          const float v = av[i];
          p.XBC()[(size_t)r * 2048 + ch] = f2bf(v);
          if (r >= TP) p.out[OFF_CONVS + ((size_t)(l * 128 + (r - TP)) * 3 + 2) * 2048 + ch] = v;
          else { const int t = r & 8191; if (t >= 8189) p.out[OFF_CONVP + ((size_t)(l * 2 + (r >> 13)) * 3 + (t - 8189)) * 2048 + ch] = v; }
        }
      } else if (cb < 4096) {
#pragma unroll
        for (int i = 0; i < 16; ++i) { const int r = rbase + (i & 3) + 8 * (i >> 2); p.U()[(size_t)r * 1024 + (c - 3072)] = f2bf(av[i]); }
      } else if (cb < 5376) {
        const bool isq = cb < 5120;
        const int cc = isq ? c - 4096 : c - 5120;
        const bool ropeblk = ((cb & 63) == 0);
#pragma unroll
        for (int i = 0; i < 16; ++i) {
          const int r = rbase + (i & 3) + 8 * (i >> 2);
          float v = av[i];
          if (ropeblk) {
            const float pv = __shfl_xor(v, 8);
            if (lr < 16) {
              const int pos = (r >= TP) ? 8192 : (r & 8191);
              const float2 cs = p.ROPE()[pos * 8 + (lr & 7)];
              v = (lr < 8) ? v * cs.x - pv * cs.y : v * cs.x + pv * cs.y;
            }
          }
          if (isq) p.Q()[(size_t)r * 1024 + cc] = f2bf(v);
          else {
            p.K()[(size_t)r * 256 + cc] = f2bf(v);
            if (r >= TP) p.out[OFF_KS + ((size_t)(l * 128 + (r - TP)) * 128 + 127) * 256 + cc] = v;
            else { const int t = r & 8191; if (t >= 8064) p.out[OFF_KP + ((size_t)(l * 2 + (r >> 13)) * 128 + (t - 8064)) * 256 + cc] = v; }
          }
        }
      } else if (cb < 5632) {
        const int cc = c - 5376;
#pragma unroll
        for (int ig = 0; ig < 4; ++ig) {
          const int r0 = rbase + 8 * ig;
          const float v0 = av[4 * ig], v1 = av[4 * ig + 1], v2 = av[4 * ig + 2], v3 = av[4 * ig + 3];
          *(uint2*)(p.VT() + (size_t)cc * T + r0) = make_uint2(pack2(v0, v1), pack2(v2, v3));
#pragma unroll
          for (int jj = 0; jj < 4; ++jj) {
            const int r = r0 + jj;
            const float v = av[4 * ig + jj];
            if (r >= TP) p.out[OFF_VS + ((size_t)(l * 128 + (r - TP)) * 128 + 127) * 256 + cc] = v;
            else { const int t = r & 8191; if (t >= 8064) p.out[OFF_VP + ((size_t)(l * 2 + (r >> 13)) * 128 + (t - 8064)) * 256 + cc] = v; }
          }
        }
      } else if (cb < 8704) {
#pragma unroll
        for (int i = 0; i < 16; ++i) { const int r = rbase + (i & 3) + 8 * (i >> 2); p.G()[(size_t)r * 3072 + (c - 5632)] = f2bf(sigm_f(av[i])); }
      } else {
        if (lr < 16) {
          const float bias = p.dt_bias[l * 16 + lr];
#pragma unroll
          for (int i = 0; i < 16; ++i) { const int r = rbase + (i & 3) + 8 * (i >> 2); p.DT()[(size_t)r * 16 + lr] = softplus_f(av[i] + bias); }
        }
      }
  __builtin_amdgcn_sched_barrier(0);
}
DI void inproj_job(const P& p, int l, int job, char* smem) {
  int mt, nt;
  if (!gemm_tile(job, 129, 35, mt, nt)) return;
  const int m0 = mt * 128, n0 = nt * 256;
  f32x16 acc[2][GNB];
#pragma unroll
  for (int a = 0; a < 2; ++a)
#pragma unroll
    for (int b = 0; b < GNB; ++b) zero16(acc[a][b]);
  gemm_mainloop(p.H() + (size_t)m0 * 1024, 1024, p.Wt() + (size_t)l * W_LAYER + WO_IN + (size_t)n0 * 1024, 1024, 1024, acc, smem);
  const int tid = tidx(), lane = tid & 63, w = __builtin_amdgcn_readfirstlane(tid >> 6), wm = w & 1, wn = w >> 1, lr = lane & 31, lh = lane >> 5;
#define EPI(mi, ni) inproj_epi_block(p, l, n0 + wn * 128 + (ni) * 32, launder(m0 + wm * 64 + (mi) * 32 + 4 * lh), lr, acc[mi][ni]);
  EPI(0, 0) EPI(1, 0) EPI(0, 1) EPI(1, 1) EPI(0, 2) EPI(1, 2) EPI(0, 3) EPI(1, 3)
#undef EPI
}

DI void conv_job(const P& p, int l, int job, char* smem) {
  const int ct = job & 31, tt = job >> 5;
  const int ch0 = ct * 64, tokb = tt * 128;
  bf16_t* sT = (bf16_t*)smem;
  const int tid = tidx();
  const float* cw = p.conv_w + (size_t)l * 4 * 2048;
  __syncthreads();
#pragma unroll
  for (int it = 0; it < 4; ++it) {
    const int item = tid + 256 * it, tl = item >> 3, chk = item & 7, ch = ch0 + chk * 8, row = tokb + tl, t = row & 8191;
    float a[8];
    {
      const float4 b0 = *(const float4*)(p.conv_b + l * 2048 + ch), b1 = *(const float4*)(p.conv_b + l * 2048 + ch + 4);
      a[0] = b0.x; a[1] = b0.y; a[2] = b0.z; a[3] = b0.w; a[4] = b1.x; a[5] = b1.y; a[6] = b1.z; a[7] = b1.w;
    }
#pragma unroll
    for (int j = 0; j < 4; ++j) {
      if (t - 3 + j >= 0) {
        const uint4 rv = *(const uint4*)(p.XBC() + (size_t)(row - 3 + j) * 2048 + ch);
        const float4 w0 = *(const float4*)(cw + j * 2048 + ch), w1 = *(const float4*)(cw + j * 2048 + ch + 4);
        a[0] += bflo(rv.x) * w0.x; a[1] += bfhi(rv.x) * w0.y; a[2] += bflo(rv.y) * w0.z; a[3] += bfhi(rv.y) * w0.w;
        a[4] += bflo(rv.z) * w1.x; a[5] += bfhi(rv.z) * w1.y; a[6] += bflo(rv.w) * w1.z; a[7] += bfhi(rv.w) * w1.w;
      }
    }
#pragma unroll
    for (int j = 0; j < 8; ++j) a[j] = silu_f(a[j]);
    if (ct >= 16) *(uint4*)(p.BC() + (size_t)row * 1024 + (ch - 1024)) = make_uint4(pack2(a[0], a[1]), pack2(a[2], a[3]), pack2(a[4], a[5]), pack2(a[6], a[7]));
    if (ct < 24) {
#pragma unroll
      for (int j = 0; j < 8; ++j) sT[(chk * 8 + j) * 136 + tl] = f2bf(a[j]);
    }
  }
  if (ct < 24) {
    __syncthreads();
#pragma unroll
    for (int it = 0; it < 4; ++it) {
      const int item = tid + 256 * it, r = item >> 4, chk = item & 15;
      *(uint4*)(p.XBT() + (size_t)(ch0 + r) * TP + tokb + chk * 8) = *(const uint4*)(sT + r * 136 + chk * 8);
    }
  }
}

DI void chunk_acum(const P& p, int l, int head, int tok0, float* sAc, float* sDt, float& alast) {
  const int lane = tidx() & 63;
  const float Ah = -expf(p.a_log[l * 16 + head]);
  const float d0 = p.DT()[(size_t)(tok0 + 2 * lane) * 16 + head], d1 = p.DT()[(size_t)(tok0 + 2 * lane + 1) * 16 + head];
  const float a0 = d0 * Ah, a1 = d1 * Ah;
  float s = a0 + a1;
#pragma unroll
  for (int off = 1; off < 64; off <<= 1) { const float tv = __shfl_up(s, off); if (lane >= off) s += tv; }
  const float excl = s - (a0 + a1);
  sAc[2 * lane] = excl + a0; sAc[2 * lane + 1] = s;
  sDt[2 * lane] = d0; sDt[2 * lane + 1] = d1;
  alast = __shfl(s, 63);
}

DI void ssd_a_job(const P& p, int l, int job, char* smem) {
  const int head = job & 15, c = (job >> 4) & 63, b = job >> 10, g = head >> 2;
  const int tok0 = b * SEQ + c * 128;
  bf16_t* sXT = (bf16_t*)smem;
  bf16_t* sBT = sXT + 64 * 136;
  float* sW = (float*)(sBT + 128 * 136);
  float* sAc = sW + 128;
  float* sDt = sAc + 128;
  const int tid = tidx(), lane = tid & 63, w = __builtin_amdgcn_readfirstlane(tid >> 6), lr = lane & 31, lh = lane >> 5;
  __syncthreads();
  if (w == 0) {
    float alast;
    chunk_acum(p, l, head, tok0, sAc, sDt, alast);
    sW[2 * lane] = sDt[2 * lane] * __expf(alast - sAc[2 * lane]);
    sW[2 * lane + 1] = sDt[2 * lane + 1] * __expf(alast - sAc[2 * lane + 1]);
    if (lane == 0) p.CDEC()[(b * 64 + c) * 16 + head] = __expf(alast);
  }
  __syncthreads();
#pragma unroll
  for (int it = 0; it < 4; ++it) {
    const int item = tid + 256 * it, pr = item >> 4, s0 = (item & 15) * 8;
    const uint4 v = *(const uint4*)(p.XBT() + (size_t)(head * 64 + pr) * TP + tok0 + s0);
    const float4 w0 = *(const float4*)(sW + s0), w1 = *(const float4*)(sW + s0 + 4);
    *(uint4*)(sXT + pr * 136 + s0) = make_uint4(pack2(bflo(v.x) * w0.x, bfhi(v.x) * w0.y), pack2(bflo(v.y) * w0.z, bfhi(v.y) * w0.w),
                                                pack2(bflo(v.z) * w1.x, bfhi(v.z) * w1.y), pack2(bflo(v.w) * w1.z, bfhi(v.w) * w1.w));
  }
#pragma unroll
  for (int it = 0; it < 8; ++it) {
    const int item = tid + 256 * it, n = item >> 4, s0 = (item & 15) * 8;
    *(uint4*)(sBT + n * 136 + s0) = *(const uint4*)(p.XBT() + (size_t)(1024 + g * 128 + n) * TP + tok0 + s0);
  }
  __syncthreads();
  const int wp = w & 1, wn = w >> 1;
  f32x16 acc[2];
  zero16(acc[0]); zero16(acc[1]);
#pragma unroll
  for (int kk = 0; kk < 8; ++kk) {
    const bf16x8 af = *(const bf16x8*)(sXT + (wp * 32 + lr) * 136 + kk * 16 + lh * 8);
#pragma unroll
    for (int ni = 0; ni < 2; ++ni) {
      const bf16x8 bfr = *(const bf16x8*)(sBT + (wn * 64 + ni * 32 + lr) * 136 + kk * 16 + lh * 8);
      acc[ni] = MFMA32(af, bfr, acc[ni]);
    }
  }
  float* st = p.ST() + ((size_t)((b * 64 + c) * 16 + head) * 64) * 128;
#pragma unroll
  for (int ni = 0; ni < 2; ++ni)
#pragma unroll
    for (int i = 0; i < 16; ++i) st[(wp * 32 + crow(i, lh)) * 128 + wn * 64 + ni * 32 + lr] = acc[ni][i];
}

DI void ssd_scan_job(const P& p, int l, int job) {
  const int gid = job * 256 + tidx();
  const int b = gid >> 15, rem = gid & 32767, head = rem >> 11;
  float4 h = make_float4(0.f, 0.f, 0.f, 0.f);
  const float4* sp0 = (const float4*)(p.ST() + (size_t)(b * 64) * 131072) + rem;
  uint2* hp0 = (uint2*)(p.HP() + (size_t)(b * 64) * 131072) + rem;
  for (int c0 = 0; c0 < 64; c0 += 8) {
    float4 sv[8];
    float dv[8];
#pragma unroll
    for (int k = 0; k < 8; ++k) { sv[k] = sp0[(size_t)(c0 + k) * 32768]; dv[k] = p.CDEC()[(b * 64 + c0 + k) * 16 + head]; }
#pragma unroll
    for (int k = 0; k < 8; ++k) {
      hp0[(size_t)(c0 + k) * 32768] = make_uint2(pack2(h.x, h.y), pack2(h.z, h.w));
      h.x = h.x * dv[k] + sv[k].x; h.y = h.y * dv[k] + sv[k].y; h.z = h.z * dv[k] + sv[k].z; h.w = h.w * dv[k] + sv[k].w;
    }
  }
  ((float4*)(p.out + OFF_SSMP + (size_t)(l * 2 + b) * 131072))[rem] = h;
}

DI void s5_scan_job(const P& p, int l, int job) {
  const int gid = job * 256 + tidx();
  const int n = gid & 63, g = (gid >> 6) & 63, b = gid >> 12;
  const float* prm = p.S5P() + ((size_t)(l * 64 + g) * 36) * 64 + n;
  const float aqr = prm[128], aqi = prm[192];
  float hr = 0.f, hi = 0.f;
  float2* sp = (float2*)p.S5S() + ((size_t)(b * 128) * 64 + g) * 64 + n;
  for (int c0 = 0; c0 < 128; c0 += 8) {
    float2 sv[8];
#pragma unroll
    for (int k = 0; k < 8; ++k) sv[k] = sp[(size_t)(c0 + k) * 4096];
#pragma unroll
    for (int k = 0; k < 8; ++k) {
      sp[(size_t)(c0 + k) * 4096] = make_float2(hr, hi);
      const float nr = aqr * hr - aqi * hi + sv[k].x, ni = aqr * hi + aqi * hr + sv[k].y;
      hr = nr; hi = ni;
    }
  }
}

DI void ssd_c_job(const P& p, int l, int job, char* smem) {
  const int g = job & 3, c = (job >> 2) & 63, b = job >> 8;
  const int tok0 = b * SEQ + c * 128;
  bf16_t* sC = (bf16_t*)smem;
  bf16_t* sB = sC + 128 * 136;
  float* sAc = (float*)(sB + 128 * 136);
  float* sDt = sAc + 512;
  const int tid = tidx(), lane = tid & 63, w = __builtin_amdgcn_readfirstlane(tid >> 6), lr = lane & 31, lh = lane >> 5, wm = w & 1, wn = w >> 1;
  __syncthreads();
  { float alast; chunk_acum(p, l, g * 4 + w, tok0, sAc + w * 128, sDt + w * 128, alast); }
#pragma unroll
  for (int it = 0; it < 8; ++it) {
    const int item = tid + 256 * it, r = item >> 4, s0 = (item & 15) * 8;
    *(uint4*)(sC + r * 136 + s0) = *(const uint4*)(p.BC() + (size_t)(tok0 + r) * 1024 + 512 + g * 128 + s0);
    *(uint4*)(sB + r * 136 + s0) = *(const uint4*)(p.BC() + (size_t)(tok0 + r) * 1024 + g * 128 + s0);
  }
  __syncthreads();
  f32x16 cb[2][2];
#pragma unroll
  for (int a = 0; a < 2; ++a)
#pragma unroll
    for (int bb = 0; bb < 2; ++bb) zero16(cb[a][bb]);
  if (!(wm == 0 && wn == 1)) {
#pragma unroll
    for (int kk = 0; kk < 8; ++kk) {
      bf16x8 af[2], bfr[2];
#pragma unroll
      for (int mi = 0; mi < 2; ++mi) af[mi] = *(const bf16x8*)(sC + (wm * 64 + mi * 32 + lr) * 136 + kk * 16 + lh * 8);
#pragma unroll
      for (int ni = 0; ni < 2; ++ni) bfr[ni] = *(const bf16x8*)(sB + (wn * 64 + ni * 32 + lr) * 136 + kk * 16 + lh * 8);
#pragma unroll
      for (int mi = 0; mi < 2; ++mi)
#pragma unroll
        for (int ni = 0; ni < 2; ++ni) cb[mi][ni] = MFMA32(af[mi], bfr[ni], cb[mi][ni]);
    }
  }
  __syncthreads();
  bf16_t* sM = sB;
  unsigned cbp[2][2][8];
#pragma unroll
  for (int a = 0; a < 2; ++a)
#pragma unroll
    for (int bb = 0; bb < 2; ++bb)
#pragma unroll
      for (int k = 0; k < 8; ++k) cbp[a][bb][k] = pack2(cb[a][bb][2 * k], cb[a][bb][2 * k + 1]);
  float ss[16];
#pragma unroll
  for (int i = 0; i < 16; ++i) ss[i] = 0.f;
#pragma unroll 1
  for (int hd = 0; hd < 4; ++hd) {
    const int head = g * 4 + hd;
    const float* ac = sAc + hd * 128;
    const float* dtv = sDt + hd * 128;
    const int lrq = launder(lr), lhq = launder(lh);
#pragma unroll
    for (int mi = 0; mi < 2; ++mi)
#pragma unroll
      for (int ni = 0; ni < 2; ++ni) {
        const int s = wn * 64 + ni * 32 + lrq;
        const float as = ac[s], ds = dtv[s];
#pragma unroll
        for (int i = 0; i < 16; ++i) {
          const int t = wm * 64 + mi * 32 + crow(i, lhq);
          const float cv = (i & 1) ? bfhi(cbp[mi][ni][i >> 1]) : bflo(cbp[mi][ni][i >> 1]);
          const float v = (s <= t) ? cv * __expf(ac[t] - as) * ds : 0.f;
          sM[t * 136 + s] = f2bf(v);
        }
        __builtin_amdgcn_sched_barrier(0);
      }
    __syncthreads();
    f32x16 yd[2];
    zero16(yd[0]); zero16(yd[1]);
    {
      const bf16_t* hb = p.HP() + (((size_t)((b * 64 + c) * 16 + head) * 64 + lr) * 128 + lh * 8);
      bf16x8 hf[8][2];
#pragma unroll
      for (int kk = 0; kk < 8; ++kk)
#pragma unroll
        for (int pb = 0; pb < 2; ++pb) hf[kk][pb] = *(const bf16x8*)(hb + (size_t)pb * 32 * 128 + kk * 16);
#pragma unroll
      for (int kk = 0; kk < 8; ++kk) {
        const bf16x8 af = *(const bf16x8*)(sC + (32 * w + lr) * 136 + kk * 16 + lh * 8);
        yd[0] = MFMA32(af, hf[kk][0], yd[0]);
        yd[1] = MFMA32(af, hf[kk][1], yd[1]);
      }
    }
#pragma unroll
    for (int i = 0; i < 16; ++i) {
      const float e = __expf(ac[32 * w + crow(i, lh)]);
      yd[0][i] *= e; yd[1][i] *= e;
    }
    {
      const int nkk = 2 * (w + 1);
      const bf16_t* xb = p.XBT() + (size_t)(head * 64 + lr) * TP + tok0 + lh * 8;
      const bf16_t* am = sM + (32 * w + lr) * 136 + lh * 8;
      bf16x8 x00 = *(const bf16x8*)(xb), x01 = *(const bf16x8*)(xb + (size_t)32 * TP);
      for (int kk = 0; kk < nkk; kk += 2) {
        const bf16x8 x10 = *(const bf16x8*)(xb + (kk + 1) * 16), x11 = *(const bf16x8*)(xb + (size_t)32 * TP + (kk + 1) * 16);
        const bf16x8 a0 = *(const bf16x8*)(am + kk * 16);
        yd[0] = MFMA32(a0, x00, yd[0]);
        yd[1] = MFMA32(a0, x01, yd[1]);
        const int kn = (kk + 2 < nkk) ? kk + 2 : kk;
        x00 = *(const bf16x8*)(xb + kn * 16); x01 = *(const bf16x8*)(xb + (size_t)32 * TP + kn * 16);
        const bf16x8 a1 = *(const bf16x8*)(am + (kk + 1) * 16);
        yd[0] = MFMA32(a1, x10, yd[0]);
        yd[1] = MFMA32(a1, x11, yd[1]);
      }
    }
    const float Dh = p.m_d[l * 16 + head];
#pragma unroll
    for (int pb = 0; pb < 2; ++pb) {
      const int pch = head * 64 + pb * 32 + lr;
#pragma unroll
      for (int ig = 0; ig < 4; ++ig) {
        const int t0 = 32 * w + 8 * ig + 4 * lh;
        const uint2 xr = *(const uint2*)(p.XBT() + (size_t)pch * TP + tok0 + t0);
        const float xs[4] = {bflo(xr.x), bfhi(xr.x), bflo(xr.y), bfhi(xr.y)};
#pragma unroll
        for (int jj = 0; jj < 4; ++jj) {
          const int i = 4 * ig + jj, t = t0 + jj;
          const float y = yd[pb][i] + Dh * xs[jj];
          const float z = bf2f(p.Z()[(size_t)(tok0 + t) * 1024 + pch]);
          const float yg = y * silu_f(z);
          ss[i] += yg * yg;
          p.YM()[(size_t)(tok0 + t) * 1024 + pch] = f2bf(yg);
        }
      }
      __builtin_amdgcn_sched_barrier(0);
    }
    __syncthreads();
  }
#pragma unroll
  for (int i = 0; i < 16; ++i) {
    float v = ss[i];
    v += __shfl_xor(v, 1); v += __shfl_xor(v, 2); v += __shfl_xor(v, 4); v += __shfl_xor(v, 8); v += __shfl_xor(v, 16);
    ss[i] = rsqrtf(v * (1.f / 256.f) + EPS);
  }
  for (int hd = 0; hd < 4; ++hd) {
#pragma unroll
    for (int pb = 0; pb < 2; ++pb) {
      const int pch = (g * 4 + hd) * 64 + pb * 32 + lr;
      const float nw = p.m_norm_w[l * 1024 + pch];
#pragma unroll
      for (int i = 0; i < 16; ++i) {
        const size_t idx = (size_t)(tok0 + 32 * w + crow(i, lh)) * 1024 + pch;
        p.YM()[idx] = f2bf(bf2f(p.YM()[idx]) * ss[i] * nw);
      }
      __builtin_amdgcn_sched_barrier(0);
    }
  }
}

DI void ssd_sample_job(const P& p, int l, int job, char* smem) {
  const int g = job & 3, b = job >> 2;
  float* sx = (float*)smem;
  float* sBv = sx + 256;
  float* sCv = sBv + 128;
  float* sY = sCv + 128;
  float* sRed = sY + 256;
  const int tid = tidx(), lane = tid & 63, w = __builtin_amdgcn_readfirstlane(tid >> 6);
  const int row = TP + b;
  __syncthreads();
#pragma unroll
  for (int it = 0; it < 2; ++it) {
    const int idx = tid + 256 * it;
    const int ch = idx < 256 ? g * 256 + idx : (idx < 384 ? 1024 + g * 128 + (idx - 256) : 1536 + g * 128 + (idx - 384));
    const float* sc = p.state_conv + ((size_t)(l * 128 + b) * 3) * 2048 + ch;
    const float s0 = sc[0], s1 = sc[2048], s2 = sc[4096];
    const float raw = bf2f(p.XBC()[(size_t)row * 2048 + ch]);
    const float* cw = p.conv_w + (size_t)l * 4 * 2048 + ch;
    float v = p.conv_b[l * 2048 + ch] + cw[0] * s0 + cw[2048] * s1 + cw[4096] * s2 + cw[6144] * raw;
    v = silu_f(v);
    sx[idx] = v;
    float* co = p.out + OFF_CONVS + ((size_t)(l * 128 + b) * 3) * 2048 + ch;
    co[0] = s1; co[2048] = s2;
  }
  __syncthreads();
  for (int hd = 0; hd < 4; ++hd) {
    const int head = g * 4 + hd;
    const float dt = p.DT()[(size_t)row * 16 + head];
    const float Ah = -expf(p.a_log[l * 16 + head]);
    const float dA = __expf(dt * Ah);
    const int pp = tid >> 2, nq = (tid & 3) * 32;
    const float xv = sx[hd * 64 + pp];
    const float coef = dt * xv;
    const size_t so = ((((size_t)l * 128 + b) * 16 + head) * 64 + pp) * 128 + nq;
    const float4* h0 = (const float4*)(p.state_ssm + so);
    float4* ho = (float4*)(p.out + OFF_SSMS + so);
    float yacc = 0.f;
#pragma unroll
    for (int q = 0; q < 8; ++q) {
      float4 hv = h0[q];
      const int n = nq + 4 * q;
      hv.x = hv.x * dA + coef * sBv[n]; hv.y = hv.y * dA + coef * sBv[n + 1]; hv.z = hv.z * dA + coef * sBv[n + 2]; hv.w = hv.w * dA + coef * sBv[n + 3];
      yacc += hv.x * sCv[n] + hv.y * sCv[n + 1] + hv.z * sCv[n + 2] + hv.w * sCv[n + 3];
      ho[q] = hv;
    }
    yacc += __shfl_xor(yacc, 1); yacc += __shfl_xor(yacc, 2);
    const float y = yacc + p.m_d[l * 16 + head] * xv;
    const float z = bf2f(p.Z()[(size_t)row * 1024 + head * 64 + pp]);
    if ((tid & 3) == 0) sY[hd * 64 + pp] = y * silu_f(z);
  }
  __syncthreads();
  const float v = sY[tid];
  const float ssq = wave_sum(v * v);
  if (lane == 0) sRed[w] = ssq;
  __syncthreads();
  const float tot = sRed[0] + sRed[1] + sRed[2] + sRed[3];
  const float sc = rsqrtf(tot * (1.f / 256.f) + EPS);
  p.YM()[(size_t)row * 1024 + g * 256 + tid] = f2bf(v * sc * p.m_norm_w[l * 1024 + g * 256 + tid]);
}

DI void s5_wave_job(const P& p, int l, int mode, int b, int g, int c, bf16_t* sH) {
  const int lane = tidx() & 63;
  const float* prm = p.S5P() + ((size_t)(l * 64 + g) * 36) * 64 + lane;
  const float abr = prm[0], abi = prm[64];
  float bbr[16], bbi[16];
#pragma unroll
  for (int i = 0; i < 16; ++i) { bbr[i] = prm[(4 + i) * 64]; bbi[i] = prm[(20 + i) * 64]; }
  float hr = 0.f, hi = 0.f;
  int row0, Q;
  if (mode == 2) {
    row0 = TP + b; Q = 1;
    hr = p.s5_sre[((size_t)(l * 128 + b) * 64 + g) * 64 + lane];
    hi = p.s5_sim[((size_t)(l * 128 + b) * 64 + g) * 64 + lane];
  } else {
    row0 = b * SEQ + c * 64; Q = 64;
    if (mode == 1) {
      const float2 s = *(const float2*)(p.S5S() + (((size_t)(b * 128 + c) * 64 + g) * 64 + lane) * 2);
      hr = s.x; hi = s.y;
    }
  }
  unsigned uw[8];
  {
    uint4 u0 = make_uint4(0u, 0u, 0u, 0u), u1 = u0;
    if (lane < Q) { const uint4* up = (const uint4*)(p.U() + (size_t)(row0 + lane) * 1024 + g * 16); u0 = up[0]; u1 = up[1]; }
    uw[0] = u0.x; uw[1] = u0.y; uw[2] = u0.z; uw[3] = u0.w; uw[4] = u1.x; uw[5] = u1.y; uw[6] = u1.z; uw[7] = u1.w;
  }
  for (int t = 0; t < Q; ++t) {
    float br_ = 0.f, bi_ = 0.f;
#pragma unroll
    for (int k = 0; k < 8; ++k) {
      const unsigned wv = (unsigned)__builtin_amdgcn_readlane((int)uw[k], t);
      const float ua = bflo(wv), ub = bfhi(wv);
      br_ += bbr[2 * k] * ua + bbr[2 * k + 1] * ub;
      bi_ += bbi[2 * k] * ua + bbi[2 * k + 1] * ub;
    }
    const float nr = abr * hr - abi * hi + br_, ni = abr * hi + abi * hr + bi_;
    hr = nr; hi = ni;
    if (mode != 0) { sH[t * 136 + lane] = f2bf(hr); sH[t * 136 + 64 + lane] = f2bf(hi); }
  }
  if (mode == 0) {
    *(float2*)(p.S5S() + (((size_t)(b * 128 + c) * 64 + g) * 64 + lane) * 2) = make_float2(hr, hi);
    return;
  }
  if (mode == 1 && c == 127) {
    p.out[OFF_S5RP + ((size_t)(l * 2 + b) * 64 + g) * 64 + lane] = hr;
    p.out[OFF_S5IP + ((size_t)(l * 2 + b) * 64 + g) * 64 + lane] = hi;
  }
  if (mode == 2) {
    p.out[OFF_S5RS + ((size_t)(l * 128 + b) * 64 + g) * 64 + lane] = hr;
    p.out[OFF_S5IS + ((size_t)(l * 128 + b) * 64 + g) * 64 + lane] = hi;
  }
  const int o = lane & 15, quad = lane >> 4;
  bf16x8 cf[4];
#pragma unroll
  for (int kk = 0; kk < 4; ++kk) {
    const float* cp = ((kk < 2) ? p.c_re : p.c_im) + ((size_t)(l * 64 + g) * 16 + o) * 64 + (kk & 1) * 32 + quad * 8;
    const float4 c0 = ((const float4*)cp)[0], c1 = ((const float4*)cp)[1];
    const float sg = (kk < 2) ? 1.f : -1.f;
    cf[kk] = u4_to_bf8(make_uint4(pack2(sg * c0.x, sg * c0.y), pack2(sg * c0.z, sg * c0.w), pack2(sg * c1.x, sg * c1.y), pack2(sg * c1.z, sg * c1.w)));
  }
  const float dsk = p.s5_d[l * 1024 + g * 16 + o];
  const int nrb = (mode == 2) ? 1 : 4;
  __builtin_amdgcn_fence(__ATOMIC_RELEASE, "wavefront");
  __builtin_amdgcn_wave_barrier();
  __builtin_amdgcn_fence(__ATOMIC_ACQUIRE, "wavefront");
  for (int rb = 0; rb < nrb; ++rb) {
    f32x4 a4 = {0.f, 0.f, 0.f, 0.f};
#pragma unroll
    for (int kk = 0; kk < 4; ++kk) {
      const bf16x8 af = *(const bf16x8*)(sH + (rb * 16 + o) * 136 + kk * 32 + quad * 8);
      a4 = MFMA16(af, cf[kk], a4);
    }
#pragma unroll
    for (int jj = 0; jj < 4; ++jj) {
      const int t = rb * 16 + quad * 4 + jj;
      if (t < Q) {
        const size_t idx = (size_t)(row0 + t) * 1024 + g * 16 + o;
        const float y = a4[jj] + dsk * bf2f(p.U()[idx]);
        p.YS()[idx] = f2bf(gelu_tanh(y));
      }
    }
  }
}

DI void attn_prompt_job(const P& p, int l, int job, char* smem) {
  const int head = job & 15, blk = (job >> 4) & 63, b = job >> 10, kvh = head >> 2;
  bf16_t* sK = (bf16_t*)smem;
  bf16_t* sVt = sK + 256 * 72;
  const int tid = tidx(), lane = tid & 63, w = __builtin_amdgcn_readfirstlane(tid >> 6), lr = lane & 31, lh = lane >> 5;
  const int tokc0 = b * SEQ + blk * 128 - 128;
  __syncthreads();
#pragma unroll
  for (int it = 0; it < 8; ++it) {
    const int item = tid + 256 * it, row = item >> 3, chk = item & 7;
    uint4 v = make_uint4(0u, 0u, 0u, 0u);
    if (blk > 0 || row >= 128) v = *(const uint4*)(p.K() + (size_t)(tokc0 + row) * 256 + kvh * 64 + chk * 8);
    *(uint4*)(sK + row * 72 + chk * 8) = v;
  }
#pragma unroll
  for (int it = 0; it < 8; ++it) {
    const int item = tid + 256 * it, d = item >> 5, chk = item & 31;
    uint4 v = make_uint4(0u, 0u, 0u, 0u);
    if (blk > 0 || chk >= 16) v = *(const uint4*)(p.VT() + (size_t)(kvh * 64 + d) * T + tokc0 + chk * 8);
    *(uint4*)(sVt + d * 264 + chk * 8) = v;
  }
  __syncthreads();
  const int qtok = b * SEQ + blk * 128 + 32 * w + lr;
  bf16x8 qf[4];
#pragma unroll
  for (int kk = 0; kk < 4; ++kk) qf[kk] = *(const bf16x8*)(p.Q() + (size_t)qtok * 1024 + head * 64 + kk * 16 + lh * 8);
  f32x16 st[5];
#pragma unroll
  for (int x = 0; x < 5; ++x) {
    zero16(st[x]);
#pragma unroll
    for (int kk = 0; kk < 4; ++kk) {
      const bf16x8 af = *(const bf16x8*)(sK + (32 * (w + x) + lr) * 72 + kk * 16 + lh * 8);
      st[x] = MFMA32(af, qf[kk], st[x]);
    }
  }
  const float sink = p.sinks[l * 16 + head];
  const int qi = 128 + 32 * w + lr;
  float m = sink;
#pragma unroll
  for (int x = 0; x < 5; ++x)
#pragma unroll
    for (int i = 0; i < 16; ++i) {
      const int kj = 32 * (w + x) + crow(i, lh);
      const bool valid = (kj <= qi) && (kj >= qi - 128) && (blk > 0 || kj >= 128);
      const float s = valid ? st[x][i] * 0.125f : -1e30f;
      st[x][i] = s;
      m = fmaxf(m, s);
    }
  m = fmaxf(m, __shfl_xor(m, 32));
  float sum = 0.f;
#pragma unroll
  for (int x = 0; x < 5; ++x)
#pragma unroll
    for (int i = 0; i < 16; ++i) { const float pv = __expf(st[x][i] - m); st[x][i] = pv; sum += pv; }
  sum += __shfl_xor(sum, 32);
  const float inv = 1.f / (sum + __expf(sink - m));
  f32x16 ot[2];
  zero16(ot[0]); zero16(ot[1]);
#pragma unroll
  for (int x = 0; x < 5; ++x)
#pragma unroll
    for (int s = 0; s < 2; ++s) {
      const uint4 pu = make_uint4(pack2(st[x][8 * s] * inv, st[x][8 * s + 1] * inv), pack2(st[x][8 * s + 2] * inv, st[x][8 * s + 3] * inv),
                                  pack2(st[x][8 * s + 4] * inv, st[x][8 * s + 5] * inv), pack2(st[x][8 * s + 6] * inv, st[x][8 * s + 7] * inv));
      const bf16x8 pf = u4_to_bf8(pu);
#pragma unroll
      for (int pb = 0; pb < 2; ++pb) {
        const bf16_t* vp = sVt + (pb * 32 + lr) * 264 + 32 * (w + x) + 16 * s + 4 * lh;
        const uint2 lo = *(const uint2*)vp, hi2 = *(const uint2*)(vp + 8);
        ot[pb] = MFMA32(u4_to_bf8(make_uint4(lo.x, lo.y, hi2.x, hi2.y)), pf, ot[pb]);
      }
    }
#pragma unroll
  for (int pb = 0; pb < 2; ++pb)
#pragma unroll
    for (int ig = 0; ig < 4; ++ig) {
      const int d0 = pb * 32 + 8 * ig + 4 * lh;
      *(uint2*)(p.O() + (size_t)qtok * 1024 + head * 64 + d0) = make_uint2(pack2(ot[pb][4 * ig], ot[pb][4 * ig + 1]), pack2(ot[pb][4 * ig + 2], ot[pb][4 * ig + 3]));
    }
}

DI void attn_sample_job(const P& p, int l, int job, char* smem) {
  const int kvh = job & 3, b = job >> 2;
  const int tid = tidx(), lane = tid & 63, w = __builtin_amdgcn_readfirstlane(tid >> 6);
  const int head = kvh * 4 + w, row = TP + b;
  float* sQ = (float*)smem;
  float* sP = sQ + 256;
  const size_t cbase = ((size_t)(l * 128 + b) * 128) * 256 + kvh * 64;
  const float4* kc4 = (const float4*)(p.cache_k + cbase);
  const float4* vc4 = (const float4*)(p.cache_v + cbase);
  float4* ko4 = (float4*)(p.out + OFF_KS + cbase);
  float4* vo4 = (float4*)(p.out + OFF_VS + cbase);
  __syncthreads();
  for (int idx = tid; idx < 127 * 16; idx += 256) {
    const int j = idx >> 4, q4 = idx & 15;
    ko4[j * 64 + q4] = kc4[(j + 1) * 64 + q4];
    vo4[j * 64 + q4] = vc4[(j + 1) * 64 + q4];
  }
  const float qd = bf2f(p.Q()[(size_t)row * 1024 + head * 64 + lane]);
  sQ[w * 64 + lane] = qd;
  __syncthreads();
  float s0 = 0.f, s1 = 0.f;
#pragma unroll 4
  for (int d4 = 0; d4 < 16; ++d4) {
    const float4 q4 = ((const float4*)(sQ + w * 64))[d4];
    const float4 k0 = kc4[lane * 64 + d4], k1 = kc4[(lane + 64) * 64 + d4];
    s0 += q4.x * k0.x + q4.y * k0.y + q4.z * k0.z + q4.w * k0.w;
    s1 += q4.x * k1.x + q4.y * k1.y + q4.z * k1.z + q4.w * k1.w;
  }
  s0 *= 0.125f; s1 *= 0.125f;
  const float s2 = wave_sum(qd * bf2f(p.K()[(size_t)row * 256 + kvh * 64 + lane])) * 0.125f;
  const float sink = p.sinks[l * 16 + head];
  float m = fmaxf(fmaxf(s0, s1), fmaxf(s2, sink));
  m = wave_max(m);
  const float p0 = __expf(s0 - m), p1 = __expf(s1 - m), p2 = __expf(s2 - m);
  const float sum = wave_sum(p0 + p1);
  const float inv = 1.f / (sum + p2 + __expf(sink - m));
  sP[w * 132 + lane] = p0 * inv; sP[w * 132 + 64 + lane] = p1 * inv;
  __syncthreads();
  const float* vc = p.cache_v + cbase + lane;
  float o = 0.f;
#pragma unroll 8
  for (int j = 0; j < 128; ++j) o += sP[w * 132 + j] * vc[(size_t)j * 256];
  o += p2 * inv * bf2f(p.VT()[(size_t)(kvh * 64 + lane) * T + row]);
  p.O()[(size_t)row * 1024 + head * 64 + lane] = f2bf(o);
}

template <int PASS>
DI void merge_pass(const P& p, const bf16_t* A, const bf16_t* Wt, int m0, int n0, char* smem) {
  m0 = launder_s(m0); n0 = launder_s(n0);
  const int tid = tidx(), lane = tid & 63, w = __builtin_amdgcn_readfirstlane(tid >> 6), wm = w & 1, wn = w >> 1, lr = lane & 31, lh = lane >> 5;
  f32x16 acc[2][GNB];
#pragma unroll
  for (int a = 0; a < 2; ++a)
#pragma unroll
    for (int b = 0; b < GNB; ++b) zero16(acc[a][b]);
  gemm_mainloop(A + (size_t)m0 * 1024, 1024, Wt + (size_t)n0 * 1024, 1024, 1024, acc, smem);
  m0 = launder_s(m0); n0 = launder_s(n0);
#pragma unroll
  for (int mi = 0; mi < 2; ++mi)
#pragma unroll
    for (int ni = 0; ni < GNB; ++ni) {
      const int c = n0 + wn * 128 + ni * 32 + lr;
#pragma unroll
      for (int i = 0; i < 16; ++i) {
        const int r = m0 + wm * 64 + mi * 32 + crow(i, lh);
        bf16_t* mp = p.MG() + (size_t)r * 1024 + c;
        const float a = acc[mi][ni][i];
        if (PASS == 0) *mp = f2bf(sigm_f(a) * bf2f(p.G()[(size_t)r * 3072 + 1024 + c]));
        else if (PASS == 1) *mp = f2bf(bf2f(*mp) * a);
        else if (PASS == 2) *mp = f2bf(bf2f(*mp) + a * bf2f(p.G()[(size_t)r * 3072 + c]));
        else *mp = f2bf(bf2f(*mp) + a * bf2f(p.G()[(size_t)r * 3072 + 2048 + c]));
      }
    }
}
DI void merge_job(const P& p, int l, int job, char* smem) {
  int mt, nt;
  if (!gemm_tile(job, 128, 4, mt, nt)) return;
  const int m0 = mt * 128, n0 = nt * 256;
  const bf16_t* wl = p.Wt() + (size_t)l * W_LAYER;
  merge_pass<0>(p, p.YS(), wl + WO_GLU + (size_t)1024 * 1024, m0, n0, smem);
  merge_pass<1>(p, p.YS(), wl + WO_GLU, m0, n0, smem);
  merge_pass<2>(p, p.YM(), wl + WO_MPROJ, m0, n0, smem);
  merge_pass<3>(p, p.O(), wl + WO_ATTNO, m0, n0, smem);
}
DI void resid_gemm_job(const P& p, const bf16_t* A, int lda, const bf16_t* Wt, int K, int job, char* smem) {
  int mt, nt;
  if (!gemm_tile(job, 128, 4, mt, nt)) return;
  const int m0 = mt * 128, n0 = nt * 256;
  const int tid = tidx(), lane = tid & 63, w = __builtin_amdgcn_readfirstlane(tid >> 6), wm = w & 1, wn = w >> 1, lr = lane & 31, lh = lane >> 5;
  f32x16 acc[2][GNB];
#pragma unroll
  for (int a = 0; a < 2; ++a)
#pragma unroll
    for (int b = 0; b < GNB; ++b) zero16(acc[a][b]);
  gemm_mainloop(A + (size_t)m0 * lda, lda, Wt + (size_t)n0 * K, K, K, acc, smem);
#pragma unroll
  for (int mi = 0; mi < 2; ++mi)
#pragma unroll
    for (int ni = 0; ni < GNB; ++ni) {
      const int c = n0 + wn * 128 + ni * 32 + lr;
#pragma unroll
      for (int i = 0; i < 16; ++i) {
        const int r = m0 + wm * 64 + mi * 32 + crow(i, lh);
        p.X()[(size_t)r * 1024 + c] += acc[mi][ni][i];
      }
    }
}
DI void up_job(const P& p, int l, int job, char* smem) {
  int mt, nt;
  if (!gemm_tile(job, 128, 16, mt, nt)) return;
  const int m0 = mt * 128, n0 = nt * 256;
  const int tid = tidx(), lane = tid & 63, w = __builtin_amdgcn_readfirstlane(tid >> 6), wm = w & 1, wn = w >> 1, lr = lane & 31, lh = lane >> 5;
  f32x16 acc[2][GNB];
#pragma unroll
  for (int a = 0; a < 2; ++a)
#pragma unroll
    for (int b = 0; b < GNB; ++b) zero16(acc[a][b]);
  gemm_mainloop(p.H() + (size_t)m0 * 1024, 1024, p.Wt() + (size_t)l * W_LAYER + WO_UP + (size_t)n0 * 1024, 1024, 1024, acc, smem);
#pragma unroll
  for (int mi = 0; mi < 2; ++mi)
#pragma unroll
    for (int ni = 0; ni < GNB; ++ni) {
      const int c = n0 + wn * 128 + ni * 32 + lr;
#pragma unroll
      for (int i = 0; i < 16; ++i) {
        const int r = m0 + wm * 64 + mi * 32 + crow(i, lh);
        const float v = fmaxf(acc[mi][ni][i], 0.f);
        p.A2()[(size_t)r * 4096 + c] = f2bf(v * v);
      }
    }
}

DI float skinny_dot(const bf16_t* __restrict__ A, int lda, const bf16_t* __restrict__ Wt, int K, int r0, int c0, char* smem) {
  float* sR = (float*)smem;
  const int tid = tidx(), lane = tid & 63, w = __builtin_amdgcn_readfirstlane(tid >> 6), r = lane & 15, quad = lane >> 4;
  const int kq = K >> 2;
  const bf16_t* ap = A + (size_t)(r0 + r) * lda + w * kq + quad * 8;
  const bf16_t* bp = Wt + (size_t)(c0 + r) * K + w * kq + quad * 8;
  f32x4 acc = {0.f, 0.f, 0.f, 0.f};
#pragma unroll 4
  for (int k = 0; k < kq; k += 32) {
    const bf16x8 a = *(const bf16x8*)(ap + k), b = *(const bf16x8*)(bp + k);
    acc = MFMA16(a, b, acc);
  }
  __syncthreads();
#pragma unroll
  for (int j = 0; j < 4; ++j) sR[w * 256 + (quad * 4 + j) * 16 + r] = acc[j];
  __syncthreads();
  return sR[tid] + sR[256 + tid] + sR[512 + tid] + sR[768 + tid];
}
DI void skinny_merge_job(const P& p, int l, int job, char* smem) {
  const int rt = job & 7, ct = job >> 3;
  const int r0 = TP + rt * 16, c0 = ct * 16;
  const bf16_t* wl = p.Wt() + (size_t)l * W_LAYER;
  const float ag = skinny_dot(p.YS(), 1024, wl + WO_GLU + (size_t)1024 * 1024, 1024, r0, c0, smem);
  const float av = skinny_dot(p.YS(), 1024, wl + WO_GLU, 1024, r0, c0, smem);
  const float am = skinny_dot(p.YM(), 1024, wl + WO_MPROJ, 1024, r0, c0, smem);
  const float aa = skinny_dot(p.O(), 1024, wl + WO_ATTNO, 1024, r0, c0, smem);
  const int tid = tidx(), r = r0 + (tid >> 4), c = c0 + (tid & 15);
  const bf16_t* gp = p.G() + (size_t)r * 3072 + c;
  const float v = bf2f(gp[0]) * am + bf2f(gp[1024]) * av * sigm_f(ag) + bf2f(gp[2048]) * aa;
  p.MG()[(size_t)r * 1024 + c] = f2bf(v);
}
DI void skinny_resid_job(const P& p, const bf16_t* A, int lda, const bf16_t* Wt, int K, int job, char* smem) {
  const int rt = job & 7, ct = job >> 3;
  const int r0 = TP + rt * 16, c0 = ct * 16;
  const float v = skinny_dot(A, lda, Wt, K, r0, c0, smem);
  const int tid = tidx();
  p.X()[(size_t)(r0 + (tid >> 4)) * 1024 + c0 + (tid & 15)] += v;
}
DI void skinny_up_job(const P& p, int l, int job, char* smem) {
  const int rt = job & 7, ct = job >> 3;
  const int r0 = TP + rt * 16, c0 = ct * 16;
  const float v = fmaxf(skinny_dot(p.H(), 1024, p.Wt() + (size_t)l * W_LAYER + WO_UP, 1024, r0, c0, smem), 0.f);
  const int tid = tidx();
  p.A2()[(size_t)(r0 + (tid >> 4)) * 4096 + c0 + (tid & 15)] = f2bf(v * v);
}

#define XB_TMO      128
#define XB_XCNT(j)  (256  + 64 * (j))
#define XB_XSUB(j)  (1280 + 64 * (j))
#define XB_XGEN(j)  (2304 + 64 * (j))
#define XB_TOP      3328
#define XB_TOPGEN   3392
#define XCD_BAR_WORDS 3456
#define XB_SPIN_CAP (1u << 20)
#define LAS __attribute__((address_space(3)))
DI unsigned xb_ld(unsigned* p) { return __hip_atomic_load(p, __ATOMIC_RELAXED, __HIP_MEMORY_SCOPE_AGENT); }
DI unsigned xb_add(unsigned* p, unsigned v) { return __hip_atomic_fetch_add(p, v, __ATOMIC_RELAXED, __HIP_MEMORY_SCOPE_AGENT); }
DI unsigned xb_xcc_id() { return (unsigned)__builtin_amdgcn_s_getreg((3 << 11) | 20) & 0xFu; }
#define XB_SPIN(cond, bar) do { unsigned _sp = 0; while (cond) { __builtin_amdgcn_s_sleep(1); \
    if ((++_sp & 255u) == 0u) { if (xb_ld(&(bar)[XB_TMO])) break; if (_sp > XB_SPIN_CAP) { atomicAdd(&(bar)[XB_TMO], 1u); break; } } } } while (0)
struct XcdBarrier { unsigned* bar; unsigned x; volatile LAS unsigned* st; };
DI XcdBarrier xcd_barrier_post(unsigned* bar, volatile LAS unsigned* st) {
  XcdBarrier b; b.bar = bar; b.x = xb_xcc_id(); b.st = st;
  if (threadIdx.x == 0) (void)xb_add(&bar[XB_XCNT(b.x)], 1u);
  return b;
}
DI void xcd_barrier_complete(unsigned* bar, unsigned x, unsigned& nloc, unsigned& nx) {
  const unsigned G = gridDim.x * gridDim.y * gridDim.z;
  unsigned sum, cnt, mine, sp = 0u;
  for (;;) {
    sum = 0u; cnt = 0u; mine = 0u;
#pragma unroll
    for (unsigned j = 0; j < 16; ++j) { const unsigned c = xb_ld(&bar[XB_XCNT(j)]); sum += c; cnt += (c > 0u) ? 1u : 0u; mine = (j == x) ? c : mine; }
    if (sum == G) break;
    __builtin_amdgcn_s_sleep(1);
    if ((++sp & 255u) == 0u) { if (xb_ld(&bar[XB_TMO])) break; if (sp > XB_SPIN_CAP) { atomicAdd(&bar[XB_TMO], 1u); break; } }
  }
  nloc = mine > 0u ? mine : 1u; nx = cnt > 0u ? cnt : 1u;
}
DI void xcd_barrier(const XcdBarrier& b) {
  asm volatile("s_waitcnt vmcnt(0)" ::: "memory");
  __syncthreads();
  if (threadIdx.x == 0) {
    unsigned* bar = b.bar;
    __builtin_amdgcn_s_waitcnt(0);
    unsigned nloc = b.st[0], nx = b.st[1];
    if (nloc == 0u) { xcd_barrier_complete(bar, b.x, nloc, nx); b.st[0] = nloc; b.st[1] = nx; }
    const unsigned old = xb_add(&bar[XB_XSUB(b.x)], 1u);
    const unsigned gen = old / nloc;
    if (old + 1u == (gen + 1u) * nloc) {
      __builtin_amdgcn_fence(__ATOMIC_RELEASE, "agent");
      asm volatile("s_waitcnt vmcnt(0)" ::: "memory");
      const unsigned og = xb_add(&bar[XB_TOP], 1u);
      const unsigned tg = og / nx;
      if (og + 1u == (tg + 1u) * nx) xb_add(&bar[XB_TOPGEN], 1u);
      else XB_SPIN(xb_ld(&bar[XB_TOPGEN]) == tg, bar);
      __builtin_amdgcn_fence(__ATOMIC_ACQUIRE, "agent");
      xb_add(&bar[XB_XGEN(b.x)], 1u);
      asm volatile("s_waitcnt vmcnt(0)" ::: "memory");
    } else {
      XB_SPIN(xb_ld(&bar[XB_XGEN(b.x)]) == gen, bar);
      __builtin_amdgcn_fence(__ATOMIC_ACQUIRE, "agent");
      asm volatile("s_waitcnt vmcnt(0)" ::: "memory");
    }
  }
  __syncthreads();
}

constexpr int NPHASE = 1 + 4 * 11;
DI void phase_jobs(int ph, int& nstd, int& nother) {
  nstd = 0;
  if (ph == 0) { nother = 22272 + 64 + 257 + 4128; return; }
  const int s = (ph - 1) % 11;
  switch (s) {
    case 0: nstd = 129 * 35; nother = 0; break;
    case 1: nother = 2048 + 4096 + 4096 + 512 + 2048 + 512; break;
    case 2: nother = 2048; break;
    case 3: nother = 256 + 32; break;
    case 4: nother = 512 + 4096; break;
    case 5: nstd = 512; nother = 512; break;
    case 6: nstd = 512; nother = 512; break;
    case 7: nother = 4128; break;
    case 8: nstd = 2048; nother = 2048; break;
    case 9: nstd = 512; nother = 512; break;
    default: nother = 4128; break;
  }
}
DI void run_std_job(const P& p, int ph, int job, char* smem) {
  const int l = (ph - 1) / 11, s = (ph - 1) % 11;
  const bf16_t* wl = p.Wt() + (size_t)l * W_LAYER;
  switch (s) {
    case 0: inproj_job(p, l, job, smem); break;
    case 5: merge_job(p, l, job, smem); break;
    case 6: resid_gemm_job(p, p.MG(), 1024, wl + WO_WOUT, 1024, job, smem); break;
    case 8: up_job(p, l, job, smem); break;
    default: resid_gemm_job(p, p.A2(), 4096, wl + WO_DOWN, 4096, job, smem); break;
  }
}
DI void run_job(const P& p, int ph, int job, char* smem) {
  if (ph == 0) {
    if (job < 22272) { prep_weight_job(p, job, smem); return; }
    job -= 22272;
    if (job < 64) { prep_s5_job(p, job); return; }
    job -= 64;
    if (job < 257) { prep_rope_job(p, job); return; }
    job -= 257;
    norm_job(p, job, p.norm1_w, true, false);
    return;
  }
  const int l = (ph - 1) / 11, s = (ph - 1) % 11;
  const bf16_t* wl = p.Wt() + (size_t)l * W_LAYER;
  const int w = __builtin_amdgcn_readfirstlane(tidx() >> 6);
  switch (s) {
    case 1:
      if (job < 512) { for (int rr = 0; rr < (PROBE_DUP == 11 ? 3 : 1); ++rr) ssd_sample_job(p, l, job, smem); break; }
      job -= 512;
      if (job < 512) { attn_sample_job(p, l, job, smem); break; }
      job -= 512;
      if (job < 2048) { for (int rr = 0; rr < (PROBE_DUP == 8 ? 3 : 1); ++rr) attn_prompt_job(p, l, job, smem); break; }
      job -= 2048;
      if (job < 4096) { for (int rr = 0; rr < (PROBE_DUP == 9 ? 3 : 1); ++rr) conv_job(p, l, job, smem); break; }
      job -= 4096;
      if (job < 4096) { const int wj = job * 4 + w; for (int rr = 0; rr < (PROBE_DUP == 10 ? 3 : 1); ++rr) s5_wave_job(p, l, 0, wj >> 13, wj & 63, (wj >> 6) & 127, nullptr); break; }
      job -= 4096;
      { const int wj = job * 4 + w; __syncthreads(); s5_wave_job(p, l, 2, wj >> 6, wj & 63, 0, (bf16_t*)smem + w * 64 * 136); }
      break;
    case 2: ssd_a_job(p, l, job, smem); break;
    case 3:
      if (job < 256) ssd_scan_job(p, l, job);
      else s5_scan_job(p, l, job - 256);
      break;
    case 4:
      if (job < 512) { ssd_c_job(p, l, job, smem); break; }
      job -= 512;
      { const int wj = job * 4 + w; __syncthreads(); s5_wave_job(p, l, 1, wj >> 13, wj & 63, (wj >> 6) & 127, (bf16_t*)smem + w * 64 * 136); }
      break;
    case 5: skinny_merge_job(p, l, job, smem); break;
    case 6: skinny_resid_job(p, p.MG(), 1024, wl + WO_WOUT, 1024, job, smem); break;
    case 7: norm_job(p, job, p.norm2_w + l * 1024, false, false); break;
    case 8: skinny_up_job(p, l, job, smem); break;
    case 9: skinny_resid_job(p, p.A2(), 4096, wl + WO_DOWN, 4096, job, smem); break;
    default:
      if (l == 3) norm_job(p, job, p.final_w, false, true);
      else norm_job(p, job, p.norm1_w + (l + 1) * 1024, false, false);
      break;
  }
}

template <bool COOP>
__global__ void __launch_bounds__(256, 2) mega(P p, int ph0, int ph1) {
  __shared__ __attribute__((aligned(16))) char smem[SMEM_BYTES];
  __shared__ uint4 xb_words;
  XcdBarrier xb;
  if (COOP) {
    if (threadIdx.x == 0) xb_words = make_uint4(0u, 0u, 0u, 0u);
    __syncthreads();
    xb = xcd_barrier_post((unsigned*)(p.ws + WS_BAR), (volatile LAS unsigned*)&xb_words);
  }
  const int G = (int)gridDim.x;
  for (int ph = ph0; ph < ph1; ++ph) {
    int nstd, nother;
    phase_jobs(ph, nstd, nother);
    int reps = 1;
#if PROBE_DUP
    { const int s_ = (ph == 0) ? -1 : (ph - 1) % 11;
      if (PROBE_DUP == 1 && (s_ == 0 || s_ == 5 || s_ == 8)) reps = 2;
      if (PROBE_DUP == 2 && (s_ == 1 || s_ == 2 || s_ == 4)) reps = 2;
      if (PROBE_DUP == 6 && s_ == 4) reps = 2;
      if (PROBE_DUP == 7 && s_ == 1) reps = 2; }
#endif
    const int nstd_r = ((nstd + G - 1) / G) * G;
    for (int rep = 0; rep < reps; ++rep) {
      for (int job = blockIdx.x; job < nstd_r; job += G) run_std_job(p, ph, job, smem);
      for (int job = blockIdx.x; job < nother; job += G) run_job(p, ph, job, smem);
    }
    if (COOP && ph + 1 < ph1) {
      if (ph == ph0) cg::this_grid().sync();
      else xcd_barrier(xb);
    }
  }
}


extern "C" void kernel_launch(void* const* d_in, const int* in_sizes, int n_in, void* d_out, int out_size, void* d_ws, size_t ws_size,
                              hipStream_t stream) {
  P p{};
  const float** pin = (const float**)&p;
  for (int i = 0; i < 33; ++i) pin[i] = (const float*)d_in[i];
  p.out = (float*)d_out;
  p.ws = (char*)d_ws;
  if (WS_TOTAL > ws_size) { fprintf(stderr, "workspace too small: need %zu have %zu\n", (size_t)WS_TOTAL, ws_size); return; }

#if COOP_MODE
  static int grid_blocks = 0;
  if (!grid_blocks) {
    int dev = 0, cus = 0, per_cu = 0;
    hipGetDevice(&dev);
    hipDeviceGetAttribute(&cus, hipDeviceAttributeMultiprocessorCount, dev);
    hipOccupancyMaxActiveBlocksPerMultiprocessor(&per_cu, mega<true>, 256, 0);
    if (per_cu > 2) per_cu = 2;
    if (per_cu < 1) per_cu = 1;
    grid_blocks = cus * per_cu;
  }
  (void)hipMemsetAsync(p.ws + WS_BAR, 0, 4096 * 4, stream);
  int ph0 = 0, ph1 = NPHASE;
  void* args[] = {&p, &ph0, &ph1};
  hipError_t e = hipLaunchCooperativeKernel((void*)mega<true>, dim3(grid_blocks), dim3(256), args, 0, stream);
  if (e != hipSuccess) fprintf(stderr, "cooperative launch failed: %s (grid %d)\n", hipGetErrorString(e), grid_blocks);
#else
  for (int ph = 0; ph < NPHASE; ++ph) mega<false><<<dim3(1024), dim3(256), 0, stream>>>(p, ph, ph + 1);
#endif
}
```

```cpp
#include <hip/hip_runtime.h>
#include <hip/hip_cooperative_groups.h>
#include <cstdio>
#include <cstdint>
namespace cg = cooperative_groups;

#define DI __device__ __forceinline__
typedef unsigned short bf16_t;
typedef short bf16x8 __attribute__((ext_vector_type(8)));
typedef float f32x16 __attribute__((ext_vector_type(16)));
typedef float f32x4 __attribute__((ext_vector_type(4)));
#define MFMA32(a, b, c) __builtin_amdgcn_mfma_f32_32x32x16_bf16((a), (b), (c), 0, 0, 0)
#define MFMA16(a, b, c) __builtin_amdgcn_mfma_f32_16x16x32_bf16((a), (b), (c), 0, 0, 0)

#ifndef COOP_MODE
#define COOP_MODE 1
#endif
#ifndef PROBE_DUP
#define PROBE_DUP 0
#endif

constexpr int TP = 16384, TS = 128, T = TP + TS, SEQ = 8192;
constexpr int NIN = 8720, NINP = 8960;
constexpr int SMEM_BYTES = 73728;
constexpr float EPS = 1e-6f;

constexpr size_t OFF_YP = 0;
constexpr size_t OFF_YS = OFF_YP + (size_t)TP * 1024;
constexpr size_t OFF_SSMP = OFF_YS + (size_t)TS * 1024;
constexpr size_t OFF_SSMS = OFF_SSMP + (size_t)4 * 2 * 16 * 64 * 128;
constexpr size_t OFF_CONVP = OFF_SSMS + (size_t)4 * 128 * 16 * 64 * 128;
constexpr size_t OFF_CONVS = OFF_CONVP + (size_t)4 * 2 * 3 * 2048;
constexpr size_t OFF_S5RP = OFF_CONVS + (size_t)4 * 128 * 3 * 2048;
constexpr size_t OFF_S5RS = OFF_S5RP + (size_t)4 * 2 * 64 * 64;
constexpr size_t OFF_S5IP = OFF_S5RS + (size_t)4 * 128 * 64 * 64;
constexpr size_t OFF_S5IS = OFF_S5IP + (size_t)4 * 2 * 64 * 64;
constexpr size_t OFF_KP = OFF_S5IS + (size_t)4 * 128 * 64 * 64;
constexpr size_t OFF_KS = OFF_KP + (size_t)4 * 2 * 128 * 256;
constexpr size_t OFF_VP = OFF_KS + (size_t)4 * 128 * 128 * 256;
constexpr size_t OFF_VS = OFF_VP + (size_t)4 * 2 * 128 * 256;

constexpr size_t WO_IN = 0;
constexpr size_t WO_MPROJ = WO_IN + (size_t)NINP * 1024;
constexpr size_t WO_GLU = WO_MPROJ + (size_t)1024 * 1024;
constexpr size_t WO_ATTNO = WO_GLU + (size_t)2048 * 1024;
constexpr size_t WO_WOUT = WO_ATTNO + (size_t)1024 * 1024;
constexpr size_t WO_UP = WO_WOUT + (size_t)1024 * 1024;
constexpr size_t WO_DOWN = WO_UP + (size_t)4096 * 1024;
constexpr size_t W_LAYER = WO_DOWN + (size_t)4096 * 1024;

constexpr size_t al256(size_t x) { return (x + 255) & ~(size_t)255; }
constexpr size_t SZ1 = (size_t)T * 1024 * 2;
constexpr size_t WS_X = 0;
constexpr size_t WS_H = WS_X + al256((size_t)T * 1024 * 4);
constexpr size_t WS_Z = WS_H + al256(SZ1);
constexpr size_t WS_U = WS_Z + al256(SZ1);
constexpr size_t WS_Q = WS_U + al256(SZ1);
constexpr size_t WS_YM = WS_Q + al256(SZ1);
constexpr size_t WS_YS = WS_YM + al256(SZ1);
constexpr size_t WS_O = WS_YS + al256(SZ1);
constexpr size_t WS_MG = WS_O + al256(SZ1);
constexpr size_t WS_XBC = WS_MG + al256(SZ1);
constexpr size_t WS_XBT = WS_XBC + al256((size_t)T * 2048 * 2);
constexpr size_t WS_BC = WS_XBT + al256((size_t)1536 * TP * 2);
constexpr size_t WS_A2END = WS_XBC + al256((size_t)T * 4096 * 2);
constexpr size_t WS_BCEND = WS_BC + al256((size_t)TP * 1024 * 2);
constexpr size_t WS_K = WS_A2END > WS_BCEND ? WS_A2END : WS_BCEND;
constexpr size_t WS_VT = WS_K + al256((size_t)T * 256 * 2);
constexpr size_t WS_G = WS_VT + al256((size_t)T * 256 * 2);
constexpr size_t WS_DT = WS_G + al256((size_t)T * 3072 * 2);
constexpr size_t WS_ST = WS_DT + al256((size_t)T * 16 * 4);
constexpr size_t WS_CDEC = WS_ST + al256((size_t)2 * 64 * 16 * 64 * 128 * 4);
constexpr size_t WS_S5S = WS_CDEC + al256((size_t)2 * 64 * 16 * 4);
constexpr size_t WS_S5P = WS_S5S + al256((size_t)2 * 128 * 64 * 64 * 2 * 4);
constexpr size_t WS_ROPE = WS_S5P + al256((size_t)4 * 64 * 36 * 64 * 4);
constexpr size_t WS_WT = WS_ROPE + al256((size_t)8193 * 8 * 8);
constexpr size_t WS_BAR = WS_WT + al256((size_t)4 * W_LAYER * 2);
constexpr size_t WS_HP = WS_BAR + al256(4096 * 4);
constexpr size_t WS_TOTAL = WS_HP + al256((size_t)2 * 64 * 16 * 64 * 128 * 2);

struct P {
  const float *x_prompt, *x_sample, *state_ssm, *state_conv, *s5_sre, *s5_sim, *cache_k, *cache_v;
  const float *norm1_w, *w_in, *conv_w, *conv_b, *dt_bias, *a_log, *m_d, *m_norm_w, *m_proj;
  const float *lam_re, *lam_im, *log_step, *b_re, *b_im, *c_re, *c_im, *s5_d, *glu_w;
  const float *sinks, *attn_o, *w_out, *norm2_w, *mlp_up, *mlp_down, *final_w;
  float* out;
  char* ws;
#define WSACC(name, type, off) __device__ __forceinline__ type* name() const { return (type*)(ws + (off)); }
  WSACC(X, float, WS_X) WSACC(H, bf16_t, WS_H) WSACC(Z, bf16_t, WS_Z) WSACC(U, bf16_t, WS_U) WSACC(Q, bf16_t, WS_Q)
  WSACC(YM, bf16_t, WS_YM) WSACC(YS, bf16_t, WS_YS) WSACC(O, bf16_t, WS_O) WSACC(MG, bf16_t, WS_MG)
  WSACC(XBC, bf16_t, WS_XBC) WSACC(XBT, bf16_t, WS_XBT) WSACC(BC, bf16_t, WS_BC) WSACC(A2, bf16_t, WS_XBC)
  WSACC(K, bf16_t, WS_K) WSACC(VT, bf16_t, WS_VT) WSACC(G, bf16_t, WS_G) WSACC(DT, float, WS_DT) WSACC(ST, float, WS_ST)
  WSACC(CDEC, float, WS_CDEC) WSACC(HP, bf16_t, WS_HP) WSACC(S5S, float, WS_S5S) WSACC(S5P, float, WS_S5P) WSACC(ROPE, float2, WS_ROPE) WSACC(Wt, bf16_t, WS_WT)
#undef WSACC
};

typedef float f32x2_t __attribute__((ext_vector_type(2)));
typedef __bf16 bf16x2_t __attribute__((ext_vector_type(2)));
DI unsigned pack2(float a, float b) { const f32x2_t v = {a, b}; return __builtin_bit_cast(unsigned, __builtin_convertvector(v, bf16x2_t)); }
DI bf16_t f2bf(float x) { return (bf16_t)(pack2(x, 0.f) & 0xffffu); }
DI float bf2f(bf16_t b) { return __uint_as_float(((unsigned)b) << 16); }
DI float bflo(unsigned u) { return __uint_as_float(u << 16); }
DI float bfhi(unsigned u) { return __uint_as_float(u & 0xffff0000u); }
DI float silu_f(float x) { return x / (1.f + __expf(-x)); }
DI float sigm_f(float x) { return 1.f / (1.f + __expf(-x)); }
DI float softplus_f(float x) { return x > 20.f ? x : log1pf(expf(x)); }
DI float gelu_tanh(float x) { float y = 0.7978845608028654f * (x + 0.044715f * x * x * x); float t = 1.f - 2.f / (__expf(2.f * y) + 1.f); return 0.5f * x * (1.f + t); }
DI int crow(int i, int lh) { return (i & 3) + 8 * (i >> 2) + 4 * lh; }
DI int launder(int x) { asm volatile("" : "+v"(x)); return x; }
DI int tidx() { int t = __builtin_amdgcn_workitem_id_x(); asm volatile("" : "+v"(t)); return t; }
DI int launder_s(int x) { asm volatile("" : "+s"(x)); return x; }
DI float wave_sum(float v) {
#pragma unroll
  for (int o = 32; o >= 1; o >>= 1) v += __shfl_xor(v, o);
  return v;
}
DI float wave_max(float v) {
#pragma unroll
  for (int o = 32; o >= 1; o >>= 1) v = fmaxf(v, __shfl_xor(v, o));
  return v;
}
DI bf16x8 u4_to_bf8(uint4 v) { return __builtin_bit_cast(bf16x8, v); }
DI void zero16(f32x16& a) {
#pragma unroll
  for (int i = 0; i < 16; ++i) a[i] = 0.f;
}

constexpr int LDT = 40;
constexpr int GNB = 4;
DI void gemm_mainloop(const bf16_t* __restrict__ A, int lda, const bf16_t* __restrict__ B, int ldb, int K,
                      f32x16 (&acc)[2][GNB], char* smem) {
  bf16_t* sa = (bf16_t*)smem;
  bf16_t* sb = sa + 2 * 128 * LDT;
  const int tid = tidx(), lane = tid & 63, w = __builtin_amdgcn_readfirstlane(tid >> 6), wm = w & 1, wn = w >> 1, lr = lane & 31, lh = lane >> 5;
  const int r0 = tid >> 2, ch = (tid & 3) * 8;
  const bf16_t* ap = A + (size_t)r0 * lda + ch;
  const bf16_t* bp = B + (size_t)r0 * ldb + ch;
  uint4 pa0, pa1, pb0, pb1, pb2, pb3;
  uint4 qa0, qa1, qb0, qb1, qb2, qb3;
#define GLOADS(R, k0)                                                                                      \
  R##a0 = *(const uint4*)(ap + (k0)); R##a1 = *(const uint4*)(ap + (size_t)64 * lda + (k0));               \
  R##b0 = *(const uint4*)(bp + (k0)); R##b1 = *(const uint4*)(bp + (size_t)64 * ldb + (k0));               \
  R##b2 = *(const uint4*)(bp + (size_t)128 * ldb + (k0)); R##b3 = *(const uint4*)(bp + (size_t)192 * ldb + (k0));
#define SSTORES(R, bufi)                                                                                   \
  { bf16_t* da = sa + (bufi)*128 * LDT; bf16_t* db = sb + (bufi)*256 * LDT;                                \
    *(uint4*)(da + (r0)*LDT + ch) = R##a0; *(uint4*)(da + (r0 + 64) * LDT + ch) = R##a1;                   \
    *(uint4*)(db + (r0)*LDT + ch) = R##b0; *(uint4*)(db + (r0 + 64) * LDT + ch) = R##b1;                   \
    *(uint4*)(db + (r0 + 128) * LDT + ch) = R##b2; *(uint4*)(db + (r0 + 192) * LDT + ch) = R##b3; }
#define COMPUTE(bufi)                                                                                      \
  { const bf16_t* ca = sa + (bufi)*128 * LDT + (wm * 64 + lr) * LDT + lh * 8;                              \
    const bf16_t* cb = sb + (bufi)*256 * LDT + (wn * 128 + lr) * LDT + lh * 8;                             \
    _Pragma("unroll") for (int kk = 0; kk < 2; ++kk) {                                                     \
      const bf16x8 af0 = *(const bf16x8*)(ca + kk * 16), af1 = *(const bf16x8*)(ca + 32 * LDT + kk * 16);  \
      _Pragma("unroll") for (int ni = 0; ni < GNB; ++ni) {                                                 \
        const bf16x8 bfr = *(const bf16x8*)(cb + ni * 32 * LDT + kk * 16);                                 \
        acc[0][ni] = MFMA32(af0, bfr, acc[0][ni]); acc[1][ni] = MFMA32(af1, bfr, acc[1][ni]); } } }
  const int nk = K >> 5;
  const int klast = (nk - 1) * 32;
  GLOADS(p, 0)
  __syncthreads();
  SSTORES(p, 0)
  GLOADS(p, 32)
  __syncthreads();
  for (int kt = 0; kt < nk; kt += 2) {
    { const int k2 = (kt + 2) * 32; const int k0 = k2 < klast ? k2 : klast; GLOADS(q, k0) }
    COMPUTE(0)
    SSTORES(p, 1)
    __syncthreads();
    { const int k3 = (kt + 3) * 32; const int k0 = k3 < klast ? k3 : klast; GLOADS(p, k0) }
    COMPUTE(1)
    SSTORES(q, 0)
    __syncthreads();
  }
#undef GLOADS
#undef SSTORES
#undef COMPUTE
}
DI bool gemm_tile(int slot, int MT, int NT, int& mt, int& nt) {
  const int G = gridDim.x, nx = G >> 3;
  int J = slot;
  if ((G & 7) == 0) J = (slot / G) * G + (slot & 7) * nx + ((slot % G) >> 3);
  if (J >= MT * NT) return false;
  const int gw = 8 * NT, grp = J / gw, rem = J - grp * gw, fm = grp * 8;
  const int gsz = (MT - fm) < 8 ? (MT - fm) : 8;
  mt = fm + rem % gsz; nt = rem / gsz;
  return true;
}

DI int win_map(int n) {
  if (n < 3072) return n;
  if (n < 8704) return n + 16;
  if (n < 8720) return n - 8704 + 3072;
  return -1;
}
DI void wtrans_tile(const float* __restrict__ src, int N, int K, bf16_t* __restrict__ dst, int kt, int nt, bool inmap, char* smem) {
  float* s = (float*)smem;
  const int tid = tidx();
  __syncthreads();
  const int nn = tid & 63;
  int sc = nt * 64 + nn;
  if (inmap) sc = win_map(sc);
#pragma unroll
  for (int it = 0; it < 16; ++it) {
    const int kk = it * 4 + (tid >> 6);
    s[kk * 65 + nn] = (sc >= 0) ? src[(size_t)(kt * 64 + kk) * N + sc] : 0.f;
  }
  __syncthreads();
#pragma unroll
  for (int it = 0; it < 16; ++it) {
    const int n2 = it * 4 + (tid >> 6), k2 = tid & 63;
    dst[(size_t)(nt * 64 + n2) * K + kt * 64 + k2] = f2bf(s[k2 * 65 + n2]);
  }
}
DI void prep_weight_job(const P& p, int j, char* smem) {
  const int l = j / 5568; int r = j % 5568;
  bf16_t* wl = p.Wt() + (size_t)l * W_LAYER;
  if (r < 2240) { wtrans_tile(p.w_in + (size_t)l * 1024 * NIN, NIN, 1024, wl + WO_IN, r / 140, r % 140, true, smem); return; }
  r -= 2240;
  if (r < 256) { wtrans_tile(p.m_proj + (size_t)l * 1024 * 1024, 1024, 1024, wl + WO_MPROJ, r / 16, r % 16, false, smem); return; }
  r -= 256;
  if (r < 512) { wtrans_tile(p.glu_w + (size_t)l * 1024 * 2048, 2048, 1024, wl + WO_GLU, r / 32, r % 32, false, smem); return; }
  r -= 512;
  if (r < 256) { wtrans_tile(p.attn_o + (size_t)l * 1024 * 1024, 1024, 1024, wl + WO_ATTNO, r / 16, r % 16, false, smem); return; }
  r -= 256;
  if (r < 256) { wtrans_tile(p.w_out + (size_t)l * 1024 * 1024, 1024, 1024, wl + WO_WOUT, r / 16, r % 16, false, smem); return; }
  r -= 256;
  if (r < 1024) { wtrans_tile(p.mlp_up + (size_t)l * 1024 * 4096, 4096, 1024, wl + WO_UP, r / 64, r % 64, false, smem); return; }
  r -= 1024;
  wtrans_tile(p.mlp_down + (size_t)l * 4096 * 1024, 1024, 4096, wl + WO_DOWN, r / 16, r % 16, false, smem);
}
DI void prep_s5_job(const P& p, int j) {
  const int idx = j * 256 + tidx();
  const int n = idx & 63, g = (idx >> 6) & 63, l = idx >> 12;
  const float step = expf(p.log_step[l * 64 + g]);
  const float lr_ = p.lam_re[(l * 64 + g) * 64 + n], li = p.lam_im[(l * 64 + g) * 64 + n];
  const float mag = expf(lr_ * step);
  const float abr = mag * cosf(li * step), abi = mag * sinf(li * step);
  float aqr = abr, aqi = abi;
#pragma unroll
  for (int q = 0; q < 6; ++q) { const float nr2 = aqr * aqr - aqi * aqi, ni2 = 2.f * aqr * aqi; aqr = nr2; aqi = ni2; }
  const float den = lr_ * lr_ + li * li;
  const float nr = abr - 1.0f, ni = abi;
  const float fre = (nr * lr_ + ni * li) / den, fim = (ni * lr_ - nr * li) / den;
  float* o = p.S5P() + ((size_t)(l * 64 + g) * 36) * 64 + n;
  o[0] = abr; o[64] = abi; o[128] = aqr; o[192] = aqi;
  const float* br = p.b_re + ((size_t)(l * 64 + g) * 64 + n) * 16;
  const float* bi = p.b_im + ((size_t)(l * 64 + g) * 64 + n) * 16;
#pragma unroll
  for (int i = 0; i < 16; ++i) {
    const float b_r = br[i], b_i = bi[i];
    o[(4 + i) * 64] = fre * b_r - fim * b_i;
    o[(20 + i) * 64] = fre * b_i + fim * b_r;
  }
}
DI void prep_rope_job(const P& p, int j) {
  const int idx = j * 256 + tidx();
  if (idx >= 8193 * 8) return;
  const int pos = idx >> 3, f = idx & 7;
  const float invf = expf(-(2.0f * (float)f / 16.0f) * logf(500000.0f));
  const float ang = (float)pos * invf;
  p.ROPE()[idx] = make_float2(cosf(ang), sinf(ang));
}

DI void norm_job(const P& p, int job, const float* wgt, bool layer0, bool final_) {
  const int w = __builtin_amdgcn_readfirstlane(tidx() >> 6), lane = tidx() & 63;
  const int r = job * 4 + w;
  const float* src = layer0 ? (r < TP ? p.x_prompt + (size_t)r * 1024 : p.x_sample + (size_t)(r - TP) * 1024) : p.X() + (size_t)r * 1024;
  float4 v[4];
  float ss = 0.f;
#pragma unroll
  for (int q = 0; q < 4; ++q) { v[q] = ((const float4*)src)[lane + 64 * q]; ss += v[q].x * v[q].x + v[q].y * v[q].y + v[q].z * v[q].z + v[q].w * v[q].w; }
  ss = wave_sum(ss);
  const float sc = rsqrtf(ss * (1.f / 1024.f) + EPS);
#pragma unroll
  for (int q = 0; q < 4; ++q) {
    const float4 wv = ((const float4*)wgt)[lane + 64 * q];
    float4 y = make_float4(v[q].x * sc * wv.x, v[q].y * sc * wv.y, v[q].z * sc * wv.z, v[q].w * sc * wv.w);
    if (final_) ((float4*)(p.out + OFF_YP + (size_t)r * 1024))[lane + 64 * q] = y;
    else *(uint2*)(p.H() + (size_t)r * 1024 + (lane + 64 * q) * 4) = make_uint2(pack2(y.x, y.y), pack2(y.z, y.w));
    if (layer0) ((float4*)(p.X() + (size_t)r * 1024))[lane + 64 * q] = v[q];
  }
}

constexpr int LDS_T = 264;
DI void stage_tile(bf16_t* sT, const f32x16 (&acc)[2][GNB], int wm, int wn, int lr, int lh) {
#pragma unroll
  for (int mi = 0; mi < 2; ++mi)
#pragma unroll
    for (int ni = 0; ni < GNB; ++ni) {
      bf16_t* d = sT + (wm * 64 + mi * 32 + 4 * lh) * LDS_T + wn * 128 + ni * 32 + lr;
#pragma unroll
      for (int ig = 0; ig < 4; ++ig) {
        const unsigned p01 = pack2(acc[mi][ni][4 * ig], acc[mi][ni][4 * ig + 1]), p23 = pack2(acc[mi][ni][4 * ig + 2], acc[mi][ni][4 * ig + 3]);
        d[(8 * ig) * LDS_T] = (bf16_t)(p01 & 0xffffu); d[(8 * ig + 1) * LDS_T] = (bf16_t)(p01 >> 16);
        d[(8 * ig + 2) * LDS_T] = (bf16_t)(p23 & 0xffffu); d[(8 * ig + 3) * LDS_T] = (bf16_t)(p23 >> 16);
      }
    }
}
DI void tile_writeout(bf16_t* __restrict__ dst, int ld, const bf16_t* sT) {
  const int tid = tidx();
#pragma unroll 4
  for (int it = 0; it < 16; ++it) {
    const int idx = tid + 256 * it, row = idx >> 5, chunk = idx & 31;
    *(uint4*)(dst + (size_t)row * ld + chunk * 8) = *(const uint4*)(sT + row * LDS_T + chunk * 8);
  }
}

DI void inproj_job(const P& p, int l, int job, char* smem) {
  int mt, nt;
  if (!gemm_tile(job, 129, 35, mt, nt)) return;
  int m0 = mt * 128, n0 = nt * 256;
  f32x16 acc[2][GNB];
#pragma unroll
  for (int a = 0; a < 2; ++a)
#pragma unroll
    for (int b = 0; b < GNB; ++b) zero16(acc[a][b]);
  gemm_mainloop(p.H() + (size_t)m0 * 1024, 1024, p.Wt() + (size_t)l * W_LAYER + WO_IN + (size_t)n0 * 1024, 1024, 1024, acc, smem);
  m0 = launder_s(m0); n0 = launder_s(n0);
  nt = launder_s(nt); mt = launder_s(mt);
  const int tid = tidx(), lane = tid & 63, w = __builtin_amdgcn_readfirstlane(tid >> 6), wm = w & 1, wn = w >> 1, lr = lane & 31, lh = lane >> 5;
  bf16_t* sT = (bf16_t*)smem;
  if (nt == 34) {
    if (wn == 0 && lr < 16) {
      const float bias = p.dt_bias[l * 16 + lr];
#pragma unroll
      for (int mi = 0; mi < 2; ++mi)
#pragma unroll
        for (int i = 0; i < 16; ++i) p.DT()[(size_t)(m0 + wm * 64 + mi * 32 + crow(i, lh)) * 16 + lr] = softplus_f(acc[mi][0][i] + bias);
    }
    return;
  }
  if (nt >= 16 && nt <= 20) {
#pragma unroll
    for (int mi = 0; mi < 2; ++mi)
#pragma unroll
      for (int ni = 0; ni < GNB; ni += 2)
#pragma unroll
        for (int i = 0; i < 16; ++i) {
          const float v = acc[mi][ni][i];
          const float pv = __shfl_xor(v, 8);
          if (lr < 16) {
            const int r = m0 + wm * 64 + mi * 32 + crow(i, lh);
            const int pos = (r >= TP) ? 8192 : (r & 8191);
            const float2 cs = p.ROPE()[pos * 8 + (lr & 7)];
            acc[mi][ni][i] = (lr < 8) ? v * cs.x - pv * cs.y : v * cs.x + pv * cs.y;
          }
        }
  }
  if (nt >= 22) {
#pragma unroll
    for (int mi = 0; mi < 2; ++mi)
#pragma unroll
      for (int ni = 0; ni < GNB; ++ni)
#pragma unroll
        for (int i = 0; i < 16; ++i) acc[mi][ni][i] = sigm_f(acc[mi][ni][i]);
  }
  if ((mt == 63 || mt == 127 || mt == 128) && ((nt >= 4 && nt < 12) || nt == 20 || nt == 21)) {
#pragma unroll
    for (int mi = 0; mi < 2; ++mi)
#pragma unroll
      for (int ni = 0; ni < GNB; ++ni) {
        const int cc = (n0 & 255) + wn * 128 + ni * 32 + lr;
        const int rb_ = launder(m0 + wm * 64 + mi * 32 + 4 * lh);
#pragma unroll
        for (int i = 0; i < 16; ++i) {
          const int r = rb_ + (i & 3) + 8 * (i >> 2);
          const float v = acc[mi][ni][i];
          if (nt < 12) {
            const int ch = (n0 - 1024) + cc;
            if (r >= TP) p.out[OFF_CONVS + ((size_t)(l * 128 + (r - TP)) * 3 + 2) * 2048 + ch] = v;
            else { const int t = r & 8191; if (t >= 8189) p.out[OFF_CONVP + ((size_t)(l * 2 + (r >> 13)) * 3 + (t - 8189)) * 2048 + ch] = v; }
          } else {
            const size_t ob = (nt == 20) ? OFF_KS : OFF_VS, obp = (nt == 20) ? OFF_KP : OFF_VP;
            if (r >= TP) p.out[ob + ((size_t)(l * 128 + (r - TP)) * 128 + 127) * 256 + cc] = v;
            else p.out[obp + ((size_t)(l * 2 + (r >> 13)) * 128 + ((r & 8191) - 8064)) * 256 + cc] = v;
          }
        }
        __builtin_amdgcn_sched_barrier(0);
      }
  }
  if (nt == 21) {
#pragma unroll
    for (int mi = 0; mi < 2; ++mi)
#pragma unroll
      for (int ni = 0; ni < GNB; ++ni) {
        bf16_t* d = sT + (wn * 128 + ni * 32 + lr) * 136 + wm * 64 + mi * 32 + 4 * lh;
#pragma unroll
        for (int ig = 0; ig < 4; ++ig)
          *(uint2*)(d + 8 * ig) = make_uint2(pack2(acc[mi][ni][4 * ig], acc[mi][ni][4 * ig + 1]), pack2(acc[mi][ni][4 * ig + 2], acc[mi][ni][4 * ig + 3]));
      }
    __syncthreads();
#pragma unroll 4
    for (int it = 0; it < 16; ++it) {
      const int idx = tid + 256 * it, c = idx >> 4, chunk = idx & 15;
      *(uint4*)(p.VT() + (size_t)c * T + m0 + chunk * 8) = *(const uint4*)(sT + c * 136 + chunk * 8);
    }
    return;
  }
  stage_tile(sT, acc, wm, wn, lr, lh);
  __syncthreads();
  bf16_t* dst; int ld;
  if (nt < 4) { dst = p.Z() + n0; ld = 1024; }
  else if (nt < 12) { dst = p.XBC() + (n0 - 1024); ld = 2048; }
  else if (nt < 16) { dst = p.U() + (n0 - 3072); ld = 1024; }
  else if (nt < 20) { dst = p.Q() + (n0 - 4096); ld = 1024; }
  else if (nt == 20) { dst = p.K(); ld = 256; }
  else { dst = p.G() + (n0 - 5632); ld = 3072; }
  tile_writeout(dst + (size_t)m0 * ld, ld, sT);
}

DI void conv_job(const P& p, int l, int job, char* smem) {
  const int ct = job & 31, tt = job >> 5;
  const int ch0 = ct * 64, tokb = tt * 128;
  bf16_t* sT = (bf16_t*)smem;
  const int tid = tidx();
  const float* cw = p.conv_w + (size_t)l * 4 * 2048;
  __syncthreads();
#pragma unroll
  for (int it = 0; it < 4; ++it) {
    const int item = tid + 256 * it, tl = item >> 3, chk = item & 7, ch = ch0 + chk * 8, row = tokb + tl, t = row & 8191;
    float a[8];
    {
      const float4 b0 = *(const float4*)(p.conv_b + l * 2048 + ch), b1 = *(const float4*)(p.conv_b + l * 2048 + ch + 4);
      a[0] = b0.x; a[1] = b0.y; a[2] = b0.z; a[3] = b0.w; a[4] = b1.x; a[5] = b1.y; a[6] = b1.z; a[7] = b1.w;
    }
#pragma unroll
    for (int j = 0; j < 4; ++j) {
      if (t - 3 + j >= 0) {
        const uint4 rv = *(const uint4*)(p.XBC() + (size_t)(row - 3 + j) * 2048 + ch);
        const float4 w0 = *(const float4*)(cw + j * 2048 + ch), w1 = *(const float4*)(cw + j * 2048 + ch + 4);
        a[0] += bflo(rv.x) * w0.x; a[1] += bfhi(rv.x) * w0.y; a[2] += bflo(rv.y) * w0.z; a[3] += bfhi(rv.y) * w0.w;
        a[4] += bflo(rv.z) * w1.x; a[5] += bfhi(rv.z) * w1.y; a[6] += bflo(rv.w) * w1.z; a[7] += bfhi(rv.w) * w1.w;
      }
    }
#pragma unroll
    for (int j = 0; j < 8; ++j) a[j] = silu_f(a[j]);
    if (ct >= 16) *(uint4*)(p.BC() + (size_t)row * 1024 + (ch - 1024)) = make_uint4(pack2(a[0], a[1]), pack2(a[2], a[3]), pack2(a[4], a[5]), pack2(a[6], a[7]));
    if (ct < 24) {
#pragma unroll
      for (int j = 0; j < 8; ++j) sT[(chk * 8 + j) * 136 + tl] = f2bf(a[j]);
    }
  }
  if (ct < 24) {
    __syncthreads();
#pragma unroll
    for (int it = 0; it < 4; ++it) {
      const int item = tid + 256 * it, r = item >> 4, chk = item & 15;
      *(uint4*)(p.XBT() + (size_t)(ch0 + r) * TP + tokb + chk * 8) = *(const uint4*)(sT + r * 136 + chk * 8);
    }
  }
}

DI void chunk_acum(const P& p, int l, int head, int tok0, float* sAc, float* sDt, float& alast) {
  const int lane = tidx() & 63;
  const float Ah = -expf(p.a_log[l * 16 + head]);
  const float d0 = p.DT()[(size_t)(tok0 + 2 * lane) * 16 + head], d1 = p.DT()[(size_t)(tok0 + 2 * lane + 1) * 16 + head];
  const float a0 = d0 * Ah, a1 = d1 * Ah;
  float s = a0 + a1;
#pragma unroll
  for (int off = 1; off < 64; off <<= 1) { const float tv = __shfl_up(s, off); if (lane >= off) s += tv; }
  const float excl = s - (a0 + a1);
  sAc[2 * lane] = excl + a0; sAc[2 * lane + 1] = s;
  sDt[2 * lane] = d0; sDt[2 * lane + 1] = d1;
  alast = __shfl(s, 63);
}

DI void ssd_a_job(const P& p, int l, int job, char* smem) {
  const int head = job & 15, c = (job >> 4) & 63, b = job >> 10, g = head >> 2;
  const int tok0 = b * SEQ + c * 128;
  bf16_t* sXT = (bf16_t*)smem;
  bf16_t* sBT = sXT + 64 * 136;
  float* sW = (float*)(sBT + 128 * 136);
  float* sAc = sW + 128;
  float* sDt = sAc + 128;
  const int tid = tidx(), lane = tid & 63, w = __builtin_amdgcn_readfirstlane(tid >> 6), lr = lane & 31, lh = lane >> 5;
  __syncthreads();
  if (w == 0) {
    float alast;
    chunk_acum(p, l, head, tok0, sAc, sDt, alast);
    sW[2 * lane] = sDt[2 * lane] * __expf(alast - sAc[2 * lane]);
    sW[2 * lane + 1] = sDt[2 * lane + 1] * __expf(alast - sAc[2 * lane + 1]);
    if (lane == 0) p.CDEC()[(b * 64 + c) * 16 + head] = __expf(alast);
  }
  __syncthreads();
#pragma unroll
  for (int it = 0; it < 4; ++it) {
    const int item = tid + 256 * it, pr = item >> 4, s0 = (item & 15) * 8;
    const uint4 v = *(const uint4*)(p.XBT() + (size_t)(head * 64 + pr) * TP + tok0 + s0);
    const float4 w0 = *(const float4*)(sW + s0), w1 = *(const float4*)(sW + s0 + 4);
    *(uint4*)(sXT + pr * 136 + s0) = make_uint4(pack2(bflo(v.x) * w0.x, bfhi(v.x) * w0.y), pack2(bflo(v.y) * w0.z, bfhi(v.y) * w0.w),
                                                pack2(bflo(v.z) * w1.x, bfhi(v.z) * w1.y), pack2(bflo(v.w) * w1.z, bfhi(v.w) * w1.w));
  }
#pragma unroll
  for (int it = 0; it < 8; ++it) {
    const int item = tid + 256 * it, n = item >> 4, s0 = (item & 15) * 8;
    *(uint4*)(sBT + n * 136 + s0) = *(const uint4*)(p.XBT() + (size_t)(1024 + g * 128 + n) * TP + tok0 + s0);
  }
  __syncthreads();
  const int wp = w & 1, wn = w >> 1;
  f32x16 acc[2];
  zero16(acc[0]); zero16(acc[1]);
#pragma unroll
  for (int kk = 0; kk < 8; ++kk) {
    const bf16x8 af = *(const bf16x8*)(sXT + (wp * 32 + lr) * 136 + kk * 16 + lh * 8);
#pragma unroll
    for (int ni = 0; ni < 2; ++ni) {
      const bf16x8 bfr = *(const bf16x8*)(sBT + (wn * 64 + ni * 32 + lr) * 136 + kk * 16 + lh * 8);
      acc[ni] = MFMA32(af, bfr, acc[ni]);
    }
  }
  float* st = p.ST() + ((size_t)((b * 64 + c) * 16 + head) * 64) * 128;
#pragma unroll
  for (int ni = 0; ni < 2; ++ni)
#pragma unroll
    for (int i = 0; i < 16; ++i) st[(wp * 32 + crow(i, lh)) * 128 + wn * 64 + ni * 32 + lr] = acc[ni][i];
}

DI void ssd_scan_job(const P& p, int l, int job) {
  const int gid = job * 256 + tidx();
  const int b = gid >> 15, rem = gid & 32767, head = rem >> 11;
  float4 h = make_float4(0.f, 0.f, 0.f, 0.f);
  const float4* sp0 = (const float4*)(p.ST() + (size_t)(b * 64) * 131072) + rem;
  uint2* hp0 = (uint2*)(p.HP() + (size_t)(b * 64) * 131072) + rem;
  for (int c0 = 0; c0 < 64; c0 += 8) {
    float4 sv[8];
    float dv[8];
#pragma unroll
    for (int k = 0; k < 8; ++k) { sv[k] = sp0[(size_t)(c0 + k) * 32768]; dv[k] = p.CDEC()[(b * 64 + c0 + k) * 16 + head]; }
#pragma unroll
    for (int k = 0; k < 8; ++k) {
      hp0[(size_t)(c0 + k) * 32768] = make_uint2(pack2(h.x, h.y), pack2(h.z, h.w));
      h.x = h.x * dv[k] + sv[k].x; h.y = h.y * dv[k] + sv[k].y; h.z = h.z * dv[k] + sv[k].z; h.w = h.w * dv[k] + sv[k].w;
    }
  }
  ((float4*)(p.out + OFF_SSMP + (size_t)(l * 2 + b) * 131072))[rem] = h;
}

DI void s5_scan_job(const P& p, int l, int job) {
  const int gid = job * 256 + tidx();
  const int n = gid & 63, g = (gid >> 6) & 63, b = gid >> 12;
  const float* prm = p.S5P() + ((size_t)(l * 64 + g) * 36) * 64 + n;
  const float aqr = prm[128], aqi = prm[192];
  float hr = 0.f, hi = 0.f;
  float2* sp = (float2*)p.S5S() + ((size_t)(b * 128) * 64 + g) * 64 + n;
  for (int c0 = 0; c0 < 128; c0 += 8) {
    float2 sv[8];
#pragma unroll
    for (int k = 0; k < 8; ++k) sv[k] = sp[(size_t)(c0 + k) * 4096];
#pragma unroll
    for (int k = 0; k < 8; ++k) {
      sp[(size_t)(c0 + k) * 4096] = make_float2(hr, hi);
      const float nr = aqr * hr - aqi * hi + sv[k].x, ni = aqr * hi + aqi * hr + sv[k].y;
      hr = nr; hi = ni;
    }
  }
}

DI void ssd_c_job(const P& p, int l, int job, char* smem) {
  const int g = job & 3, c = (job >> 2) & 63, b = job >> 8;
  const int tok0 = b * SEQ + c * 128;
  bf16_t* sC = (bf16_t*)smem;
  bf16_t* sB = sC + 128 * 136;
  float* sAc = (float*)(sB + 128 * 136);
  float* sDt = sAc + 512;
  const int tid = tidx(), lane = tid & 63, w = __builtin_amdgcn_readfirstlane(tid >> 6), lr = lane & 31, lh = lane >> 5, wm = w & 1, wn = w >> 1;
  __syncthreads();
  { float alast; chunk_acum(p, l, g * 4 + w, tok0, sAc + w * 128, sDt + w * 128, alast); }
#pragma unroll
  for (int it = 0; it < 8; ++it) {
    const int item = tid + 256 * it, r = item >> 4, s0 = (item & 15) * 8;
    *(uint4*)(sC + r * 136 + s0) = *(const uint4*)(p.BC() + (size_t)(tok0 + r) * 1024 + 512 + g * 128 + s0);
    *(uint4*)(sB + r * 136 + s0) = *(const uint4*)(p.BC() + (size_t)(tok0 + r) * 1024 + g * 128 + s0);
  }
  __syncthreads();
  f32x16 cb[2][2];
#pragma unroll
  for (int a = 0; a < 2; ++a)
#pragma unroll
    for (int bb = 0; bb < 2; ++bb) zero16(cb[a][bb]);
  if (!(wm == 0 && wn == 1)) {
#pragma unroll
    for (int kk = 0; kk < 8; ++kk) {
      bf16x8 af[2], bfr[2];
#pragma unroll
      for (int mi = 0; mi < 2; ++mi) af[mi] = *(const bf16x8*)(sC + (wm * 64 + mi * 32 + lr) * 136 + kk * 16 + lh * 8);
#pragma unroll
      for (int ni = 0; ni < 2; ++ni) bfr[ni] = *(const bf16x8*)(sB + (wn * 64 + ni * 32 + lr) * 136 + kk * 16 + lh * 8);
#pragma unroll
      for (int mi = 0; mi < 2; ++mi)
#pragma unroll
        for (int ni = 0; ni < 2; ++ni) cb[mi][ni] = MFMA32(af[mi], bfr[ni], cb[mi][ni]);
    }
  }
  __syncthreads();
  bf16_t* sM = sB;
  unsigned cbp[2][2][8];
#pragma unroll
  for (int a = 0; a < 2; ++a)
#pragma unroll
    for (int bb = 0; bb < 2; ++bb)
#pragma unroll
      for (int k = 0; k < 8; ++k) cbp[a][bb][k] = pack2(cb[a][bb][2 * k], cb[a][bb][2 * k + 1]);
  float ss[16];
#pragma unroll
  for (int i = 0; i < 16; ++i) ss[i] = 0.f;
#pragma unroll 1
  for (int hd = 0; hd < 4; ++hd) {
    const int head = g * 4 + hd;
    const float* ac = sAc + hd * 128;
    const float* dtv = sDt + hd * 128;
    const int lrq = launder(lr), lhq = launder(lh);
#pragma unroll
    for (int mi = 0; mi < 2; ++mi)
#pragma unroll
      for (int ni = 0; ni < 2; ++ni) {
        const int s = wn * 64 + ni * 32 + lrq;
        const float as = ac[s], ds = dtv[s];
#pragma unroll
        for (int i = 0; i < 16; ++i) {
          const int t = wm * 64 + mi * 32 + crow(i, lhq);
          const float cv = (i & 1) ? bfhi(cbp[mi][ni][i >> 1]) : bflo(cbp[mi][ni][i >> 1]);
          const float v = (s <= t) ? cv * __expf(ac[t] - as) * ds : 0.f;
          sM[t * 136 + s] = f2bf(v);
        }
        __builtin_amdgcn_sched_barrier(0);
      }
    __syncthreads();
    f32x16 yd[2];
    zero16(yd[0]); zero16(yd[1]);
    {
      const bf16_t* hb = p.HP() + (((size_t)((b * 64 + c) * 16 + head) * 64 + lr) * 128 + lh * 8);
      bf16x8 hf[8][2];
#pragma unroll
      for (int kk = 0; kk < 8; ++kk)
#pragma unroll
        for (int pb = 0; pb < 2; ++pb) hf[kk][pb] = *(const bf16x8*)(hb + (size_t)pb * 32 * 128 + kk * 16);
#pragma unroll
      for (int kk = 0; kk < 8; ++kk) {
        const bf16x8 af = *(const bf16x8*)(sC + (32 * w + lr) * 136 + kk * 16 + lh * 8);
        yd[0] = MFMA32(af, hf[kk][0], yd[0]);
        yd[1] = MFMA32(af, hf[kk][1], yd[1]);
      }
    }
#pragma unroll
    for (int i = 0; i < 16; ++i) {
      const float e = __expf(ac[32 * w + crow(i, lh)]);
      yd[0][i] *= e; yd[1][i] *= e;
    }
    {
      const int nkk = 2 * (w + 1);
      const bf16_t* xb = p.XBT() + (size_t)(head * 64 + lr) * TP + tok0 + lh * 8;
      const bf16_t* am = sM + (32 * w + lr) * 136 + lh * 8;
      bf16x8 x00 = *(const bf16x8*)(xb), x01 = *(const bf16x8*)(xb + (size_t)32 * TP);
      for (int kk = 0; kk < nkk; kk += 2) {
        const bf16x8 x10 = *(const bf16x8*)(xb + (kk + 1) * 16), x11 = *(const bf16x8*)(xb + (size_t)32 * TP + (kk + 1) * 16);
        const bf16x8 a0 = *(const bf16x8*)(am + kk * 16);
        yd[0] = MFMA32(a0, x00, yd[0]);
        yd[1] = MFMA32(a0, x01, yd[1]);
        const int kn = (kk + 2 < nkk) ? kk + 2 : kk;
        x00 = *(const bf16x8*)(xb + kn * 16); x01 = *(const bf16x8*)(xb + (size_t)32 * TP + kn * 16);
        const bf16x8 a1 = *(const bf16x8*)(am + (kk + 1) * 16);
        yd[0] = MFMA32(a1, x10, yd[0]);
        yd[1] = MFMA32(a1, x11, yd[1]);
      }
    }
    const float Dh = p.m_d[l * 16 + head];
#pragma unroll
    for (int pb = 0; pb < 2; ++pb) {
      const int pch = head * 64 + pb * 32 + lr;
#pragma unroll
      for (int ig = 0; ig < 4; ++ig) {
        const int t0 = 32 * w + 8 * ig + 4 * lh;
        const uint2 xr = *(const uint2*)(p.XBT() + (size_t)pch * TP + tok0 + t0);
        const float xs[4] = {bflo(xr.x), bfhi(xr.x), bflo(xr.y), bfhi(xr.y)};
#pragma unroll
        for (int jj = 0; jj < 4; ++jj) {
          const int i = 4 * ig + jj, t = t0 + jj;
          const float y = yd[pb][i] + Dh * xs[jj];
          const float z = bf2f(p.Z()[(size_t)(tok0 + t) * 1024 + pch]);
          const float yg = y * silu_f(z);
          ss[i] += yg * yg;
          p.YM()[(size_t)(tok0 + t) * 1024 + pch] = f2bf(yg);
        }
      }
      __builtin_amdgcn_sched_barrier(0);
    }
    __syncthreads();
  }
#pragma unroll
  for (int i = 0; i < 16; ++i) {
    float v = ss[i];
    v += __shfl_xor(v, 1); v += __shfl_xor(v, 2); v += __shfl_xor(v, 4); v += __shfl_xor(v, 8); v += __shfl_xor(v, 16);
    ss[i] = rsqrtf(v * (1.f / 256.f) + EPS);
  }
  for (int hd = 0; hd < 4; ++hd) {
#pragma unroll
    for (int pb = 0; pb < 2; ++pb) {
      const int pch = (g * 4 + hd) * 64 + pb * 32 + lr;
      const float nw = p.m_norm_w[l * 1024 + pch];
#pragma unroll
      for (int i = 0; i < 16; ++i) {
        const size_t idx = (size_t)(tok0 + 32 * w + crow(i, lh)) * 1024 + pch;
        p.YM()[idx] = f2bf(bf2f(p.YM()[idx]) * ss[i] * nw);
      }
      __builtin_amdgcn_sched_barrier(0);
    }
  }
}

DI void ssd_sample_job(const P& p, int l, int job, char* smem) {
  const int g = job & 3, b = job >> 2;
  float* sx = (float*)smem;
  float* sBv = sx + 256;
  float* sCv = sBv + 128;
  float* sY = sCv + 128;
  float* sRed = sY + 256;
  const int tid = tidx(), lane = tid & 63, w = __builtin_amdgcn_readfirstlane(tid >> 6);
  const int row = TP + b;
  __syncthreads();
#pragma unroll
  for (int it = 0; it < 2; ++it) {
    const int idx = tid + 256 * it;
    const int ch = idx < 256 ? g * 256 + idx : (idx < 384 ? 1024 + g * 128 + (idx - 256) : 1536 + g * 128 + (idx - 384));
    const float* sc = p.state_conv + ((size_t)(l * 128 + b) * 3) * 2048 + ch;
    const float s0 = sc[0], s1 = sc[2048], s2 = sc[4096];
    const float raw = bf2f(p.XBC()[(size_t)row * 2048 + ch]);
    const float* cw = p.conv_w + (size_t)l * 4 * 2048 + ch;
    float v = p.conv_b[l * 2048 + ch] + cw[0] * s0 + cw[2048] * s1 + cw[4096] * s2 + cw[6144] * raw;
    v = silu_f(v);
    sx[idx] = v;
    float* co = p.out + OFF_CONVS + ((size_t)(l * 128 + b) * 3) * 2048 + ch;
    co[0] = s1; co[2048] = s2;
  }
  __syncthreads();
  for (int hd = 0; hd < 4; ++hd) {
    const int head = g * 4 + hd;
    const float dt = p.DT()[(size_t)row * 16 + head];
    const float Ah = -expf(p.a_log[l * 16 + head]);
    const float dA = __expf(dt * Ah);
    const int pp = tid >> 2, nq = (tid & 3) * 32;
    const float xv = sx[hd * 64 + pp];
    const float coef = dt * xv;
    const size_t so = ((((size_t)l * 128 + b) * 16 + head) * 64 + pp) * 128 + nq;
    const float4* h0 = (const float4*)(p.state_ssm + so);
    float4* ho = (float4*)(p.out + OFF_SSMS + so);
    float yacc = 0.f;
#pragma unroll
    for (int q = 0; q < 8; ++q) {
      float4 hv = h0[q];
      const int n = nq + 4 * q;
      hv.x = hv.x * dA + coef * sBv[n]; hv.y = hv.y * dA + coef * sBv[n + 1]; hv.z = hv.z * dA + coef * sBv[n + 2]; hv.w = hv.w * dA + coef * sBv[n + 3];
      yacc += hv.x * sCv[n] + hv.y * sCv[n + 1] + hv.z * sCv[n + 2] + hv.w * sCv[n + 3];
      ho[q] = hv;
    }
    yacc += __shfl_xor(yacc, 1); yacc += __shfl_xor(yacc, 2);
    const float y = yacc + p.m_d[l * 16 + head] * xv;
    const float z = bf2f(p.Z()[(size_t)row * 1024 + head * 64 + pp]);
    if ((tid & 3) == 0) sY[hd * 64 + pp] = y * silu_f(z);
  }
  __syncthreads();
  const float v = sY[tid];
  const float ssq = wave_sum(v * v);
  if (lane == 0) sRed[w] = ssq;
  __syncthreads();
  const float tot = sRed[0] + sRed[1] + sRed[2] + sRed[3];
  const float sc = rsqrtf(tot * (1.f / 256.f) + EPS);
  p.YM()[(size_t)row * 1024 + g * 256 + tid] = f2bf(v * sc * p.m_norm_w[l * 1024 + g * 256 + tid]);
}

DI void s5_wave_job(const P& p, int l, int mode, int b, int g, int c, bf16_t* sH) {
  const int lane = tidx() & 63;
  const float* prm = p.S5P() + ((size_t)(l * 64 + g) * 36) * 64 + lane;
  const float abr = prm[0], abi = prm[64];
  float bbr[16], bbi[16];
#pragma unroll
  for (int i = 0; i < 16; ++i) { bbr[i] = prm[(4 + i) * 64]; bbi[i] = prm[(20 + i) * 64]; }
  float hr = 0.f, hi = 0.f;
  int row0, Q;
  if (mode == 2) {
    row0 = TP + b; Q = 1;
    hr = p.s5_sre[((size_t)(l * 128 + b) * 64 + g) * 64 + lane];
    hi = p.s5_sim[((size_t)(l * 128 + b) * 64 + g) * 64 + lane];
  } else {
    row0 = b * SEQ + c * 64; Q = 64;
    if (mode == 1) {
      const float2 s = *(const float2*)(p.S5S() + (((size_t)(b * 128 + c) * 64 + g) * 64 + lane) * 2);
      hr = s.x; hi = s.y;
    }
  }
  unsigned uw[8];
  {
    uint4 u0 = make_uint4(0u, 0u, 0u, 0u), u1 = u0;
    if (lane < Q) { const uint4* up = (const uint4*)(p.U() + (size_t)(row0 + lane) * 1024 + g * 16); u0 = up[0]; u1 = up[1]; }
    uw[0] = u0.x; uw[1] = u0.y; uw[2] = u0.z; uw[3] = u0.w; uw[4] = u1.x; uw[5] = u1.y; uw[6] = u1.z; uw[7] = u1.w;
  }
  for (int t = 0; t < Q; ++t) {
    float br_ = 0.f, bi_ = 0.f;
#pragma unroll
    for (int k = 0; k < 8; ++k) {
      const unsigned wv = (unsigned)__builtin_amdgcn_readlane((int)uw[k], t);
      const float ua = bflo(wv), ub = bfhi(wv);
      br_ += bbr[2 * k] * ua + bbr[2 * k + 1] * ub;
      bi_ += bbi[2 * k] * ua + bbi[2 * k + 1] * ub;
    }
    const float nr = abr * hr - abi * hi + br_, ni = abr * hi + abi * hr + bi_;
    hr = nr; hi = ni;
    if (mode != 0) { sH[t * 136 + lane] = f2bf(hr); sH[t * 136 + 64 + lane] = f2bf(hi); }
  }
  if (mode == 0) {
    *(float2*)(p.S5S() + (((size_t)(b * 128 + c) * 64 + g) * 64 + lane) * 2) = make_float2(hr, hi);
    return;
  }
  if (mode == 1 && c == 127) {
    p.out[OFF_S5RP + ((size_t)(l * 2 + b) * 64 + g) * 64 + lane] = hr;
    p.out[OFF_S5IP + ((size_t)(l * 2 + b) * 64 + g) * 64 + lane] = hi;
  }
  if (mode == 2) {
    p.out[OFF_S5RS + ((size_t)(l * 128 + b) * 64 + g) * 64 + lane] = hr;
    p.out[OFF_S5IS + ((size_t)(l * 128 + b) * 64 + g) * 64 + lane] = hi;
  }
  const int o = lane & 15, quad = lane >> 4;
  bf16x8 cf[4];
#pragma unroll
  for (int kk = 0; kk < 4; ++kk) {
    const float* cp = ((kk < 2) ? p.c_re : p.c_im) + ((size_t)(l * 64 + g) * 16 + o) * 64 + (kk & 1) * 32 + quad * 8;
    const float4 c0 = ((const float4*)cp)[0], c1 = ((const float4*)cp)[1];
    const float sg = (kk < 2) ? 1.f : -1.f;
    cf[kk] = u4_to_bf8(make_uint4(pack2(sg * c0.x, sg * c0.y), pack2(sg * c0.z, sg * c0.w), pack2(sg * c1.x, sg * c1.y), pack2(sg * c1.z, sg * c1.w)));
  }
  const float dsk = p.s5_d[l * 1024 + g * 16 + o];
  const int nrb = (mode == 2) ? 1 : 4;
  __builtin_amdgcn_fence(__ATOMIC_RELEASE, "wavefront");
  __builtin_amdgcn_wave_barrier();
  __builtin_amdgcn_fence(__ATOMIC_ACQUIRE, "wavefront");
  for (int rb = 0; rb < nrb; ++rb) {
    f32x4 a4 = {0.f, 0.f, 0.f, 0.f};
#pragma unroll
    for (int kk = 0; kk < 4; ++kk) {
      const bf16x8 af = *(const bf16x8*)(sH + (rb * 16 + o) * 136 + kk * 32 + quad * 8);
      a4 = MFMA16(af, cf[kk], a4);
    }
#pragma unroll
    for (int jj = 0; jj < 4; ++jj) {
      const int t = rb * 16 + quad * 4 + jj;
      if (t < Q) {
        const size_t idx = (size_t)(row0 + t) * 1024 + g * 16 + o;
        const float y = a4[jj] + dsk * bf2f(p.U()[idx]);
        p.YS()[idx] = f2bf(gelu_tanh(y));
      }
    }
  }
}

DI void attn_prompt_job(const P& p, int l, int job, char* smem) {
  const int head = job & 15, blk = (job >> 4) & 63, b = job >> 10, kvh = head >> 2;
  bf16_t* sK = (bf16_t*)smem;
  bf16_t* sVt = sK + 256 * 72;
  const int tid = tidx(), lane = tid & 63, w = __builtin_amdgcn_readfirstlane(tid >> 6), lr = lane & 31, lh = lane >> 5;
  const int tokc0 = b * SEQ + blk * 128 - 128;
  __syncthreads();
#pragma unroll
  for (int it = 0; it < 8; ++it) {
    const int item = tid + 256 * it, row = item >> 3, chk = item & 7;
    uint4 v = make_uint4(0u, 0u, 0u, 0u);
    if (blk > 0 || row >= 128) v = *(const uint4*)(p.K() + (size_t)(tokc0 + row) * 256 + kvh * 64 + chk * 8);
    *(uint4*)(sK + row * 72 + chk * 8) = v;
  }
#pragma unroll
  for (int it = 0; it < 8; ++it) {
    const int item = tid + 256 * it, d = item >> 5, chk = item & 31;
    uint4 v = make_uint4(0u, 0u, 0u, 0u);
    if (blk > 0 || chk >= 16) v = *(const uint4*)(p.VT() + (size_t)(kvh * 64 + d) * T + tokc0 + chk * 8);
    *(uint4*)(sVt + d * 264 + chk * 8) = v;
  }
  __syncthreads();
  const int qtok = b * SEQ + blk * 128 + 32 * w + lr;
  bf16x8 qf[4];
#pragma unroll
  for (int kk = 0; kk < 4; ++kk) qf[kk] = *(const bf16x8*)(p.Q() + (size_t)qtok * 1024 + head * 64 + kk * 16 + lh * 8);
  f32x16 st[5];
#pragma unroll
  for (int x = 0; x < 5; ++x) {
    zero16(st[x]);
#pragma unroll
    for (int kk = 0; kk < 4; ++kk) {
      const bf16x8 af = *(const bf16x8*)(sK + (32 * (w + x) + lr) * 72 + kk * 16 + lh * 8);
      st[x] = MFMA32(af, qf[kk], st[x]);
    }
  }
  const float sink = p.sinks[l * 16 + head];
  const int qi = 128 + 32 * w + lr;
  float m = sink;
#pragma unroll
  for (int x = 0; x < 5; ++x)
#pragma unroll
    for (int i = 0; i < 16; ++i) {
      const int kj = 32 * (w + x) + crow(i, lh);
      const bool valid = (kj <= qi) && (kj >= qi - 128) && (blk > 0 || kj >= 128);
      const float s = valid ? st[x][i] * 0.125f : -1e30f;
      st[x][i] = s;
      m = fmaxf(m, s);
    }
  m = fmaxf(m, __shfl_xor(m, 32));
  float sum = 0.f;
#pragma unroll
  for (int x = 0; x < 5; ++x)
#pragma unroll
    for (int i = 0; i < 16; ++i) { const float pv = __expf(st[x][i] - m); st[x][i] = pv; sum += pv; }
  sum += __shfl_xor(sum, 32);
  const float inv = 1.f / (sum + __expf(sink - m));
  f32x16 ot[2];
  zero16(ot[0]); zero16(ot[1]);
#pragma unroll
  for (int x = 0; x < 5; ++x)
#pragma unroll
    for (int s = 0; s < 2; ++s) {
      const uint4 pu = make_uint4(pack2(st[x][8 * s] * inv, st[x][8 * s + 1] * inv), pack2(st[x][8 * s + 2] * inv, st[x][8 * s + 3] * inv),
                                  pack2(st[x][8 * s + 4] * inv, st[x][8 * s + 5] * inv), pack2(st[x][8 * s + 6] * inv, st[x][8 * s + 7] * inv));
      const bf16x8 pf = u4_to_bf8(pu);
#pragma unroll
      for (int pb = 0; pb < 2; ++pb) {
        const bf16_t* vp = sVt + (pb * 32 + lr) * 264 + 32 * (w + x) + 16 * s + 4 * lh;
        const uint2 lo = *(const uint2*)vp, hi2 = *(const uint2*)(vp + 8);
        ot[pb] = MFMA32(u4_to_bf8(make_uint4(lo.x, lo.y, hi2.x, hi2.y)), pf, ot[pb]);
      }
    }
#pragma unroll
  for (int pb = 0; pb < 2; ++pb)
#pragma unroll
    for (int ig = 0; ig < 4; ++ig) {
      const int d0 = pb * 32 + 8 * ig + 4 * lh;
      *(uint2*)(p.O() + (size_t)qtok * 1024 + head * 64 + d0) = make_uint2(pack2(ot[pb][4 * ig], ot[pb][4 * ig + 1]), pack2(ot[pb][4 * ig + 2], ot[pb][4 * ig + 3]));
    }
}

DI void attn_sample_job(const P& p, int l, int job, char* smem) {
  const int kvh = job & 3, b = job >> 2;
  const int tid = tidx(), lane = tid & 63, w = __builtin_amdgcn_readfirstlane(tid >> 6);
  const int head = kvh * 4 + w, row = TP + b;
  float* sQ = (float*)smem;
  float* sP = sQ + 256;
  const size_t cbase = ((size_t)(l * 128 + b) * 128) * 256 + kvh * 64;
  const float4* kc4 = (const float4*)(p.cache_k + cbase);
  const float4* vc4 = (const float4*)(p.cache_v + cbase);
  float4* ko4 = (float4*)(p.out + OFF_KS + cbase);
  float4* vo4 = (float4*)(p.out + OFF_VS + cbase);
  __syncthreads();
  for (int idx = tid; idx < 127 * 16; idx += 256) {
    const int j = idx >> 4, q4 = idx & 15;
    ko4[j * 64 + q4] = kc4[(j + 1) * 64 + q4];
    vo4[j * 64 + q4] = vc4[(j + 1) * 64 + q4];
  }
  const float qd = bf2f(p.Q()[(size_t)row * 1024 + head * 64 + lane]);
  sQ[w * 64 + lane] = qd;
  __syncthreads();
  float s0 = 0.f, s1 = 0.f;
#pragma unroll 4
  for (int d4 = 0; d4 < 16; ++d4) {
    const float4 q4 = ((const float4*)(sQ + w * 64))[d4];
    const float4 k0 = kc4[lane * 64 + d4], k1 = kc4[(lane + 64) * 64 + d4];
    s0 += q4.x * k0.x + q4.y * k0.y + q4.z * k0.z + q4.w * k0.w;
    s1 += q4.x * k1.x + q4.y * k1.y + q4.z * k1.z + q4.w * k1.w;
  }
  s0 *= 0.125f; s1 *= 0.125f;
  const float s2 = wave_sum(qd * bf2f(p.K()[(size_t)row * 256 + kvh * 64 + lane])) * 0.125f;
  const float sink = p.sinks[l * 16 + head];
  float m = fmaxf(fmaxf(s0, s1), fmaxf(s2, sink));
  m = wave_max(m);
  const float p0 = __expf(s0 - m), p1 = __expf(s1 - m), p2 = __expf(s2 - m);
  const float sum = wave_sum(p0 + p1);
  const float inv = 1.f / (sum + p2 + __expf(sink - m));
  sP[w * 132 + lane] = p0 * inv; sP[w * 132 + 64 + lane] = p1 * inv;
  __syncthreads();
  const float* vc = p.cache_v + cbase + lane;
  float o = 0.f;
#pragma unroll 8
  for (int j = 0; j < 128; ++j) o += sP[w * 132 + j] * vc[(size_t)j * 256];
  o += p2 * inv * bf2f(p.VT()[(size_t)(kvh * 64 + lane) * T + row]);
  p.O()[(size_t)row * 1024 + head * 64 + lane] = f2bf(o);
}

template <int PASS>
DI void merge_pass(const P& p, const bf16_t* A, const bf16_t* Wt, int m0, int n0, char* smem) {
  m0 = launder_s(m0); n0 = launder_s(n0);
  const int tid = tidx(), lane = tid & 63, w = __builtin_amdgcn_readfirstlane(tid >> 6), wm = w & 1, wn = w >> 1, lr = lane & 31, lh = lane >> 5;
  f32x16 acc[2][GNB];
#pragma unroll
  for (int a = 0; a < 2; ++a)
#pragma unroll
    for (int b = 0; b < GNB; ++b) zero16(acc[a][b]);
  gemm_mainloop(A + (size_t)m0 * 1024, 1024, Wt + (size_t)n0 * 1024, 1024, 1024, acc, smem);
  m0 = launder_s(m0); n0 = launder_s(n0);
  bf16_t* sT = (bf16_t*)smem;
  stage_tile(sT, acc, wm, wn, lr, lh);
  __syncthreads();
  const int goff = (PASS == 0) ? 1024 : (PASS == 2) ? 0 : 2048;
#pragma unroll 2
  for (int it = 0; it < 16; ++it) {
    const int idx = tid + 256 * it, row = idx >> 5, chunk = idx & 31;
    const uint4 av = *(const uint4*)(sT + row * LDS_T + chunk * 8);
    uint4* mp = (uint4*)(p.MG() + (size_t)(m0 + row) * 1024 + n0 + chunk * 8);
    uint4 gv = make_uint4(0u, 0u, 0u, 0u), mv = gv;
    if (PASS != 1) gv = *(const uint4*)(p.G() + (size_t)(m0 + row) * 3072 + goff + n0 + chunk * 8);
    if (PASS != 0) mv = *mp;
    const unsigned aw[4] = {av.x, av.y, av.z, av.w}, gw[4] = {gv.x, gv.y, gv.z, gv.w}, mw[4] = {mv.x, mv.y, mv.z, mv.w};
    unsigned ow[4];
#pragma unroll
    for (int k = 0; k < 4; ++k) {
      const float a0 = bflo(aw[k]), a1 = bfhi(aw[k]), g0 = bflo(gw[k]), g1 = bfhi(gw[k]), m0_ = bflo(mw[k]), m1_ = bfhi(mw[k]);
      float o0, o1;
      if (PASS == 0) { o0 = sigm_f(a0) * g0; o1 = sigm_f(a1) * g1; }
      else if (PASS == 1) { o0 = m0_ * a0; o1 = m1_ * a1; }
      else { o0 = m0_ + a0 * g0; o1 = m1_ + a1 * g1; }
      ow[k] = pack2(o0, o1);
    }
    *mp = make_uint4(ow[0], ow[1], ow[2], ow[3]);
  }
}
DI void merge_job(const P& p, int l, int job, char* smem) {
  int mt, nt;
  if (!gemm_tile(job, 128, 4, mt, nt)) return;
  const int m0 = mt * 128, n0 = nt * 256;
  const bf16_t* wl = p.Wt() + (size_t)l * W_LAYER;
  merge_pass<0>(p, p.YS(), wl + WO_GLU + (size_t)1024 * 1024, m0, n0, smem);
  merge_pass<1>(p, p.YS(), wl + WO_GLU, m0, n0, smem);
  merge_pass<2>(p, p.YM(), wl + WO_MPROJ, m0, n0, smem);
  merge_pass<3>(p, p.O(), wl + WO_ATTNO, m0, n0, smem);
}
DI void resid_gemm_job(const P& p, const bf16_t* A, int lda, const bf16_t* Wt, int K, int job, char* smem) {
  int mt, nt;
  if (!gemm_tile(job, 128, 4, mt, nt)) return;
  const int m0 = mt * 128, n0 = nt * 256;
  const int tid = tidx(), lane = tid & 63, w = __builtin_amdgcn_readfirstlane(tid >> 6), wm = w & 1, wn = w >> 1, lr = lane & 31, lh = lane >> 5;
  f32x16 acc[2][GNB];
#pragma unroll
  for (int a = 0; a < 2; ++a)
#pragma unroll
    for (int b = 0; b < GNB; ++b) zero16(acc[a][b]);
  gemm_mainloop(A + (size_t)m0 * lda, lda, Wt + (size_t)n0 * K, K, K, acc, smem);
#pragma unroll
  for (int mi = 0; mi < 2; ++mi)
#pragma unroll
    for (int ni = 0; ni < GNB; ++ni) {
      const int c = n0 + wn * 128 + ni * 32 + lr;
#pragma unroll
      for (int i = 0; i < 16; ++i) {
        const int r = m0 + wm * 64 + mi * 32 + crow(i, lh);
        p.X()[(size_t)r * 1024 + c] += acc[mi][ni][i];
      }
    }
}
DI void up_job(const P& p, int l, int job, char* smem) {
  int mt, nt;
  if (!gemm_tile(job, 128, 16, mt, nt)) return;
  int m0 = mt * 128, n0 = nt * 256;
  const int tid = tidx(), lane = tid & 63, w = __builtin_amdgcn_readfirstlane(tid >> 6), wm = w & 1, wn = w >> 1, lr = lane & 31, lh = lane >> 5;
  f32x16 acc[2][GNB];
#pragma unroll
  for (int a = 0; a < 2; ++a)
#pragma unroll
    for (int b = 0; b < GNB; ++b) zero16(acc[a][b]);
  gemm_mainloop(p.H() + (size_t)m0 * 1024, 1024, p.Wt() + (size_t)l * W_LAYER + WO_UP + (size_t)n0 * 1024, 1024, 1024, acc, smem);
  m0 = launder_s(m0); n0 = launder_s(n0);
#pragma unroll
  for (int mi = 0; mi < 2; ++mi)
#pragma unroll
    for (int ni = 0; ni < GNB; ++ni)
#pragma unroll
      for (int i = 0; i < 16; ++i) { const float v = fmaxf(acc[mi][ni][i], 0.f); acc[mi][ni][i] = v * v; }
  bf16_t* sT = (bf16_t*)smem;
  stage_tile(sT, acc, wm, wn, lr, lh);
  __syncthreads();
  tile_writeout(p.A2() + (size_t)m0 * 4096 + n0, 4096, sT);
}

DI float skinny_dot(const bf16_t* __restrict__ A, int lda, const bf16_t* __restrict__ Wt, int K, int r0, int c0, char* smem) {
  float* sR = (float*)smem;
  const int tid = tidx(), lane = tid & 63, w = __builtin_amdgcn_readfirstlane(tid >> 6), r = lane & 15, quad = lane >> 4;
  const int kq = K >> 2;
  const bf16_t* ap = A + (size_t)(r0 + r) * lda + w * kq + quad * 8;
  const bf16_t* bp = Wt + (size_t)(c0 + r) * K + w * kq + quad * 8;
  f32x4 acc = {0.f, 0.f, 0.f, 0.f};
#pragma unroll 4
  for (int k = 0; k < kq; k += 32) {
    const bf16x8 a = *(const bf16x8*)(ap + k), b = *(const bf16x8*)(bp + k);
    acc = MFMA16(a, b, acc);
  }
  __syncthreads();
#pragma unroll
  for (int j = 0; j < 4; ++j) sR[w * 256 + (quad * 4 + j) * 16 + r] = acc[j];
  __syncthreads();
  return sR[tid] + sR[256 + tid] + sR[512 + tid] + sR[768 + tid];
}
DI void skinny_merge_job(const P& p, int l, int job, char* smem) {
  const int rt = job & 7, ct = job >> 3;
  const int r0 = TP + rt * 16, c0 = ct * 16;
  const bf16_t* wl = p.Wt() + (size_t)l * W_LAYER;
  const float ag = skinny_dot(p.YS(), 1024, wl + WO_GLU + (size_t)1024 * 1024, 1024, r0, c0, smem);
  const float av = skinny_dot(p.YS(), 1024, wl + WO_GLU, 1024, r0, c0, smem);
  const float am = skinny_dot(p.YM(), 1024, wl + WO_MPROJ, 1024, r0, c0, smem);
  const float aa = skinny_dot(p.O(), 1024, wl + WO_ATTNO, 1024, r0, c0, smem);
  const int tid = tidx(), r = r0 + (tid >> 4), c = c0 + (tid & 15);
  const bf16_t* gp = p.G() + (size_t)r * 3072 + c;
  const float v = bf2f(gp[0]) * am + bf2f(gp[1024]) * av * sigm_f(ag) + bf2f(gp[2048]) * aa;
  p.MG()[(size_t)r * 1024 + c] = f2bf(v);
}
DI void skinny_resid_job(const P& p, const bf16_t* A, int lda, const bf16_t* Wt, int K, int job, char* smem) {
  const int rt = job & 7, ct = job >> 3;
  const int r0 = TP + rt * 16, c0 = ct * 16;
  const float v = skinny_dot(A, lda, Wt, K, r0, c0, smem);
  const int tid = tidx();
  p.X()[(size_t)(r0 + (tid >> 4)) * 1024 + c0 + (tid & 15)] += v;
}
DI void skinny_up_job(const P& p, int l, int job, char* smem) {
  const int rt = job & 7, ct = job >> 3;
  const int r0 = TP + rt * 16, c0 = ct * 16;
  const float v = fmaxf(skinny_dot(p.H(), 1024, p.Wt() + (size_t)l * W_LAYER + WO_UP, 1024, r0, c0, smem), 0.f);
  const int tid = tidx();
  p.A2()[(size_t)(r0 + (tid >> 4)) * 4096 + c0 + (tid & 15)] = f2bf(v * v);
}

#define XB_TMO      128
#define XB_XCNT(j)  (256  + 64 * (j))
#define XB_XSUB(j)  (1280 + 64 * (j))
#define XB_XGEN(j)  (2304 + 64 * (j))
#define XB_TOP      3328
#define XB_TOPGEN   3392
#define XCD_BAR_WORDS 3456
#define XB_SPIN_CAP (1u << 20)
#define LAS __attribute__((address_space(3)))
DI unsigned xb_ld(unsigned* p) { return __hip_atomic_load(p, __ATOMIC_RELAXED, __HIP_MEMORY_SCOPE_AGENT); }
DI unsigned xb_add(unsigned* p, unsigned v) { return __hip_atomic_fetch_add(p, v, __ATOMIC_RELAXED, __HIP_MEMORY_SCOPE_AGENT); }
DI unsigned xb_xcc_id() { return (unsigned)__builtin_amdgcn_s_getreg((3 << 11) | 20) & 0xFu; }
#define XB_SPIN(cond, bar) do { unsigned _sp = 0; while (cond) { __builtin_amdgcn_s_sleep(1); \
    if ((++_sp & 255u) == 0u) { if (xb_ld(&(bar)[XB_TMO])) break; if (_sp > XB_SPIN_CAP) { atomicAdd(&(bar)[XB_TMO], 1u); break; } } } } while (0)
struct XcdBarrier { unsigned* bar; unsigned x; volatile LAS unsigned* st; };
DI XcdBarrier xcd_barrier_post(unsigned* bar, volatile LAS unsigned* st) {
  XcdBarrier b; b.bar = bar; b.x = xb_xcc_id(); b.st = st;
  if (threadIdx.x == 0) (void)xb_add(&bar[XB_XCNT(b.x)], 1u);
  return b;
}
DI void xcd_barrier_complete(unsigned* bar, unsigned x, unsigned& nloc, unsigned& nx) {
  const unsigned G = gridDim.x * gridDim.y * gridDim.z;
  unsigned sum, cnt, mine, sp = 0u;
  for (;;) {
    sum = 0u; cnt = 0u; mine = 0u;
#pragma unroll
    for (unsigned j = 0; j < 16; ++j) { const unsigned c = xb_ld(&bar[XB_XCNT(j)]); sum += c; cnt += (c > 0u) ? 1u : 0u; mine = (j == x) ? c : mine; }
    if (sum == G) break;
    __builtin_amdgcn_s_sleep(1);
    if ((++sp & 255u) == 0u) { if (xb_ld(&bar[XB_TMO])) break; if (sp > XB_SPIN_CAP) { atomicAdd(&bar[XB_TMO], 1u); break; } }
  }
  nloc = mine > 0u ? mine : 1u; nx = cnt > 0u ? cnt : 1u;
}
DI void xcd_barrier(const XcdBarrier& b) {
  asm volatile("s_waitcnt vmcnt(0)" ::: "memory");
  __syncthreads();
  if (threadIdx.x == 0) {
    unsigned* bar = b.bar;
    __builtin_amdgcn_s_waitcnt(0);
    unsigned nloc = b.st[0], nx = b.st[1];
    if (nloc == 0u) { xcd_barrier_complete(bar, b.x, nloc, nx); b.st[0] = nloc; b.st[1] = nx; }
    const unsigned old = xb_add(&bar[XB_XSUB(b.x)], 1u);
    const unsigned gen = old / nloc;
    if (old + 1u == (gen + 1u) * nloc) {
      __builtin_amdgcn_fence(__ATOMIC_RELEASE, "agent");
      asm volatile("s_waitcnt vmcnt(0)" ::: "memory");
      const unsigned og = xb_add(&bar[XB_TOP], 1u);
      const unsigned tg = og / nx;
      if (og + 1u == (tg + 1u) * nx) xb_add(&bar[XB_TOPGEN], 1u);
      else XB_SPIN(xb_ld(&bar[XB_TOPGEN]) == tg, bar);
      __builtin_amdgcn_fence(__ATOMIC_ACQUIRE, "agent");
      xb_add(&bar[XB_XGEN(b.x)], 1u);
      asm volatile("s_waitcnt vmcnt(0)" ::: "memory");
    } else {
      XB_SPIN(xb_ld(&bar[XB_XGEN(b.x)]) == gen, bar);
      __builtin_amdgcn_fence(__ATOMIC_ACQUIRE, "agent");
      asm volatile("s_waitcnt vmcnt(0)" ::: "memory");
    }
  }
  __syncthreads();
}

constexpr int NPHASE = 1 + 4 * 11;
DI void phase_jobs(int ph, int& nstd, int& nother) {
  nstd = 0;
  if (ph == 0) { nother = 22272 + 64 + 257 + 4128; return; }
  const int s = (ph - 1) % 11;
  switch (s) {
    case 0: nstd = 129 * 35; nother = 0; break;
    case 1: nother = 2048 + 4096 + 4096 + 512 + 2048 + 512; break;
    case 2: nother = 2048; break;
    case 3: nother = 256 + 32; break;
    case 4: nother = 512 + 4096; break;
    case 5: nstd = 512; nother = 512; break;
    case 6: nstd = 512; nother = 512; break;
    case 7: nother = 4128; break;
    case 8: nstd = 2048; nother = 2048; break;
    case 9: nstd = 512; nother = 512; break;
    default: nother = 4128; break;
  }
}
DI void run_std_job(const P& p, int ph, int job, char* smem) {
  const int l = (ph - 1) / 11, s = (ph - 1) % 11;
  const bf16_t* wl = p.Wt() + (size_t)l * W_LAYER;
  switch (s) {
    case 0: inproj_job(p, l, job, smem); break;
    case 5: merge_job(p, l, job, smem); break;
    case 6: resid_gemm_job(p, p.MG(), 1024, wl + WO_WOUT, 1024, job, smem); break;
    case 8: up_job(p, l, job, smem); break;
    default: resid_gemm_job(p, p.A2(), 4096, wl + WO_DOWN, 4096, job, smem); break;
  }
}
DI void run_job(const P& p, int ph, int job, char* smem) {
  if (ph == 0) {
    if (job < 22272) { prep_weight_job(p, job, smem); return; }
    job -= 22272;
    if (job < 64) { prep_s5_job(p, job); return; }
    job -= 64;
    if (job < 257) { prep_rope_job(p, job); return; }
    job -= 257;
    norm_job(p, job, p.norm1_w, true, false);
    return;
  }
  const int l = (ph - 1) / 11, s = (ph - 1) % 11;
  const bf16_t* wl = p.Wt() + (size_t)l * W_LAYER;
  const int w = __builtin_amdgcn_readfirstlane(tidx() >> 6);
  switch (s) {
    case 1:
      if (job < 512) { for (int rr = 0; rr < (PROBE_DUP == 11 ? 3 : 1); ++rr) ssd_sample_job(p, l, job, smem); break; }
      job -= 512;
      if (job < 512) { attn_sample_job(p, l, job, smem); break; }
      job -= 512;
      if (job < 2048) { for (int rr = 0; rr < (PROBE_DUP == 8 ? 3 : 1); ++rr) attn_prompt_job(p, l, job, smem); break; }
      job -= 2048;
      if (job < 4096) { for (int rr = 0; rr < (PROBE_DUP == 9 ? 3 : 1); ++rr) conv_job(p, l, job, smem); break; }
      job -= 4096;
      if (job < 4096) { const int wj = job * 4 + w; for (int rr = 0; rr < (PROBE_DUP == 10 ? 3 : 1); ++rr) s5_wave_job(p, l, 0, wj >> 13, wj & 63, (wj >> 6) & 127, nullptr); break; }
      job -= 4096;
      { const int wj = job * 4 + w; __syncthreads(); s5_wave_job(p, l, 2, wj >> 6, wj & 63, 0, (bf16_t*)smem + w * 64 * 136); }
      break;
    case 2: ssd_a_job(p, l, job, smem); break;
    case 3:
      if (job < 256) ssd_scan_job(p, l, job);
      else s5_scan_job(p, l, job - 256);
      break;
    case 4:
      if (job < 512) { ssd_c_job(p, l, job, smem); break; }
      job -= 512;
      { const int wj = job * 4 + w; __syncthreads(); s5_wave_job(p, l, 1, wj >> 13, wj & 63, (wj >> 6) & 127, (bf16_t*)smem + w * 64 * 136); }
      break;
    case 5: skinny_merge_job(p, l, job, smem); break;
    case 6: skinny_resid_job(p, p.MG(), 1024, wl + WO_WOUT, 1024, job, smem); break;
    case 7: norm_job(p, job, p.norm2_w + l * 1024, false, false); break;
    case 8: skinny_up_job(p, l, job, smem); break;
    case 9: skinny_resid_job(p, p.A2(), 4096, wl + WO_DOWN, 4096, job, smem); break;
    default:
      if (l == 3) norm_job(p, job, p.final_w, false, true);
      else norm_job(p, job, p.norm1_w + (l + 1) * 1024, false, false);
      break;
  }
}

template <bool COOP>
__global__ void __launch_bounds__(256, 2) mega(P p, int ph0, int ph1) {
  __shared__ __attribute__((aligned(16))) char smem[SMEM_BYTES];
  __shared__ uint4 xb_words;
  XcdBarrier xb;
  if (COOP) {
    if (threadIdx.x == 0) xb_words = make_uint4(0u, 0u, 0u, 0u);
    __syncthreads();
    xb = xcd_barrier_post((unsigned*)(p.ws + WS_BAR), (volatile LAS unsigned*)&xb_words);
  }
  const int G = (int)gridDim.x;
  for (int ph = ph0; ph < ph1; ++ph) {
    int nstd, nother;
    phase_jobs(ph, nstd, nother);
    int reps = 1;
#if PROBE_DUP
    { const int s_ = (ph == 0) ? -1 : (ph - 1) % 11;
      if (PROBE_DUP == 1 && (s_ == 0 || s_ == 5 || s_ == 8)) reps = 2;
      if (PROBE_DUP == 2 && (s_ == 1 || s_ == 2 || s_ == 4)) reps = 2;
      if (PROBE_DUP == 6 && s_ == 4) reps = 2;
      if (PROBE_DUP == 7 && s_ == 1) reps = 2; }
#endif
    const int nstd_r = ((nstd + G - 1) / G) * G;
    for (int rep = 0; rep < reps; ++rep) {
      for (int job = blockIdx.x; job < nstd_r; job += G) run_std_job(p, ph, job, smem);
      for (int job = blockIdx.x; job < nother; job += G) run_job(p, ph, job, smem);
    }
    if (COOP && ph + 1 < ph1) {
      if (ph == ph0) cg::this_grid().sync();
      else xcd_barrier(xb);
    }
  }
}


extern "C" void kernel_launch(void* const* d_in, const int* in_sizes, int n_in, void* d_out, int out_size, void* d_ws, size_t ws_size,
                              hipStream_t stream) {
  P p{};
  const float** pin = (const float**)&p;
  for (int i = 0; i < 33; ++i) pin[i] = (const float*)d_in[i];
  p.out = (float*)d_out;
  p.ws = (char*)d_ws;
  if (WS_TOTAL > ws_size) { fprintf(stderr, "workspace too small: need %zu have %zu\n", (size_t)WS_TOTAL, ws_size); return; }

#if COOP_MODE
  static int grid_blocks = 0;
  if (!grid_blocks) {
    int dev = 0, cus = 0, per_cu = 0;
    hipGetDevice(&dev);
    hipDeviceGetAttribute(&cus, hipDeviceAttributeMultiprocessorCount, dev);
    hipOccupancyMaxActiveBlocksPerMultiprocessor(&per_cu, mega<true>, 256, 0);
    if (per_cu > 2) per_cu = 2;
    if (per_cu < 1) per_cu = 1;
    grid_blocks = cus * per_cu;
  }
  (void)hipMemsetAsync(p.ws + WS_BAR, 0, 4096 * 4, stream);
  int ph0 = 0, ph1 = NPHASE;
  void* args[] = {&p, &ph0, &ph1};
  hipError_t e = hipLaunchCooperativeKernel((void*)mega<true>, dim3(grid_blocks), dim3(256), args, 0, stream);
  if (e != hipSuccess) fprintf(stderr, "cooperative launch failed: %s (grid %d)\n", hipGetErrorString(e), grid_blocks);
#else
  for (int ph = 0; ph < NPHASE; ++ph) mega<false><<<dim3(1024), dim3(256), 0, stream>>>(p, ph, ph + 1);
#endif
}
```

```cpp
#include <hip/hip_runtime.h>
#include <hip/hip_cooperative_groups.h>
#include <cstdio>
#include <cstdint>
namespace cg = cooperative_groups;

#define DI __device__ __forceinline__
typedef unsigned short bf16_t;
typedef short bf16x8 __attribute__((ext_vector_type(8)));
typedef float f32x16 __attribute__((ext_vector_type(16)));
typedef float f32x4 __attribute__((ext_vector_type(4)));
#define MFMA32(a, b, c) __builtin_amdgcn_mfma_f32_32x32x16_bf16((a), (b), (c), 0, 0, 0)
#define MFMA16(a, b, c) __builtin_amdgcn_mfma_f32_16x16x32_bf16((a), (b), (c), 0, 0, 0)

#ifndef COOP_MODE
#define COOP_MODE 1
#endif
#ifndef PROBE_DUP
#define PROBE_DUP 0
#endif

constexpr int TP = 16384, TS = 128, T = TP + TS, SEQ = 8192;
constexpr int NIN = 8720, NINP = 8960;
constexpr int SMEM_BYTES = 73728;
constexpr float EPS = 1e-6f;

constexpr size_t OFF_YP = 0;
constexpr size_t OFF_YS = OFF_YP + (size_t)TP * 1024;
constexpr size_t OFF_SSMP = OFF_YS + (size_t)TS * 1024;
constexpr size_t OFF_SSMS = OFF_SSMP + (size_t)4 * 2 * 16 * 64 * 128;
constexpr size_t OFF_CONVP = OFF_SSMS + (size_t)4 * 128 * 16 * 64 * 128;
constexpr size_t OFF_CONVS = OFF_CONVP + (size_t)4 * 2 * 3 * 2048;
constexpr size_t OFF_S5RP = OFF_CONVS + (size_t)4 * 128 * 3 * 2048;
constexpr size_t OFF_S5RS = OFF_S5RP + (size_t)4 * 2 * 64 * 64;
constexpr size_t OFF_S5IP = OFF_S5RS + (size_t)4 * 128 * 64 * 64;
constexpr size_t OFF_S5IS = OFF_S5IP + (size_t)4 * 2 * 64 * 64;
constexpr size_t OFF_KP = OFF_S5IS + (size_t)4 * 128 * 64 * 64;
constexpr size_t OFF_KS = OFF_KP + (size_t)4 * 2 * 128 * 256;
constexpr size_t OFF_VP = OFF_KS + (size_t)4 * 128 * 128 * 256;
constexpr size_t OFF_VS = OFF_VP + (size_t)4 * 2 * 128 * 256;

constexpr size_t WO_IN = 0;
constexpr size_t WO_MPROJ = WO_IN + (size_t)NINP * 1024;
constexpr size_t WO_GLU = WO_MPROJ + (size_t)1024 * 1024;
constexpr size_t WO_ATTNO = WO_GLU + (size_t)2048 * 1024;
constexpr size_t WO_WOUT = WO_ATTNO + (size_t)1024 * 1024;
constexpr size_t WO_UP = WO_WOUT + (size_t)1024 * 1024;
constexpr size_t WO_DOWN = WO_UP + (size_t)4096 * 1024;
constexpr size_t W_LAYER = WO_DOWN + (size_t)4096 * 1024;

constexpr size_t al256(size_t x) { return (x + 255) & ~(size_t)255; }
constexpr size_t SZ1 = (size_t)T * 1024 * 2;
constexpr size_t WS_X = 0;
constexpr size_t WS_H = WS_X + al256((size_t)T * 1024 * 4);
constexpr size_t WS_Z = WS_H + al256(SZ1);
constexpr size_t WS_U = WS_Z + al256(SZ1);
constexpr size_t WS_Q = WS_U + al256(SZ1);
constexpr size_t WS_YM = WS_Q + al256(SZ1);
constexpr size_t WS_YS = WS_YM + al256(SZ1);
constexpr size_t WS_O = WS_YS + al256(SZ1);
constexpr size_t WS_MG = WS_O + al256(SZ1);
constexpr size_t WS_XBC = WS_MG + al256(SZ1);
constexpr size_t WS_XBT = WS_XBC + al256((size_t)T * 2048 * 2);
constexpr size_t WS_BC = WS_XBT + al256((size_t)1536 * TP * 2);
constexpr size_t WS_A2END = WS_XBC + al256((size_t)T * 4096 * 2);
constexpr size_t WS_BCEND = WS_BC + al256((size_t)TP * 1024 * 2);
constexpr size_t WS_K = WS_A2END > WS_BCEND ? WS_A2END : WS_BCEND;
constexpr size_t WS_VT = WS_K + al256((size_t)T * 256 * 2);
constexpr size_t WS_G = WS_VT + al256((size_t)T * 256 * 2);
constexpr size_t WS_DT = WS_G + al256((size_t)T * 3072 * 2);
constexpr size_t WS_ST = WS_DT + al256((size_t)T * 16 * 4);
constexpr size_t WS_CDEC = WS_ST + al256((size_t)2 * 64 * 16 * 64 * 128 * 4);
constexpr size_t WS_S5S = WS_CDEC + al256((size_t)2 * 64 * 16 * 4);
constexpr size_t WS_S5P = WS_S5S + al256((size_t)2 * 128 * 64 * 64 * 2 * 4);
constexpr size_t WS_ROPE = WS_S5P + al256((size_t)4 * 64 * 36 * 64 * 4);
constexpr size_t WS_WT = WS_ROPE + al256((size_t)8193 * 8 * 8);
constexpr size_t WS_BAR = WS_WT + al256((size_t)4 * W_LAYER * 2);
constexpr size_t WS_HP = WS_BAR + al256(4096 * 4);
constexpr size_t WS_BBT = WS_HP + al256((size_t)2 * 64 * 16 * 64 * 128 * 2);
constexpr size_t WS_TOTAL = WS_BBT + al256((size_t)4 * 64 * 128 * 16 * 2);

struct P {
  const float *x_prompt, *x_sample, *state_ssm, *state_conv, *s5_sre, *s5_sim, *cache_k, *cache_v;
  const float *norm1_w, *w_in, *conv_w, *conv_b, *dt_bias, *a_log, *m_d, *m_norm_w, *m_proj;
  const float *lam_re, *lam_im, *log_step, *b_re, *b_im, *c_re, *c_im, *s5_d, *glu_w;
  const float *sinks, *attn_o, *w_out, *norm2_w, *mlp_up, *mlp_down, *final_w;
  float* out;
  char* ws;
#define WSACC(name, type, off) __device__ __forceinline__ type* name() const { return (type*)(ws + (off)); }
  WSACC(X, float, WS_X) WSACC(H, bf16_t, WS_H) WSACC(Z, bf16_t, WS_Z) WSACC(U, bf16_t, WS_U) WSACC(Q, bf16_t, WS_Q)
  WSACC(YM, bf16_t, WS_YM) WSACC(YS, bf16_t, WS_YS) WSACC(O, bf16_t, WS_O) WSACC(MG, bf16_t, WS_MG)
  WSACC(XBC, bf16_t, WS_XBC) WSACC(XBT, bf16_t, WS_XBT) WSACC(BC, bf16_t, WS_BC) WSACC(A2, bf16_t, WS_XBC)
  WSACC(K, bf16_t, WS_K) WSACC(VT, bf16_t, WS_VT) WSACC(G, bf16_t, WS_G) WSACC(DT, float, WS_DT) WSACC(ST, float, WS_ST)
  WSACC(CDEC, float, WS_CDEC) WSACC(HP, bf16_t, WS_HP) WSACC(BBT, bf16_t, WS_BBT) WSACC(S5S, float, WS_S5S) WSACC(S5P, float, WS_S5P) WSACC(ROPE, float2, WS_ROPE) WSACC(Wt, bf16_t, WS_WT)
#undef WSACC
};

typedef float f32x2_t __attribute__((ext_vector_type(2)));
typedef __bf16 bf16x2_t __attribute__((ext_vector_type(2)));
DI unsigned pack2(float a, float b) { const f32x2_t v = {a, b}; return __builtin_bit_cast(unsigned, __builtin_convertvector(v, bf16x2_t)); }
DI bf16_t f2bf(float x) { return (bf16_t)(pack2(x, 0.f) & 0xffffu); }
DI float bf2f(bf16_t b) { return __uint_as_float(((unsigned)b) << 16); }
DI float bflo(unsigned u) { return __uint_as_float(u << 16); }
DI float bfhi(unsigned u) { return __uint_as_float(u & 0xffff0000u); }
DI float silu_f(float x) { return x / (1.f + __expf(-x)); }
DI float sigm_f(float x) { return 1.f / (1.f + __expf(-x)); }
DI float softplus_f(float x) { return x > 20.f ? x : log1pf(expf(x)); }
DI float gelu_tanh(float x) { float y = 0.7978845608028654f * (x + 0.044715f * x * x * x); float t = 1.f - 2.f / (__expf(2.f * y) + 1.f); return 0.5f * x * (1.f + t); }
DI int crow(int i, int lh) { return (i & 3) + 8 * (i >> 2) + 4 * lh; }
DI int launder(int x) { asm volatile("" : "+v"(x)); return x; }
DI int tidx() { int t = __builtin_amdgcn_workitem_id_x(); asm volatile("" : "+v"(t)); return t; }
DI int launder_s(int x) { asm volatile("" : "+s"(x)); return x; }
DI float wave_sum(float v) {
#pragma unroll
  for (int o = 32; o >= 1; o >>= 1) v += __shfl_xor(v, o);
  return v;
}
DI float wave_max(float v) {
#pragma unroll
  for (int o = 32; o >= 1; o >>= 1) v = fmaxf(v, __shfl_xor(v, o));
  return v;
}
DI bf16x8 u4_to_bf8(uint4 v) { return __builtin_bit_cast(bf16x8, v); }
DI void zero16(f32x16& a) {
#pragma unroll
  for (int i = 0; i < 16; ++i) a[i] = 0.f;
}

constexpr int LDT = 40;
constexpr int GNB = 4;
DI void gemm_mainloop(const bf16_t* __restrict__ A, int lda, const bf16_t* __restrict__ B, int ldb, int K,
                      f32x16 (&acc)[2][GNB], char* smem) {
  bf16_t* sa = (bf16_t*)smem;
  bf16_t* sb = sa + 2 * 128 * LDT;
  const int tid = tidx(), lane = tid & 63, w = __builtin_amdgcn_readfirstlane(tid >> 6), wm = w & 1, wn = w >> 1, lr = lane & 31, lh = lane >> 5;
  const int r0 = tid >> 2, ch = (tid & 3) * 8;
  const bf16_t* ap = A + (size_t)r0 * lda + ch;
  const bf16_t* bp = B + (size_t)r0 * ldb + ch;
  uint4 pa0, pa1, pb0, pb1, pb2, pb3;
  uint4 qa0, qa1, qb0, qb1, qb2, qb3;
#define GLOADS(R, k0)                                                                                      \
  R##a0 = *(const uint4*)(ap + (k0)); R##a1 = *(const uint4*)(ap + (size_t)64 * lda + (k0));               \
  R##b0 = *(const uint4*)(bp + (k0)); R##b1 = *(const uint4*)(bp + (size_t)64 * ldb + (k0));               \
  R##b2 = *(const uint4*)(bp + (size_t)128 * ldb + (k0)); R##b3 = *(const uint4*)(bp + (size_t)192 * ldb + (k0));
#define SSTORES(R, bufi)                                                                                   \
  { bf16_t* da = sa + (bufi)*128 * LDT; bf16_t* db = sb + (bufi)*256 * LDT;                                \
    *(uint4*)(da + (r0)*LDT + ch) = R##a0; *(uint4*)(da + (r0 + 64) * LDT + ch) = R##a1;                   \
    *(uint4*)(db + (r0)*LDT + ch) = R##b0; *(uint4*)(db + (r0 + 64) * LDT + ch) = R##b1;                   \
    *(uint4*)(db + (r0 + 128) * LDT + ch) = R##b2; *(uint4*)(db + (r0 + 192) * LDT + ch) = R##b3; }
#define COMPUTE(bufi)                                                                                      \
  { const bf16_t* ca = sa + (bufi)*128 * LDT + (wm * 64 + lr) * LDT + lh * 8;                              \
    const bf16_t* cb = sb + (bufi)*256 * LDT + (wn * 128 + lr) * LDT + lh * 8;                             \
    _Pragma("unroll") for (int kk = 0; kk < 2; ++kk) {                                                     \
      const bf16x8 af0 = *(const bf16x8*)(ca + kk * 16), af1 = *(const bf16x8*)(ca + 32 * LDT + kk * 16);  \
      _Pragma("unroll") for (int ni = 0; ni < GNB; ++ni) {                                                 \
        const bf16x8 bfr = *(const bf16x8*)(cb + ni * 32 * LDT + kk * 16);                                 \
        acc[0][ni] = MFMA32(af0, bfr, acc[0][ni]); acc[1][ni] = MFMA32(af1, bfr, acc[1][ni]); } } }
  const int nk = K >> 5;
  const int klast = (nk - 1) * 32;
  GLOADS(p, 0)
  __syncthreads();
  SSTORES(p, 0)
  GLOADS(p, 32)
  __syncthreads();
  for (int kt = 0; kt < nk; kt += 2) {
    { const int k2 = (kt + 2) * 32; const int k0 = k2 < klast ? k2 : klast; GLOADS(q, k0) }
    COMPUTE(0)
    SSTORES(p, 1)
    __syncthreads();
    { const int k3 = (kt + 3) * 32; const int k0 = k3 < klast ? k3 : klast; GLOADS(p, k0) }
    COMPUTE(1)
    SSTORES(q, 0)
    __syncthreads();
  }
#undef GLOADS
#undef SSTORES
#undef COMPUTE
}
DI bool gemm_tile(int slot, int MT, int NT, int& mt, int& nt) {
  const int G = gridDim.x, nx = G >> 3;
  int J = slot;
  if ((G & 7) == 0) J = (slot / G) * G + (slot & 7) * nx + ((slot % G) >> 3);
  if (J >= MT * NT) return false;
  const int gw = 8 * NT, grp = J / gw, rem = J - grp * gw, fm = grp * 8;
  const int gsz = (MT - fm) < 8 ? (MT - fm) : 8;
  mt = fm + rem % gsz; nt = rem / gsz;
  return true;
}

DI int win_map(int n) {
  if (n < 3072) return n;
  if (n < 8704) return n + 16;
  if (n < 8720) return n - 8704 + 3072;
  return -1;
}
DI void wtrans_tile(const float* __restrict__ src, int N, int K, bf16_t* __restrict__ dst, int kt, int nt, bool inmap, char* smem) {
  float* s = (float*)smem;
  const int tid = tidx();
  __syncthreads();
  const int nn = tid & 63;
  int sc = nt * 64 + nn;
  if (inmap) sc = win_map(sc);
#pragma unroll
  for (int it = 0; it < 16; ++it) {
    const int kk = it * 4 + (tid >> 6);
    s[kk * 65 + nn] = (sc >= 0) ? src[(size_t)(kt * 64 + kk) * N + sc] : 0.f;
  }
  __syncthreads();
#pragma unroll
  for (int it = 0; it < 16; ++it) {
    const int n2 = it * 4 + (tid >> 6), k2 = tid & 63;
    dst[(size_t)(nt * 64 + n2) * K + kt * 64 + k2] = f2bf(s[k2 * 65 + n2]);
  }
}
DI void prep_weight_job(const P& p, int j, char* smem) {
  const int l = j / 5568; int r = j % 5568;
  bf16_t* wl = p.Wt() + (size_t)l * W_LAYER;
  if (r < 2240) { wtrans_tile(p.w_in + (size_t)l * 1024 * NIN, NIN, 1024, wl + WO_IN, r / 140, r % 140, true, smem); return; }
  r -= 2240;
  if (r < 256) { wtrans_tile(p.m_proj + (size_t)l * 1024 * 1024, 1024, 1024, wl + WO_MPROJ, r / 16, r % 16, false, smem); return; }
  r -= 256;
  if (r < 512) { wtrans_tile(p.glu_w + (size_t)l * 1024 * 2048, 2048, 1024, wl + WO_GLU, r / 32, r % 32, false, smem); return; }
  r -= 512;
  if (r < 256) { wtrans_tile(p.attn_o + (size_t)l * 1024 * 1024, 1024, 1024, wl + WO_ATTNO, r / 16, r % 16, false, smem); return; }
  r -= 256;
  if (r < 256) { wtrans_tile(p.w_out + (size_t)l * 1024 * 1024, 1024, 1024, wl + WO_WOUT, r / 16, r % 16, false, smem); return; }
  r -= 256;
  if (r < 1024) { wtrans_tile(p.mlp_up + (size_t)l * 1024 * 4096, 4096, 1024, wl + WO_UP, r / 64, r % 64, false, smem); return; }
  r -= 1024;
  wtrans_tile(p.mlp_down + (size_t)l * 4096 * 1024, 1024, 4096, wl + WO_DOWN, r / 16, r % 16, false, smem);
}
DI void prep_s5_job(const P& p, int j) {
  const int idx = j * 256 + tidx();
  const int n = idx & 63, g = (idx >> 6) & 63, l = idx >> 12;
  const float step = expf(p.log_step[l * 64 + g]);
  const float lr_ = p.lam_re[(l * 64 + g) * 64 + n], li = p.lam_im[(l * 64 + g) * 64 + n];
  const float mag = expf(lr_ * step);
  const float abr = mag * cosf(li * step), abi = mag * sinf(li * step);
  float aqr = abr, aqi = abi;
#pragma unroll
  for (int q = 0; q < 6; ++q) { const float nr2 = aqr * aqr - aqi * aqi, ni2 = 2.f * aqr * aqi; aqr = nr2; aqi = ni2; }
  const float den = lr_ * lr_ + li * li;
  const float nr = abr - 1.0f, ni = abi;
  const float fre = (nr * lr_ + ni * li) / den, fim = (ni * lr_ - nr * li) / den;
  float* o = p.S5P() + ((size_t)(l * 64 + g) * 36) * 64 + n;
  o[0] = abr; o[64] = abi; o[128] = aqr; o[192] = aqi;
  const float* br = p.b_re + ((size_t)(l * 64 + g) * 64 + n) * 16;
  const float* bi = p.b_im + ((size_t)(l * 64 + g) * 64 + n) * 16;
  float vre[16], vim[16];
#pragma unroll
  for (int i = 0; i < 16; ++i) {
    const float b_r = br[i], b_i = bi[i];
    vre[i] = fre * b_r - fim * b_i;
    vim[i] = fre * b_i + fim * b_r;
    o[(4 + i) * 64] = vre[i];
    o[(20 + i) * 64] = vim[i];
  }
  uint4* bt = (uint4*)(p.BBT() + ((size_t)(l * 64 + g) * 128 + n) * 16);
  bt[0] = make_uint4(pack2(vre[0], vre[1]), pack2(vre[2], vre[3]), pack2(vre[4], vre[5]), pack2(vre[6], vre[7]));
  bt[1] = make_uint4(pack2(vre[8], vre[9]), pack2(vre[10], vre[11]), pack2(vre[12], vre[13]), pack2(vre[14], vre[15]));
  bt[128] = make_uint4(pack2(vim[0], vim[1]), pack2(vim[2], vim[3]), pack2(vim[4], vim[5]), pack2(vim[6], vim[7]));
  bt[129] = make_uint4(pack2(vim[8], vim[9]), pack2(vim[10], vim[11]), pack2(vim[12], vim[13]), pack2(vim[14], vim[15]));
}
DI void prep_rope_job(const P& p, int j) {
  const int idx = j * 256 + tidx();
  if (idx >= 8193 * 8) return;
  const int pos = idx >> 3, f = idx & 7;
  const float invf = expf(-(2.0f * (float)f / 16.0f) * logf(500000.0f));
  const float ang = (float)pos * invf;
  p.ROPE()[idx] = make_float2(cosf(ang), sinf(ang));
}

DI void norm_job(const P& p, int job, const float* wgt, bool layer0, bool final_) {
  const int w = __builtin_amdgcn_readfirstlane(tidx() >> 6), lane = tidx() & 63;
  const int r = job * 4 + w;
  const float* src = layer0 ? (r < TP ? p.x_prompt + (size_t)r * 1024 : p.x_sample + (size_t)(r - TP) * 1024) : p.X() + (size_t)r * 1024;
  float4 v[4];
  float ss = 0.f;
#pragma unroll
  for (int q = 0; q < 4; ++q) { v[q] = ((const float4*)src)[lane + 64 * q]; ss += v[q].x * v[q].x + v[q].y * v[q].y + v[q].z * v[q].z + v[q].w * v[q].w; }
  ss = wave_sum(ss);
  const float sc = rsqrtf(ss * (1.f / 1024.f) + EPS);
#pragma unroll
  for (int q = 0; q < 4; ++q) {
    const float4 wv = ((const float4*)wgt)[lane + 64 * q];
    float4 y = make_float4(v[q].x * sc * wv.x, v[q].y * sc * wv.y, v[q].z * sc * wv.z, v[q].w * sc * wv.w);
    if (final_) ((float4*)(p.out + OFF_YP + (size_t)r * 1024))[lane + 64 * q] = y;
    else *(uint2*)(p.H() + (size_t)r * 1024 + (lane + 64 * q) * 4) = make_uint2(pack2(y.x, y.y), pack2(y.z, y.w));
    if (layer0) ((float4*)(p.X() + (size_t)r * 1024))[lane + 64 * q] = v[q];
  }
}

constexpr int LDS_T = 264;
DI void stage_tile(bf16_t* sT, const f32x16 (&acc)[2][GNB], int wm, int wn, int lr, int lh) {
#pragma unroll
  for (int mi = 0; mi < 2; ++mi)
#pragma unroll
    for (int ni = 0; ni < GNB; ++ni) {
      bf16_t* d = sT + (wm * 64 + mi * 32 + 4 * lh) * LDS_T + wn * 128 + ni * 32 + lr;
#pragma unroll
      for (int ig = 0; ig < 4; ++ig) {
        const unsigned p01 = pack2(acc[mi][ni][4 * ig], acc[mi][ni][4 * ig + 1]), p23 = pack2(acc[mi][ni][4 * ig + 2], acc[mi][ni][4 * ig + 3]);
        d[(8 * ig) * LDS_T] = (bf16_t)(p01 & 0xffffu); d[(8 * ig + 1) * LDS_T] = (bf16_t)(p01 >> 16);
        d[(8 * ig + 2) * LDS_T] = (bf16_t)(p23 & 0xffffu); d[(8 * ig + 3) * LDS_T] = (bf16_t)(p23 >> 16);
      }
    }
}
DI void tile_writeout(bf16_t* __restrict__ dst, int ld, const bf16_t* sT) {
  const int tid = tidx();
#pragma unroll 4
  for (int it = 0; it < 16; ++it) {
    const int idx = tid + 256 * it, row = idx >> 5, chunk = idx & 31;
    *(uint4*)(dst + (size_t)row * ld + chunk * 8) = *(const uint4*)(sT + row * LDS_T + chunk * 8);
  }
}

DI void inproj_job(const P& p, int l, int job, char* smem) {
  int mt, nt;
  if (!gemm_tile(job, 129, 35, mt, nt)) return;
  int m0 = mt * 128, n0 = nt * 256;
  f32x16 acc[2][GNB];
#pragma unroll
  for (int a = 0; a < 2; ++a)
#pragma unroll
    for (int b = 0; b < GNB; ++b) zero16(acc[a][b]);
  gemm_mainloop(p.H() + (size_t)m0 * 1024, 1024, p.Wt() + (size_t)l * W_LAYER + WO_IN + (size_t)n0 * 1024, 1024, 1024, acc, smem);
  m0 = launder_s(m0); n0 = launder_s(n0);
  nt = launder_s(nt); mt = launder_s(mt);
  const int tid = tidx(), lane = tid & 63, w = __builtin_amdgcn_readfirstlane(tid >> 6), wm = w & 1, wn = w >> 1, lr = lane & 31, lh = lane >> 5;
  bf16_t* sT = (bf16_t*)smem;
  if (nt == 34) {
    if (wn == 0 && lr < 16) {
      const float bias = p.dt_bias[l * 16 + lr];
#pragma unroll
      for (int mi = 0; mi < 2; ++mi)
#pragma unroll
        for (int i = 0; i < 16; ++i) p.DT()[(size_t)(m0 + wm * 64 + mi * 32 + crow(i, lh)) * 16 + lr] = softplus_f(acc[mi][0][i] + bias);
    }
    return;
  }
  if (nt >= 16 && nt <= 20) {
#pragma unroll
    for (int mi = 0; mi < 2; ++mi)
#pragma unroll
      for (int ni = 0; ni < GNB; ni += 2)
#pragma unroll
        for (int i = 0; i < 16; ++i) {
          const float v = acc[mi][ni][i];
          const float pv = __shfl_xor(v, 8);
          if (lr < 16) {
            const int r = m0 + wm * 64 + mi * 32 + crow(i, lh);
            const int pos = (r >= TP) ? 8192 : (r & 8191);
            const float2 cs = p.ROPE()[pos * 8 + (lr & 7)];
            acc[mi][ni][i] = (lr < 8) ? v * cs.x - pv * cs.y : v * cs.x + pv * cs.y;
          }
        }
  }
  if (nt >= 22) {
#pragma unroll
    for (int mi = 0; mi < 2; ++mi)
#pragma unroll
      for (int ni = 0; ni < GNB; ++ni)
#pragma unroll
        for (int i = 0; i < 16; ++i) acc[mi][ni][i] = sigm_f(acc[mi][ni][i]);
  }
  if ((mt == 63 || mt == 127 || mt == 128) && ((nt >= 4 && nt < 12) || nt == 20 || nt == 21)) {
#pragma unroll
    for (int mi = 0; mi < 2; ++mi)
#pragma unroll
      for (int ni = 0; ni < GNB; ++ni) {
        const int cc = (n0 & 255) + wn * 128 + ni * 32 + lr;
        const int rb_ = launder(m0 + wm * 64 + mi * 32 + 4 * lh);
#pragma unroll
        for (int i = 0; i < 16; ++i) {
          const int r = rb_ + (i & 3) + 8 * (i >> 2);
          const float v = acc[mi][ni][i];
          if (nt < 12) {
            const int ch = (n0 - 1024) + cc;
            if (r >= TP) p.out[OFF_CONVS + ((size_t)(l * 128 + (r - TP)) * 3 + 2) * 2048 + ch] = v;
            else { const int t = r & 8191; if (t >= 8189) p.out[OFF_CONVP + ((size_t)(l * 2 + (r >> 13)) * 3 + (t - 8189)) * 2048 + ch] = v; }
          } else {
            const size_t ob = (nt == 20) ? OFF_KS : OFF_VS, obp = (nt == 20) ? OFF_KP : OFF_VP;
            if (r >= TP) p.out[ob + ((size_t)(l * 128 + (r - TP)) * 128 + 127) * 256 + cc] = v;
            else p.out[obp + ((size_t)(l * 2 + (r >> 13)) * 128 + ((r & 8191) - 8064)) * 256 + cc] = v;
          }
        }
        __builtin_amdgcn_sched_barrier(0);
      }
  }
  if (nt == 21) {
#pragma unroll
    for (int mi = 0; mi < 2; ++mi)
#pragma unroll
      for (int ni = 0; ni < GNB; ++ni) {
        bf16_t* d = sT + (wn * 128 + ni * 32 + lr) * 136 + wm * 64 + mi * 32 + 4 * lh;
#pragma unroll
        for (int ig = 0; ig < 4; ++ig)
          *(uint2*)(d + 8 * ig) = make_uint2(pack2(acc[mi][ni][4 * ig], acc[mi][ni][4 * ig + 1]), pack2(acc[mi][ni][4 * ig + 2], acc[mi][ni][4 * ig + 3]));
      }
    __syncthreads();
#pragma unroll 4
    for (int it = 0; it < 16; ++it) {
      const int idx = tid + 256 * it, c = idx >> 4, chunk = idx & 15;
      *(uint4*)(p.VT() + (size_t)c * T + m0 + chunk * 8) = *(const uint4*)(sT + c * 136 + chunk * 8);
    }
    return;
  }
  stage_tile(sT, acc, wm, wn, lr, lh);
  __syncthreads();
  bf16_t* dst; int ld;
  if (nt < 4) { dst = p.Z() + n0; ld = 1024; }
  else if (nt < 12) { dst = p.XBC() + (n0 - 1024); ld = 2048; }
  else if (nt < 16) { dst = p.U() + (n0 - 3072); ld = 1024; }
  else if (nt < 20) { dst = p.Q() + (n0 - 4096); ld = 1024; }
  else if (nt == 20) { dst = p.K(); ld = 256; }
  else { dst = p.G() + (n0 - 5632); ld = 3072; }
  tile_writeout(dst + (size_t)m0 * ld, ld, sT);
}

DI void conv_job(const P& p, int l, int job, char* smem) {
  const int ct = job & 31, tt = job >> 5;
  const int ch0 = ct * 64, tokb = tt * 128;
  bf16_t* sT = (bf16_t*)smem;
  const int tid = tidx();
  const float* cw = p.conv_w + (size_t)l * 4 * 2048;
  __syncthreads();
#pragma unroll
  for (int it = 0; it < 4; ++it) {
    const int item = tid + 256 * it, tl = item >> 3, chk = item & 7, ch = ch0 + chk * 8, row = tokb + tl, t = row & 8191;
    float a[8];
    {
      const float4 b0 = *(const float4*)(p.conv_b + l * 2048 + ch), b1 = *(const float4*)(p.conv_b + l * 2048 + ch + 4);
      a[0] = b0.x; a[1] = b0.y; a[2] = b0.z; a[3] = b0.w; a[4] = b1.x; a[5] = b1.y; a[6] = b1.z; a[7] = b1.w;
    }
#pragma unroll
    for (int j = 0; j < 4; ++j) {
      if (t - 3 + j >= 0) {
        const uint4 rv = *(const uint4*)(p.XBC() + (size_t)(row - 3 + j) * 2048 + ch);
        const float4 w0 = *(const float4*)(cw + j * 2048 + ch), w1 = *(const float4*)(cw + j * 2048 + ch + 4);
        a[0] += bflo(rv.x) * w0.x; a[1] += bfhi(rv.x) * w0.y; a[2] += bflo(rv.y) * w0.z; a[3] += bfhi(rv.y) * w0.w;
        a[4] += bflo(rv.z) * w1.x; a[5] += bfhi(rv.z) * w1.y; a[6] += bflo(rv.w) * w1.z; a[7] += bfhi(rv.w) * w1.w;
      }
    }
#pragma unroll
    for (int j = 0; j < 8; ++j) a[j] = silu_f(a[j]);
    if (ct >= 16) *(uint4*)(p.BC() + (size_t)row * 1024 + (ch - 1024)) = make_uint4(pack2(a[0], a[1]), pack2(a[2], a[3]), pack2(a[4], a[5]), pack2(a[6], a[7]));
    if (ct < 24) {
#pragma unroll
      for (int j = 0; j < 8; ++j) sT[(chk * 8 + j) * 136 + tl] = f2bf(a[j]);
    }
  }
  if (ct < 24) {
    __syncthreads();
#pragma unroll
    for (int it = 0; it < 4; ++it) {
      const int item = tid + 256 * it, r = item >> 4, chk = item & 15;
      *(uint4*)(p.XBT() + (size_t)(ch0 + r) * TP + tokb + chk * 8) = *(const uint4*)(sT + r * 136 + chk * 8);
    }
  }
}

DI void chunk_acum(const P& p, int l, int head, int tok0, float* sAc, float* sDt, float& alast) {
  const int lane = tidx() & 63;
  const float Ah = -expf(p.a_log[l * 16 + head]);
  const float d0 = p.DT()[(size_t)(tok0 + 2 * lane) * 16 + head], d1 = p.DT()[(size_t)(tok0 + 2 * lane + 1) * 16 + head];
  const float a0 = d0 * Ah, a1 = d1 * Ah;
  float s = a0 + a1;
#pragma unroll
  for (int off = 1; off < 64; off <<= 1) { const float tv = __shfl_up(s, off); if (lane >= off) s += tv; }
  const float excl = s - (a0 + a1);
  sAc[2 * lane] = excl + a0; sAc[2 * lane + 1] = s;
  sDt[2 * lane] = d0; sDt[2 * lane + 1] = d1;
  alast = __shfl(s, 63);
}

DI void ssd_a_job(const P& p, int l, int job, char* smem) {
  const int head = job & 15, c = (job >> 4) & 63, b = job >> 10, g = head >> 2;
  const int tok0 = b * SEQ + c * 128;
  bf16_t* sXT = (bf16_t*)smem;
  bf16_t* sBT = sXT + 64 * 136;
  float* sW = (float*)(sBT + 128 * 136);
  float* sAc = sW + 128;
  float* sDt = sAc + 128;
  const int tid = tidx(), lane = tid & 63, w = __builtin_amdgcn_readfirstlane(tid >> 6), lr = lane & 31, lh = lane >> 5;
  __syncthreads();
  if (w == 0) {
    float alast;
    chunk_acum(p, l, head, tok0, sAc, sDt, alast);
    sW[2 * lane] = sDt[2 * lane] * __expf(alast - sAc[2 * lane]);
    sW[2 * lane + 1] = sDt[2 * lane + 1] * __expf(alast - sAc[2 * lane + 1]);
    if (lane == 0) p.CDEC()[(b * 64 + c) * 16 + head] = __expf(alast);
  }
  __syncthreads();
#pragma unroll
  for (int it = 0; it < 4; ++it) {
    const int item = tid + 256 * it, pr = item >> 4, s0 = (item & 15) * 8;
    const uint4 v = *(const uint4*)(p.XBT() + (size_t)(head * 64 + pr) * TP + tok0 + s0);
    const float4 w0 = *(const float4*)(sW + s0), w1 = *(const float4*)(sW + s0 + 4);
    *(uint4*)(sXT + pr * 136 + s0) = make_uint4(pack2(bflo(v.x) * w0.x, bfhi(v.x) * w0.y), pack2(bflo(v.y) * w0.z, bfhi(v.y) * w0.w),
                                                pack2(bflo(v.z) * w1.x, bfhi(v.z) * w1.y), pack2(bflo(v.w) * w1.z, bfhi(v.w) * w1.w));
  }
#pragma unroll
  for (int it = 0; it < 8; ++it) {
    const int item = tid + 256 * it, n = item >> 4, s0 = (item & 15) * 8;
    *(uint4*)(sBT + n * 136 + s0) = *(const uint4*)(p.XBT() + (size_t)(1024 + g * 128 + n) * TP + tok0 + s0);
  }
  __syncthreads();
  const int wp = w & 1, wn = w >> 1;
  f32x16 acc[2];
  zero16(acc[0]); zero16(acc[1]);
#pragma unroll
  for (int kk = 0; kk < 8; ++kk) {
    const bf16x8 af = *(const bf16x8*)(sXT + (wp * 32 + lr) * 136 + kk * 16 + lh * 8);
#pragma unroll
    for (int ni = 0; ni < 2; ++ni) {
      const bf16x8 bfr = *(const bf16x8*)(sBT + (wn * 64 + ni * 32 + lr) * 136 + kk * 16 + lh * 8);
      acc[ni] = MFMA32(af, bfr, acc[ni]);
    }
  }
  float* st = p.ST() + ((size_t)((b * 64 + c) * 16 + head) * 64) * 128;
#pragma unroll
  for (int ni = 0; ni < 2; ++ni)
#pragma unroll
    for (int i = 0; i < 16; ++i) st[(wp * 32 + crow(i, lh)) * 128 + wn * 64 + ni * 32 + lr] = acc[ni][i];
}

DI void ssd_scan_job(const P& p, int l, int job) {
  const int gid = job * 256 + tidx();
  const int b = gid >> 15, rem = gid & 32767, head = rem >> 11;
  float4 h = make_float4(0.f, 0.f, 0.f, 0.f);
  const float4* sp0 = (const float4*)(p.ST() + (size_t)(b * 64) * 131072) + rem;
  uint2* hp0 = (uint2*)(p.HP() + (size_t)(b * 64) * 131072) + rem;
  for (int c0 = 0; c0 < 64; c0 += 8) {
    float4 sv[8];
    float dv[8];
#pragma unroll
    for (int k = 0; k < 8; ++k) { sv[k] = sp0[(size_t)(c0 + k) * 32768]; dv[k] = p.CDEC()[(b * 64 + c0 + k) * 16 + head]; }
#pragma unroll
    for (int k = 0; k < 8; ++k) {
      hp0[(size_t)(c0 + k) * 32768] = make_uint2(pack2(h.x, h.y), pack2(h.z, h.w));
      h.x = h.x * dv[k] + sv[k].x; h.y = h.y * dv[k] + sv[k].y; h.z = h.z * dv[k] + sv[k].z; h.w = h.w * dv[k] + sv[k].w;
    }
  }
  ((float4*)(p.out + OFF_SSMP + (size_t)(l * 2 + b) * 131072))[rem] = h;
}

DI void s5_scan_job(const P& p, int l, int job) {
  const int gid = job * 256 + tidx();
  const int n = gid & 63, g = (gid >> 6) & 63, b = gid >> 12;
  const float* prm = p.S5P() + ((size_t)(l * 64 + g) * 36) * 64 + n;
  const float aqr = prm[128], aqi = prm[192];
  float hr = 0.f, hi = 0.f;
  float2* sp = (float2*)p.S5S() + ((size_t)(b * 128) * 64 + g) * 64 + n;
  for (int c0 = 0; c0 < 128; c0 += 8) {
    float2 sv[8];
#pragma unroll
    for (int k = 0; k < 8; ++k) sv[k] = sp[(size_t)(c0 + k) * 4096];
#pragma unroll
    for (int k = 0; k < 8; ++k) {
      sp[(size_t)(c0 + k) * 4096] = make_float2(hr, hi);
      const float nr = aqr * hr - aqi * hi + sv[k].x, ni = aqr * hi + aqi * hr + sv[k].y;
      hr = nr; hi = ni;
    }
  }
}

DI void ssd_c_job(const P& p, int l, int job, char* smem) {
  const int g = job & 3, c = (job >> 2) & 63, b = job >> 8;
  const int tok0 = b * SEQ + c * 128;
  bf16_t* sC = (bf16_t*)smem;
  bf16_t* sB = sC + 128 * 136;
  float* sAc = (float*)(sB + 128 * 136);
  float* sDt = sAc + 512;
  const int tid = tidx(), lane = tid & 63, w = __builtin_amdgcn_readfirstlane(tid >> 6), lr = lane & 31, lh = lane >> 5, wm = w & 1, wn = w >> 1;
  __syncthreads();
  { float alast; chunk_acum(p, l, g * 4 + w, tok0, sAc + w * 128, sDt + w * 128, alast); }
#pragma unroll
  for (int it = 0; it < 8; ++it) {
    const int item = tid + 256 * it, r = item >> 4, s0 = (item & 15) * 8;
    *(uint4*)(sC + r * 136 + s0) = *(const uint4*)(p.BC() + (size_t)(tok0 + r) * 1024 + 512 + g * 128 + s0);
    *(uint4*)(sB + r * 136 + s0) = *(const uint4*)(p.BC() + (size_t)(tok0 + r) * 1024 + g * 128 + s0);
  }
  __syncthreads();
  f32x16 cb[2][2];
#pragma unroll
  for (int a = 0; a < 2; ++a)
#pragma unroll
    for (int bb = 0; bb < 2; ++bb) zero16(cb[a][bb]);
  if (!(wm == 0 && wn == 1)) {
#pragma unroll
    for (int kk = 0; kk < 8; ++kk) {
      bf16x8 af[2], bfr[2];
#pragma unroll
      for (int mi = 0; mi < 2; ++mi) af[mi] = *(const bf16x8*)(sC + (wm * 64 + mi * 32 + lr) * 136 + kk * 16 + lh * 8);
#pragma unroll
      for (int ni = 0; ni < 2; ++ni) bfr[ni] = *(const bf16x8*)(sB + (wn * 64 + ni * 32 + lr) * 136 + kk * 16 + lh * 8);
#pragma unroll
      for (int mi = 0; mi < 2; ++mi)
#pragma unroll
        for (int ni = 0; ni < 2; ++ni) cb[mi][ni] = MFMA32(af[mi], bfr[ni], cb[mi][ni]);
    }
  }
  __syncthreads();
  bf16_t* sM = sB;
  unsigned cbp[2][2][8];
#pragma unroll
  for (int a = 0; a < 2; ++a)
#pragma unroll
    for (int bb = 0; bb < 2; ++bb)
#pragma unroll
      for (int k = 0; k < 8; ++k) cbp[a][bb][k] = pack2(cb[a][bb][2 * k], cb[a][bb][2 * k + 1]);
  float ss[16];
#pragma unroll
  for (int i = 0; i < 16; ++i) ss[i] = 0.f;
#pragma unroll 1
  for (int hd = 0; hd < 4; ++hd) {
    const int head = g * 4 + hd;
    const float* ac = sAc + hd * 128;
    const float* dtv = sDt + hd * 128;
    const int lrq = launder(lr), lhq = launder(lh);
#pragma unroll
    for (int mi = 0; mi < 2; ++mi)
#pragma unroll
      for (int ni = 0; ni < 2; ++ni) {
        const int s = wn * 64 + ni * 32 + lrq;
        const float as = ac[s], ds = dtv[s];
#pragma unroll
        for (int i = 0; i < 16; ++i) {
          const int t = wm * 64 + mi * 32 + crow(i, lhq);
          const float cv = (i & 1) ? bfhi(cbp[mi][ni][i >> 1]) : bflo(cbp[mi][ni][i >> 1]);
          const float v = (s <= t) ? cv * __expf(ac[t] - as) * ds : 0.f;
          sM[t * 136 + s] = f2bf(v);
        }
        __builtin_amdgcn_sched_barrier(0);
      }
    __syncthreads();
    f32x16 yd[2];
    zero16(yd[0]); zero16(yd[1]);
    {
      const bf16_t* hb = p.HP() + (((size_t)((b * 64 + c) * 16 + head) * 64 + lr) * 128 + lh * 8);
      bf16x8 hf[8][2];
#pragma unroll
      for (int kk = 0; kk < 8; ++kk)
#pragma unroll
        for (int pb = 0; pb < 2; ++pb) hf[kk][pb] = *(const bf16x8*)(hb + (size_t)pb * 32 * 128 + kk * 16);
#pragma unroll
      for (int kk = 0; kk < 8; ++kk) {
        const bf16x8 af = *(const bf16x8*)(sC + (32 * w + lr) * 136 + kk * 16 + lh * 8);
        yd[0] = MFMA32(af, hf[kk][0], yd[0]);
        yd[1] = MFMA32(af, hf[kk][1], yd[1]);
      }
    }
#pragma unroll
    for (int i = 0; i < 16; ++i) {
      const float e = __expf(ac[32 * w + crow(i, lh)]);
      yd[0][i] *= e; yd[1][i] *= e;
    }
    {
      const int nkk = 2 * (w + 1);
      const bf16_t* xb = p.XBT() + (size_t)(head * 64 + lr) * TP + tok0 + lh * 8;
      const bf16_t* am = sM + (32 * w + lr) * 136 + lh * 8;
      bf16x8 x00 = *(const bf16x8*)(xb), x01 = *(const bf16x8*)(xb + (size_t)32 * TP);
      for (int kk = 0; kk < nkk; kk += 2) {
        const bf16x8 x10 = *(const bf16x8*)(xb + (kk + 1) * 16), x11 = *(const bf16x8*)(xb + (size_t)32 * TP + (kk + 1) * 16);
        const bf16x8 a0 = *(const bf16x8*)(am + kk * 16);
        yd[0] = MFMA32(a0, x00, yd[0]);
        yd[1] = MFMA32(a0, x01, yd[1]);
        const int kn = (kk + 2 < nkk) ? kk + 2 : kk;
        x00 = *(const bf16x8*)(xb + kn * 16); x01 = *(const bf16x8*)(xb + (size_t)32 * TP + kn * 16);
        const bf16x8 a1 = *(const bf16x8*)(am + (kk + 1) * 16);
        yd[0] = MFMA32(a1, x10, yd[0]);
        yd[1] = MFMA32(a1, x11, yd[1]);
      }
    }
    const float Dh = p.m_d[l * 16 + head];
#pragma unroll
    for (int pb = 0; pb < 2; ++pb) {
      const int pch = head * 64 + pb * 32 + lr;
#pragma unroll
      for (int ig = 0; ig < 4; ++ig) {
        const int t0 = 32 * w + 8 * ig + 4 * lh;
        const uint2 xr = *(const uint2*)(p.XBT() + (size_t)pch * TP + tok0 + t0);
        const float xs[4] = {bflo(xr.x), bfhi(xr.x), bflo(xr.y), bfhi(xr.y)};
#pragma unroll
        for (int jj = 0; jj < 4; ++jj) {
          const int i = 4 * ig + jj, t = t0 + jj;
          const float y = yd[pb][i] + Dh * xs[jj];
          const float z = bf2f(p.Z()[(size_t)(tok0 + t) * 1024 + pch]);
          const float yg = y * silu_f(z);
          ss[i] += yg * yg;
          p.YM()[(size_t)(tok0 + t) * 1024 + pch] = f2bf(yg);
        }
      }
      __builtin_amdgcn_sched_barrier(0);
    }
    __syncthreads();
  }
#pragma unroll
  for (int i = 0; i < 16; ++i) {
    float v = ss[i];
    v += __shfl_xor(v, 1); v += __shfl_xor(v, 2); v += __shfl_xor(v, 4); v += __shfl_xor(v, 8); v += __shfl_xor(v, 16);
    ss[i] = rsqrtf(v * (1.f / 256.f) + EPS);
  }
  for (int hd = 0; hd < 4; ++hd) {
#pragma unroll
    for (int pb = 0; pb < 2; ++pb) {
      const int pch = (g * 4 + hd) * 64 + pb * 32 + lr;
      const float nw = p.m_norm_w[l * 1024 + pch];
#pragma unroll
      for (int i = 0; i < 16; ++i) {
        const size_t idx = (size_t)(tok0 + 32 * w + crow(i, lh)) * 1024 + pch;
        p.YM()[idx] = f2bf(bf2f(p.YM()[idx]) * ss[i] * nw);
      }
      __builtin_amdgcn_sched_barrier(0);
    }
  }
}

DI void ssd_sample_job(const P& p, int l, int job, char* smem) {
  const int g = job & 3, b = job >> 2;
  float* sx = (float*)smem;
  float* sBv = sx + 256;
  float* sCv = sBv + 128;
  float* sY = sCv + 128;
  float* sRed = sY + 256;
  const int tid = tidx(), lane = tid & 63, w = __builtin_amdgcn_readfirstlane(tid >> 6);
  const int row = TP + b;
  __syncthreads();
#pragma unroll
  for (int it = 0; it < 2; ++it) {
    const int idx = tid + 256 * it;
    const int ch = idx < 256 ? g * 256 + idx : (idx < 384 ? 1024 + g * 128 + (idx - 256) : 1536 + g * 128 + (idx - 384));
    const float* sc = p.state_conv + ((size_t)(l * 128 + b) * 3) * 2048 + ch;
    const float s0 = sc[0], s1 = sc[2048], s2 = sc[4096];
    const float raw = bf2f(p.XBC()[(size_t)row * 2048 + ch]);
    const float* cw = p.conv_w + (size_t)l * 4 * 2048 + ch;
    float v = p.conv_b[l * 2048 + ch] + cw[0] * s0 + cw[2048] * s1 + cw[4096] * s2 + cw[6144] * raw;
    v = silu_f(v);
    sx[idx] = v;
    float* co = p.out + OFF_CONVS + ((size_t)(l * 128 + b) * 3) * 2048 + ch;
    co[0] = s1; co[2048] = s2;
  }
  __syncthreads();
  for (int hd = 0; hd < 4; ++hd) {
    const int head = g * 4 + hd;
    const float dt = p.DT()[(size_t)row * 16 + head];
    const float Ah = -expf(p.a_log[l * 16 + head]);
    const float dA = __expf(dt * Ah);
    const int pp = tid >> 2, nq = (tid & 3) * 32;
    const float xv = sx[hd * 64 + pp];
    const float coef = dt * xv;
    const size_t so = ((((size_t)l * 128 + b) * 16 + head) * 64 + pp) * 128 + nq;
    const float4* h0 = (const float4*)(p.state_ssm + so);
    float4* ho = (float4*)(p.out + OFF_SSMS + so);
    float yacc = 0.f;
#pragma unroll
    for (int q = 0; q < 8; ++q) {
      float4 hv = h0[q];
      const int n = nq + 4 * q;
      hv.x = hv.x * dA + coef * sBv[n]; hv.y = hv.y * dA + coef * sBv[n + 1]; hv.z = hv.z * dA + coef * sBv[n + 2]; hv.w = hv.w * dA + coef * sBv[n + 3];
      yacc += hv.x * sCv[n] + hv.y * sCv[n + 1] + hv.z * sCv[n + 2] + hv.w * sCv[n + 3];
      ho[q] = hv;
    }
    yacc += __shfl_xor(yacc, 1); yacc += __shfl_xor(yacc, 2);
    const float y = yacc + p.m_d[l * 16 + head] * xv;
    const float z = bf2f(p.Z()[(size_t)row * 1024 + head * 64 + pp]);
    if ((tid & 3) == 0) sY[hd * 64 + pp] = y * silu_f(z);
  }
  __syncthreads();
  const float v = sY[tid];
  const float ssq = wave_sum(v * v);
  if (lane == 0) sRed[w] = ssq;
  __syncthreads();
  const float tot = sRed[0] + sRed[1] + sRed[2] + sRed[3];
  const float sc = rsqrtf(tot * (1.f / 256.f) + EPS);
  p.YM()[(size_t)row * 1024 + g * 256 + tid] = f2bf(v * sc * p.m_norm_w[l * 1024 + g * 256 + tid]);
}

DI void s5_wave_job(const P& p, int l, int mode, int b, int g, int c, bf16_t* sH) {
  const int lane = tidx() & 63, lr = lane & 31, lh = lane >> 5;
  bf16x8 bq[4];
#pragma unroll
  for (int nb = 0; nb < 4; ++nb) bq[nb] = *(const bf16x8*)(p.BBT() + ((size_t)(l * 64 + g) * 128 + nb * 32 + lr) * 16 + lh * 8);
  float ar[2], ai[2], cr_[2], ci_[2];
  int row0, Q;
  if (mode == 2) { row0 = TP + b; Q = 1; } else { row0 = b * SEQ + c * 64; Q = 64; }
#pragma unroll
  for (int k = 0; k < 2; ++k) {
    const int n = k * 32 + lr;
    const float* prm = p.S5P() + ((size_t)(l * 64 + g) * 36) * 64 + n;
    ar[k] = prm[0]; ai[k] = prm[64];
    cr_[k] = 0.f; ci_[k] = 0.f;
    if (mode == 2) {
      cr_[k] = p.s5_sre[((size_t)(l * 128 + b) * 64 + g) * 64 + n];
      ci_[k] = p.s5_sim[((size_t)(l * 128 + b) * 64 + g) * 64 + n];
    } else if (mode == 1) {
      const float2 sv = *(const float2*)(p.S5S() + (((size_t)(b * 128 + c) * 64 + g) * 64 + n) * 2);
      cr_[k] = sv.x; ci_[k] = sv.y;
    }
  }
  const int ntb = (mode == 2) ? 1 : 2;
  for (int tb = 0; tb < ntb; ++tb) {
    const bf16x8 uf = *(const bf16x8*)(p.U() + (size_t)(row0 + tb * 32 + lr) * 1024 + g * 16 + lh * 8);
    f32x16 acc[4];
#pragma unroll
    for (int nb = 0; nb < 4; ++nb) { zero16(acc[nb]); acc[nb] = MFMA32(uf, bq[nb], acc[nb]); }
#pragma unroll
    for (int k = 0; k < 2; ++k) {
      const float a1r = ar[k], a1i = ai[k];
      const float a2r = a1r * a1r - a1i * a1i, a2i = 2.f * a1r * a1i;
      const float a3r = a2r * a1r - a2i * a1i, a3i = a2r * a1i + a2i * a1r;
      const float a4r = a2r * a2r - a2i * a2i, a4i = 2.f * a2r * a2i;
      float er[4], ei[4];
#pragma unroll
      for (int q = 0; q < 4; ++q) {
        float hr = acc[k][4 * q], hi = acc[2 + k][4 * q];
#pragma unroll
        for (int j = 1; j < 4; ++j) {
          const float nr = a1r * hr - a1i * hi + acc[k][4 * q + j], ni = a1r * hi + a1i * hr + acc[2 + k][4 * q + j];
          hr = nr; hi = ni;
          acc[k][4 * q + j] = hr; acc[2 + k][4 * q + j] = hi;
        }
        er[q] = hr; ei[q] = hi;
      }
      float cinr[4], cini[4];
      float cr = cr_[k], ci = ci_[k];
#pragma unroll
      for (int q = 0; q < 4; ++q) {
        const float per = __shfl_xor(er[q], 32), pei = __shfl_xor(ei[q], 32);
        const float e0r = lh ? per : er[q], e0i = lh ? pei : ei[q];
        const float e1r = lh ? er[q] : per, e1i = lh ? ei[q] : pei;
        const float c1r = a4r * cr - a4i * ci + e0r, c1i = a4r * ci + a4i * cr + e0i;
        cinr[q] = lh ? c1r : cr; cini[q] = lh ? c1i : ci;
        cr = a4r * c1r - a4i * c1i + e1r; ci = a4r * c1i + a4i * c1r + e1i;
      }
#pragma unroll
      for (int q = 0; q < 4; ++q) {
        const float xr = cinr[q], xi = cini[q];
        acc[k][4 * q] += a1r * xr - a1i * xi;     acc[2 + k][4 * q] += a1r * xi + a1i * xr;
        acc[k][4 * q + 1] += a2r * xr - a2i * xi; acc[2 + k][4 * q + 1] += a2r * xi + a2i * xr;
        acc[k][4 * q + 2] += a3r * xr - a3i * xi; acc[2 + k][4 * q + 2] += a3r * xi + a3i * xr;
        acc[k][4 * q + 3] += a4r * xr - a4i * xi; acc[2 + k][4 * q + 3] += a4r * xi + a4i * xr;
      }
      if (mode == 2) { cr_[k] = acc[k][0]; ci_[k] = acc[2 + k][0]; }
      else { cr_[k] = cr; ci_[k] = ci; }
      if (mode != 0) {
#pragma unroll
        for (int i = 0; i < 16; ++i) {
          const int t = tb * 32 + crow(i, lh);
          sH[t * 136 + k * 32 + lr] = f2bf(acc[k][i]);
          sH[t * 136 + 64 + k * 32 + lr] = f2bf(acc[2 + k][i]);
        }
      }
    }
  }
  if (lh == 0) {
#pragma unroll
    for (int k = 0; k < 2; ++k) {
      const int n = k * 32 + lr;
      if (mode == 0) *(float2*)(p.S5S() + (((size_t)(b * 128 + c) * 64 + g) * 64 + n) * 2) = make_float2(cr_[k], ci_[k]);
      if (mode == 1 && c == 127) {
        p.out[OFF_S5RP + ((size_t)(l * 2 + b) * 64 + g) * 64 + n] = cr_[k];
        p.out[OFF_S5IP + ((size_t)(l * 2 + b) * 64 + g) * 64 + n] = ci_[k];
      }
      if (mode == 2) {
        p.out[OFF_S5RS + ((size_t)(l * 128 + b) * 64 + g) * 64 + n] = cr_[k];
        p.out[OFF_S5IS + ((size_t)(l * 128 + b) * 64 + g) * 64 + n] = ci_[k];
      }
    }
  }
  if (mode == 0) return;
  const int o = lane & 15, quad = lane >> 4;
  bf16x8 cf[4];
#pragma unroll
  for (int kk = 0; kk < 4; ++kk) {
    const float* cp = ((kk < 2) ? p.c_re : p.c_im) + ((size_t)(l * 64 + g) * 16 + o) * 64 + (kk & 1) * 32 + quad * 8;
    const float4 c0 = ((const float4*)cp)[0], c1 = ((const float4*)cp)[1];
    const float sg = (kk < 2) ? 1.f : -1.f;
    cf[kk] = u4_to_bf8(make_uint4(pack2(sg * c0.x, sg * c0.y), pack2(sg * c0.z, sg * c0.w), pack2(sg * c1.x, sg * c1.y), pack2(sg * c1.z, sg * c1.w)));
  }
  const float dsk = p.s5_d[l * 1024 + g * 16 + o];
  const int nrb = (mode == 2) ? 1 : 4;
  __builtin_amdgcn_fence(__ATOMIC_RELEASE, "wavefront");
  __builtin_amdgcn_wave_barrier();
  __builtin_amdgcn_fence(__ATOMIC_ACQUIRE, "wavefront");
  for (int rb = 0; rb < nrb; ++rb) {
    f32x4 a4 = {0.f, 0.f, 0.f, 0.f};
#pragma unroll
    for (int kk = 0; kk < 4; ++kk) {
      const bf16x8 af = *(const bf16x8*)(sH + (rb * 16 + o) * 136 + kk * 32 + quad * 8);
      a4 = MFMA16(af, cf[kk], a4);
    }
#pragma unroll
    for (int jj = 0; jj < 4; ++jj) {
      const int t = rb * 16 + quad * 4 + jj;
      if (t < Q) {
        const size_t idx = (size_t)(row0 + t) * 1024 + g * 16 + o;
        const float y = a4[jj] + dsk * bf2f(p.U()[idx]);
        p.YS()[idx] = f2bf(gelu_tanh(y));
      }
    }
  }
}

DI void attn_prompt_job(const P& p, int l, int job, char* smem) {
  const int head = job & 15, blk = (job >> 4) & 63, b = job >> 10, kvh = head >> 2;
  bf16_t* sK = (bf16_t*)smem;
  bf16_t* sVt = sK + 256 * 72;
  const int tid = tidx(), lane = tid & 63, w = __builtin_amdgcn_readfirstlane(tid >> 6), lr = lane & 31, lh = lane >> 5;
  const int tokc0 = b * SEQ + blk * 128 - 128;
  __syncthreads();
#pragma unroll
  for (int it = 0; it < 8; ++it) {
    const int item = tid + 256 * it, row = item >> 3, chk = item & 7;
    uint4 v = make_uint4(0u, 0u, 0u, 0u);
    if (blk > 0 || row >= 128) v = *(const uint4*)(p.K() + (size_t)(tokc0 + row) * 256 + kvh * 64 + chk * 8);
    *(uint4*)(sK + row * 72 + chk * 8) = v;
  }
#pragma unroll
  for (int it = 0; it < 8; ++it) {
    const int item = tid + 256 * it, d = item >> 5, chk = item & 31;
    uint4 v = make_uint4(0u, 0u, 0u, 0u);
    if (blk > 0 || chk >= 16) v = *(const uint4*)(p.VT() + (size_t)(kvh * 64 + d) * T + tokc0 + chk * 8);
    *(uint4*)(sVt + d * 264 + chk * 8) = v;
  }
  __syncthreads();
  const int qtok = b * SEQ + blk * 128 + 32 * w + lr;
  bf16x8 qf[4];
#pragma unroll
  for (int kk = 0; kk < 4; ++kk) qf[kk] = *(const bf16x8*)(p.Q() + (size_t)qtok * 1024 + head * 64 + kk * 16 + lh * 8);
  f32x16 st[5];
#pragma unroll
  for (int x = 0; x < 5; ++x) {
    zero16(st[x]);
#pragma unroll
    for (int kk = 0; kk < 4; ++kk) {
      const bf16x8 af = *(const bf16x8*)(sK + (32 * (w + x) + lr) * 72 + kk * 16 + lh * 8);
      st[x] = MFMA32(af, qf[kk], st[x]);
    }
  }
  const float sink = p.sinks[l * 16 + head];
  const int qi = 128 + 32 * w + lr;
  float m = sink;
#pragma unroll
  for (int x = 0; x < 5; ++x)
#pragma unroll
    for (int i = 0; i < 16; ++i) {
      const int kj = 32 * (w + x) + crow(i, lh);
      const bool valid = (kj <= qi) && (kj >= qi - 128) && (blk > 0 || kj >= 128);
      const float s = valid ? st[x][i] * 0.125f : -1e30f;
      st[x][i] = s;
      m = fmaxf(m, s);
    }
  m = fmaxf(m, __shfl_xor(m, 32));
  float sum = 0.f;
#pragma unroll
  for (int x = 0; x < 5; ++x)
#pragma unroll
    for (int i = 0; i < 16; ++i) { const float pv = __expf(st[x][i] - m); st[x][i] = pv; sum += pv; }
  sum += __shfl_xor(sum, 32);
  const float inv = 1.f / (sum + __expf(sink - m));
  f32x16 ot[2];
  zero16(ot[0]); zero16(ot[1]);
#pragma unroll
  for (int x = 0; x < 5; ++x)
#pragma unroll
    for (int s = 0; s < 2; ++s) {
      const uint4 pu = make_uint4(pack2(st[x][8 * s] * inv, st[x][8 * s + 1] * inv), pack2(st[x][8 * s + 2] * inv, st[x][8 * s + 3] * inv),
                                  pack2(st[x][8 * s + 4] * inv, st[x][8 * s + 5] * inv), pack2(st[x][8 * s + 6] * inv, st[x][8 * s + 7] * inv));
      const bf16x8 pf = u4_to_bf8(pu);
#pragma unroll
      for (int pb = 0; pb < 2; ++pb) {
        const bf16_t* vp = sVt + (pb * 32 + lr) * 264 + 32 * (w + x) + 16 * s + 4 * lh;
        const uint2 lo = *(const uint2*)vp, hi2 = *(const uint2*)(vp + 8);
        ot[pb] = MFMA32(u4_to_bf8(make_uint4(lo.x, lo.y, hi2.x, hi2.y)), pf, ot[pb]);
      }
    }
#pragma unroll
  for (int pb = 0; pb < 2; ++pb)
#pragma unroll
    for (int ig = 0; ig < 4; ++ig) {
      const int d0 = pb * 32 + 8 * ig + 4 * lh;
      *(uint2*)(p.O() + (size_t)qtok * 1024 + head * 64 + d0) = make_uint2(pack2(ot[pb][4 * ig], ot[pb][4 * ig + 1]), pack2(ot[pb][4 * ig + 2], ot[pb][4 * ig + 3]));
    }
}

DI void attn_sample_job(const P& p, int l, int job, char* smem) {
  const int kvh = job & 3, b = job >> 2;
  const int tid = tidx(), lane = tid & 63, w = __builtin_amdgcn_readfirstlane(tid >> 6);
  const int head = kvh * 4 + w, row = TP + b;
  float* sQ = (float*)smem;
  float* sP = sQ + 256;
  const size_t cbase = ((size_t)(l * 128 + b) * 128) * 256 + kvh * 64;
  const float4* kc4 = (const float4*)(p.cache_k + cbase);
  const float4* vc4 = (const float4*)(p.cache_v + cbase);
  float4* ko4 = (float4*)(p.out + OFF_KS + cbase);
  float4* vo4 = (float4*)(p.out + OFF_VS + cbase);
  __syncthreads();
  for (int idx = tid; idx < 127 * 16; idx += 256) {
    const int j = idx >> 4, q4 = idx & 15;
    ko4[j * 64 + q4] = kc4[(j + 1) * 64 + q4];
    vo4[j * 64 + q4] = vc4[(j + 1) * 64 + q4];
  }
  const float qd = bf2f(p.Q()[(size_t)row * 1024 + head * 64 + lane]);
  sQ[w * 64 + lane] = qd;
  __syncthreads();
  float s0 = 0.f, s1 = 0.f;
#pragma unroll 4
  for (int d4 = 0; d4 < 16; ++d4) {
    const float4 q4 = ((const float4*)(sQ + w * 64))[d4];
    const float4 k0 = kc4[lane * 64 + d4], k1 = kc4[(lane + 64) * 64 + d4];
    s0 += q4.x * k0.x + q4.y * k0.y + q4.z * k0.z + q4.w * k0.w;
    s1 += q4.x * k1.x + q4.y * k1.y + q4.z * k1.z + q4.w * k1.w;
  }
  s0 *= 0.125f; s1 *= 0.125f;
  const float s2 = wave_sum(qd * bf2f(p.K()[(size_t)row * 256 + kvh * 64 + lane])) * 0.125f;
  const float sink = p.sinks[l * 16 + head];
  float m = fmaxf(fmaxf(s0, s1), fmaxf(s2, sink));
  m = wave_max(m);
  const float p0 = __expf(s0 - m), p1 = __expf(s1 - m), p2 = __expf(s2 - m);
  const float sum = wave_sum(p0 + p1);
  const float inv = 1.f / (sum + p2 + __expf(sink - m));
  sP[w * 132 + lane] = p0 * inv; sP[w * 132 + 64 + lane] = p1 * inv;
  __syncthreads();
  const float* vc = p.cache_v + cbase + lane;
  float o = 0.f;
#pragma unroll 8
  for (int j = 0; j < 128; ++j) o += sP[w * 132 + j] * vc[(size_t)j * 256];
  o += p2 * inv * bf2f(p.VT()[(size_t)(kvh * 64 + lane) * T + row]);
  p.O()[(size_t)row * 1024 + head * 64 + lane] = f2bf(o);
}

template <int PASS>
DI void merge_pass(const P& p, const bf16_t* A, const bf16_t* Wt, int m0, int n0, char* smem) {
  m0 = launder_s(m0); n0 = launder_s(n0);
  const int tid = tidx(), lane = tid & 63, w = __builtin_amdgcn_readfirstlane(tid >> 6), wm = w & 1, wn = w >> 1, lr = lane & 31, lh = lane >> 5;
  f32x16 acc[2][GNB];
#pragma unroll
  for (int a = 0; a < 2; ++a)
#pragma unroll
    for (int b = 0; b < GNB; ++b) zero16(acc[a][b]);
  gemm_mainloop(A + (size_t)m0 * 1024, 1024, Wt + (size_t)n0 * 1024, 1024, 1024, acc, smem);
  m0 = launder_s(m0); n0 = launder_s(n0);
  bf16_t* sT = (bf16_t*)smem;
  stage_tile(sT, acc, wm, wn, lr, lh);
  __syncthreads();
  const int goff = (PASS == 0) ? 1024 : (PASS == 2) ? 0 : 2048;
#pragma unroll 2
  for (int it = 0; it < 16; ++it) {
    const int idx = tid + 256 * it, row = idx >> 5, chunk = idx & 31;
    const uint4 av = *(const uint4*)(sT + row * LDS_T + chunk * 8);
    uint4* mp = (uint4*)(p.MG() + (size_t)(m0 + row) * 1024 + n0 + chunk * 8);
    uint4 gv = make_uint4(0u, 0u, 0u, 0u), mv = gv;
    if (PASS != 1) gv = *(const uint4*)(p.G() + (size_t)(m0 + row) * 3072 + goff + n0 + chunk * 8);
    if (PASS != 0) mv = *mp;
    const unsigned aw[4] = {av.x, av.y, av.z, av.w}, gw[4] = {gv.x, gv.y, gv.z, gv.w}, mw[4] = {mv.x, mv.y, mv.z, mv.w};
    unsigned ow[4];
#pragma unroll
    for (int k = 0; k < 4; ++k) {
      const float a0 = bflo(aw[k]), a1 = bfhi(aw[k]), g0 = bflo(gw[k]), g1 = bfhi(gw[k]), m0_ = bflo(mw[k]), m1_ = bfhi(mw[k]);
      float o0, o1;
      if (PASS == 0) { o0 = sigm_f(a0) * g0; o1 = sigm_f(a1) * g1; }
      else if (PASS == 1) { o0 = m0_ * a0; o1 = m1_ * a1; }
      else { o0 = m0_ + a0 * g0; o1 = m1_ + a1 * g1; }
      ow[k] = pack2(o0, o1);
    }
    *mp = make_uint4(ow[0], ow[1], ow[2], ow[3]);
  }
}
DI void merge_job(const P& p, int l, int job, char* smem) {
  int mt, nt;
  if (!gemm_tile(job, 128, 4, mt, nt)) return;
  const int m0 = mt * 128, n0 = nt * 256;
  const bf16_t* wl = p.Wt() + (size_t)l * W_LAYER;
  merge_pass<0>(p, p.YS(), wl + WO_GLU + (size_t)1024 * 1024, m0, n0, smem);
  merge_pass<1>(p, p.YS(), wl + WO_GLU, m0, n0, smem);
  merge_pass<2>(p, p.YM(), wl + WO_MPROJ, m0, n0, smem);
  merge_pass<3>(p, p.O(), wl + WO_ATTNO, m0, n0, smem);
}
DI void resid_gemm_job(const P& p, const bf16_t* A, int lda, const bf16_t* Wt, int K, int job, char* smem) {
  int mt, nt;
  if (!gemm_tile(job, 128, 4, mt, nt)) return;
  const int m0 = mt * 128, n0 = nt * 256;
  const int tid = tidx(), lane = tid & 63, w = __builtin_amdgcn_readfirstlane(tid >> 6), wm = w & 1, wn = w >> 1, lr = lane & 31, lh = lane >> 5;
  f32x16 acc[2][GNB];
#pragma unroll
  for (int a = 0; a < 2; ++a)
#pragma unroll
    for (int b = 0; b < GNB; ++b) zero16(acc[a][b]);
  gemm_mainloop(A + (size_t)m0 * lda, lda, Wt + (size_t)n0 * K, K, K, acc, smem);
#pragma unroll
  for (int mi = 0; mi < 2; ++mi)
#pragma unroll
    for (int ni = 0; ni < GNB; ++ni) {
      const int c = n0 + wn * 128 + ni * 32 + lr;
#pragma unroll
      for (int i = 0; i < 16; ++i) {
        const int r = m0 + wm * 64 + mi * 32 + crow(i, lh);
        p.X()[(size_t)r * 1024 + c] += acc[mi][ni][i];
      }
    }
}
DI void up_job(const P& p, int l, int job, char* smem) {
  int mt, nt;
  if (!gemm_tile(job, 128, 16, mt, nt)) return;
  int m0 = mt * 128, n0 = nt * 256;
  const int tid = tidx(), lane = tid & 63, w = __builtin_amdgcn_readfirstlane(tid >> 6), wm = w & 1, wn = w >> 1, lr = lane & 31, lh = lane >> 5;
  f32x16 acc[2][GNB];
#pragma unroll
  for (int a = 0; a < 2; ++a)
#pragma unroll
    for (int b = 0; b < GNB; ++b) zero16(acc[a][b]);
  gemm_mainloop(p.H() + (size_t)m0 * 1024, 1024, p.Wt() + (size_t)l * W_LAYER + WO_UP + (size_t)n0 * 1024, 1024, 1024, acc, smem);
#if PROBE_DUP == 12
  gemm_mainloop(p.H() + (size_t)m0 * 1024, 1024, p.Wt() + (size_t)l * W_LAYER + WO_UP + (size_t)n0 * 1024, 1024, 1024, acc, smem);
#pragma unroll
  for (int mi = 0; mi < 2; ++mi)
#pragma unroll
    for (int ni = 0; ni < GNB; ++ni)
#pragma unroll
      for (int i = 0; i < 16; ++i) acc[mi][ni][i] *= 0.5f;
#endif
  m0 = launder_s(m0); n0 = launder_s(n0);
#pragma unroll
  for (int mi = 0; mi < 2; ++mi)
#pragma unroll
    for (int ni = 0; ni < GNB; ++ni)
#pragma unroll
      for (int i = 0; i < 16; ++i) { const float v = fmaxf(acc[mi][ni][i], 0.f); acc[mi][ni][i] = v * v; }
  bf16_t* sT = (bf16_t*)smem;
  stage_tile(sT, acc, wm, wn, lr, lh);
  __syncthreads();
  tile_writeout(p.A2() + (size_t)m0 * 4096 + n0, 4096, sT);
}

DI float skinny_dot(const bf16_t* __restrict__ A, int lda, const bf16_t* __restrict__ Wt, int K, int r0, int c0, char* smem) {
  float* sR = (float*)smem;
  const int tid = tidx(), lane = tid & 63, w = __builtin_amdgcn_readfirstlane(tid >> 6), r = lane & 15, quad = lane >> 4;
  const int kq = K >> 2;
  const bf16_t* ap = A + (size_t)(r0 + r) * lda + w * kq + quad * 8;
  const bf16_t* bp = Wt + (size_t)(c0 + r) * K + w * kq + quad * 8;
  f32x4 acc = {0.f, 0.f, 0.f, 0.f};
#pragma unroll 4
  for (int k = 0; k < kq; k += 32) {
    const bf16x8 a = *(const bf16x8*)(ap + k), b = *(const bf16x8*)(bp + k);
    acc = MFMA16(a, b, acc);
  }
  __syncthreads();
#pragma unroll
  for (int j = 0; j < 4; ++j) sR[w * 256 + (quad * 4 + j) * 16 + r] = acc[j];
  __syncthreads();
  return sR[tid] + sR[256 + tid] + sR[512 + tid] + sR[768 + tid];
}
DI void skinny_merge_job(const P& p, int l, int job, char* smem) {
  const int rt = job & 7, ct = job >> 3;
  const int r0 = TP + rt * 16, c0 = ct * 16;
  const bf16_t* wl = p.Wt() + (size_t)l * W_LAYER;
  const float ag = skinny_dot(p.YS(), 1024, wl + WO_GLU + (size_t)1024 * 1024, 1024, r0, c0, smem);
  const float av = skinny_dot(p.YS(), 1024, wl + WO_GLU, 1024, r0, c0, smem);
  const float am = skinny_dot(p.YM(), 1024, wl + WO_MPROJ, 1024, r0, c0, smem);
  const float aa = skinny_dot(p.O(), 1024, wl + WO_ATTNO, 1024, r0, c0, smem);
  const int tid = tidx(), r = r0 + (tid >> 4), c = c0 + (tid & 15);
  const bf16_t* gp = p.G() + (size_t)r * 3072 + c;
  const float v = bf2f(gp[0]) * am + bf2f(gp[1024]) * av * sigm_f(ag) + bf2f(gp[2048]) * aa;
  p.MG()[(size_t)r * 1024 + c] = f2bf(v);
}
DI void skinny_resid_job(const P& p, const bf16_t* A, int lda, const bf16_t* Wt, int K, int job, char* smem) {
  const int rt = job & 7, ct = job >> 3;
  const int r0 = TP + rt * 16, c0 = ct * 16;
  const float v = skinny_dot(A, lda, Wt, K, r0, c0, smem);
  const int tid = tidx();
  p.X()[(size_t)(r0 + (tid >> 4)) * 1024 + c0 + (tid & 15)] += v;
}
DI void skinny_up_job(const P& p, int l, int job, char* smem) {
  const int rt = job & 7, ct = job >> 3;
  const int r0 = TP + rt * 16, c0 = ct * 16;
  const float v = fmaxf(skinny_dot(p.H(), 1024, p.Wt() + (size_t)l * W_LAYER + WO_UP, 1024, r0, c0, smem), 0.f);
  const int tid = tidx();
  p.A2()[(size_t)(r0 + (tid >> 4)) * 4096 + c0 + (tid & 15)] = f2bf(v * v);
}

#define XB_TMO      128
#define XB_XCNT(j)  (256  + 64 * (j))
#define XB_XSUB(j)  (1280 + 64 * (j))
#define XB_XGEN(j)  (2304 + 64 * (j))
#define XB_TOP      3328
#define XB_TOPGEN   3392
#define XCD_BAR_WORDS 3456
#define XB_SPIN_CAP (1u << 20)
#define LAS __attribute__((address_space(3)))
DI unsigned xb_ld(unsigned* p) { return __hip_atomic_load(p, __ATOMIC_RELAXED, __HIP_MEMORY_SCOPE_AGENT); }
DI unsigned xb_add(unsigned* p, unsigned v) { return __hip_atomic_fetch_add(p, v, __ATOMIC_RELAXED, __HIP_MEMORY_SCOPE_AGENT); }
DI unsigned xb_xcc_id() { return (unsigned)__builtin_amdgcn_s_getreg((3 << 11) | 20) & 0xFu; }
#define XB_SPIN(cond, bar) do { unsigned _sp = 0; while (cond) { __builtin_amdgcn_s_sleep(1); \
    if ((++_sp & 255u) == 0u) { if (xb_ld(&(bar)[XB_TMO])) break; if (_sp > XB_SPIN_CAP) { atomicAdd(&(bar)[XB_TMO], 1u); break; } } } } while (0)
struct XcdBarrier { unsigned* bar; unsigned x; volatile LAS unsigned* st; };
DI XcdBarrier xcd_barrier_post(unsigned* bar, volatile LAS unsigned* st) {
  XcdBarrier b; b.bar = bar; b.x = xb_xcc_id(); b.st = st;
  if (threadIdx.x == 0) (void)xb_add(&bar[XB_XCNT(b.x)], 1u);
  return b;
}
DI void xcd_barrier_complete(unsigned* bar, unsigned x, unsigned& nloc, unsigned& nx) {
  const unsigned G = gridDim.x * gridDim.y * gridDim.z;
  unsigned sum, cnt, mine, sp = 0u;
  for (;;) {
    sum = 0u; cnt = 0u; mine = 0u;
#pragma unroll
    for (unsigned j = 0; j < 16; ++j) { const unsigned c = xb_ld(&bar[XB_XCNT(j)]); sum += c; cnt += (c > 0u) ? 1u : 0u; mine = (j == x) ? c : mine; }
    if (sum == G) break;
    __builtin_amdgcn_s_sleep(1);
    if ((++sp & 255u) == 0u) { if (xb_ld(&bar[XB_TMO])) break; if (sp > XB_SPIN_CAP) { atomicAdd(&bar[XB_TMO], 1u); break; } }
  }
  nloc = mine > 0u ? mine : 1u; nx = cnt > 0u ? cnt : 1u;
}
DI void xcd_barrier(const XcdBarrier& b) {
  asm volatile("s_waitcnt vmcnt(0)" ::: "memory");
  __syncthreads();
  if (threadIdx.x == 0) {
    unsigned* bar = b.bar;
    __builtin_amdgcn_s_waitcnt(0);
    unsigned nloc = b.st[0], nx = b.st[1];
    if (nloc == 0u) { xcd_barrier_complete(bar, b.x, nloc, nx); b.st[0] = nloc; b.st[1] = nx; }
    const unsigned old = xb_add(&bar[XB_XSUB(b.x)], 1u);
    const unsigned gen = old / nloc;
    if (old + 1u == (gen + 1u) * nloc) {
      __builtin_amdgcn_fence(__ATOMIC_RELEASE, "agent");
      asm volatile("s_waitcnt vmcnt(0)" ::: "memory");
      const unsigned og = xb_add(&bar[XB_TOP], 1u);
      const unsigned tg = og / nx;
      if (og + 1u == (tg + 1u) * nx) xb_add(&bar[XB_TOPGEN], 1u);
      else XB_SPIN(xb_ld(&bar[XB_TOPGEN]) == tg, bar);
      __builtin_amdgcn_fence(__ATOMIC_ACQUIRE, "agent");
      xb_add(&bar[XB_XGEN(b.x)], 1u);
      asm volatile("s_waitcnt vmcnt(0)" ::: "memory");
    } else {
      XB_SPIN(xb_ld(&bar[XB_XGEN(b.x)]) == gen, bar);
      __builtin_amdgcn_fence(__ATOMIC_ACQUIRE, "agent");
      asm volatile("s_waitcnt vmcnt(0)" ::: "memory");
    }
  }
  __syncthreads();
}

constexpr int NPHASE = 1 + 4 * 11;
DI void phase_jobs(int ph, int& nstd, int& nother) {
  nstd = 0;
  if (ph == 0) { nother = 22272 + 64 + 257 + 4128; return; }
  const int s = (ph - 1) % 11;
  switch (s) {
    case 0: nstd = 129 * 35; nother = 0; break;
    case 1: nother = 2048 + 4096 + 4096 + 512 + 2048 + 512; break;
    case 2: nother = 2048; break;
    case 3: nother = 256 + 32; break;
    case 4: nother = 512 + 4096; break;
    case 5: nstd = 512; nother = 512; break;
    case 6: nstd = 512; nother = 512; break;
    case 7: nother = 4128; break;
    case 8: nstd = 2048; nother = 2048; break;
    case 9: nstd = 512; nother = 512; break;
    default: nother = 4128; break;
  }
}
DI void run_std_job(const P& p, int ph, int job, char* smem) {
  const int l = (ph - 1) / 11, s = (ph - 1) % 11;
  const bf16_t* wl = p.Wt() + (size_t)l * W_LAYER;
  switch (s) {
    case 0: inproj_job(p, l, job, smem); break;
    case 5: merge_job(p, l, job, smem); break;
    case 6: resid_gemm_job(p, p.MG(), 1024, wl + WO_WOUT, 1024, job, smem); break;
    case 8: up_job(p, l, job, smem); break;
    default: resid_gemm_job(p, p.A2(), 4096, wl + WO_DOWN, 4096, job, smem); break;
  }
}
DI void run_job(const P& p, int ph, int job, char* smem) {
  if (ph == 0) {
    if (job < 22272) { prep_weight_job(p, job, smem); return; }
    job -= 22272;
    if (job < 64) { prep_s5_job(p, job); return; }
    job -= 64;
    if (job < 257) { prep_rope_job(p, job); return; }
    job -= 257;
    norm_job(p, job, p.norm1_w, true, false);
    return;
  }
  const int l = (ph - 1) / 11, s = (ph - 1) % 11;
  const bf16_t* wl = p.Wt() + (size_t)l * W_LAYER;
  const int w = __builtin_amdgcn_readfirstlane(tidx() >> 6);
  switch (s) {
    case 1:
      if (job < 512) { for (int rr = 0; rr < (PROBE_DUP == 11 ? 3 : 1); ++rr) ssd_sample_job(p, l, job, smem); break; }
      job -= 512;
      if (job < 512) { attn_sample_job(p, l, job, smem); break; }
      job -= 512;
      if (job < 2048) { for (int rr = 0; rr < (PROBE_DUP == 8 ? 3 : 1); ++rr) attn_prompt_job(p, l, job, smem); break; }
      job -= 2048;
      if (job < 4096) { for (int rr = 0; rr < (PROBE_DUP == 9 ? 3 : 1); ++rr) conv_job(p, l, job, smem); break; }
      job -= 4096;
      if (job < 4096) { const int wj = job * 4 + w; for (int rr = 0; rr < (PROBE_DUP == 10 ? 3 : 1); ++rr) s5_wave_job(p, l, 0, wj >> 13, wj & 63, (wj >> 6) & 127, nullptr); break; }
      job -= 4096;
      { const int wj = job * 4 + w; __syncthreads(); s5_wave_job(p, l, 2, wj >> 6, wj & 63, 0, (bf16_t*)smem + w * 64 * 136); }
      break;
    case 2: ssd_a_job(p, l, job, smem); break;
    case 3:
      if (job < 256) ssd_scan_job(p, l, job);
      else s5_scan_job(p, l, job - 256);
      break;
    case 4:
      if (job < 512) { ssd_c_job(p, l, job, smem); break; }
      job -= 512;
      { const int wj = job * 4 + w; __syncthreads(); s5_wave_job(p, l, 1, wj >> 13, wj & 63, (wj >> 6) & 127, (bf16_t*)smem + w * 64 * 136); }
      break;
    case 5: skinny_merge_job(p, l, job, smem); break;
    case 6: skinny_resid_job(p, p.MG(), 1024, wl + WO_WOUT, 1024, job, smem); break;
    case 7: norm_job(p, job, p.norm2_w + l * 1024, false, false); break;
    case 8: skinny_up_job(p, l, job, smem); break;
    case 9: skinny_resid_job(p, p.A2(), 4096, wl + WO_DOWN, 4096, job, smem); break;
    default:
      if (l == 3) norm_job(p, job, p.final_w, false, true);
      else norm_job(p, job, p.norm1_w + (l + 1) * 1024, false, false);
      break;
  }
}

template <bool COOP>
__global__ void __launch_bounds__(256, 2) mega(P p, int ph0, int ph1) {
  __shared__ __attribute__((aligned(16))) char smem[SMEM_BYTES];
  __shared__ uint4 xb_words;
  XcdBarrier xb;
  if (COOP) {
    if (threadIdx.x == 0) xb_words = make_uint4(0u, 0u, 0u, 0u);
    __syncthreads();
    xb = xcd_barrier_post((unsigned*)(p.ws + WS_BAR), (volatile LAS unsigned*)&xb_words);
  }
  const int G = (int)gridDim.x;
  for (int ph = ph0; ph < ph1; ++ph) {
    int nstd, nother;
    phase_jobs(ph, nstd, nother);
    int reps = 1;
#if PROBE_DUP
    { const int s_ = (ph == 0) ? -1 : (ph - 1) % 11;
      if (PROBE_DUP == 1 && (s_ == 0 || s_ == 5 || s_ == 8)) reps = 2;
      if (PROBE_DUP == 2 && (s_ == 1 || s_ == 2 || s_ == 4)) reps = 2;
      if (PROBE_DUP == 6 && s_ == 4) reps = 2;
      if (PROBE_DUP == 13 && s_ == 8) reps = 2;
      if (PROBE_DUP == 7 && s_ == 1) reps = 2; }
#endif
    const int nstd_r = ((nstd + G - 1) / G) * G;
    for (int rep = 0; rep < reps; ++rep) {
      for (int job = blockIdx.x; job < nstd_r; job += G) run_std_job(p, ph, job, smem);
      for (int job = blockIdx.x; job < nother; job += G) run_job(p, ph, job, smem);
    }
    if (COOP && ph + 1 < ph1) {
      if (ph == ph0) cg::this_grid().sync();
      else xcd_barrier(xb);
    }
  }
}


extern "C" void kernel_launch(void* const* d_in, const int* in_sizes, int n_in, void* d_out, int out_size, void* d_ws, size_t ws_size,
                              hipStream_t stream) {
  P p{};
  const float** pin = (const float**)&p;
  for (int i = 0; i < 33; ++i) pin[i] = (const float*)d_in[i];
  p.out = (float*)d_out;
  p.ws = (char*)d_ws;
  if (WS_TOTAL > ws_size) { fprintf(stderr, "workspace too small: need %zu have %zu\n", (size_t)WS_TOTAL, ws_size); return; }

#if COOP_MODE
  static int grid_blocks = 0;
  if (!grid_blocks) {
    int dev = 0, cus = 0, per_cu = 0;
    hipGetDevice(&dev);
    hipDeviceGetAttribute(&cus, hipDeviceAttributeMultiprocessorCount, dev);
    hipOccupancyMaxActiveBlocksPerMultiprocessor(&per_cu, mega<true>, 256, 0);
    if (per_cu > 2) per_cu = 2;
    if (per_cu < 1) per_cu = 1;
    grid_blocks = cus * per_cu;
  }
  (void)hipMemsetAsync(p.ws + WS_BAR, 0, 4096 * 4, stream);
  int ph0 = 0, ph1 = NPHASE;
  void* args[] = {&p, &ph0, &ph1};
  hipError_t e = hipLaunchCooperativeKernel((void*)mega<true>, dim3(grid_blocks), dim3(256), args, 0, stream);
  if (e != hipSuccess) fprintf(stderr, "cooperative launch failed: %s (grid %d)\n", hipGetErrorString(e), grid_blocks);
#else
  for (int ph = 0; ph < NPHASE; ++ph) mega<false><<<dim3(1024), dim3(256), 0, stream>>>(p, ph, ph + 1);
#endif
}
```

```cpp
#include <hip/hip_runtime.h>
#include <hip/hip_cooperative_groups.h>
#include <cstdio>
#include <cstdint>
namespace cg = cooperative_groups;

#define DI __device__ __forceinline__
typedef unsigned short bf16_t;
typedef short bf16x8 __attribute__((ext_vector_type(8)));
typedef float f32x16 __attribute__((ext_vector_type(16)));
typedef float f32x4 __attribute__((ext_vector_type(4)));
#define MFMA32(a, b, c) __builtin_amdgcn_mfma_f32_32x32x16_bf16((a), (b), (c), 0, 0, 0)
#define MFMA16(a, b, c) __builtin_amdgcn_mfma_f32_16x16x32_bf16((a), (b), (c), 0, 0, 0)

#ifndef COOP_MODE
#define COOP_MODE 1
#endif
#ifndef PROBE_DUP
#define PROBE_DUP 0
#endif

constexpr int TP = 16384, TS = 128, T = TP + TS, SEQ = 8192;
constexpr int NIN = 8720, NINP = 8960;
constexpr int SMEM_BYTES = 73728;
constexpr float EPS = 1e-6f;

constexpr size_t OFF_YP = 0;
constexpr size_t OFF_YS = OFF_YP + (size_t)TP * 1024;
constexpr size_t OFF_SSMP = OFF_YS + (size_t)TS * 1024;
constexpr size_t OFF_SSMS = OFF_SSMP + (size_t)4 * 2 * 16 * 64 * 128;
constexpr size_t OFF_CONVP = OFF_SSMS + (size_t)4 * 128 * 16 * 64 * 128;
constexpr size_t OFF_CONVS = OFF_CONVP + (size_t)4 * 2 * 3 * 2048;
constexpr size_t OFF_S5RP = OFF_CONVS + (size_t)4 * 128 * 3 * 2048;
constexpr size_t OFF_S5RS = OFF_S5RP + (size_t)4 * 2 * 64 * 64;
constexpr size_t OFF_S5IP = OFF_S5RS + (size_t)4 * 128 * 64 * 64;
constexpr size_t OFF_S5IS = OFF_S5IP + (size_t)4 * 2 * 64 * 64;
constexpr size_t OFF_KP = OFF_S5IS + (size_t)4 * 128 * 64 * 64;
constexpr size_t OFF_KS = OFF_KP + (size_t)4 * 2 * 128 * 256;
constexpr size_t OFF_VP = OFF_KS + (size_t)4 * 128 * 128 * 256;
constexpr size_t OFF_VS = OFF_VP + (size_t)4 * 2 * 128 * 256;

constexpr size_t WO_IN = 0;
constexpr size_t WO_MPROJ = WO_IN + (size_t)NINP * 1024;
constexpr size_t WO_GLU = WO_MPROJ + (size_t)1024 * 1024;
constexpr size_t WO_ATTNO = WO_GLU + (size_t)2048 * 1024;
constexpr size_t WO_WOUT = WO_ATTNO + (size_t)1024 * 1024;
constexpr size_t WO_UP = WO_WOUT + (size_t)1024 * 1024;
constexpr size_t WO_DOWN = WO_UP + (size_t)4096 * 1024;
constexpr size_t W_LAYER = WO_DOWN + (size_t)4096 * 1024;

constexpr size_t al256(size_t x) { return (x + 255) & ~(size_t)255; }
constexpr size_t SZ1 = (size_t)T * 1024 * 2;
constexpr size_t WS_X = 0;
constexpr size_t WS_H = WS_X + al256((size_t)T * 1024 * 4);
constexpr size_t WS_Z = WS_H + al256(SZ1);
constexpr size_t WS_U = WS_Z + al256(SZ1);
constexpr size_t WS_Q = WS_U + al256(SZ1);
constexpr size_t WS_YM = WS_Q + al256(SZ1);
constexpr size_t WS_YS = WS_YM + al256(SZ1);
constexpr size_t WS_O = WS_YS + al256(SZ1);
constexpr size_t WS_MG = WS_O + al256(SZ1);
constexpr size_t WS_XBC = WS_MG + al256(SZ1);
constexpr size_t WS_XBT = WS_XBC + al256((size_t)T * 2048 * 2);
constexpr size_t WS_BC = WS_XBT + al256((size_t)1536 * TP * 2);
constexpr size_t WS_A2END = WS_XBC + al256((size_t)T * 4096 * 2);
constexpr size_t WS_BCEND = WS_BC + al256((size_t)TP * 1024 * 2);
constexpr size_t WS_K = WS_A2END > WS_BCEND ? WS_A2END : WS_BCEND;
constexpr size_t WS_VT = WS_K + al256((size_t)T * 256 * 2);
constexpr size_t WS_G = WS_VT + al256((size_t)T * 256 * 2);
constexpr size_t WS_DT = WS_G + al256((size_t)T * 3072 * 2);
constexpr size_t WS_ST = WS_DT + al256((size_t)T * 16 * 4);
constexpr size_t WS_CDEC = WS_ST + al256((size_t)2 * 64 * 16 * 64 * 128 * 4);
constexpr size_t WS_S5S = WS_CDEC + al256((size_t)2 * 64 * 16 * 4);
constexpr size_t WS_S5P = WS_S5S + al256((size_t)2 * 128 * 64 * 64 * 2 * 4);
constexpr size_t WS_ROPE = WS_S5P + al256((size_t)4 * 64 * 36 * 64 * 4);
constexpr size_t WS_WT = WS_ROPE + al256((size_t)8193 * 8 * 8);
constexpr size_t WS_BAR = WS_WT + al256((size_t)4 * W_LAYER * 2);
constexpr size_t WS_HP = WS_BAR + al256(4096 * 4);
constexpr size_t WS_BBT = WS_HP + al256((size_t)2 * 64 * 16 * 64 * 128 * 2);
constexpr size_t WS_TOTAL = WS_BBT + al256((size_t)4 * 64 * 128 * 16 * 2);

struct P {
  const float *x_prompt, *x_sample, *state_ssm, *state_conv, *s5_sre, *s5_sim, *cache_k, *cache_v;
  const float *norm1_w, *w_in, *conv_w, *conv_b, *dt_bias, *a_log, *m_d, *m_norm_w, *m_proj;
  const float *lam_re, *lam_im, *log_step, *b_re, *b_im, *c_re, *c_im, *s5_d, *glu_w;
  const float *sinks, *attn_o, *w_out, *norm2_w, *mlp_up, *mlp_down, *final_w;
  float* out;
  char* ws;
#define WSACC(name, type, off) __device__ __forceinline__ type* name() const { return (type*)(ws + (off)); }
  WSACC(X, float, WS_X) WSACC(H, bf16_t, WS_H) WSACC(Z, bf16_t, WS_Z) WSACC(U, bf16_t, WS_U) WSACC(Q, bf16_t, WS_Q)
  WSACC(YM, bf16_t, WS_YM) WSACC(YS, bf16_t, WS_YS) WSACC(O, bf16_t, WS_O) WSACC(MG, bf16_t, WS_MG)
  WSACC(XBC, bf16_t, WS_XBC) WSACC(XBT, bf16_t, WS_XBT) WSACC(BC, bf16_t, WS_BC) WSACC(A2, bf16_t, WS_XBC)
  WSACC(K, bf16_t, WS_K) WSACC(VT, bf16_t, WS_VT) WSACC(G, bf16_t, WS_G) WSACC(DT, float, WS_DT) WSACC(ST, float, WS_ST)
  WSACC(CDEC, float, WS_CDEC) WSACC(HP, bf16_t, WS_HP) WSACC(BBT, bf16_t, WS_BBT) WSACC(S5S, float, WS_S5S) WSACC(S5P, float, WS_S5P) WSACC(ROPE, float2, WS_ROPE) WSACC(Wt, bf16_t, WS_WT)
#undef WSACC
};

typedef float f32x2_t __attribute__((ext_vector_type(2)));
typedef __bf16 bf16x2_t __attribute__((ext_vector_type(2)));
DI unsigned pack2(float a, float b) { const f32x2_t v = {a, b}; return __builtin_bit_cast(unsigned, __builtin_convertvector(v, bf16x2_t)); }
DI bf16_t f2bf(float x) { return (bf16_t)(pack2(x, 0.f) & 0xffffu); }
DI float bf2f(bf16_t b) { return __uint_as_float(((unsigned)b) << 16); }
DI float bflo(unsigned u) { return __uint_as_float(u << 16); }
DI float bfhi(unsigned u) { return __uint_as_float(u & 0xffff0000u); }
DI float silu_f(float x) { return x / (1.f + __expf(-x)); }
DI float sigm_f(float x) { return 1.f / (1.f + __expf(-x)); }
DI float softplus_f(float x) { return x > 20.f ? x : log1pf(expf(x)); }
DI float gelu_tanh(float x) { float y = 0.7978845608028654f * (x + 0.044715f * x * x * x); float t = 1.f - 2.f / (__expf(2.f * y) + 1.f); return 0.5f * x * (1.f + t); }
DI int crow(int i, int lh) { return (i & 3) + 8 * (i >> 2) + 4 * lh; }
DI int launder(int x) { asm volatile("" : "+v"(x)); return x; }
DI int tidx() { int t = __builtin_amdgcn_workitem_id_x(); asm volatile("" : "+v"(t)); return t; }
DI int launder_s(int x) { asm volatile("" : "+s"(x)); return x; }
DI float wave_sum(float v) {
#pragma unroll
  for (int o = 32; o >= 1; o >>= 1) v += __shfl_xor(v, o);
  return v;
}
DI float wave_max(float v) {
#pragma unroll
  for (int o = 32; o >= 1; o >>= 1) v = fmaxf(v, __shfl_xor(v, o));
  return v;
}
DI bf16x8 u4_to_bf8(uint4 v) { return __builtin_bit_cast(bf16x8, v); }
DI void zero16(f32x16& a) {
#pragma unroll
  for (int i = 0; i < 16; ++i) a[i] = 0.f;
}

constexpr int LDT = 40;
constexpr int GNB = 4;
DI void gemm_mainloop(const bf16_t* __restrict__ A, int lda, const bf16_t* __restrict__ B, int ldb, int K,
                      f32x16 (&acc)[2][GNB], char* smem) {
  bf16_t* sa = (bf16_t*)smem;
  bf16_t* sb = sa + 2 * 128 * LDT;
  const int tid = tidx(), lane = tid & 63, w = __builtin_amdgcn_readfirstlane(tid >> 6), wm = w & 1, wn = w >> 1, lr = lane & 31, lh = lane >> 5;
  const int r0 = tid >> 2, ch = (tid & 3) * 8;
  const bf16_t* ap = A + (size_t)r0 * lda + ch;
  const bf16_t* bp = B + (size_t)r0 * ldb + ch;
  uint4 pa0, pa1, pb0, pb1, pb2, pb3;
  uint4 qa0, qa1, qb0, qb1, qb2, qb3;
#define GLOADS(R, k0)                                                                                      \
  R##a0 = *(const uint4*)(ap + (k0)); R##a1 = *(const uint4*)(ap + (size_t)64 * lda + (k0));               \
  R##b0 = *(const uint4*)(bp + (k0)); R##b1 = *(const uint4*)(bp + (size_t)64 * ldb + (k0));               \
  R##b2 = *(const uint4*)(bp + (size_t)128 * ldb + (k0)); R##b3 = *(const uint4*)(bp + (size_t)192 * ldb + (k0));
#define SSTORES(R, bufi)                                                                                   \
  { bf16_t* da = sa + (bufi)*128 * LDT; bf16_t* db = sb + (bufi)*256 * LDT;                                \
    *(uint4*)(da + (r0)*LDT + ch) = R##a0; *(uint4*)(da + (r0 + 64) * LDT + ch) = R##a1;                   \
    *(uint4*)(db + (r0)*LDT + ch) = R##b0; *(uint4*)(db + (r0 + 64) * LDT + ch) = R##b1;                   \
    *(uint4*)(db + (r0 + 128) * LDT + ch) = R##b2; *(uint4*)(db + (r0 + 192) * LDT + ch) = R##b3; }
#define COMPUTE(bufi)                                                                                      \
  { const bf16_t* ca = sa + (bufi)*128 * LDT + (wm * 64 + lr) * LDT + lh * 8;                              \
    const bf16_t* cb = sb + (bufi)*256 * LDT + (wn * 128 + lr) * LDT + lh * 8;                             \
    _Pragma("unroll") for (int kk = 0; kk < 2; ++kk) {                                                     \
      const bf16x8 af0 = *(const bf16x8*)(ca + kk * 16), af1 = *(const bf16x8*)(ca + 32 * LDT + kk * 16);  \
      _Pragma("unroll") for (int ni = 0; ni < GNB; ++ni) {                                                 \
        const bf16x8 bfr = *(const bf16x8*)(cb + ni * 32 * LDT + kk * 16);                                 \
        acc[0][ni] = MFMA32(af0, bfr, acc[0][ni]); acc[1][ni] = MFMA32(af1, bfr, acc[1][ni]); } } }
  const int nk = K >> 5;
  const int klast = (nk - 1) * 32;
  GLOADS(p, 0)
  __syncthreads();
  SSTORES(p, 0)
  GLOADS(p, 32)
  __syncthreads();
  for (int kt = 0; kt < nk; kt += 2) {
    { const int k2 = (kt + 2) * 32; const int k0 = k2 < klast ? k2 : klast; GLOADS(q, k0) }
    COMPUTE(0)
    SSTORES(p, 1)
    __syncthreads();
    { const int k3 = (kt + 3) * 32; const int k0 = k3 < klast ? k3 : klast; GLOADS(p, k0) }
    COMPUTE(1)
    SSTORES(q, 0)
    __syncthreads();
  }
#undef GLOADS
#undef SSTORES
#undef COMPUTE
}
DI bool gemm_tile(int slot, int MT, int NT, int& mt, int& nt) {
  const int G = gridDim.x, nx = G >> 3;
  int J = slot;
  if ((G & 7) == 0) J = (slot / G) * G + (slot & 7) * nx + ((slot % G) >> 3);
  if (J >= MT * NT) return false;
  const int gw = 8 * NT, grp = J / gw, rem = J - grp * gw, fm = grp * 8;
  const int gsz = (MT - fm) < 8 ? (MT - fm) : 8;
  mt = fm + rem % gsz; nt = rem / gsz;
  return true;
}

DI int win_map(int n) {
  if (n < 3072) return n;
  if (n < 8704) return n + 16;
  if (n < 8720) return n - 8704 + 3072;
  return -1;
}
DI void wtrans_tile(const float* __restrict__ src, int N, int K, bf16_t* __restrict__ dst, int kt, int nt, bool inmap, char* smem) {
  float* s = (float*)smem;
  const int tid = tidx();
  __syncthreads();
  const int nn = tid & 63;
  int sc = nt * 64 + nn;
  if (inmap) sc = win_map(sc);
#pragma unroll
  for (int it = 0; it < 16; ++it) {
    const int kk = it * 4 + (tid >> 6);
    s[kk * 65 + nn] = (sc >= 0) ? src[(size_t)(kt * 64 + kk) * N + sc] : 0.f;
  }
  __syncthreads();
#pragma unroll
  for (int it = 0; it < 16; ++it) {
    const int n2 = it * 4 + (tid >> 6), k2 = tid & 63;
    dst[(size_t)(nt * 64 + n2) * K + kt * 64 + k2] = f2bf(s[k2 * 65 + n2]);
  }
}
DI void prep_weight_job(const P& p, int j, char* smem) {
  const int l = j / 5568; int r = j % 5568;
  bf16_t* wl = p.Wt() + (size_t)l * W_LAYER;
  if (r < 2240) { wtrans_tile(p.w_in + (size_t)l * 1024 * NIN, NIN, 1024, wl + WO_IN, r / 140, r % 140, true, smem); return; }
  r -= 2240;
  if (r < 256) { wtrans_tile(p.m_proj + (size_t)l * 1024 * 1024, 1024, 1024, wl + WO_MPROJ, r / 16, r % 16, false, smem); return; }
  r -= 256;
  if (r < 512) { wtrans_tile(p.glu_w + (size_t)l * 1024 * 2048, 2048, 1024, wl + WO_GLU, r / 32, r % 32, false, smem); return; }
  r -= 512;
  if (r < 256) { wtrans_tile(p.attn_o + (size_t)l * 1024 * 1024, 1024, 1024, wl + WO_ATTNO, r / 16, r % 16, false, smem); return; }
  r -= 256;
  if (r < 256) { wtrans_tile(p.w_out + (size_t)l * 1024 * 1024, 1024, 1024, wl + WO_WOUT, r / 16, r % 16, false, smem); return; }
  r -= 256;
  if (r < 1024) { wtrans_tile(p.mlp_up + (size_t)l * 1024 * 4096, 4096, 1024, wl + WO_UP, r / 64, r % 64, false, smem); return; }
  r -= 1024;
  wtrans_tile(p.mlp_down + (size_t)l * 4096 * 1024, 1024, 4096, wl + WO_DOWN, r / 16, r % 16, false, smem);
}
DI void prep_s5_job(const P& p, int j) {
  const int idx = j * 256 + tidx();
  const int n = idx & 63, g = (idx >> 6) & 63, l = idx >> 12;
  const float step = expf(p.log_step[l * 64 + g]);
  const float lr_ = p.lam_re[(l * 64 + g) * 64 + n], li = p.lam_im[(l * 64 + g) * 64 + n];
  const float mag = expf(lr_ * step);
  const float abr = mag * cosf(li * step), abi = mag * sinf(li * step);
  float aqr = abr, aqi = abi;
#pragma unroll
  for (int q = 0; q < 6; ++q) { const float nr2 = aqr * aqr - aqi * aqi, ni2 = 2.f * aqr * aqi; aqr = nr2; aqi = ni2; }
  const float den = lr_ * lr_ + li * li;
  const float nr = abr - 1.0f, ni = abi;
  const float fre = (nr * lr_ + ni * li) / den, fim = (ni * lr_ - nr * li) / den;
  float* o = p.S5P() + ((size_t)(l * 64 + g) * 36) * 64 + n;
  o[0] = abr; o[64] = abi; o[128] = aqr; o[192] = aqi;
  const float* br = p.b_re + ((size_t)(l * 64 + g) * 64 + n) * 16;
  const float* bi = p.b_im + ((size_t)(l * 64 + g) * 64 + n) * 16;
  float vre[16], vim[16];
#pragma unroll
  for (int i = 0; i < 16; ++i) {
    const float b_r = br[i], b_i = bi[i];
    vre[i] = fre * b_r - fim * b_i;
    vim[i] = fre * b_i + fim * b_r;
    o[(4 + i) * 64] = vre[i];
    o[(20 + i) * 64] = vim[i];
  }
  uint4* bt = (uint4*)(p.BBT() + ((size_t)(l * 64 + g) * 128 + n) * 16);
  bt[0] = make_uint4(pack2(vre[0], vre[1]), pack2(vre[2], vre[3]), pack2(vre[4], vre[5]), pack2(vre[6], vre[7]));
  bt[1] = make_uint4(pack2(vre[8], vre[9]), pack2(vre[10], vre[11]), pack2(vre[12], vre[13]), pack2(vre[14], vre[15]));
  bt[128] = make_uint4(pack2(vim[0], vim[1]), pack2(vim[2], vim[3]), pack2(vim[4], vim[5]), pack2(vim[6], vim[7]));
  bt[129] = make_uint4(pack2(vim[8], vim[9]), pack2(vim[10], vim[11]), pack2(vim[12], vim[13]), pack2(vim[14], vim[15]));
}
DI void prep_rope_job(const P& p, int j) {
  const int idx = j * 256 + tidx();
  if (idx >= 8193 * 8) return;
  const int pos = idx >> 3, f = idx & 7;
  const float invf = expf(-(2.0f * (float)f / 16.0f) * logf(500000.0f));
  const float ang = (float)pos * invf;
  p.ROPE()[idx] = make_float2(cosf(ang), sinf(ang));
}

DI void norm_job(const P& p, int job, const float* wgt, bool layer0, bool final_) {
  const int w = __builtin_amdgcn_readfirstlane(tidx() >> 6), lane = tidx() & 63;
  const int r = job * 4 + w;
  const float* src = layer0 ? (r < TP ? p.x_prompt + (size_t)r * 1024 : p.x_sample + (size_t)(r - TP) * 1024) : p.X() + (size_t)r * 1024;
  float4 v[4];
  float ss = 0.f;
#pragma unroll
  for (int q = 0; q < 4; ++q) { v[q] = ((const float4*)src)[lane + 64 * q]; ss += v[q].x * v[q].x + v[q].y * v[q].y + v[q].z * v[q].z + v[q].w * v[q].w; }
  ss = wave_sum(ss);
  const float sc = rsqrtf(ss * (1.f / 1024.f) + EPS);
#pragma unroll
  for (int q = 0; q < 4; ++q) {
    const float4 wv = ((const float4*)wgt)[lane + 64 * q];
    float4 y = make_float4(v[q].x * sc * wv.x, v[q].y * sc * wv.y, v[q].z * sc * wv.z, v[q].w * sc * wv.w);
    if (final_) ((float4*)(p.out + OFF_YP + (size_t)r * 1024))[lane + 64 * q] = y;
    else *(uint2*)(p.H() + (size_t)r * 1024 + (lane + 64 * q) * 4) = make_uint2(pack2(y.x, y.y), pack2(y.z, y.w));
    if (layer0) ((float4*)(p.X() + (size_t)r * 1024))[lane + 64 * q] = v[q];
  }
}

constexpr int LDS_T = 264;
DI void stage_tile(bf16_t* sT, const f32x16 (&acc)[2][GNB], int wm, int wn, int lr, int lh) {
#pragma unroll
  for (int mi = 0; mi < 2; ++mi)
#pragma unroll
    for (int ni = 0; ni < GNB; ++ni) {
      bf16_t* d = sT + (wm * 64 + mi * 32 + 4 * lh) * LDS_T + wn * 128 + ni * 32 + lr;
#pragma unroll
      for (int ig = 0; ig < 4; ++ig) {
        const unsigned p01 = pack2(acc[mi][ni][4 * ig], acc[mi][ni][4 * ig + 1]), p23 = pack2(acc[mi][ni][4 * ig + 2], acc[mi][ni][4 * ig + 3]);
        d[(8 * ig) * LDS_T] = (bf16_t)(p01 & 0xffffu); d[(8 * ig + 1) * LDS_T] = (bf16_t)(p01 >> 16);
        d[(8 * ig + 2) * LDS_T] = (bf16_t)(p23 & 0xffffu); d[(8 * ig + 3) * LDS_T] = (bf16_t)(p23 >> 16);
      }
    }
}
DI void tile_writeout(bf16_t* __restrict__ dst, int ld, const bf16_t* sT) {
  const int tid = tidx();
#pragma unroll 4
  for (int it = 0; it < 16; ++it) {
    const int idx = tid + 256 * it, row = idx >> 5, chunk = idx & 31;
    *(uint4*)(dst + (size_t)row * ld + chunk * 8) = *(const uint4*)(sT + row * LDS_T + chunk * 8);
  }
}

DI void inproj_job(const P& p, int l, int job, char* smem) {
  int mt, nt;
  if (!gemm_tile(job, 129, 35, mt, nt)) return;
  int m0 = mt * 128, n0 = nt * 256;
  f32x16 acc[2][GNB];
#pragma unroll
  for (int a = 0; a < 2; ++a)
#pragma unroll
    for (int b = 0; b < GNB; ++b) zero16(acc[a][b]);
  gemm_mainloop(p.H() + (size_t)m0 * 1024, 1024, p.Wt() + (size_t)l * W_LAYER + WO_IN + (size_t)n0 * 1024, 1024, 1024, acc, smem);
  m0 = launder_s(m0); n0 = launder_s(n0);
  nt = launder_s(nt); mt = launder_s(mt);
  const int tid = tidx(), lane = tid & 63, w = __builtin_amdgcn_readfirstlane(tid >> 6), wm = w & 1, wn = w >> 1, lr = lane & 31, lh = lane >> 5;
  bf16_t* sT = (bf16_t*)smem;
  if (nt == 34) {
    if (wn == 0 && lr < 16) {
      const float bias = p.dt_bias[l * 16 + lr];
#pragma unroll
      for (int mi = 0; mi < 2; ++mi)
#pragma unroll
        for (int i = 0; i < 16; ++i) p.DT()[(size_t)(m0 + wm * 64 + mi * 32 + crow(i, lh)) * 16 + lr] = softplus_f(acc[mi][0][i] + bias);
    }
    return;
  }
  if (nt >= 16 && nt <= 20) {
#pragma unroll
    for (int mi = 0; mi < 2; ++mi)
#pragma unroll
      for (int ni = 0; ni < GNB; ni += 2)
#pragma unroll
        for (int i = 0; i < 16; ++i) {
          const float v = acc[mi][ni][i];
          const float pv = __shfl_xor(v, 8);
          if (lr < 16) {
            const int r = m0 + wm * 64 + mi * 32 + crow(i, lh);
            const int pos = (r >= TP) ? 8192 : (r & 8191);
            const float2 cs = p.ROPE()[pos * 8 + (lr & 7)];
            acc[mi][ni][i] = (lr < 8) ? v * cs.x - pv * cs.y : v * cs.x + pv * cs.y;
          }
        }
  }
  if (nt >= 22) {
#pragma unroll
    for (int mi = 0; mi < 2; ++mi)
#pragma unroll
      for (int ni = 0; ni < GNB; ++ni)
#pragma unroll
        for (int i = 0; i < 16; ++i) acc[mi][ni][i] = sigm_f(acc[mi][ni][i]);
  }
  if ((mt == 63 || mt == 127 || mt == 128) && ((nt >= 4 && nt < 12) || nt == 20 || nt == 21)) {
#pragma unroll
    for (int mi = 0; mi < 2; ++mi)
#pragma unroll
      for (int ni = 0; ni < GNB; ++ni) {
        const int cc = (n0 & 255) + wn * 128 + ni * 32 + lr;
        const int rb_ = launder(m0 + wm * 64 + mi * 32 + 4 * lh);
#pragma unroll
        for (int i = 0; i < 16; ++i) {
          const int r = rb_ + (i & 3) + 8 * (i >> 2);
          const float v = acc[mi][ni][i];
          if (nt < 12) {
            const int ch = (n0 - 1024) + cc;
            if (r >= TP) p.out[OFF_CONVS + ((size_t)(l * 128 + (r - TP)) * 3 + 2) * 2048 + ch] = v;
            else { const int t = r & 8191; if (t >= 8189) p.out[OFF_CONVP + ((size_t)(l * 2 + (r >> 13)) * 3 + (t - 8189)) * 2048 + ch] = v; }
          } else {
            const size_t ob = (nt == 20) ? OFF_KS : OFF_VS, obp = (nt == 20) ? OFF_KP : OFF_VP;
            if (r >= TP) p.out[ob + ((size_t)(l * 128 + (r - TP)) * 128 + 127) * 256 + cc] = v;
            else p.out[obp + ((size_t)(l * 2 + (r >> 13)) * 128 + ((r & 8191) - 8064)) * 256 + cc] = v;
          }
        }
        __builtin_amdgcn_sched_barrier(0);
      }
  }
  if (nt == 21) {
#pragma unroll
    for (int mi = 0; mi < 2; ++mi)
#pragma unroll
      for (int ni = 0; ni < GNB; ++ni) {
        bf16_t* d = sT + (wn * 128 + ni * 32 + lr) * 136 + wm * 64 + mi * 32 + 4 * lh;
#pragma unroll
        for (int ig = 0; ig < 4; ++ig)
          *(uint2*)(d + 8 * ig) = make_uint2(pack2(acc[mi][ni][4 * ig], acc[mi][ni][4 * ig + 1]), pack2(acc[mi][ni][4 * ig + 2], acc[mi][ni][4 * ig + 3]));
      }
    __syncthreads();
#pragma unroll 4
    for (int it = 0; it < 16; ++it) {
      const int idx = tid + 256 * it, c = idx >> 4, chunk = idx & 15;
      *(uint4*)(p.VT() + (size_t)c * T + m0 + chunk * 8) = *(const uint4*)(sT + c * 136 + chunk * 8);
    }
    return;
  }
  stage_tile(sT, acc, wm, wn, lr, lh);
  __syncthreads();
  bf16_t* dst; int ld;
  if (nt < 4) { dst = p.Z() + n0; ld = 1024; }
  else if (nt < 12) { dst = p.XBC() + (n0 - 1024); ld = 2048; }
  else if (nt < 16) { dst = p.U() + (n0 - 3072); ld = 1024; }
  else if (nt < 20) { dst = p.Q() + (n0 - 4096); ld = 1024; }
  else if (nt == 20) { dst = p.K(); ld = 256; }
  else { dst = p.G() + (n0 - 5632); ld = 3072; }
  tile_writeout(dst + (size_t)m0 * ld, ld, sT);
}

DI void conv_job(const P& p, int l, int job, char* smem) {
  const int ct = job & 31, tt = job >> 5;
  const int ch0 = ct * 64, tokb = tt * 128;
  bf16_t* sT = (bf16_t*)smem;
  const int tid = tidx();
  const float* cw = p.conv_w + (size_t)l * 4 * 2048;
  __syncthreads();
#pragma unroll
  for (int it = 0; it < 4; ++it) {
    const int item = tid + 256 * it, tl = item >> 3, chk = item & 7, ch = ch0 + chk * 8, row = tokb + tl, t = row & 8191;
    float a[8];
    {
      const float4 b0 = *(const float4*)(p.conv_b + l * 2048 + ch), b1 = *(const float4*)(p.conv_b + l * 2048 + ch + 4);
      a[0] = b0.x; a[1] = b0.y; a[2] = b0.z; a[3] = b0.w; a[4] = b1.x; a[5] = b1.y; a[6] = b1.z; a[7] = b1.w;
    }
#pragma unroll
    for (int j = 0; j < 4; ++j) {
      if (t - 3 + j >= 0) {
        const uint4 rv = *(const uint4*)(p.XBC() + (size_t)(row - 3 + j) * 2048 + ch);
        const float4 w0 = *(const float4*)(cw + j * 2048 + ch), w1 = *(const float4*)(cw + j * 2048 + ch + 4);
        a[0] += bflo(rv.x) * w0.x; a[1] += bfhi(rv.x) * w0.y; a[2] += bflo(rv.y) * w0.z; a[3] += bfhi(rv.y) * w0.w;
        a[4] += bflo(rv.z) * w1.x; a[5] += bfhi(rv.z) * w1.y; a[6] += bflo(rv.w) * w1.z; a[7] += bfhi(rv.w) * w1.w;
      }
    }
#pragma unroll
    for (int j = 0; j < 8; ++j) a[j] = silu_f(a[j]);
    if (ct >= 16) *(uint4*)(p.BC() + (size_t)row * 1024 + (ch - 1024)) = make_uint4(pack2(a[0], a[1]), pack2(a[2], a[3]), pack2(a[4], a[5]), pack2(a[6], a[7]));
    if (ct < 24) {
#pragma unroll
      for (int j = 0; j < 8; ++j) sT[(chk * 8 + j) * 136 + tl] = f2bf(a[j]);
    }
  }
  if (ct < 24) {
    __syncthreads();
#pragma unroll
    for (int it = 0; it < 4; ++it) {
      const int item = tid + 256 * it, r = item >> 4, chk = item & 15;
      *(uint4*)(p.XBT() + (size_t)(ch0 + r) * TP + tokb + chk * 8) = *(const uint4*)(sT + r * 136 + chk * 8);
    }
  }
}

DI void chunk_acum(const P& p, int l, int head, int tok0, float* sAc, float* sDt, float& alast) {
  const int lane = tidx() & 63;
  const float Ah = -expf(p.a_log[l * 16 + head]);
  const float d0 = p.DT()[(size_t)(tok0 + 2 * lane) * 16 + head], d1 = p.DT()[(size_t)(tok0 + 2 * lane + 1) * 16 + head];
  const float a0 = d0 * Ah, a1 = d1 * Ah;
  float s = a0 + a1;
#pragma unroll
  for (int off = 1; off < 64; off <<= 1) { const float tv = __shfl_up(s, off); if (lane >= off) s += tv; }
  const float excl = s - (a0 + a1);
  sAc[2 * lane] = excl + a0; sAc[2 * lane + 1] = s;
  sDt[2 * lane] = d0; sDt[2 * lane + 1] = d1;
  alast = __shfl(s, 63);
}

DI void ssd_a_job(const P& p, int l, int job, char* smem) {
  const int head = job & 15, c = (job >> 4) & 63, b = job >> 10, g = head >> 2;
  const int tok0 = b * SEQ + c * 128;
  bf16_t* sXT = (bf16_t*)smem;
  bf16_t* sBT = sXT + 64 * 136;
  float* sW = (float*)(sBT + 128 * 136);
  float* sAc = sW + 128;
  float* sDt = sAc + 128;
  const int tid = tidx(), lane = tid & 63, w = __builtin_amdgcn_readfirstlane(tid >> 6), lr = lane & 31, lh = lane >> 5;
  __syncthreads();
  if (w == 0) {
    float alast;
    chunk_acum(p, l, head, tok0, sAc, sDt, alast);
    sW[2 * lane] = sDt[2 * lane] * __expf(alast - sAc[2 * lane]);
    sW[2 * lane + 1] = sDt[2 * lane + 1] * __expf(alast - sAc[2 * lane + 1]);
    if (lane == 0) p.CDEC()[(b * 64 + c) * 16 + head] = __expf(alast);
  }
  __syncthreads();
#pragma unroll
  for (int it = 0; it < 4; ++it) {
    const int item = tid + 256 * it, pr = item >> 4, s0 = (item & 15) * 8;
    const uint4 v = *(const uint4*)(p.XBT() + (size_t)(head * 64 + pr) * TP + tok0 + s0);
    const float4 w0 = *(const float4*)(sW + s0), w1 = *(const float4*)(sW + s0 + 4);
    *(uint4*)(sXT + pr * 136 + s0) = make_uint4(pack2(bflo(v.x) * w0.x, bfhi(v.x) * w0.y), pack2(bflo(v.y) * w0.z, bfhi(v.y) * w0.w),
                                                pack2(bflo(v.z) * w1.x, bfhi(v.z) * w1.y), pack2(bflo(v.w) * w1.z, bfhi(v.w) * w1.w));
  }
#pragma unroll
  for (int it = 0; it < 8; ++it) {
    const int item = tid + 256 * it, n = item >> 4, s0 = (item & 15) * 8;
    *(uint4*)(sBT + n * 136 + s0) = *(const uint4*)(p.XBT() + (size_t)(1024 + g * 128 + n) * TP + tok0 + s0);
  }
  __syncthreads();
  const int wp = w & 1, wn = w >> 1;
  f32x16 acc[2];
  zero16(acc[0]); zero16(acc[1]);
#pragma unroll
  for (int kk = 0; kk < 8; ++kk) {
    const bf16x8 af = *(const bf16x8*)(sXT + (wp * 32 + lr) * 136 + kk * 16 + lh * 8);
#pragma unroll
    for (int ni = 0; ni < 2; ++ni) {
      const bf16x8 bfr = *(const bf16x8*)(sBT + (wn * 64 + ni * 32 + lr) * 136 + kk * 16 + lh * 8);
      acc[ni] = MFMA32(af, bfr, acc[ni]);
    }
  }
  float* st = p.ST() + ((size_t)((b * 64 + c) * 16 + head) * 64) * 128;
#pragma unroll
  for (int ni = 0; ni < 2; ++ni)
#pragma unroll
    for (int i = 0; i < 16; ++i) st[(wp * 32 + crow(i, lh)) * 128 + wn * 64 + ni * 32 + lr] = acc[ni][i];
}

DI void ssd_scan_job(const P& p, int l, int job) {
  const int gid = job * 256 + tidx();
  const int b = gid >> 15, rem = gid & 32767, head = rem >> 11;
  float4 h = make_float4(0.f, 0.f, 0.f, 0.f);
  const float4* sp0 = (const float4*)(p.ST() + (size_t)(b * 64) * 131072) + rem;
  uint2* hp0 = (uint2*)(p.HP() + (size_t)(b * 64) * 131072) + rem;
  for (int c0 = 0; c0 < 64; c0 += 8) {
    float4 sv[8];
    float dv[8];
#pragma unroll
    for (int k = 0; k < 8; ++k) { sv[k] = sp0[(size_t)(c0 + k) * 32768]; dv[k] = p.CDEC()[(b * 64 + c0 + k) * 16 + head]; }
#pragma unroll
    for (int k = 0; k < 8; ++k) {
      hp0[(size_t)(c0 + k) * 32768] = make_uint2(pack2(h.x, h.y), pack2(h.z, h.w));
      h.x = h.x * dv[k] + sv[k].x; h.y = h.y * dv[k] + sv[k].y; h.z = h.z * dv[k] + sv[k].z; h.w = h.w * dv[k] + sv[k].w;
    }
  }
  ((float4*)(p.out + OFF_SSMP + (size_t)(l * 2 + b) * 131072))[rem] = h;
}

DI void s5_scan_job(const P& p, int l, int job) {
  const int gid = job * 256 + tidx();
  const int n = gid & 63, g = (gid >> 6) & 63, b = gid >> 12;
  const float* prm = p.S5P() + ((size_t)(l * 64 + g) * 36) * 64 + n;
  const float aqr = prm[128], aqi = prm[192];
  float hr = 0.f, hi = 0.f;
  float2* sp = (float2*)p.S5S() + ((size_t)(b * 128) * 64 + g) * 64 + n;
  for (int c0 = 0; c0 < 128; c0 += 8) {
    float2 sv[8];
#pragma unroll
    for (int k = 0; k < 8; ++k) sv[k] = sp[(size_t)(c0 + k) * 4096];
#pragma unroll
    for (int k = 0; k < 8; ++k) {
      sp[(size_t)(c0 + k) * 4096] = make_float2(hr, hi);
      const float nr = aqr * hr - aqi * hi + sv[k].x, ni = aqr * hi + aqi * hr + sv[k].y;
      hr = nr; hi = ni;
    }
  }
}

DI void ssd_c_job(const P& p, int l, int job, char* smem) {
  const int g = job & 3, c = (job >> 2) & 63, b = job >> 8;
  const int tok0 = b * SEQ + c * 128;
  bf16_t* sC = (bf16_t*)smem;
  bf16_t* sB = sC + 128 * 136;
  float* sAc = (float*)(sB + 128 * 136);
  float* sDt = sAc + 512;
  const int tid = tidx(), lane = tid & 63, w = __builtin_amdgcn_readfirstlane(tid >> 6), lr = lane & 31, lh = lane >> 5, wm = w & 1, wn = w >> 1;
  __syncthreads();
  { float alast; chunk_acum(p, l, g * 4 + w, tok0, sAc + w * 128, sDt + w * 128, alast); }
#pragma unroll
  for (int it = 0; it < 8; ++it) {
    const int item = tid + 256 * it, r = item >> 4, s0 = (item & 15) * 8;
    *(uint4*)(sC + r * 136 + s0) = *(const uint4*)(p.BC() + (size_t)(tok0 + r) * 1024 + 512 + g * 128 + s0);
    *(uint4*)(sB + r * 136 + s0) = *(const uint4*)(p.BC() + (size_t)(tok0 + r) * 1024 + g * 128 + s0);
  }
  __syncthreads();
  f32x16 cb[2][2];
#pragma unroll
  for (int a = 0; a < 2; ++a)
#pragma unroll
    for (int bb = 0; bb < 2; ++bb) zero16(cb[a][bb]);
  if (!(wm == 0 && wn == 1)) {
#pragma unroll
    for (int kk = 0; kk < 8; ++kk) {
      bf16x8 af[2], bfr[2];
#pragma unroll
      for (int mi = 0; mi < 2; ++mi) af[mi] = *(const bf16x8*)(sC + (wm * 64 + mi * 32 + lr) * 136 + kk * 16 + lh * 8);
#pragma unroll
      for (int ni = 0; ni < 2; ++ni) bfr[ni] = *(const bf16x8*)(sB + (wn * 64 + ni * 32 + lr) * 136 + kk * 16 + lh * 8);
#pragma unroll
      for (int mi = 0; mi < 2; ++mi)
#pragma unroll
        for (int ni = 0; ni < 2; ++ni) cb[mi][ni] = MFMA32(af[mi], bfr[ni], cb[mi][ni]);
    }
  }
  __syncthreads();
  bf16_t* sM = sB;
  unsigned cbp[2][2][8];
#pragma unroll
  for (int a = 0; a < 2; ++a)
#pragma unroll
    for (int bb = 0; bb < 2; ++bb)
#pragma unroll
      for (int k = 0; k < 8; ++k) cbp[a][bb][k] = pack2(cb[a][bb][2 * k], cb[a][bb][2 * k + 1]);
  float ss[16];
#pragma unroll
  for (int i = 0; i < 16; ++i) ss[i] = 0.f;
#pragma unroll 1
  for (int hd = 0; hd < 4; ++hd) {
    const int head = g * 4 + hd;
    const float* ac = sAc + hd * 128;
    const float* dtv = sDt + hd * 128;
    const int lrq = launder(lr), lhq = launder(lh);
#pragma unroll
    for (int mi = 0; mi < 2; ++mi)
#pragma unroll
      for (int ni = 0; ni < 2; ++ni) {
        const int s = wn * 64 + ni * 32 + lrq;
        const float as = ac[s], ds = dtv[s];
#pragma unroll
        for (int i = 0; i < 16; ++i) {
          const int t = wm * 64 + mi * 32 + crow(i, lhq);
          const float cv = (i & 1) ? bfhi(cbp[mi][ni][i >> 1]) : bflo(cbp[mi][ni][i >> 1]);
          const float v = (s <= t) ? cv * __expf(ac[t] - as) * ds : 0.f;
          sM[t * 136 + s] = f2bf(v);
        }
        __builtin_amdgcn_sched_barrier(0);
      }
    __syncthreads();
    f32x16 yd[2];
    zero16(yd[0]); zero16(yd[1]);
    {
      const bf16_t* hb = p.HP() + (((size_t)((b * 64 + c) * 16 + head) * 64 + lr) * 128 + lh * 8);
      bf16x8 hf[8][2];
#pragma unroll
      for (int kk = 0; kk < 8; ++kk)
#pragma unroll
        for (int pb = 0; pb < 2; ++pb) hf[kk][pb] = *(const bf16x8*)(hb + (size_t)pb * 32 * 128 + kk * 16);
#pragma unroll
      for (int kk = 0; kk < 8; ++kk) {
        const bf16x8 af = *(const bf16x8*)(sC + (32 * w + lr) * 136 + kk * 16 + lh * 8);
        yd[0] = MFMA32(af, hf[kk][0], yd[0]);
        yd[1] = MFMA32(af, hf[kk][1], yd[1]);
      }
    }
#pragma unroll
    for (int i = 0; i < 16; ++i) {
      const float e = __expf(ac[32 * w + crow(i, lh)]);
      yd[0][i] *= e; yd[1][i] *= e;
    }
    {
      const int nkk = 2 * (w + 1);
      const bf16_t* xb = p.XBT() + (size_t)(head * 64 + lr) * TP + tok0 + lh * 8;
      const bf16_t* am = sM + (32 * w + lr) * 136 + lh * 8;
      bf16x8 x00 = *(const bf16x8*)(xb), x01 = *(const bf16x8*)(xb + (size_t)32 * TP);
      for (int kk = 0; kk < nkk; kk += 2) {
        const bf16x8 x10 = *(const bf16x8*)(xb + (kk + 1) * 16), x11 = *(const bf16x8*)(xb + (size_t)32 * TP + (kk + 1) * 16);
        const bf16x8 a0 = *(const bf16x8*)(am + kk * 16);
        yd[0] = MFMA32(a0, x00, yd[0]);
        yd[1] = MFMA32(a0, x01, yd[1]);
        const int kn = (kk + 2 < nkk) ? kk + 2 : kk;
        x00 = *(const bf16x8*)(xb + kn * 16); x01 = *(const bf16x8*)(xb + (size_t)32 * TP + kn * 16);
        const bf16x8 a1 = *(const bf16x8*)(am + (kk + 1) * 16);
        yd[0] = MFMA32(a1, x10, yd[0]);
        yd[1] = MFMA32(a1, x11, yd[1]);
      }
    }
    const float Dh = p.m_d[l * 16 + head];
#pragma unroll
    for (int pb = 0; pb < 2; ++pb) {
      const int pch = head * 64 + pb * 32 + lr;
#pragma unroll
      for (int ig = 0; ig < 4; ++ig) {
        const int t0 = 32 * w + 8 * ig + 4 * lh;
        const uint2 xr = *(const uint2*)(p.XBT() + (size_t)pch * TP + tok0 + t0);
        const float xs[4] = {bflo(xr.x), bfhi(xr.x), bflo(xr.y), bfhi(xr.y)};
#pragma unroll
        for (int jj = 0; jj < 4; ++jj) {
          const int i = 4 * ig + jj, t = t0 + jj;
          const float y = yd[pb][i] + Dh * xs[jj];
          const float z = bf2f(p.Z()[(size_t)(tok0 + t) * 1024 + pch]);
          const float yg = y * silu_f(z);
          ss[i] += yg * yg;
          p.YM()[(size_t)(tok0 + t) * 1024 + pch] = f2bf(yg);
        }
      }
      __builtin_amdgcn_sched_barrier(0);
    }
    __syncthreads();
  }
#pragma unroll
  for (int i = 0; i < 16; ++i) {
    float v = ss[i];
    v += __shfl_xor(v, 1); v += __shfl_xor(v, 2); v += __shfl_xor(v, 4); v += __shfl_xor(v, 8); v += __shfl_xor(v, 16);
    ss[i] = rsqrtf(v * (1.f / 256.f) + EPS);
  }
  for (int hd = 0; hd < 4; ++hd) {
#pragma unroll
    for (int pb = 0; pb < 2; ++pb) {
      const int pch = (g * 4 + hd) * 64 + pb * 32 + lr;
      const float nw = p.m_norm_w[l * 1024 + pch];
#pragma unroll
      for (int i = 0; i < 16; ++i) {
        const size_t idx = (size_t)(tok0 + 32 * w + crow(i, lh)) * 1024 + pch;
        p.YM()[idx] = f2bf(bf2f(p.YM()[idx]) * ss[i] * nw);
      }
      __builtin_amdgcn_sched_barrier(0);
    }
  }
}

DI void ssd_sample_job(const P& p, int l, int job, char* smem) {
  const int g = job & 3, b = job >> 2;
  float* sx = (float*)smem;
  float* sBv = sx + 256;
  float* sCv = sBv + 128;
  float* sY = sCv + 128;
  float* sRed = sY + 256;
  const int tid = tidx(), lane = tid & 63, w = __builtin_amdgcn_readfirstlane(tid >> 6);
  const int row = TP + b;
  __syncthreads();
#pragma unroll
  for (int it = 0; it < 2; ++it) {
    const int idx = tid + 256 * it;
    const int ch = idx < 256 ? g * 256 + idx : (idx < 384 ? 1024 + g * 128 + (idx - 256) : 1536 + g * 128 + (idx - 384));
    const float* sc = p.state_conv + ((size_t)(l * 128 + b) * 3) * 2048 + ch;
    const float s0 = sc[0], s1 = sc[2048], s2 = sc[4096];
    const float raw = bf2f(p.XBC()[(size_t)row * 2048 + ch]);
    const float* cw = p.conv_w + (size_t)l * 4 * 2048 + ch;
    float v = p.conv_b[l * 2048 + ch] + cw[0] * s0 + cw[2048] * s1 + cw[4096] * s2 + cw[6144] * raw;
    v = silu_f(v);
    sx[idx] = v;
    float* co = p.out + OFF_CONVS + ((size_t)(l * 128 + b) * 3) * 2048 + ch;
    co[0] = s1; co[2048] = s2;
  }
  __syncthreads();
  const int pp = tid >> 2, nq = (tid & 3) * 32;
  float4 hv[4][8];
#pragma unroll
  for (int hd = 0; hd < 4; ++hd) {
    const float4* h0 = (const float4*)(p.state_ssm + ((((size_t)l * 128 + b) * 16 + g * 4 + hd) * 64 + pp) * 128 + nq);
#pragma unroll
    for (int q = 0; q < 8; ++q) hv[hd][q] = h0[q];
  }
#pragma unroll
  for (int hd = 0; hd < 4; ++hd) {
    const int head = g * 4 + hd;
    const float dt = p.DT()[(size_t)row * 16 + head];
    const float Ah = -expf(p.a_log[l * 16 + head]);
    const float dA = __expf(dt * Ah);
    const float xv = sx[hd * 64 + pp];
    const float coef = dt * xv;
    float4* ho = (float4*)(p.out + OFF_SSMS + ((((size_t)l * 128 + b) * 16 + head) * 64 + pp) * 128 + nq);
    float yacc = 0.f;
#pragma unroll
    for (int q = 0; q < 8; ++q) {
      float4 h4 = hv[hd][q];
      const int n = nq + 4 * q;
      h4.x = h4.x * dA + coef * sBv[n]; h4.y = h4.y * dA + coef * sBv[n + 1]; h4.z = h4.z * dA + coef * sBv[n + 2]; h4.w = h4.w * dA + coef * sBv[n + 3];
      yacc += h4.x * sCv[n] + h4.y * sCv[n + 1] + h4.z * sCv[n + 2] + h4.w * sCv[n + 3];
      ho[q] = h4;
    }
    yacc += __shfl_xor(yacc, 1); yacc += __shfl_xor(yacc, 2);
    const float y = yacc + p.m_d[l * 16 + head] * xv;
    const float z = bf2f(p.Z()[(size_t)row * 1024 + head * 64 + pp]);
    if ((tid & 3) == 0) sY[hd * 64 + pp] = y * silu_f(z);
  }
  __syncthreads();
  const float v = sY[tid];
  const float ssq = wave_sum(v * v);
  if (lane == 0) sRed[w] = ssq;
  __syncthreads();
  const float tot = sRed[0] + sRed[1] + sRed[2] + sRed[3];
  const float sc = rsqrtf(tot * (1.f / 256.f) + EPS);
  p.YM()[(size_t)row * 1024 + g * 256 + tid] = f2bf(v * sc * p.m_norm_w[l * 1024 + g * 256 + tid]);
}

DI void s5_wave_job(const P& p, int l, int mode, int b, int g, int c, bf16_t* sH) {
  const int lane = tidx() & 63, lr = lane & 31, lh = lane >> 5;
  bf16x8 bq[4];
#pragma unroll
  for (int nb = 0; nb < 4; ++nb) bq[nb] = *(const bf16x8*)(p.BBT() + ((size_t)(l * 64 + g) * 128 + nb * 32 + lr) * 16 + lh * 8);
  float ar[2], ai[2], cr_[2], ci_[2];
  int row0, Q;
  if (mode == 2) { row0 = TP + b; Q = 1; } else { row0 = b * SEQ + c * 64; Q = 64; }
#pragma unroll
  for (int k = 0; k < 2; ++k) {
    const int n = k * 32 + lr;
    const float* prm = p.S5P() + ((size_t)(l * 64 + g) * 36) * 64 + n;
    ar[k] = prm[0]; ai[k] = prm[64];
    cr_[k] = 0.f; ci_[k] = 0.f;
    if (mode == 2) {
      cr_[k] = p.s5_sre[((size_t)(l * 128 + b) * 64 + g) * 64 + n];
      ci_[k] = p.s5_sim[((size_t)(l * 128 + b) * 64 + g) * 64 + n];
    } else if (mode == 1) {
      const float2 sv = *(const float2*)(p.S5S() + (((size_t)(b * 128 + c) * 64 + g) * 64 + n) * 2);
      cr_[k] = sv.x; ci_[k] = sv.y;
    }
  }
  const int ntb = (mode == 2) ? 1 : 2;
  for (int tb = 0; tb < ntb; ++tb) {
    const bf16x8 uf = *(const bf16x8*)(p.U() + (size_t)(row0 + tb * 32 + lr) * 1024 + g * 16 + lh * 8);
    f32x16 acc[4];
#pragma unroll
    for (int nb = 0; nb < 4; ++nb) { zero16(acc[nb]); acc[nb] = MFMA32(uf, bq[nb], acc[nb]); }
#pragma unroll
    for (int k = 0; k < 2; ++k) {
      const float a1r = ar[k], a1i = ai[k];
      const float a2r = a1r * a1r - a1i * a1i, a2i = 2.f * a1r * a1i;
      const float a3r = a2r * a1r - a2i * a1i, a3i = a2r * a1i + a2i * a1r;
      const float a4r = a2r * a2r - a2i * a2i, a4i = 2.f * a2r * a2i;
      float er[4], ei[4];
#pragma unroll
      for (int q = 0; q < 4; ++q) {
        float hr = acc[k][4 * q], hi = acc[2 + k][4 * q];
#pragma unroll
        for (int j = 1; j < 4; ++j) {
          const float nr = a1r * hr - a1i * hi + acc[k][4 * q + j], ni = a1r * hi + a1i * hr + acc[2 + k][4 * q + j];
          hr = nr; hi = ni;
          acc[k][4 * q + j] = hr; acc[2 + k][4 * q + j] = hi;
        }
        er[q] = hr; ei[q] = hi;
      }
      float cinr[4], cini[4];
      float cr = cr_[k], ci = ci_[k];
#pragma unroll
      for (int q = 0; q < 4; ++q) {
        const float per = __shfl_xor(er[q], 32), pei = __shfl_xor(ei[q], 32);
        const float e0r = lh ? per : er[q], e0i = lh ? pei : ei[q];
        const float e1r = lh ? er[q] : per, e1i = lh ? ei[q] : pei;
        const float c1r = a4r * cr - a4i * ci + e0r, c1i = a4r * ci + a4i * cr + e0i;
        cinr[q] = lh ? c1r : cr; cini[q] = lh ? c1i : ci;
        cr = a4r * c1r - a4i * c1i + e1r; ci = a4r * c1i + a4i * c1r + e1i;
      }
#pragma unroll
      for (int q = 0; q < 4; ++q) {
        const float xr = cinr[q], xi = cini[q];
        acc[k][4 * q] += a1r * xr - a1i * xi;     acc[2 + k][4 * q] += a1r * xi + a1i * xr;
        acc[k][4 * q + 1] += a2r * xr - a2i * xi; acc[2 + k][4 * q + 1] += a2r * xi + a2i * xr;
        acc[k][4 * q + 2] += a3r * xr - a3i * xi; acc[2 + k][4 * q + 2] += a3r * xi + a3i * xr;
        acc[k][4 * q + 3] += a4r * xr - a4i * xi; acc[2 + k][4 * q + 3] += a4r * xi + a4i * xr;
      }
      if (mode == 2) { cr_[k] = acc[k][0]; ci_[k] = acc[2 + k][0]; }
      else { cr_[k] = cr; ci_[k] = ci; }
      if (mode != 0) {
#pragma unroll
        for (int i = 0; i < 16; ++i) {
          const int t = tb * 32 + crow(i, lh);
          sH[t * 136 + k * 32 + lr] = f2bf(acc[k][i]);
          sH[t * 136 + 64 + k * 32 + lr] = f2bf(acc[2 + k][i]);
        }
      }
    }
  }
  if (lh == 0) {
#pragma unroll
    for (int k = 0; k < 2; ++k) {
      const int n = k * 32 + lr;
      if (mode == 0) *(float2*)(p.S5S() + (((size_t)(b * 128 + c) * 64 + g) * 64 + n) * 2) = make_float2(cr_[k], ci_[k]);
      if (mode == 1 && c == 127) {
        p.out[OFF_S5RP + ((size_t)(l * 2 + b) * 64 + g) * 64 + n] = cr_[k];
        p.out[OFF_S5IP + ((size_t)(l * 2 + b) * 64 + g) * 64 + n] = ci_[k];
      }
      if (mode == 2) {
        p.out[OFF_S5RS + ((size_t)(l * 128 + b) * 64 + g) * 64 + n] = cr_[k];
        p.out[OFF_S5IS + ((size_t)(l * 128 + b) * 64 + g) * 64 + n] = ci_[k];
      }
    }
  }
  if (mode == 0) return;
  const int o = lane & 15, quad = lane >> 4;
  bf16x8 cf[4];
#pragma unroll
  for (int kk = 0; kk < 4; ++kk) {
    const float* cp = ((kk < 2) ? p.c_re : p.c_im) + ((size_t)(l * 64 + g) * 16 + o) * 64 + (kk & 1) * 32 + quad * 8;
    const float4 c0 = ((const float4*)cp)[0], c1 = ((const float4*)cp)[1];
    const float sg = (kk < 2) ? 1.f : -1.f;
    cf[kk] = u4_to_bf8(make_uint4(pack2(sg * c0.x, sg * c0.y), pack2(sg * c0.z, sg * c0.w), pack2(sg * c1.x, sg * c1.y), pack2(sg * c1.z, sg * c1.w)));
  }
  const float dsk = p.s5_d[l * 1024 + g * 16 + o];
  const int nrb = (mode == 2) ? 1 : 4;
  __builtin_amdgcn_fence(__ATOMIC_RELEASE, "wavefront");
  __builtin_amdgcn_wave_barrier();
  __builtin_amdgcn_fence(__ATOMIC_ACQUIRE, "wavefront");
  for (int rb = 0; rb < nrb; ++rb) {
    f32x4 a4 = {0.f, 0.f, 0.f, 0.f};
#pragma unroll
    for (int kk = 0; kk < 4; ++kk) {
      const bf16x8 af = *(const bf16x8*)(sH + (rb * 16 + o) * 136 + kk * 32 + quad * 8);
      a4 = MFMA16(af, cf[kk], a4);
    }
#pragma unroll
    for (int jj = 0; jj < 4; ++jj) {
      const int t = rb * 16 + quad * 4 + jj;
      if (t < Q) {
        const size_t idx = (size_t)(row0 + t) * 1024 + g * 16 + o;
        const float y = a4[jj] + dsk * bf2f(p.U()[idx]);
        p.YS()[idx] = f2bf(gelu_tanh(y));
      }
    }
  }
}

DI void attn_prompt_job(const P& p, int l, int job, char* smem) {
  const int head = job & 15, blk = (job >> 4) & 63, b = job >> 10, kvh = head >> 2;
  bf16_t* sK = (bf16_t*)smem;
  bf16_t* sVt = sK + 256 * 72;
  const int tid = tidx(), lane = tid & 63, w = __builtin_amdgcn_readfirstlane(tid >> 6), lr = lane & 31, lh = lane >> 5;
  const int tokc0 = b * SEQ + blk * 128 - 128;
  __syncthreads();
#pragma unroll
  for (int it = 0; it < 8; ++it) {
    const int item = tid + 256 * it, row = item >> 3, chk = item & 7;
    uint4 v = make_uint4(0u, 0u, 0u, 0u);
    if (blk > 0 || row >= 128) v = *(const uint4*)(p.K() + (size_t)(tokc0 + row) * 256 + kvh * 64 + chk * 8);
    *(uint4*)(sK + row * 72 + chk * 8) = v;
  }
#pragma unroll
  for (int it = 0; it < 8; ++it) {
    const int item = tid + 256 * it, d = item >> 5, chk = item & 31;
    uint4 v = make_uint4(0u, 0u, 0u, 0u);
    if (blk > 0 || chk >= 16) v = *(const uint4*)(p.VT() + (size_t)(kvh * 64 + d) * T + tokc0 + chk * 8);
    *(uint4*)(sVt + d * 264 + chk * 8) = v;
  }
  __syncthreads();
  const int qtok = b * SEQ + blk * 128 + 32 * w + lr;
  bf16x8 qf[4];
#pragma unroll
  for (int kk = 0; kk < 4; ++kk) qf[kk] = *(const bf16x8*)(p.Q() + (size_t)qtok * 1024 + head * 64 + kk * 16 + lh * 8);
  f32x16 st[5];
#pragma unroll
  for (int x = 0; x < 5; ++x) {
    zero16(st[x]);
#pragma unroll
    for (int kk = 0; kk < 4; ++kk) {
      const bf16x8 af = *(const bf16x8*)(sK + (32 * (w + x) + lr) * 72 + kk * 16 + lh * 8);
      st[x] = MFMA32(af, qf[kk], st[x]);
    }
  }
  const float sink = p.sinks[l * 16 + head];
  const int qi = 128 + 32 * w + lr;
  float m = sink;
#pragma unroll
  for (int x = 0; x < 5; ++x)
#pragma unroll
    for (int i = 0; i < 16; ++i) {
      const int kj = 32 * (w + x) + crow(i, lh);
      const bool valid = (kj <= qi) && (kj >= qi - 128) && (blk > 0 || kj >= 128);
      const float s = valid ? st[x][i] * 0.125f : -1e30f;
      st[x][i] = s;
      m = fmaxf(m, s);
    }
  m = fmaxf(m, __shfl_xor(m, 32));
  float sum = 0.f;
#pragma unroll
  for (int x = 0; x < 5; ++x)
#pragma unroll
    for (int i = 0; i < 16; ++i) { const float pv = __expf(st[x][i] - m); st[x][i] = pv; sum += pv; }
  sum += __shfl_xor(sum, 32);
  const float inv = 1.f / (sum + __expf(sink - m));
  f32x16 ot[2];
  zero16(ot[0]); zero16(ot[1]);
#pragma unroll
  for (int x = 0; x < 5; ++x)
#pragma unroll
    for (int s = 0; s < 2; ++s) {
      const uint4 pu = make_uint4(pack2(st[x][8 * s] * inv, st[x][8 * s + 1] * inv), pack2(st[x][8 * s + 2] * inv, st[x][8 * s + 3] * inv),
                                  pack2(st[x][8 * s + 4] * inv, st[x][8 * s + 5] * inv), pack2(st[x][8 * s + 6] * inv, st[x][8 * s + 7] * inv));
      const bf16x8 pf = u4_to_bf8(pu);
#pragma unroll
      for (int pb = 0; pb < 2; ++pb) {
        const bf16_t* vp = sVt + (pb * 32 + lr) * 264 + 32 * (w + x) + 16 * s + 4 * lh;
        const uint2 lo = *(const uint2*)vp, hi2 = *(const uint2*)(vp + 8);
        ot[pb] = MFMA32(u4_to_bf8(make_uint4(lo.x, lo.y, hi2.x, hi2.y)), pf, ot[pb]);
      }
    }
#pragma unroll
  for (int pb = 0; pb < 2; ++pb)
#pragma unroll
    for (int ig = 0; ig < 4; ++ig) {
      const int d0 = pb * 32 + 8 * ig + 4 * lh;
      *(uint2*)(p.O() + (size_t)qtok * 1024 + head * 64 + d0) = make_uint2(pack2(ot[pb][4 * ig], ot[pb][4 * ig + 1]), pack2(ot[pb][4 * ig + 2], ot[pb][4 * ig + 3]));
    }
}

DI void attn_sample_job(const P& p, int l, int job, char* smem) {
  const int kvh = job & 3, b = job >> 2;
  const int tid = tidx(), lane = tid & 63, w = __builtin_amdgcn_readfirstlane(tid >> 6);
  const int head = kvh * 4 + w, row = TP + b;
  float* sQ = (float*)smem;
  float* sP = sQ + 256;
  const size_t cbase = ((size_t)(l * 128 + b) * 128) * 256 + kvh * 64;
  const float4* kc4 = (const float4*)(p.cache_k + cbase);
  const float4* vc4 = (const float4*)(p.cache_v + cbase);
  float4* ko4 = (float4*)(p.out + OFF_KS + cbase);
  float4* vo4 = (float4*)(p.out + OFF_VS + cbase);
  __syncthreads();
  for (int idx = tid; idx < 127 * 16; idx += 256) {
    const int j = idx >> 4, q4 = idx & 15;
    ko4[j * 64 + q4] = kc4[(j + 1) * 64 + q4];
    vo4[j * 64 + q4] = vc4[(j + 1) * 64 + q4];
  }
  const float qd = bf2f(p.Q()[(size_t)row * 1024 + head * 64 + lane]);
  sQ[w * 64 + lane] = qd;
  __syncthreads();
  float s0 = 0.f, s1 = 0.f;
#pragma unroll 4
  for (int d4 = 0; d4 < 16; ++d4) {
    const float4 q4 = ((const float4*)(sQ + w * 64))[d4];
    const float4 k0 = kc4[lane * 64 + d4], k1 = kc4[(lane + 64) * 64 + d4];
    s0 += q4.x * k0.x + q4.y * k0.y + q4.z * k0.z + q4.w * k0.w;
    s1 += q4.x * k1.x + q4.y * k1.y + q4.z * k1.z + q4.w * k1.w;
  }
  s0 *= 0.125f; s1 *= 0.125f;
  const float s2 = wave_sum(qd * bf2f(p.K()[(size_t)row * 256 + kvh * 64 + lane])) * 0.125f;
  const float sink = p.sinks[l * 16 + head];
  float m = fmaxf(fmaxf(s0, s1), fmaxf(s2, sink));
  m = wave_max(m);
  const float p0 = __expf(s0 - m), p1 = __expf(s1 - m), p2 = __expf(s2 - m);
  const float sum = wave_sum(p0 + p1);
  const float inv = 1.f / (sum + p2 + __expf(sink - m));
  sP[w * 132 + lane] = p0 * inv; sP[w * 132 + 64 + lane] = p1 * inv;
  __syncthreads();
  const float* vc = p.cache_v + cbase + lane;
  float o = 0.f;
#pragma unroll 8
  for (int j = 0; j < 128; ++j) o += sP[w * 132 + j] * vc[(size_t)j * 256];
  o += p2 * inv * bf2f(p.VT()[(size_t)(kvh * 64 + lane) * T + row]);
  p.O()[(size_t)row * 1024 + head * 64 + lane] = f2bf(o);
}

template <int PASS>
DI void merge_pass(const P& p, const bf16_t* A, const bf16_t* Wt, int m0, int n0, char* smem) {
  m0 = launder_s(m0); n0 = launder_s(n0);
  const int tid = tidx(), lane = tid & 63, w = __builtin_amdgcn_readfirstlane(tid >> 6), wm = w & 1, wn = w >> 1, lr = lane & 31, lh = lane >> 5;
  f32x16 acc[2][GNB];
#pragma unroll
  for (int a = 0; a < 2; ++a)
#pragma unroll
    for (int b = 0; b < GNB; ++b) zero16(acc[a][b]);
  gemm_mainloop(A + (size_t)m0 * 1024, 1024, Wt + (size_t)n0 * 1024, 1024, 1024, acc, smem);
  m0 = launder_s(m0); n0 = launder_s(n0);
  bf16_t* sT = (bf16_t*)smem;
  stage_tile(sT, acc, wm, wn, lr, lh);
  __syncthreads();
  const int goff = (PASS == 0) ? 1024 : (PASS == 2) ? 0 : 2048;
#pragma unroll 2
  for (int it = 0; it < 16; ++it) {
    const int idx = tid + 256 * it, row = idx >> 5, chunk = idx & 31;
    const uint4 av = *(const uint4*)(sT + row * LDS_T + chunk * 8);
    uint4* mp = (uint4*)(p.MG() + (size_t)(m0 + row) * 1024 + n0 + chunk * 8);
    uint4 gv = make_uint4(0u, 0u, 0u, 0u), mv = gv;
    if (PASS != 1) gv = *(const uint4*)(p.G() + (size_t)(m0 + row) * 3072 + goff + n0 + chunk * 8);
    if (PASS != 0) mv = *mp;
    const unsigned aw[4] = {av.x, av.y, av.z, av.w}, gw[4] = {gv.x, gv.y, gv.z, gv.w}, mw[4] = {mv.x, mv.y, mv.z, mv.w};
    unsigned ow[4];
#pragma unroll
    for (int k = 0; k < 4; ++k) {
      const float a0 = bflo(aw[k]), a1 = bfhi(aw[k]), g0 = bflo(gw[k]), g1 = bfhi(gw[k]), m0_ = bflo(mw[k]), m1_ = bfhi(mw[k]);
      float o0, o1;
      if (PASS == 0) { o0 = sigm_f(a0) * g0; o1 = sigm_f(a1) * g1; }
      else if (PASS == 1) { o0 = m0_ * a0; o1 = m1_ * a1; }
      else { o0 = m0_ + a0 * g0; o1 = m1_ + a1 * g1; }
      ow[k] = pack2(o0, o1);
    }
    *mp = make_uint4(ow[0], ow[1], ow[2], ow[3]);
  }
}
DI void merge_job(const P& p, int l, int job, char* smem) {
  int mt, nt;
  if (!gemm_tile(job, 128, 4, mt, nt)) return;
  const int m0 = mt * 128, n0 = nt * 256;
  const bf16_t* wl = p.Wt() + (size_t)l * W_LAYER;
  merge_pass<0>(p, p.YS(), wl + WO_GLU + (size_t)1024 * 1024, m0, n0, smem);
  merge_pass<1>(p, p.YS(), wl + WO_GLU, m0, n0, smem);
  merge_pass<2>(p, p.YM(), wl + WO_MPROJ, m0, n0, smem);
  merge_pass<3>(p, p.O(), wl + WO_ATTNO, m0, n0, smem);
}
DI void resid_gemm_job(const P& p, const bf16_t* A, int lda, const bf16_t* Wt, int K, int job, char* smem) {
  int mt, nt;
  if (!gemm_tile(job, 128, 4, mt, nt)) return;
  int m0 = mt * 128, n0 = nt * 256;
  const int tid = tidx(), lane = tid & 63, w = __builtin_amdgcn_readfirstlane(tid >> 6), wm = w & 1, wn = w >> 1, lr = lane & 31, lh = lane >> 5;
  f32x16 acc[2][GNB];
#pragma unroll
  for (int a = 0; a < 2; ++a)
#pragma unroll
    for (int b = 0; b < GNB; ++b) zero16(acc[a][b]);
  gemm_mainloop(A + (size_t)m0 * lda, lda, Wt + (size_t)n0 * K, K, K, acc, smem);
  m0 = launder_s(m0); n0 = launder_s(n0);
  float* sF = (float*)smem;
#pragma unroll
  for (int h = 0; h < 2; ++h) {
    if (h) __syncthreads();
#pragma unroll
    for (int ni = 0; ni < GNB; ++ni) {
      float* d = sF + (wm * 32 + 4 * lh) * 260 + wn * 128 + ni * 32 + lr;
#pragma unroll
      for (int i = 0; i < 16; ++i) d[((i & 3) + 8 * (i >> 2)) * 260] = acc[h][ni][i];
    }
    __syncthreads();
#pragma unroll 4
    for (int it = 0; it < 16; ++it) {
      const int idx = tid + 256 * it, rl = idx >> 6, c4 = idx & 63;
      const int r = m0 + (rl >> 5) * 64 + h * 32 + (rl & 31);
      float4* xp = (float4*)(p.X() + (size_t)r * 1024 + n0) + c4;
      const float4 a = *(const float4*)(sF + rl * 260 + c4 * 4);
      float4 x = *xp;
      x.x += a.x; x.y += a.y; x.z += a.z; x.w += a.w;
      *xp = x;
    }
  }
}
DI void up_job(const P& p, int l, int job, char* smem) {
  int mt, nt;
  if (!gemm_tile(job, 128, 16, mt, nt)) return;
  int m0 = mt * 128, n0 = nt * 256;
  const int tid = tidx(), lane = tid & 63, w = __builtin_amdgcn_readfirstlane(tid >> 6), wm = w & 1, wn = w >> 1, lr = lane & 31, lh = lane >> 5;
  f32x16 acc[2][GNB];
#pragma unroll
  for (int a = 0; a < 2; ++a)
#pragma unroll
    for (int b = 0; b < GNB; ++b) zero16(acc[a][b]);
  gemm_mainloop(p.H() + (size_t)m0 * 1024, 1024, p.Wt() + (size_t)l * W_LAYER + WO_UP + (size_t)n0 * 1024, 1024, 1024, acc, smem);
#if PROBE_DUP == 12
  gemm_mainloop(p.H() + (size_t)m0 * 1024, 1024, p.Wt() + (size_t)l * W_LAYER + WO_UP + (size_t)n0 * 1024, 1024, 1024, acc, smem);
#pragma unroll
  for (int mi = 0; mi < 2; ++mi)
#pragma unroll
    for (int ni = 0; ni < GNB; ++ni)
#pragma unroll
      for (int i = 0; i < 16; ++i) acc[mi][ni][i] *= 0.5f;
#endif
  m0 = launder_s(m0); n0 = launder_s(n0);
#pragma unroll
  for (int mi = 0; mi < 2; ++mi)
#pragma unroll
    for (int ni = 0; ni < GNB; ++ni)
#pragma unroll
      for (int i = 0; i < 16; ++i) { const float v = fmaxf(acc[mi][ni][i], 0.f); acc[mi][ni][i] = v * v; }
  bf16_t* sT = (bf16_t*)smem;
  stage_tile(sT, acc, wm, wn, lr, lh);
  __syncthreads();
  tile_writeout(p.A2() + (size_t)m0 * 4096 + n0, 4096, sT);
}

DI float skinny_dot(const bf16_t* __restrict__ A, int lda, const bf16_t* __restrict__ Wt, int K, int r0, int c0, char* smem) {
  float* sR = (float*)smem;
  const int tid = tidx(), lane = tid & 63, w = __builtin_amdgcn_readfirstlane(tid >> 6), r = lane & 15, quad = lane >> 4;
  const int kq = K >> 2;
  const bf16_t* ap = A + (size_t)(r0 + r) * lda + w * kq + quad * 8;
  const bf16_t* bp = Wt + (size_t)(c0 + r) * K + w * kq + quad * 8;
  f32x4 acc = {0.f, 0.f, 0.f, 0.f};
#pragma unroll 4
  for (int k = 0; k < kq; k += 32) {
    const bf16x8 a = *(const bf16x8*)(ap + k), b = *(const bf16x8*)(bp + k);
    acc = MFMA16(a, b, acc);
  }
  __syncthreads();
#pragma unroll
  for (int j = 0; j < 4; ++j) sR[w * 256 + (quad * 4 + j) * 16 + r] = acc[j];
  __syncthreads();
  return sR[tid] + sR[256 + tid] + sR[512 + tid] + sR[768 + tid];
}
DI void skinny_merge_job(const P& p, int l, int job, char* smem) {
  const int rt = job & 7, ct = job >> 3;
  const int r0 = TP + rt * 16, c0 = ct * 16;
  const bf16_t* wl = p.Wt() + (size_t)l * W_LAYER;
  const float ag = skinny_dot(p.YS(), 1024, wl + WO_GLU + (size_t)1024 * 1024, 1024, r0, c0, smem);
  const float av = skinny_dot(p.YS(), 1024, wl + WO_GLU, 1024, r0, c0, smem);
  const float am = skinny_dot(p.YM(), 1024, wl + WO_MPROJ, 1024, r0, c0, smem);
  const float aa = skinny_dot(p.O(), 1024, wl + WO_ATTNO, 1024, r0, c0, smem);
  const int tid = tidx(), r = r0 + (tid >> 4), c = c0 + (tid & 15);
  const bf16_t* gp = p.G() + (size_t)r * 3072 + c;
  const float v = bf2f(gp[0]) * am + bf2f(gp[1024]) * av * sigm_f(ag) + bf2f(gp[2048]) * aa;
  p.MG()[(size_t)r * 1024 + c] = f2bf(v);
}
DI void skinny_resid_job(const P& p, const bf16_t* A, int lda, const bf16_t* Wt, int K, int job, char* smem) {
  const int rt = job & 7, ct = job >> 3;
  const int r0 = TP + rt * 16, c0 = ct * 16;
  const float v = skinny_dot(A, lda, Wt, K, r0, c0, smem);
  const int tid = tidx();
  p.X()[(size_t)(r0 + (tid >> 4)) * 1024 + c0 + (tid & 15)] += v;
}
DI void skinny_up_job(const P& p, int l, int job, char* smem) {
  const int rt = job & 7, ct = job >> 3;
  const int r0 = TP + rt * 16, c0 = ct * 16;
  const float v = fmaxf(skinny_dot(p.H(), 1024, p.Wt() + (size_t)l * W_LAYER + WO_UP, 1024, r0, c0, smem), 0.f);
  const int tid = tidx();
  p.A2()[(size_t)(r0 + (tid >> 4)) * 4096 + c0 + (tid & 15)] = f2bf(v * v);
}

#define XB_TMO      128
#define XB_XCNT(j)  (256  + 64 * (j))
#define XB_XSUB(j)  (1280 + 64 * (j))
#define XB_XGEN(j)  (2304 + 64 * (j))
#define XB_TOP      3328
#define XB_TOPGEN   3392
#define XCD_BAR_WORDS 3456
#define XB_SPIN_CAP (1u << 20)
#define LAS __attribute__((address_space(3)))
DI unsigned xb_ld(unsigned* p) { return __hip_atomic_load(p, __ATOMIC_RELAXED, __HIP_MEMORY_SCOPE_AGENT); }
DI unsigned xb_add(unsigned* p, unsigned v) { return __hip_atomic_fetch_add(p, v, __ATOMIC_RELAXED, __HIP_MEMORY_SCOPE_AGENT); }
DI unsigned xb_xcc_id() { return (unsigned)__builtin_amdgcn_s_getreg((3 << 11) | 20) & 0xFu; }
#define XB_SPIN(cond, bar) do { unsigned _sp = 0; while (cond) { __builtin_amdgcn_s_sleep(1); \
    if ((++_sp & 255u) == 0u) { if (xb_ld(&(bar)[XB_TMO])) break; if (_sp > XB_SPIN_CAP) { atomicAdd(&(bar)[XB_TMO], 1u); break; } } } } while (0)
struct XcdBarrier { unsigned* bar; unsigned x; volatile LAS unsigned* st; };
DI XcdBarrier xcd_barrier_post(unsigned* bar, volatile LAS unsigned* st) {
  XcdBarrier b; b.bar = bar; b.x = xb_xcc_id(); b.st = st;
  if (threadIdx.x == 0) (void)xb_add(&bar[XB_XCNT(b.x)], 1u);
  return b;
}
DI void xcd_barrier_complete(unsigned* bar, unsigned x, unsigned& nloc, unsigned& nx) {
  const unsigned G = gridDim.x * gridDim.y * gridDim.z;
  unsigned sum, cnt, mine, sp = 0u;
  for (;;) {
    sum = 0u; cnt = 0u; mine = 0u;
#pragma unroll
    for (unsigned j = 0; j < 16; ++j) { const unsigned c = xb_ld(&bar[XB_XCNT(j)]); sum += c; cnt += (c > 0u) ? 1u : 0u; mine = (j == x) ? c : mine; }
    if (sum == G) break;
    __builtin_amdgcn_s_sleep(1);
    if ((++sp & 255u) == 0u) { if (xb_ld(&bar[XB_TMO])) break; if (sp > XB_SPIN_CAP) { atomicAdd(&bar[XB_TMO], 1u); break; } }
  }
  nloc = mine > 0u ? mine : 1u; nx = cnt > 0u ? cnt : 1u;
}
DI void xcd_barrier(const XcdBarrier& b) {
  asm volatile("s_waitcnt vmcnt(0)" ::: "memory");
  __syncthreads();
  if (threadIdx.x == 0) {
    unsigned* bar = b.bar;
    __builtin_amdgcn_s_waitcnt(0);
    unsigned nloc = b.st[0], nx = b.st[1];
    if (nloc == 0u) { xcd_barrier_complete(bar, b.x, nloc, nx); b.st[0] = nloc; b.st[1] = nx; }
    const unsigned old = xb_add(&bar[XB_XSUB(b.x)], 1u);
    const unsigned gen = old / nloc;
    if (old + 1u == (gen + 1u) * nloc) {
      __builtin_amdgcn_fence(__ATOMIC_RELEASE, "agent");
      asm volatile("s_waitcnt vmcnt(0)" ::: "memory");
      const unsigned og = xb_add(&bar[XB_TOP], 1u);
      const unsigned tg = og / nx;
      if (og + 1u == (tg + 1u) * nx) xb_add(&bar[XB_TOPGEN], 1u);
      else XB_SPIN(xb_ld(&bar[XB_TOPGEN]) == tg, bar);
      __builtin_amdgcn_fence(__ATOMIC_ACQUIRE, "agent");
      xb_add(&bar[XB_XGEN(b.x)], 1u);
      asm volatile("s_waitcnt vmcnt(0)" ::: "memory");
    } else {
      XB_SPIN(xb_ld(&bar[XB_XGEN(b.x)]) == gen, bar);
      __builtin_amdgcn_fence(__ATOMIC_ACQUIRE, "agent");
      asm volatile("s_waitcnt vmcnt(0)" ::: "memory");
    }
  }
  __syncthreads();
}

constexpr int NPHASE = 1 + 4 * 11;
DI void phase_jobs(int ph, int& nstd, int& nother) {
  nstd = 0;
  if (ph == 0) { nother = 22272 + 64 + 257 + 4128; return; }
  const int s = (ph - 1) % 11;
  switch (s) {
    case 0: nstd = 129 * 35; nother = 0; break;
    case 1: nother = 2048 + 4096 + 4096 + 512 + 2048 + 512; break;
    case 2: nother = 2048; break;
    case 3: nother = 256 + 32; break;
    case 4: nother = 512 + 4096; break;
    case 5: nstd = 512; nother = 512; break;
    case 6: nstd = 512; nother = 512; break;
    case 7: nother = 4128; break;
    case 8: nstd = 2048; nother = 2048; break;
    case 9: nstd = 512; nother = 512; break;
    default: nother = 4128; break;
  }
}
DI void run_std_job(const P& p, int ph, int job, char* smem) {
  const int l = (ph - 1) / 11, s = (ph - 1) % 11;
  const bf16_t* wl = p.Wt() + (size_t)l * W_LAYER;
  switch (s) {
    case 0: inproj_job(p, l, job, smem); break;
    case 5: merge_job(p, l, job, smem); break;
    case 6: resid_gemm_job(p, p.MG(), 1024, wl + WO_WOUT, 1024, job, smem); break;
    case 8: up_job(p, l, job, smem); break;
    default: resid_gemm_job(p, p.A2(), 4096, wl + WO_DOWN, 4096, job, smem); break;
  }
}
DI void run_job(const P& p, int ph, int job, char* smem) {
  if (ph == 0) {
    if (job < 22272) { prep_weight_job(p, job, smem); return; }
    job -= 22272;
    if (job < 64) { prep_s5_job(p, job); return; }
    job -= 64;
    if (job < 257) { prep_rope_job(p, job); return; }
    job -= 257;
    norm_job(p, job, p.norm1_w, true, false);
    return;
  }
  const int l = (ph - 1) / 11, s = (ph - 1) % 11;
  const bf16_t* wl = p.Wt() + (size_t)l * W_LAYER;
  const int w = __builtin_amdgcn_readfirstlane(tidx() >> 6);
  switch (s) {
    case 1:
      if (job < 512) { for (int rr = 0; rr < (PROBE_DUP == 11 ? 3 : 1); ++rr) ssd_sample_job(p, l, job, smem); break; }
      job -= 512;
      if (job < 512) { attn_sample_job(p, l, job, smem); break; }
      job -= 512;
      if (job < 2048) { for (int rr = 0; rr < (PROBE_DUP == 8 ? 3 : 1); ++rr) attn_prompt_job(p, l, job, smem); break; }
      job -= 2048;
      if (job < 4096) { for (int rr = 0; rr < (PROBE_DUP == 9 ? 3 : 1); ++rr) conv_job(p, l, job, smem); break; }
      job -= 4096;
      if (job < 4096) { const int wj = job * 4 + w; for (int rr = 0; rr < (PROBE_DUP == 10 ? 3 : 1); ++rr) s5_wave_job(p, l, 0, wj >> 13, wj & 63, (wj >> 6) & 127, nullptr); break; }
      job -= 4096;
      { const int wj = job * 4 + w; __syncthreads(); s5_wave_job(p, l, 2, wj >> 6, wj & 63, 0, (bf16_t*)smem + w * 64 * 136); }
      break;
    case 2: ssd_a_job(p, l, job, smem); break;
    case 3:
      if (job < 256) ssd_scan_job(p, l, job);
      else s5_scan_job(p, l, job - 256);
      break;
    case 4:
      if (job < 512) { for (int rr = 0; rr < (PROBE_DUP == 16 ? 3 : 1); ++rr) ssd_c_job(p, l, job, smem); break; }
      job -= 512;
      { const int wj = job * 4 + w; for (int rr = 0; rr < (PROBE_DUP == 17 ? 3 : 1); ++rr) { __syncthreads(); s5_wave_job(p, l, 1, wj >> 13, wj & 63, (wj >> 6) & 127, (bf16_t*)smem + w * 64 * 136); } }
      break;
    case 5: skinny_merge_job(p, l, job, smem); break;
    case 6: skinny_resid_job(p, p.MG(), 1024, wl + WO_WOUT, 1024, job, smem); break;
    case 7: norm_job(p, job, p.norm2_w + l * 1024, false, false); break;
    case 8: skinny_up_job(p, l, job, smem); break;
    case 9: skinny_resid_job(p, p.A2(), 4096, wl + WO_DOWN, 4096, job, smem); break;
    default:
      if (l == 3) norm_job(p, job, p.final_w, false, true);
      else norm_job(p, job, p.norm1_w + (l + 1) * 1024, false, false);
      break;
  }
}

template <bool COOP>
__global__ void __launch_bounds__(256, 2) mega(P p, int ph0, int ph1) {
  __shared__ __attribute__((aligned(16))) char smem[SMEM_BYTES];
  __shared__ uint4 xb_words;
  XcdBarrier xb;
  if (COOP) {
    if (threadIdx.x == 0) xb_words = make_uint4(0u, 0u, 0u, 0u);
    __syncthreads();
    xb = xcd_barrier_post((unsigned*)(p.ws + WS_BAR), (volatile LAS unsigned*)&xb_words);
  }
  const int G = (int)gridDim.x;
  for (int ph = ph0; ph < ph1; ++ph) {
    int nstd, nother;
    phase_jobs(ph, nstd, nother);
    int reps = 1;
#if PROBE_DUP
    { const int s_ = (ph == 0) ? -1 : (ph - 1) % 11;
      if (PROBE_DUP == 1 && (s_ == 0 || s_ == 5 || s_ == 8)) reps = 2;
      if (PROBE_DUP == 2 && (s_ == 1 || s_ == 2 || s_ == 4)) reps = 2;
      if (PROBE_DUP == 6 && s_ == 4) reps = 2;
      if (PROBE_DUP == 13 && s_ == 8) reps = 2;
      if (PROBE_DUP == 7 && s_ == 1) reps = 2; }
#endif
    const int nstd_r = ((nstd + G - 1) / G) * G;
    for (int rep = 0; rep < reps; ++rep) {
      for (int job = blockIdx.x; job < nstd_r; job += G) run_std_job(p, ph, job, smem);
      for (int job = blockIdx.x; job < nother; job += G) run_job(p, ph, job, smem);
    }
    if (COOP && ph + 1 < ph1) {
      if (ph == ph0) cg::this_grid().sync();
      else xcd_barrier(xb);
    }
  }
}


extern "C" void kernel_launch(void* const* d_in, const int* in_sizes, int n_in, void* d_out, int out_size, void* d_ws, size_t ws_size,
                              hipStream_t stream) {
  P p{};
  const float** pin = (const float**)&p;
  for (int i = 0; i < 33; ++i) pin[i] = (const float*)d_in[i];
  p.out = (float*)d_out;
  p.ws = (char*)d_ws;
  if (WS_TOTAL > ws_size) { fprintf(stderr, "workspace too small: need %zu have %zu\n", (size_t)WS_TOTAL, ws_size); return; }

#if COOP_MODE
  static int grid_blocks = 0;
  if (!grid_blocks) {
    int dev = 0, cus = 0, per_cu = 0;
    hipGetDevice(&dev);
    hipDeviceGetAttribute(&cus, hipDeviceAttributeMultiprocessorCount, dev);
    hipOccupancyMaxActiveBlocksPerMultiprocessor(&per_cu, mega<true>, 256, 0);
    if (per_cu > 2) per_cu = 2;
    if (per_cu < 1) per_cu = 1;
    grid_blocks = cus * per_cu;
  }
  (void)hipMemsetAsync(p.ws + WS_BAR, 0, 4096 * 4, stream);
  int ph0 = 0, ph1 = NPHASE;
  void* args[] = {&p, &ph0, &ph1};
  hipError_t e = hipLaunchCooperativeKernel((void*)mega<true>, dim3(grid_blocks), dim3(256), args, 0, stream);
  if (e != hipSuccess) fprintf(stderr, "cooperative launch failed: %s (grid %d)\n", hipGetErrorString(e), grid_blocks);
#else
  for (int ph = 0; ph < NPHASE; ++ph) mega<false><<<dim3(1024), dim3(256), 0, stream>>>(p, ph, ph + 1);
#endif
}
```

```cpp
#include <hip/hip_runtime.h>
#include <hip/hip_cooperative_groups.h>
#include <cstdio>
#include <cstdint>
namespace cg = cooperative_groups;

#define DI __device__ __forceinline__
typedef unsigned short bf16_t;
typedef short bf16x8 __attribute__((ext_vector_type(8)));
typedef float f32x16 __attribute__((ext_vector_type(16)));
typedef float f32x4 __attribute__((ext_vector_type(4)));
#define MFMA32(a, b, c) __builtin_amdgcn_mfma_f32_32x32x16_bf16((a), (b), (c), 0, 0, 0)
#define MFMA16(a, b, c) __builtin_amdgcn_mfma_f32_16x16x32_bf16((a), (b), (c), 0, 0, 0)

#ifndef COOP_MODE
#define COOP_MODE 1
#endif
#ifndef PROBE_DUP
#define PROBE_DUP 0
#endif

constexpr int TP = 16384, TS = 128, T = TP + TS, SEQ = 8192;
constexpr int NIN = 8720, NINP = 8960;
constexpr int SMEM_BYTES = 73728;
constexpr float EPS = 1e-6f;

constexpr size_t OFF_YP = 0;
constexpr size_t OFF_YS = OFF_YP + (size_t)TP * 1024;
constexpr size_t OFF_SSMP = OFF_YS + (size_t)TS * 1024;
constexpr size_t OFF_SSMS = OFF_SSMP + (size_t)4 * 2 * 16 * 64 * 128;
constexpr size_t OFF_CONVP = OFF_SSMS + (size_t)4 * 128 * 16 * 64 * 128;
constexpr size_t OFF_CONVS = OFF_CONVP + (size_t)4 * 2 * 3 * 2048;
constexpr size_t OFF_S5RP = OFF_CONVS + (size_t)4 * 128 * 3 * 2048;
constexpr size_t OFF_S5RS = OFF_S5RP + (size_t)4 * 2 * 64 * 64;
constexpr size_t OFF_S5IP = OFF_S5RS + (size_t)4 * 128 * 64 * 64;
constexpr size_t OFF_S5IS = OFF_S5IP + (size_t)4 * 2 * 64 * 64;
constexpr size_t OFF_KP = OFF_S5IS + (size_t)4 * 128 * 64 * 64;
constexpr size_t OFF_KS = OFF_KP + (size_t)4 * 2 * 128 * 256;
constexpr size_t OFF_VP = OFF_KS + (size_t)4 * 128 * 128 * 256;
constexpr size_t OFF_VS = OFF_VP + (size_t)4 * 2 * 128 * 256;

constexpr size_t WO_IN = 0;
constexpr size_t WO_MPROJ = WO_IN + (size_t)NINP * 1024;
constexpr size_t WO_GLU = WO_MPROJ + (size_t)1024 * 1024;
constexpr size_t WO_ATTNO = WO_GLU + (size_t)2048 * 1024;
constexpr size_t WO_WOUT = WO_ATTNO + (size_t)1024 * 1024;
constexpr size_t WO_UP = WO_WOUT + (size_t)1024 * 1024;
constexpr size_t WO_DOWN = WO_UP + (size_t)4096 * 1024;
constexpr size_t W_LAYER = WO_DOWN + (size_t)4096 * 1024;

constexpr size_t al256(size_t x) { return (x + 255) & ~(size_t)255; }
constexpr size_t SZ1 = (size_t)T * 1024 * 2;
constexpr size_t WS_X = 0;
constexpr size_t WS_H = WS_X + al256((size_t)T * 1024 * 4);
constexpr size_t WS_Z = WS_H + al256(SZ1);
constexpr size_t WS_U = WS_Z + al256(SZ1);
constexpr size_t WS_Q = WS_U + al256(SZ1);
constexpr size_t WS_YM = WS_Q + al256(SZ1);
constexpr size_t WS_YS = WS_YM + al256(SZ1);
constexpr size_t WS_O = WS_YS + al256(SZ1);
constexpr size_t WS_MG = WS_O + al256(SZ1);
constexpr size_t WS_XBC = WS_MG + al256(SZ1);
constexpr size_t WS_XBT = WS_XBC + al256((size_t)T * 2048 * 2);
constexpr size_t WS_BC = WS_XBT + al256((size_t)1536 * TP * 2);
constexpr size_t WS_A2END = WS_XBC + al256((size_t)T * 4096 * 2);
constexpr size_t WS_BCEND = WS_BC + al256((size_t)TP * 1024 * 2);
constexpr size_t WS_K = WS_A2END > WS_BCEND ? WS_A2END : WS_BCEND;
constexpr size_t WS_VT = WS_K + al256((size_t)T * 256 * 2);
constexpr size_t WS_G = WS_VT + al256((size_t)T * 256 * 2);
constexpr size_t WS_DT = WS_G + al256((size_t)T * 3072 * 2);
constexpr size_t WS_ST = WS_DT + al256((size_t)T * 16 * 4);
constexpr size_t WS_CDEC = WS_ST + al256((size_t)2 * 64 * 16 * 64 * 128 * 4);
constexpr size_t WS_S5S = WS_CDEC + al256((size_t)2 * 64 * 16 * 4);
constexpr size_t WS_S5P = WS_S5S + al256((size_t)2 * 128 * 64 * 64 * 2 * 4);
constexpr size_t WS_ROPE = WS_S5P + al256((size_t)4 * 64 * 36 * 64 * 4);
constexpr size_t WS_WT = WS_ROPE + al256((size_t)8193 * 8 * 8);
constexpr size_t WS_BAR = WS_WT + al256((size_t)4 * W_LAYER * 2);
constexpr size_t WS_HP = WS_BAR + al256(4096 * 4);
constexpr size_t WS_BBT = WS_HP + al256((size_t)2 * 64 * 16 * 64 * 128 * 2);
constexpr size_t WS_TOTAL = WS_BBT + al256((size_t)4 * 64 * 128 * 16 * 2);

struct P {
  const float *x_prompt, *x_sample, *state_ssm, *state_conv, *s5_sre, *s5_sim, *cache_k, *cache_v;
  const float *norm1_w, *w_in, *conv_w, *conv_b, *dt_bias, *a_log, *m_d, *m_norm_w, *m_proj;
  const float *lam_re, *lam_im, *log_step, *b_re, *b_im, *c_re, *c_im, *s5_d, *glu_w;
  const float *sinks, *attn_o, *w_out, *norm2_w, *mlp_up, *mlp_down, *final_w;
  float* out;
  char* ws;
#define WSACC(name, type, off) __device__ __forceinline__ type* name() const { return (type*)(ws + (off)); }
  WSACC(X, float, WS_X) WSACC(H, bf16_t, WS_H) WSACC(Z, bf16_t, WS_Z) WSACC(U, bf16_t, WS_U) WSACC(Q, bf16_t, WS_Q)
  WSACC(YM, bf16_t, WS_YM) WSACC(YS, bf16_t, WS_YS) WSACC(O, bf16_t, WS_O) WSACC(MG, bf16_t, WS_MG)
  WSACC(XBC, bf16_t, WS_XBC) WSACC(XBT, bf16_t, WS_XBT) WSACC(BC, bf16_t, WS_BC) WSACC(A2, bf16_t, WS_XBC)
  WSACC(K, bf16_t, WS_K) WSACC(VT, bf16_t, WS_VT) WSACC(G, bf16_t, WS_G) WSACC(DT, float, WS_DT) WSACC(ST, float, WS_ST)
  WSACC(CDEC, float, WS_CDEC) WSACC(HP, bf16_t, WS_HP) WSACC(BBT, bf16_t, WS_BBT) WSACC(S5S, float, WS_S5S) WSACC(S5P, float, WS_S5P) WSACC(ROPE, float2, WS_ROPE) WSACC(Wt, bf16_t, WS_WT)
#undef WSACC
};

typedef float f32x2_t __attribute__((ext_vector_type(2)));
typedef __bf16 bf16x2_t __attribute__((ext_vector_type(2)));
DI unsigned pack2(float a, float b) { const f32x2_t v = {a, b}; return __builtin_bit_cast(unsigned, __builtin_convertvector(v, bf16x2_t)); }
DI bf16_t f2bf(float x) { return (bf16_t)(pack2(x, 0.f) & 0xffffu); }
DI float bf2f(bf16_t b) { return __uint_as_float(((unsigned)b) << 16); }
DI float bflo(unsigned u) { return __uint_as_float(u << 16); }
DI float bfhi(unsigned u) { return __uint_as_float(u & 0xffff0000u); }
DI float silu_f(float x) { return x / (1.f + __expf(-x)); }
DI float sigm_f(float x) { return 1.f / (1.f + __expf(-x)); }
DI float softplus_f(float x) { return x > 20.f ? x : log1pf(expf(x)); }
DI float gelu_tanh(float x) { float y = 0.7978845608028654f * (x + 0.044715f * x * x * x); float t = 1.f - 2.f / (__expf(2.f * y) + 1.f); return 0.5f * x * (1.f + t); }
DI int crow(int i, int lh) { return (i & 3) + 8 * (i >> 2) + 4 * lh; }
DI int launder(int x) { asm volatile("" : "+v"(x)); return x; }
DI int tidx() { int t = __builtin_amdgcn_workitem_id_x(); asm volatile("" : "+v"(t)); return t; }
DI int launder_s(int x) { asm volatile("" : "+s"(x)); return x; }
DI float wave_sum(float v) {
#pragma unroll
  for (int o = 32; o >= 1; o >>= 1) v += __shfl_xor(v, o);
  return v;
}
DI float wave_max(float v) {
#pragma unroll
  for (int o = 32; o >= 1; o >>= 1) v = fmaxf(v, __shfl_xor(v, o));
  return v;
}
DI bf16x8 u4_to_bf8(uint4 v) { return __builtin_bit_cast(bf16x8, v); }
DI void zero16(f32x16& a) {
#pragma unroll
  for (int i = 0; i < 16; ++i) a[i] = 0.f;
}

constexpr int LDT = 40;
constexpr int GNB = 4;
DI void gemm_mainloop(const bf16_t* __restrict__ A, int lda, const bf16_t* __restrict__ B, int ldb, int K,
                      f32x16 (&acc)[2][GNB], char* smem) {
  bf16_t* sa = (bf16_t*)smem;
  bf16_t* sb = sa + 2 * 128 * LDT;
  const int tid = tidx(), lane = tid & 63, w = __builtin_amdgcn_readfirstlane(tid >> 6), wm = w & 1, wn = w >> 1, lr = lane & 31, lh = lane >> 5;
  const int r0 = tid >> 2, ch = (tid & 3) * 8;
  const bf16_t* ap = A + (size_t)r0 * lda + ch;
  const bf16_t* bp = B + (size_t)r0 * ldb + ch;
  uint4 pa0, pa1, pb0, pb1, pb2, pb3;
  uint4 qa0, qa1, qb0, qb1, qb2, qb3;
#define GLOADS(R, k0)                                                                                      \
  R##a0 = *(const uint4*)(ap + (k0)); R##a1 = *(const uint4*)(ap + (size_t)64 * lda + (k0));               \
  R##b0 = *(const uint4*)(bp + (k0)); R##b1 = *(const uint4*)(bp + (size_t)64 * ldb + (k0));               \
  R##b2 = *(const uint4*)(bp + (size_t)128 * ldb + (k0)); R##b3 = *(const uint4*)(bp + (size_t)192 * ldb + (k0));
#define SSTORES(R, bufi)                                                                                   \
  { bf16_t* da = sa + (bufi)*128 * LDT; bf16_t* db = sb + (bufi)*256 * LDT;                                \
    *(uint4*)(da + (r0)*LDT + ch) = R##a0; *(uint4*)(da + (r0 + 64) * LDT + ch) = R##a1;                   \
    *(uint4*)(db + (r0)*LDT + ch) = R##b0; *(uint4*)(db + (r0 + 64) * LDT + ch) = R##b1;                   \
    *(uint4*)(db + (r0 + 128) * LDT + ch) = R##b2; *(uint4*)(db + (r0 + 192) * LDT + ch) = R##b3; }
#define COMPUTE(bufi)                                                                                      \
  { const bf16_t* ca = sa + (bufi)*128 * LDT + (wm * 64 + lr) * LDT + lh * 8;                              \
    const bf16_t* cb = sb + (bufi)*256 * LDT + (wn * 128 + lr) * LDT + lh * 8;                             \
    _Pragma("unroll") for (int kk = 0; kk < 2; ++kk) {                                                     \
      const bf16x8 af0 = *(const bf16x8*)(ca + kk * 16), af1 = *(const bf16x8*)(ca + 32 * LDT + kk * 16);  \
      _Pragma("unroll") for (int ni = 0; ni < GNB; ++ni) {                                                 \
        const bf16x8 bfr = *(const bf16x8*)(cb + ni * 32 * LDT + kk * 16);                                 \
        acc[0][ni] = MFMA32(af0, bfr, acc[0][ni]); acc[1][ni] = MFMA32(af1, bfr, acc[1][ni]); } } }
  const int nk = K >> 5;
  const int klast = (nk - 1) * 32;
  GLOADS(p, 0)
  __syncthreads();
  SSTORES(p, 0)
  GLOADS(p, 32)
  __syncthreads();
  for (int kt = 0; kt < nk; kt += 2) {
    { const int k2 = (kt + 2) * 32; const int k0 = k2 < klast ? k2 : klast; GLOADS(q, k0) }
    COMPUTE(0)
    SSTORES(p, 1)
    __syncthreads();
    { const int k3 = (kt + 3) * 32; const int k0 = k3 < klast ? k3 : klast; GLOADS(p, k0) }
    COMPUTE(1)
    SSTORES(q, 0)
    __syncthreads();
  }
#undef GLOADS
#undef SSTORES
#undef COMPUTE
}
DI bool gemm_tile(int slot, int MT, int NT, int& mt, int& nt) {
  const int G = gridDim.x, nx = G >> 3;
  int J = slot;
  if ((G & 7) == 0) J = (slot / G) * G + (slot & 7) * nx + ((slot % G) >> 3);
  if (J >= MT * NT) return false;
  const int gw = 8 * NT, grp = J / gw, rem = J - grp * gw, fm = grp * 8;
  const int gsz = (MT - fm) < 8 ? (MT - fm) : 8;
  mt = fm + rem % gsz; nt = rem / gsz;
  return true;
}

DI int win_map(int n) {
  if (n < 3072) return n;
  if (n < 8704) return n + 16;
  if (n < 8720) return n - 8704 + 3072;
  return -1;
}
DI void wtrans_tile(const float* __restrict__ src, int N, int K, bf16_t* __restrict__ dst, int kt, int nt, bool inmap, char* smem) {
  float* s = (float*)smem;
  const int tid = tidx();
  __syncthreads();
  {
    const int n4 = (tid & 15) * 4;
    int sc = nt * 64 + n4;
    if (inmap) sc = win_map(sc);
#pragma unroll
    for (int ps = 0; ps < 4; ++ps) {
      const int kk = (tid >> 4) + 16 * ps;
      float4 v = make_float4(0.f, 0.f, 0.f, 0.f);
      if (sc >= 0) v = *(const float4*)(src + (size_t)(kt * 64 + kk) * N + sc);
      float* d = s + kk * 65 + n4;
      d[0] = v.x; d[1] = v.y; d[2] = v.z; d[3] = v.w;
    }
  }
  __syncthreads();
  {
    const int n2 = tid >> 2, kq = (tid & 3) * 16;
    unsigned w[8];
#pragma unroll
    for (int j = 0; j < 8; ++j) w[j] = pack2(s[(kq + 2 * j) * 65 + n2], s[(kq + 2 * j + 1) * 65 + n2]);
    uint4* d = (uint4*)(dst + (size_t)(nt * 64 + n2) * K + kt * 64 + kq);
    d[0] = make_uint4(w[0], w[1], w[2], w[3]);
    d[1] = make_uint4(w[4], w[5], w[6], w[7]);
  }
}
DI void prep_weight_job(const P& p, int j, char* smem) {
  const int l = j / 5568; int r = j % 5568;
  bf16_t* wl = p.Wt() + (size_t)l * W_LAYER;
  if (r < 2240) { wtrans_tile(p.w_in + (size_t)l * 1024 * NIN, NIN, 1024, wl + WO_IN, r / 140, r % 140, true, smem); return; }
  r -= 2240;
  if (r < 256) { wtrans_tile(p.m_proj + (size_t)l * 1024 * 1024, 1024, 1024, wl + WO_MPROJ, r / 16, r % 16, false, smem); return; }
  r -= 256;
  if (r < 512) { wtrans_tile(p.glu_w + (size_t)l * 1024 * 2048, 2048, 1024, wl + WO_GLU, r / 32, r % 32, false, smem); return; }
  r -= 512;
  if (r < 256) { wtrans_tile(p.attn_o + (size_t)l * 1024 * 1024, 1024, 1024, wl + WO_ATTNO, r / 16, r % 16, false, smem); return; }
  r -= 256;
  if (r < 256) { wtrans_tile(p.w_out + (size_t)l * 1024 * 1024, 1024, 1024, wl + WO_WOUT, r / 16, r % 16, false, smem); return; }
  r -= 256;
  if (r < 1024) { wtrans_tile(p.mlp_up + (size_t)l * 1024 * 4096, 4096, 1024, wl + WO_UP, r / 64, r % 64, false, smem); return; }
  r -= 1024;
  wtrans_tile(p.mlp_down + (size_t)l * 4096 * 1024, 1024, 4096, wl + WO_DOWN, r / 16, r % 16, false, smem);
}
DI void prep_s5_job(const P& p, int j) {
  const int idx = j * 256 + tidx();
  const int n = idx & 63, g = (idx >> 6) & 63, l = idx >> 12;
  const float step = expf(p.log_step[l * 64 + g]);
  const float lr_ = p.lam_re[(l * 64 + g) * 64 + n], li = p.lam_im[(l * 64 + g) * 64 + n];
  const float mag = expf(lr_ * step);
  const float abr = mag * cosf(li * step), abi = mag * sinf(li * step);
  float aqr = abr, aqi = abi;
#pragma unroll
  for (int q = 0; q < 6; ++q) { const float nr2 = aqr * aqr - aqi * aqi, ni2 = 2.f * aqr * aqi; aqr = nr2; aqi = ni2; }
  const float den = lr_ * lr_ + li * li;
  const float nr = abr - 1.0f, ni = abi;
  const float fre = (nr * lr_ + ni * li) / den, fim = (ni * lr_ - nr * li) / den;
  float* o = p.S5P() + ((size_t)(l * 64 + g) * 36) * 64 + n;
  o[0] = abr; o[64] = abi; o[128] = aqr; o[192] = aqi;
  const float* br = p.b_re + ((size_t)(l * 64 + g) * 64 + n) * 16;
  const float* bi = p.b_im + ((size_t)(l * 64 + g) * 64 + n) * 16;
  float vre[16], vim[16];
#pragma unroll
  for (int i = 0; i < 16; ++i) {
    const float b_r = br[i], b_i = bi[i];
    vre[i] = fre * b_r - fim * b_i;
    vim[i] = fre * b_i + fim * b_r;
    o[(4 + i) * 64] = vre[i];
    o[(20 + i) * 64] = vim[i];
  }
  uint4* bt = (uint4*)(p.BBT() + ((size_t)(l * 64 + g) * 128 + n) * 16);
  bt[0] = make_uint4(pack2(vre[0], vre[1]), pack2(vre[2], vre[3]), pack2(vre[4], vre[5]), pack2(vre[6], vre[7]));
  bt[1] = make_uint4(pack2(vre[8], vre[9]), pack2(vre[10], vre[11]), pack2(vre[12], vre[13]), pack2(vre[14], vre[15]));
  bt[128] = make_uint4(pack2(vim[0], vim[1]), pack2(vim[2], vim[3]), pack2(vim[4], vim[5]), pack2(vim[6], vim[7]));
  bt[129] = make_uint4(pack2(vim[8], vim[9]), pack2(vim[10], vim[11]), pack2(vim[12], vim[13]), pack2(vim[14], vim[15]));
}
DI void prep_rope_job(const P& p, int j) {
  const int idx = j * 256 + tidx();
  if (idx >= 8193 * 8) return;
  const int pos = idx >> 3, f = idx & 7;
  const float invf = expf(-(2.0f * (float)f / 16.0f) * logf(500000.0f));
  const float ang = (float)pos * invf;
  p.ROPE()[idx] = make_float2(cosf(ang), sinf(ang));
}

DI void norm_job(const P& p, int job, const float* wgt, bool layer0, bool final_) {
  const int w = __builtin_amdgcn_readfirstlane(tidx() >> 6), lane = tidx() & 63;
  const int r = job * 4 + w;
  const float* src = layer0 ? (r < TP ? p.x_prompt + (size_t)r * 1024 : p.x_sample + (size_t)(r - TP) * 1024) : p.X() + (size_t)r * 1024;
  float4 v[4];
  float ss = 0.f;
#pragma unroll
  for (int q = 0; q < 4; ++q) { v[q] = ((const float4*)src)[lane + 64 * q]; ss += v[q].x * v[q].x + v[q].y * v[q].y + v[q].z * v[q].z + v[q].w * v[q].w; }
  ss = wave_sum(ss);
  const float sc = rsqrtf(ss * (1.f / 1024.f) + EPS);
#pragma unroll
  for (int q = 0; q < 4; ++q) {
    const float4 wv = ((const float4*)wgt)[lane + 64 * q];
    float4 y = make_float4(v[q].x * sc * wv.x, v[q].y * sc * wv.y, v[q].z * sc * wv.z, v[q].w * sc * wv.w);
    if (final_) ((float4*)(p.out + OFF_YP + (size_t)r * 1024))[lane + 64 * q] = y;
    else *(uint2*)(p.H() + (size_t)r * 1024 + (lane + 64 * q) * 4) = make_uint2(pack2(y.x, y.y), pack2(y.z, y.w));
    if (layer0) ((float4*)(p.X() + (size_t)r * 1024))[lane + 64 * q] = v[q];
  }
}

constexpr int LDS_T = 264;
DI void stage_tile(bf16_t* sT, const f32x16 (&acc)[2][GNB], int wm, int wn, int lr, int lh) {
#pragma unroll
  for (int mi = 0; mi < 2; ++mi)
#pragma unroll
    for (int ni = 0; ni < GNB; ++ni) {
      bf16_t* d = sT + (wm * 64 + mi * 32 + 4 * lh) * LDS_T + wn * 128 + ni * 32 + lr;
#pragma unroll
      for (int ig = 0; ig < 4; ++ig) {
        const unsigned p01 = pack2(acc[mi][ni][4 * ig], acc[mi][ni][4 * ig + 1]), p23 = pack2(acc[mi][ni][4 * ig + 2], acc[mi][ni][4 * ig + 3]);
        d[(8 * ig) * LDS_T] = (bf16_t)(p01 & 0xffffu); d[(8 * ig + 1) * LDS_T] = (bf16_t)(p01 >> 16);
        d[(8 * ig + 2) * LDS_T] = (bf16_t)(p23 & 0xffffu); d[(8 * ig + 3) * LDS_T] = (bf16_t)(p23 >> 16);
      }
    }
}
DI void tile_writeout(bf16_t* __restrict__ dst, int ld, const bf16_t* sT) {
  const int tid = tidx();
#pragma unroll 4
  for (int it = 0; it < 16; ++it) {
    const int idx = tid + 256 * it, row = idx >> 5, chunk = idx & 31;
    *(uint4*)(dst + (size_t)row * ld + chunk * 8) = *(const uint4*)(sT + row * LDS_T + chunk * 8);
  }
}

DI void inproj_job(const P& p, int l, int job, char* smem) {
  int mt, nt;
  if (!gemm_tile(job, 129, 35, mt, nt)) return;
  int m0 = mt * 128, n0 = nt * 256;
  f32x16 acc[2][GNB];
#pragma unroll
  for (int a = 0; a < 2; ++a)
#pragma unroll
    for (int b = 0; b < GNB; ++b) zero16(acc[a][b]);
  gemm_mainloop(p.H() + (size_t)m0 * 1024, 1024, p.Wt() + (size_t)l * W_LAYER + WO_IN + (size_t)n0 * 1024, 1024, 1024, acc, smem);
  m0 = launder_s(m0); n0 = launder_s(n0);
  nt = launder_s(nt); mt = launder_s(mt);
  const int tid = tidx(), lane = tid & 63, w = __builtin_amdgcn_readfirstlane(tid >> 6), wm = w & 1, wn = w >> 1, lr = lane & 31, lh = lane >> 5;
  bf16_t* sT = (bf16_t*)smem;
  if (nt == 34) {
    if (wn == 0 && lr < 16) {
      const float bias = p.dt_bias[l * 16 + lr];
#pragma unroll
      for (int mi = 0; mi < 2; ++mi)
#pragma unroll
        for (int i = 0; i < 16; ++i) p.DT()[(size_t)(m0 + wm * 64 + mi * 32 + crow(i, lh)) * 16 + lr] = softplus_f(acc[mi][0][i] + bias);
    }
    return;
  }
  if (nt >= 16 && nt <= 20) {
#pragma unroll
    for (int mi = 0; mi < 2; ++mi)
#pragma unroll
      for (int ni = 0; ni < GNB; ni += 2)
#pragma unroll
        for (int i = 0; i < 16; ++i) {
          const float v = acc[mi][ni][i];
          const float pv = __shfl_xor(v, 8);
          if (lr < 16) {
            const int r = m0 + wm * 64 + mi * 32 + crow(i, lh);
            const int pos = (r >= TP) ? 8192 : (r & 8191);
            const float2 cs = p.ROPE()[pos * 8 + (lr & 7)];
            acc[mi][ni][i] = (lr < 8) ? v * cs.x - pv * cs.y : v * cs.x + pv * cs.y;
          }
        }
  }
  if (nt >= 22) {
#pragma unroll
    for (int mi = 0; mi < 2; ++mi)
#pragma unroll
      for (int ni = 0; ni < GNB; ++ni)
#pragma unroll
        for (int i = 0; i < 16; ++i) acc[mi][ni][i] = sigm_f(acc[mi][ni][i]);
  }
  if ((mt == 63 || mt == 127 || mt == 128) && ((nt >= 4 && nt < 12) || nt == 20 || nt == 21)) {
#pragma unroll
    for (int mi = 0; mi < 2; ++mi)
#pragma unroll
      for (int ni = 0; ni < GNB; ++ni) {
        const int cc = (n0 & 255) + wn * 128 + ni * 32 + lr;
        const int rb_ = launder(m0 + wm * 64 + mi * 32 + 4 * lh);
#pragma unroll
        for (int i = 0; i < 16; ++i) {
          const int r = rb_ + (i & 3) + 8 * (i >> 2);
          const float v = acc[mi][ni][i];
          if (nt < 12) {
            const int ch = (n0 - 1024) + cc;
            if (r >= TP) p.out[OFF_CONVS + ((size_t)(l * 128 + (r - TP)) * 3 + 2) * 2048 + ch] = v;
            else { const int t = r & 8191; if (t >= 8189) p.out[OFF_CONVP + ((size_t)(l * 2 + (r >> 13)) * 3 + (t - 8189)) * 2048 + ch] = v; }
          } else {
            const size_t ob = (nt == 20) ? OFF_KS : OFF_VS, obp = (nt == 20) ? OFF_KP : OFF_VP;
            if (r >= TP) p.out[ob + ((size_t)(l * 128 + (r - TP)) * 128 + 127) * 256 + cc] = v;
            else p.out[obp + ((size_t)(l * 2 + (r >> 13)) * 128 + ((r & 8191) - 8064)) * 256 + cc] = v;
          }
        }
        __builtin_amdgcn_sched_barrier(0);
      }
  }
  if (nt == 21) {
#pragma unroll
    for (int mi = 0; mi < 2; ++mi)
#pragma unroll
      for (int ni = 0; ni < GNB; ++ni) {
        bf16_t* d = sT + (wn * 128 + ni * 32 + lr) * 136 + wm * 64 + mi * 32 + 4 * lh;
#pragma unroll
        for (int ig = 0; ig < 4; ++ig)
          *(uint2*)(d + 8 * ig) = make_uint2(pack2(acc[mi][ni][4 * ig], acc[mi][ni][4 * ig + 1]), pack2(acc[mi][ni][4 * ig + 2], acc[mi][ni][4 * ig + 3]));
      }
    __syncthreads();
#pragma unroll 4
    for (int it = 0; it < 16; ++it) {
      const int idx = tid + 256 * it, c = idx >> 4, chunk = idx & 15;
      *(uint4*)(p.VT() + (size_t)c * T + m0 + chunk * 8) = *(const uint4*)(sT + c * 136 + chunk * 8);
    }
    return;
  }
  stage_tile(sT, acc, wm, wn, lr, lh);
  __syncthreads();
  bf16_t* dst; int ld;
  if (nt < 4) { dst = p.Z() + n0; ld = 1024; }
  else if (nt < 12) { dst = p.XBC() + (n0 - 1024); ld = 2048; }
  else if (nt < 16) { dst = p.U() + (n0 - 3072); ld = 1024; }
  else if (nt < 20) { dst = p.Q() + (n0 - 4096); ld = 1024; }
  else if (nt == 20) { dst = p.K(); ld = 256; }
  else { dst = p.G() + (n0 - 5632); ld = 3072; }
  tile_writeout(dst + (size_t)m0 * ld, ld, sT);
}

DI void conv_job(const P& p, int l, int job, char* smem) {
  const int ct = job & 31, tt = job >> 5;
  const int ch0 = ct * 64, tokb = tt * 128;
  bf16_t* sT = (bf16_t*)smem;
  const int tid = tidx();
  const float* cw = p.conv_w + (size_t)l * 4 * 2048;
  __syncthreads();
#pragma unroll
  for (int it = 0; it < 4; ++it) {
    const int item = tid + 256 * it, tl = item >> 3, chk = item & 7, ch = ch0 + chk * 8, row = tokb + tl, t = row & 8191;
    float a[8];
    {
      const float4 b0 = *(const float4*)(p.conv_b + l * 2048 + ch), b1 = *(const float4*)(p.conv_b + l * 2048 + ch + 4);
      a[0] = b0.x; a[1] = b0.y; a[2] = b0.z; a[3] = b0.w; a[4] = b1.x; a[5] = b1.y; a[6] = b1.z; a[7] = b1.w;
    }
#pragma unroll
    for (int j = 0; j < 4; ++j) {
      if (t - 3 + j >= 0) {
        const uint4 rv = *(const uint4*)(p.XBC() + (size_t)(row - 3 + j) * 2048 + ch);
        const float4 w0 = *(const float4*)(cw + j * 2048 + ch), w1 = *(const float4*)(cw + j * 2048 + ch + 4);
        a[0] += bflo(rv.x) * w0.x; a[1] += bfhi(rv.x) * w0.y; a[2] += bflo(rv.y) * w0.z; a[3] += bfhi(rv.y) * w0.w;
        a[4] += bflo(rv.z) * w1.x; a[5] += bfhi(rv.z) * w1.y; a[6] += bflo(rv.w) * w1.z; a[7] += bfhi(rv.w) * w1.w;
      }
    }
#pragma unroll
    for (int j = 0; j < 8; ++j) a[j] = silu_f(a[j]);
    if (ct >= 16) *(uint4*)(p.BC() + (size_t)row * 1024 + (ch - 1024)) = make_uint4(pack2(a[0], a[1]), pack2(a[2], a[3]), pack2(a[4], a[5]), pack2(a[6], a[7]));
    if (ct < 24) {
#pragma unroll
      for (int j = 0; j < 8; ++j) sT[(chk * 8 + j) * 136 + tl] = f2bf(a[j]);
    }
  }
  if (ct < 24) {
    __syncthreads();
#pragma unroll
    for (int it = 0; it < 4; ++it) {
      const int item = tid + 256 * it, r = item >> 4, chk = item & 15;
      *(uint4*)(p.XBT() + (size_t)(ch0 + r) * TP + tokb + chk * 8) = *(const uint4*)(sT + r * 136 + chk * 8);
    }
  }
}

DI void chunk_acum(const P& p, int l, int head, int tok0, float* sAc, float* sDt, float& alast) {
  const int lane = tidx() & 63;
  const float Ah = -expf(p.a_log[l * 16 + head]);
  const float d0 = p.DT()[(size_t)(tok0 + 2 * lane) * 16 + head], d1 = p.DT()[(size_t)(tok0 + 2 * lane + 1) * 16 + head];
  const float a0 = d0 * Ah, a1 = d1 * Ah;
  float s = a0 + a1;
#pragma unroll
  for (int off = 1; off < 64; off <<= 1) { const float tv = __shfl_up(s, off); if (lane >= off) s += tv; }
  const float excl = s - (a0 + a1);
  sAc[2 * lane] = excl + a0; sAc[2 * lane + 1] = s;
  sDt[2 * lane] = d0; sDt[2 * lane + 1] = d1;
  alast = __shfl(s, 63);
}

DI void ssd_a_job(const P& p, int l, int job, char* smem) {
  const int head = job & 15, c = (job >> 4) & 63, b = job >> 10, g = head >> 2;
  const int tok0 = b * SEQ + c * 128;
  bf16_t* sXT = (bf16_t*)smem;
  bf16_t* sBT = sXT + 64 * 136;
  float* sW = (float*)(sBT + 128 * 136);
  float* sAc = sW + 128;
  float* sDt = sAc + 128;
  const int tid = tidx(), lane = tid & 63, w = __builtin_amdgcn_readfirstlane(tid >> 6), lr = lane & 31, lh = lane >> 5;
  __syncthreads();
  if (w == 0) {
    float alast;
    chunk_acum(p, l, head, tok0, sAc, sDt, alast);
    sW[2 * lane] = sDt[2 * lane] * __expf(alast - sAc[2 * lane]);
    sW[2 * lane + 1] = sDt[2 * lane + 1] * __expf(alast - sAc[2 * lane + 1]);
    if (lane == 0) p.CDEC()[(b * 64 + c) * 16 + head] = __expf(alast);
  }
  __syncthreads();
#pragma unroll
  for (int it = 0; it < 4; ++it) {
    const int item = tid + 256 * it, pr = item >> 4, s0 = (item & 15) * 8;
    const uint4 v = *(const uint4*)(p.XBT() + (size_t)(head * 64 + pr) * TP + tok0 + s0);
    const float4 w0 = *(const float4*)(sW + s0), w1 = *(const float4*)(sW + s0 + 4);
    *(uint4*)(sXT + pr * 136 + s0) = make_uint4(pack2(bflo(v.x) * w0.x, bfhi(v.x) * w0.y), pack2(bflo(v.y) * w0.z, bfhi(v.y) * w0.w),
                                                pack2(bflo(v.z) * w1.x, bfhi(v.z) * w1.y), pack2(bflo(v.w) * w1.z, bfhi(v.w) * w1.w));
  }
#pragma unroll
  for (int it = 0; it < 8; ++it) {
    const int item = tid + 256 * it, n = item >> 4, s0 = (item & 15) * 8;
    *(uint4*)(sBT + n * 136 + s0) = *(const uint4*)(p.XBT() + (size_t)(1024 + g * 128 + n) * TP + tok0 + s0);
  }
  __syncthreads();
  const int wp = w & 1, wn = w >> 1;
  f32x16 acc[2];
  zero16(acc[0]); zero16(acc[1]);
#pragma unroll
  for (int kk = 0; kk < 8; ++kk) {
    const bf16x8 af = *(const bf16x8*)(sXT + (wp * 32 + lr) * 136 + kk * 16 + lh * 8);
#pragma unroll
    for (int ni = 0; ni < 2; ++ni) {
      const bf16x8 bfr = *(const bf16x8*)(sBT + (wn * 64 + ni * 32 + lr) * 136 + kk * 16 + lh * 8);
      acc[ni] = MFMA32(af, bfr, acc[ni]);
    }
  }
  float* st = p.ST() + ((size_t)((b * 64 + c) * 16 + head) * 64) * 128;
#pragma unroll
  for (int ni = 0; ni < 2; ++ni)
#pragma unroll
    for (int i = 0; i < 16; ++i) st[(wp * 32 + crow(i, lh)) * 128 + wn * 64 + ni * 32 + lr] = acc[ni][i];
}

DI void ssd_scan_job(const P& p, int l, int job) {
  const int gid = job * 256 + tidx();
  const int b = gid >> 15, rem = gid & 32767, head = rem >> 11;
  float4 h = make_float4(0.f, 0.f, 0.f, 0.f);
  const float4* sp0 = (const float4*)(p.ST() + (size_t)(b * 64) * 131072) + rem;
  uint2* hp0 = (uint2*)(p.HP() + (size_t)(b * 64) * 131072) + rem;
  for (int c0 = 0; c0 < 64; c0 += 8) {
    float4 sv[8];
    float dv[8];
#pragma unroll
    for (int k = 0; k < 8; ++k) { sv[k] = sp0[(size_t)(c0 + k) * 32768]; dv[k] = p.CDEC()[(b * 64 + c0 + k) * 16 + head]; }
#pragma unroll
    for (int k = 0; k < 8; ++k) {
      hp0[(size_t)(c0 + k) * 32768] = make_uint2(pack2(h.x, h.y), pack2(h.z, h.w));
      h.x = h.x * dv[k] + sv[k].x; h.y = h.y * dv[k] + sv[k].y; h.z = h.z * dv[k] + sv[k].z; h.w = h.w * dv[k] + sv[k].w;
    }
  }
  ((float4*)(p.out + OFF_SSMP + (size_t)(l * 2 + b) * 131072))[rem] = h;
}

DI void s5_scan_job(const P& p, int l, int job) {
  const int gid = job * 256 + tidx();
  const int n = gid & 63, g = (gid >> 6) & 63, b = gid >> 12;
  const float* prm = p.S5P() + ((size_t)(l * 64 + g) * 36) * 64 + n;
  const float aqr = prm[128], aqi = prm[192];
  float hr = 0.f, hi = 0.f;
  float2* sp = (float2*)p.S5S() + ((size_t)(b * 128) * 64 + g) * 64 + n;
  for (int c0 = 0; c0 < 128; c0 += 8) {
    float2 sv[8];
#pragma unroll
    for (int k = 0; k < 8; ++k) sv[k] = sp[(size_t)(c0 + k) * 4096];
#pragma unroll
    for (int k = 0; k < 8; ++k) {
      sp[(size_t)(c0 + k) * 4096] = make_float2(hr, hi);
      const float nr = aqr * hr - aqi * hi + sv[k].x, ni = aqr * hi + aqi * hr + sv[k].y;
      hr = nr; hi = ni;
    }
  }
}

DI void ssd_c_job(const P& p, int l, int job, char* smem) {
  const int g = job & 3, c = (job >> 2) & 63, b = job >> 8;
  const int tok0 = b * SEQ + c * 128;
  bf16_t* sC = (bf16_t*)smem;
  bf16_t* sB = sC + 128 * 136;
  float* sAc = (float*)(sB + 128 * 136);
  float* sDt = sAc + 512;
  const int tid = tidx(), lane = tid & 63, w = __builtin_amdgcn_readfirstlane(tid >> 6), lr = lane & 31, lh = lane >> 5, wm = w & 1, wn = w >> 1;
  __syncthreads();
  { float alast; chunk_acum(p, l, g * 4 + w, tok0, sAc + w * 128, sDt + w * 128, alast); }
#pragma unroll
  for (int it = 0; it < 8; ++it) {
    const int item = tid + 256 * it, r = item >> 4, s0 = (item & 15) * 8;
    *(uint4*)(sC + r * 136 + s0) = *(const uint4*)(p.BC() + (size_t)(tok0 + r) * 1024 + 512 + g * 128 + s0);
    *(uint4*)(sB + r * 136 + s0) = *(const uint4*)(p.BC() + (size_t)(tok0 + r) * 1024 + g * 128 + s0);
  }
  __syncthreads();
  f32x16 cb[2][2];
#pragma unroll
  for (int a = 0; a < 2; ++a)
#pragma unroll
    for (int bb = 0; bb < 2; ++bb) zero16(cb[a][bb]);
  if (!(wm == 0 && wn == 1)) {
#pragma unroll
    for (int kk = 0; kk < 8; ++kk) {
      bf16x8 af[2], bfr[2];
#pragma unroll
      for (int mi = 0; mi < 2; ++mi) af[mi] = *(const bf16x8*)(sC + (wm * 64 + mi * 32 + lr) * 136 + kk * 16 + lh * 8);
#pragma unroll
      for (int ni = 0; ni < 2; ++ni) bfr[ni] = *(const bf16x8*)(sB + (wn * 64 + ni * 32 + lr) * 136 + kk * 16 + lh * 8);
#pragma unroll
      for (int mi = 0; mi < 2; ++mi)
#pragma unroll
        for (int ni = 0; ni < 2; ++ni) cb[mi][ni] = MFMA32(af[mi], bfr[ni], cb[mi][ni]);
    }
  }
  __syncthreads();
  bf16_t* sM = sB;
  unsigned cbp[2][2][8];
#pragma unroll
  for (int a = 0; a < 2; ++a)
#pragma unroll
    for (int bb = 0; bb < 2; ++bb)
#pragma unroll
      for (int k = 0; k < 8; ++k) cbp[a][bb][k] = pack2(cb[a][bb][2 * k], cb[a][bb][2 * k + 1]);
  float ss[16];
#pragma unroll
  for (int i = 0; i < 16; ++i) ss[i] = 0.f;
#pragma unroll 1
  for (int hd = 0; hd < 4; ++hd) {
    const int head = g * 4 + hd;
    const float* ac = sAc + hd * 128;
    const float* dtv = sDt + hd * 128;
    const int lrq = launder(lr), lhq = launder(lh);
#pragma unroll
    for (int mi = 0; mi < 2; ++mi)
#pragma unroll
      for (int ni = 0; ni < 2; ++ni) {
        const int s = wn * 64 + ni * 32 + lrq;
        const float as = ac[s], ds = dtv[s];
#pragma unroll
        for (int i = 0; i < 16; ++i) {
          const int t = wm * 64 + mi * 32 + crow(i, lhq);
          const float cv = (i & 1) ? bfhi(cbp[mi][ni][i >> 1]) : bflo(cbp[mi][ni][i >> 1]);
          const float v = (s <= t) ? cv * __expf(ac[t] - as) * ds : 0.f;
          sM[t * 136 + s] = f2bf(v);
        }
        __builtin_amdgcn_sched_barrier(0);
      }
    __syncthreads();
    f32x16 yd[2];
    zero16(yd[0]); zero16(yd[1]);
    {
      const bf16_t* hb = p.HP() + (((size_t)((b * 64 + c) * 16 + head) * 64 + lr) * 128 + lh * 8);
      bf16x8 hf[8][2];
#pragma unroll
      for (int kk = 0; kk < 8; ++kk)
#pragma unroll
        for (int pb = 0; pb < 2; ++pb) hf[kk][pb] = *(const bf16x8*)(hb + (size_t)pb * 32 * 128 + kk * 16);
#pragma unroll
      for (int kk = 0; kk < 8; ++kk) {
        const bf16x8 af = *(const bf16x8*)(sC + (32 * w + lr) * 136 + kk * 16 + lh * 8);
        yd[0] = MFMA32(af, hf[kk][0], yd[0]);
        yd[1] = MFMA32(af, hf[kk][1], yd[1]);
      }
    }
#pragma unroll
    for (int i = 0; i < 16; ++i) {
      const float e = __expf(ac[32 * w + crow(i, lh)]);
      yd[0][i] *= e; yd[1][i] *= e;
    }
    {
      const int nkk = 2 * (w + 1);
      const bf16_t* xb = p.XBT() + (size_t)(head * 64 + lr) * TP + tok0 + lh * 8;
      const bf16_t* am = sM + (32 * w + lr) * 136 + lh * 8;
      bf16x8 x00 = *(const bf16x8*)(xb), x01 = *(const bf16x8*)(xb + (size_t)32 * TP);
      for (int kk = 0; kk < nkk; kk += 2) {
        const bf16x8 x10 = *(const bf16x8*)(xb + (kk + 1) * 16), x11 = *(const bf16x8*)(xb + (size_t)32 * TP + (kk + 1) * 16);
        const bf16x8 a0 = *(const bf16x8*)(am + kk * 16);
        yd[0] = MFMA32(a0, x00, yd[0]);
        yd[1] = MFMA32(a0, x01, yd[1]);
        const int kn = (kk + 2 < nkk) ? kk + 2 : kk;
        x00 = *(const bf16x8*)(xb + kn * 16); x01 = *(const bf16x8*)(xb + (size_t)32 * TP + kn * 16);
        const bf16x8 a1 = *(const bf16x8*)(am + (kk + 1) * 16);
        yd[0] = MFMA32(a1, x10, yd[0]);
        yd[1] = MFMA32(a1, x11, yd[1]);
      }
    }
    const float Dh = p.m_d[l * 16 + head];
#pragma unroll
    for (int pb = 0; pb < 2; ++pb) {
      const int pch = head * 64 + pb * 32 + lr;
#pragma unroll
      for (int ig = 0; ig < 4; ++ig) {
        const int t0 = 32 * w + 8 * ig + 4 * lh;
        const uint2 xr = *(const uint2*)(p.XBT() + (size_t)pch * TP + tok0 + t0);
        const float xs[4] = {bflo(xr.x), bfhi(xr.x), bflo(xr.y), bfhi(xr.y)};
#pragma unroll
        for (int jj = 0; jj < 4; ++jj) {
          const int i = 4 * ig + jj, t = t0 + jj;
          const float y = yd[pb][i] + Dh * xs[jj];
          const float z = bf2f(p.Z()[(size_t)(tok0 + t) * 1024 + pch]);
          const float yg = y * silu_f(z);
          ss[i] += yg * yg;
          p.YM()[(size_t)(tok0 + t) * 1024 + pch] = f2bf(yg);
        }
      }
      __builtin_amdgcn_sched_barrier(0);
    }
    __syncthreads();
  }
#pragma unroll
  for (int i = 0; i < 16; ++i) {
    float v = ss[i];
    v += __shfl_xor(v, 1); v += __shfl_xor(v, 2); v += __shfl_xor(v, 4); v += __shfl_xor(v, 8); v += __shfl_xor(v, 16);
    ss[i] = rsqrtf(v * (1.f / 256.f) + EPS);
  }
  for (int hd = 0; hd < 4; ++hd) {
#pragma unroll
    for (int pb = 0; pb < 2; ++pb) {
      const int pch = (g * 4 + hd) * 64 + pb * 32 + lr;
      const float nw = p.m_norm_w[l * 1024 + pch];
#pragma unroll
      for (int i = 0; i < 16; ++i) {
        const size_t idx = (size_t)(tok0 + 32 * w + crow(i, lh)) * 1024 + pch;
        p.YM()[idx] = f2bf(bf2f(p.YM()[idx]) * ss[i] * nw);
      }
      __builtin_amdgcn_sched_barrier(0);
    }
  }
}

DI void ssd_sample_job(const P& p, int l, int job, char* smem) {
  const int g = job & 3, b = job >> 2;
  float* sx = (float*)smem;
  float* sBv = sx + 256;
  float* sCv = sBv + 128;
  float* sY = sCv + 128;
  float* sRed = sY + 256;
  const int tid = tidx(), lane = tid & 63, w = __builtin_amdgcn_readfirstlane(tid >> 6);
  const int row = TP + b;
  __syncthreads();
#pragma unroll
  for (int it = 0; it < 2; ++it) {
    const int idx = tid + 256 * it;
    const int ch = idx < 256 ? g * 256 + idx : (idx < 384 ? 1024 + g * 128 + (idx - 256) : 1536 + g * 128 + (idx - 384));
    const float* sc = p.state_conv + ((size_t)(l * 128 + b) * 3) * 2048 + ch;
    const float s0 = sc[0], s1 = sc[2048], s2 = sc[4096];
    const float raw = bf2f(p.XBC()[(size_t)row * 2048 + ch]);
    const float* cw = p.conv_w + (size_t)l * 4 * 2048 + ch;
    float v = p.conv_b[l * 2048 + ch] + cw[0] * s0 + cw[2048] * s1 + cw[4096] * s2 + cw[6144] * raw;
    v = silu_f(v);
    sx[idx] = v;
    float* co = p.out + OFF_CONVS + ((size_t)(l * 128 + b) * 3) * 2048 + ch;
    co[0] = s1; co[2048] = s2;
  }
  __syncthreads();
  const int pp = tid >> 2, nq = (tid & 3) * 32;
  float4 hv[4][8];
#pragma unroll
  for (int hd = 0; hd < 4; ++hd) {
    const float4* h0 = (const float4*)(p.state_ssm + ((((size_t)l * 128 + b) * 16 + g * 4 + hd) * 64 + pp) * 128 + nq);
#pragma unroll
    for (int q = 0; q < 8; ++q) hv[hd][q] = h0[q];
  }
#pragma unroll
  for (int hd = 0; hd < 4; ++hd) {
    const int head = g * 4 + hd;
    const float dt = p.DT()[(size_t)row * 16 + head];
    const float Ah = -expf(p.a_log[l * 16 + head]);
    const float dA = __expf(dt * Ah);
    const float xv = sx[hd * 64 + pp];
    const float coef = dt * xv;
    float4* ho = (float4*)(p.out + OFF_SSMS + ((((size_t)l * 128 + b) * 16 + head) * 64 + pp) * 128 + nq);
    float yacc = 0.f;
#pragma unroll
    for (int q = 0; q < 8; ++q) {
      float4 h4 = hv[hd][q];
      const int n = nq + 4 * q;
      h4.x = h4.x * dA + coef * sBv[n]; h4.y = h4.y * dA + coef * sBv[n + 1]; h4.z = h4.z * dA + coef * sBv[n + 2]; h4.w = h4.w * dA + coef * sBv[n + 3];
      yacc += h4.x * sCv[n] + h4.y * sCv[n + 1] + h4.z * sCv[n + 2] + h4.w * sCv[n + 3];
      ho[q] = h4;
    }
    yacc += __shfl_xor(yacc, 1); yacc += __shfl_xor(yacc, 2);
    const float y = yacc + p.m_d[l * 16 + head] * xv;
    const float z = bf2f(p.Z()[(size_t)row * 1024 + head * 64 + pp]);
    if ((tid & 3) == 0) sY[hd * 64 + pp] = y * silu_f(z);
  }
  __syncthreads();
  const float v = sY[tid];
  const float ssq = wave_sum(v * v);
  if (lane == 0) sRed[w] = ssq;
  __syncthreads();
  const float tot = sRed[0] + sRed[1] + sRed[2] + sRed[3];
  const float sc = rsqrtf(tot * (1.f / 256.f) + EPS);
  p.YM()[(size_t)row * 1024 + g * 256 + tid] = f2bf(v * sc * p.m_norm_w[l * 1024 + g * 256 + tid]);
}

DI void s5_wave_job(const P& p, int l, int mode, int b, int g, int c, bf16_t* sH) {
  const int lane = tidx() & 63, lr = lane & 31, lh = lane >> 5;
  bf16x8 bq[4];
#pragma unroll
  for (int nb = 0; nb < 4; ++nb) bq[nb] = *(const bf16x8*)(p.BBT() + ((size_t)(l * 64 + g) * 128 + nb * 32 + lr) * 16 + lh * 8);
  float ar[2], ai[2], cr_[2], ci_[2];
  int row0, Q;
  if (mode == 2) { row0 = TP + b; Q = 1; } else { row0 = b * SEQ + c * 64; Q = 64; }
#pragma unroll
  for (int k = 0; k < 2; ++k) {
    const int n = k * 32 + lr;
    const float* prm = p.S5P() + ((size_t)(l * 64 + g) * 36) * 64 + n;
    ar[k] = prm[0]; ai[k] = prm[64];
    cr_[k] = 0.f; ci_[k] = 0.f;
    if (mode == 2) {
      cr_[k] = p.s5_sre[((size_t)(l * 128 + b) * 64 + g) * 64 + n];
      ci_[k] = p.s5_sim[((size_t)(l * 128 + b) * 64 + g) * 64 + n];
    } else if (mode == 1) {
      const float2 sv = *(const float2*)(p.S5S() + (((size_t)(b * 128 + c) * 64 + g) * 64 + n) * 2);
      cr_[k] = sv.x; ci_[k] = sv.y;
    }
  }
  const int ntb = (mode == 2) ? 1 : 2;
  for (int tb = 0; tb < ntb; ++tb) {
    const bf16x8 uf = *(const bf16x8*)(p.U() + (size_t)(row0 + tb * 32 + lr) * 1024 + g * 16 + lh * 8);
    f32x16 acc[4];
#pragma unroll
    for (int nb = 0; nb < 4; ++nb) { zero16(acc[nb]); acc[nb] = MFMA32(uf, bq[nb], acc[nb]); }
#pragma unroll
    for (int k = 0; k < 2; ++k) {
      const float a1r = ar[k], a1i = ai[k];
      const float a2r = a1r * a1r - a1i * a1i, a2i = 2.f * a1r * a1i;
      const float a3r = a2r * a1r - a2i * a1i, a3i = a2r * a1i + a2i * a1r;
      const float a4r = a2r * a2r - a2i * a2i, a4i = 2.f * a2r * a2i;
      float er[4], ei[4];
#pragma unroll
      for (int q = 0; q < 4; ++q) {
        float hr = acc[k][4 * q], hi = acc[2 + k][4 * q];
#pragma unroll
        for (int j = 1; j < 4; ++j) {
          const float nr = a1r * hr - a1i * hi + acc[k][4 * q + j], ni = a1r * hi + a1i * hr + acc[2 + k][4 * q + j];
          hr = nr; hi = ni;
          acc[k][4 * q + j] = hr; acc[2 + k][4 * q + j] = hi;
        }
        er[q] = hr; ei[q] = hi;
      }
      float cinr[4], cini[4];
      float cr = cr_[k], ci = ci_[k];
#pragma unroll
      for (int q = 0; q < 4; ++q) {
        const float per = __shfl_xor(er[q], 32), pei = __shfl_xor(ei[q], 32);
        const float e0r = lh ? per : er[q], e0i = lh ? pei : ei[q];
        const float e1r = lh ? er[q] : per, e1i = lh ? ei[q] : pei;
        const float c1r = a4r * cr - a4i * ci + e0r, c1i = a4r * ci + a4i * cr + e0i;
        cinr[q] = lh ? c1r : cr; cini[q] = lh ? c1i : ci;
        cr = a4r * c1r - a4i * c1i + e1r; ci = a4r * c1i + a4i * c1r + e1i;
      }
#pragma unroll
      for (int q = 0; q < 4; ++q) {
        const float xr = cinr[q], xi = cini[q];
        acc[k][4 * q] += a1r * xr - a1i * xi;     acc[2 + k][4 * q] += a1r * xi + a1i * xr;
        acc[k][4 * q + 1] += a2r * xr - a2i * xi; acc[2 + k][4 * q + 1] += a2r * xi + a2i * xr;
        acc[k][4 * q + 2] += a3r * xr - a3i * xi; acc[2 + k][4 * q + 2] += a3r * xi + a3i * xr;
        acc[k][4 * q + 3] += a4r * xr - a4i * xi; acc[2 + k][4 * q + 3] += a4r * xi + a4i * xr;
      }
      if (mode == 2) { cr_[k] = acc[k][0]; ci_[k] = acc[2 + k][0]; }
      else { cr_[k] = cr; ci_[k] = ci; }
      if (mode != 0) {
#pragma unroll
        for (int i = 0; i < 16; ++i) {
          const int t = tb * 32 + crow(i, lh);
          sH[t * 136 + k * 32 + lr] = f2bf(acc[k][i]);
          sH[t * 136 + 64 + k * 32 + lr] = f2bf(acc[2 + k][i]);
        }
      }
    }
  }
  if (lh == 0) {
#pragma unroll
    for (int k = 0; k < 2; ++k) {
      const int n = k * 32 + lr;
      if (mode == 0) *(float2*)(p.S5S() + (((size_t)(b * 128 + c) * 64 + g) * 64 + n) * 2) = make_float2(cr_[k], ci_[k]);
      if (mode == 1 && c == 127) {
        p.out[OFF_S5RP + ((size_t)(l * 2 + b) * 64 + g) * 64 + n] = cr_[k];
        p.out[OFF_S5IP + ((size_t)(l * 2 + b) * 64 + g) * 64 + n] = ci_[k];
      }
      if (mode == 2) {
        p.out[OFF_S5RS + ((size_t)(l * 128 + b) * 64 + g) * 64 + n] = cr_[k];
        p.out[OFF_S5IS + ((size_t)(l * 128 + b) * 64 + g) * 64 + n] = ci_[k];
      }
    }
  }
  if (mode == 0) return;
  const int o = lane & 15, quad = lane >> 4;
  bf16x8 cf[4];
#pragma unroll
  for (int kk = 0; kk < 4; ++kk) {
    const float* cp = ((kk < 2) ? p.c_re : p.c_im) + ((size_t)(l * 64 + g) * 16 + o) * 64 + (kk & 1) * 32 + quad * 8;
    const float4 c0 = ((const float4*)cp)[0], c1 = ((const float4*)cp)[1];
    const float sg = (kk < 2) ? 1.f : -1.f;
    cf[kk] = u4_to_bf8(make_uint4(pack2(sg * c0.x, sg * c0.y), pack2(sg * c0.z, sg * c0.w), pack2(sg * c1.x, sg * c1.y), pack2(sg * c1.z, sg * c1.w)));
  }
  const float dsk = p.s5_d[l * 1024 + g * 16 + o];
  const int nrb = (mode == 2) ? 1 : 4;
  __builtin_amdgcn_fence(__ATOMIC_RELEASE, "wavefront");
  __builtin_amdgcn_wave_barrier();
  __builtin_amdgcn_fence(__ATOMIC_ACQUIRE, "wavefront");
  for (int rb = 0; rb < nrb; ++rb) {
    f32x4 a4 = {0.f, 0.f, 0.f, 0.f};
#pragma unroll
    for (int kk = 0; kk < 4; ++kk) {
      const bf16x8 af = *(const bf16x8*)(sH + (rb * 16 + o) * 136 + kk * 32 + quad * 8);
      a4 = MFMA16(af, cf[kk], a4);
    }
#pragma unroll
    for (int jj = 0; jj < 4; ++jj) {
      const int t = rb * 16 + quad * 4 + jj;
      if (t < Q) {
        const size_t idx = (size_t)(row0 + t) * 1024 + g * 16 + o;
        const float y = a4[jj] + dsk * bf2f(p.U()[idx]);
        p.YS()[idx] = f2bf(gelu_tanh(y));
      }
    }
  }
}

DI void attn_prompt_job(const P& p, int l, int job, char* smem) {
  const int head = job & 15, blk = (job >> 4) & 63, b = job >> 10, kvh = head >> 2;
  bf16_t* sK = (bf16_t*)smem;
  bf16_t* sVt = sK + 256 * 72;
  const int tid = tidx(), lane = tid & 63, w = __builtin_amdgcn_readfirstlane(tid >> 6), lr = lane & 31, lh = lane >> 5;
  const int tokc0 = b * SEQ + blk * 128 - 128;
  __syncthreads();
#pragma unroll
  for (int it = 0; it < 8; ++it) {
    const int item = tid + 256 * it, row = item >> 3, chk = item & 7;
    uint4 v = make_uint4(0u, 0u, 0u, 0u);
    if (blk > 0 || row >= 128) v = *(const uint4*)(p.K() + (size_t)(tokc0 + row) * 256 + kvh * 64 + chk * 8);
    *(uint4*)(sK + row * 72 + chk * 8) = v;
  }
#pragma unroll
  for (int it = 0; it < 8; ++it) {
    const int item = tid + 256 * it, d = item >> 5, chk = item & 31;
    uint4 v = make_uint4(0u, 0u, 0u, 0u);
    if (blk > 0 || chk >= 16) v = *(const uint4*)(p.VT() + (size_t)(kvh * 64 + d) * T + tokc0 + chk * 8);
    *(uint4*)(sVt + d * 264 + chk * 8) = v;
  }
  __syncthreads();
  const int qtok = b * SEQ + blk * 128 + 32 * w + lr;
  bf16x8 qf[4];
#pragma unroll
  for (int kk = 0; kk < 4; ++kk) qf[kk] = *(const bf16x8*)(p.Q() + (size_t)qtok * 1024 + head * 64 + kk * 16 + lh * 8);
  f32x16 st[5];
#pragma unroll
  for (int x = 0; x < 5; ++x) {
    zero16(st[x]);
#pragma unroll
    for (int kk = 0; kk < 4; ++kk) {
      const bf16x8 af = *(const bf16x8*)(sK + (32 * (w + x) + lr) * 72 + kk * 16 + lh * 8);
      st[x] = MFMA32(af, qf[kk], st[x]);
    }
  }
  const float sink = p.sinks[l * 16 + head];
  const int qi = 128 + 32 * w + lr;
  float m = sink;
#pragma unroll
  for (int x = 0; x < 5; ++x)
#pragma unroll
    for (int i = 0; i < 16; ++i) {
      const int kj = 32 * (w + x) + crow(i, lh);
      const bool valid = (kj <= qi) && (kj >= qi - 128) && (blk > 0 || kj >= 128);
      const float s = valid ? st[x][i] * 0.125f : -1e30f;
      st[x][i] = s;
      m = fmaxf(m, s);
    }
  m = fmaxf(m, __shfl_xor(m, 32));
  float sum = 0.f;
#pragma unroll
  for (int x = 0; x < 5; ++x)
#pragma unroll
    for (int i = 0; i < 16; ++i) { const float pv = __expf(st[x][i] - m); st[x][i] = pv; sum += pv; }
  sum += __shfl_xor(sum, 32);
  const float inv = 1.f / (sum + __expf(sink - m));
  f32x16 ot[2];
  zero16(ot[0]); zero16(ot[1]);
#pragma unroll
  for (int x = 0; x < 5; ++x)
#pragma unroll
    for (int s = 0; s < 2; ++s) {
      const uint4 pu = make_uint4(pack2(st[x][8 * s] * inv, st[x][8 * s + 1] * inv), pack2(st[x][8 * s + 2] * inv, st[x][8 * s + 3] * inv),
                                  pack2(st[x][8 * s + 4] * inv, st[x][8 * s + 5] * inv), pack2(st[x][8 * s + 6] * inv, st[x][8 * s + 7] * inv));
      const bf16x8 pf = u4_to_bf8(pu);
#pragma unroll
      for (int pb = 0; pb < 2; ++pb) {
        const bf16_t* vp = sVt + (pb * 32 + lr) * 264 + 32 * (w + x) + 16 * s + 4 * lh;
        const uint2 lo = *(const uint2*)vp, hi2 = *(const uint2*)(vp + 8);
        ot[pb] = MFMA32(u4_to_bf8(make_uint4(lo.x, lo.y, hi2.x, hi2.y)), pf, ot[pb]);
      }
    }
#pragma unroll
  for (int pb = 0; pb < 2; ++pb)
#pragma unroll
    for (int ig = 0; ig < 4; ++ig) {
      const int d0 = pb * 32 + 8 * ig + 4 * lh;
      *(uint2*)(p.O() + (size_t)qtok * 1024 + head * 64 + d0) = make_uint2(pack2(ot[pb][4 * ig], ot[pb][4 * ig + 1]), pack2(ot[pb][4 * ig + 2], ot[pb][4 * ig + 3]));
    }
}

DI void attn_sample_job(const P& p, int l, int job, char* smem) {
  const int kvh = job & 3, b = job >> 2;
  const int tid = tidx(), lane = tid & 63, w = __builtin_amdgcn_readfirstlane(tid >> 6);
  const int head = kvh * 4 + w, row = TP + b;
  float* sQ = (float*)smem;
  float* sP = sQ + 256;
  const size_t cbase = ((size_t)(l * 128 + b) * 128) * 256 + kvh * 64;
  const float4* kc4 = (const float4*)(p.cache_k + cbase);
  const float4* vc4 = (const float4*)(p.cache_v + cbase);
  float4* ko4 = (float4*)(p.out + OFF_KS + cbase);
  float4* vo4 = (float4*)(p.out + OFF_VS + cbase);
  __syncthreads();
  for (int idx = tid; idx < 127 * 16; idx += 256) {
    const int j = idx >> 4, q4 = idx & 15;
    ko4[j * 64 + q4] = kc4[(j + 1) * 64 + q4];
    vo4[j * 64 + q4] = vc4[(j + 1) * 64 + q4];
  }
  const float qd = bf2f(p.Q()[(size_t)row * 1024 + head * 64 + lane]);
  sQ[w * 64 + lane] = qd;
  __syncthreads();
  float s0 = 0.f, s1 = 0.f;
#pragma unroll 4
  for (int d4 = 0; d4 < 16; ++d4) {
    const float4 q4 = ((const float4*)(sQ + w * 64))[d4];
    const float4 k0 = kc4[lane * 64 + d4], k1 = kc4[(lane + 64) * 64 + d4];
    s0 += q4.x * k0.x + q4.y * k0.y + q4.z * k0.z + q4.w * k0.w;
    s1 += q4.x * k1.x + q4.y * k1.y + q4.z * k1.z + q4.w * k1.w;
  }
  s0 *= 0.125f; s1 *= 0.125f;
  const float s2 = wave_sum(qd * bf2f(p.K()[(size_t)row * 256 + kvh * 64 + lane])) * 0.125f;
  const float sink = p.sinks[l * 16 + head];
  float m = fmaxf(fmaxf(s0, s1), fmaxf(s2, sink));
  m = wave_max(m);
  const float p0 = __expf(s0 - m), p1 = __expf(s1 - m), p2 = __expf(s2 - m);
  const float sum = wave_sum(p0 + p1);
  const float inv = 1.f / (sum + p2 + __expf(sink - m));
  sP[w * 132 + lane] = p0 * inv; sP[w * 132 + 64 + lane] = p1 * inv;
  __syncthreads();
  const float* vc = p.cache_v + cbase + lane;
  float o = 0.f;
#pragma unroll 8
  for (int j = 0; j < 128; ++j) o += sP[w * 132 + j] * vc[(size_t)j * 256];
  o += p2 * inv * bf2f(p.VT()[(size_t)(kvh * 64 + lane) * T + row]);
  p.O()[(size_t)row * 1024 + head * 64 + lane] = f2bf(o);
}

template <int PASS>
DI void merge_pass(const P& p, const bf16_t* A, const bf16_t* Wt, int m0, int n0, char* smem) {
  m0 = launder_s(m0); n0 = launder_s(n0);
  const int tid = tidx(), lane = tid & 63, w = __builtin_amdgcn_readfirstlane(tid >> 6), wm = w & 1, wn = w >> 1, lr = lane & 31, lh = lane >> 5;
  f32x16 acc[2][GNB];
#pragma unroll
  for (int a = 0; a < 2; ++a)
#pragma unroll
    for (int b = 0; b < GNB; ++b) zero16(acc[a][b]);
  gemm_mainloop(A + (size_t)m0 * 1024, 1024, Wt + (size_t)n0 * 1024, 1024, 1024, acc, smem);
  m0 = launder_s(m0); n0 = launder_s(n0);
  bf16_t* sT = (bf16_t*)smem;
  stage_tile(sT, acc, wm, wn, lr, lh);
  __syncthreads();
  const int goff = (PASS == 0) ? 1024 : (PASS == 2) ? 0 : 2048;
#pragma unroll 2
  for (int it = 0; it < 16; ++it) {
    const int idx = tid + 256 * it, row = idx >> 5, chunk = idx & 31;
    const uint4 av = *(const uint4*)(sT + row * LDS_T + chunk * 8);
    uint4* mp = (uint4*)(p.MG() + (size_t)(m0 + row) * 1024 + n0 + chunk * 8);
    uint4 gv = make_uint4(0u, 0u, 0u, 0u), mv = gv;
    if (PASS != 1) gv = *(const uint4*)(p.G() + (size_t)(m0 + row) * 3072 + goff + n0 + chunk * 8);
    if (PASS != 0) mv = *mp;
    const unsigned aw[4] = {av.x, av.y, av.z, av.w}, gw[4] = {gv.x, gv.y, gv.z, gv.w}, mw[4] = {mv.x, mv.y, mv.z, mv.w};
    unsigned ow[4];
#pragma unroll
    for (int k = 0; k < 4; ++k) {
      const float a0 = bflo(aw[k]), a1 = bfhi(aw[k]), g0 = bflo(gw[k]), g1 = bfhi(gw[k]), m0_ = bflo(mw[k]), m1_ = bfhi(mw[k]);
      float o0, o1;
      if (PASS == 0) { o0 = sigm_f(a0) * g0; o1 = sigm_f(a1) * g1; }
      else if (PASS == 1) { o0 = m0_ * a0; o1 = m1_ * a1; }
      else { o0 = m0_ + a0 * g0; o1 = m1_ + a1 * g1; }
      ow[k] = pack2(o0, o1);
    }
    *mp = make_uint4(ow[0], ow[1], ow[2], ow[3]);
  }
}
DI void merge_job(const P& p, int l, int job, char* smem) {
  int mt, nt;
  if (!gemm_tile(job, 128, 4, mt, nt)) return;
  const int m0 = mt * 128, n0 = nt * 256;
  const bf16_t* wl = p.Wt() + (size_t)l * W_LAYER;
  merge_pass<0>(p, p.YS(), wl + WO_GLU + (size_t)1024 * 1024, m0, n0, smem);
  merge_pass<1>(p, p.YS(), wl + WO_GLU, m0, n0, smem);
  merge_pass<2>(p, p.YM(), wl + WO_MPROJ, m0, n0, smem);
  merge_pass<3>(p, p.O(), wl + WO_ATTNO, m0, n0, smem);
}
DI void resid_gemm_job(const P& p, const bf16_t* A, int lda, const bf16_t* Wt, int K, int job, char* smem) {
  int mt, nt;
  if (!gemm_tile(job, 128, 4, mt, nt)) return;
  int m0 = mt * 128, n0 = nt * 256;
  const int tid = tidx(), lane = tid & 63, w = __builtin_amdgcn_readfirstlane(tid >> 6), wm = w & 1, wn = w >> 1, lr = lane & 31, lh = lane >> 5;
  f32x16 acc[2][GNB];
#pragma unroll
  for (int a = 0; a < 2; ++a)
#pragma unroll
    for (int b = 0; b < GNB; ++b) zero16(acc[a][b]);
  gemm_mainloop(A + (size_t)m0 * lda, lda, Wt + (size_t)n0 * K, K, K, acc, smem);
  m0 = launder_s(m0); n0 = launder_s(n0);
  float* sF = (float*)smem;
#pragma unroll
  for (int h = 0; h < 2; ++h) {
    if (h) __syncthreads();
#pragma unroll
    for (int ni = 0; ni < GNB; ++ni) {
      float* d = sF + (wm * 32 + 4 * lh) * 260 + wn * 128 + ni * 32 + lr;
#pragma unroll
      for (int i = 0; i < 16; ++i) d[((i & 3) + 8 * (i >> 2)) * 260] = acc[h][ni][i];
    }
    __syncthreads();
#pragma unroll 4
    for (int it = 0; it < 16; ++it) {
      const int idx = tid + 256 * it, rl = idx >> 6, c4 = idx & 63;
      const int r = m0 + (rl >> 5) * 64 + h * 32 + (rl & 31);
      float4* xp = (float4*)(p.X() + (size_t)r * 1024 + n0) + c4;
      const float4 a = *(const float4*)(sF + rl * 260 + c4 * 4);
      float4 x = *xp;
      x.x += a.x; x.y += a.y; x.z += a.z; x.w += a.w;
      *xp = x;
    }
  }
}
DI void up_job(const P& p, int l, int job, char* smem) {
  int mt, nt;
  if (!gemm_tile(job, 128, 16, mt, nt)) return;
  int m0 = mt * 128, n0 = nt * 256;
  const int tid = tidx(), lane = tid & 63, w = __builtin_amdgcn_readfirstlane(tid >> 6), wm = w & 1, wn = w >> 1, lr = lane & 31, lh = lane >> 5;
  f32x16 acc[2][GNB];
#pragma unroll
  for (int a = 0; a < 2; ++a)
#pragma unroll
    for (int b = 0; b < GNB; ++b) zero16(acc[a][b]);
  gemm_mainloop(p.H() + (size_t)m0 * 1024, 1024, p.Wt() + (size_t)l * W_LAYER + WO_UP + (size_t)n0 * 1024, 1024, 1024, acc, smem);
#if PROBE_DUP == 12
  gemm_mainloop(p.H() + (size_t)m0 * 1024, 1024, p.Wt() + (size_t)l * W_LAYER + WO_UP + (size_t)n0 * 1024, 1024, 1024, acc, smem);
#pragma unroll
  for (int mi = 0; mi < 2; ++mi)
#pragma unroll
    for (int ni = 0; ni < GNB; ++ni)
#pragma unroll
      for (int i = 0; i < 16; ++i) acc[mi][ni][i] *= 0.5f;
#endif
  m0 = launder_s(m0); n0 = launder_s(n0);
#pragma unroll
  for (int mi = 0; mi < 2; ++mi)
#pragma unroll
    for (int ni = 0; ni < GNB; ++ni)
#pragma unroll
      for (int i = 0; i < 16; ++i) { const float v = fmaxf(acc[mi][ni][i], 0.f); acc[mi][ni][i] = v * v; }
  bf16_t* sT = (bf16_t*)smem;
  stage_tile(sT, acc, wm, wn, lr, lh);
  __syncthreads();
  tile_writeout(p.A2() + (size_t)m0 * 4096 + n0, 4096, sT);
}

DI float skinny_dot(const bf16_t* __restrict__ A, int lda, const bf16_t* __restrict__ Wt, int K, int r0, int c0, char* smem) {
  float* sR = (float*)smem;
  const int tid = tidx(), lane = tid & 63, w = __builtin_amdgcn_readfirstlane(tid >> 6), r = lane & 15, quad = lane >> 4;
  const int kq = K >> 2;
  const bf16_t* ap = A + (size_t)(r0 + r) * lda + w * kq + quad * 8;
  const bf16_t* bp = Wt + (size_t)(c0 + r) * K + w * kq + quad * 8;
  f32x4 acc = {0.f, 0.f, 0.f, 0.f};
#pragma unroll 4
  for (int k = 0; k < kq; k += 32) {
    const bf16x8 a = *(const bf16x8*)(ap + k), b = *(const bf16x8*)(bp + k);
    acc = MFMA16(a, b, acc);
  }
  __syncthreads();
#pragma unroll
  for (int j = 0; j < 4; ++j) sR[w * 256 + (quad * 4 + j) * 16 + r] = acc[j];
  __syncthreads();
  return sR[tid] + sR[256 + tid] + sR[512 + tid] + sR[768 + tid];
}
DI void skinny_merge_job(const P& p, int l, int job, char* smem) {
  const int rt = job & 7, ct = job >> 3;
  const int r0 = TP + rt * 16, c0 = ct * 16;
  const bf16_t* wl = p.Wt() + (size_t)l * W_LAYER;
  const float ag = skinny_dot(p.YS(), 1024, wl + WO_GLU + (size_t)1024 * 1024, 1024, r0, c0, smem);
  const float av = skinny_dot(p.YS(), 1024, wl + WO_GLU, 1024, r0, c0, smem);
  const float am = skinny_dot(p.YM(), 1024, wl + WO_MPROJ, 1024, r0, c0, smem);
  const float aa = skinny_dot(p.O(), 1024, wl + WO_ATTNO, 1024, r0, c0, smem);
  const int tid = tidx(), r = r0 + (tid >> 4), c = c0 + (tid & 15);
  const bf16_t* gp = p.G() + (size_t)r * 3072 + c;
  const float v = bf2f(gp[0]) * am + bf2f(gp[1024]) * av * sigm_f(ag) + bf2f(gp[2048]) * aa;
  p.MG()[(size_t)r * 1024 + c] = f2bf(v);
}
DI void skinny_resid_job(const P& p, const bf16_t* A, int lda, const bf16_t* Wt, int K, int job, char* smem) {
  const int rt = job & 7, ct = job >> 3;
  const int r0 = TP + rt * 16, c0 = ct * 16;
  const float v = skinny_dot(A, lda, Wt, K, r0, c0, smem);
  const int tid = tidx();
  p.X()[(size_t)(r0 + (tid >> 4)) * 1024 + c0 + (tid & 15)] += v;
}
DI void skinny_up_job(const P& p, int l, int job, char* smem) {
  const int rt = job & 7, ct = job >> 3;
  const int r0 = TP + rt * 16, c0 = ct * 16;
  const float v = fmaxf(skinny_dot(p.H(), 1024, p.Wt() + (size_t)l * W_LAYER + WO_UP, 1024, r0, c0, smem), 0.f);
  const int tid = tidx();
  p.A2()[(size_t)(r0 + (tid >> 4)) * 4096 + c0 + (tid & 15)] = f2bf(v * v);
}

#define XB_TMO      128
#define XB_XCNT(j)  (256  + 64 * (j))
#define XB_XSUB(j)  (1280 + 64 * (j))
#define XB_XGEN(j)  (2304 + 64 * (j))
#define XB_TOP      3328
#define XB_TOPGEN   3392
#define XCD_BAR_WORDS 3456
#define XB_SPIN_CAP (1u << 20)
#define LAS __attribute__((address_space(3)))
DI unsigned xb_ld(unsigned* p) { return __hip_atomic_load(p, __ATOMIC_RELAXED, __HIP_MEMORY_SCOPE_AGENT); }
DI unsigned xb_add(unsigned* p, unsigned v) { return __hip_atomic_fetch_add(p, v, __ATOMIC_RELAXED, __HIP_MEMORY_SCOPE_AGENT); }
DI unsigned xb_xcc_id() { return (unsigned)__builtin_amdgcn_s_getreg((3 << 11) | 20) & 0xFu; }
#define XB_SPIN(cond, bar) do { unsigned _sp = 0; while (cond) { __builtin_amdgcn_s_sleep(1); \
    if ((++_sp & 255u) == 0u) { if (xb_ld(&(bar)[XB_TMO])) break; if (_sp > XB_SPIN_CAP) { atomicAdd(&(bar)[XB_TMO], 1u); break; } } } } while (0)
struct XcdBarrier { unsigned* bar; unsigned x; volatile LAS unsigned* st; };
DI XcdBarrier xcd_barrier_post(unsigned* bar, volatile LAS unsigned* st) {
  XcdBarrier b; b.bar = bar; b.x = xb_xcc_id(); b.st = st;
  if (threadIdx.x == 0) (void)xb_add(&bar[XB_XCNT(b.x)], 1u);
  return b;
}
DI void xcd_barrier_complete(unsigned* bar, unsigned x, unsigned& nloc, unsigned& nx) {
  const unsigned G = gridDim.x * gridDim.y * gridDim.z;
  unsigned sum, cnt, mine, sp = 0u;
  for (;;) {
    sum = 0u; cnt = 0u; mine = 0u;
#pragma unroll
    for (unsigned j = 0; j < 16; ++j) { const unsigned c = xb_ld(&bar[XB_XCNT(j)]); sum += c; cnt += (c > 0u) ? 1u : 0u; mine = (j == x) ? c : mine; }
    if (sum == G) break;
    __builtin_amdgcn_s_sleep(1);
    if ((++sp & 255u) == 0u) { if (xb_ld(&bar[XB_TMO])) break; if (sp > XB_SPIN_CAP) { atomicAdd(&bar[XB_TMO], 1u); break; } }
  }
  nloc = mine > 0u ? mine : 1u; nx = cnt > 0u ? cnt : 1u;
}
DI void xcd_barrier(const XcdBarrier& b) {
  asm volatile("s_waitcnt vmcnt(0)" ::: "memory");
  __syncthreads();
  if (threadIdx.x == 0) {
    unsigned* bar = b.bar;
    __builtin_amdgcn_s_waitcnt(0);
    unsigned nloc = b.st[0], nx = b.st[1];
    if (nloc == 0u) { xcd_barrier_complete(bar, b.x, nloc, nx); b.st[0] = nloc; b.st[1] = nx; }
    const unsigned old = xb_add(&bar[XB_XSUB(b.x)], 1u);
    const unsigned gen = old / nloc;
    if (old + 1u == (gen + 1u) * nloc) {
      __builtin_amdgcn_fence(__ATOMIC_RELEASE, "agent");
      asm volatile("s_waitcnt vmcnt(0)" ::: "memory");
      const unsigned og = xb_add(&bar[XB_TOP], 1u);
      const unsigned tg = og / nx;
      if (og + 1u == (tg + 1u) * nx) xb_add(&bar[XB_TOPGEN], 1u);
      else XB_SPIN(xb_ld(&bar[XB_TOPGEN]) == tg, bar);
      __builtin_amdgcn_fence(__ATOMIC_ACQUIRE, "agent");
      xb_add(&bar[XB_XGEN(b.x)], 1u);
      asm volatile("s_waitcnt vmcnt(0)" ::: "memory");
    } else {
      XB_SPIN(xb_ld(&bar[XB_XGEN(b.x)]) == gen, bar);
      __builtin_amdgcn_fence(__ATOMIC_ACQUIRE, "agent");
      asm volatile("s_waitcnt vmcnt(0)" ::: "memory");
    }
  }
  __syncthreads();
}

constexpr int NPHASE = 1 + 4 * 11;
DI void phase_jobs(int ph, int& nstd, int& nother) {
  nstd = 0;
  if (ph == 0) { nother = 22272 + 64 + 257 + 4128; return; }
  const int s = (ph - 1) % 11;
  switch (s) {
    case 0: nstd = 129 * 35; nother = 0; break;
    case 1: nother = 2048 + 4096 + 4096 + 512 + 2048 + 512; break;
    case 2: nother = 2048; break;
    case 3: nother = 256 + 32; break;
    case 4: nother = 512 + 4096; break;
    case 5: nstd = 512; nother = 512; break;
    case 6: nstd = 512; nother = 512; break;
    case 7: nother = 4128; break;
    case 8: nstd = 2048; nother = 2048; break;
    case 9: nstd = 512; nother = 512; break;
    default: nother = 4128; break;
  }
}
DI void run_std_job(const P& p, int ph, int job, char* smem) {
  const int l = (ph - 1) / 11, s = (ph - 1) % 11;
  const bf16_t* wl = p.Wt() + (size_t)l * W_LAYER;
  switch (s) {
    case 0: inproj_job(p, l, job, smem); break;
    case 5: merge_job(p, l, job, smem); break;
    case 6: resid_gemm_job(p, p.MG(), 1024, wl + WO_WOUT, 1024, job, smem); break;
    case 8: up_job(p, l, job, smem); break;
    default: resid_gemm_job(p, p.A2(), 4096, wl + WO_DOWN, 4096, job, smem); break;
  }
}
DI void run_job(const P& p, int ph, int job, char* smem) {
  if (ph == 0) {
    if (job < 22272) { prep_weight_job(p, job, smem); return; }
    job -= 22272;
    if (job < 64) { prep_s5_job(p, job); return; }
    job -= 64;
    if (job < 257) { prep_rope_job(p, job); return; }
    job -= 257;
    norm_job(p, job, p.norm1_w, true, false);
    return;
  }
  const int l = (ph - 1) / 11, s = (ph - 1) % 11;
  const bf16_t* wl = p.Wt() + (size_t)l * W_LAYER;
  const int w = __builtin_amdgcn_readfirstlane(tidx() >> 6);
  switch (s) {
    case 1:
      if (job < 512) { for (int rr = 0; rr < (PROBE_DUP == 11 ? 3 : 1); ++rr) ssd_sample_job(p, l, job, smem); break; }
      job -= 512;
      if (job < 512) { attn_sample_job(p, l, job, smem); break; }
      job -= 512;
      if (job < 2048) { for (int rr = 0; rr < (PROBE_DUP == 8 ? 3 : 1); ++rr) attn_prompt_job(p, l, job, smem); break; }
      job -= 2048;
      if (job < 4096) { for (int rr = 0; rr < (PROBE_DUP == 9 ? 3 : 1); ++rr) conv_job(p, l, job, smem); break; }
      job -= 4096;
      if (job < 4096) { const int wj = job * 4 + w; for (int rr = 0; rr < (PROBE_DUP == 10 ? 3 : 1); ++rr) s5_wave_job(p, l, 0, wj >> 13, wj & 63, (wj >> 6) & 127, nullptr); break; }
      job -= 4096;
      { const int wj = job * 4 + w; __syncthreads(); s5_wave_job(p, l, 2, wj >> 6, wj & 63, 0, (bf16_t*)smem + w * 64 * 136); }
      break;
    case 2: ssd_a_job(p, l, job, smem); break;
    case 3:
      if (job < 256) ssd_scan_job(p, l, job);
      else s5_scan_job(p, l, job - 256);
      break;
    case 4:
      if (job < 512) { for (int rr = 0; rr < (PROBE_DUP == 16 ? 3 : 1); ++rr) ssd_c_job(p, l, job, smem); break; }
      job -= 512;
      { const int wj = job * 4 + w; for (int rr = 0; rr < (PROBE_DUP == 17 ? 3 : 1); ++rr) { __syncthreads(); s5_wave_job(p, l, 1, wj >> 13, wj & 63, (wj >> 6) & 127, (bf16_t*)smem + w * 64 * 136); } }
      break;
    case 5: skinny_merge_job(p, l, job, smem); break;
    case 6: skinny_resid_job(p, p.MG(), 1024, wl + WO_WOUT, 1024, job, smem); break;
    case 7: norm_job(p, job, p.norm2_w + l * 1024, false, false); break;
    case 8: skinny_up_job(p, l, job, smem); break;
    case 9: skinny_resid_job(p, p.A2(), 4096, wl + WO_DOWN, 4096, job, smem); break;
    default:
      if (l == 3) norm_job(p, job, p.final_w, false, true);
      else norm_job(p, job, p.norm1_w + (l + 1) * 1024, false, false);
      break;
  }
}

template <bool COOP>
__global__ void __launch_bounds__(256, 2) mega(P p, int ph0, int ph1) {
  __shared__ __attribute__((aligned(16))) char smem[SMEM_BYTES];
  __shared__ uint4 xb_words;
  XcdBarrier xb;
  if (COOP) {
    if (threadIdx.x == 0) xb_words = make_uint4(0u, 0u, 0u, 0u);
    __syncthreads();
    xb = xcd_barrier_post((unsigned*)(p.ws + WS_BAR), (volatile LAS unsigned*)&xb_words);
  }
  const int G = (int)gridDim.x;
  for (int ph = ph0; ph < ph1; ++ph) {
    int nstd, nother;
    phase_jobs(ph, nstd, nother);
    int reps = 1;
#if PROBE_DUP
    { const int s_ = (ph == 0) ? -1 : (ph - 1) % 11;
      if (PROBE_DUP == 1 && (s_ == 0 || s_ == 5 || s_ == 8)) reps = 2;
      if (PROBE_DUP == 2 && (s_ == 1 || s_ == 2 || s_ == 4)) reps = 2;
      if (PROBE_DUP == 6 && s_ == 4) reps = 2;
      if (PROBE_DUP == 13 && s_ == 8) reps = 2;
      if (PROBE_DUP == 14 && s_ == 2) reps = 3;
      if (PROBE_DUP == 15 && (s_ == 6 || s_ == 9)) reps = 1;
      if (PROBE_DUP == 7 && s_ == 1) reps = 2; }
#endif
    const int nstd_r = ((nstd + G - 1) / G) * G;
    for (int rep = 0; rep < reps; ++rep) {
      for (int job = blockIdx.x; job < nstd_r; job += G) run_std_job(p, ph, job, smem);
      for (int job = blockIdx.x; job < nother; job += G) run_job(p, ph, job, smem);
    }
    if (COOP && ph + 1 < ph1) {
      if (ph == ph0) cg::this_grid().sync();
      else xcd_barrier(xb);
    }
  }
}


extern "C" void kernel_launch(void* const* d_in, const int* in_sizes, int n_in, void* d_out, int out_size, void* d_ws, size_t ws_size,
                              hipStream_t stream) {
  P p{};
  const float** pin = (const float**)&p;
  for (int i = 0; i < 33; ++i) pin[i] = (const float*)d_in[i];
  p.out = (float*)d_out;
  p.ws = (char*)d_ws;
  if (WS_TOTAL > ws_size) { fprintf(stderr, "workspace too small: need %zu have %zu\n", (size_t)WS_TOTAL, ws_size); return; }

#if COOP_MODE
  static int grid_blocks = 0;
  if (!grid_blocks) {
    int dev = 0, cus = 0, per_cu = 0;
    hipGetDevice(&dev);
    hipDeviceGetAttribute(&cus, hipDeviceAttributeMultiprocessorCount, dev);
    hipOccupancyMaxActiveBlocksPerMultiprocessor(&per_cu, mega<true>, 256, 0);
    if (per_cu > 2) per_cu = 2;
    if (per_cu < 1) per_cu = 1;
    grid_blocks = cus * per_cu;
  }
  (void)hipMemsetAsync(p.ws + WS_BAR, 0, 4096 * 4, stream);
  int ph0 = 0, ph1 = NPHASE;
  void* args[] = {&p, &ph0, &ph1};
  hipError_t e = hipLaunchCooperativeKernel((void*)mega<true>, dim3(grid_blocks), dim3(256), args, 0, stream);
  if (e != hipSuccess) fprintf(stderr, "cooperative launch failed: %s (grid %d)\n", hipGetErrorString(e), grid_blocks);
#else
  for (int ph = 0; ph < NPHASE; ++ph) mega<false><<<dim3(1024), dim3(256), 0, stream>>>(p, ph, ph + 1);
#endif
}
```

```cpp
#include <hip/hip_runtime.h>
#include <hip/hip_cooperative_groups.h>
#include <cstdio>
#include <cstdint>
namespace cg = cooperative_groups;

#define DI __device__ __forceinline__
typedef unsigned short bf16_t;
typedef short bf16x8 __attribute__((ext_vector_type(8)));
typedef float f32x16 __attribute__((ext_vector_type(16)));
typedef float f32x4 __attribute__((ext_vector_type(4)));
#define MFMA32(a, b, c) __builtin_amdgcn_mfma_f32_32x32x16_bf16((a), (b), (c), 0, 0, 0)
#define MFMA16(a, b, c) __builtin_amdgcn_mfma_f32_16x16x32_bf16((a), (b), (c), 0, 0, 0)

#ifndef COOP_MODE
#define COOP_MODE 1
#endif
#ifndef PROBE_DUP
#define PROBE_DUP 0
#endif

constexpr int TP = 16384, TS = 128, T = TP + TS, SEQ = 8192;
constexpr int NIN = 8720, NINP = 8960;
constexpr int SMEM_BYTES = 73728;
constexpr float EPS = 1e-6f;

constexpr size_t OFF_YP = 0;
constexpr size_t OFF_YS = OFF_YP + (size_t)TP * 1024;
constexpr size_t OFF_SSMP = OFF_YS + (size_t)TS * 1024;
constexpr size_t OFF_SSMS = OFF_SSMP + (size_t)4 * 2 * 16 * 64 * 128;
constexpr size_t OFF_CONVP = OFF_SSMS + (size_t)4 * 128 * 16 * 64 * 128;
constexpr size_t OFF_CONVS = OFF_CONVP + (size_t)4 * 2 * 3 * 2048;
constexpr size_t OFF_S5RP = OFF_CONVS + (size_t)4 * 128 * 3 * 2048;
constexpr size_t OFF_S5RS = OFF_S5RP + (size_t)4 * 2 * 64 * 64;
constexpr size_t OFF_S5IP = OFF_S5RS + (size_t)4 * 128 * 64 * 64;
constexpr size_t OFF_S5IS = OFF_S5IP + (size_t)4 * 2 * 64 * 64;
constexpr size_t OFF_KP = OFF_S5IS + (size_t)4 * 128 * 64 * 64;
constexpr size_t OFF_KS = OFF_KP + (size_t)4 * 2 * 128 * 256;
constexpr size_t OFF_VP = OFF_KS + (size_t)4 * 128 * 128 * 256;
constexpr size_t OFF_VS = OFF_VP + (size_t)4 * 2 * 128 * 256;

constexpr size_t WO_IN = 0;
constexpr size_t WO_MPROJ = WO_IN + (size_t)NINP * 1024;
constexpr size_t WO_GLU = WO_MPROJ + (size_t)1024 * 1024;
constexpr size_t WO_ATTNO = WO_GLU + (size_t)2048 * 1024;
constexpr size_t WO_WOUT = WO_ATTNO + (size_t)1024 * 1024;
constexpr size_t WO_UP = WO_WOUT + (size_t)1024 * 1024;
constexpr size_t WO_DOWN = WO_UP + (size_t)4096 * 1024;
constexpr size_t W_LAYER = WO_DOWN + (size_t)4096 * 1024;

constexpr size_t al256(size_t x) { return (x + 255) & ~(size_t)255; }
constexpr size_t SZ1 = (size_t)T * 1024 * 2;
constexpr size_t WS_X = 0;
constexpr size_t WS_H = WS_X + al256((size_t)T * 1024 * 4);
constexpr size_t WS_Z = WS_H + al256(SZ1);
constexpr size_t WS_U = WS_Z + al256(SZ1);
constexpr size_t WS_Q = WS_U + al256(SZ1);
constexpr size_t WS_YM = WS_Q + al256(SZ1);
constexpr size_t WS_YS = WS_YM + al256(SZ1);
constexpr size_t WS_O = WS_YS + al256(SZ1);
constexpr size_t WS_MG = WS_O + al256(SZ1);
constexpr size_t WS_XBC = WS_MG + al256(SZ1);
constexpr size_t WS_XBT = WS_XBC + al256((size_t)T * 2048 * 2);
constexpr size_t WS_BC = WS_XBT + al256((size_t)1536 * TP * 2);
constexpr size_t WS_A2END = WS_XBC + al256((size_t)T * 4096 * 2);
constexpr size_t WS_BCEND = WS_BC + al256((size_t)TP * 1024 * 2);
constexpr size_t WS_K = WS_A2END > WS_BCEND ? WS_A2END : WS_BCEND;
constexpr size_t WS_VT = WS_K + al256((size_t)T * 256 * 2);
constexpr size_t WS_G = WS_VT + al256((size_t)T * 256 * 2);
constexpr size_t WS_DT = WS_G + al256((size_t)T * 3072 * 2);
constexpr size_t WS_ST = WS_DT + al256((size_t)T * 16 * 4);
constexpr size_t WS_CDEC = WS_ST + al256((size_t)2 * 64 * 16 * 64 * 128 * 4);
constexpr size_t WS_S5S = WS_CDEC + al256((size_t)2 * 64 * 16 * 4);
constexpr size_t WS_S5P = WS_S5S + al256((size_t)2 * 128 * 64 * 64 * 2 * 4);
constexpr size_t WS_ROPE = WS_S5P + al256((size_t)4 * 64 * 36 * 64 * 4);
constexpr size_t WS_WT = WS_ROPE + al256((size_t)8193 * 8 * 8);
constexpr size_t WS_BAR = WS_WT + al256((size_t)4 * W_LAYER * 2);
constexpr size_t WS_HP = WS_BAR + al256(4096 * 4);
constexpr size_t WS_BBT = WS_HP + al256((size_t)2 * 64 * 16 * 64 * 128 * 2);
constexpr size_t WS_TOTAL = WS_BBT + al256((size_t)4 * 64 * 128 * 16 * 2);

struct P {
  const float *x_prompt, *x_sample, *state_ssm, *state_conv, *s5_sre, *s5_sim, *cache_k, *cache_v;
  const float *norm1_w, *w_in, *conv_w, *conv_b, *dt_bias, *a_log, *m_d, *m_norm_w, *m_proj;
  const float *lam_re, *lam_im, *log_step, *b_re, *b_im, *c_re, *c_im, *s5_d, *glu_w;
  const float *sinks, *attn_o, *w_out, *norm2_w, *mlp_up, *mlp_down, *final_w;
  float* out;
  char* ws;
#define WSACC(name, type, off) __device__ __forceinline__ type* name() const { return (type*)(ws + (off)); }
  WSACC(X, float, WS_X) WSACC(H, bf16_t, WS_H) WSACC(Z, bf16_t, WS_Z) WSACC(U, bf16_t, WS_U) WSACC(Q, bf16_t, WS_Q)
  WSACC(YM, bf16_t, WS_YM) WSACC(YS, bf16_t, WS_YS) WSACC(O, bf16_t, WS_O) WSACC(MG, bf16_t, WS_MG)
  WSACC(XBC, bf16_t, WS_XBC) WSACC(XBT, bf16_t, WS_XBT) WSACC(BC, bf16_t, WS_BC) WSACC(A2, bf16_t, WS_XBC)
  WSACC(K, bf16_t, WS_K) WSACC(VT, bf16_t, WS_VT) WSACC(G, bf16_t, WS_G) WSACC(DT, float, WS_DT) WSACC(ST, float, WS_ST)
  WSACC(CDEC, float, WS_CDEC) WSACC(HP, bf16_t, WS_HP) WSACC(BBT, bf16_t, WS_BBT) WSACC(S5S, float, WS_S5S) WSACC(S5P, float, WS_S5P) WSACC(ROPE, float2, WS_ROPE) WSACC(Wt, bf16_t, WS_WT)
#undef WSACC
};

typedef float f32x2_t __attribute__((ext_vector_type(2)));
typedef __bf16 bf16x2_t __attribute__((ext_vector_type(2)));
DI unsigned pack2(float a, float b) { const f32x2_t v = {a, b}; return __builtin_bit_cast(unsigned, __builtin_convertvector(v, bf16x2_t)); }
DI bf16_t f2bf(float x) { return (bf16_t)(pack2(x, 0.f) & 0xffffu); }
DI float bf2f(bf16_t b) { return __uint_as_float(((unsigned)b) << 16); }
DI float bflo(unsigned u) { return __uint_as_float(u << 16); }
DI float bfhi(unsigned u) { return __uint_as_float(u & 0xffff0000u); }
DI float silu_f(float x) { return x / (1.f + __expf(-x)); }
DI float sigm_f(float x) { return 1.f / (1.f + __expf(-x)); }
DI float softplus_f(float x) { return x > 20.f ? x : log1pf(expf(x)); }
DI float gelu_tanh(float x) { float y = 0.7978845608028654f * (x + 0.044715f * x * x * x); float t = 1.f - 2.f / (__expf(2.f * y) + 1.f); return 0.5f * x * (1.f + t); }
DI int crow(int i, int lh) { return (i & 3) + 8 * (i >> 2) + 4 * lh; }
DI int launder(int x) { asm volatile("" : "+v"(x)); return x; }
DI int tidx() { int t = __builtin_amdgcn_workitem_id_x(); asm volatile("" : "+v"(t)); return t; }
DI int launder_s(int x) { asm volatile("" : "+s"(x)); return x; }
DI float wave_sum(float v) {
#pragma unroll
  for (int o = 32; o >= 1; o >>= 1) v += __shfl_xor(v, o);
  return v;
}
DI float wave_max(float v) {
#pragma unroll
  for (int o = 32; o >= 1; o >>= 1) v = fmaxf(v, __shfl_xor(v, o));
  return v;
}
DI bf16x8 u4_to_bf8(uint4 v) { return __builtin_bit_cast(bf16x8, v); }
DI void zero16(f32x16& a) {
#pragma unroll
  for (int i = 0; i < 16; ++i) a[i] = 0.f;
}

constexpr int LDT = 40;
constexpr int GNB = 4;
DI void gemm_mainloop(const bf16_t* __restrict__ A, int lda, const bf16_t* __restrict__ B, int ldb, int K,
                      f32x16 (&acc)[2][GNB], char* smem) {
  bf16_t* sa = (bf16_t*)smem;
  bf16_t* sb = sa + 2 * 128 * LDT;
  const int tid = tidx(), lane = tid & 63, w = __builtin_amdgcn_readfirstlane(tid >> 6), wm = w & 1, wn = w >> 1, lr = lane & 31, lh = lane >> 5;
  const int r0 = tid >> 2, ch = (tid & 3) * 8;
  const bf16_t* ap = A + (size_t)r0 * lda + ch;
  const bf16_t* bp = B + (size_t)r0 * ldb + ch;
  uint4 pa0, pa1, pb0, pb1, pb2, pb3;
  uint4 qa0, qa1, qb0, qb1, qb2, qb3;
#define GLOADS(R, k0)                                                                                      \
  R##a0 = *(const uint4*)(ap + (k0)); R##a1 = *(const uint4*)(ap + (size_t)64 * lda + (k0));               \
  R##b0 = *(const uint4*)(bp + (k0)); R##b1 = *(const uint4*)(bp + (size_t)64 * ldb + (k0));               \
  R##b2 = *(const uint4*)(bp + (size_t)128 * ldb + (k0)); R##b3 = *(const uint4*)(bp + (size_t)192 * ldb + (k0));
#define SSTORES(R, bufi)                                                                                   \
  { bf16_t* da = sa + (bufi)*128 * LDT; bf16_t* db = sb + (bufi)*256 * LDT;                                \
    *(uint4*)(da + (r0)*LDT + ch) = R##a0; *(uint4*)(da + (r0 + 64) * LDT + ch) = R##a1;                   \
    *(uint4*)(db + (r0)*LDT + ch) = R##b0; *(uint4*)(db + (r0 + 64) * LDT + ch) = R##b1;                   \
    *(uint4*)(db + (r0 + 128) * LDT + ch) = R##b2; *(uint4*)(db + (r0 + 192) * LDT + ch) = R##b3; }
#define COMPUTE(bufi)                                                                                      \
  { const bf16_t* ca = sa + (bufi)*128 * LDT + (wm * 64 + lr) * LDT + lh * 8;                              \
    const bf16_t* cb = sb + (bufi)*256 * LDT + (wn * 128 + lr) * LDT + lh * 8;                             \
    _Pragma("unroll") for (int kk = 0; kk < 2; ++kk) {                                                     \
      const bf16x8 af0 = *(const bf16x8*)(ca + kk * 16), af1 = *(const bf16x8*)(ca + 32 * LDT + kk * 16);  \
      _Pragma("unroll") for (int ni = 0; ni < GNB; ++ni) {                                                 \
        const bf16x8 bfr = *(const bf16x8*)(cb + ni * 32 * LDT + kk * 16);                                 \
        acc[0][ni] = MFMA32(af0, bfr, acc[0][ni]); acc[1][ni] = MFMA32(af1, bfr, acc[1][ni]); } } }
  const int nk = K >> 5;
  const int klast = (nk - 1) * 32;
  GLOADS(p, 0)
  __syncthreads();
  SSTORES(p, 0)
  GLOADS(p, 32)
  __syncthreads();
  for (int kt = 0; kt < nk; kt += 2) {
    { const int k2 = (kt + 2) * 32; const int k0 = k2 < klast ? k2 : klast; GLOADS(q, k0) }
    COMPUTE(0)
    SSTORES(p, 1)
    __syncthreads();
    { const int k3 = (kt + 3) * 32; const int k0 = k3 < klast ? k3 : klast; GLOADS(p, k0) }
    COMPUTE(1)
    SSTORES(q, 0)
    __syncthreads();
  }
#undef GLOADS
#undef SSTORES
#undef COMPUTE
}
DI bool gemm_tile(int slot, int MT, int NT, int& mt, int& nt) {
  const int G = gridDim.x, nx = G >> 3;
  int J = slot;
  if ((G & 7) == 0) J = (slot / G) * G + (slot & 7) * nx + ((slot % G) >> 3);
  if (J >= MT * NT) return false;
  const int gw = 8 * NT, grp = J / gw, rem = J - grp * gw, fm = grp * 8;
  const int gsz = (MT - fm) < 8 ? (MT - fm) : 8;
  mt = fm + rem % gsz; nt = rem / gsz;
  return true;
}

DI int win_map(int n) {
  if (n < 3072) return n;
  if (n < 8704) return n + 16;
  if (n < 8720) return n - 8704 + 3072;
  return -1;
}
DI void wtrans_tile(const float* __restrict__ src, int N, int K, bf16_t* __restrict__ dst, int kt, int nt, bool inmap, char* smem) {
  float* s = (float*)smem;
  const int tid = tidx();
  __syncthreads();
  {
    const int n4 = (tid & 15) * 4;
    int sc = nt * 64 + n4;
    if (inmap) sc = win_map(sc);
#pragma unroll
    for (int ps = 0; ps < 4; ++ps) {
      const int kk = (tid >> 4) + 16 * ps;
      float4 v = make_float4(0.f, 0.f, 0.f, 0.f);
      if (sc >= 0) v = *(const float4*)(src + (size_t)(kt * 64 + kk) * N + sc);
      float* d = s + kk * 65 + n4;
      d[0] = v.x; d[1] = v.y; d[2] = v.z; d[3] = v.w;
    }
  }
  __syncthreads();
  {
    const int n2 = tid >> 2, kq = (tid & 3) * 16;
    unsigned w[8];
#pragma unroll
    for (int j = 0; j < 8; ++j) w[j] = pack2(s[(kq + 2 * j) * 65 + n2], s[(kq + 2 * j + 1) * 65 + n2]);
    uint4* d = (uint4*)(dst + (size_t)(nt * 64 + n2) * K + kt * 64 + kq);
    d[0] = make_uint4(w[0], w[1], w[2], w[3]);
    d[1] = make_uint4(w[4], w[5], w[6], w[7]);
  }
}
DI void prep_weight_job(const P& p, int j, char* smem) {
  const int l = j / 5568; int r = j % 5568;
  bf16_t* wl = p.Wt() + (size_t)l * W_LAYER;
  if (r < 2240) { wtrans_tile(p.w_in + (size_t)l * 1024 * NIN, NIN, 1024, wl + WO_IN, r / 140, r % 140, true, smem); return; }
  r -= 2240;
  if (r < 256) { wtrans_tile(p.m_proj + (size_t)l * 1024 * 1024, 1024, 1024, wl + WO_MPROJ, r / 16, r % 16, false, smem); return; }
  r -= 256;
  if (r < 512) { wtrans_tile(p.glu_w + (size_t)l * 1024 * 2048, 2048, 1024, wl + WO_GLU, r / 32, r % 32, false, smem); return; }
  r -= 512;
  if (r < 256) { wtrans_tile(p.attn_o + (size_t)l * 1024 * 1024, 1024, 1024, wl + WO_ATTNO, r / 16, r % 16, false, smem); return; }
  r -= 256;
  if (r < 256) { wtrans_tile(p.w_out + (size_t)l * 1024 * 1024, 1024, 1024, wl + WO_WOUT, r / 16, r % 16, false, smem); return; }
  r -= 256;
  if (r < 1024) { wtrans_tile(p.mlp_up + (size_t)l * 1024 * 4096, 4096, 1024, wl + WO_UP, r / 64, r % 64, false, smem); return; }
  r -= 1024;
  wtrans_tile(p.mlp_down + (size_t)l * 4096 * 1024, 1024, 4096, wl + WO_DOWN, r / 16, r % 16, false, smem);
}
DI void prep_s5_job(const P& p, int j) {
  const int idx = j * 256 + tidx();
  const int n = idx & 63, g = (idx >> 6) & 63, l = idx >> 12;
  const float step = expf(p.log_step[l * 64 + g]);
  const float lr_ = p.lam_re[(l * 64 + g) * 64 + n], li = p.lam_im[(l * 64 + g) * 64 + n];
  const float mag = expf(lr_ * step);
  const float abr = mag * cosf(li * step), abi = mag * sinf(li * step);
  float aqr = abr, aqi = abi;
#pragma unroll
  for (int q = 0; q < 6; ++q) { const float nr2 = aqr * aqr - aqi * aqi, ni2 = 2.f * aqr * aqi; aqr = nr2; aqi = ni2; }
  const float den = lr_ * lr_ + li * li;
  const float nr = abr - 1.0f, ni = abi;
  const float fre = (nr * lr_ + ni * li) / den, fim = (ni * lr_ - nr * li) / den;
  float* o = p.S5P() + ((size_t)(l * 64 + g) * 36) * 64 + n;
  o[0] = abr; o[64] = abi; o[128] = aqr; o[192] = aqi;
  const float* br = p.b_re + ((size_t)(l * 64 + g) * 64 + n) * 16;
  const float* bi = p.b_im + ((size_t)(l * 64 + g) * 64 + n) * 16;
  float vre[16], vim[16];
#pragma unroll
  for (int i = 0; i < 16; ++i) {
    const float b_r = br[i], b_i = bi[i];
    vre[i] = fre * b_r - fim * b_i;
    vim[i] = fre * b_i + fim * b_r;
    o[(4 + i) * 64] = vre[i];
    o[(20 + i) * 64] = vim[i];
  }
  uint4* bt = (uint4*)(p.BBT() + ((size_t)(l * 64 + g) * 128 + n) * 16);
  bt[0] = make_uint4(pack2(vre[0], vre[1]), pack2(vre[2], vre[3]), pack2(vre[4], vre[5]), pack2(vre[6], vre[7]));
  bt[1] = make_uint4(pack2(vre[8], vre[9]), pack2(vre[10], vre[11]), pack2(vre[12], vre[13]), pack2(vre[14], vre[15]));
  bt[128] = make_uint4(pack2(vim[0], vim[1]), pack2(vim[2], vim[3]), pack2(vim[4], vim[5]), pack2(vim[6], vim[7]));
  bt[129] = make_uint4(pack2(vim[8], vim[9]), pack2(vim[10], vim[11]), pack2(vim[12], vim[13]), pack2(vim[14], vim[15]));
}
DI void prep_rope_job(const P& p, int j) {
  const int idx = j * 256 + tidx();
  if (idx >= 8193 * 8) return;
  const int pos = idx >> 3, f = idx & 7;
  const float invf = expf(-(2.0f * (float)f / 16.0f) * logf(500000.0f));
  const float ang = (float)pos * invf;
  p.ROPE()[idx] = make_float2(cosf(ang), sinf(ang));
}

DI void norm_job(const P& p, int job, const float* wgt, bool layer0, bool final_) {
  const int w = __builtin_amdgcn_readfirstlane(tidx() >> 6), lane = tidx() & 63;
  const int r = job * 4 + w;
  const float* src = layer0 ? (r < TP ? p.x_prompt + (size_t)r * 1024 : p.x_sample + (size_t)(r - TP) * 1024) : p.X() + (size_t)r * 1024;
  float4 v[4];
  float ss = 0.f;
#pragma unroll
  for (int q = 0; q < 4; ++q) { v[q] = ((const float4*)src)[lane + 64 * q]; ss += v[q].x * v[q].x + v[q].y * v[q].y + v[q].z * v[q].z + v[q].w * v[q].w; }
  ss = wave_sum(ss);
  const float sc = rsqrtf(ss * (1.f / 1024.f) + EPS);
#pragma unroll
  for (int q = 0; q < 4; ++q) {
    const float4 wv = ((const float4*)wgt)[lane + 64 * q];
    float4 y = make_float4(v[q].x * sc * wv.x, v[q].y * sc * wv.y, v[q].z * sc * wv.z, v[q].w * sc * wv.w);
    if (final_) ((float4*)(p.out + OFF_YP + (size_t)r * 1024))[lane + 64 * q] = y;
    else *(uint2*)(p.H() + (size_t)r * 1024 + (lane + 64 * q) * 4) = make_uint2(pack2(y.x, y.y), pack2(y.z, y.w));
    if (layer0) ((float4*)(p.X() + (size_t)r * 1024))[lane + 64 * q] = v[q];
  }
}

constexpr int LDS_T = 264;
DI void stage_tile(bf16_t* sT, const f32x16 (&acc)[2][GNB], int wm, int wn, int lr, int lh) {
#pragma unroll
  for (int mi = 0; mi < 2; ++mi)
#pragma unroll
    for (int ni = 0; ni < GNB; ++ni) {
      bf16_t* d = sT + (wm * 64 + mi * 32 + 4 * lh) * LDS_T + wn * 128 + ni * 32 + lr;
#pragma unroll
      for (int ig = 0; ig < 4; ++ig) {
        const unsigned p01 = pack2(acc[mi][ni][4 * ig], acc[mi][ni][4 * ig + 1]), p23 = pack2(acc[mi][ni][4 * ig + 2], acc[mi][ni][4 * ig + 3]);
        d[(8 * ig) * LDS_T] = (bf16_t)(p01 & 0xffffu); d[(8 * ig + 1) * LDS_T] = (bf16_t)(p01 >> 16);
        d[(8 * ig + 2) * LDS_T] = (bf16_t)(p23 & 0xffffu); d[(8 * ig + 3) * LDS_T] = (bf16_t)(p23 >> 16);
      }
    }
}
DI void tile_writeout(bf16_t* __restrict__ dst, int ld, const bf16_t* sT) {
  const int tid = tidx();
#pragma unroll 4
  for (int it = 0; it < 16; ++it) {
    const int idx = tid + 256 * it, row = idx >> 5, chunk = idx & 31;
    *(uint4*)(dst + (size_t)row * ld + chunk * 8) = *(const uint4*)(sT + row * LDS_T + chunk * 8);
  }
}

DI void inproj_job(const P& p, int l, int job, char* smem) {
  int mt, nt;
  if (!gemm_tile(job, 129, 35, mt, nt)) return;
  int m0 = mt * 128, n0 = nt * 256;
  f32x16 acc[2][GNB];
#pragma unroll
  for (int a = 0; a < 2; ++a)
#pragma unroll
    for (int b = 0; b < GNB; ++b) zero16(acc[a][b]);
  gemm_mainloop(p.H() + (size_t)m0 * 1024, 1024, p.Wt() + (size_t)l * W_LAYER + WO_IN + (size_t)n0 * 1024, 1024, 1024, acc, smem);
  m0 = launder_s(m0); n0 = launder_s(n0);
  nt = launder_s(nt); mt = launder_s(mt);
  const int tid = tidx(), lane = tid & 63, w = __builtin_amdgcn_readfirstlane(tid >> 6), wm = w & 1, wn = w >> 1, lr = lane & 31, lh = lane >> 5;
  bf16_t* sT = (bf16_t*)smem;
  if (nt == 34) {
    if (wn == 0 && lr < 16) {
      const float bias = p.dt_bias[l * 16 + lr];
#pragma unroll
      for (int mi = 0; mi < 2; ++mi)
#pragma unroll
        for (int i = 0; i < 16; ++i) p.DT()[(size_t)(m0 + wm * 64 + mi * 32 + crow(i, lh)) * 16 + lr] = softplus_f(acc[mi][0][i] + bias);
    }
    return;
  }
  if (nt >= 16 && nt <= 20) {
#pragma unroll
    for (int mi = 0; mi < 2; ++mi)
#pragma unroll
      for (int ni = 0; ni < GNB; ni += 2)
#pragma unroll
        for (int i = 0; i < 16; ++i) {
          const float v = acc[mi][ni][i];
          const float pv = __shfl_xor(v, 8);
          if (lr < 16) {
            const int r = m0 + wm * 64 + mi * 32 + crow(i, lh);
            const int pos = (r >= TP) ? 8192 : (r & 8191);
            const float2 cs = p.ROPE()[pos * 8 + (lr & 7)];
            acc[mi][ni][i] = (lr < 8) ? v * cs.x - pv * cs.y : v * cs.x + pv * cs.y;
          }
        }
  }
  if (nt >= 22) {
#pragma unroll
    for (int mi = 0; mi < 2; ++mi)
#pragma unroll
      for (int ni = 0; ni < GNB; ++ni)
#pragma unroll
        for (int i = 0; i < 16; ++i) acc[mi][ni][i] = sigm_f(acc[mi][ni][i]);
  }
  if ((mt == 63 || mt == 127 || mt == 128) && ((nt >= 4 && nt < 12) || nt == 20 || nt == 21)) {
#pragma unroll
    for (int mi = 0; mi < 2; ++mi)
#pragma unroll
      for (int ni = 0; ni < GNB; ++ni) {
        const int cc = (n0 & 255) + wn * 128 + ni * 32 + lr;
        const int rb_ = launder(m0 + wm * 64 + mi * 32 + 4 * lh);
#pragma unroll
        for (int i = 0; i < 16; ++i) {
          const int r = rb_ + (i & 3) + 8 * (i >> 2);
          const float v = acc[mi][ni][i];
          if (nt < 12) {
            const int ch = (n0 - 1024) + cc;
            if (r >= TP) p.out[OFF_CONVS + ((size_t)(l * 128 + (r - TP)) * 3 + 2) * 2048 + ch] = v;
            else { const int t = r & 8191; if (t >= 8189) p.out[OFF_CONVP + ((size_t)(l * 2 + (r >> 13)) * 3 + (t - 8189)) * 2048 + ch] = v; }
          } else {
            const size_t ob = (nt == 20) ? OFF_KS : OFF_VS, obp = (nt == 20) ? OFF_KP : OFF_VP;
            if (r >= TP) p.out[ob + ((size_t)(l * 128 + (r - TP)) * 128 + 127) * 256 + cc] = v;
            else p.out[obp + ((size_t)(l * 2 + (r >> 13)) * 128 + ((r & 8191) - 8064)) * 256 + cc] = v;
          }
        }
        __builtin_amdgcn_sched_barrier(0);
      }
  }
  if (nt == 21) {
#pragma unroll
    for (int mi = 0; mi < 2; ++mi)
#pragma unroll
      for (int ni = 0; ni < GNB; ++ni) {
        bf16_t* d = sT + (wn * 128 + ni * 32 + lr) * 136 + wm * 64 + mi * 32 + 4 * lh;
#pragma unroll
        for (int ig = 0; ig < 4; ++ig)
          *(uint2*)(d + 8 * ig) = make_uint2(pack2(acc[mi][ni][4 * ig], acc[mi][ni][4 * ig + 1]), pack2(acc[mi][ni][4 * ig + 2], acc[mi][ni][4 * ig + 3]));
      }
    __syncthreads();
#pragma unroll 4
    for (int it = 0; it < 16; ++it) {
      const int idx = tid + 256 * it, c = idx >> 4, chunk = idx & 15;
      *(uint4*)(p.VT() + (size_t)c * T + m0 + chunk * 8) = *(const uint4*)(sT + c * 136 + chunk * 8);
    }
    return;
  }
  stage_tile(sT, acc, wm, wn, lr, lh);
  __syncthreads();
  bf16_t* dst; int ld;
  if (nt < 4) { dst = p.Z() + n0; ld = 1024; }
  else if (nt < 12) { dst = p.XBC() + (n0 - 1024); ld = 2048; }
  else if (nt < 16) { dst = p.U() + (n0 - 3072); ld = 1024; }
  else if (nt < 20) { dst = p.Q() + (n0 - 4096); ld = 1024; }
  else if (nt == 20) { dst = p.K(); ld = 256; }
  else { dst = p.G() + (n0 - 5632); ld = 3072; }
  tile_writeout(dst + (size_t)m0 * ld, ld, sT);
}

DI void conv_job(const P& p, int l, int job, char* smem) {
  const int ct = job & 31, tt = job >> 5;
  const int ch0 = ct * 64, tokb = tt * 128;
  bf16_t* sT = (bf16_t*)smem;
  const int tid = tidx();
  const float* cw = p.conv_w + (size_t)l * 4 * 2048;
  __syncthreads();
#pragma unroll
  for (int it = 0; it < 4; ++it) {
    const int item = tid + 256 * it, tl = item >> 3, chk = item & 7, ch = ch0 + chk * 8, row = tokb + tl, t = row & 8191;
    float a[8];
    {
      const float4 b0 = *(const float4*)(p.conv_b + l * 2048 + ch), b1 = *(const float4*)(p.conv_b + l * 2048 + ch + 4);
      a[0] = b0.x; a[1] = b0.y; a[2] = b0.z; a[3] = b0.w; a[4] = b1.x; a[5] = b1.y; a[6] = b1.z; a[7] = b1.w;
    }
#pragma unroll
    for (int j = 0; j < 4; ++j) {
      if (t - 3 + j >= 0) {
        const uint4 rv = *(const uint4*)(p.XBC() + (size_t)(row - 3 + j) * 2048 + ch);
        const float4 w0 = *(const float4*)(cw + j * 2048 + ch), w1 = *(const float4*)(cw + j * 2048 + ch + 4);
        a[0] += bflo(rv.x) * w0.x; a[1] += bfhi(rv.x) * w0.y; a[2] += bflo(rv.y) * w0.z; a[3] += bfhi(rv.y) * w0.w;
        a[4] += bflo(rv.z) * w1.x; a[5] += bfhi(rv.z) * w1.y; a[6] += bflo(rv.w) * w1.z; a[7] += bfhi(rv.w) * w1.w;
      }
    }
#pragma unroll
    for (int j = 0; j < 8; ++j) a[j] = silu_f(a[j]);
    if (ct >= 16) *(uint4*)(p.BC() + (size_t)row * 1024 + (ch - 1024)) = make_uint4(pack2(a[0], a[1]), pack2(a[2], a[3]), pack2(a[4], a[5]), pack2(a[6], a[7]));
    if (ct < 24) {
#pragma unroll
      for (int j = 0; j < 8; ++j) sT[(chk * 8 + j) * 136 + (tl ^ (chk << 3))] = f2bf(a[j]);
    }
  }
  if (ct < 24) {
    __syncthreads();
#pragma unroll
    for (int it = 0; it < 4; ++it) {
      const int item = tid + 256 * it, r = item >> 4, chk = item & 15;
      *(uint4*)(p.XBT() + (size_t)(ch0 + r) * TP + tokb + chk * 8) = *(const uint4*)(sT + r * 136 + ((chk ^ (r >> 3)) << 3));
    }
  }
}

DI void chunk_acum(const P& p, int l, int head, int tok0, float* sAc, float* sDt, float& alast) {
  const int lane = tidx() & 63;
  const float Ah = -expf(p.a_log[l * 16 + head]);
  const float d0 = p.DT()[(size_t)(tok0 + 2 * lane) * 16 + head], d1 = p.DT()[(size_t)(tok0 + 2 * lane + 1) * 16 + head];
  const float a0 = d0 * Ah, a1 = d1 * Ah;
  float s = a0 + a1;
#pragma unroll
  for (int off = 1; off < 64; off <<= 1) { const float tv = __shfl_up(s, off); if (lane >= off) s += tv; }
  const float excl = s - (a0 + a1);
  sAc[2 * lane] = excl + a0; sAc[2 * lane + 1] = s;
  sDt[2 * lane] = d0; sDt[2 * lane + 1] = d1;
  alast = __shfl(s, 63);
}

DI void ssd_a_job(const P& p, int l, int job, char* smem) {
  const int head = job & 15, c = (job >> 4) & 63, b = job >> 10, g = head >> 2;
  const int tok0 = b * SEQ + c * 128;
  bf16_t* sXT = (bf16_t*)smem;
  bf16_t* sBT = sXT + 64 * 136;
  float* sW = (float*)(sBT + 128 * 136);
  float* sAc = sW + 128;
  float* sDt = sAc + 128;
  const int tid = tidx(), lane = tid & 63, w = __builtin_amdgcn_readfirstlane(tid >> 6), lr = lane & 31, lh = lane >> 5;
  __syncthreads();
  if (w == 0) {
    float alast;
    chunk_acum(p, l, head, tok0, sAc, sDt, alast);
    sW[2 * lane] = sDt[2 * lane] * __expf(alast - sAc[2 * lane]);
    sW[2 * lane + 1] = sDt[2 * lane + 1] * __expf(alast - sAc[2 * lane + 1]);
    if (lane == 0) p.CDEC()[(b * 64 + c) * 16 + head] = __expf(alast);
  }
  __syncthreads();
#pragma unroll
  for (int it = 0; it < 4; ++it) {
    const int item = tid + 256 * it, pr = item >> 4, s0 = (item & 15) * 8;
    const uint4 v = *(const uint4*)(p.XBT() + (size_t)(head * 64 + pr) * TP + tok0 + s0);
    const float4 w0 = *(const float4*)(sW + s0), w1 = *(const float4*)(sW + s0 + 4);
    *(uint4*)(sXT + pr * 136 + s0) = make_uint4(pack2(bflo(v.x) * w0.x, bfhi(v.x) * w0.y), pack2(bflo(v.y) * w0.z, bfhi(v.y) * w0.w),
                                                pack2(bflo(v.z) * w1.x, bfhi(v.z) * w1.y), pack2(bflo(v.w) * w1.z, bfhi(v.w) * w1.w));
  }
#pragma unroll
  for (int it = 0; it < 8; ++it) {
    const int item = tid + 256 * it, n = item >> 4, s0 = (item & 15) * 8;
    *(uint4*)(sBT + n * 136 + s0) = *(const uint4*)(p.XBT() + (size_t)(1024 + g * 128 + n) * TP + tok0 + s0);
  }
  __syncthreads();
  const int wp = w & 1, wn = w >> 1;
  f32x16 acc[2];
  zero16(acc[0]); zero16(acc[1]);
#pragma unroll
  for (int kk = 0; kk < 8; ++kk) {
    const bf16x8 af = *(const bf16x8*)(sXT + (wp * 32 + lr) * 136 + kk * 16 + lh * 8);
#pragma unroll
    for (int ni = 0; ni < 2; ++ni) {
      const bf16x8 bfr = *(const bf16x8*)(sBT + (wn * 64 + ni * 32 + lr) * 136 + kk * 16 + lh * 8);
      acc[ni] = MFMA32(af, bfr, acc[ni]);
    }
  }
  float* st = p.ST() + ((size_t)((b * 64 + c) * 16 + head) * 64) * 128;
#pragma unroll
  for (int ni = 0; ni < 2; ++ni)
#pragma unroll
    for (int i = 0; i < 16; ++i) st[(wp * 32 + crow(i, lh)) * 128 + wn * 64 + ni * 32 + lr] = acc[ni][i];
}

DI void ssd_scan_job(const P& p, int l, int job) {
  const int gid = job * 256 + tidx();
  const int b = gid >> 15, rem = gid & 32767, head = rem >> 11;
  float4 h = make_float4(0.f, 0.f, 0.f, 0.f);
  const float4* sp0 = (const float4*)(p.ST() + (size_t)(b * 64) * 131072) + rem;
  uint2* hp0 = (uint2*)(p.HP() + (size_t)(b * 64) * 131072) + rem;
  for (int c0 = 0; c0 < 64; c0 += 16) {
    float4 sv[16];
    float dv[16];
#pragma unroll
    for (int k = 0; k < 16; ++k) { sv[k] = sp0[(size_t)(c0 + k) * 32768]; dv[k] = p.CDEC()[(b * 64 + c0 + k) * 16 + head]; }
#pragma unroll
    for (int k = 0; k < 16; ++k) {
      hp0[(size_t)(c0 + k) * 32768] = make_uint2(pack2(h.x, h.y), pack2(h.z, h.w));
      h.x = h.x * dv[k] + sv[k].x; h.y = h.y * dv[k] + sv[k].y; h.z = h.z * dv[k] + sv[k].z; h.w = h.w * dv[k] + sv[k].w;
    }
  }
  ((float4*)(p.out + OFF_SSMP + (size_t)(l * 2 + b) * 131072))[rem] = h;
}

DI void s5_scan_job(const P& p, int l, int job) {
  const int gid = job * 256 + tidx();
  const int n = gid & 63, g = (gid >> 6) & 63, b = gid >> 12;
  const float* prm = p.S5P() + ((size_t)(l * 64 + g) * 36) * 64 + n;
  const float aqr = prm[128], aqi = prm[192];
  float hr = 0.f, hi = 0.f;
  float2* sp = (float2*)p.S5S() + ((size_t)(b * 128) * 64 + g) * 64 + n;
  for (int c0 = 0; c0 < 128; c0 += 8) {
    float2 sv[8];
#pragma unroll
    for (int k = 0; k < 8; ++k) sv[k] = sp[(size_t)(c0 + k) * 4096];
#pragma unroll
    for (int k = 0; k < 8; ++k) {
      sp[(size_t)(c0 + k) * 4096] = make_float2(hr, hi);
      const float nr = aqr * hr - aqi * hi + sv[k].x, ni = aqr * hi + aqi * hr + sv[k].y;
      hr = nr; hi = ni;
    }
  }
}

DI void ssd_c_job(const P& p, int l, int job, char* smem) {
  const int g = job & 3, c = (job >> 2) & 63, b = job >> 8;
  const int tok0 = b * SEQ + c * 128;
  bf16_t* sC = (bf16_t*)smem;
  bf16_t* sB = sC + 128 * 136;
  float* sAc = (float*)(sB + 128 * 136);
  float* sDt = sAc + 512;
  const int tid = tidx(), lane = tid & 63, w = __builtin_amdgcn_readfirstlane(tid >> 6), lr = lane & 31, lh = lane >> 5, wm = w & 1, wn = w >> 1;
  __syncthreads();
  { float alast; chunk_acum(p, l, g * 4 + w, tok0, sAc + w * 128, sDt + w * 128, alast); }
#pragma unroll
  for (int it = 0; it < 8; ++it) {
    const int item = tid + 256 * it, r = item >> 4, s0 = (item & 15) * 8;
    *(uint4*)(sC + r * 136 + s0) = *(const uint4*)(p.BC() + (size_t)(tok0 + r) * 1024 + 512 + g * 128 + s0);
    *(uint4*)(sB + r * 136 + s0) = *(const uint4*)(p.BC() + (size_t)(tok0 + r) * 1024 + g * 128 + s0);
  }
  __syncthreads();
  f32x16 cb[2][2];
#pragma unroll
  for (int a = 0; a < 2; ++a)
#pragma unroll
    for (int bb = 0; bb < 2; ++bb) zero16(cb[a][bb]);
  if (!(wm == 0 && wn == 1)) {
#pragma unroll
    for (int kk = 0; kk < 8; ++kk) {
      bf16x8 af[2], bfr[2];
#pragma unroll
      for (int mi = 0; mi < 2; ++mi) af[mi] = *(const bf16x8*)(sC + (wm * 64 + mi * 32 + lr) * 136 + kk * 16 + lh * 8);
#pragma unroll
      for (int ni = 0; ni < 2; ++ni) bfr[ni] = *(const bf16x8*)(sB + (wn * 64 + ni * 32 + lr) * 136 + kk * 16 + lh * 8);
#pragma unroll
      for (int mi = 0; mi < 2; ++mi)
#pragma unroll
        for (int ni = 0; ni < 2; ++ni) cb[mi][ni] = MFMA32(af[mi], bfr[ni], cb[mi][ni]);
    }
  }
  __syncthreads();
  bf16_t* sM = sB;
  unsigned cbp[2][2][8];
#pragma unroll
  for (int a = 0; a < 2; ++a)
#pragma unroll
    for (int bb = 0; bb < 2; ++bb)
#pragma unroll
      for (int k = 0; k < 8; ++k) cbp[a][bb][k] = pack2(cb[a][bb][2 * k], cb[a][bb][2 * k + 1]);
  float ss[16];
#pragma unroll
  for (int i = 0; i < 16; ++i) ss[i] = 0.f;
#pragma unroll 1
  for (int hd = 0; hd < 4; ++hd) {
    const int head = g * 4 + hd;
    const float* ac = sAc + hd * 128;
    const float* dtv = sDt + hd * 128;
    const int lrq = launder(lr), lhq = launder(lh);
#pragma unroll
    for (int mi = 0; mi < 2; ++mi)
#pragma unroll
      for (int ni = 0; ni < 2; ++ni) {
        const int s = wn * 64 + ni * 32 + lrq;
        const float as = ac[s], ds = dtv[s];
#pragma unroll
        for (int i = 0; i < 16; ++i) {
          const int t = wm * 64 + mi * 32 + crow(i, lhq);
          const float cv = (i & 1) ? bfhi(cbp[mi][ni][i >> 1]) : bflo(cbp[mi][ni][i >> 1]);
          const float v = (s <= t) ? cv * __expf(ac[t] - as) * ds : 0.f;
          sM[t * 136 + s] = f2bf(v);
        }
        __builtin_amdgcn_sched_barrier(0);
      }
    __syncthreads();
    f32x16 yd[2];
    zero16(yd[0]); zero16(yd[1]);
    {
      const bf16_t* hb = p.HP() + (((size_t)((b * 64 + c) * 16 + head) * 64 + lr) * 128 + lh * 8);
      bf16x8 hf[8][2];
#pragma unroll
      for (int kk = 0; kk < 8; ++kk)
#pragma unroll
        for (int pb = 0; pb < 2; ++pb) hf[kk][pb] = *(const bf16x8*)(hb + (size_t)pb * 32 * 128 + kk * 16);
#pragma unroll
      for (int kk = 0; kk < 8; ++kk) {
        const bf16x8 af = *(const bf16x8*)(sC + (32 * w + lr) * 136 + kk * 16 + lh * 8);
        yd[0] = MFMA32(af, hf[kk][0], yd[0]);
        yd[1] = MFMA32(af, hf[kk][1], yd[1]);
      }
    }
#pragma unroll
    for (int i = 0; i < 16; ++i) {
      const float e = __expf(ac[32 * w + crow(i, lh)]);
      yd[0][i] *= e; yd[1][i] *= e;
    }
    {
      const int nkk = 2 * (w + 1);
      const bf16_t* xb = p.XBT() + (size_t)(head * 64 + lr) * TP + tok0 + lh * 8;
      const bf16_t* am = sM + (32 * w + lr) * 136 + lh * 8;
      bf16x8 x00 = *(const bf16x8*)(xb), x01 = *(const bf16x8*)(xb + (size_t)32 * TP);
      for (int kk = 0; kk < nkk; kk += 2) {
        const bf16x8 x10 = *(const bf16x8*)(xb + (kk + 1) * 16), x11 = *(const bf16x8*)(xb + (size_t)32 * TP + (kk + 1) * 16);
        const bf16x8 a0 = *(const bf16x8*)(am + kk * 16);
        yd[0] = MFMA32(a0, x00, yd[0]);
        yd[1] = MFMA32(a0, x01, yd[1]);
        const int kn = (kk + 2 < nkk) ? kk + 2 : kk;
        x00 = *(const bf16x8*)(xb + kn * 16); x01 = *(const bf16x8*)(xb + (size_t)32 * TP + kn * 16);
        const bf16x8 a1 = *(const bf16x8*)(am + (kk + 1) * 16);
        yd[0] = MFMA32(a1, x10, yd[0]);
        yd[1] = MFMA32(a1, x11, yd[1]);
      }
    }
    const float Dh = p.m_d[l * 16 + head];
#pragma unroll
    for (int pb = 0; pb < 2; ++pb) {
      const int pch = head * 64 + pb * 32 + lr;
#pragma unroll
      for (int ig = 0; ig < 4; ++ig) {
        const int t0 = 32 * w + 8 * ig + 4 * lh;
        const uint2 xr = *(const uint2*)(p.XBT() + (size_t)pch * TP + tok0 + t0);
        const float xs[4] = {bflo(xr.x), bfhi(xr.x), bflo(xr.y), bfhi(xr.y)};
#pragma unroll
        for (int jj = 0; jj < 4; ++jj) {
          const int i = 4 * ig + jj, t = t0 + jj;
          const float y = yd[pb][i] + Dh * xs[jj];
          const float z = bf2f(p.Z()[(size_t)(tok0 + t) * 1024 + pch]);
          const float yg = y * silu_f(z);
          ss[i] += yg * yg;
          p.YM()[(size_t)(tok0 + t) * 1024 + pch] = f2bf(yg);
        }
      }
      __builtin_amdgcn_sched_barrier(0);
    }
    __syncthreads();
  }
#pragma unroll
  for (int i = 0; i < 16; ++i) {
    float v = ss[i];
    v += __shfl_xor(v, 1); v += __shfl_xor(v, 2); v += __shfl_xor(v, 4); v += __shfl_xor(v, 8); v += __shfl_xor(v, 16);
    ss[i] = rsqrtf(v * (1.f / 256.f) + EPS);
  }
  for (int hd = 0; hd < 4; ++hd) {
#pragma unroll
    for (int pb = 0; pb < 2; ++pb) {
      const int pch = (g * 4 + hd) * 64 + pb * 32 + lr;
      const float nw = p.m_norm_w[l * 1024 + pch];
#pragma unroll
      for (int i = 0; i < 16; ++i) {
        const size_t idx = (size_t)(tok0 + 32 * w + crow(i, lh)) * 1024 + pch;
        p.YM()[idx] = f2bf(bf2f(p.YM()[idx]) * ss[i] * nw);
      }
      __builtin_amdgcn_sched_barrier(0);
    }
  }
}

DI void ssd_sample_job(const P& p, int l, int job, char* smem) {
  const int g = job & 3, b = job >> 2;
  float* sx = (float*)smem;
  float* sBv = sx + 256;
  float* sCv = sBv + 128;
  float* sY = sCv + 128;
  float* sRed = sY + 256;
  const int tid = tidx(), lane = tid & 63, w = __builtin_amdgcn_readfirstlane(tid >> 6);
  const int row = TP + b;
  __syncthreads();
#pragma unroll
  for (int it = 0; it < 2; ++it) {
    const int idx = tid + 256 * it;
    const int ch = idx < 256 ? g * 256 + idx : (idx < 384 ? 1024 + g * 128 + (idx - 256) : 1536 + g * 128 + (idx - 384));
    const float* sc = p.state_conv + ((size_t)(l * 128 + b) * 3) * 2048 + ch;
    const float s0 = sc[0], s1 = sc[2048], s2 = sc[4096];
    const float raw = bf2f(p.XBC()[(size_t)row * 2048 + ch]);
    const float* cw = p.conv_w + (size_t)l * 4 * 2048 + ch;
    float v = p.conv_b[l * 2048 + ch] + cw[0] * s0 + cw[2048] * s1 + cw[4096] * s2 + cw[6144] * raw;
    v = silu_f(v);
    sx[idx] = v;
    float* co = p.out + OFF_CONVS + ((size_t)(l * 128 + b) * 3) * 2048 + ch;
    co[0] = s1; co[2048] = s2;
  }
  __syncthreads();
  const int pp = tid >> 2, nq = (tid & 3) * 32;
  float4 hv[4][8];
#pragma unroll
  for (int hd = 0; hd < 4; ++hd) {
    const float4* h0 = (const float4*)(p.state_ssm + ((((size_t)l * 128 + b) * 16 + g * 4 + hd) * 64 + pp) * 128 + nq);
#pragma unroll
    for (int q = 0; q < 8; ++q) hv[hd][q] = h0[q];
  }
#pragma unroll
  for (int hd = 0; hd < 4; ++hd) {
    const int head = g * 4 + hd;
    const float dt = p.DT()[(size_t)row * 16 + head];
    const float Ah = -expf(p.a_log[l * 16 + head]);
    const float dA = __expf(dt * Ah);
    const float xv = sx[hd * 64 + pp];
    const float coef = dt * xv;
    float4* ho = (float4*)(p.out + OFF_SSMS + ((((size_t)l * 128 + b) * 16 + head) * 64 + pp) * 128 + nq);
    float yacc = 0.f;
#pragma unroll
    for (int q = 0; q < 8; ++q) {
      float4 h4 = hv[hd][q];
      const int n = nq + 4 * q;
      h4.x = h4.x * dA + coef * sBv[n]; h4.y = h4.y * dA + coef * sBv[n + 1]; h4.z = h4.z * dA + coef * sBv[n + 2]; h4.w = h4.w * dA + coef * sBv[n + 3];
      yacc += h4.x * sCv[n] + h4.y * sCv[n + 1] + h4.z * sCv[n + 2] + h4.w * sCv[n + 3];
      ho[q] = h4;
    }
    yacc += __shfl_xor(yacc, 1); yacc += __shfl_xor(yacc, 2);
    const float y = yacc + p.m_d[l * 16 + head] * xv;
    const float z = bf2f(p.Z()[(size_t)row * 1024 + head * 64 + pp]);
    if ((tid & 3) == 0) sY[hd * 64 + pp] = y * silu_f(z);
  }
  __syncthreads();
  const float v = sY[tid];
  const float ssq = wave_sum(v * v);
  if (lane == 0) sRed[w] = ssq;
  __syncthreads();
  const float tot = sRed[0] + sRed[1] + sRed[2] + sRed[3];
  const float sc = rsqrtf(tot * (1.f / 256.f) + EPS);
  p.YM()[(size_t)row * 1024 + g * 256 + tid] = f2bf(v * sc * p.m_norm_w[l * 1024 + g * 256 + tid]);
}

DI void s5_wave_job(const P& p, int l, int mode, int b, int g, int c_first, int nch, bf16_t* sH) {
  const int lane = tidx() & 63, lr = lane & 31, lh = lane >> 5;
  bf16x8 bq[4];
#pragma unroll
  for (int nb = 0; nb < 4; ++nb) bq[nb] = *(const bf16x8*)(p.BBT() + ((size_t)(l * 64 + g) * 128 + nb * 32 + lr) * 16 + lh * 8);
  float ar[2], ai[2], cr_[2], ci_[2];
#pragma unroll
  for (int k = 0; k < 2; ++k) {
    const float* prm = p.S5P() + ((size_t)(l * 64 + g) * 36) * 64 + k * 32 + lr;
    ar[k] = prm[0]; ai[k] = prm[64];
  }
  const int o = lane & 15, quad = lane >> 4;
  bf16x8 cf[4];
  float dsk = 0.f;
  if (mode != 0) {
#pragma unroll
    for (int kk = 0; kk < 4; ++kk) {
      const float* cp = ((kk < 2) ? p.c_re : p.c_im) + ((size_t)(l * 64 + g) * 16 + o) * 64 + (kk & 1) * 32 + quad * 8;
      const float4 c0 = ((const float4*)cp)[0], c1 = ((const float4*)cp)[1];
      const float sg = (kk < 2) ? 1.f : -1.f;
      cf[kk] = u4_to_bf8(make_uint4(pack2(sg * c0.x, sg * c0.y), pack2(sg * c0.z, sg * c0.w), pack2(sg * c1.x, sg * c1.y), pack2(sg * c1.z, sg * c1.w)));
    }
    dsk = p.s5_d[l * 1024 + g * 16 + o];
  }
  for (int cc = 0; cc < nch; ++cc) {
  const int c = c_first + cc;
  int row0, Q;
  if (mode == 2) { row0 = TP + b; Q = 1; } else { row0 = b * SEQ + c * 64; Q = 64; }
#pragma unroll
  for (int k = 0; k < 2; ++k) {
    const int n = k * 32 + lr;
    cr_[k] = 0.f; ci_[k] = 0.f;
    if (mode == 2) {
      cr_[k] = p.s5_sre[((size_t)(l * 128 + b) * 64 + g) * 64 + n];
      ci_[k] = p.s5_sim[((size_t)(l * 128 + b) * 64 + g) * 64 + n];
    } else if (mode == 1) {
      const float2 sv = *(const float2*)(p.S5S() + (((size_t)(b * 128 + c) * 64 + g) * 64 + n) * 2);
      cr_[k] = sv.x; ci_[k] = sv.y;
    }
  }
  const int ntb = (mode == 2) ? 1 : 2;
  for (int tb = 0; tb < ntb; ++tb) {
    const bf16x8 uf = *(const bf16x8*)(p.U() + (size_t)(row0 + tb * 32 + lr) * 1024 + g * 16 + lh * 8);
    f32x16 acc[4];
#pragma unroll
    for (int nb = 0; nb < 4; ++nb) { zero16(acc[nb]); acc[nb] = MFMA32(uf, bq[nb], acc[nb]); }
#pragma unroll
    for (int k = 0; k < 2; ++k) {
      const float a1r = ar[k], a1i = ai[k];
      const float a2r = a1r * a1r - a1i * a1i, a2i = 2.f * a1r * a1i;
      const float a3r = a2r * a1r - a2i * a1i, a3i = a2r * a1i + a2i * a1r;
      const float a4r = a2r * a2r - a2i * a2i, a4i = 2.f * a2r * a2i;
      float er[4], ei[4];
#pragma unroll
      for (int q = 0; q < 4; ++q) {
        float hr = acc[k][4 * q], hi = acc[2 + k][4 * q];
#pragma unroll
        for (int j = 1; j < 4; ++j) {
          const float nr = a1r * hr - a1i * hi + acc[k][4 * q + j], ni = a1r * hi + a1i * hr + acc[2 + k][4 * q + j];
          hr = nr; hi = ni;
          acc[k][4 * q + j] = hr; acc[2 + k][4 * q + j] = hi;
        }
        er[q] = hr; ei[q] = hi;
      }
      float cinr[4], cini[4];
      float cr = cr_[k], ci = ci_[k];
#pragma unroll
      for (int q = 0; q < 4; ++q) {
        const float per = __shfl_xor(er[q], 32), pei = __shfl_xor(ei[q], 32);
        const float e0r = lh ? per : er[q], e0i = lh ? pei : ei[q];
        const float e1r = lh ? er[q] : per, e1i = lh ? ei[q] : pei;
        const float c1r = a4r * cr - a4i * ci + e0r, c1i = a4r * ci + a4i * cr + e0i;
        cinr[q] = lh ? c1r : cr; cini[q] = lh ? c1i : ci;
        cr = a4r * c1r - a4i * c1i + e1r; ci = a4r * c1i + a4i * c1r + e1i;
      }
#pragma unroll
      for (int q = 0; q < 4; ++q) {
        const float xr = cinr[q], xi = cini[q];
        acc[k][4 * q] += a1r * xr - a1i * xi;     acc[2 + k][4 * q] += a1r * xi + a1i * xr;
        acc[k][4 * q + 1] += a2r * xr - a2i * xi; acc[2 + k][4 * q + 1] += a2r * xi + a2i * xr;
        acc[k][4 * q + 2] += a3r * xr - a3i * xi; acc[2 + k][4 * q + 2] += a3r * xi + a3i * xr;
        acc[k][4 * q + 3] += a4r * xr - a4i * xi; acc[2 + k][4 * q + 3] += a4r * xi + a4i * xr;
      }
      if (mode == 2) { cr_[k] = acc[k][0]; ci_[k] = acc[2 + k][0]; }
      else { cr_[k] = cr; ci_[k] = ci; }
      if (mode != 0) {
#pragma unroll
        for (int i = 0; i < 16; ++i) {
          const int t = tb * 32 + crow(i, lh);
          sH[t * 136 + k * 32 + lr] = f2bf(acc[k][i]);
          sH[t * 136 + 64 + k * 32 + lr] = f2bf(acc[2 + k][i]);
        }
      }
    }
  }
  if (lh == 0) {
#pragma unroll
    for (int k = 0; k < 2; ++k) {
      const int n = k * 32 + lr;
      if (mode == 0) *(float2*)(p.S5S() + (((size_t)(b * 128 + c) * 64 + g) * 64 + n) * 2) = make_float2(cr_[k], ci_[k]);
      if (mode == 1 && c == 127) {
        p.out[OFF_S5RP + ((size_t)(l * 2 + b) * 64 + g) * 64 + n] = cr_[k];
        p.out[OFF_S5IP + ((size_t)(l * 2 + b) * 64 + g) * 64 + n] = ci_[k];
      }
      if (mode == 2) {
        p.out[OFF_S5RS + ((size_t)(l * 128 + b) * 64 + g) * 64 + n] = cr_[k];
        p.out[OFF_S5IS + ((size_t)(l * 128 + b) * 64 + g) * 64 + n] = ci_[k];
      }
    }
  }
  if (mode == 0) continue;
  const int nrb = (mode == 2) ? 1 : 4;
  __builtin_amdgcn_fence(__ATOMIC_RELEASE, "wavefront");
  __builtin_amdgcn_wave_barrier();
  __builtin_amdgcn_fence(__ATOMIC_ACQUIRE, "wavefront");
  for (int rb = 0; rb < nrb; ++rb) {
    f32x4 a4 = {0.f, 0.f, 0.f, 0.f};
#pragma unroll
    for (int kk = 0; kk < 4; ++kk) {
      const bf16x8 af = *(const bf16x8*)(sH + (rb * 16 + o) * 136 + kk * 32 + quad * 8);
      a4 = MFMA16(af, cf[kk], a4);
    }
#pragma unroll
    for (int jj = 0; jj < 4; ++jj) {
      const int t = rb * 16 + quad * 4 + jj;
      if (t < Q) {
        const size_t idx = (size_t)(row0 + t) * 1024 + g * 16 + o;
        const float y = a4[jj] + dsk * bf2f(p.U()[idx]);
        p.YS()[idx] = f2bf(gelu_tanh(y));
      }
    }
  }
  __builtin_amdgcn_fence(__ATOMIC_RELEASE, "wavefront");
  __builtin_amdgcn_wave_barrier();
  }
}

DI void attn_prompt_job(const P& p, int l, int job, char* smem) {
  const int head = job & 15, blk = (job >> 4) & 63, b = job >> 10, kvh = head >> 2;
  bf16_t* sK = (bf16_t*)smem;
  bf16_t* sVt = sK + 256 * 72;
  const int tid = tidx(), lane = tid & 63, w = __builtin_amdgcn_readfirstlane(tid >> 6), lr = lane & 31, lh = lane >> 5;
  const int tokc0 = b * SEQ + blk * 128 - 128;
  __syncthreads();
#pragma unroll
  for (int it = 0; it < 8; ++it) {
    const int item = tid + 256 * it, row = item >> 3, chk = item & 7;
    uint4 v = make_uint4(0u, 0u, 0u, 0u);
    if (blk > 0 || row >= 128) v = *(const uint4*)(p.K() + (size_t)(tokc0 + row) * 256 + kvh * 64 + chk * 8);
    *(uint4*)(sK + row * 72 + chk * 8) = v;
  }
#pragma unroll
  for (int it = 0; it < 8; ++it) {
    const int item = tid + 256 * it, d = item >> 5, chk = item & 31;
    uint4 v = make_uint4(0u, 0u, 0u, 0u);
    if (blk > 0 || chk >= 16) v = *(const uint4*)(p.VT() + (size_t)(kvh * 64 + d) * T + tokc0 + chk * 8);
    *(uint4*)(sVt + d * 264 + chk * 8) = v;
  }
  __syncthreads();
  const int qtok = b * SEQ + blk * 128 + 32 * w + lr;
  bf16x8 qf[4];
#pragma unroll
  for (int kk = 0; kk < 4; ++kk) qf[kk] = *(const bf16x8*)(p.Q() + (size_t)qtok * 1024 + head * 64 + kk * 16 + lh * 8);
  f32x16 st[5];
#pragma unroll
  for (int x = 0; x < 5; ++x) {
    zero16(st[x]);
#pragma unroll
    for (int kk = 0; kk < 4; ++kk) {
      const bf16x8 af = *(const bf16x8*)(sK + (32 * (w + x) + lr) * 72 + kk * 16 + lh * 8);
      st[x] = MFMA32(af, qf[kk], st[x]);
    }
  }
  const float sink = p.sinks[l * 16 + head];
  const int qi = 128 + 32 * w + lr;
  float m = sink;
#pragma unroll
  for (int x = 0; x < 5; ++x)
#pragma unroll
    for (int i = 0; i < 16; ++i) {
      const int kj = 32 * (w + x) + crow(i, lh);
      const bool valid = (kj <= qi) && (kj >= qi - 128) && (blk > 0 || kj >= 128);
      const float s = valid ? st[x][i] * 0.125f : -1e30f;
      st[x][i] = s;
      m = fmaxf(m, s);
    }
  m = fmaxf(m, __shfl_xor(m, 32));
  float sum = 0.f;
#pragma unroll
  for (int x = 0; x < 5; ++x)
#pragma unroll
    for (int i = 0; i < 16; ++i) { const float pv = __expf(st[x][i] - m); st[x][i] = pv; sum += pv; }
  sum += __shfl_xor(sum, 32);
  const float inv = 1.f / (sum + __expf(sink - m));
  f32x16 ot[2];
  zero16(ot[0]); zero16(ot[1]);
#pragma unroll
  for (int x = 0; x < 5; ++x)
#pragma unroll
    for (int s = 0; s < 2; ++s) {
      const uint4 pu = make_uint4(pack2(st[x][8 * s] * inv, st[x][8 * s + 1] * inv), pack2(st[x][8 * s + 2] * inv, st[x][8 * s + 3] * inv),
                                  pack2(st[x][8 * s + 4] * inv, st[x][8 * s + 5] * inv), pack2(st[x][8 * s + 6] * inv, st[x][8 * s + 7] * inv));
      const bf16x8 pf = u4_to_bf8(pu);
#pragma unroll
      for (int pb = 0; pb < 2; ++pb) {
        const bf16_t* vp = sVt + (pb * 32 + lr) * 264 + 32 * (w + x) + 16 * s + 4 * lh;
        const uint2 lo = *(const uint2*)vp, hi2 = *(const uint2*)(vp + 8);
        ot[pb] = MFMA32(u4_to_bf8(make_uint4(lo.x, lo.y, hi2.x, hi2.y)), pf, ot[pb]);
      }
    }
#pragma unroll
  for (int pb = 0; pb < 2; ++pb)
#pragma unroll
    for (int ig = 0; ig < 4; ++ig) {
      const int d0 = pb * 32 + 8 * ig + 4 * lh;
      *(uint2*)(p.O() + (size_t)qtok * 1024 + head * 64 + d0) = make_uint2(pack2(ot[pb][4 * ig], ot[pb][4 * ig + 1]), pack2(ot[pb][4 * ig + 2], ot[pb][4 * ig + 3]));
    }
}

DI void attn_sample_job(const P& p, int l, int job, char* smem) {
  const int kvh = job & 3, b = job >> 2;
  const int tid = tidx(), lane = tid & 63, w = __builtin_amdgcn_readfirstlane(tid >> 6);
  const int head = kvh * 4 + w, row = TP + b;
  float* sQ = (float*)smem;
  float* sP = sQ + 256;
  const size_t cbase = ((size_t)(l * 128 + b) * 128) * 256 + kvh * 64;
  const float4* kc4 = (const float4*)(p.cache_k + cbase);
  const float4* vc4 = (const float4*)(p.cache_v + cbase);
  float4* ko4 = (float4*)(p.out + OFF_KS + cbase);
  float4* vo4 = (float4*)(p.out + OFF_VS + cbase);
  __syncthreads();
  for (int idx = tid; idx < 127 * 16; idx += 256) {
    const int j = idx >> 4, q4 = idx & 15;
    ko4[j * 64 + q4] = kc4[(j + 1) * 64 + q4];
    vo4[j * 64 + q4] = vc4[(j + 1) * 64 + q4];
  }
  const float qd = bf2f(p.Q()[(size_t)row * 1024 + head * 64 + lane]);
  sQ[w * 64 + lane] = qd;
  __syncthreads();
  float s0 = 0.f, s1 = 0.f;
#pragma unroll 4
  for (int d4 = 0; d4 < 16; ++d4) {
    const float4 q4 = ((const float4*)(sQ + w * 64))[d4];
    const float4 k0 = kc4[lane * 64 + d4], k1 = kc4[(lane + 64) * 64 + d4];
    s0 += q4.x * k0.x + q4.y * k0.y + q4.z * k0.z + q4.w * k0.w;
    s1 += q4.x * k1.x + q4.y * k1.y + q4.z * k1.z + q4.w * k1.w;
  }
  s0 *= 0.125f; s1 *= 0.125f;
  const float s2 = wave_sum(qd * bf2f(p.K()[(size_t)row * 256 + kvh * 64 + lane])) * 0.125f;
  const float sink = p.sinks[l * 16 + head];
  float m = fmaxf(fmaxf(s0, s1), fmaxf(s2, sink));
  m = wave_max(m);
  const float p0 = __expf(s0 - m), p1 = __expf(s1 - m), p2 = __expf(s2 - m);
  const float sum = wave_sum(p0 + p1);
  const float inv = 1.f / (sum + p2 + __expf(sink - m));
  sP[w * 132 + lane] = p0 * inv; sP[w * 132 + 64 + lane] = p1 * inv;
  __syncthreads();
  const float* vc = p.cache_v + cbase + lane;
  float o = 0.f;
#pragma unroll 8
  for (int j = 0; j < 128; ++j) o += sP[w * 132 + j] * vc[(size_t)j * 256];
  o += p2 * inv * bf2f(p.VT()[(size_t)(kvh * 64 + lane) * T + row]);
  p.O()[(size_t)row * 1024 + head * 64 + lane] = f2bf(o);
}

template <int PASS>
DI void merge_pass(const P& p, const bf16_t* A, const bf16_t* Wt, int m0, int n0, char* smem) {
  m0 = launder_s(m0); n0 = launder_s(n0);
  const int tid = tidx(), lane = tid & 63, w = __builtin_amdgcn_readfirstlane(tid >> 6), wm = w & 1, wn = w >> 1, lr = lane & 31, lh = lane >> 5;
  f32x16 acc[2][GNB];
#pragma unroll
  for (int a = 0; a < 2; ++a)
#pragma unroll
    for (int b = 0; b < GNB; ++b) zero16(acc[a][b]);
  gemm_mainloop(A + (size_t)m0 * 1024, 1024, Wt + (size_t)n0 * 1024, 1024, 1024, acc, smem);
  m0 = launder_s(m0); n0 = launder_s(n0);
  bf16_t* sT = (bf16_t*)smem;
  stage_tile(sT, acc, wm, wn, lr, lh);
  __syncthreads();
  const int goff = (PASS == 0) ? 1024 : (PASS == 2) ? 0 : 2048;
#pragma unroll 2
  for (int it = 0; it < 16; ++it) {
    const int idx = tid + 256 * it, row = idx >> 5, chunk = idx & 31;
    const uint4 av = *(const uint4*)(sT + row * LDS_T + chunk * 8);
    uint4* mp = (uint4*)(p.MG() + (size_t)(m0 + row) * 1024 + n0 + chunk * 8);
    uint4 gv = make_uint4(0u, 0u, 0u, 0u), mv = gv;
    if (PASS != 1) gv = *(const uint4*)(p.G() + (size_t)(m0 + row) * 3072 + goff + n0 + chunk * 8);
    if (PASS != 0) mv = *mp;
    const unsigned aw[4] = {av.x, av.y, av.z, av.w}, gw[4] = {gv.x, gv.y, gv.z, gv.w}, mw[4] = {mv.x, mv.y, mv.z, mv.w};
    unsigned ow[4];
#pragma unroll
    for (int k = 0; k < 4; ++k) {
      const float a0 = bflo(aw[k]), a1 = bfhi(aw[k]), g0 = bflo(gw[k]), g1 = bfhi(gw[k]), m0_ = bflo(mw[k]), m1_ = bfhi(mw[k]);
      float o0, o1;
      if (PASS == 0) { o0 = sigm_f(a0) * g0; o1 = sigm_f(a1) * g1; }
      else if (PASS == 1) { o0 = m0_ * a0; o1 = m1_ * a1; }
      else { o0 = m0_ + a0 * g0; o1 = m1_ + a1 * g1; }
      ow[k] = pack2(o0, o1);
    }
    *mp = make_uint4(ow[0], ow[1], ow[2], ow[3]);
  }
}
DI void merge_job(const P& p, int l, int job, char* smem) {
  int mt, nt;
  if (!gemm_tile(job, 128, 4, mt, nt)) return;
  const int m0 = mt * 128, n0 = nt * 256;
  const bf16_t* wl = p.Wt() + (size_t)l * W_LAYER;
  merge_pass<0>(p, p.YS(), wl + WO_GLU + (size_t)1024 * 1024, m0, n0, smem);
  merge_pass<1>(p, p.YS(), wl + WO_GLU, m0, n0, smem);
  merge_pass<2>(p, p.YM(), wl + WO_MPROJ, m0, n0, smem);
  merge_pass<3>(p, p.O(), wl + WO_ATTNO, m0, n0, smem);
}
DI void resid_gemm_job(const P& p, const bf16_t* A, int lda, const bf16_t* Wt, int K, int job, char* smem) {
  int mt, nt;
  if (!gemm_tile(job, 128, 4, mt, nt)) return;
  int m0 = mt * 128, n0 = nt * 256;
  const int tid = tidx(), lane = tid & 63, w = __builtin_amdgcn_readfirstlane(tid >> 6), wm = w & 1, wn = w >> 1, lr = lane & 31, lh = lane >> 5;
  f32x16 acc[2][GNB];
#pragma unroll
  for (int a = 0; a < 2; ++a)
#pragma unroll
    for (int b = 0; b < GNB; ++b) zero16(acc[a][b]);
  gemm_mainloop(A + (size_t)m0 * lda, lda, Wt + (size_t)n0 * K, K, K, acc, smem);
  m0 = launder_s(m0); n0 = launder_s(n0);
  float* sF = (float*)smem;
#pragma unroll
  for (int h = 0; h < 2; ++h) {
    if (h) __syncthreads();
#pragma unroll
    for (int ni = 0; ni < GNB; ++ni) {
      float* d = sF + (wm * 32 + 4 * lh) * 260 + wn * 128 + ni * 32 + lr;
#pragma unroll
      for (int i = 0; i < 16; ++i) d[((i & 3) + 8 * (i >> 2)) * 260] = acc[h][ni][i];
    }
    __syncthreads();
#pragma unroll 4
    for (int it = 0; it < 16; ++it) {
      const int idx = tid + 256 * it, rl = idx >> 6, c4 = idx & 63;
      const int r = m0 + (rl >> 5) * 64 + h * 32 + (rl & 31);
      float4* xp = (float4*)(p.X() + (size_t)r * 1024 + n0) + c4;
      const float4 a = *(const float4*)(sF + rl * 260 + c4 * 4);
      float4 x = *xp;
      x.x += a.x; x.y += a.y; x.z += a.z; x.w += a.w;
      *xp = x;
    }
  }
}
DI void up_job(const P& p, int l, int job, char* smem) {
  int mt, nt;
  if (!gemm_tile(job, 128, 16, mt, nt)) return;
  int m0 = mt * 128, n0 = nt * 256;
  const int tid = tidx(), lane = tid & 63, w = __builtin_amdgcn_readfirstlane(tid >> 6), wm = w & 1, wn = w >> 1, lr = lane & 31, lh = lane >> 5;
  f32x16 acc[2][GNB];
#pragma unroll
  for (int a = 0; a < 2; ++a)
#pragma unroll
    for (int b = 0; b < GNB; ++b) zero16(acc[a][b]);
  gemm_mainloop(p.H() + (size_t)m0 * 1024, 1024, p.Wt() + (size_t)l * W_LAYER + WO_UP + (size_t)n0 * 1024, 1024, 1024, acc, smem);
#if PROBE_DUP == 12
  gemm_mainloop(p.H() + (size_t)m0 * 1024, 1024, p.Wt() + (size_t)l * W_LAYER + WO_UP + (size_t)n0 * 1024, 1024, 1024, acc, smem);
#pragma unroll
  for (int mi = 0; mi < 2; ++mi)
#pragma unroll
    for (int ni = 0; ni < GNB; ++ni)
#pragma unroll
      for (int i = 0; i < 16; ++i) acc[mi][ni][i] *= 0.5f;
#endif
  m0 = launder_s(m0); n0 = launder_s(n0);
#pragma unroll
  for (int mi = 0; mi < 2; ++mi)
#pragma unroll
    for (int ni = 0; ni < GNB; ++ni)
#pragma unroll
      for (int i = 0; i < 16; ++i) { const float v = fmaxf(acc[mi][ni][i], 0.f); acc[mi][ni][i] = v * v; }
  bf16_t* sT = (bf16_t*)smem;
  stage_tile(sT, acc, wm, wn, lr, lh);
  __syncthreads();
  tile_writeout(p.A2() + (size_t)m0 * 4096 + n0, 4096, sT);
}

DI float skinny_dot(const bf16_t* __restrict__ A, int lda, const bf16_t* __restrict__ Wt, int K, int r0, int c0, char* smem) {
  float* sR = (float*)smem;
  const int tid = tidx(), lane = tid & 63, w = __builtin_amdgcn_readfirstlane(tid >> 6), r = lane & 15, quad = lane >> 4;
  const int kq = K >> 2;
  const bf16_t* ap = A + (size_t)(r0 + r) * lda + w * kq + quad * 8;
  const bf16_t* bp = Wt + (size_t)(c0 + r) * K + w * kq + quad * 8;
  f32x4 acc = {0.f, 0.f, 0.f, 0.f};
#pragma unroll 4
  for (int k = 0; k < kq; k += 32) {
    const bf16x8 a = *(const bf16x8*)(ap + k), b = *(const bf16x8*)(bp + k);
    acc = MFMA16(a, b, acc);
  }
  __syncthreads();
#pragma unroll
  for (int j = 0; j < 4; ++j) sR[w * 256 + (quad * 4 + j) * 16 + r] = acc[j];
  __syncthreads();
  return sR[tid] + sR[256 + tid] + sR[512 + tid] + sR[768 + tid];
}
DI void skinny_merge_job(const P& p, int l, int job, char* smem) {
  const int rt = job & 7, ct = job >> 3;
  const int r0 = TP + rt * 16, c0 = ct * 16;
  const bf16_t* wl = p.Wt() + (size_t)l * W_LAYER;
  const float ag = skinny_dot(p.YS(), 1024, wl + WO_GLU + (size_t)1024 * 1024, 1024, r0, c0, smem);
  const float av = skinny_dot(p.YS(), 1024, wl + WO_GLU, 1024, r0, c0, smem);
  const float am = skinny_dot(p.YM(), 1024, wl + WO_MPROJ, 1024, r0, c0, smem);
  const float aa = skinny_dot(p.O(), 1024, wl + WO_ATTNO, 1024, r0, c0, smem);
  const int tid = tidx(), r = r0 + (tid >> 4), c = c0 + (tid & 15);
  const bf16_t* gp = p.G() + (size_t)r * 3072 + c;
  const float v = bf2f(gp[0]) * am + bf2f(gp[1024]) * av * sigm_f(ag) + bf2f(gp[2048]) * aa;
  p.MG()[(size_t)r * 1024 + c] = f2bf(v);
}
DI void skinny_resid_job(const P& p, const bf16_t* A, int lda, const bf16_t* Wt, int K, int job, char* smem) {
  const int rt = job & 7, ct = job >> 3;
  const int r0 = TP + rt * 16, c0 = ct * 16;
  const float v = skinny_dot(A, lda, Wt, K, r0, c0, smem);
  const int tid = tidx();
  p.X()[(size_t)(r0 + (tid >> 4)) * 1024 + c0 + (tid & 15)] += v;
}
DI void skinny_up_job(const P& p, int l, int job, char* smem) {
  const int rt = job & 7, ct = job >> 3;
  const int r0 = TP + rt * 16, c0 = ct * 16;
  const float v = fmaxf(skinny_dot(p.H(), 1024, p.Wt() + (size_t)l * W_LAYER + WO_UP, 1024, r0, c0, smem), 0.f);
  const int tid = tidx();
  p.A2()[(size_t)(r0 + (tid >> 4)) * 4096 + c0 + (tid & 15)] = f2bf(v * v);
}

#define XB_TMO      128
#define XB_XCNT(j)  (256  + 64 * (j))
#define XB_XSUB(j)  (1280 + 64 * (j))
#define XB_XGEN(j)  (2304 + 64 * (j))
#define XB_TOP      3328
#define XB_TOPGEN   3392
#define XCD_BAR_WORDS 3456
#define XB_SPIN_CAP (1u << 20)
#define LAS __attribute__((address_space(3)))
DI unsigned xb_ld(unsigned* p) { return __hip_atomic_load(p, __ATOMIC_RELAXED, __HIP_MEMORY_SCOPE_AGENT); }
DI unsigned xb_add(unsigned* p, unsigned v) { return __hip_atomic_fetch_add(p, v, __ATOMIC_RELAXED, __HIP_MEMORY_SCOPE_AGENT); }
DI unsigned xb_xcc_id() { return (unsigned)__builtin_amdgcn_s_getreg((3 << 11) | 20) & 0xFu; }
#define XB_SPIN(cond, bar) do { unsigned _sp = 0; while (cond) { __builtin_amdgcn_s_sleep(1); \
    if ((++_sp & 255u) == 0u) { if (xb_ld(&(bar)[XB_TMO])) break; if (_sp > XB_SPIN_CAP) { atomicAdd(&(bar)[XB_TMO], 1u); break; } } } } while (0)
struct XcdBarrier { unsigned* bar; unsigned x; volatile LAS unsigned* st; };
DI XcdBarrier xcd_barrier_post(unsigned* bar, volatile LAS unsigned* st) {
  XcdBarrier b; b.bar = bar; b.x = xb_xcc_id(); b.st = st;
  if (threadIdx.x == 0) (void)xb_add(&bar[XB_XCNT(b.x)], 1u);
  return b;
}
DI void xcd_barrier_complete(unsigned* bar, unsigned x, unsigned& nloc, unsigned& nx) {
  const unsigned G = gridDim.x * gridDim.y * gridDim.z;
  unsigned sum, cnt, mine, sp = 0u;
  for (;;) {
    sum = 0u; cnt = 0u; mine = 0u;
#pragma unroll
    for (unsigned j = 0; j < 16; ++j) { const unsigned c = xb_ld(&bar[XB_XCNT(j)]); sum += c; cnt += (c > 0u) ? 1u : 0u; mine = (j == x) ? c : mine; }
    if (sum == G) break;
    __builtin_amdgcn_s_sleep(1);
    if ((++sp & 255u) == 0u) { if (xb_ld(&bar[XB_TMO])) break; if (sp > XB_SPIN_CAP) { atomicAdd(&bar[XB_TMO], 1u); break; } }
  }
  nloc = mine > 0u ? mine : 1u; nx = cnt > 0u ? cnt : 1u;
}
DI void xcd_barrier(const XcdBarrier& b) {
  asm volatile("s_waitcnt vmcnt(0)" ::: "memory");
  __syncthreads();
  if (threadIdx.x == 0) {
    unsigned* bar = b.bar;
    __builtin_amdgcn_s_waitcnt(0);
    unsigned nloc = b.st[0], nx = b.st[1];
    if (nloc == 0u) { xcd_barrier_complete(bar, b.x, nloc, nx); b.st[0] = nloc; b.st[1] = nx; }
    const unsigned old = xb_add(&bar[XB_XSUB(b.x)], 1u);
    const unsigned gen = old / nloc;
    if (old + 1u == (gen + 1u) * nloc) {
      __builtin_amdgcn_fence(__ATOMIC_RELEASE, "agent");
      asm volatile("s_waitcnt vmcnt(0)" ::: "memory");
      const unsigned og = xb_add(&bar[XB_TOP], 1u);
      const unsigned tg = og / nx;
      if (og + 1u == (tg + 1u) * nx) xb_add(&bar[XB_TOPGEN], 1u);
      else XB_SPIN(xb_ld(&bar[XB_TOPGEN]) == tg, bar);
      __builtin_amdgcn_fence(__ATOMIC_ACQUIRE, "agent");
      xb_add(&bar[XB_XGEN(b.x)], 1u);
      asm volatile("s_waitcnt vmcnt(0)" ::: "memory");
    } else {
      XB_SPIN(xb_ld(&bar[XB_XGEN(b.x)]) == gen, bar);
      __builtin_amdgcn_fence(__ATOMIC_ACQUIRE, "agent");
      asm volatile("s_waitcnt vmcnt(0)" ::: "memory");
    }
  }
  __syncthreads();
}

constexpr int NPHASE = 1 + 4 * 11;
DI void phase_jobs(int ph, int& nstd, int& nother) {
  nstd = 0;
  if (ph == 0) { nother = 22272 + 64 + 257 + 4128; return; }
  const int s = (ph - 1) % 11;
  switch (s) {
    case 0: nstd = 129 * 35; nother = 0; break;
    case 1: nother = 512 + 512 + 2048 + 4096 + 2048 + 2048; break;
    case 2: nother = 2048; break;
    case 3: nother = 256 + 32; break;
    case 4: nother = 512 + 2048; break;
    case 5: nstd = 512; nother = 512; break;
    case 6: nstd = 512; nother = 512; break;
    case 7: nother = 4128; break;
    case 8: nstd = 2048; nother = 2048; break;
    case 9: nstd = 512; nother = 512; break;
    default: nother = 4128; break;
  }
}
DI void run_std_job(const P& p, int ph, int job, char* smem) {
  const int l = (ph - 1) / 11, s = (ph - 1) % 11;
  const bf16_t* wl = p.Wt() + (size_t)l * W_LAYER;
  switch (s) {
    case 0: inproj_job(p, l, job, smem); break;
    case 5: merge_job(p, l, job, smem); break;
    case 6: resid_gemm_job(p, p.MG(), 1024, wl + WO_WOUT, 1024, job, smem); break;
    case 8: up_job(p, l, job, smem); break;
    default: resid_gemm_job(p, p.A2(), 4096, wl + WO_DOWN, 4096, job, smem); break;
  }
}
DI void run_job(const P& p, int ph, int job, char* smem) {
  if (ph == 0) {
    if (job < 22272) { prep_weight_job(p, job, smem); return; }
    job -= 22272;
    if (job < 64) { prep_s5_job(p, job); return; }
    job -= 64;
    if (job < 257) { prep_rope_job(p, job); return; }
    job -= 257;
    norm_job(p, job, p.norm1_w, true, false);
    return;
  }
  const int l = (ph - 1) / 11, s = (ph - 1) % 11;
  const bf16_t* wl = p.Wt() + (size_t)l * W_LAYER;
  const int w = __builtin_amdgcn_readfirstlane(tidx() >> 6);
  switch (s) {
    case 1:
      if (job < 512) { for (int rr = 0; rr < (PROBE_DUP == 11 ? 3 : 1); ++rr) ssd_sample_job(p, l, job, smem); break; }
      job -= 512;
      if (job < 512) { attn_sample_job(p, l, job, smem); break; }
      job -= 512;
      if (job < 2048) { for (int rr = 0; rr < (PROBE_DUP == 8 ? 3 : 1); ++rr) attn_prompt_job(p, l, job, smem); break; }
      job -= 2048;
      if (job < 4096) { for (int rr = 0; rr < (PROBE_DUP == 9 ? 3 : 1); ++rr) conv_job(p, l, job, smem); break; }
      job -= 4096;
      if (job < 2048) { const int wj = job * 4 + w; s5_wave_job(p, l, 0, wj >> 12, wj & 63, ((wj >> 6) & 63) * 2, 2, nullptr); break; }
      job -= 2048;
      { const int wj = job * 4 + w; __syncthreads(); s5_wave_job(p, l, 2, wj >> 6, wj & 63, 0, 1, (bf16_t*)smem + w * 64 * 136); }
      break;
    case 2: ssd_a_job(p, l, job, smem); break;
    case 3:
      if (job < 256) ssd_scan_job(p, l, job);
      else s5_scan_job(p, l, job - 256);
      break;
    case 4:
      if (job < 512) { for (int rr = 0; rr < (PROBE_DUP == 16 ? 3 : 1); ++rr) ssd_c_job(p, l, job, smem); break; }
      job -= 512;
      { const int wj = job * 4 + w; __syncthreads(); s5_wave_job(p, l, 1, wj >> 12, wj & 63, ((wj >> 6) & 63) * 2, 2, (bf16_t*)smem + w * 64 * 136); }
      break;
    case 5: skinny_merge_job(p, l, job, smem); break;
    case 6: skinny_resid_job(p, p.MG(), 1024, wl + WO_WOUT, 1024, job, smem); break;
    case 7: norm_job(p, job, p.norm2_w + l * 1024, false, false); break;
    case 8: skinny_up_job(p, l, job, smem); break;
    case 9: skinny_resid_job(p, p.A2(), 4096, wl + WO_DOWN, 4096, job, smem); break;
    default:
      if (l == 3) norm_job(p, job, p.final_w, false, true);
      else norm_job(p, job, p.norm1_w + (l + 1) * 1024, false, false);
      break;
  }
}

template <bool COOP>
__global__ void __launch_bounds__(256, 2) mega(P p, int ph0, int ph1) {
  __shared__ __attribute__((aligned(16))) char smem[SMEM_BYTES];
  __shared__ uint4 xb_words;
  XcdBarrier xb;
  if (COOP) {
    if (threadIdx.x == 0) xb_words = make_uint4(0u, 0u, 0u, 0u);
    __syncthreads();
    xb = xcd_barrier_post((unsigned*)(p.ws + WS_BAR), (volatile LAS unsigned*)&xb_words);
  }
  const int G = (int)gridDim.x;
  for (int ph = ph0; ph < ph1; ++ph) {
    int nstd, nother;
    phase_jobs(ph, nstd, nother);
    int reps = 1;
#if PROBE_DUP
    { const int s_ = (ph == 0) ? -1 : (ph - 1) % 11;
      if (PROBE_DUP == 1 && (s_ == 0 || s_ == 5 || s_ == 8)) reps = 2;
      if (PROBE_DUP == 2 && (s_ == 1 || s_ == 2 || s_ == 4)) reps = 2;
      if (PROBE_DUP == 6 && s_ == 4) reps = 2;
      if (PROBE_DUP == 13 && s_ == 8) reps = 2;
      if (PROBE_DUP == 14 && s_ == 2) reps = 3;
      if (PROBE_DUP == 15 && (s_ == 6 || s_ == 9)) reps = 1;
      if (PROBE_DUP == 7 && s_ == 1) reps = 2; }
#endif
    const int nstd_r = ((nstd + G - 1) / G) * G;
    for (int rep = 0; rep < reps; ++rep) {
      for (int job = blockIdx.x; job < nstd_r; job += G) run_std_job(p, ph, job, smem);
      for (int job = blockIdx.x; job < nother; job += G) run_job(p, ph, job, smem);
    }
    if (COOP && ph + 1 < ph1) {
      if (ph == ph0) cg::this_grid().sync();
      else xcd_barrier(xb);
    }
  }
}


extern "C" void kernel_launch(void* const* d_in, const int* in_sizes, int n_in, void* d_out, int out_size, void* d_ws, size_t ws_size,
                              hipStream_t stream) {
  P p{};
  const float** pin = (const float**)&p;
  for (int i = 0; i < 33; ++i) pin[i] = (const float*)d_in[i];
  p.out = (float*)d_out;
  p.ws = (char*)d_ws;
  if (WS_TOTAL > ws_size) { fprintf(stderr, "workspace too small: need %zu have %zu\n", (size_t)WS_TOTAL, ws_size); return; }

#if COOP_MODE
  static int grid_blocks = 0;
  if (!grid_blocks) {
    int dev = 0, cus = 0, per_cu = 0;
    hipGetDevice(&dev);
    hipDeviceGetAttribute(&cus, hipDeviceAttributeMultiprocessorCount, dev);
    hipOccupancyMaxActiveBlocksPerMultiprocessor(&per_cu, mega<true>, 256, 0);
    if (per_cu > 2) per_cu = 2;
    if (per_cu < 1) per_cu = 1;
    grid_blocks = cus * per_cu;
  }
  (void)hipMemsetAsync(p.ws + WS_BAR, 0, 4096 * 4, stream);
  int ph0 = 0, ph1 = NPHASE;
  void* args[] = {&p, &ph0, &ph1};
  hipError_t e = hipLaunchCooperativeKernel((void*)mega<true>, dim3(grid_blocks), dim3(256), args, 0, stream);
  if (e != hipSuccess) fprintf(stderr, "cooperative launch failed: %s (grid %d)\n", hipGetErrorString(e), grid_blocks);
#else
  for (int ph = 0; ph < NPHASE; ++ph) mega<false><<<dim3(1024), dim3(256), 0, stream>>>(p, ph, ph + 1);
#endif
}
```

```cpp
#include <hip/hip_runtime.h>
#include <hip/hip_cooperative_groups.h>
#include <cstdio>
#include <cstdint>
namespace cg = cooperative_groups;

#define DI __device__ __forceinline__
typedef unsigned short bf16_t;
typedef short bf16x8 __attribute__((ext_vector_type(8)));
typedef float f32x16 __attribute__((ext_vector_type(16)));
typedef float f32x4 __attribute__((ext_vector_type(4)));
#define MFMA32(a, b, c) __builtin_amdgcn_mfma_f32_32x32x16_bf16((a), (b), (c), 0, 0, 0)
#define MFMA16(a, b, c) __builtin_amdgcn_mfma_f32_16x16x32_bf16((a), (b), (c), 0, 0, 0)

#ifndef COOP_MODE
#define COOP_MODE 1
#endif
#ifndef PROBE_DUP
#define PROBE_DUP 0
#endif

constexpr int TP = 16384, TS = 128, T = TP + TS, SEQ = 8192;
constexpr int NIN = 8720, NINP = 8960;
constexpr int SMEM_BYTES = 73728;
constexpr float EPS = 1e-6f;

constexpr size_t OFF_YP = 0;
constexpr size_t OFF_YS = OFF_YP + (size_t)TP * 1024;
constexpr size_t OFF_SSMP = OFF_YS + (size_t)TS * 1024;
constexpr size_t OFF_SSMS = OFF_SSMP + (size_t)4 * 2 * 16 * 64 * 128;
constexpr size_t OFF_CONVP = OFF_SSMS + (size_t)4 * 128 * 16 * 64 * 128;
constexpr size_t OFF_CONVS = OFF_CONVP + (size_t)4 * 2 * 3 * 2048;
constexpr size_t OFF_S5RP = OFF_CONVS + (size_t)4 * 128 * 3 * 2048;
constexpr size_t OFF_S5RS = OFF_S5RP + (size_t)4 * 2 * 64 * 64;
constexpr size_t OFF_S5IP = OFF_S5RS + (size_t)4 * 128 * 64 * 64;
constexpr size_t OFF_S5IS = OFF_S5IP + (size_t)4 * 2 * 64 * 64;
constexpr size_t OFF_KP = OFF_S5IS + (size_t)4 * 128 * 64 * 64;
constexpr size_t OFF_KS = OFF_KP + (size_t)4 * 2 * 128 * 256;
constexpr size_t OFF_VP = OFF_KS + (size_t)4 * 128 * 128 * 256;
constexpr size_t OFF_VS = OFF_VP + (size_t)4 * 2 * 128 * 256;

constexpr size_t WO_IN = 0;
constexpr size_t WO_MPROJ = WO_IN + (size_t)NINP * 1024;
constexpr size_t WO_GLU = WO_MPROJ + (size_t)1024 * 1024;
constexpr size_t WO_ATTNO = WO_GLU + (size_t)2048 * 1024;
constexpr size_t WO_WOUT = WO_ATTNO + (size_t)1024 * 1024;
constexpr size_t WO_UP = WO_WOUT + (size_t)1024 * 1024;
constexpr size_t WO_DOWN = WO_UP + (size_t)4096 * 1024;
constexpr size_t W_LAYER = WO_DOWN + (size_t)4096 * 1024;

constexpr size_t al256(size_t x) { return (x + 255) & ~(size_t)255; }
constexpr size_t SZ1 = (size_t)T * 1024 * 2;
constexpr size_t WS_X = 0;
constexpr size_t WS_H = WS_X + al256((size_t)T * 1024 * 4);
constexpr size_t WS_Z = WS_H + al256(SZ1);
constexpr size_t WS_U = WS_Z + al256(SZ1);
constexpr size_t WS_Q = WS_U + al256(SZ1);
constexpr size_t WS_YM = WS_Q + al256(SZ1);
constexpr size_t WS_YS = WS_YM + al256(SZ1);
constexpr size_t WS_O = WS_YS + al256(SZ1);
constexpr size_t WS_MG = WS_O + al256(SZ1);
constexpr size_t WS_XBC = WS_MG + al256(SZ1);
constexpr size_t WS_XBT = WS_XBC + al256((size_t)T * 2048 * 2);
constexpr size_t WS_BC = WS_XBT + al256((size_t)1536 * TP * 2);
constexpr size_t WS_A2END = WS_XBC + al256((size_t)T * 4096 * 2);
constexpr size_t WS_BCEND = WS_BC + al256((size_t)TP * 1024 * 2);
constexpr size_t WS_K = WS_A2END > WS_BCEND ? WS_A2END : WS_BCEND;
constexpr size_t WS_VT = WS_K + al256((size_t)T * 256 * 2);
constexpr size_t WS_G = WS_VT + al256((size_t)T * 256 * 2);
constexpr size_t WS_DT = WS_G + al256((size_t)T * 3072 * 2);
constexpr size_t WS_ST = WS_DT + al256((size_t)T * 16 * 4);
constexpr size_t WS_CDEC = WS_ST + al256((size_t)2 * 64 * 16 * 64 * 128 * 4);
constexpr size_t WS_S5S = WS_CDEC + al256((size_t)2 * 64 * 16 * 4);
constexpr size_t WS_S5P = WS_S5S + al256((size_t)2 * 128 * 64 * 64 * 2 * 4);
constexpr size_t WS_ROPE = WS_S5P + al256((size_t)4 * 64 * 36 * 64 * 4);
constexpr size_t WS_WT = WS_ROPE + al256((size_t)8193 * 8 * 8);
constexpr size_t WS_BAR = WS_WT + al256((size_t)4 * W_LAYER * 2);
constexpr size_t WS_HP = WS_BAR + al256(4096 * 4);
constexpr size_t WS_BBT = WS_HP + al256((size_t)2 * 64 * 16 * 64 * 128 * 2);
constexpr size_t WS_TOTAL = WS_BBT + al256((size_t)4 * 64 * 128 * 16 * 2);

struct P {
  const float *x_prompt, *x_sample, *state_ssm, *state_conv, *s5_sre, *s5_sim, *cache_k, *cache_v;
  const float *norm1_w, *w_in, *conv_w, *conv_b, *dt_bias, *a_log, *m_d, *m_norm_w, *m_proj;
  const float *lam_re, *lam_im, *log_step, *b_re, *b_im, *c_re, *c_im, *s5_d, *glu_w;
  const float *sinks, *attn_o, *w_out, *norm2_w, *mlp_up, *mlp_down, *final_w;
  float* out;
  char* ws;
#define WSACC(name, type, off) __device__ __forceinline__ type* name() const { return (type*)(ws + (off)); }
  WSACC(X, float, WS_X) WSACC(H, bf16_t, WS_H) WSACC(Z, bf16_t, WS_Z) WSACC(U, bf16_t, WS_U) WSACC(Q, bf16_t, WS_Q)
  WSACC(YM, bf16_t, WS_YM) WSACC(YS, bf16_t, WS_YS) WSACC(O, bf16_t, WS_O) WSACC(MG, bf16_t, WS_MG)
  WSACC(XBC, bf16_t, WS_XBC) WSACC(XBT, bf16_t, WS_XBT) WSACC(BC, bf16_t, WS_BC) WSACC(A2, bf16_t, WS_XBC)
  WSACC(K, bf16_t, WS_K) WSACC(VT, bf16_t, WS_VT) WSACC(G, bf16_t, WS_G) WSACC(DT, float, WS_DT) WSACC(ST, float, WS_ST)
  WSACC(CDEC, float, WS_CDEC) WSACC(HP, bf16_t, WS_HP) WSACC(BBT, bf16_t, WS_BBT) WSACC(S5S, float, WS_S5S) WSACC(S5P, float, WS_S5P) WSACC(ROPE, float2, WS_ROPE) WSACC(Wt, bf16_t, WS_WT)
#undef WSACC
};

typedef float f32x2_t __attribute__((ext_vector_type(2)));
typedef __bf16 bf16x2_t __attribute__((ext_vector_type(2)));
DI unsigned pack2(float a, float b) { const f32x2_t v = {a, b}; return __builtin_bit_cast(unsigned, __builtin_convertvector(v, bf16x2_t)); }
DI bf16_t f2bf(float x) { return (bf16_t)(pack2(x, 0.f) & 0xffffu); }
DI float bf2f(bf16_t b) { return __uint_as_float(((unsigned)b) << 16); }
DI float bflo(unsigned u) { return __uint_as_float(u << 16); }
DI float bfhi(unsigned u) { return __uint_as_float(u & 0xffff0000u); }
DI float frcp(float x) { return __builtin_amdgcn_rcpf(x); }
DI float silu_f(float x) { return x * frcp(1.f + __expf(-x)); }
DI float sigm_f(float x) { return frcp(1.f + __expf(-x)); }
DI float softplus_f(float x) { return x > 20.f ? x : log1pf(expf(x)); }
DI float gelu_tanh(float x) { float y = 0.7978845608028654f * (x + 0.044715f * x * x * x); float t = 1.f - 2.f * frcp(__expf(2.f * y) + 1.f); return 0.5f * x * (1.f + t); }
DI int crow(int i, int lh) { return (i & 3) + 8 * (i >> 2) + 4 * lh; }
DI int launder(int x) { asm volatile("" : "+v"(x)); return x; }
DI int tidx() { int t = __builtin_amdgcn_workitem_id_x(); asm volatile("" : "+v"(t)); return t; }
DI int launder_s(int x) { asm volatile("" : "+s"(x)); return x; }
DI float wave_sum(float v) {
#pragma unroll
  for (int o = 32; o >= 1; o >>= 1) v += __shfl_xor(v, o);
  return v;
}
DI float wave_max(float v) {
#pragma unroll
  for (int o = 32; o >= 1; o >>= 1) v = fmaxf(v, __shfl_xor(v, o));
  return v;
}
DI bf16x8 u4_to_bf8(uint4 v) { return __builtin_bit_cast(bf16x8, v); }
DI void zero16(f32x16& a) {
#pragma unroll
  for (int i = 0; i < 16; ++i) a[i] = 0.f;
}

constexpr int LDT = 40;
constexpr int GNB = 4;
DI void gemm_mainloop(const bf16_t* __restrict__ A, int lda, const bf16_t* __restrict__ B, int ldb, int K,
                      f32x16 (&acc)[2][GNB], char* smem) {
  bf16_t* sa = (bf16_t*)smem;
  bf16_t* sb = sa + 2 * 128 * LDT;
  const int tid = tidx(), lane = tid & 63, w = __builtin_amdgcn_readfirstlane(tid >> 6), wm = w & 1, wn = w >> 1, lr = lane & 31, lh = lane >> 5;
  const int r0 = tid >> 2, ch = (tid & 3) * 8;
  const bf16_t* ap = A + (size_t)r0 * lda + ch;
  const bf16_t* bp = B + (size_t)r0 * ldb + ch;
  uint4 pa0, pa1, pb0, pb1, pb2, pb3;
  uint4 qa0, qa1, qb0, qb1, qb2, qb3;
#define GLOADS(R, k0)                                                                                      \
  R##a0 = *(const uint4*)(ap + (k0)); R##a1 = *(const uint4*)(ap + (size_t)64 * lda + (k0));               \
  R##b0 = *(const uint4*)(bp + (k0)); R##b1 = *(const uint4*)(bp + (size_t)64 * ldb + (k0));               \
  R##b2 = *(const uint4*)(bp + (size_t)128 * ldb + (k0)); R##b3 = *(const uint4*)(bp + (size_t)192 * ldb + (k0));
#define SSTORES(R, bufi)                                                                                   \
  { bf16_t* da = sa + (bufi)*128 * LDT; bf16_t* db = sb + (bufi)*256 * LDT;                                \
    *(uint4*)(da + (r0)*LDT + ch) = R##a0; *(uint4*)(da + (r0 + 64) * LDT + ch) = R##a1;                   \
    *(uint4*)(db + (r0)*LDT + ch) = R##b0; *(uint4*)(db + (r0 + 64) * LDT + ch) = R##b1;                   \
    *(uint4*)(db + (r0 + 128) * LDT + ch) = R##b2; *(uint4*)(db + (r0 + 192) * LDT + ch) = R##b3; }
#define COMPUTE(bufi)                                                                                      \
  { const bf16_t* ca = sa + (bufi)*128 * LDT + (wm * 64 + lr) * LDT + lh * 8;                              \
    const bf16_t* cb = sb + (bufi)*256 * LDT + (wn * 128 + lr) * LDT + lh * 8;                             \
    _Pragma("unroll") for (int kk = 0; kk < 2; ++kk) {                                                     \
      const bf16x8 af0 = *(const bf16x8*)(ca + kk * 16), af1 = *(const bf16x8*)(ca + 32 * LDT + kk * 16);  \
      _Pragma("unroll") for (int ni = 0; ni < GNB; ++ni) {                                                 \
        const bf16x8 bfr = *(const bf16x8*)(cb + ni * 32 * LDT + kk * 16);                                 \
        acc[0][ni] = MFMA32(af0, bfr, acc[0][ni]); acc[1][ni] = MFMA32(af1, bfr, acc[1][ni]); } } }
  const int nk = K >> 5;
  const int klast = (nk - 1) * 32;
  GLOADS(p, 0)
  __syncthreads();
  SSTORES(p, 0)
  GLOADS(p, 32)
  __syncthreads();
  for (int kt = 0; kt < nk; kt += 2) {
    { const int k2 = (kt + 2) * 32; const int k0 = k2 < klast ? k2 : klast; GLOADS(q, k0) }
    COMPUTE(0)
    SSTORES(p, 1)
    __syncthreads();
    { const int k3 = (kt + 3) * 32; const int k0 = k3 < klast ? k3 : klast; GLOADS(p, k0) }
    COMPUTE(1)
    SSTORES(q, 0)
    __syncthreads();
  }
#undef GLOADS
#undef SSTORES
#undef COMPUTE
}
DI bool gemm_tile(int slot, int MT, int NT, int& mt, int& nt) {
  const int G = gridDim.x, nx = G >> 3;
  int J = slot;
  if ((G & 7) == 0) J = (slot / G) * G + (slot & 7) * nx + ((slot % G) >> 3);
  if (J >= MT * NT) return false;
  const int gw = 8 * NT, grp = J / gw, rem = J - grp * gw, fm = grp * 8;
  const int gsz = (MT - fm) < 8 ? (MT - fm) : 8;
  mt = fm + rem % gsz; nt = rem / gsz;
  return true;
}

DI int win_map(int n) {
  if (n < 3072) return n;
  if (n < 8704) return n + 16;
  if (n < 8720) return n - 8704 + 3072;
  return -1;
}
DI void wtrans_tile(const float* __restrict__ src, int N, int K, bf16_t* __restrict__ dst, int kt, int nt, bool inmap, char* smem) {
  float* s = (float*)smem;
  const int tid = tidx();
  __syncthreads();
  {
    const int n4 = (tid & 15) * 4;
    int sc = nt * 64 + n4;
    if (inmap) sc = win_map(sc);
#pragma unroll
    for (int ps = 0; ps < 4; ++ps) {
      const int kk = (tid >> 4) + 16 * ps;
      float4 v = make_float4(0.f, 0.f, 0.f, 0.f);
      if (sc >= 0) v = *(const float4*)(src + (size_t)(kt * 64 + kk) * N + sc);
      float* d = s + kk * 65 + n4;
      d[0] = v.x; d[1] = v.y; d[2] = v.z; d[3] = v.w;
    }
  }
  __syncthreads();
  {
    const int n2 = tid >> 2, kq = (tid & 3) * 16;
    unsigned w[8];
#pragma unroll
    for (int j = 0; j < 8; ++j) w[j] = pack2(s[(kq + 2 * j) * 65 + n2], s[(kq + 2 * j + 1) * 65 + n2]);
    uint4* d = (uint4*)(dst + (size_t)(nt * 64 + n2) * K + kt * 64 + kq);
    d[0] = make_uint4(w[0], w[1], w[2], w[3]);
    d[1] = make_uint4(w[4], w[5], w[6], w[7]);
  }
}
DI void prep_weight_job(const P& p, int j, char* smem) {
  const int l = j / 5568; int r = j % 5568;
  bf16_t* wl = p.Wt() + (size_t)l * W_LAYER;
  if (r < 2240) { wtrans_tile(p.w_in + (size_t)l * 1024 * NIN, NIN, 1024, wl + WO_IN, r / 140, r % 140, true, smem); return; }
  r -= 2240;
  if (r < 256) { wtrans_tile(p.m_proj + (size_t)l * 1024 * 1024, 1024, 1024, wl + WO_MPROJ, r / 16, r % 16, false, smem); return; }
  r -= 256;
  if (r < 512) { wtrans_tile(p.glu_w + (size_t)l * 1024 * 2048, 2048, 1024, wl + WO_GLU, r / 32, r % 32, false, smem); return; }
  r -= 512;
  if (r < 256) { wtrans_tile(p.attn_o + (size_t)l * 1024 * 1024, 1024, 1024, wl + WO_ATTNO, r / 16, r % 16, false, smem); return; }
  r -= 256;
  if (r < 256) { wtrans_tile(p.w_out + (size_t)l * 1024 * 1024, 1024, 1024, wl + WO_WOUT, r / 16, r % 16, false, smem); return; }
  r -= 256;
  if (r < 1024) { wtrans_tile(p.mlp_up + (size_t)l * 1024 * 4096, 4096, 1024, wl + WO_UP, r / 64, r % 64, false, smem); return; }
  r -= 1024;
  wtrans_tile(p.mlp_down + (size_t)l * 4096 * 1024, 1024, 4096, wl + WO_DOWN, r / 16, r % 16, false, smem);
}
DI void prep_s5_job(const P& p, int j) {
  const int idx = j * 256 + tidx();
  const int n = idx & 63, g = (idx >> 6) & 63, l = idx >> 12;
  const float step = expf(p.log_step[l * 64 + g]);
  const float lr_ = p.lam_re[(l * 64 + g) * 64 + n], li = p.lam_im[(l * 64 + g) * 64 + n];
  const float mag = expf(lr_ * step);
  const float abr = mag * cosf(li * step), abi = mag * sinf(li * step);
  float aqr = abr, aqi = abi;
#pragma unroll
  for (int q = 0; q < 6; ++q) { const float nr2 = aqr * aqr - aqi * aqi, ni2 = 2.f * aqr * aqi; aqr = nr2; aqi = ni2; }
  const float den = lr_ * lr_ + li * li;
  const float nr = abr - 1.0f, ni = abi;
  const float fre = (nr * lr_ + ni * li) / den, fim = (ni * lr_ - nr * li) / den;
  float* o = p.S5P() + ((size_t)(l * 64 + g) * 36) * 64 + n;
  o[0] = abr; o[64] = abi; o[128] = aqr; o[192] = aqi;
  const float* br = p.b_re + ((size_t)(l * 64 + g) * 64 + n) * 16;
  const float* bi = p.b_im + ((size_t)(l * 64 + g) * 64 + n) * 16;
  float vre[16], vim[16];
#pragma unroll
  for (int i = 0; i < 16; ++i) {
    const float b_r = br[i], b_i = bi[i];
    vre[i] = fre * b_r - fim * b_i;
    vim[i] = fre * b_i + fim * b_r;
    o[(4 + i) * 64] = vre[i];
    o[(20 + i) * 64] = vim[i];
  }
  uint4* bt = (uint4*)(p.BBT() + ((size_t)(l * 64 + g) * 128 + n) * 16);
  bt[0] = make_uint4(pack2(vre[0], vre[1]), pack2(vre[2], vre[3]), pack2(vre[4], vre[5]), pack2(vre[6], vre[7]));
  bt[1] = make_uint4(pack2(vre[8], vre[9]), pack2(vre[10], vre[11]), pack2(vre[12], vre[13]), pack2(vre[14], vre[15]));
  bt[128] = make_uint4(pack2(vim[0], vim[1]), pack2(vim[2], vim[3]), pack2(vim[4], vim[5]), pack2(vim[6], vim[7]));
  bt[129] = make_uint4(pack2(vim[8], vim[9]), pack2(vim[10], vim[11]), pack2(vim[12], vim[13]), pack2(vim[14], vim[15]));
}
DI void prep_rope_job(const P& p, int j) {
  const int idx = j * 256 + tidx();
  if (idx >= 8193 * 8) return;
  const int pos = idx >> 3, f = idx & 7;
  const float invf = expf(-(2.0f * (float)f / 16.0f) * logf(500000.0f));
  const float ang = (float)pos * invf;
  p.ROPE()[idx] = make_float2(cosf(ang), sinf(ang));
}

DI void norm_job(const P& p, int job, const float* wgt, bool layer0, bool final_) {
  const int w = __builtin_amdgcn_readfirstlane(tidx() >> 6), lane = tidx() & 63;
  const int r = job * 4 + w;
  const float* src = layer0 ? (r < TP ? p.x_prompt + (size_t)r * 1024 : p.x_sample + (size_t)(r - TP) * 1024) : p.X() + (size_t)r * 1024;
  float4 v[4];
  float ss = 0.f;
#pragma unroll
  for (int q = 0; q < 4; ++q) { v[q] = ((const float4*)src)[lane + 64 * q]; ss += v[q].x * v[q].x + v[q].y * v[q].y + v[q].z * v[q].z + v[q].w * v[q].w; }
  ss = wave_sum(ss);
  const float sc = rsqrtf(ss * (1.f / 1024.f) + EPS);
#pragma unroll
  for (int q = 0; q < 4; ++q) {
    const float4 wv = ((const float4*)wgt)[lane + 64 * q];
    float4 y = make_float4(v[q].x * sc * wv.x, v[q].y * sc * wv.y, v[q].z * sc * wv.z, v[q].w * sc * wv.w);
    if (final_) ((float4*)(p.out + OFF_YP + (size_t)r * 1024))[lane + 64 * q] = y;
    else *(uint2*)(p.H() + (size_t)r * 1024 + (lane + 64 * q) * 4) = make_uint2(pack2(y.x, y.y), pack2(y.z, y.w));
    if (layer0) ((float4*)(p.X() + (size_t)r * 1024))[lane + 64 * q] = v[q];
  }
}

constexpr int LDS_T = 264;
DI void stage_tile(bf16_t* sT, const f32x16 (&acc)[2][GNB], int wm, int wn, int lr, int lh) {
#pragma unroll
  for (int mi = 0; mi < 2; ++mi)
#pragma unroll
    for (int ni = 0; ni < GNB; ++ni) {
      bf16_t* d = sT + (wm * 64 + mi * 32 + 4 * lh) * LDS_T + wn * 128 + ni * 32 + lr;
#pragma unroll
      for (int ig = 0; ig < 4; ++ig) {
        const unsigned p01 = pack2(acc[mi][ni][4 * ig], acc[mi][ni][4 * ig + 1]), p23 = pack2(acc[mi][ni][4 * ig + 2], acc[mi][ni][4 * ig + 3]);
        d[(8 * ig) * LDS_T] = (bf16_t)(p01 & 0xffffu); d[(8 * ig + 1) * LDS_T] = (bf16_t)(p01 >> 16);
        d[(8 * ig + 2) * LDS_T] = (bf16_t)(p23 & 0xffffu); d[(8 * ig + 3) * LDS_T] = (bf16_t)(p23 >> 16);
      }
    }
}
DI void tile_writeout(bf16_t* __restrict__ dst, int ld, const bf16_t* sT) {
  const int tid = tidx();
#pragma unroll 4
  for (int it = 0; it < 16; ++it) {
    const int idx = tid + 256 * it, row = idx >> 5, chunk = idx & 31;
    *(uint4*)(dst + (size_t)row * ld + chunk * 8) = *(const uint4*)(sT + row * LDS_T + chunk * 8);
  }
}

DI void inproj_job(const P& p, int l, int job, char* smem) {
  int mt, nt;
  if (!gemm_tile(job, 129, 35, mt, nt)) return;
  int m0 = mt * 128, n0 = nt * 256;
  f32x16 acc[2][GNB];
#pragma unroll
  for (int a = 0; a < 2; ++a)
#pragma unroll
    for (int b = 0; b < GNB; ++b) zero16(acc[a][b]);
  gemm_mainloop(p.H() + (size_t)m0 * 1024, 1024, p.Wt() + (size_t)l * W_LAYER + WO_IN + (size_t)n0 * 1024, 1024, 1024, acc, smem);
  m0 = launder_s(m0); n0 = launder_s(n0);
  nt = launder_s(nt); mt = launder_s(mt);
  const int tid = tidx(), lane = tid & 63, w = __builtin_amdgcn_readfirstlane(tid >> 6), wm = w & 1, wn = w >> 1, lr = lane & 31, lh = lane >> 5;
  bf16_t* sT = (bf16_t*)smem;
  if (nt == 34) {
    if (wn == 0 && lr < 16) {
      const float bias = p.dt_bias[l * 16 + lr];
#pragma unroll
      for (int mi = 0; mi < 2; ++mi)
#pragma unroll
        for (int i = 0; i < 16; ++i) p.DT()[(size_t)(m0 + wm * 64 + mi * 32 + crow(i, lh)) * 16 + lr] = softplus_f(acc[mi][0][i] + bias);
    }
    return;
  }
  if (nt >= 16 && nt <= 20) {
#pragma unroll
    for (int mi = 0; mi < 2; ++mi)
#pragma unroll
      for (int ni = 0; ni < GNB; ni += 2)
#pragma unroll
        for (int i = 0; i < 16; ++i) {
          const float v = acc[mi][ni][i];
          const float pv = __shfl_xor(v, 8);
          if (lr < 16) {
            const int r = m0 + wm * 64 + mi * 32 + crow(i, lh);
            const int pos = (r >= TP) ? 8192 : (r & 8191);
            const float2 cs = p.ROPE()[pos * 8 + (lr & 7)];
            acc[mi][ni][i] = (lr < 8) ? v * cs.x - pv * cs.y : v * cs.x + pv * cs.y;
          }
        }
  }
  if (nt >= 22) {
#pragma unroll
    for (int mi = 0; mi < 2; ++mi)
#pragma unroll
      for (int ni = 0; ni < GNB; ++ni)
#pragma unroll
        for (int i = 0; i < 16; ++i) acc[mi][ni][i] = sigm_f(acc[mi][ni][i]);
  }
  if ((mt == 63 || mt == 127 || mt == 128) && ((nt >= 4 && nt < 12) || nt == 20 || nt == 21)) {
#pragma unroll
    for (int mi = 0; mi < 2; ++mi)
#pragma unroll
      for (int ni = 0; ni < GNB; ++ni) {
        const int cc = (n0 & 255) + wn * 128 + ni * 32 + lr;
        const int rb_ = launder(m0 + wm * 64 + mi * 32 + 4 * lh);
#pragma unroll
        for (int i = 0; i < 16; ++i) {
          const int r = rb_ + (i & 3) + 8 * (i >> 2);
          const float v = acc[mi][ni][i];
          if (nt < 12) {
            const int ch = (n0 - 1024) + cc;
            if (r >= TP) p.out[OFF_CONVS + ((size_t)(l * 128 + (r - TP)) * 3 + 2) * 2048 + ch] = v;
            else { const int t = r & 8191; if (t >= 8189) p.out[OFF_CONVP + ((size_t)(l * 2 + (r >> 13)) * 3 + (t - 8189)) * 2048 + ch] = v; }
          } else {
            const size_t ob = (nt == 20) ? OFF_KS : OFF_VS, obp = (nt == 20) ? OFF_KP : OFF_VP;
            if (r >= TP) p.out[ob + ((size_t)(l * 128 + (r - TP)) * 128 + 127) * 256 + cc] = v;
            else p.out[obp + ((size_t)(l * 2 + (r >> 13)) * 128 + ((r & 8191) - 8064)) * 256 + cc] = v;
          }
        }
        __builtin_amdgcn_sched_barrier(0);
      }
  }
  if (nt == 21) {
#pragma unroll
    for (int mi = 0; mi < 2; ++mi)
#pragma unroll
      for (int ni = 0; ni < GNB; ++ni) {
        bf16_t* d = sT + (wn * 128 + ni * 32 + lr) * 136 + wm * 64 + mi * 32 + 4 * lh;
#pragma unroll
        for (int ig = 0; ig < 4; ++ig)
          *(uint2*)(d + 8 * ig) = make_uint2(pack2(acc[mi][ni][4 * ig], acc[mi][ni][4 * ig + 1]), pack2(acc[mi][ni][4 * ig + 2], acc[mi][ni][4 * ig + 3]));
      }
    __syncthreads();
#pragma unroll 4
    for (int it = 0; it < 16; ++it) {
      const int idx = tid + 256 * it, c = idx >> 4, chunk = idx & 15;
      *(uint4*)(p.VT() + (size_t)c * T + m0 + chunk * 8) = *(const uint4*)(sT + c * 136 + chunk * 8);
    }
    return;
  }
  stage_tile(sT, acc, wm, wn, lr, lh);
  __syncthreads();
  bf16_t* dst; int ld;
  if (nt < 4) { dst = p.Z() + n0; ld = 1024; }
  else if (nt < 12) { dst = p.XBC() + (n0 - 1024); ld = 2048; }
  else if (nt < 16) { dst = p.U() + (n0 - 3072); ld = 1024; }
  else if (nt < 20) { dst = p.Q() + (n0 - 4096); ld = 1024; }
  else if (nt == 20) { dst = p.K(); ld = 256; }
  else { dst = p.G() + (n0 - 5632); ld = 3072; }
  tile_writeout(dst + (size_t)m0 * ld, ld, sT);
}

DI void conv_job(const P& p, int l, int job, char* smem) {
  const int ct = job & 31, tt = job >> 5;
  const int ch0 = ct * 64, tokb = tt * 128;
  bf16_t* sT = (bf16_t*)smem;
  const int tid = tidx();
  const float* cw = p.conv_w + (size_t)l * 4 * 2048;
  __syncthreads();
  const int chk = tid & 7, ch = ch0 + chk * 8;
  float wt[4][8], bs[8];
  {
    const float4 b0 = *(const float4*)(p.conv_b + l * 2048 + ch), b1 = *(const float4*)(p.conv_b + l * 2048 + ch + 4);
    bs[0] = b0.x; bs[1] = b0.y; bs[2] = b0.z; bs[3] = b0.w; bs[4] = b1.x; bs[5] = b1.y; bs[6] = b1.z; bs[7] = b1.w;
#pragma unroll
    for (int j = 0; j < 4; ++j) {
      const float4 w0 = *(const float4*)(cw + j * 2048 + ch), w1 = *(const float4*)(cw + j * 2048 + ch + 4);
      wt[j][0] = w0.x; wt[j][1] = w0.y; wt[j][2] = w0.z; wt[j][3] = w0.w; wt[j][4] = w1.x; wt[j][5] = w1.y; wt[j][6] = w1.z; wt[j][7] = w1.w;
    }
  }
#pragma unroll
  for (int it = 0; it < 4; ++it) {
    const int item = tid + 256 * it, tl = item >> 3, row = tokb + tl, t = row & 8191;
    float a[8];
#pragma unroll
    for (int j = 0; j < 8; ++j) a[j] = bs[j];
#pragma unroll
    for (int j = 0; j < 4; ++j) {
      if (t - 3 + j >= 0) {
        const uint4 rv = *(const uint4*)(p.XBC() + (size_t)(row - 3 + j) * 2048 + ch);
        a[0] += bflo(rv.x) * wt[j][0]; a[1] += bfhi(rv.x) * wt[j][1]; a[2] += bflo(rv.y) * wt[j][2]; a[3] += bfhi(rv.y) * wt[j][3];
        a[4] += bflo(rv.z) * wt[j][4]; a[5] += bfhi(rv.z) * wt[j][5]; a[6] += bflo(rv.w) * wt[j][6]; a[7] += bfhi(rv.w) * wt[j][7];
      }
    }
#pragma unroll
    for (int j = 0; j < 8; ++j) a[j] = silu_f(a[j]);
    if (ct >= 16) *(uint4*)(p.BC() + (size_t)row * 1024 + (ch - 1024)) = make_uint4(pack2(a[0], a[1]), pack2(a[2], a[3]), pack2(a[4], a[5]), pack2(a[6], a[7]));
    if (ct < 24) {
#pragma unroll
      for (int j = 0; j < 8; ++j) sT[(chk * 8 + j) * 136 + (tl ^ (chk << 3))] = f2bf(a[j]);
    }
  }
  if (ct < 24) {
    __syncthreads();
#pragma unroll
    for (int it = 0; it < 4; ++it) {
      const int item = tid + 256 * it, r = item >> 4, chk = item & 15;
      *(uint4*)(p.XBT() + (size_t)(ch0 + r) * TP + tokb + chk * 8) = *(const uint4*)(sT + r * 136 + ((chk ^ (r >> 3)) << 3));
    }
  }
}

DI void chunk_acum(const P& p, int l, int head, int tok0, float* sAc, float* sDt, float& alast) {
  const int lane = tidx() & 63;
  const float Ah = -expf(p.a_log[l * 16 + head]);
  const float d0 = p.DT()[(size_t)(tok0 + 2 * lane) * 16 + head], d1 = p.DT()[(size_t)(tok0 + 2 * lane + 1) * 16 + head];
  const float a0 = d0 * Ah, a1 = d1 * Ah;
  float s = a0 + a1;
#pragma unroll
  for (int off = 1; off < 64; off <<= 1) { const float tv = __shfl_up(s, off); if (lane >= off) s += tv; }
  const float excl = s - (a0 + a1);
  sAc[2 * lane] = excl + a0; sAc[2 * lane + 1] = s;
  sDt[2 * lane] = d0; sDt[2 * lane + 1] = d1;
  alast = __shfl(s, 63);
}

DI void ssd_a_job(const P& p, int l, int job, char* smem) {
  const int head = job & 15, c = (job >> 4) & 63, b = job >> 10, g = head >> 2;
  const int tok0 = b * SEQ + c * 128;
  bf16_t* sXT = (bf16_t*)smem;
  bf16_t* sBT = sXT + 64 * 136;
  float* sW = (float*)(sBT + 128 * 136);
  float* sAc = sW + 128;
  float* sDt = sAc + 128;
  const int tid = tidx(), lane = tid & 63, w = __builtin_amdgcn_readfirstlane(tid >> 6), lr = lane & 31, lh = lane >> 5;
  __syncthreads();
  if (w == 0) {
    float alast;
    chunk_acum(p, l, head, tok0, sAc, sDt, alast);
    sW[2 * lane] = sDt[2 * lane] * __expf(alast - sAc[2 * lane]);
    sW[2 * lane + 1] = sDt[2 * lane + 1] * __expf(alast - sAc[2 * lane + 1]);
    if (lane == 0) p.CDEC()[(b * 64 + c) * 16 + head] = __expf(alast);
  }
  __syncthreads();
#pragma unroll
  for (int it = 0; it < 4; ++it) {
    const int item = tid + 256 * it, pr = item >> 4, s0 = (item & 15) * 8;
    const uint4 v = *(const uint4*)(p.XBT() + (size_t)(head * 64 + pr) * TP + tok0 + s0);
    const float4 w0 = *(const float4*)(sW + s0), w1 = *(const float4*)(sW + s0 + 4);
    *(uint4*)(sXT + pr * 136 + s0) = make_uint4(pack2(bflo(v.x) * w0.x, bfhi(v.x) * w0.y), pack2(bflo(v.y) * w0.z, bfhi(v.y) * w0.w),
                                                pack2(bflo(v.z) * w1.x, bfhi(v.z) * w1.y), pack2(bflo(v.w) * w1.z, bfhi(v.w) * w1.w));
  }
#pragma unroll
  for (int it = 0; it < 8; ++it) {
    const int item = tid + 256 * it, n = item >> 4, s0 = (item & 15) * 8;
    *(uint4*)(sBT + n * 136 + s0) = *(const uint4*)(p.XBT() + (size_t)(1024 + g * 128 + n) * TP + tok0 + s0);
  }
  __syncthreads();
  const int wp = w & 1, wn = w >> 1;
  f32x16 acc[2];
  zero16(acc[0]); zero16(acc[1]);
#pragma unroll
  for (int kk = 0; kk < 8; ++kk) {
    const bf16x8 af = *(const bf16x8*)(sXT + (wp * 32 + lr) * 136 + kk * 16 + lh * 8);
#pragma unroll
    for (int ni = 0; ni < 2; ++ni) {
      const bf16x8 bfr = *(const bf16x8*)(sBT + (wn * 64 + ni * 32 + lr) * 136 + kk * 16 + lh * 8);
      acc[ni] = MFMA32(af, bfr, acc[ni]);
    }
  }
  float* st = p.ST() + ((size_t)((b * 64 + c) * 16 + head) * 64) * 128;
#pragma unroll
  for (int ni = 0; ni < 2; ++ni)
#pragma unroll
    for (int i = 0; i < 16; ++i) st[(wp * 32 + crow(i, lh)) * 128 + wn * 64 + ni * 32 + lr] = acc[ni][i];
}

DI void ssd_scan_job(const P& p, int l, int job) {
  const int gid = job * 256 + tidx();
  const int b = gid >> 15, rem = gid & 32767, head = rem >> 11;
  float4 h = make_float4(0.f, 0.f, 0.f, 0.f);
  const float4* sp0 = (const float4*)(p.ST() + (size_t)(b * 64) * 131072) + rem;
  uint2* hp0 = (uint2*)(p.HP() + (size_t)(b * 64) * 131072) + rem;
  for (int c0 = 0; c0 < 64; c0 += 16) {
    float4 sv[16];
    float dv[16];
#pragma unroll
    for (int k = 0; k < 16; ++k) { sv[k] = sp0[(size_t)(c0 + k) * 32768]; dv[k] = p.CDEC()[(b * 64 + c0 + k) * 16 + head]; }
#pragma unroll
    for (int k = 0; k < 16; ++k) {
      hp0[(size_t)(c0 + k) * 32768] = make_uint2(pack2(h.x, h.y), pack2(h.z, h.w));
      h.x = h.x * dv[k] + sv[k].x; h.y = h.y * dv[k] + sv[k].y; h.z = h.z * dv[k] + sv[k].z; h.w = h.w * dv[k] + sv[k].w;
    }
  }
  ((float4*)(p.out + OFF_SSMP + (size_t)(l * 2 + b) * 131072))[rem] = h;
}

DI void s5_scan_job(const P& p, int l, int job) {
  const int gid = job * 256 + tidx();
  const int n = gid & 63, g = (gid >> 6) & 63, b = gid >> 12;
  const float* prm = p.S5P() + ((size_t)(l * 64 + g) * 36) * 64 + n;
  const float aqr = prm[128], aqi = prm[192];
  float hr = 0.f, hi = 0.f;
  float2* sp = (float2*)p.S5S() + ((size_t)(b * 128) * 64 + g) * 64 + n;
  for (int c0 = 0; c0 < 128; c0 += 8) {
    float2 sv[8];
#pragma unroll
    for (int k = 0; k < 8; ++k) sv[k] = sp[(size_t)(c0 + k) * 4096];
#pragma unroll
    for (int k = 0; k < 8; ++k) {
      sp[(size_t)(c0 + k) * 4096] = make_float2(hr, hi);
      const float nr = aqr * hr - aqi * hi + sv[k].x, ni = aqr * hi + aqi * hr + sv[k].y;
      hr = nr; hi = ni;
    }
  }
}

DI void ssd_c_job(const P& p, int l, int job, char* smem) {
  const int g = job & 3, c = (job >> 2) & 63, b = job >> 8;
  const int tok0 = b * SEQ + c * 128;
  bf16_t* sC = (bf16_t*)smem;
  bf16_t* sB = sC + 128 * 136;
  float* sAc = (float*)(sB + 128 * 136);
  float* sDt = sAc + 512;
  const int tid = tidx(), lane = tid & 63, w = __builtin_amdgcn_readfirstlane(tid >> 6), lr = lane & 31, lh = lane >> 5, wm = w & 1, wn = w >> 1;
  __syncthreads();
  { float alast; chunk_acum(p, l, g * 4 + w, tok0, sAc + w * 128, sDt + w * 128, alast); }
#pragma unroll
  for (int it = 0; it < 8; ++it) {
    const int item = tid + 256 * it, r = item >> 4, s0 = (item & 15) * 8;
    *(uint4*)(sC + r * 136 + s0) = *(const uint4*)(p.BC() + (size_t)(tok0 + r) * 1024 + 512 + g * 128 + s0);
    *(uint4*)(sB + r * 136 + s0) = *(const uint4*)(p.BC() + (size_t)(tok0 + r) * 1024 + g * 128 + s0);
  }
  __syncthreads();
  f32x16 cb[2][2];
#pragma unroll
  for (int a = 0; a < 2; ++a)
#pragma unroll
    for (int bb = 0; bb < 2; ++bb) zero16(cb[a][bb]);
  if (!(wm == 0 && wn == 1)) {
#pragma unroll
    for (int kk = 0; kk < 8; ++kk) {
      bf16x8 af[2], bfr[2];
#pragma unroll
      for (int mi = 0; mi < 2; ++mi) af[mi] = *(const bf16x8*)(sC + (wm * 64 + mi * 32 + lr) * 136 + kk * 16 + lh * 8);
#pragma unroll
      for (int ni = 0; ni < 2; ++ni) bfr[ni] = *(const bf16x8*)(sB + (wn * 64 + ni * 32 + lr) * 136 + kk * 16 + lh * 8);
#pragma unroll
      for (int mi = 0; mi < 2; ++mi)
#pragma unroll
        for (int ni = 0; ni < 2; ++ni) cb[mi][ni] = MFMA32(af[mi], bfr[ni], cb[mi][ni]);
    }
  }
  __syncthreads();
  bf16_t* sM = sB;
  unsigned cbp[2][2][8];
#pragma unroll
  for (int a = 0; a < 2; ++a)
#pragma unroll
    for (int bb = 0; bb < 2; ++bb)
#pragma unroll
      for (int k = 0; k < 8; ++k) cbp[a][bb][k] = pack2(cb[a][bb][2 * k], cb[a][bb][2 * k + 1]);
  float ss[16];
#pragma unroll
  for (int i = 0; i < 16; ++i) ss[i] = 0.f;
#pragma unroll 1
  for (int hd = 0; hd < 4; ++hd) {
    const int head = g * 4 + hd;
    const float* ac = sAc + hd * 128;
    const float* dtv = sDt + hd * 128;
    const int lrq = launder(lr), lhq = launder(lh);
#pragma unroll
    for (int mi = 0; mi < 2; ++mi)
#pragma unroll
      for (int ni = 0; ni < 2; ++ni) {
        const int s = wn * 64 + ni * 32 + lrq;
        const float as = ac[s], ds = dtv[s];
#pragma unroll
        for (int i = 0; i < 16; ++i) {
          const int t = wm * 64 + mi * 32 + crow(i, lhq);
          const float cv = (i & 1) ? bfhi(cbp[mi][ni][i >> 1]) : bflo(cbp[mi][ni][i >> 1]);
          const float v = (s <= t) ? cv * __expf(ac[t] - as) * ds : 0.f;
          sM[t * 136 + s] = f2bf(v);
        }
        __builtin_amdgcn_sched_barrier(0);
      }
    __syncthreads();
    f32x16 yd[2];
    zero16(yd[0]); zero16(yd[1]);
    {
      const bf16_t* hb = p.HP() + (((size_t)((b * 64 + c) * 16 + head) * 64 + lr) * 128 + lh * 8);
      bf16x8 hf[8][2];
#pragma unroll
      for (int kk = 0; kk < 8; ++kk)
#pragma unroll
        for (int pb = 0; pb < 2; ++pb) hf[kk][pb] = *(const bf16x8*)(hb + (size_t)pb * 32 * 128 + kk * 16);
#pragma unroll
      for (int kk = 0; kk < 8; ++kk) {
        const bf16x8 af = *(const bf16x8*)(sC + (32 * w + lr) * 136 + kk * 16 + lh * 8);
        yd[0] = MFMA32(af, hf[kk][0], yd[0]);
        yd[1] = MFMA32(af, hf[kk][1], yd[1]);
      }
    }
#pragma unroll
    for (int i = 0; i < 16; ++i) {
      const float e = __expf(ac[32 * w + crow(i, lh)]);
      yd[0][i] *= e; yd[1][i] *= e;
    }
    {
      const int nkk = 2 * (w + 1);
      const bf16_t* xb = p.XBT() + (size_t)(head * 64 + lr) * TP + tok0 + lh * 8;
      const bf16_t* am = sM + (32 * w + lr) * 136 + lh * 8;
      bf16x8 x00 = *(const bf16x8*)(xb), x01 = *(const bf16x8*)(xb + (size_t)32 * TP);
      for (int kk = 0; kk < nkk; kk += 2) {
        const bf16x8 x10 = *(const bf16x8*)(xb + (kk + 1) * 16), x11 = *(const bf16x8*)(xb + (size_t)32 * TP + (kk + 1) * 16);
        const bf16x8 a0 = *(const bf16x8*)(am + kk * 16);
        yd[0] = MFMA32(a0, x00, yd[0]);
        yd[1] = MFMA32(a0, x01, yd[1]);
        const int kn = (kk + 2 < nkk) ? kk + 2 : kk;
        x00 = *(const bf16x8*)(xb + kn * 16); x01 = *(const bf16x8*)(xb + (size_t)32 * TP + kn * 16);
        const bf16x8 a1 = *(const bf16x8*)(am + (kk + 1) * 16);
        yd[0] = MFMA32(a1, x10, yd[0]);
        yd[1] = MFMA32(a1, x11, yd[1]);
      }
    }
    const float Dh = p.m_d[l * 16 + head];
#pragma unroll
    for (int pb = 0; pb < 2; ++pb) {
      const int pch = head * 64 + pb * 32 + lr;
#pragma unroll
      for (int ig = 0; ig < 4; ++ig) {
        const int t0 = 32 * w + 8 * ig + 4 * lh;
        const uint2 xr = *(const uint2*)(p.XBT() + (size_t)pch * TP + tok0 + t0);
        const float xs[4] = {bflo(xr.x), bfhi(xr.x), bflo(xr.y), bfhi(xr.y)};
#pragma unroll
        for (int jj = 0; jj < 4; ++jj) {
          const int i = 4 * ig + jj, t = t0 + jj;
          const float y = yd[pb][i] + Dh * xs[jj];
          const float z = bf2f(p.Z()[(size_t)(tok0 + t) * 1024 + pch]);
          const float yg = y * silu_f(z);
          ss[i] += yg * yg;
          p.YM()[(size_t)(tok0 + t) * 1024 + pch] = f2bf(yg);
        }
      }
      __builtin_amdgcn_sched_barrier(0);
    }
    __syncthreads();
  }
#pragma unroll
  for (int i = 0; i < 16; ++i) {
    float v = ss[i];
    v += __shfl_xor(v, 1); v += __shfl_xor(v, 2); v += __shfl_xor(v, 4); v += __shfl_xor(v, 8); v += __shfl_xor(v, 16);
    ss[i] = rsqrtf(v * (1.f / 256.f) + EPS);
  }
  for (int hd = 0; hd < 4; ++hd) {
#pragma unroll
    for (int pb = 0; pb < 2; ++pb) {
      const int pch = (g * 4 + hd) * 64 + pb * 32 + lr;
      const float nw = p.m_norm_w[l * 1024 + pch];
#pragma unroll
      for (int i = 0; i < 16; ++i) {
        const size_t idx = (size_t)(tok0 + 32 * w + crow(i, lh)) * 1024 + pch;
        p.YM()[idx] = f2bf(bf2f(p.YM()[idx]) * ss[i] * nw);
      }
      __builtin_amdgcn_sched_barrier(0);
    }
  }
}

DI void ssd_sample_job(const P& p, int l, int job, char* smem) {
  const int g = job & 3, b = job >> 2;
  float* sx = (float*)smem;
  float* sBv = sx + 256;
  float* sCv = sBv + 128;
  float* sY = sCv + 128;
  float* sRed = sY + 256;
  const int tid = tidx(), lane = tid & 63, w = __builtin_amdgcn_readfirstlane(tid >> 6);
  const int row = TP + b;
  __syncthreads();
#pragma unroll
  for (int it = 0; it < 2; ++it) {
    const int idx = tid + 256 * it;
    const int ch = idx < 256 ? g * 256 + idx : (idx < 384 ? 1024 + g * 128 + (idx - 256) : 1536 + g * 128 + (idx - 384));
    const float* sc = p.state_conv + ((size_t)(l * 128 + b) * 3) * 2048 + ch;
    const float s0 = sc[0], s1 = sc[2048], s2 = sc[4096];
    const float raw = bf2f(p.XBC()[(size_t)row * 2048 + ch]);
    const float* cw = p.conv_w + (size_t)l * 4 * 2048 + ch;
    float v = p.conv_b[l * 2048 + ch] + cw[0] * s0 + cw[2048] * s1 + cw[4096] * s2 + cw[6144] * raw;
    v = silu_f(v);
    sx[idx] = v;
    float* co = p.out + OFF_CONVS + ((size_t)(l * 128 + b) * 3) * 2048 + ch;
    co[0] = s1; co[2048] = s2;
  }
  __syncthreads();
  const int pp = tid >> 2, nq = (tid & 3) * 32;
  float4 hv[4][8];
#pragma unroll
  for (int hd = 0; hd < 4; ++hd) {
    const float4* h0 = (const float4*)(p.state_ssm + ((((size_t)l * 128 + b) * 16 + g * 4 + hd) * 64 + pp) * 128 + nq);
#pragma unroll
    for (int q = 0; q < 8; ++q) hv[hd][q] = h0[q];
  }
#pragma unroll
  for (int hd = 0; hd < 4; ++hd) {
    const int head = g * 4 + hd;
    const float dt = p.DT()[(size_t)row * 16 + head];
    const float Ah = -expf(p.a_log[l * 16 + head]);
    const float dA = __expf(dt * Ah);
    const float xv = sx[hd * 64 + pp];
    const float coef = dt * xv;
    float4* ho = (float4*)(p.out + OFF_SSMS + ((((size_t)l * 128 + b) * 16 + head) * 64 + pp) * 128 + nq);
    float yacc = 0.f;
#pragma unroll
    for (int q = 0; q < 8; ++q) {
      float4 h4 = hv[hd][q];
      const int n = nq + 4 * q;
      h4.x = h4.x * dA + coef * sBv[n]; h4.y = h4.y * dA + coef * sBv[n + 1]; h4.z = h4.z * dA + coef * sBv[n + 2]; h4.w = h4.w * dA + coef * sBv[n + 3];
      yacc += h4.x * sCv[n] + h4.y * sCv[n + 1] + h4.z * sCv[n + 2] + h4.w * sCv[n + 3];
      ho[q] = h4;
    }
    yacc += __shfl_xor(yacc, 1); yacc += __shfl_xor(yacc, 2);
    const float y = yacc + p.m_d[l * 16 + head] * xv;
    const float z = bf2f(p.Z()[(size_t)row * 1024 + head * 64 + pp]);
    if ((tid & 3) == 0) sY[hd * 64 + pp] = y * silu_f(z);
  }
  __syncthreads();
  const float v = sY[tid];
  const float ssq = wave_sum(v * v);
  if (lane == 0) sRed[w] = ssq;
  __syncthreads();
  const float tot = sRed[0] + sRed[1] + sRed[2] + sRed[3];
  const float sc = rsqrtf(tot * (1.f / 256.f) + EPS);
  p.YM()[(size_t)row * 1024 + g * 256 + tid] = f2bf(v * sc * p.m_norm_w[l * 1024 + g * 256 + tid]);
}

DI void s5_wave_job(const P& p, int l, int mode, int b, int g, int c_first, int nch, bf16_t* sH) {
  const int lane = tidx() & 63, lr = lane & 31, lh = lane >> 5;
  bf16x8 bq[4];
#pragma unroll
  for (int nb = 0; nb < 4; ++nb) bq[nb] = *(const bf16x8*)(p.BBT() + ((size_t)(l * 64 + g) * 128 + nb * 32 + lr) * 16 + lh * 8);
  float ar[2], ai[2], cr_[2], ci_[2];
#pragma unroll
  for (int k = 0; k < 2; ++k) {
    const float* prm = p.S5P() + ((size_t)(l * 64 + g) * 36) * 64 + k * 32 + lr;
    ar[k] = prm[0]; ai[k] = prm[64];
  }
  const int o = lane & 15, quad = lane >> 4;
  bf16x8 cf[4];
  float dsk = 0.f;
  if (mode != 0) {
#pragma unroll
    for (int kk = 0; kk < 4; ++kk) {
      const float* cp = ((kk < 2) ? p.c_re : p.c_im) + ((size_t)(l * 64 + g) * 16 + o) * 64 + (kk & 1) * 32 + quad * 8;
      const float4 c0 = ((const float4*)cp)[0], c1 = ((const float4*)cp)[1];
      const float sg = (kk < 2) ? 1.f : -1.f;
      cf[kk] = u4_to_bf8(make_uint4(pack2(sg * c0.x, sg * c0.y), pack2(sg * c0.z, sg * c0.w), pack2(sg * c1.x, sg * c1.y), pack2(sg * c1.z, sg * c1.w)));
    }
    dsk = p.s5_d[l * 1024 + g * 16 + o];
  }
  for (int cc = 0; cc < nch; ++cc) {
  const int c = c_first + cc;
  int row0, Q;
  if (mode == 2) { row0 = TP + b; Q = 1; } else { row0 = b * SEQ + c * 64; Q = 64; }
#pragma unroll
  for (int k = 0; k < 2; ++k) {
    const int n = k * 32 + lr;
    cr_[k] = 0.f; ci_[k] = 0.f;
    if (mode == 2) {
      cr_[k] = p.s5_sre[((size_t)(l * 128 + b) * 64 + g) * 64 + n];
      ci_[k] = p.s5_sim[((size_t)(l * 128 + b) * 64 + g) * 64 + n];
    } else if (mode == 1) {
      const float2 sv = *(const float2*)(p.S5S() + (((size_t)(b * 128 + c) * 64 + g) * 64 + n) * 2);
      cr_[k] = sv.x; ci_[k] = sv.y;
    }
  }
  const int ntb = (mode == 2) ? 1 : 2;
  for (int tb = 0; tb < ntb; ++tb) {
    const bf16x8 uf = *(const bf16x8*)(p.U() + (size_t)(row0 + tb * 32 + lr) * 1024 + g * 16 + lh * 8);
    f32x16 acc[4];
#pragma unroll
    for (int nb = 0; nb < 4; ++nb) { zero16(acc[nb]); acc[nb] = MFMA32(uf, bq[nb], acc[nb]); }
#pragma unroll
    for (int k = 0; k < 2; ++k) {
      const float a1r = ar[k], a1i = ai[k];
      const float a2r = a1r * a1r - a1i * a1i, a2i = 2.f * a1r * a1i;
      const float a3r = a2r * a1r - a2i * a1i, a3i = a2r * a1i + a2i * a1r;
      const float a4r = a2r * a2r - a2i * a2i, a4i = 2.f * a2r * a2i;
      float er[4], ei[4];
#pragma unroll
      for (int q = 0; q < 4; ++q) {
        float hr = acc[k][4 * q], hi = acc[2 + k][4 * q];
#pragma unroll
        for (int j = 1; j < 4; ++j) {
          const float nr = a1r * hr - a1i * hi + acc[k][4 * q + j], ni = a1r * hi + a1i * hr + acc[2 + k][4 * q + j];
          hr = nr; hi = ni;
          acc[k][4 * q + j] = hr; acc[2 + k][4 * q + j] = hi;
        }
        er[q] = hr; ei[q] = hi;
      }
      float cinr[4], cini[4];
      float cr = cr_[k], ci = ci_[k];
#pragma unroll
      for (int q = 0; q < 4; ++q) {
        const float per = __shfl_xor(er[q], 32), pei = __shfl_xor(ei[q], 32);
        const float e0r = lh ? per : er[q], e0i = lh ? pei : ei[q];
        const float e1r = lh ? er[q] : per, e1i = lh ? ei[q] : pei;
        const float c1r = a4r * cr - a4i * ci + e0r, c1i = a4r * ci + a4i * cr + e0i;
        cinr[q] = lh ? c1r : cr; cini[q] = lh ? c1i : ci;
        cr = a4r * c1r - a4i * c1i + e1r; ci = a4r * c1i + a4i * c1r + e1i;
      }
#pragma unroll
      for (int q = 0; q < 4; ++q) {
        const float xr = cinr[q], xi = cini[q];
        acc[k][4 * q] += a1r * xr - a1i * xi;     acc[2 + k][4 * q] += a1r * xi + a1i * xr;
        acc[k][4 * q + 1] += a2r * xr - a2i * xi; acc[2 + k][4 * q + 1] += a2r * xi + a2i * xr;
        acc[k][4 * q + 2] += a3r * xr - a3i * xi; acc[2 + k][4 * q + 2] += a3r * xi + a3i * xr;
        acc[k][4 * q + 3] += a4r * xr - a4i * xi; acc[2 + k][4 * q + 3] += a4r * xi + a4i * xr;
      }
      if (mode == 2) { cr_[k] = acc[k][0]; ci_[k] = acc[2 + k][0]; }
      else { cr_[k] = cr; ci_[k] = ci; }
      if (mode != 0) {
#pragma unroll
        for (int i = 0; i < 16; ++i) {
          const int t = tb * 32 + crow(i, lh);
          sH[t * 136 + k * 32 + lr] = f2bf(acc[k][i]);
          sH[t * 136 + 64 + k * 32 + lr] = f2bf(acc[2 + k][i]);
        }
      }
    }
  }
  if (lh == 0) {
#pragma unroll
    for (int k = 0; k < 2; ++k) {
      const int n = k * 32 + lr;
      if (mode == 0) *(float2*)(p.S5S() + (((size_t)(b * 128 + c) * 64 + g) * 64 + n) * 2) = make_float2(cr_[k], ci_[k]);
      if (mode == 1 && c == 127) {
        p.out[OFF_S5RP + ((size_t)(l * 2 + b) * 64 + g) * 64 + n] = cr_[k];
        p.out[OFF_S5IP + ((size_t)(l * 2 + b) * 64 + g) * 64 + n] = ci_[k];
      }
      if (mode == 2) {
        p.out[OFF_S5RS + ((size_t)(l * 128 + b) * 64 + g) * 64 + n] = cr_[k];
        p.out[OFF_S5IS + ((size_t)(l * 128 + b) * 64 + g) * 64 + n] = ci_[k];
      }
    }
  }
  if (mode == 0) continue;
  const int nrb = (mode == 2) ? 1 : 4;
  __builtin_amdgcn_fence(__ATOMIC_RELEASE, "wavefront");
  __builtin_amdgcn_wave_barrier();
  __builtin_amdgcn_fence(__ATOMIC_ACQUIRE, "wavefront");
  for (int rb = 0; rb < nrb; ++rb) {
    f32x4 a4 = {0.f, 0.f, 0.f, 0.f};
#pragma unroll
    for (int kk = 0; kk < 4; ++kk) {
      const bf16x8 af = *(const bf16x8*)(sH + (rb * 16 + o) * 136 + kk * 32 + quad * 8);
      a4 = MFMA16(af, cf[kk], a4);
    }
#pragma unroll
    for (int jj = 0; jj < 4; ++jj) {
      const int t = rb * 16 + quad * 4 + jj;
      if (t < Q) {
        const size_t idx = (size_t)(row0 + t) * 1024 + g * 16 + o;
        const float y = a4[jj] + dsk * bf2f(p.U()[idx]);
        p.YS()[idx] = f2bf(gelu_tanh(y));
      }
    }
  }
  __builtin_amdgcn_fence(__ATOMIC_RELEASE, "wavefront");
  __builtin_amdgcn_wave_barrier();
  }
}

DI void attn_prompt_job(const P& p, int l, int job, char* smem) {
  const int kvh = job & 3, blk = (job >> 2) & 63, b = job >> 8;
  bf16_t* sK = (bf16_t*)smem;
  bf16_t* sVt = sK + 256 * 72;
  const int tid = tidx(), lane = tid & 63, w = __builtin_amdgcn_readfirstlane(tid >> 6), lr = lane & 31, lh = lane >> 5;
  const int tokc0 = b * SEQ + blk * 128 - 128;
  __syncthreads();
#pragma unroll
  for (int it = 0; it < 8; ++it) {
    const int item = tid + 256 * it, row = item >> 3, chk = item & 7;
    uint4 v = make_uint4(0u, 0u, 0u, 0u);
    if (blk > 0 || row >= 128) v = *(const uint4*)(p.K() + (size_t)(tokc0 + row) * 256 + kvh * 64 + chk * 8);
    *(uint4*)(sK + row * 72 + chk * 8) = v;
  }
#pragma unroll
  for (int it = 0; it < 8; ++it) {
    const int item = tid + 256 * it, d = item >> 5, chk = item & 31;
    uint4 v = make_uint4(0u, 0u, 0u, 0u);
    if (blk > 0 || chk >= 16) v = *(const uint4*)(p.VT() + (size_t)(kvh * 64 + d) * T + tokc0 + chk * 8);
    *(uint4*)(sVt + d * 264 + chk * 8) = v;
  }
  __syncthreads();
  const int qtok = b * SEQ + blk * 128 + 32 * w + lr;
#pragma unroll 1
  for (int hq = 0; hq < 4; ++hq) {
  const int head = kvh * 4 + hq;
  const int lrq = launder(lr), lhq = launder(lh);
  bf16x8 qf[4];
#pragma unroll
  for (int kk = 0; kk < 4; ++kk) qf[kk] = *(const bf16x8*)(p.Q() + (size_t)qtok * 1024 + head * 64 + kk * 16 + lhq * 8);
  f32x16 st[5];
#pragma unroll
  for (int x = 0; x < 5; ++x) {
    zero16(st[x]);
#pragma unroll
    for (int kk = 0; kk < 4; ++kk) {
      const bf16x8 af = *(const bf16x8*)(sK + (32 * (w + x) + lrq) * 72 + kk * 16 + lhq * 8);
      st[x] = MFMA32(af, qf[kk], st[x]);
    }
  }
  const float sink = p.sinks[l * 16 + head];
  const int qi = 128 + 32 * w + lrq;
  float m = sink;
#pragma unroll
  for (int x = 0; x < 5; ++x)
#pragma unroll
    for (int i = 0; i < 16; ++i) {
      const int kj = 32 * (w + x) + crow(i, lhq);
      const bool valid = (kj <= qi) && (kj >= qi - 128) && (blk > 0 || kj >= 128);
      const float s = valid ? st[x][i] * 0.125f : -1e30f;
      st[x][i] = s;
      m = fmaxf(m, s);
    }
  m = fmaxf(m, __shfl_xor(m, 32));
  float sum = 0.f;
#pragma unroll
  for (int x = 0; x < 5; ++x)
#pragma unroll
    for (int i = 0; i < 16; ++i) { const float pv = __expf(st[x][i] - m); st[x][i] = pv; sum += pv; }
  sum += __shfl_xor(sum, 32);
  const float inv = 1.f / (sum + __expf(sink - m));
  f32x16 ot[2];
  zero16(ot[0]); zero16(ot[1]);
#pragma unroll
  for (int x = 0; x < 5; ++x)
#pragma unroll
    for (int s = 0; s < 2; ++s) {
      const uint4 pu = make_uint4(pack2(st[x][8 * s] * inv, st[x][8 * s + 1] * inv), pack2(st[x][8 * s + 2] * inv, st[x][8 * s + 3] * inv),
                                  pack2(st[x][8 * s + 4] * inv, st[x][8 * s + 5] * inv), pack2(st[x][8 * s + 6] * inv, st[x][8 * s + 7] * inv));
      const bf16x8 pf = u4_to_bf8(pu);
#pragma unroll
      for (int pb = 0; pb < 2; ++pb) {
        const bf16_t* vp = sVt + (pb * 32 + lrq) * 264 + 32 * (w + x) + 16 * s + 4 * lhq;
        const uint2 lo = *(const uint2*)vp, hi2 = *(const uint2*)(vp + 8);
        ot[pb] = MFMA32(u4_to_bf8(make_uint4(lo.x, lo.y, hi2.x, hi2.y)), pf, ot[pb]);
      }
    }
#pragma unroll
  for (int pb = 0; pb < 2; ++pb)
#pragma unroll
    for (int ig = 0; ig < 4; ++ig) {
      const int d0 = pb * 32 + 8 * ig + 4 * lhq;
      *(uint2*)(p.O() + (size_t)qtok * 1024 + head * 64 + d0) = make_uint2(pack2(ot[pb][4 * ig], ot[pb][4 * ig + 1]), pack2(ot[pb][4 * ig + 2], ot[pb][4 * ig + 3]));
    }
  }
}

DI void attn_sample_job(const P& p, int l, int job, char* smem) {
  const int kvh = job & 3, b = job >> 2;
  const int tid = tidx(), lane = tid & 63, w = __builtin_amdgcn_readfirstlane(tid >> 6);
  const int head = kvh * 4 + w, row = TP + b;
  float* sQ = (float*)smem;
  float* sP = sQ + 256;
  const size_t cbase = ((size_t)(l * 128 + b) * 128) * 256 + kvh * 64;
  const float4* kc4 = (const float4*)(p.cache_k + cbase);
  const float4* vc4 = (const float4*)(p.cache_v + cbase);
  float4* ko4 = (float4*)(p.out + OFF_KS + cbase);
  float4* vo4 = (float4*)(p.out + OFF_VS + cbase);
  __syncthreads();
  for (int idx = tid; idx < 127 * 16; idx += 256) {
    const int j = idx >> 4, q4 = idx & 15;
    ko4[j * 64 + q4] = kc4[(j + 1) * 64 + q4];
    vo4[j * 64 + q4] = vc4[(j + 1) * 64 + q4];
  }
  const float qd = bf2f(p.Q()[(size_t)row * 1024 + head * 64 + lane]);
  sQ[w * 64 + lane] = qd;
  __syncthreads();
  float s0 = 0.f, s1 = 0.f;
#pragma unroll 4
  for (int d4 = 0; d4 < 16; ++d4) {
    const float4 q4 = ((const float4*)(sQ + w * 64))[d4];
    const float4 k0 = kc4[lane * 64 + d4], k1 = kc4[(lane + 64) * 64 + d4];
    s0 += q4.x * k0.x + q4.y * k0.y + q4.z * k0.z + q4.w * k0.w;
    s1 += q4.x * k1.x + q4.y * k1.y + q4.z * k1.z + q4.w * k1.w;
  }
  s0 *= 0.125f; s1 *= 0.125f;
  const float s2 = wave_sum(qd * bf2f(p.K()[(size_t)row * 256 + kvh * 64 + lane])) * 0.125f;
  const float sink = p.sinks[l * 16 + head];
  float m = fmaxf(fmaxf(s0, s1), fmaxf(s2, sink));
  m = wave_max(m);
  const float p0 = __expf(s0 - m), p1 = __expf(s1 - m), p2 = __expf(s2 - m);
  const float sum = wave_sum(p0 + p1);
  const float inv = 1.f / (sum + p2 + __expf(sink - m));
  sP[w * 132 + lane] = p0 * inv; sP[w * 132 + 64 + lane] = p1 * inv;
  __syncthreads();
  const float* vc = p.cache_v + cbase + lane;
  float o = 0.f;
#pragma unroll 8
  for (int j = 0; j < 128; ++j) o += sP[w * 132 + j] * vc[(size_t)j * 256];
  o += p2 * inv * bf2f(p.VT()[(size_t)(kvh * 64 + lane) * T + row]);
  p.O()[(size_t)row * 1024 + head * 64 + lane] = f2bf(o);
}

template <int PASS>
DI void merge_pass(const P& p, const bf16_t* A, const bf16_t* Wt, int m0, int n0, char* smem) {
  m0 = launder_s(m0); n0 = launder_s(n0);
  const int tid = tidx(), lane = tid & 63, w = __builtin_amdgcn_readfirstlane(tid >> 6), wm = w & 1, wn = w >> 1, lr = lane & 31, lh = lane >> 5;
  f32x16 acc[2][GNB];
#pragma unroll
  for (int a = 0; a < 2; ++a)
#pragma unroll
    for (int b = 0; b < GNB; ++b) zero16(acc[a][b]);
  gemm_mainloop(A + (size_t)m0 * 1024, 1024, Wt + (size_t)n0 * 1024, 1024, 1024, acc, smem);
  m0 = launder_s(m0); n0 = launder_s(n0);
  bf16_t* sT = (bf16_t*)smem;
  stage_tile(sT, acc, wm, wn, lr, lh);
  __syncthreads();
  const int goff = (PASS == 0) ? 1024 : (PASS == 2) ? 0 : 2048;
#pragma unroll 2
  for (int it = 0; it < 16; ++it) {
    const int idx = tid + 256 * it, row = idx >> 5, chunk = idx & 31;
    const uint4 av = *(const uint4*)(sT + row * LDS_T + chunk * 8);
    uint4* mp = (uint4*)(p.MG() + (size_t)(m0 + row) * 1024 + n0 + chunk * 8);
    uint4 gv = make_uint4(0u, 0u, 0u, 0u), mv = gv;
    if (PASS != 1) gv = *(const uint4*)(p.G() + (size_t)(m0 + row) * 3072 + goff + n0 + chunk * 8);
    if (PASS != 0) mv = *mp;
    const unsigned aw[4] = {av.x, av.y, av.z, av.w}, gw[4] = {gv.x, gv.y, gv.z, gv.w}, mw[4] = {mv.x, mv.y, mv.z, mv.w};
    unsigned ow[4];
#pragma unroll
    for (int k = 0; k < 4; ++k) {
      const float a0 = bflo(aw[k]), a1 = bfhi(aw[k]), g0 = bflo(gw[k]), g1 = bfhi(gw[k]), m0_ = bflo(mw[k]), m1_ = bfhi(mw[k]);
      float o0, o1;
      if (PASS == 0) { o0 = sigm_f(a0) * g0; o1 = sigm_f(a1) * g1; }
      else if (PASS == 1) { o0 = m0_ * a0; o1 = m1_ * a1; }
      else { o0 = m0_ + a0 * g0; o1 = m1_ + a1 * g1; }
      ow[k] = pack2(o0, o1);
    }
    *mp = make_uint4(ow[0], ow[1], ow[2], ow[3]);
  }
}
DI void merge_job(const P& p, int l, int job, char* smem) {
  int mt, nt;
  if (!gemm_tile(job, 128, 4, mt, nt)) return;
  const int m0 = mt * 128, n0 = nt * 256;
  const bf16_t* wl = p.Wt() + (size_t)l * W_LAYER;
  merge_pass<0>(p, p.YS(), wl + WO_GLU + (size_t)1024 * 1024, m0, n0, smem);
  merge_pass<1>(p, p.YS(), wl + WO_GLU, m0, n0, smem);
  merge_pass<2>(p, p.YM(), wl + WO_MPROJ, m0, n0, smem);
  merge_pass<3>(p, p.O(), wl + WO_ATTNO, m0, n0, smem);
}
DI void resid_gemm_job(const P& p, const bf16_t* A, int lda, const bf16_t* Wt, int K, int job, char* smem) {
  int mt, nt;
  if (!gemm_tile(job, 128, 4, mt, nt)) return;
  int m0 = mt * 128, n0 = nt * 256;
  const int tid = tidx(), lane = tid & 63, w = __builtin_amdgcn_readfirstlane(tid >> 6), wm = w & 1, wn = w >> 1, lr = lane & 31, lh = lane >> 5;
  f32x16 acc[2][GNB];
#pragma unroll
  for (int a = 0; a < 2; ++a)
#pragma unroll
    for (int b = 0; b < GNB; ++b) zero16(acc[a][b]);
  gemm_mainloop(A + (size_t)m0 * lda, lda, Wt + (size_t)n0 * K, K, K, acc, smem);
  m0 = launder_s(m0); n0 = launder_s(n0);
  float* sF = (float*)smem;
#pragma unroll
  for (int h = 0; h < 2; ++h) {
    if (h) __syncthreads();
#pragma unroll
    for (int ni = 0; ni < GNB; ++ni) {
      float* d = sF + (wm * 32 + 4 * lh) * 260 + wn * 128 + ni * 32 + lr;
#pragma unroll
      for (int i = 0; i < 16; ++i) d[((i & 3) + 8 * (i >> 2)) * 260] = acc[h][ni][i];
    }
    __syncthreads();
#pragma unroll 4
    for (int it = 0; it < 16; ++it) {
      const int idx = tid + 256 * it, rl = idx >> 6, c4 = idx & 63;
      const int r = m0 + (rl >> 5) * 64 + h * 32 + (rl & 31);
      float4* xp = (float4*)(p.X() + (size_t)r * 1024 + n0) + c4;
      const float4 a = *(const float4*)(sF + rl * 260 + c4 * 4);
      float4 x = *xp;
      x.x += a.x; x.y += a.y; x.z += a.z; x.w += a.w;
      *xp = x;
    }
  }
}
DI void up_job(const P& p, int l, int job, char* smem) {
  int mt, nt;
  if (!gemm_tile(job, 128, 16, mt, nt)) return;
  int m0 = mt * 128, n0 = nt * 256;
  const int tid = tidx(), lane = tid & 63, w = __builtin_amdgcn_readfirstlane(tid >> 6), wm = w & 1, wn = w >> 1, lr = lane & 31, lh = lane >> 5;
  f32x16 acc[2][GNB];
#pragma unroll
  for (int a = 0; a < 2; ++a)
#pragma unroll
    for (int b = 0; b < GNB; ++b) zero16(acc[a][b]);
  gemm_mainloop(p.H() + (size_t)m0 * 1024, 1024, p.Wt() + (size_t)l * W_LAYER + WO_UP + (size_t)n0 * 1024, 1024, 1024, acc, smem);
#if PROBE_DUP == 12
  gemm_mainloop(p.H() + (size_t)m0 * 1024, 1024, p.Wt() + (size_t)l * W_LAYER + WO_UP + (size_t)n0 * 1024, 1024, 1024, acc, smem);
#pragma unroll
  for (int mi = 0; mi < 2; ++mi)
#pragma unroll
    for (int ni = 0; ni < GNB; ++ni)
#pragma unroll
      for (int i = 0; i < 16; ++i) acc[mi][ni][i] *= 0.5f;
#endif
  m0 = launder_s(m0); n0 = launder_s(n0);
#pragma unroll
  for (int mi = 0; mi < 2; ++mi)
#pragma unroll
    for (int ni = 0; ni < GNB; ++ni)
#pragma unroll
      for (int i = 0; i < 16; ++i) { const float v = fmaxf(acc[mi][ni][i], 0.f); acc[mi][ni][i] = v * v; }
  bf16_t* sT = (bf16_t*)smem;
  stage_tile(sT, acc, wm, wn, lr, lh);
  __syncthreads();
  tile_writeout(p.A2() + (size_t)m0 * 4096 + n0, 4096, sT);
}

DI float skinny_dot(const bf16_t* __restrict__ A, int lda, const bf16_t* __restrict__ Wt, int K, int r0, int c0, char* smem) {
  float* sR = (float*)smem;
  const int tid = tidx(), lane = tid & 63, w = __builtin_amdgcn_readfirstlane(tid >> 6), r = lane & 15, quad = lane >> 4;
  const int kq = K >> 2;
  const bf16_t* ap = A + (size_t)(r0 + r) * lda + w * kq + quad * 8;
  const bf16_t* bp = Wt + (size_t)(c0 + r) * K + w * kq + quad * 8;
  f32x4 acc = {0.f, 0.f, 0.f, 0.f};
#pragma unroll 4
  for (int k = 0; k < kq; k += 32) {
    const bf16x8 a = *(const bf16x8*)(ap + k), b = *(const bf16x8*)(bp + k);
    acc = MFMA16(a, b, acc);
  }
  __syncthreads();
#pragma unroll
  for (int j = 0; j < 4; ++j) sR[w * 256 + (quad * 4 + j) * 16 + r] = acc[j];
  __syncthreads();
  return sR[tid] + sR[256 + tid] + sR[512 + tid] + sR[768 + tid];
}
DI void skinny_merge_job(const P& p, int l, int job, char* smem) {
  const int rt = job & 7, ct = job >> 3;
  const int r0 = TP + rt * 16, c0 = ct * 16;
  const bf16_t* wl = p.Wt() + (size_t)l * W_LAYER;
  const float ag = skinny_dot(p.YS(), 1024, wl + WO_GLU + (size_t)1024 * 1024, 1024, r0, c0, smem);
  const float av = skinny_dot(p.YS(), 1024, wl + WO_GLU, 1024, r0, c0, smem);
  const float am = skinny_dot(p.YM(), 1024, wl + WO_MPROJ, 1024, r0, c0, smem);
  const float aa = skinny_dot(p.O(), 1024, wl + WO_ATTNO, 1024, r0, c0, smem);
  const int tid = tidx(), r = r0 + (tid >> 4), c = c0 + (tid & 15);
  const bf16_t* gp = p.G() + (size_t)r * 3072 + c;
  const float v = bf2f(gp[0]) * am + bf2f(gp[1024]) * av * sigm_f(ag) + bf2f(gp[2048]) * aa;
  p.MG()[(size_t)r * 1024 + c] = f2bf(v);
}
DI void skinny_resid_job(const P& p, const bf16_t* A, int lda, const bf16_t* Wt, int K, int job, char* smem) {
  const int rt = job & 7, ct = job >> 3;
  const int r0 = TP + rt * 16, c0 = ct * 16;
  const float v = skinny_dot(A, lda, Wt, K, r0, c0, smem);
  const int tid = tidx();
  p.X()[(size_t)(r0 + (tid >> 4)) * 1024 + c0 + (tid & 15)] += v;
}
DI void skinny_up_job(const P& p, int l, int job, char* smem) {
  const int rt = job & 7, ct = job >> 3;
  const int r0 = TP + rt * 16, c0 = ct * 16;
  const float v = fmaxf(skinny_dot(p.H(), 1024, p.Wt() + (size_t)l * W_LAYER + WO_UP, 1024, r0, c0, smem), 0.f);
  const int tid = tidx();
  p.A2()[(size_t)(r0 + (tid >> 4)) * 4096 + c0 + (tid & 15)] = f2bf(v * v);
}

#define XB_TMO      128
#define XB_XCNT(j)  (256  + 64 * (j))
#define XB_XSUB(j)  (1280 + 64 * (j))
#define XB_XGEN(j)  (2304 + 64 * (j))
#define XB_TOP      3328
#define XB_TOPGEN   3392
#define XCD_BAR_WORDS 3456
#define XB_SPIN_CAP (1u << 20)
#define LAS __attribute__((address_space(3)))
DI unsigned xb_ld(unsigned* p) { return __hip_atomic_load(p, __ATOMIC_RELAXED, __HIP_MEMORY_SCOPE_AGENT); }
DI unsigned xb_add(unsigned* p, unsigned v) { return __hip_atomic_fetch_add(p, v, __ATOMIC_RELAXED, __HIP_MEMORY_SCOPE_AGENT); }
DI unsigned xb_xcc_id() { return (unsigned)__builtin_amdgcn_s_getreg((3 << 11) | 20) & 0xFu; }
#define XB_SPIN(cond, bar) do { unsigned _sp = 0; while (cond) { __builtin_amdgcn_s_sleep(1); \
    if ((++_sp & 255u) == 0u) { if (xb_ld(&(bar)[XB_TMO])) break; if (_sp > XB_SPIN_CAP) { atomicAdd(&(bar)[XB_TMO], 1u); break; } } } } while (0)
struct XcdBarrier { unsigned* bar; unsigned x; volatile LAS unsigned* st; };
DI XcdBarrier xcd_barrier_post(unsigned* bar, volatile LAS unsigned* st) {
  XcdBarrier b; b.bar = bar; b.x = xb_xcc_id(); b.st = st;
  if (threadIdx.x == 0) (void)xb_add(&bar[XB_XCNT(b.x)], 1u);
  return b;
}
DI void xcd_barrier_complete(unsigned* bar, unsigned x, unsigned& nloc, unsigned& nx) {
  const unsigned G = gridDim.x * gridDim.y * gridDim.z;
  unsigned sum, cnt, mine, sp = 0u;
  for (;;) {
    sum = 0u; cnt = 0u; mine = 0u;
#pragma unroll
    for (unsigned j = 0; j < 16; ++j) { const unsigned c = xb_ld(&bar[XB_XCNT(j)]); sum += c; cnt += (c > 0u) ? 1u : 0u; mine = (j == x) ? c : mine; }
    if (sum == G) break;
    __builtin_amdgcn_s_sleep(1);
    if ((++sp & 255u) == 0u) { if (xb_ld(&bar[XB_TMO])) break; if (sp > XB_SPIN_CAP) { atomicAdd(&bar[XB_TMO], 1u); break; } }
  }
  nloc = mine > 0u ? mine : 1u; nx = cnt > 0u ? cnt : 1u;
}
DI void xcd_barrier(const XcdBarrier& b) {
  asm volatile("s_waitcnt vmcnt(0)" ::: "memory");
  __syncthreads();
  if (threadIdx.x == 0) {
    unsigned* bar = b.bar;
    __builtin_amdgcn_s_waitcnt(0);
    unsigned nloc = b.st[0], nx = b.st[1];
    if (nloc == 0u) { xcd_barrier_complete(bar, b.x, nloc, nx); b.st[0] = nloc; b.st[1] = nx; }
    const unsigned old = xb_add(&bar[XB_XSUB(b.x)], 1u);
    const unsigned gen = old / nloc;
    if (old + 1u == (gen + 1u) * nloc) {
      __builtin_amdgcn_fence(__ATOMIC_RELEASE, "agent");
      asm volatile("s_waitcnt vmcnt(0)" ::: "memory");
      const unsigned og = xb_add(&bar[XB_TOP], 1u);
      const unsigned tg = og / nx;
      if (og + 1u == (tg + 1u) * nx) xb_add(&bar[XB_TOPGEN], 1u);
      else XB_SPIN(xb_ld(&bar[XB_TOPGEN]) == tg, bar);
      __builtin_amdgcn_fence(__ATOMIC_ACQUIRE, "agent");
      xb_add(&bar[XB_XGEN(b.x)], 1u);
      asm volatile("s_waitcnt vmcnt(0)" ::: "memory");
    } else {
      XB_SPIN(xb_ld(&bar[XB_XGEN(b.x)]) == gen, bar);
      __builtin_amdgcn_fence(__ATOMIC_ACQUIRE, "agent");
      asm volatile("s_waitcnt vmcnt(0)" ::: "memory");
    }
  }
  __syncthreads();
}

constexpr int NPHASE = 1 + 4 * 11;
DI void phase_jobs(int ph, int& nstd, int& nother) {
  nstd = 0;
  if (ph == 0) { nother = 22272 + 64 + 257 + 4128; return; }
  const int s = (ph - 1) % 11;
  switch (s) {
    case 0: nstd = 129 * 35; nother = 0; break;
    case 1: nother = 512 + 512 + 512 + 4096 + 2048 + 2048; break;
    case 2: nother = 2048; break;
    case 3: nother = 256 + 32; break;
    case 4: nother = 512 + 2048; break;
    case 5: nstd = 512; nother = 512; break;
    case 6: nstd = 512; nother = 512; break;
    case 7: nother = 4128; break;
    case 8: nstd = 2048; nother = 2048; break;
    case 9: nstd = 512; nother = 512; break;
    default: nother = 4128; break;
  }
}
DI void run_std_job(const P& p, int ph, int job, char* smem) {
  const int l = (ph - 1) / 11, s = (ph - 1) % 11;
  const bf16_t* wl = p.Wt() + (size_t)l * W_LAYER;
  switch (s) {
    case 0: inproj_job(p, l, job, smem); break;
    case 5: merge_job(p, l, job, smem); break;
    case 6: resid_gemm_job(p, p.MG(), 1024, wl + WO_WOUT, 1024, job, smem); break;
    case 8: up_job(p, l, job, smem); break;
    default: resid_gemm_job(p, p.A2(), 4096, wl + WO_DOWN, 4096, job, smem); break;
  }
}
DI void run_job(const P& p, int ph, int job, char* smem) {
  if (ph == 0) {
    if (job < 22272) { prep_weight_job(p, job, smem); return; }
    job -= 22272;
    if (job < 64) { prep_s5_job(p, job); return; }
    job -= 64;
    if (job < 257) { prep_rope_job(p, job); return; }
    job -= 257;
    norm_job(p, job, p.norm1_w, true, false);
    return;
  }
  const int l = (ph - 1) / 11, s = (ph - 1) % 11;
  const bf16_t* wl = p.Wt() + (size_t)l * W_LAYER;
  const int w = __builtin_amdgcn_readfirstlane(tidx() >> 6);
  switch (s) {
    case 1:
      if (job < 512) { for (int rr = 0; rr < (PROBE_DUP == 11 ? 3 : 1); ++rr) ssd_sample_job(p, l, job, smem); break; }
      job -= 512;
      if (job < 512) { attn_sample_job(p, l, job, smem); break; }
      job -= 512;
      if (job < 512) { attn_prompt_job(p, l, job, smem); break; }
      job -= 512;
      if (job < 4096) { for (int rr = 0; rr < (PROBE_DUP == 9 ? 3 : 1); ++rr) conv_job(p, l, job, smem); break; }
      job -= 4096;
      if (job < 2048) { const int wj = job * 4 + w; s5_wave_job(p, l, 0, wj >> 12, wj & 63, ((wj >> 6) & 63) * 2, 2, nullptr); break; }
      job -= 2048;
      { const int wj = job * 4 + w; __syncthreads(); s5_wave_job(p, l, 2, wj >> 6, wj & 63, 0, 1, (bf16_t*)smem + w * 64 * 136); }
      break;
    case 2: ssd_a_job(p, l, job, smem); break;
    case 3:
      if (job < 256) ssd_scan_job(p, l, job);
      else s5_scan_job(p, l, job - 256);
      break;
    case 4:
      if (job < 512) { for (int rr = 0; rr < (PROBE_DUP == 16 ? 3 : 1); ++rr) ssd_c_job(p, l, job, smem); break; }
      job -= 512;
      { const int wj = job * 4 + w; __syncthreads(); s5_wave_job(p, l, 1, wj >> 12, wj & 63, ((wj >> 6) & 63) * 2, 2, (bf16_t*)smem + w * 64 * 136); }
      break;
    case 5: skinny_merge_job(p, l, job, smem); break;
    case 6: skinny_resid_job(p, p.MG(), 1024, wl + WO_WOUT, 1024, job, smem); break;
    case 7: norm_job(p, job, p.norm2_w + l * 1024, false, false); break;
    case 8: skinny_up_job(p, l, job, smem); break;
    case 9: skinny_resid_job(p, p.A2(), 4096, wl + WO_DOWN, 4096, job, smem); break;
    default:
      if (l == 3) norm_job(p, job, p.final_w, false, true);
      else norm_job(p, job, p.norm1_w + (l + 1) * 1024, false, false);
      break;
  }
}

template <bool COOP>
__global__ void __launch_bounds__(256, 2) mega(P p, int ph0, int ph1) {
  __shared__ __attribute__((aligned(16))) char smem[SMEM_BYTES];
  __shared__ uint4 xb_words;
  XcdBarrier xb;
  if (COOP) {
    if (threadIdx.x == 0) xb_words = make_uint4(0u, 0u, 0u, 0u);
    __syncthreads();
    xb = xcd_barrier_post((unsigned*)(p.ws + WS_BAR), (volatile LAS unsigned*)&xb_words);
  }
  const int G = (int)gridDim.x;
  for (int ph = ph0; ph < ph1; ++ph) {
    int nstd, nother;
    phase_jobs(ph, nstd, nother);
    int reps = 1;
#if PROBE_DUP
    { const int s_ = (ph == 0) ? -1 : (ph - 1) % 11;
      if (PROBE_DUP == 1 && (s_ == 0 || s_ == 5 || s_ == 8)) reps = 2;
      if (PROBE_DUP == 2 && (s_ == 1 || s_ == 2 || s_ == 4)) reps = 2;
      if (PROBE_DUP == 6 && s_ == 4) reps = 2;
      if (PROBE_DUP == 13 && s_ == 8) reps = 2;
      if (PROBE_DUP == 14 && s_ == 2) reps = 3;
      if (PROBE_DUP == 15 && (s_ == 6 || s_ == 9)) reps = 1;
      if (PROBE_DUP == 7 && s_ == 1) reps = 2; }
#endif
    const int nstd_r = ((nstd + G - 1) / G) * G;
    for (int rep = 0; rep < reps; ++rep) {
      for (int job = blockIdx.x; job < nstd_r; job += G) run_std_job(p, ph, job, smem);
      for (int job = blockIdx.x; job < nother; job += G) run_job(p, ph, job, smem);
    }
    if (COOP && ph + 1 < ph1) {
      if (ph == ph0) cg::this_grid().sync();
      else xcd_barrier(xb);
    }
  }
}


extern "C" void kernel_launch(void* const* d_in, const int* in_sizes, int n_in, void* d_out, int out_size, void* d_ws, size_t ws_size,
                              hipStream_t stream) {
  P p{};
  const float** pin = (const float**)&p;
  for (int i = 0; i < 33; ++i) pin[i] = (const float*)d_in[i];
  p.out = (float*)d_out;
  p.ws = (char*)d_ws;
  if (WS_TOTAL > ws_size) { fprintf(stderr, "workspace too small: need %zu have %zu\n", (size_t)WS_TOTAL, ws_size); return; }

#if COOP_MODE
  static int grid_blocks = 0;
  if (!grid_blocks) {
    int dev = 0, cus = 0, per_cu = 0;
    hipGetDevice(&dev);
    hipDeviceGetAttribute(&cus, hipDeviceAttributeMultiprocessorCount, dev);
    hipOccupancyMaxActiveBlocksPerMultiprocessor(&per_cu, mega<true>, 256, 0);
    if (per_cu > 2) per_cu = 2;
    if (per_cu < 1) per_cu = 1;
    grid_blocks = cus * per_cu;
  }
  (void)hipMemsetAsync(p.ws + WS_BAR, 0, 4096 * 4, stream);
  int ph0 = 0, ph1 = NPHASE;
  void* args[] = {&p, &ph0, &ph1};
  hipError_t e = hipLaunchCooperativeKernel((void*)mega<true>, dim3(grid_blocks), dim3(256), args, 0, stream);
  if (e != hipSuccess) fprintf(stderr, "cooperative launch failed: %s (grid %d)\n", hipGetErrorString(e), grid_blocks);
#else
  for (int ph = 0; ph < NPHASE; ++ph) mega<false><<<dim3(1024), dim3(256), 0, stream>>>(p, ph, ph + 1);
#endif
}
```

```cpp
#include <hip/hip_runtime.h>
#include <hip/hip_cooperative_groups.h>
#include <cstdio>
#include <cstdint>
namespace cg = cooperative_groups;

#define DI __device__ __forceinline__
typedef unsigned short bf16_t;
typedef short bf16x8 __attribute__((ext_vector_type(8)));
typedef float f32x16 __attribute__((ext_vector_type(16)));
typedef float f32x4 __attribute__((ext_vector_type(4)));
#define MFMA32(a, b, c) __builtin_amdgcn_mfma_f32_32x32x16_bf16((a), (b), (c), 0, 0, 0)
#define MFMA16(a, b, c) __builtin_amdgcn_mfma_f32_16x16x32_bf16((a), (b), (c), 0, 0, 0)

#ifndef COOP_MODE
#define COOP_MODE 1
#endif
#ifndef PROBE_DUP
#define PROBE_DUP 0
#endif

constexpr int TP = 16384, TS = 128, T = TP + TS, SEQ = 8192;
constexpr int NIN = 8720, NINP = 8960;
constexpr int SMEM_BYTES = 73728;
constexpr float EPS = 1e-6f;

constexpr size_t OFF_YP = 0;
constexpr size_t OFF_YS = OFF_YP + (size_t)TP * 1024;
constexpr size_t OFF_SSMP = OFF_YS + (size_t)TS * 1024;
constexpr size_t OFF_SSMS = OFF_SSMP + (size_t)4 * 2 * 16 * 64 * 128;
constexpr size_t OFF_CONVP = OFF_SSMS + (size_t)4 * 128 * 16 * 64 * 128;
constexpr size_t OFF_CONVS = OFF_CONVP + (size_t)4 * 2 * 3 * 2048;
constexpr size_t OFF_S5RP = OFF_CONVS + (size_t)4 * 128 * 3 * 2048;
constexpr size_t OFF_S5RS = OFF_S5RP + (size_t)4 * 2 * 64 * 64;
constexpr size_t OFF_S5IP = OFF_S5RS + (size_t)4 * 128 * 64 * 64;
constexpr size_t OFF_S5IS = OFF_S5IP + (size_t)4 * 2 * 64 * 64;
constexpr size_t OFF_KP = OFF_S5IS + (size_t)4 * 128 * 64 * 64;
constexpr size_t OFF_KS = OFF_KP + (size_t)4 * 2 * 128 * 256;
constexpr size_t OFF_VP = OFF_KS + (size_t)4 * 128 * 128 * 256;
constexpr size_t OFF_VS = OFF_VP + (size_t)4 * 2 * 128 * 256;

constexpr size_t WO_IN = 0;
constexpr size_t WO_MPROJ = WO_IN + (size_t)NINP * 1024;
constexpr size_t WO_GLU = WO_MPROJ + (size_t)1024 * 1024;
constexpr size_t WO_ATTNO = WO_GLU + (size_t)2048 * 1024;
constexpr size_t WO_WOUT = WO_ATTNO + (size_t)1024 * 1024;
constexpr size_t WO_UP = WO_WOUT + (size_t)1024 * 1024;
constexpr size_t WO_DOWN = WO_UP + (size_t)4096 * 1024;
constexpr size_t W_LAYER = WO_DOWN + (size_t)4096 * 1024;

constexpr size_t al256(size_t x) { return (x + 255) & ~(size_t)255; }
constexpr size_t SZ1 = (size_t)T * 1024 * 2;
constexpr size_t WS_X = 0;
constexpr size_t WS_H = WS_X + al256((size_t)T * 1024 * 4);
constexpr size_t WS_Z = WS_H + al256(SZ1);
constexpr size_t WS_U = WS_Z + al256(SZ1);
constexpr size_t WS_Q = WS_U + al256(SZ1);
constexpr size_t WS_YM = WS_Q + al256(SZ1);
constexpr size_t WS_YS = WS_YM + al256(SZ1);
constexpr size_t WS_O = WS_YS + al256(SZ1);
constexpr size_t WS_MG = WS_O + al256(SZ1);
constexpr size_t WS_XBC = WS_MG + al256(SZ1);
constexpr size_t WS_XBT = WS_XBC + al256((size_t)T * 2048 * 2);
constexpr size_t WS_BC = WS_XBT + al256((size_t)1536 * TP * 2);
constexpr size_t WS_A2END = WS_XBC + al256((size_t)T * 4096 * 2);
constexpr size_t WS_BCEND = WS_BC + al256((size_t)TP * 1024 * 2);
constexpr size_t WS_K = WS_A2END > WS_BCEND ? WS_A2END : WS_BCEND;
constexpr size_t WS_VT = WS_K + al256((size_t)T * 256 * 2);
constexpr size_t WS_G = WS_VT + al256((size_t)T * 256 * 2);
constexpr size_t WS_DT = WS_G + al256((size_t)T * 3072 * 2);
constexpr size_t WS_ST = WS_DT + al256((size_t)T * 16 * 4);
constexpr size_t WS_CDEC = WS_ST + al256((size_t)2 * 64 * 16 * 64 * 128 * 4);
constexpr size_t WS_S5S = WS_CDEC + al256((size_t)2 * 64 * 16 * 4);
constexpr size_t WS_S5P = WS_S5S + al256((size_t)2 * 128 * 64 * 64 * 2 * 4);
constexpr size_t WS_ROPE = WS_S5P + al256((size_t)4 * 64 * 36 * 64 * 4);
constexpr size_t WS_WT = WS_ROPE + al256((size_t)8193 * 8 * 8);
constexpr size_t WS_BAR = WS_WT + al256((size_t)4 * W_LAYER * 2);
constexpr size_t WS_HP = WS_BAR + al256(4096 * 4);
constexpr size_t WS_BBT = WS_HP + al256((size_t)2 * 64 * 16 * 64 * 128 * 2);
constexpr size_t WS_TOTAL = WS_BBT + al256((size_t)4 * 64 * 128 * 16 * 2);

struct P {
  const float *x_prompt, *x_sample, *state_ssm, *state_conv, *s5_sre, *s5_sim, *cache_k, *cache_v;
  const float *norm1_w, *w_in, *conv_w, *conv_b, *dt_bias, *a_log, *m_d, *m_norm_w, *m_proj;
  const float *lam_re, *lam_im, *log_step, *b_re, *b_im, *c_re, *c_im, *s5_d, *glu_w;
  const float *sinks, *attn_o, *w_out, *norm2_w, *mlp_up, *mlp_down, *final_w;
  float* out;
  char* ws;
#define WSACC(name, type, off) __device__ __forceinline__ type* name() const { return (type*)(ws + (off)); }
  WSACC(X, float, WS_X) WSACC(H, bf16_t, WS_H) WSACC(Z, bf16_t, WS_Z) WSACC(U, bf16_t, WS_U) WSACC(Q, bf16_t, WS_Q)
  WSACC(YM, bf16_t, WS_YM) WSACC(YS, bf16_t, WS_YS) WSACC(O, bf16_t, WS_O) WSACC(MG, bf16_t, WS_MG)
  WSACC(XBC, bf16_t, WS_XBC) WSACC(XBT, bf16_t, WS_XBT) WSACC(BC, bf16_t, WS_BC) WSACC(A2, bf16_t, WS_XBC)
  WSACC(K, bf16_t, WS_K) WSACC(VT, bf16_t, WS_VT) WSACC(G, bf16_t, WS_G) WSACC(DT, float, WS_DT) WSACC(ST, float, WS_ST)
  WSACC(CDEC, float, WS_CDEC) WSACC(HP, bf16_t, WS_HP) WSACC(BBT, bf16_t, WS_BBT) WSACC(S5S, float, WS_S5S) WSACC(S5P, float, WS_S5P) WSACC(ROPE, float2, WS_ROPE) WSACC(Wt, bf16_t, WS_WT)
#undef WSACC
};

typedef float f32x2_t __attribute__((ext_vector_type(2)));
typedef __bf16 bf16x2_t __attribute__((ext_vector_type(2)));
DI unsigned pack2(float a, float b) { const f32x2_t v = {a, b}; return __builtin_bit_cast(unsigned, __builtin_convertvector(v, bf16x2_t)); }
DI bf16_t f2bf(float x) { return (bf16_t)(pack2(x, 0.f) & 0xffffu); }
DI float bf2f(bf16_t b) { return __uint_as_float(((unsigned)b) << 16); }
DI float bflo(unsigned u) { return __uint_as_float(u << 16); }
DI float bfhi(unsigned u) { return __uint_as_float(u & 0xffff0000u); }
DI float frcp(float x) { return __builtin_amdgcn_rcpf(x); }
DI float silu_f(float x) { return x * frcp(1.f + __expf(-x)); }
DI float sigm_f(float x) { return frcp(1.f + __expf(-x)); }
DI float softplus_f(float x) { return x > 20.f ? x : log1pf(expf(x)); }
DI float gelu_tanh(float x) { float y = 0.7978845608028654f * (x + 0.044715f * x * x * x); float t = 1.f - 2.f * frcp(__expf(2.f * y) + 1.f); return 0.5f * x * (1.f + t); }
DI int crow(int i, int lh) { return (i & 3) + 8 * (i >> 2) + 4 * lh; }
DI int launder(int x) { asm volatile("" : "+v"(x)); return x; }
DI int tidx() { int t = __builtin_amdgcn_workitem_id_x(); asm volatile("" : "+v"(t)); return t; }
DI int launder_s(int x) { asm volatile("" : "+s"(x)); return x; }
DI float wave_sum(float v) {
#pragma unroll
  for (int o = 32; o >= 1; o >>= 1) v += __shfl_xor(v, o);
  return v;
}
DI float wave_max(float v) {
#pragma unroll
  for (int o = 32; o >= 1; o >>= 1) v = fmaxf(v, __shfl_xor(v, o));
  return v;
}
DI bf16x8 u4_to_bf8(uint4 v) { return __builtin_bit_cast(bf16x8, v); }
DI void zero16(f32x16& a) {
#pragma unroll
  for (int i = 0; i < 16; ++i) a[i] = 0.f;
}

constexpr int LDT = 40;
constexpr int GNB = 4;
DI void gemm_mainloop(const bf16_t* __restrict__ A, int lda, const bf16_t* __restrict__ B, int ldb, int K,
                      f32x16 (&acc)[2][GNB], char* smem) {
  bf16_t* sa = (bf16_t*)smem;
  bf16_t* sb = sa + 2 * 128 * LDT;
  const int tid = tidx(), lane = tid & 63, w = __builtin_amdgcn_readfirstlane(tid >> 6), wm = w & 1, wn = w >> 1, lr = lane & 31, lh = lane >> 5;
  const int r0 = tid >> 2, ch = (tid & 3) * 8;
  const bf16_t* ap = A + (size_t)r0 * lda + ch;
  const bf16_t* bp = B + (size_t)r0 * ldb + ch;
  uint4 pa0, pa1, pb0, pb1, pb2, pb3;
  uint4 qa0, qa1, qb0, qb1, qb2, qb3;
#define GLOADS(R, k0)                                                                                      \
  R##a0 = *(const uint4*)(ap + (k0)); R##a1 = *(const uint4*)(ap + (size_t)64 * lda + (k0));               \
  R##b0 = *(const uint4*)(bp + (k0)); R##b1 = *(const uint4*)(bp + (size_t)64 * ldb + (k0));               \
  R##b2 = *(const uint4*)(bp + (size_t)128 * ldb + (k0)); R##b3 = *(const uint4*)(bp + (size_t)192 * ldb + (k0));
#define SSTORES(R, bufi)                                                                                   \
  { bf16_t* da = sa + (bufi)*128 * LDT; bf16_t* db = sb + (bufi)*256 * LDT;                                \
    *(uint4*)(da + (r0)*LDT + ch) = R##a0; *(uint4*)(da + (r0 + 64) * LDT + ch) = R##a1;                   \
    *(uint4*)(db + (r0)*LDT + ch) = R##b0; *(uint4*)(db + (r0 + 64) * LDT + ch) = R##b1;                   \
    *(uint4*)(db + (r0 + 128) * LDT + ch) = R##b2; *(uint4*)(db + (r0 + 192) * LDT + ch) = R##b3; }
#define COMPUTE(bufi)                                                                                      \
  { const bf16_t* ca = sa + (bufi)*128 * LDT + (wm * 64 + lr) * LDT + lh * 8;                              \
    const bf16_t* cb = sb + (bufi)*256 * LDT + (wn * 128 + lr) * LDT + lh * 8;                             \
    _Pragma("unroll") for (int kk = 0; kk < 2; ++kk) {                                                     \
      const bf16x8 af0 = *(const bf16x8*)(ca + kk * 16), af1 = *(const bf16x8*)(ca + 32 * LDT + kk * 16);  \
      _Pragma("unroll") for (int ni = 0; ni < GNB; ++ni) {                                                 \
        const bf16x8 bfr = *(const bf16x8*)(cb + ni * 32 * LDT + kk * 16);                                 \
        acc[0][ni] = MFMA32(af0, bfr, acc[0][ni]); acc[1][ni] = MFMA32(af1, bfr, acc[1][ni]); } } }
  const int nk = K >> 5;
  const int klast = (nk - 1) * 32;
  GLOADS(p, 0)
  __syncthreads();
  SSTORES(p, 0)
  GLOADS(p, 32)
  __syncthreads();
  for (int kt = 0; kt < nk; kt += 2) {
    { const int k2 = (kt + 2) * 32; const int k0 = k2 < klast ? k2 : klast; GLOADS(q, k0) }
    COMPUTE(0)
    SSTORES(p, 1)
    __syncthreads();
    { const int k3 = (kt + 3) * 32; const int k0 = k3 < klast ? k3 : klast; GLOADS(p, k0) }
    COMPUTE(1)
    SSTORES(q, 0)
    __syncthreads();
  }
#undef GLOADS
#undef SSTORES
#undef COMPUTE
}
DI bool gemm_tile(int slot, int MT, int NT, int& mt, int& nt) {
  const int G = gridDim.x, nx = G >> 3;
  int J = slot;
  if ((G & 7) == 0) J = (slot / G) * G + (slot & 7) * nx + ((slot % G) >> 3);
  if (J >= MT * NT) return false;
  const int gw = 8 * NT, grp = J / gw, rem = J - grp * gw, fm = grp * 8;
  const int gsz = (MT - fm) < 8 ? (MT - fm) : 8;
  mt = fm + rem % gsz; nt = rem / gsz;
  return true;
}

DI int win_map(int n) {
  if (n < 3072) return n;
  if (n < 8704) return n + 16;
  if (n < 8720) return n - 8704 + 3072;
  return -1;
}
DI void wtrans_tile(const float* __restrict__ src, int N, int K, bf16_t* __restrict__ dst, int kt, int nt, bool inmap, char* smem) {
  float* s = (float*)smem;
  const int tid = tidx();
  __syncthreads();
  {
    const int n4 = (tid & 15) * 4;
    int sc = nt * 64 + n4;
    if (inmap) sc = win_map(sc);
#pragma unroll
    for (int ps = 0; ps < 4; ++ps) {
      const int kk = (tid >> 4) + 16 * ps;
      float4 v = make_float4(0.f, 0.f, 0.f, 0.f);
      if (sc >= 0) v = *(const float4*)(src + (size_t)(kt * 64 + kk) * N + sc);
      float* d = s + kk * 65 + n4;
      d[0] = v.x; d[1] = v.y; d[2] = v.z; d[3] = v.w;
    }
  }
  __syncthreads();
  {
    const int n2 = tid >> 2, kq = (tid & 3) * 16;
    unsigned w[8];
#pragma unroll
    for (int j = 0; j < 8; ++j) w[j] = pack2(s[(kq + 2 * j) * 65 + n2], s[(kq + 2 * j + 1) * 65 + n2]);
    uint4* d = (uint4*)(dst + (size_t)(nt * 64 + n2) * K + kt * 64 + kq);
    d[0] = make_uint4(w[0], w[1], w[2], w[3]);
    d[1] = make_uint4(w[4], w[5], w[6], w[7]);
  }
}
DI void prep_weight_job(const P& p, int j, char* smem) {
  const int l = j / 5568; int r = j % 5568;
  bf16_t* wl = p.Wt() + (size_t)l * W_LAYER;
  if (r < 2240) { wtrans_tile(p.w_in + (size_t)l * 1024 * NIN, NIN, 1024, wl + WO_IN, r / 140, r % 140, true, smem); return; }
  r -= 2240;
  if (r < 256) { wtrans_tile(p.m_proj + (size_t)l * 1024 * 1024, 1024, 1024, wl + WO_MPROJ, r / 16, r % 16, false, smem); return; }
  r -= 256;
  if (r < 512) { wtrans_tile(p.glu_w + (size_t)l * 1024 * 2048, 2048, 1024, wl + WO_GLU, r / 32, r % 32, false, smem); return; }
  r -= 512;
  if (r < 256) { wtrans_tile(p.attn_o + (size_t)l * 1024 * 1024, 1024, 1024, wl + WO_ATTNO, r / 16, r % 16, false, smem); return; }
  r -= 256;
  if (r < 256) { wtrans_tile(p.w_out + (size_t)l * 1024 * 1024, 1024, 1024, wl + WO_WOUT, r / 16, r % 16, false, smem); return; }
  r -= 256;
  if (r < 1024) { wtrans_tile(p.mlp_up + (size_t)l * 1024 * 4096, 4096, 1024, wl + WO_UP, r / 64, r % 64, false, smem); return; }
  r -= 1024;
  wtrans_tile(p.mlp_down + (size_t)l * 4096 * 1024, 1024, 4096, wl + WO_DOWN, r / 16, r % 16, false, smem);
}
DI void prep_s5_job(const P& p, int j) {
  const int idx = j * 256 + tidx();
  const int n = idx & 63, g = (idx >> 6) & 63, l = idx >> 12;
  const float step = expf(p.log_step[l * 64 + g]);
  const float lr_ = p.lam_re[(l * 64 + g) * 64 + n], li = p.lam_im[(l * 64 + g) * 64 + n];
  const float mag = expf(lr_ * step);
  const float abr = mag * cosf(li * step), abi = mag * sinf(li * step);
  float aqr = abr, aqi = abi;
#pragma unroll
  for (int q = 0; q < 6; ++q) { const float nr2 = aqr * aqr - aqi * aqi, ni2 = 2.f * aqr * aqi; aqr = nr2; aqi = ni2; }
  const float den = lr_ * lr_ + li * li;
  const float nr = abr - 1.0f, ni = abi;
  const float fre = (nr * lr_ + ni * li) / den, fim = (ni * lr_ - nr * li) / den;
  float* o = p.S5P() + ((size_t)(l * 64 + g) * 36) * 64 + n;
  o[0] = abr; o[64] = abi; o[128] = aqr; o[192] = aqi;
  const float* br = p.b_re + ((size_t)(l * 64 + g) * 64 + n) * 16;
  const float* bi = p.b_im + ((size_t)(l * 64 + g) * 64 + n) * 16;
  float vre[16], vim[16];
#pragma unroll
  for (int i = 0; i < 16; ++i) {
    const float b_r = br[i], b_i = bi[i];
    vre[i] = fre * b_r - fim * b_i;
    vim[i] = fre * b_i + fim * b_r;
    o[(4 + i) * 64] = vre[i];
    o[(20 + i) * 64] = vim[i];
  }
  uint4* bt = (uint4*)(p.BBT() + ((size_t)(l * 64 + g) * 128 + n) * 16);
  bt[0] = make_uint4(pack2(vre[0], vre[1]), pack2(vre[2], vre[3]), pack2(vre[4], vre[5]), pack2(vre[6], vre[7]));
  bt[1] = make_uint4(pack2(vre[8], vre[9]), pack2(vre[10], vre[11]), pack2(vre[12], vre[13]), pack2(vre[14], vre[15]));
  bt[128] = make_uint4(pack2(vim[0], vim[1]), pack2(vim[2], vim[3]), pack2(vim[4], vim[5]), pack2(vim[6], vim[7]));
  bt[129] = make_uint4(pack2(vim[8], vim[9]), pack2(vim[10], vim[11]), pack2(vim[12], vim[13]), pack2(vim[14], vim[15]));
}
DI void prep_rope_job(const P& p, int j) {
  const int idx = j * 256 + tidx();
  if (idx >= 8193 * 8) return;
  const int pos = idx >> 3, f = idx & 7;
  const float invf = expf(-(2.0f * (float)f / 16.0f) * logf(500000.0f));
  const float ang = (float)pos * invf;
  p.ROPE()[idx] = make_float2(cosf(ang), sinf(ang));
}

DI void norm_job(const P& p, int job, const float* wgt, bool layer0, bool final_) {
  const int w = __builtin_amdgcn_readfirstlane(tidx() >> 6), lane = tidx() & 63;
  const int r = job * 4 + w;
  const float* src = layer0 ? (r < TP ? p.x_prompt + (size_t)r * 1024 : p.x_sample + (size_t)(r - TP) * 1024) : p.X() + (size_t)r * 1024;
  float4 v[4];
  float ss = 0.f;
#pragma unroll
  for (int q = 0; q < 4; ++q) { v[q] = ((const float4*)src)[lane + 64 * q]; ss += v[q].x * v[q].x + v[q].y * v[q].y + v[q].z * v[q].z + v[q].w * v[q].w; }
  ss = wave_sum(ss);
  const float sc = rsqrtf(ss * (1.f / 1024.f) + EPS);
#pragma unroll
  for (int q = 0; q < 4; ++q) {
    const float4 wv = ((const float4*)wgt)[lane + 64 * q];
    float4 y = make_float4(v[q].x * sc * wv.x, v[q].y * sc * wv.y, v[q].z * sc * wv.z, v[q].w * sc * wv.w);
    if (final_) ((float4*)(p.out + OFF_YP + (size_t)r * 1024))[lane + 64 * q] = y;
    else *(uint2*)(p.H() + (size_t)r * 1024 + (lane + 64 * q) * 4) = make_uint2(pack2(y.x, y.y), pack2(y.z, y.w));
    if (layer0) ((float4*)(p.X() + (size_t)r * 1024))[lane + 64 * q] = v[q];
  }
}

constexpr int LDS_T = 264;
DI void stage_tile(bf16_t* sT, const f32x16 (&acc)[2][GNB], int wm, int wn, int lr, int lh) {
#pragma unroll
  for (int mi = 0; mi < 2; ++mi)
#pragma unroll
    for (int ni = 0; ni < GNB; ++ni) {
      bf16_t* d = sT + (wm * 64 + mi * 32 + 4 * lh) * LDS_T + wn * 128 + ni * 32 + lr;
#pragma unroll
      for (int ig = 0; ig < 4; ++ig) {
        const unsigned p01 = pack2(acc[mi][ni][4 * ig], acc[mi][ni][4 * ig + 1]), p23 = pack2(acc[mi][ni][4 * ig + 2], acc[mi][ni][4 * ig + 3]);
        d[(8 * ig) * LDS_T] = (bf16_t)(p01 & 0xffffu); d[(8 * ig + 1) * LDS_T] = (bf16_t)(p01 >> 16);
        d[(8 * ig + 2) * LDS_T] = (bf16_t)(p23 & 0xffffu); d[(8 * ig + 3) * LDS_T] = (bf16_t)(p23 >> 16);
      }
    }
}
DI void tile_writeout(bf16_t* __restrict__ dst, int ld, const bf16_t* sT) {
  const int tid = tidx();
#pragma unroll 4
  for (int it = 0; it < 16; ++it) {
    const int idx = tid + 256 * it, row = idx >> 5, chunk = idx & 31;
    *(uint4*)(dst + (size_t)row * ld + chunk * 8) = *(const uint4*)(sT + row * LDS_T + chunk * 8);
  }
}

DI void inproj_job(const P& p, int l, int job, char* smem) {
  int mt, nt;
  if (!gemm_tile(job, 129, 35, mt, nt)) return;
  int m0 = mt * 128, n0 = nt * 256;
  f32x16 acc[2][GNB];
#pragma unroll
  for (int a = 0; a < 2; ++a)
#pragma unroll
    for (int b = 0; b < GNB; ++b) zero16(acc[a][b]);
  gemm_mainloop(p.H() + (size_t)m0 * 1024, 1024, p.Wt() + (size_t)l * W_LAYER + WO_IN + (size_t)n0 * 1024, 1024, 1024, acc, smem);
  m0 = launder_s(m0); n0 = launder_s(n0);
  nt = launder_s(nt); mt = launder_s(mt);
  const int tid = tidx(), lane = tid & 63, w = __builtin_amdgcn_readfirstlane(tid >> 6), wm = w & 1, wn = w >> 1, lr = lane & 31, lh = lane >> 5;
  bf16_t* sT = (bf16_t*)smem;
  if (nt == 34) {
    if (wn == 0 && lr < 16) {
      const float bias = p.dt_bias[l * 16 + lr];
#pragma unroll
      for (int mi = 0; mi < 2; ++mi)
#pragma unroll
        for (int i = 0; i < 16; ++i) p.DT()[(size_t)(m0 + wm * 64 + mi * 32 + crow(i, lh)) * 16 + lr] = softplus_f(acc[mi][0][i] + bias);
    }
    return;
  }
  if (nt >= 16 && nt <= 20) {
#pragma unroll
    for (int mi = 0; mi < 2; ++mi)
#pragma unroll
      for (int ni = 0; ni < GNB; ni += 2)
#pragma unroll
        for (int i = 0; i < 16; ++i) {
          const float v = acc[mi][ni][i];
          const float pv = __shfl_xor(v, 8);
          if (lr < 16) {
            const int r = m0 + wm * 64 + mi * 32 + crow(i, lh);
            const int pos = (r >= TP) ? 8192 : (r & 8191);
            const float2 cs = p.ROPE()[pos * 8 + (lr & 7)];
            acc[mi][ni][i] = (lr < 8) ? v * cs.x - pv * cs.y : v * cs.x + pv * cs.y;
          }
        }
  }
  if (nt >= 22) {
#pragma unroll
    for (int mi = 0; mi < 2; ++mi)
#pragma unroll
      for (int ni = 0; ni < GNB; ++ni)
#pragma unroll
        for (int i = 0; i < 16; ++i) acc[mi][ni][i] = sigm_f(acc[mi][ni][i]);
  }
  if ((mt == 63 || mt == 127 || mt == 128) && ((nt >= 4 && nt < 12) || nt == 20 || nt == 21)) {
#pragma unroll
    for (int mi = 0; mi < 2; ++mi)
#pragma unroll
      for (int ni = 0; ni < GNB; ++ni) {
        const int cc = (n0 & 255) + wn * 128 + ni * 32 + lr;
        const int rb_ = launder(m0 + wm * 64 + mi * 32 + 4 * lh);
#pragma unroll
        for (int i = 0; i < 16; ++i) {
          const int r = rb_ + (i & 3) + 8 * (i >> 2);
          const float v = acc[mi][ni][i];
          if (nt < 12) {
            const int ch = (n0 - 1024) + cc;
            if (r >= TP) p.out[OFF_CONVS + ((size_t)(l * 128 + (r - TP)) * 3 + 2) * 2048 + ch] = v;
            else { const int t = r & 8191; if (t >= 8189) p.out[OFF_CONVP + ((size_t)(l * 2 + (r >> 13)) * 3 + (t - 8189)) * 2048 + ch] = v; }
          } else {
            const size_t ob = (nt == 20) ? OFF_KS : OFF_VS, obp = (nt == 20) ? OFF_KP : OFF_VP;
            if (r >= TP) p.out[ob + ((size_t)(l * 128 + (r - TP)) * 128 + 127) * 256 + cc] = v;
            else p.out[obp + ((size_t)(l * 2 + (r >> 13)) * 128 + ((r & 8191) - 8064)) * 256 + cc] = v;
          }
        }
        __builtin_amdgcn_sched_barrier(0);
      }
  }
  if (nt == 21) {
#pragma unroll
    for (int mi = 0; mi < 2; ++mi)
#pragma unroll
      for (int ni = 0; ni < GNB; ++ni) {
        bf16_t* d = sT + (wn * 128 + ni * 32 + lr) * 136 + wm * 64 + mi * 32 + 4 * lh;
#pragma unroll
        for (int ig = 0; ig < 4; ++ig)
          *(uint2*)(d + 8 * ig) = make_uint2(pack2(acc[mi][ni][4 * ig], acc[mi][ni][4 * ig + 1]), pack2(acc[mi][ni][4 * ig + 2], acc[mi][ni][4 * ig + 3]));
      }
    __syncthreads();
#pragma unroll 4
    for (int it = 0; it < 16; ++it) {
      const int idx = tid + 256 * it, c = idx >> 4, chunk = idx & 15;
      *(uint4*)(p.VT() + (size_t)c * T + m0 + chunk * 8) = *(const uint4*)(sT + c * 136 + chunk * 8);
    }
    return;
  }
  stage_tile(sT, acc, wm, wn, lr, lh);
  __syncthreads();
  bf16_t* dst; int ld;
  if (nt < 4) { dst = p.Z() + n0; ld = 1024; }
  else if (nt < 12) { dst = p.XBC() + (n0 - 1024); ld = 2048; }
  else if (nt < 16) { dst = p.U() + (n0 - 3072); ld = 1024; }
  else if (nt < 20) { dst = p.Q() + (n0 - 4096); ld = 1024; }
  else if (nt == 20) { dst = p.K(); ld = 256; }
  else { dst = p.G() + (n0 - 5632); ld = 3072; }
  tile_writeout(dst + (size_t)m0 * ld, ld, sT);
}

DI void conv_job(const P& p, int l, int job, char* smem) {
  const int ct = job & 31, tt = job >> 5;
  const int ch0 = ct * 64, tokb = tt * 128;
  bf16_t* sT = (bf16_t*)smem;
  const int tid = tidx();
  const float* cw = p.conv_w + (size_t)l * 4 * 2048;
  __syncthreads();
  const int chk = tid & 7, ch = ch0 + chk * 8;
  float wt[4][8], bs[8];
  {
    const float4 b0 = *(const float4*)(p.conv_b + l * 2048 + ch), b1 = *(const float4*)(p.conv_b + l * 2048 + ch + 4);
    bs[0] = b0.x; bs[1] = b0.y; bs[2] = b0.z; bs[3] = b0.w; bs[4] = b1.x; bs[5] = b1.y; bs[6] = b1.z; bs[7] = b1.w;
#pragma unroll
    for (int j = 0; j < 4; ++j) {
      const float4 w0 = *(const float4*)(cw + j * 2048 + ch), w1 = *(const float4*)(cw + j * 2048 + ch + 4);
      wt[j][0] = w0.x; wt[j][1] = w0.y; wt[j][2] = w0.z; wt[j][3] = w0.w; wt[j][4] = w1.x; wt[j][5] = w1.y; wt[j][6] = w1.z; wt[j][7] = w1.w;
    }
  }
#pragma unroll
  for (int it = 0; it < 4; ++it) {
    const int item = tid + 256 * it, tl = item >> 3, row = tokb + tl, t = row & 8191;
    float a[8];
#pragma unroll
    for (int j = 0; j < 8; ++j) a[j] = bs[j];
#pragma unroll
    for (int j = 0; j < 4; ++j) {
      if (t - 3 + j >= 0) {
        const uint4 rv = *(const uint4*)(p.XBC() + (size_t)(row - 3 + j) * 2048 + ch);
        a[0] += bflo(rv.x) * wt[j][0]; a[1] += bfhi(rv.x) * wt[j][1]; a[2] += bflo(rv.y) * wt[j][2]; a[3] += bfhi(rv.y) * wt[j][3];
        a[4] += bflo(rv.z) * wt[j][4]; a[5] += bfhi(rv.z) * wt[j][5]; a[6] += bflo(rv.w) * wt[j][6]; a[7] += bfhi(rv.w) * wt[j][7];
      }
    }
#pragma unroll
    for (int j = 0; j < 8; ++j) a[j] = silu_f(a[j]);
    if (ct >= 16) *(uint4*)(p.BC() + (size_t)row * 1024 + (ch - 1024)) = make_uint4(pack2(a[0], a[1]), pack2(a[2], a[3]), pack2(a[4], a[5]), pack2(a[6], a[7]));
    if (ct < 24) {
#pragma unroll
      for (int j = 0; j < 8; ++j) sT[(chk * 8 + j) * 136 + (tl ^ (chk << 3))] = f2bf(a[j]);
    }
  }
  if (ct < 24) {
    __syncthreads();
#pragma unroll
    for (int it = 0; it < 4; ++it) {
      const int item = tid + 256 * it, r = item >> 4, chk = item & 15;
      *(uint4*)(p.XBT() + (size_t)(ch0 + r) * TP + tokb + chk * 8) = *(const uint4*)(sT + r * 136 + ((chk ^ (r >> 3)) << 3));
    }
  }
}

DI void chunk_acum(const P& p, int l, int head, int tok0, float* sAc, float* sDt, float& alast) {
  const int lane = tidx() & 63;
  const float Ah = -expf(p.a_log[l * 16 + head]);
  const float d0 = p.DT()[(size_t)(tok0 + 2 * lane) * 16 + head], d1 = p.DT()[(size_t)(tok0 + 2 * lane + 1) * 16 + head];
  const float a0 = d0 * Ah, a1 = d1 * Ah;
  float s = a0 + a1;
#pragma unroll
  for (int off = 1; off < 64; off <<= 1) { const float tv = __shfl_up(s, off); if (lane >= off) s += tv; }
  const float excl = s - (a0 + a1);
  sAc[2 * lane] = excl + a0; sAc[2 * lane + 1] = s;
  sDt[2 * lane] = d0; sDt[2 * lane + 1] = d1;
  alast = __shfl(s, 63);
}

DI void ssd_a_job(const P& p, int l, int job, char* smem) {
  const int head = job & 15, c = (job >> 4) & 63, b = job >> 10, g = head >> 2;
  const int tok0 = b * SEQ + c * 128;
  bf16_t* sXT = (bf16_t*)smem;
  bf16_t* sBT = sXT + 64 * 136;
  float* sW = (float*)(sBT + 128 * 136);
  float* sAc = sW + 128;
  float* sDt = sAc + 128;
  const int tid = tidx(), lane = tid & 63, w = __builtin_amdgcn_readfirstlane(tid >> 6), lr = lane & 31, lh = lane >> 5;
  __syncthreads();
  if (w == 0) {
    float alast;
    chunk_acum(p, l, head, tok0, sAc, sDt, alast);
    sW[2 * lane] = sDt[2 * lane] * __expf(alast - sAc[2 * lane]);
    sW[2 * lane + 1] = sDt[2 * lane + 1] * __expf(alast - sAc[2 * lane + 1]);
    if (lane == 0) p.CDEC()[(b * 64 + c) * 16 + head] = __expf(alast);
  }
  __syncthreads();
#pragma unroll
  for (int it = 0; it < 4; ++it) {
    const int item = tid + 256 * it, pr = item >> 4, s0 = (item & 15) * 8;
    const uint4 v = *(const uint4*)(p.XBT() + (size_t)(head * 64 + pr) * TP + tok0 + s0);
    const float4 w0 = *(const float4*)(sW + s0), w1 = *(const float4*)(sW + s0 + 4);
    *(uint4*)(sXT + pr * 136 + s0) = make_uint4(pack2(bflo(v.x) * w0.x, bfhi(v.x) * w0.y), pack2(bflo(v.y) * w0.z, bfhi(v.y) * w0.w),
                                                pack2(bflo(v.z) * w1.x, bfhi(v.z) * w1.y), pack2(bflo(v.w) * w1.z, bfhi(v.w) * w1.w));
  }
#pragma unroll
  for (int it = 0; it < 8; ++it) {
    const int item = tid + 256 * it, n = item >> 4, s0 = (item & 15) * 8;
    *(uint4*)(sBT + n * 136 + s0) = *(const uint4*)(p.XBT() + (size_t)(1024 + g * 128 + n) * TP + tok0 + s0);
  }
  __syncthreads();
  const int wp = w & 1, wn = w >> 1;
  f32x16 acc[2];
  zero16(acc[0]); zero16(acc[1]);
#pragma unroll
  for (int kk = 0; kk < 8; ++kk) {
    const bf16x8 af = *(const bf16x8*)(sXT + (wp * 32 + lr) * 136 + kk * 16 + lh * 8);
#pragma unroll
    for (int ni = 0; ni < 2; ++ni) {
      const bf16x8 bfr = *(const bf16x8*)(sBT + (wn * 64 + ni * 32 + lr) * 136 + kk * 16 + lh * 8);
      acc[ni] = MFMA32(af, bfr, acc[ni]);
    }
  }
  float* st = p.ST() + ((size_t)((b * 64 + c) * 16 + head) * 64) * 128;
#pragma unroll
  for (int ni = 0; ni < 2; ++ni)
#pragma unroll
    for (int i = 0; i < 16; ++i) st[(wp * 32 + crow(i, lh)) * 128 + wn * 64 + ni * 32 + lr] = acc[ni][i];
}

DI void ssd_scan_job(const P& p, int l, int job) {
  const int gid = job * 256 + tidx();
  const int b = gid >> 15, rem = gid & 32767, head = rem >> 11;
  float4 h = make_float4(0.f, 0.f, 0.f, 0.f);
  const float4* sp0 = (const float4*)(p.ST() + (size_t)(b * 64) * 131072) + rem;
  uint2* hp0 = (uint2*)(p.HP() + (size_t)(b * 64) * 131072) + rem;
  for (int c0 = 0; c0 < 64; c0 += 16) {
    float4 sv[16];
    float dv[16];
#pragma unroll
    for (int k = 0; k < 16; ++k) { sv[k] = sp0[(size_t)(c0 + k) * 32768]; dv[k] = p.CDEC()[(b * 64 + c0 + k) * 16 + head]; }
#pragma unroll
    for (int k = 0; k < 16; ++k) {
      hp0[(size_t)(c0 + k) * 32768] = make_uint2(pack2(h.x, h.y), pack2(h.z, h.w));
      h.x = h.x * dv[k] + sv[k].x; h.y = h.y * dv[k] + sv[k].y; h.z = h.z * dv[k] + sv[k].z; h.w = h.w * dv[k] + sv[k].w;
    }
  }
  ((float4*)(p.out + OFF_SSMP + (size_t)(l * 2 + b) * 131072))[rem] = h;
}

DI void s5_scan_job(const P& p, int l, int job) {
  const int gid = job * 256 + tidx();
  const int n = gid & 63, g = (gid >> 6) & 63, b = gid >> 12;
  const float* prm = p.S5P() + ((size_t)(l * 64 + g) * 36) * 64 + n;
  const float aqr = prm[128], aqi = prm[192];
  float hr = 0.f, hi = 0.f;
  float2* sp = (float2*)p.S5S() + ((size_t)(b * 128) * 64 + g) * 64 + n;
  for (int c0 = 0; c0 < 128; c0 += 8) {
    float2 sv[8];
#pragma unroll
    for (int k = 0; k < 8; ++k) sv[k] = sp[(size_t)(c0 + k) * 4096];
#pragma unroll
    for (int k = 0; k < 8; ++k) {
      sp[(size_t)(c0 + k) * 4096] = make_float2(hr, hi);
      const float nr = aqr * hr - aqi * hi + sv[k].x, ni = aqr * hi + aqi * hr + sv[k].y;
      hr = nr; hi = ni;
    }
  }
}

DI void ssd_c_job(const P& p, int l, int job, char* smem) {
  const int g = job & 3, c = (job >> 2) & 63, b = job >> 8;
  const int tok0 = b * SEQ + c * 128;
  bf16_t* sC = (bf16_t*)smem;
  bf16_t* sB = sC + 128 * 136;
  float* sAc = (float*)(sB + 128 * 136);
  float* sDt = sAc + 512;
  const int tid = tidx(), lane = tid & 63, w = __builtin_amdgcn_readfirstlane(tid >> 6), lr = lane & 31, lh = lane >> 5, wm = w & 1, wn = w >> 1;
  __syncthreads();
  { float alast; chunk_acum(p, l, g * 4 + w, tok0, sAc + w * 128, sDt + w * 128, alast); }
#pragma unroll
  for (int it = 0; it < 8; ++it) {
    const int item = tid + 256 * it, r = item >> 4, s0 = (item & 15) * 8;
    *(uint4*)(sC + r * 136 + s0) = *(const uint4*)(p.BC() + (size_t)(tok0 + r) * 1024 + 512 + g * 128 + s0);
    *(uint4*)(sB + r * 136 + s0) = *(const uint4*)(p.BC() + (size_t)(tok0 + r) * 1024 + g * 128 + s0);
  }
  __syncthreads();
  f32x16 cb[2][2];
#pragma unroll
  for (int a = 0; a < 2; ++a)
#pragma unroll
    for (int bb = 0; bb < 2; ++bb) zero16(cb[a][bb]);
  if (!(wm == 0 && wn == 1)) {
#pragma unroll
    for (int kk = 0; kk < 8; ++kk) {
      bf16x8 af[2], bfr[2];
#pragma unroll
      for (int mi = 0; mi < 2; ++mi) af[mi] = *(const bf16x8*)(sC + (wm * 64 + mi * 32 + lr) * 136 + kk * 16 + lh * 8);
#pragma unroll
      for (int ni = 0; ni < 2; ++ni) bfr[ni] = *(const bf16x8*)(sB + (wn * 64 + ni * 32 + lr) * 136 + kk * 16 + lh * 8);
#pragma unroll
      for (int mi = 0; mi < 2; ++mi)
#pragma unroll
        for (int ni = 0; ni < 2; ++ni) cb[mi][ni] = MFMA32(af[mi], bfr[ni], cb[mi][ni]);
    }
  }
  __syncthreads();
  bf16_t* sM = sB;
  unsigned cbp[2][2][8];
#pragma unroll
  for (int a = 0; a < 2; ++a)
#pragma unroll
    for (int bb = 0; bb < 2; ++bb)
#pragma unroll
      for (int k = 0; k < 8; ++k) cbp[a][bb][k] = pack2(cb[a][bb][2 * k], cb[a][bb][2 * k + 1]);
  float ss[16];
#pragma unroll
  for (int i = 0; i < 16; ++i) ss[i] = 0.f;
#pragma unroll 1
  for (int hd = 0; hd < 4; ++hd) {
    const int head = g * 4 + hd;
    const float* ac = sAc + hd * 128;
    const float* dtv = sDt + hd * 128;
    const int lrq = launder(lr), lhq = launder(lh);
#pragma unroll
    for (int mi = 0; mi < 2; ++mi)
#pragma unroll
      for (int ni = 0; ni < 2; ++ni) {
        const int s = wn * 64 + ni * 32 + lrq;
        const float as = ac[s], ds = dtv[s];
#pragma unroll
        for (int i = 0; i < 16; ++i) {
          const int t = wm * 64 + mi * 32 + crow(i, lhq);
          const float cv = (i & 1) ? bfhi(cbp[mi][ni][i >> 1]) : bflo(cbp[mi][ni][i >> 1]);
          const float v = (s <= t) ? cv * __expf(ac[t] - as) * ds : 0.f;
          sM[t * 136 + s] = f2bf(v);
        }
        __builtin_amdgcn_sched_barrier(0);
      }
    __syncthreads();
    f32x16 yd[2];
    zero16(yd[0]); zero16(yd[1]);
    {
      const bf16_t* hb = p.HP() + (((size_t)((b * 64 + c) * 16 + head) * 64 + lr) * 128 + lh * 8);
      bf16x8 hf[8][2];
#pragma unroll
      for (int kk = 0; kk < 8; ++kk)
#pragma unroll
        for (int pb = 0; pb < 2; ++pb) hf[kk][pb] = *(const bf16x8*)(hb + (size_t)pb * 32 * 128 + kk * 16);
#pragma unroll
      for (int kk = 0; kk < 8; ++kk) {
        const bf16x8 af = *(const bf16x8*)(sC + (32 * w + lr) * 136 + kk * 16 + lh * 8);
        yd[0] = MFMA32(af, hf[kk][0], yd[0]);
        yd[1] = MFMA32(af, hf[kk][1], yd[1]);
      }
    }
#pragma unroll
    for (int i = 0; i < 16; ++i) {
      const float e = __expf(ac[32 * w + crow(i, lh)]);
      yd[0][i] *= e; yd[1][i] *= e;
    }
    {
      const int nkk = 2 * (w + 1);
      const bf16_t* xb = p.XBT() + (size_t)(head * 64 + lr) * TP + tok0 + lh * 8;
      const bf16_t* am = sM + (32 * w + lr) * 136 + lh * 8;
      bf16x8 x00 = *(const bf16x8*)(xb), x01 = *(const bf16x8*)(xb + (size_t)32 * TP);
      for (int kk = 0; kk < nkk; kk += 2) {
        const bf16x8 x10 = *(const bf16x8*)(xb + (kk + 1) * 16), x11 = *(const bf16x8*)(xb + (size_t)32 * TP + (kk + 1) * 16);
        const bf16x8 a0 = *(const bf16x8*)(am + kk * 16);
        yd[0] = MFMA32(a0, x00, yd[0]);
        yd[1] = MFMA32(a0, x01, yd[1]);
        const int kn = (kk + 2 < nkk) ? kk + 2 : kk;
        x00 = *(const bf16x8*)(xb + kn * 16); x01 = *(const bf16x8*)(xb + (size_t)32 * TP + kn * 16);
        const bf16x8 a1 = *(const bf16x8*)(am + (kk + 1) * 16);
        yd[0] = MFMA32(a1, x10, yd[0]);
        yd[1] = MFMA32(a1, x11, yd[1]);
      }
    }
    const float Dh = p.m_d[l * 16 + head];
#pragma unroll
    for (int pb = 0; pb < 2; ++pb) {
      const int pch = head * 64 + pb * 32 + lr;
#pragma unroll
      for (int ig = 0; ig < 4; ++ig) {
        const int t0 = 32 * w + 8 * ig + 4 * lh;
        const uint2 xr = *(const uint2*)(p.XBT() + (size_t)pch * TP + tok0 + t0);
        const float xs[4] = {bflo(xr.x), bfhi(xr.x), bflo(xr.y), bfhi(xr.y)};
#pragma unroll
        for (int jj = 0; jj < 4; ++jj) {
          const int i = 4 * ig + jj, t = t0 + jj;
          const float y = yd[pb][i] + Dh * xs[jj];
          const float z = bf2f(p.Z()[(size_t)(tok0 + t) * 1024 + pch]);
          const float yg = y * silu_f(z);
          ss[i] += yg * yg;
          p.YM()[(size_t)(tok0 + t) * 1024 + pch] = f2bf(yg);
        }
      }
      __builtin_amdgcn_sched_barrier(0);
    }
    __syncthreads();
  }
#pragma unroll
  for (int i = 0; i < 16; ++i) {
    float v = ss[i];
    v += __shfl_xor(v, 1); v += __shfl_xor(v, 2); v += __shfl_xor(v, 4); v += __shfl_xor(v, 8); v += __shfl_xor(v, 16);
    ss[i] = rsqrtf(v * (1.f / 256.f) + EPS);
  }
  for (int hd = 0; hd < 4; ++hd) {
#pragma unroll
    for (int pb = 0; pb < 2; ++pb) {
      const int pch = (g * 4 + hd) * 64 + pb * 32 + lr;
      const float nw = p.m_norm_w[l * 1024 + pch];
#pragma unroll
      for (int i = 0; i < 16; ++i) {
        const size_t idx = (size_t)(tok0 + 32 * w + crow(i, lh)) * 1024 + pch;
        p.YM()[idx] = f2bf(bf2f(p.YM()[idx]) * ss[i] * nw);
      }
      __builtin_amdgcn_sched_barrier(0);
    }
  }
}

DI void ssd_sample_job(const P& p, int l, int job, char* smem) {
  const int g = job & 3, b = job >> 2;
  float* sx = (float*)smem;
  float* sBv = sx + 256;
  float* sCv = sBv + 128;
  float* sY = sCv + 128;
  float* sRed = sY + 256;
  const int tid = tidx(), lane = tid & 63, w = __builtin_amdgcn_readfirstlane(tid >> 6);
  const int row = TP + b;
  __syncthreads();
#pragma unroll
  for (int it = 0; it < 2; ++it) {
    const int idx = tid + 256 * it;
    const int ch = idx < 256 ? g * 256 + idx : (idx < 384 ? 1024 + g * 128 + (idx - 256) : 1536 + g * 128 + (idx - 384));
    const float* sc = p.state_conv + ((size_t)(l * 128 + b) * 3) * 2048 + ch;
    const float s0 = sc[0], s1 = sc[2048], s2 = sc[4096];
    const float raw = bf2f(p.XBC()[(size_t)row * 2048 + ch]);
    const float* cw = p.conv_w + (size_t)l * 4 * 2048 + ch;
    float v = p.conv_b[l * 2048 + ch] + cw[0] * s0 + cw[2048] * s1 + cw[4096] * s2 + cw[6144] * raw;
    v = silu_f(v);
    sx[idx] = v;
    float* co = p.out + OFF_CONVS + ((size_t)(l * 128 + b) * 3) * 2048 + ch;
    co[0] = s1; co[2048] = s2;
  }
  __syncthreads();
  const int pp = tid >> 2, nq = (tid & 3) * 32;
  float4 hv[4][8];
#pragma unroll
  for (int hd = 0; hd < 4; ++hd) {
    const float4* h0 = (const float4*)(p.state_ssm + ((((size_t)l * 128 + b) * 16 + g * 4 + hd) * 64 + pp) * 128 + nq);
#pragma unroll
    for (int q = 0; q < 8; ++q) hv[hd][q] = h0[q];
  }
#pragma unroll
  for (int hd = 0; hd < 4; ++hd) {
    const int head = g * 4 + hd;
    const float dt = p.DT()[(size_t)row * 16 + head];
    const float Ah = -expf(p.a_log[l * 16 + head]);
    const float dA = __expf(dt * Ah);
    const float xv = sx[hd * 64 + pp];
    const float coef = dt * xv;
    float4* ho = (float4*)(p.out + OFF_SSMS + ((((size_t)l * 128 + b) * 16 + head) * 64 + pp) * 128 + nq);
    float yacc = 0.f;
#pragma unroll
    for (int q = 0; q < 8; ++q) {
      float4 h4 = hv[hd][q];
      const int n = nq + 4 * q;
      h4.x = h4.x * dA + coef * sBv[n]; h4.y = h4.y * dA + coef * sBv[n + 1]; h4.z = h4.z * dA + coef * sBv[n + 2]; h4.w = h4.w * dA + coef * sBv[n + 3];
      yacc += h4.x * sCv[n] + h4.y * sCv[n + 1] + h4.z * sCv[n + 2] + h4.w * sCv[n + 3];
      ho[q] = h4;
    }
    yacc += __shfl_xor(yacc, 1); yacc += __shfl_xor(yacc, 2);
    const float y = yacc + p.m_d[l * 16 + head] * xv;
    const float z = bf2f(p.Z()[(size_t)row * 1024 + head * 64 + pp]);
    if ((tid & 3) == 0) sY[hd * 64 + pp] = y * silu_f(z);
  }
  __syncthreads();
  const float v = sY[tid];
  const float ssq = wave_sum(v * v);
  if (lane == 0) sRed[w] = ssq;
  __syncthreads();
  const float tot = sRed[0] + sRed[1] + sRed[2] + sRed[3];
  const float sc = rsqrtf(tot * (1.f / 256.f) + EPS);
  p.YM()[(size_t)row * 1024 + g * 256 + tid] = f2bf(v * sc * p.m_norm_w[l * 1024 + g * 256 + tid]);
}

DI void s5_wave_job(const P& p, int l, int mode, int b, int g, int c_first, int nch, bf16_t* sH) {
  const int lane = tidx() & 63, lr = lane & 31, lh = lane >> 5;
  bf16x8 bq[4];
#pragma unroll
  for (int nb = 0; nb < 4; ++nb) bq[nb] = *(const bf16x8*)(p.BBT() + ((size_t)(l * 64 + g) * 128 + nb * 32 + lr) * 16 + lh * 8);
  float ar[2], ai[2], cr_[2], ci_[2];
#pragma unroll
  for (int k = 0; k < 2; ++k) {
    const float* prm = p.S5P() + ((size_t)(l * 64 + g) * 36) * 64 + k * 32 + lr;
    ar[k] = prm[0]; ai[k] = prm[64];
  }
  const int o = lane & 15, quad = lane >> 4;
  bf16x8 cf[4];
  float dsk = 0.f;
  if (mode != 0) {
#pragma unroll
    for (int kk = 0; kk < 4; ++kk) {
      const float* cp = ((kk < 2) ? p.c_re : p.c_im) + ((size_t)(l * 64 + g) * 16 + o) * 64 + (kk & 1) * 32 + quad * 8;
      const float4 c0 = ((const float4*)cp)[0], c1 = ((const float4*)cp)[1];
      const float sg = (kk < 2) ? 1.f : -1.f;
      cf[kk] = u4_to_bf8(make_uint4(pack2(sg * c0.x, sg * c0.y), pack2(sg * c0.z, sg * c0.w), pack2(sg * c1.x, sg * c1.y), pack2(sg * c1.z, sg * c1.w)));
    }
    dsk = p.s5_d[l * 1024 + g * 16 + o];
  }
  for (int cc = 0; cc < nch; ++cc) {
  const int c = c_first + cc;
  int row0, Q;
  if (mode == 2) { row0 = TP + b; Q = 1; } else { row0 = b * SEQ + c * 64; Q = 64; }
#pragma unroll
  for (int k = 0; k < 2; ++k) {
    const int n = k * 32 + lr;
    cr_[k] = 0.f; ci_[k] = 0.f;
    if (mode == 2) {
      cr_[k] = p.s5_sre[((size_t)(l * 128 + b) * 64 + g) * 64 + n];
      ci_[k] = p.s5_sim[((size_t)(l * 128 + b) * 64 + g) * 64 + n];
    } else if (mode == 1) {
      const float2 sv = *(const float2*)(p.S5S() + (((size_t)(b * 128 + c) * 64 + g) * 64 + n) * 2);
      cr_[k] = sv.x; ci_[k] = sv.y;
    }
  }
  const int ntb = (mode == 2) ? 1 : 2;
  for (int tb = 0; tb < ntb; ++tb) {
    const bf16x8 uf = *(const bf16x8*)(p.U() + (size_t)(row0 + tb * 32 + lr) * 1024 + g * 16 + lh * 8);
    f32x16 acc[4];
#pragma unroll
    for (int nb = 0; nb < 4; ++nb) { zero16(acc[nb]); acc[nb] = MFMA32(uf, bq[nb], acc[nb]); }
#pragma unroll
    for (int k = 0; k < 2; ++k) {
      const float a1r = ar[k], a1i = ai[k];
      const float a2r = a1r * a1r - a1i * a1i, a2i = 2.f * a1r * a1i;
      const float a3r = a2r * a1r - a2i * a1i, a3i = a2r * a1i + a2i * a1r;
      const float a4r = a2r * a2r - a2i * a2i, a4i = 2.f * a2r * a2i;
      float er[4], ei[4];
#pragma unroll
      for (int q = 0; q < 4; ++q) {
        float hr = acc[k][4 * q], hi = acc[2 + k][4 * q];
#pragma unroll
        for (int j = 1; j < 4; ++j) {
          const float nr = a1r * hr - a1i * hi + acc[k][4 * q + j], ni = a1r * hi + a1i * hr + acc[2 + k][4 * q + j];
          hr = nr; hi = ni;
          acc[k][4 * q + j] = hr; acc[2 + k][4 * q + j] = hi;
        }
        er[q] = hr; ei[q] = hi;
      }
      float cinr[4], cini[4];
      float cr = cr_[k], ci = ci_[k];
#pragma unroll
      for (int q = 0; q < 4; ++q) {
        const float per = __shfl_xor(er[q], 32), pei = __shfl_xor(ei[q], 32);
        const float e0r = lh ? per : er[q], e0i = lh ? pei : ei[q];
        const float e1r = lh ? er[q] : per, e1i = lh ? ei[q] : pei;
        const float c1r = a4r * cr - a4i * ci + e0r, c1i = a4r * ci + a4i * cr + e0i;
        cinr[q] = lh ? c1r : cr; cini[q] = lh ? c1i : ci;
        cr = a4r * c1r - a4i * c1i + e1r; ci = a4r * c1i + a4i * c1r + e1i;
      }
#pragma unroll
      for (int q = 0; q < 4; ++q) {
        const float xr = cinr[q], xi = cini[q];
        acc[k][4 * q] += a1r * xr - a1i * xi;     acc[2 + k][4 * q] += a1r * xi + a1i * xr;
        acc[k][4 * q + 1] += a2r * xr - a2i * xi; acc[2 + k][4 * q + 1] += a2r * xi + a2i * xr;
        acc[k][4 * q + 2] += a3r * xr - a3i * xi; acc[2 + k][4 * q + 2] += a3r * xi + a3i * xr;
        acc[k][4 * q + 3] += a4r * xr - a4i * xi; acc[2 + k][4 * q + 3] += a4r * xi + a4i * xr;
      }
      if (mode == 2) { cr_[k] = acc[k][0]; ci_[k] = acc[2 + k][0]; }
      else { cr_[k] = cr; ci_[k] = ci; }
      if (mode != 0) {
#pragma unroll
        for (int i = 0; i < 16; ++i) {
          const int t = tb * 32 + crow(i, lh);
          sH[t * 136 + k * 32 + lr] = f2bf(acc[k][i]);
          sH[t * 136 + 64 + k * 32 + lr] = f2bf(acc[2 + k][i]);
        }
      }
    }
  }
  if (lh == 0) {
#pragma unroll
    for (int k = 0; k < 2; ++k) {
      const int n = k * 32 + lr;
      if (mode == 0) *(float2*)(p.S5S() + (((size_t)(b * 128 + c) * 64 + g) * 64 + n) * 2) = make_float2(cr_[k], ci_[k]);
      if (mode == 1 && c == 127) {
        p.out[OFF_S5RP + ((size_t)(l * 2 + b) * 64 + g) * 64 + n] = cr_[k];
        p.out[OFF_S5IP + ((size_t)(l * 2 + b) * 64 + g) * 64 + n] = ci_[k];
      }
      if (mode == 2) {
        p.out[OFF_S5RS + ((size_t)(l * 128 + b) * 64 + g) * 64 + n] = cr_[k];
        p.out[OFF_S5IS + ((size_t)(l * 128 + b) * 64 + g) * 64 + n] = ci_[k];
      }
    }
  }
  if (mode == 0) continue;
  const int nrb = (mode == 2) ? 1 : 4;
  __builtin_amdgcn_fence(__ATOMIC_RELEASE, "wavefront");
  __builtin_amdgcn_wave_barrier();
  __builtin_amdgcn_fence(__ATOMIC_ACQUIRE, "wavefront");
  for (int rb = 0; rb < nrb; ++rb) {
    f32x4 a4 = {0.f, 0.f, 0.f, 0.f};
#pragma unroll
    for (int kk = 0; kk < 4; ++kk) {
      const bf16x8 af = *(const bf16x8*)(sH + (rb * 16 + o) * 136 + kk * 32 + quad * 8);
      a4 = MFMA16(af, cf[kk], a4);
    }
#pragma unroll
    for (int jj = 0; jj < 4; ++jj) {
      const int t = rb * 16 + quad * 4 + jj;
      if (t < Q) {
        const size_t idx = (size_t)(row0 + t) * 1024 + g * 16 + o;
        const float y = a4[jj] + dsk * bf2f(p.U()[idx]);
        p.YS()[idx] = f2bf(gelu_tanh(y));
      }
    }
  }
  __builtin_amdgcn_fence(__ATOMIC_RELEASE, "wavefront");
  __builtin_amdgcn_wave_barrier();
  }
}

DI void attn_prompt_job(const P& p, int l, int job, char* smem) {
  const int kvh = job & 3, blk = (job >> 2) & 63, b = job >> 8;
  bf16_t* sK = (bf16_t*)smem;
  bf16_t* sVt = sK + 256 * 72;
  const int tid = tidx(), lane = tid & 63, w = __builtin_amdgcn_readfirstlane(tid >> 6), lr = lane & 31, lh = lane >> 5;
  const int tokc0 = b * SEQ + blk * 128 - 128;
  __syncthreads();
#pragma unroll
  for (int it = 0; it < 8; ++it) {
    const int item = tid + 256 * it, row = item >> 3, chk = item & 7;
    uint4 v = make_uint4(0u, 0u, 0u, 0u);
    if (blk > 0 || row >= 128) v = *(const uint4*)(p.K() + (size_t)(tokc0 + row) * 256 + kvh * 64 + chk * 8);
    *(uint4*)(sK + row * 72 + chk * 8) = v;
  }
#pragma unroll
  for (int it = 0; it < 8; ++it) {
    const int item = tid + 256 * it, d = item >> 5, chk = item & 31;
    uint4 v = make_uint4(0u, 0u, 0u, 0u);
    if (blk > 0 || chk >= 16) v = *(const uint4*)(p.VT() + (size_t)(kvh * 64 + d) * T + tokc0 + chk * 8);
    *(uint4*)(sVt + d * 264 + chk * 8) = v;
  }
  __syncthreads();
  const int qtok = b * SEQ + blk * 128 + 32 * w + lr;
#pragma unroll 1
  for (int hq = 0; hq < 4; ++hq) {
  const int head = kvh * 4 + hq;
  const int lrq = launder(lr), lhq = launder(lh);
  bf16x8 qf[4];
#pragma unroll
  for (int kk = 0; kk < 4; ++kk) qf[kk] = *(const bf16x8*)(p.Q() + (size_t)qtok * 1024 + head * 64 + kk * 16 + lhq * 8);
  f32x16 st[5];
#pragma unroll
  for (int x = 0; x < 5; ++x) {
    zero16(st[x]);
#pragma unroll
    for (int kk = 0; kk < 4; ++kk) {
      const bf16x8 af = *(const bf16x8*)(sK + (32 * (w + x) + lrq) * 72 + kk * 16 + lhq * 8);
      st[x] = MFMA32(af, qf[kk], st[x]);
    }
  }
  const float sink = p.sinks[l * 16 + head];
  const int qi = 128 + 32 * w + lrq;
  float m = sink;
#pragma unroll
  for (int x = 0; x < 5; ++x)
#pragma unroll
    for (int i = 0; i < 16; ++i) {
      const int kj = 32 * (w + x) + crow(i, lhq);
      const bool valid = (kj <= qi) && (kj >= qi - 128) && (blk > 0 || kj >= 128);
      const float s = valid ? st[x][i] * 0.125f : -1e30f;
      st[x][i] = s;
      m = fmaxf(m, s);
    }
  m = fmaxf(m, __shfl_xor(m, 32));
  float sum = 0.f;
#pragma unroll
  for (int x = 0; x < 5; ++x)
#pragma unroll
    for (int i = 0; i < 16; ++i) { const float pv = __expf(st[x][i] - m); st[x][i] = pv; sum += pv; }
  sum += __shfl_xor(sum, 32);
  const float inv = 1.f / (sum + __expf(sink - m));
  f32x16 ot[2];
  zero16(ot[0]); zero16(ot[1]);
#pragma unroll
  for (int x = 0; x < 5; ++x)
#pragma unroll
    for (int s = 0; s < 2; ++s) {
      const uint4 pu = make_uint4(pack2(st[x][8 * s] * inv, st[x][8 * s + 1] * inv), pack2(st[x][8 * s + 2] * inv, st[x][8 * s + 3] * inv),
                                  pack2(st[x][8 * s + 4] * inv, st[x][8 * s + 5] * inv), pack2(st[x][8 * s + 6] * inv, st[x][8 * s + 7] * inv));
      const bf16x8 pf = u4_to_bf8(pu);
#pragma unroll
      for (int pb = 0; pb < 2; ++pb) {
        const bf16_t* vp = sVt + (pb * 32 + lrq) * 264 + 32 * (w + x) + 16 * s + 4 * lhq;
        const uint2 lo = *(const uint2*)vp, hi2 = *(const uint2*)(vp + 8);
        ot[pb] = MFMA32(u4_to_bf8(make_uint4(lo.x, lo.y, hi2.x, hi2.y)), pf, ot[pb]);
      }
    }
#pragma unroll
  for (int pb = 0; pb < 2; ++pb)
#pragma unroll
    for (int ig = 0; ig < 4; ++ig) {
      const int d0 = pb * 32 + 8 * ig + 4 * lhq;
      *(uint2*)(p.O() + (size_t)qtok * 1024 + head * 64 + d0) = make_uint2(pack2(ot[pb][4 * ig], ot[pb][4 * ig + 1]), pack2(ot[pb][4 * ig + 2], ot[pb][4 * ig + 3]));
    }
  }
}

DI void attn_sample_job(const P& p, int l, int job, char* smem) {
  const int kvh = job & 3, b = job >> 2;
  const int tid = tidx(), lane = tid & 63, w = __builtin_amdgcn_readfirstlane(tid >> 6);
  const int head = kvh * 4 + w, row = TP + b;
  float* sQ = (float*)smem;
  float* sP = sQ + 256;
  const size_t cbase = ((size_t)(l * 128 + b) * 128) * 256 + kvh * 64;
  const float4* kc4 = (const float4*)(p.cache_k + cbase);
  const float4* vc4 = (const float4*)(p.cache_v + cbase);
  float4* ko4 = (float4*)(p.out + OFF_KS + cbase);
  float4* vo4 = (float4*)(p.out + OFF_VS + cbase);
  __syncthreads();
  for (int idx = tid; idx < 127 * 16; idx += 256) {
    const int j = idx >> 4, q4 = idx & 15;
    ko4[j * 64 + q4] = kc4[(j + 1) * 64 + q4];
    vo4[j * 64 + q4] = vc4[(j + 1) * 64 + q4];
  }
  const float qd = bf2f(p.Q()[(size_t)row * 1024 + head * 64 + lane]);
  sQ[w * 64 + lane] = qd;
  __syncthreads();
  float s0 = 0.f, s1 = 0.f;
#pragma unroll 4
  for (int d4 = 0; d4 < 16; ++d4) {
    const float4 q4 = ((const float4*)(sQ + w * 64))[d4];
    const float4 k0 = kc4[lane * 64 + d4], k1 = kc4[(lane + 64) * 64 + d4];
    s0 += q4.x * k0.x + q4.y * k0.y + q4.z * k0.z + q4.w * k0.w;
    s1 += q4.x * k1.x + q4.y * k1.y + q4.z * k1.z + q4.w * k1.w;
  }
  s0 *= 0.125f; s1 *= 0.125f;
  const float s2 = wave_sum(qd * bf2f(p.K()[(size_t)row * 256 + kvh * 64 + lane])) * 0.125f;
  const float sink = p.sinks[l * 16 + head];
  float m = fmaxf(fmaxf(s0, s1), fmaxf(s2, sink));
  m = wave_max(m);
  const float p0 = __expf(s0 - m), p1 = __expf(s1 - m), p2 = __expf(s2 - m);
  const float sum = wave_sum(p0 + p1);
  const float inv = 1.f / (sum + p2 + __expf(sink - m));
  sP[w * 132 + lane] = p0 * inv; sP[w * 132 + 64 + lane] = p1 * inv;
  __syncthreads();
  const float* vc = p.cache_v + cbase + lane;
  float o = 0.f;
#pragma unroll 8
  for (int j = 0; j < 128; ++j) o += sP[w * 132 + j] * vc[(size_t)j * 256];
  o += p2 * inv * bf2f(p.VT()[(size_t)(kvh * 64 + lane) * T + row]);
  p.O()[(size_t)row * 1024 + head * 64 + lane] = f2bf(o);
}

template <int PASS>
DI void merge_pass(const P& p, const bf16_t* A, const bf16_t* Wt, int m0, int n0, char* smem) {
  m0 = launder_s(m0); n0 = launder_s(n0);
  const int tid = tidx(), lane = tid & 63, w = __builtin_amdgcn_readfirstlane(tid >> 6), wm = w & 1, wn = w >> 1, lr = lane & 31, lh = lane >> 5;
  f32x16 acc[2][GNB];
#pragma unroll
  for (int a = 0; a < 2; ++a)
#pragma unroll
    for (int b = 0; b < GNB; ++b) zero16(acc[a][b]);
  gemm_mainloop(A + (size_t)m0 * 1024, 1024, Wt + (size_t)n0 * 1024, 1024, 1024, acc, smem);
  m0 = launder_s(m0); n0 = launder_s(n0);
  bf16_t* sT = (bf16_t*)smem;
  stage_tile(sT, acc, wm, wn, lr, lh);
  __syncthreads();
  const int goff = (PASS == 0) ? 1024 : (PASS == 2) ? 0 : 2048;
#pragma unroll 2
  for (int it = 0; it < 16; ++it) {
    const int idx = tid + 256 * it, row = idx >> 5, chunk = idx & 31;
    const uint4 av = *(const uint4*)(sT + row * LDS_T + chunk * 8);
    uint4* mp = (uint4*)(p.MG() + (size_t)(m0 + row) * 1024 + n0 + chunk * 8);
    uint4 gv = make_uint4(0u, 0u, 0u, 0u), mv = gv;
    if (PASS != 1) gv = *(const uint4*)(p.G() + (size_t)(m0 + row) * 3072 + goff + n0 + chunk * 8);
    if (PASS != 0) mv = *mp;
    const unsigned aw[4] = {av.x, av.y, av.z, av.w}, gw[4] = {gv.x, gv.y, gv.z, gv.w}, mw[4] = {mv.x, mv.y, mv.z, mv.w};
    unsigned ow[4];
#pragma unroll
    for (int k = 0; k < 4; ++k) {
      const float a0 = bflo(aw[k]), a1 = bfhi(aw[k]), g0 = bflo(gw[k]), g1 = bfhi(gw[k]), m0_ = bflo(mw[k]), m1_ = bfhi(mw[k]);
      float o0, o1;
      if (PASS == 0) { o0 = sigm_f(a0) * g0; o1 = sigm_f(a1) * g1; }
      else if (PASS == 1) { o0 = m0_ * a0; o1 = m1_ * a1; }
      else { o0 = m0_ + a0 * g0; o1 = m1_ + a1 * g1; }
      ow[k] = pack2(o0, o1);
    }
    *mp = make_uint4(ow[0], ow[1], ow[2], ow[3]);
  }
}
DI void merge_job(const P& p, int l, int job, char* smem) {
  int mt, nt;
  if (!gemm_tile(job, 128, 4, mt, nt)) return;
  const int m0 = mt * 128, n0 = nt * 256;
  const bf16_t* wl = p.Wt() + (size_t)l * W_LAYER;
  merge_pass<0>(p, p.YS(), wl + WO_GLU + (size_t)1024 * 1024, m0, n0, smem);
  merge_pass<1>(p, p.YS(), wl + WO_GLU, m0, n0, smem);
  merge_pass<2>(p, p.YM(), wl + WO_MPROJ, m0, n0, smem);
  merge_pass<3>(p, p.O(), wl + WO_ATTNO, m0, n0, smem);
}
DI void resid_gemm_job(const P& p, const bf16_t* A, int lda, const bf16_t* Wt, int K, int job, char* smem) {
  int mt, nt;
  if (!gemm_tile(job, 128, 4, mt, nt)) return;
  int m0 = mt * 128, n0 = nt * 256;
  const int tid = tidx(), lane = tid & 63, w = __builtin_amdgcn_readfirstlane(tid >> 6), wm = w & 1, wn = w >> 1, lr = lane & 31, lh = lane >> 5;
  f32x16 acc[2][GNB];
#pragma unroll
  for (int a = 0; a < 2; ++a)
#pragma unroll
    for (int b = 0; b < GNB; ++b) zero16(acc[a][b]);
  gemm_mainloop(A + (size_t)m0 * lda, lda, Wt + (size_t)n0 * K, K, K, acc, smem);
  m0 = launder_s(m0); n0 = launder_s(n0);
  float* sF = (float*)smem;
#pragma unroll
  for (int h = 0; h < 2; ++h) {
    if (h) __syncthreads();
#pragma unroll
    for (int ni = 0; ni < GNB; ++ni) {
      float* d = sF + (wm * 32 + 4 * lh) * 260 + wn * 128 + ni * 32 + lr;
#pragma unroll
      for (int i = 0; i < 16; ++i) d[((i & 3) + 8 * (i >> 2)) * 260] = acc[h][ni][i];
    }
    __syncthreads();
#pragma unroll 4
    for (int it = 0; it < 16; ++it) {
      const int idx = tid + 256 * it, rl = idx >> 6, c4 = idx & 63;
      const int r = m0 + (rl >> 5) * 64 + h * 32 + (rl & 31);
      float4* xp = (float4*)(p.X() + (size_t)r * 1024 + n0) + c4;
      const float4 a = *(const float4*)(sF + rl * 260 + c4 * 4);
      float4 x = *xp;
      x.x += a.x; x.y += a.y; x.z += a.z; x.w += a.w;
      *xp = x;
    }
  }
}
DI void up_job(const P& p, int l, int job, char* smem) {
  int mt, nt;
  if (!gemm_tile(job, 128, 16, mt, nt)) return;
  int m0 = mt * 128, n0 = nt * 256;
  const int tid = tidx(), lane = tid & 63, w = __builtin_amdgcn_readfirstlane(tid >> 6), wm = w & 1, wn = w >> 1, lr = lane & 31, lh = lane >> 5;
  f32x16 acc[2][GNB];
#pragma unroll
  for (int a = 0; a < 2; ++a)
#pragma unroll
    for (int b = 0; b < GNB; ++b) zero16(acc[a][b]);
  gemm_mainloop(p.H() + (size_t)m0 * 1024, 1024, p.Wt() + (size_t)l * W_LAYER + WO_UP + (size_t)n0 * 1024, 1024, 1024, acc, smem);
#if PROBE_DUP == 12
  gemm_mainloop(p.H() + (size_t)m0 * 1024, 1024, p.Wt() + (size_t)l * W_LAYER + WO_UP + (size_t)n0 * 1024, 1024, 1024, acc, smem);
#pragma unroll
  for (int mi = 0; mi < 2; ++mi)
#pragma unroll
    for (int ni = 0; ni < GNB; ++ni)
#pragma unroll
      for (int i = 0; i < 16; ++i) acc[mi][ni][i] *= 0.5f;
#endif
  m0 = launder_s(m0); n0 = launder_s(n0);
#pragma unroll
  for (int mi = 0; mi < 2; ++mi)
#pragma unroll
    for (int ni = 0; ni < GNB; ++ni)
#pragma unroll
      for (int i = 0; i < 16; ++i) { const float v = fmaxf(acc[mi][ni][i], 0.f); acc[mi][ni][i] = v * v; }
  bf16_t* sT = (bf16_t*)smem;
  stage_tile(sT, acc, wm, wn, lr, lh);
  __syncthreads();
  tile_writeout(p.A2() + (size_t)m0 * 4096 + n0, 4096, sT);
}

DI float skinny_dot(const bf16_t* __restrict__ A, int lda, const bf16_t* __restrict__ Wt, int K, int r0, int c0, char* smem) {
  float* sR = (float*)smem;
  const int tid = tidx(), lane = tid & 63, w = __builtin_amdgcn_readfirstlane(tid >> 6), r = lane & 15, quad = lane >> 4;
  const int kq = K >> 2;
  const bf16_t* ap = A + (size_t)(r0 + r) * lda + w * kq + quad * 8;
  const bf16_t* bp = Wt + (size_t)(c0 + r) * K + w * kq + quad * 8;
  f32x4 acc = {0.f, 0.f, 0.f, 0.f};
#pragma unroll 4
  for (int k = 0; k < kq; k += 32) {
    const bf16x8 a = *(const bf16x8*)(ap + k), b = *(const bf16x8*)(bp + k);
    acc = MFMA16(a, b, acc);
  }
  __syncthreads();
#pragma unroll
  for (int j = 0; j < 4; ++j) sR[w * 256 + (quad * 4 + j) * 16 + r] = acc[j];
  __syncthreads();
  return sR[tid] + sR[256 + tid] + sR[512 + tid] + sR[768 + tid];
}
DI void skinny_dot4(const bf16_t* A0, const bf16_t* A1, const bf16_t* A2_, const bf16_t* A3, const bf16_t* W0, const bf16_t* W1, const bf16_t* W2,
                    const bf16_t* W3, int c00, int c01, int c02, int c03, int r0, char* smem, float (&out)[4]) {
  float* sR = (float*)smem;
  const int tid = tidx(), lane = tid & 63, w = __builtin_amdgcn_readfirstlane(tid >> 6), r = lane & 15, quad = lane >> 4;
  const size_t ao = (size_t)(r0 + r) * 1024 + w * 256 + quad * 8;
  const size_t bo = (size_t)r * 1024 + w * 256 + quad * 8;
  const bf16_t* ap0 = A0 + ao; const bf16_t* ap1 = A1 + ao; const bf16_t* ap2 = A2_ + ao; const bf16_t* ap3 = A3 + ao;
  const bf16_t* bp0 = W0 + (size_t)c00 * 1024 + bo; const bf16_t* bp1 = W1 + (size_t)c01 * 1024 + bo;
  const bf16_t* bp2 = W2 + (size_t)c02 * 1024 + bo; const bf16_t* bp3 = W3 + (size_t)c03 * 1024 + bo;
  f32x4 acc0 = {0.f, 0.f, 0.f, 0.f}, acc1 = acc0, acc2 = acc0, acc3 = acc0;
#pragma unroll 2
  for (int k = 0; k < 256; k += 32) {
    const bf16x8 a0 = *(const bf16x8*)(ap0 + k), b0 = *(const bf16x8*)(bp0 + k);
    const bf16x8 a1 = *(const bf16x8*)(ap1 + k), b1 = *(const bf16x8*)(bp1 + k);
    const bf16x8 a2 = *(const bf16x8*)(ap2 + k), b2 = *(const bf16x8*)(bp2 + k);
    const bf16x8 a3 = *(const bf16x8*)(ap3 + k), b3 = *(const bf16x8*)(bp3 + k);
    acc0 = MFMA16(a0, b0, acc0); acc1 = MFMA16(a1, b1, acc1); acc2 = MFMA16(a2, b2, acc2); acc3 = MFMA16(a3, b3, acc3);
  }
  __syncthreads();
#pragma unroll
  for (int j = 0; j < 4; ++j) {
    const int o = w * 256 + (quad * 4 + j) * 16 + r;
    sR[o] = acc0[j]; sR[1024 + o] = acc1[j]; sR[2048 + o] = acc2[j]; sR[3072 + o] = acc3[j];
  }
  __syncthreads();
#pragma unroll
  for (int q = 0; q < 4; ++q) out[q] = sR[q * 1024 + tid] + sR[q * 1024 + 256 + tid] + sR[q * 1024 + 512 + tid] + sR[q * 1024 + 768 + tid];
}
DI void skinny_merge_job(const P& p, int l, int job, char* smem) {
  const int rt = job & 7, ct = job >> 3;
  const int r0 = TP + rt * 16, c0 = ct * 16;
  const bf16_t* wl = p.Wt() + (size_t)l * W_LAYER;
  float d[4];
  skinny_dot4(p.YS(), p.YS(), p.YM(), p.O(), wl + WO_GLU + (size_t)1024 * 1024, wl + WO_GLU, wl + WO_MPROJ, wl + WO_ATTNO, c0, c0, c0, c0, r0, smem, d);
  const int tid = tidx(), r = r0 + (tid >> 4), c = c0 + (tid & 15);
  const bf16_t* gp = p.G() + (size_t)r * 3072 + c;
  const float v = bf2f(gp[0]) * d[2] + bf2f(gp[1024]) * d[1] * sigm_f(d[0]) + bf2f(gp[2048]) * d[3];
  p.MG()[(size_t)r * 1024 + c] = f2bf(v);
}
DI void skinny_resid_job(const P& p, const bf16_t* A, int lda, const bf16_t* Wt, int K, int job, char* smem) {
  const int rt = job & 7, ct = job >> 3;
  const int r0 = TP + rt * 16, c0 = ct * 16;
  const float v = skinny_dot(A, lda, Wt, K, r0, c0, smem);
  const int tid = tidx();
  p.X()[(size_t)(r0 + (tid >> 4)) * 1024 + c0 + (tid & 15)] += v;
}
DI void skinny_up_job(const P& p, int l, int job, char* smem) {
  const int rt = job & 7, cs = job >> 3;
  const int r0 = TP + rt * 16, c0 = cs * 64;
  const bf16_t* wu = p.Wt() + (size_t)l * W_LAYER + WO_UP;
  float d[4];
  skinny_dot4(p.H(), p.H(), p.H(), p.H(), wu, wu, wu, wu, c0, c0 + 16, c0 + 32, c0 + 48, r0, smem, d);
  const int tid = tidx();
  bf16_t* dst = p.A2() + (size_t)(r0 + (tid >> 4)) * 4096 + c0 + (tid & 15);
#pragma unroll
  for (int q = 0; q < 4; ++q) { const float v = fmaxf(d[q], 0.f); dst[q * 16] = f2bf(v * v); }
}

#define XB_TMO      128
#define XB_XCNT(j)  (256  + 64 * (j))
#define XB_XSUB(j)  (1280 + 64 * (j))
#define XB_XGEN(j)  (2304 + 64 * (j))
#define XB_TOP      3328
#define XB_TOPGEN   3392
#define XCD_BAR_WORDS 3456
#define XB_SPIN_CAP (1u << 20)
#define LAS __attribute__((address_space(3)))
DI unsigned xb_ld(unsigned* p) { return __hip_atomic_load(p, __ATOMIC_RELAXED, __HIP_MEMORY_SCOPE_AGENT); }
DI unsigned xb_add(unsigned* p, unsigned v) { return __hip_atomic_fetch_add(p, v, __ATOMIC_RELAXED, __HIP_MEMORY_SCOPE_AGENT); }
DI unsigned xb_xcc_id() { return (unsigned)__builtin_amdgcn_s_getreg((3 << 11) | 20) & 0xFu; }
#define XB_SPIN(cond, bar) do { unsigned _sp = 0; while (cond) { __builtin_amdgcn_s_sleep(1); \
    if ((++_sp & 255u) == 0u) { if (xb_ld(&(bar)[XB_TMO])) break; if (_sp > XB_SPIN_CAP) { atomicAdd(&(bar)[XB_TMO], 1u); break; } } } } while (0)
struct XcdBarrier { unsigned* bar; unsigned x; volatile LAS unsigned* st; };
DI XcdBarrier xcd_barrier_post(unsigned* bar, volatile LAS unsigned* st) {
  XcdBarrier b; b.bar = bar; b.x = xb_xcc_id(); b.st = st;
  if (threadIdx.x == 0) (void)xb_add(&bar[XB_XCNT(b.x)], 1u);
  return b;
}
DI void xcd_barrier_complete(unsigned* bar, unsigned x, unsigned& nloc, unsigned& nx) {
  const unsigned G = gridDim.x * gridDim.y * gridDim.z;
  unsigned sum, cnt, mine, sp = 0u;
  for (;;) {
    sum = 0u; cnt = 0u; mine = 0u;
#pragma unroll
    for (unsigned j = 0; j < 16; ++j) { const unsigned c = xb_ld(&bar[XB_XCNT(j)]); sum += c; cnt += (c > 0u) ? 1u : 0u; mine = (j == x) ? c : mine; }
    if (sum == G) break;
    __builtin_amdgcn_s_sleep(1);
    if ((++sp & 255u) == 0u) { if (xb_ld(&bar[XB_TMO])) break; if (sp > XB_SPIN_CAP) { atomicAdd(&bar[XB_TMO], 1u); break; } }
  }
  nloc = mine > 0u ? mine : 1u; nx = cnt > 0u ? cnt : 1u;
}
DI void xcd_barrier(const XcdBarrier& b) {
  asm volatile("s_waitcnt vmcnt(0)" ::: "memory");
  __syncthreads();
  if (threadIdx.x == 0) {
    unsigned* bar = b.bar;
    __builtin_amdgcn_s_waitcnt(0);
    unsigned nloc = b.st[0], nx = b.st[1];
    if (nloc == 0u) { xcd_barrier_complete(bar, b.x, nloc, nx); b.st[0] = nloc; b.st[1] = nx; }
    const unsigned old = xb_add(&bar[XB_XSUB(b.x)], 1u);
    const unsigned gen = old / nloc;
    if (old + 1u == (gen + 1u) * nloc) {
      __builtin_amdgcn_fence(__ATOMIC_RELEASE, "agent");
      asm volatile("s_waitcnt vmcnt(0)" ::: "memory");
      const unsigned og = xb_add(&bar[XB_TOP], 1u);
      const unsigned tg = og / nx;
      if (og + 1u == (tg + 1u) * nx) xb_add(&bar[XB_TOPGEN], 1u);
      else XB_SPIN(xb_ld(&bar[XB_TOPGEN]) == tg, bar);
      __builtin_amdgcn_fence(__ATOMIC_ACQUIRE, "agent");
      xb_add(&bar[XB_XGEN(b.x)], 1u);
      asm volatile("s_waitcnt vmcnt(0)" ::: "memory");
    } else {
      XB_SPIN(xb_ld(&bar[XB_XGEN(b.x)]) == gen, bar);
      __builtin_amdgcn_fence(__ATOMIC_ACQUIRE, "agent");
      asm volatile("s_waitcnt vmcnt(0)" ::: "memory");
    }
  }
  __syncthreads();
}

constexpr int NPHASE = 1 + 4 * 11;
DI void phase_jobs(int ph, int& nstd, int& nother) {
  nstd = 0;
  if (ph == 0) { nother = 22272 + 64 + 257 + 4128; return; }
  const int s = (ph - 1) % 11;
  switch (s) {
    case 0: nstd = 129 * 35; nother = 0; break;
    case 1: nother = 512 + 512 + 512 + 4096 + 2048 + 2048; break;
    case 2: nother = 2048; break;
    case 3: nother = 256 + 32; break;
    case 4: nother = 512 + 2048; break;
    case 5: nstd = 512; nother = 512; break;
    case 6: nstd = 512; nother = 512; break;
    case 7: nother = 4128; break;
    case 8: nstd = 2048; nother = 512; break;
    case 9: nstd = 512; nother = 512; break;
    default: nother = 4128; break;
  }
}
DI void run_std_job(const P& p, int ph, int job, char* smem) {
  const int l = (ph - 1) / 11, s = (ph - 1) % 11;
  const bf16_t* wl = p.Wt() + (size_t)l * W_LAYER;
  switch (s) {
    case 0: inproj_job(p, l, job, smem); break;
    case 5: merge_job(p, l, job, smem); break;
    case 6: resid_gemm_job(p, p.MG(), 1024, wl + WO_WOUT, 1024, job, smem); break;
    case 8: up_job(p, l, job, smem); break;
    default: resid_gemm_job(p, p.A2(), 4096, wl + WO_DOWN, 4096, job, smem); break;
  }
}
DI void run_job(const P& p, int ph, int job, char* smem) {
  if (ph == 0) {
    if (job < 22272) { prep_weight_job(p, job, smem); return; }
    job -= 22272;
    if (job < 64) { prep_s5_job(p, job); return; }
    job -= 64;
    if (job < 257) { prep_rope_job(p, job); return; }
    job -= 257;
    norm_job(p, job, p.norm1_w, true, false);
    return;
  }
  const int l = (ph - 1) / 11, s = (ph - 1) % 11;
  const bf16_t* wl = p.Wt() + (size_t)l * W_LAYER;
  const int w = __builtin_amdgcn_readfirstlane(tidx() >> 6);
  switch (s) {
    case 1:
      if (job < 512) { for (int rr = 0; rr < (PROBE_DUP == 11 ? 3 : 1); ++rr) ssd_sample_job(p, l, job, smem); break; }
      job -= 512;
      if (job < 512) { attn_sample_job(p, l, job, smem); break; }
      job -= 512;
      if (job < 512) { attn_prompt_job(p, l, job, smem); break; }
      job -= 512;
      if (job < 4096) { for (int rr = 0; rr < (PROBE_DUP == 9 ? 3 : 1); ++rr) conv_job(p, l, job, smem); break; }
      job -= 4096;
      if (job < 2048) { const int wj = job * 4 + w; s5_wave_job(p, l, 0, wj >> 12, wj & 63, ((wj >> 6) & 63) * 2, 2, nullptr); break; }
      job -= 2048;
      { const int wj = job * 4 + w; __syncthreads(); s5_wave_job(p, l, 2, wj >> 6, wj & 63, 0, 1, (bf16_t*)smem + w * 64 * 136); }
      break;
    case 2: ssd_a_job(p, l, job, smem); break;
    case 3:
      if (job < 256) ssd_scan_job(p, l, job);
      else s5_scan_job(p, l, job - 256);
      break;
    case 4:
      if (job < 512) { for (int rr = 0; rr < (PROBE_DUP == 16 ? 3 : 1); ++rr) ssd_c_job(p, l, job, smem); break; }
      job -= 512;
      { const int wj = job * 4 + w; __syncthreads(); s5_wave_job(p, l, 1, wj >> 12, wj & 63, ((wj >> 6) & 63) * 2, 2, (bf16_t*)smem + w * 64 * 136); }
      break;
    case 5: skinny_merge_job(p, l, job, smem); break;
    case 6: skinny_resid_job(p, p.MG(), 1024, wl + WO_WOUT, 1024, job, smem); break;
    case 7: norm_job(p, job, p.norm2_w + l * 1024, false, false); break;
    case 8: skinny_up_job(p, l, job, smem); break;
    case 9: skinny_resid_job(p, p.A2(), 4096, wl + WO_DOWN, 4096, job, smem); break;
    default:
      if (l == 3) norm_job(p, job, p.final_w, false, true);
      else norm_job(p, job, p.norm1_w + (l + 1) * 1024, false, false);
      break;
  }
}

template <bool COOP>
__global__ void __launch_bounds__(256, 2) mega(P p, int ph0, int ph1) {
  __shared__ __attribute__((aligned(16))) char smem[SMEM_BYTES];
  __shared__ uint4 xb_words;
  XcdBarrier xb;
  if (COOP) {
    if (threadIdx.x == 0) xb_words = make_uint4(0u, 0u, 0u, 0u);
    __syncthreads();
    xb = xcd_barrier_post((unsigned*)(p.ws + WS_BAR), (volatile LAS unsigned*)&xb_words);
  }
  const int G = (int)gridDim.x;
  for (int ph = ph0; ph < ph1; ++ph) {
    int nstd, nother;
    phase_jobs(ph, nstd, nother);
    int reps = 1;
#if PROBE_DUP
    { const int s_ = (ph == 0) ? -1 : (ph - 1) % 11;
      if (PROBE_DUP == 1 && (s_ == 0 || s_ == 5 || s_ == 8)) reps = 2;
      if (PROBE_DUP == 2 && (s_ == 1 || s_ == 2 || s_ == 4)) reps = 2;
      if (PROBE_DUP == 6 && s_ == 4) reps = 2;
      if (PROBE_DUP == 13 && s_ == 8) reps = 2;
      if (PROBE_DUP == 14 && s_ == 2) reps = 3;
      if (PROBE_DUP == 15 && (s_ == 6 || s_ == 9)) reps = 1;
      if (PROBE_DUP == 7 && s_ == 1) reps = 2; }
#endif
    const int nstd_r = ((nstd + G - 1) / G) * G;
    for (int rep = 0; rep < reps; ++rep) {
      for (int job = blockIdx.x; job < nstd_r; job += G) run_std_job(p, ph, job, smem);
      for (int job = blockIdx.x; job < nother; job += G) run_job(p, ph, job, smem);
    }
    if (COOP && ph + 1 < ph1) {
      if (ph == ph0) cg::this_grid().sync();
      else xcd_barrier(xb);
    }
  }
}


extern "C" void kernel_launch(void* const* d_in, const int* in_sizes, int n_in, void* d_out, int out_size, void* d_ws, size_t ws_size,
                              hipStream_t stream) {
  P p{};
  const float** pin = (const float**)&p;
  for (int i = 0; i < 33; ++i) pin[i] = (const float*)d_in[i];
  p.out = (float*)d_out;
  p.ws = (char*)d_ws;
  if (WS_TOTAL > ws_size) { fprintf(stderr, "workspace too small: need %zu have %zu\n", (size_t)WS_TOTAL, ws_size); return; }

#if COOP_MODE
  static int grid_blocks = 0;
  if (!grid_blocks) {
    int dev = 0, cus = 0, per_cu = 0;
    hipGetDevice(&dev);
    hipDeviceGetAttribute(&cus, hipDeviceAttributeMultiprocessorCount, dev);
    hipOccupancyMaxActiveBlocksPerMultiprocessor(&per_cu, mega<true>, 256, 0);
    if (per_cu > 2) per_cu = 2;
    if (per_cu < 1) per_cu = 1;
    grid_blocks = cus * per_cu;
  }
  (void)hipMemsetAsync(p.ws + WS_BAR, 0, 4096 * 4, stream);
  int ph0 = 0, ph1 = NPHASE;
  void* args[] = {&p, &ph0, &ph1};
  hipError_t e = hipLaunchCooperativeKernel((void*)mega<true>, dim3(grid_blocks), dim3(256), args, 0, stream);
  if (e != hipSuccess) fprintf(stderr, "cooperative launch failed: %s (grid %d)\n", hipGetErrorString(e), grid_blocks);
#else
  for (int ph = 0; ph < NPHASE; ++ph) mega<false><<<dim3(1024), dim3(256), 0, stream>>>(p, ph, ph + 1);
#endif
}
```

```cpp
#include <hip/hip_runtime.h>
#include <hip/hip_cooperative_groups.h>
#include <cstdio>
#include <cstdint>
namespace cg = cooperative_groups;

#define DI __device__ __forceinline__
typedef unsigned short bf16_t;
typedef short bf16x8 __attribute__((ext_vector_type(8)));
typedef float f32x16 __attribute__((ext_vector_type(16)));
typedef float f32x4 __attribute__((ext_vector_type(4)));
#define MFMA32(a, b, c) __builtin_amdgcn_mfma_f32_32x32x16_bf16((a), (b), (c), 0, 0, 0)
#define MFMA16(a, b, c) __builtin_amdgcn_mfma_f32_16x16x32_bf16((a), (b), (c), 0, 0, 0)

#ifndef COOP_MODE
#define COOP_MODE 1
#endif
#ifndef PROBE_DUP
#define PROBE_DUP 0
#endif

constexpr int TP = 16384, TS = 128, T = TP + TS, SEQ = 8192;
constexpr int NIN = 8720, NINP = 8960;
constexpr int SMEM_BYTES = 73728;
constexpr float EPS = 1e-6f;

constexpr size_t OFF_YP = 0;
constexpr size_t OFF_YS = OFF_YP + (size_t)TP * 1024;
constexpr size_t OFF_SSMP = OFF_YS + (size_t)TS * 1024;
constexpr size_t OFF_SSMS = OFF_SSMP + (size_t)4 * 2 * 16 * 64 * 128;
constexpr size_t OFF_CONVP = OFF_SSMS + (size_t)4 * 128 * 16 * 64 * 128;
constexpr size_t OFF_CONVS = OFF_CONVP + (size_t)4 * 2 * 3 * 2048;
constexpr size_t OFF_S5RP = OFF_CONVS + (size_t)4 * 128 * 3 * 2048;
constexpr size_t OFF_S5RS = OFF_S5RP + (size_t)4 * 2 * 64 * 64;
constexpr size_t OFF_S5IP = OFF_S5RS + (size_t)4 * 128 * 64 * 64;
constexpr size_t OFF_S5IS = OFF_S5IP + (size_t)4 * 2 * 64 * 64;
constexpr size_t OFF_KP = OFF_S5IS + (size_t)4 * 128 * 64 * 64;
constexpr size_t OFF_KS = OFF_KP + (size_t)4 * 2 * 128 * 256;
constexpr size_t OFF_VP = OFF_KS + (size_t)4 * 128 * 128 * 256;
constexpr size_t OFF_VS = OFF_VP + (size_t)4 * 2 * 128 * 256;

constexpr size_t WO_IN = 0;
constexpr size_t WO_MPROJ = WO_IN + (size_t)NINP * 1024;
constexpr size_t WO_GLU = WO_MPROJ + (size_t)1024 * 1024;
constexpr size_t WO_ATTNO = WO_GLU + (size_t)2048 * 1024;
constexpr size_t WO_WOUT = WO_ATTNO + (size_t)1024 * 1024;
constexpr size_t WO_UP = WO_WOUT + (size_t)1024 * 1024;
constexpr size_t WO_DOWN = WO_UP + (size_t)4096 * 1024;
constexpr size_t W_LAYER = WO_DOWN + (size_t)4096 * 1024;

constexpr size_t al256(size_t x) { return (x + 255) & ~(size_t)255; }
constexpr size_t SZ1 = (size_t)T * 1024 * 2;
constexpr size_t WS_X = 0;
constexpr size_t WS_H = WS_X + al256((size_t)T * 1024 * 4);
constexpr size_t WS_Z = WS_H + al256(SZ1);
constexpr size_t WS_U = WS_Z + al256(SZ1);
constexpr size_t WS_Q = WS_U + al256(SZ1);
constexpr size_t WS_YM = WS_Q + al256(SZ1);
constexpr size_t WS_YS = WS_YM + al256(SZ1);
constexpr size_t WS_O = WS_YS + al256(SZ1);
constexpr size_t WS_MG = WS_O + al256(SZ1);
constexpr size_t WS_XBC = WS_MG + al256(SZ1);
constexpr size_t WS_XBT = WS_XBC + al256((size_t)T * 2048 * 2);
constexpr size_t WS_BC = WS_XBT + al256((size_t)1536 * TP * 2);
constexpr size_t WS_A2END = WS_XBC + al256((size_t)T * 4096 * 2);
constexpr size_t WS_BCEND = WS_BC + al256((size_t)TP * 1024 * 2);
constexpr size_t WS_K = WS_A2END > WS_BCEND ? WS_A2END : WS_BCEND;
constexpr size_t WS_VT = WS_K + al256((size_t)T * 256 * 2);
constexpr size_t WS_G = WS_VT + al256((size_t)T * 256 * 2);
constexpr size_t WS_DT = WS_G + al256((size_t)T * 3072 * 2);
constexpr size_t WS_ST = WS_DT + al256((size_t)T * 16 * 4);
constexpr size_t WS_CDEC = WS_ST + al256((size_t)2 * 64 * 16 * 64 * 128 * 4);
constexpr size_t WS_S5S = WS_CDEC + al256((size_t)2 * 64 * 16 * 4);
constexpr size_t WS_S5P = WS_S5S + al256((size_t)2 * 128 * 64 * 64 * 2 * 4);
constexpr size_t WS_ROPE = WS_S5P + al256((size_t)4 * 64 * 36 * 64 * 4);
constexpr size_t WS_WT = WS_ROPE + al256((size_t)8193 * 8 * 8);
constexpr size_t WS_BAR = WS_WT + al256((size_t)4 * W_LAYER * 2);
constexpr size_t WS_HP = WS_BAR + al256(4096 * 4);
constexpr size_t WS_BBT = WS_HP + al256((size_t)2 * 64 * 16 * 64 * 128 * 2);
constexpr size_t WS_TOTAL = WS_BBT + al256((size_t)4 * 64 * 128 * 16 * 2);

struct P {
  const float *x_prompt, *x_sample, *state_ssm, *state_conv, *s5_sre, *s5_sim, *cache_k, *cache_v;
  const float *norm1_w, *w_in, *conv_w, *conv_b, *dt_bias, *a_log, *m_d, *m_norm_w, *m_proj;
  const float *lam_re, *lam_im, *log_step, *b_re, *b_im, *c_re, *c_im, *s5_d, *glu_w;
  const float *sinks, *attn_o, *w_out, *norm2_w, *mlp_up, *mlp_down, *final_w;
  float* out;
  char* ws;
#define WSACC(name, type, off) __device__ __forceinline__ type* name() const { return (type*)(ws + (off)); }
  WSACC(X, float, WS_X) WSACC(H, bf16_t, WS_H) WSACC(Z, bf16_t, WS_Z) WSACC(U, bf16_t, WS_U) WSACC(Q, bf16_t, WS_Q)
  WSACC(YM, bf16_t, WS_YM) WSACC(YS, bf16_t, WS_YS) WSACC(O, bf16_t, WS_O) WSACC(MG, bf16_t, WS_MG)
  WSACC(XBC, bf16_t, WS_XBC) WSACC(XBT, bf16_t, WS_XBT) WSACC(BC, bf16_t, WS_BC) WSACC(A2, bf16_t, WS_XBC)
  WSACC(K, bf16_t, WS_K) WSACC(VT, bf16_t, WS_VT) WSACC(G, bf16_t, WS_G) WSACC(DT, float, WS_DT) WSACC(ST, float, WS_ST)
  WSACC(CDEC, float, WS_CDEC) WSACC(HP, bf16_t, WS_HP) WSACC(BBT, bf16_t, WS_BBT) WSACC(S5S, float, WS_S5S) WSACC(S5P, float, WS_S5P) WSACC(ROPE, float2, WS_ROPE) WSACC(Wt, bf16_t, WS_WT)
#undef WSACC
};

typedef float f32x2_t __attribute__((ext_vector_type(2)));
typedef __bf16 bf16x2_t __attribute__((ext_vector_type(2)));
DI unsigned pack2(float a, float b) { const f32x2_t v = {a, b}; return __builtin_bit_cast(unsigned, __builtin_convertvector(v, bf16x2_t)); }
DI bf16_t f2bf(float x) { return (bf16_t)(pack2(x, 0.f) & 0xffffu); }
DI float bf2f(bf16_t b) { return __uint_as_float(((unsigned)b) << 16); }
DI float bflo(unsigned u) { return __uint_as_float(u << 16); }
DI float bfhi(unsigned u) { return __uint_as_float(u & 0xffff0000u); }
DI float frcp(float x) { return __builtin_amdgcn_rcpf(x); }
DI float silu_f(float x) { return x * frcp(1.f + __expf(-x)); }
DI float sigm_f(float x) { return frcp(1.f + __expf(-x)); }
DI float softplus_f(float x) { return x > 20.f ? x : log1pf(expf(x)); }
DI float gelu_tanh(float x) { float y = 0.7978845608028654f * (x + 0.044715f * x * x * x); float t = 1.f - 2.f * frcp(__expf(2.f * y) + 1.f); return 0.5f * x * (1.f + t); }
DI int crow(int i, int lh) { return (i & 3) + 8 * (i >> 2) + 4 * lh; }
DI int launder(int x) { asm volatile("" : "+v"(x)); return x; }
DI int tidx() { int t = __builtin_amdgcn_workitem_id_x(); asm volatile("" : "+v"(t)); return t; }
DI int launder_s(int x) { asm volatile("" : "+s"(x)); return x; }
DI float wave_sum(float v) {
#pragma unroll
  for (int o = 32; o >= 1; o >>= 1) v += __shfl_xor(v, o);
  return v;
}
DI float wave_max(float v) {
#pragma unroll
  for (int o = 32; o >= 1; o >>= 1) v = fmaxf(v, __shfl_xor(v, o));
  return v;
}
DI bf16x8 u4_to_bf8(uint4 v) { return __builtin_bit_cast(bf16x8, v); }
DI void zero16(f32x16& a) {
#pragma unroll
  for (int i = 0; i < 16; ++i) a[i] = 0.f;
}

constexpr int LDT = 40;
constexpr int GNB = 4;
DI size_t wfrag(int n, int k8, int K) { return ((size_t)(n >> 5) * (K >> 4) + (k8 >> 4)) * 512 + (((k8 >> 3) & 1) * 32 + (n & 31)) * 8; }
DI void gemm_mainloop(const bf16_t* __restrict__ A, int lda, const bf16_t* __restrict__ Bf, int n0, int K,
                      f32x16 (&acc)[2][GNB], char* smem) {
  bf16_t* sa = (bf16_t*)smem;
  const int tid = tidx(), lane = tid & 63, w = __builtin_amdgcn_readfirstlane(tid >> 6), wm = w & 1, wn = w >> 1, lr = lane & 31, lh = lane >> 5;
  const int r0 = tid >> 2, ch = (tid & 3) * 8;
  const bf16_t* ap = A + (size_t)r0 * lda + ch;
  const int ksteps = K >> 4;
  const bf16_t* bq = Bf + ((size_t)((n0 >> 5) + wn * 4) * ksteps) * 512 + lane * 8;
  const size_t bstride = (size_t)ksteps * 512;
  uint4 pa0, pa1;
  bf16x8 bP0, bP1, bP2, bP3, bP4, bP5, bP6, bP7, bQ0, bQ1, bQ2, bQ3, bQ4, bQ5, bQ6, bQ7;
#define GLOADS(R, k0) R##a0 = *(const uint4*)(ap + (k0)); R##a1 = *(const uint4*)(ap + (size_t)64 * lda + (k0));
#define SSTORES(R, bufi) { bf16_t* da = sa + (bufi)*128 * LDT; *(uint4*)(da + (r0)*LDT + ch) = R##a0; *(uint4*)(da + (r0 + 64) * LDT + ch) = R##a1; }
#define BLOADS(R, kt_)                                                                                     \
  { const bf16_t* bb = bq + (size_t)(kt_) * 1024;                                                          \
    R##0 = *(const bf16x8*)(bb); R##1 = *(const bf16x8*)(bb + 512);                                        \
    R##2 = *(const bf16x8*)(bb + bstride); R##3 = *(const bf16x8*)(bb + bstride + 512);                    \
    R##4 = *(const bf16x8*)(bb + 2 * bstride); R##5 = *(const bf16x8*)(bb + 2 * bstride + 512);            \
    R##6 = *(const bf16x8*)(bb + 3 * bstride); R##7 = *(const bf16x8*)(bb + 3 * bstride + 512); }
#define COMPUTE(bufi, R)                                                                                   \
  { const bf16_t* ca = sa + (bufi)*128 * LDT + (wm * 64 + lr) * LDT + lh * 8;                              \
    const bf16x8 a00 = *(const bf16x8*)(ca), a10 = *(const bf16x8*)(ca + 32 * LDT);                        \
    const bf16x8 a01 = *(const bf16x8*)(ca + 16), a11 = *(const bf16x8*)(ca + 32 * LDT + 16);              \
    acc[0][0] = MFMA32(a00, R##0, acc[0][0]); acc[1][0] = MFMA32(a10, R##0, acc[1][0]);                    \
    acc[0][1] = MFMA32(a00, R##2, acc[0][1]); acc[1][1] = MFMA32(a10, R##2, acc[1][1]);                    \
    acc[0][2] = MFMA32(a00, R##4, acc[0][2]); acc[1][2] = MFMA32(a10, R##4, acc[1][2]);                    \
    acc[0][3] = MFMA32(a00, R##6, acc[0][3]); acc[1][3] = MFMA32(a10, R##6, acc[1][3]);                    \
    acc[0][0] = MFMA32(a01, R##1, acc[0][0]); acc[1][0] = MFMA32(a11, R##1, acc[1][0]);                    \
    acc[0][1] = MFMA32(a01, R##3, acc[0][1]); acc[1][1] = MFMA32(a11, R##3, acc[1][1]);                    \
    acc[0][2] = MFMA32(a01, R##5, acc[0][2]); acc[1][2] = MFMA32(a11, R##5, acc[1][2]);                    \
    acc[0][3] = MFMA32(a01, R##7, acc[0][3]); acc[1][3] = MFMA32(a11, R##7, acc[1][3]); }
  const int nk = K >> 5;
  const int klast = (nk - 1) * 32;
  GLOADS(p, 0)
  BLOADS(bP, 0)
  __syncthreads();
  SSTORES(p, 0)
  BLOADS(bQ, 1)
  __syncthreads();
  for (int kt = 0; kt < nk; kt += 2) {
    GLOADS(p, (kt + 1) * 32)
    COMPUTE(0, bP)
    { const int t2 = (kt + 2 < nk) ? kt + 2 : nk - 1; BLOADS(bP, t2) }
    SSTORES(p, 1)
    __syncthreads();
    { const int k2 = (kt + 2) * 32; const int k0 = k2 < klast ? k2 : klast; GLOADS(p, k0) }
    COMPUTE(1, bQ)
    { const int t3 = (kt + 3 < nk) ? kt + 3 : nk - 1; BLOADS(bQ, t3) }
    SSTORES(p, 0)
    __syncthreads();
  }
#undef GLOADS
#undef SSTORES
#undef BLOADS
#undef COMPUTE
}
DI bool gemm_tile(int slot, int MT, int NT, int& mt, int& nt) {
  const int G = gridDim.x, nx = G >> 3;
  int J = slot;
  if ((G & 7) == 0) J = (slot / G) * G + (slot & 7) * nx + ((slot % G) >> 3);
  if (J >= MT * NT) return false;
  const int gw = 8 * NT, grp = J / gw, rem = J - grp * gw, fm = grp * 8;
  const int gsz = (MT - fm) < 8 ? (MT - fm) : 8;
  mt = fm + rem % gsz; nt = rem / gsz;
  return true;
}

DI int win_map(int n) {
  if (n < 3072) return n;
  if (n < 8704) return n + 16;
  if (n < 8720) return n - 8704 + 3072;
  return -1;
}
DI void wtrans_tile(const float* __restrict__ src, int N, int K, bf16_t* __restrict__ dst, int kt, int nt, bool inmap, char* smem) {
  float* s = (float*)smem;
  const int tid = tidx();
  __syncthreads();
  {
    const int n4 = (tid & 15) * 4;
    int sc = nt * 64 + n4;
    if (inmap) sc = win_map(sc);
#pragma unroll
    for (int ps = 0; ps < 4; ++ps) {
      const int kk = (tid >> 4) + 16 * ps;
      float4 v = make_float4(0.f, 0.f, 0.f, 0.f);
      if (sc >= 0) v = *(const float4*)(src + (size_t)(kt * 64 + kk) * N + sc);
      float* d = s + kk * 65 + n4;
      d[0] = v.x; d[1] = v.y; d[2] = v.z; d[3] = v.w;
    }
  }
  __syncthreads();
  {
    const int n2 = tid >> 2, kq = (tid & 3) * 16;
    unsigned w[8];
#pragma unroll
    for (int j = 0; j < 8; ++j) w[j] = pack2(s[(kq + 2 * j) * 65 + n2], s[(kq + 2 * j + 1) * 65 + n2]);
    const int n = nt * 64 + n2, k0 = kt * 64 + kq;
    bf16_t* d = dst + ((size_t)(n >> 5) * (K >> 4) + (k0 >> 4)) * 512 + (n & 31) * 8;
    *(uint4*)d = make_uint4(w[0], w[1], w[2], w[3]);
    *(uint4*)(d + 256) = make_uint4(w[4], w[5], w[6], w[7]);
  }
}
DI void prep_weight_job(const P& p, int j, char* smem) {
  const int l = j / 5568; int r = j % 5568;
  bf16_t* wl = p.Wt() + (size_t)l * W_LAYER;
  if (r < 2240) { wtrans_tile(p.w_in + (size_t)l * 1024 * NIN, NIN, 1024, wl + WO_IN, r / 140, r % 140, true, smem); return; }
  r -= 2240;
  if (r < 256) { wtrans_tile(p.m_proj + (size_t)l * 1024 * 1024, 1024, 1024, wl + WO_MPROJ, r / 16, r % 16, false, smem); return; }
  r -= 256;
  if (r < 512) { wtrans_tile(p.glu_w + (size_t)l * 1024 * 2048, 2048, 1024, wl + WO_GLU, r / 32, r % 32, false, smem); return; }
  r -= 512;
  if (r < 256) { wtrans_tile(p.attn_o + (size_t)l * 1024 * 1024, 1024, 1024, wl + WO_ATTNO, r / 16, r % 16, false, smem); return; }
  r -= 256;
  if (r < 256) { wtrans_tile(p.w_out + (size_t)l * 1024 * 1024, 1024, 1024, wl + WO_WOUT, r / 16, r % 16, false, smem); return; }
  r -= 256;
  if (r < 1024) { wtrans_tile(p.mlp_up + (size_t)l * 1024 * 4096, 4096, 1024, wl + WO_UP, r / 64, r % 64, false, smem); return; }
  r -= 1024;
  wtrans_tile(p.mlp_down + (size_t)l * 4096 * 1024, 1024, 4096, wl + WO_DOWN, r / 16, r % 16, false, smem);
}
DI void prep_s5_job(const P& p, int j) {
  const int idx = j * 256 + tidx();
  const int n = idx & 63, g = (idx >> 6) & 63, l = idx >> 12;
  const float step = expf(p.log_step[l * 64 + g]);
  const float lr_ = p.lam_re[(l * 64 + g) * 64 + n], li = p.lam_im[(l * 64 + g) * 64 + n];
  const float mag = expf(lr_ * step);
  const float abr = mag * cosf(li * step), abi = mag * sinf(li * step);
  float aqr = abr, aqi = abi;
#pragma unroll
  for (int q = 0; q < 6; ++q) { const float nr2 = aqr * aqr - aqi * aqi, ni2 = 2.f * aqr * aqi; aqr = nr2; aqi = ni2; }
  const float den = lr_ * lr_ + li * li;
  const float nr = abr - 1.0f, ni = abi;
  const float fre = (nr * lr_ + ni * li) / den, fim = (ni * lr_ - nr * li) / den;
  float* o = p.S5P() + ((size_t)(l * 64 + g) * 36) * 64 + n;
  o[0] = abr; o[64] = abi; o[128] = aqr; o[192] = aqi;
  const float* br = p.b_re + ((size_t)(l * 64 + g) * 64 + n) * 16;
  const float* bi = p.b_im + ((size_t)(l * 64 + g) * 64 + n) * 16;
  float vre[16], vim[16];
#pragma unroll
  for (int i = 0; i < 16; ++i) {
    const float b_r = br[i], b_i = bi[i];
    vre[i] = fre * b_r - fim * b_i;
    vim[i] = fre * b_i + fim * b_r;
    o[(4 + i) * 64] = vre[i];
    o[(20 + i) * 64] = vim[i];
  }
  uint4* bt = (uint4*)(p.BBT() + ((size_t)(l * 64 + g) * 128 + n) * 16);
  bt[0] = make_uint4(pack2(vre[0], vre[1]), pack2(vre[2], vre[3]), pack2(vre[4], vre[5]), pack2(vre[6], vre[7]));
  bt[1] = make_uint4(pack2(vre[8], vre[9]), pack2(vre[10], vre[11]), pack2(vre[12], vre[13]), pack2(vre[14], vre[15]));
  bt[128] = make_uint4(pack2(vim[0], vim[1]), pack2(vim[2], vim[3]), pack2(vim[4], vim[5]), pack2(vim[6], vim[7]));
  bt[129] = make_uint4(pack2(vim[8], vim[9]), pack2(vim[10], vim[11]), pack2(vim[12], vim[13]), pack2(vim[14], vim[15]));
}
DI void prep_rope_job(const P& p, int j) {
  const int idx = j * 256 + tidx();
  if (idx >= 8193 * 8) return;
  const int pos = idx >> 3, f = idx & 7;
  const float invf = expf(-(2.0f * (float)f / 16.0f) * logf(500000.0f));
  const float ang = (float)pos * invf;
  p.ROPE()[idx] = make_float2(cosf(ang), sinf(ang));
}

DI void norm_job(const P& p, int job, const float* wgt, bool layer0, bool final_) {
  const int w = __builtin_amdgcn_readfirstlane(tidx() >> 6), lane = tidx() & 63;
  const int r = job * 4 + w;
  const float* src = layer0 ? (r < TP ? p.x_prompt + (size_t)r * 1024 : p.x_sample + (size_t)(r - TP) * 1024) : p.X() + (size_t)r * 1024;
  float4 v[4];
  float ss = 0.f;
#pragma unroll
  for (int q = 0; q < 4; ++q) { v[q] = ((const float4*)src)[lane + 64 * q]; ss += v[q].x * v[q].x + v[q].y * v[q].y + v[q].z * v[q].z + v[q].w * v[q].w; }
  ss = wave_sum(ss);
  const float sc = rsqrtf(ss * (1.f / 1024.f) + EPS);
#pragma unroll
  for (int q = 0; q < 4; ++q) {
    const float4 wv = ((const float4*)wgt)[lane + 64 * q];
    float4 y = make_float4(v[q].x * sc * wv.x, v[q].y * sc * wv.y, v[q].z * sc * wv.z, v[q].w * sc * wv.w);
    if (final_) ((float4*)(p.out + OFF_YP + (size_t)r * 1024))[lane + 64 * q] = y;
    else *(uint2*)(p.H() + (size_t)r * 1024 + (lane + 64 * q) * 4) = make_uint2(pack2(y.x, y.y), pack2(y.z, y.w));
    if (layer0) ((float4*)(p.X() + (size_t)r * 1024))[lane + 64 * q] = v[q];
  }
}

constexpr int LDS_T = 264;
DI void stage_tile(bf16_t* sT, const f32x16 (&acc)[2][GNB], int wm, int wn, int lr, int lh) {
#pragma unroll
  for (int mi = 0; mi < 2; ++mi)
#pragma unroll
    for (int ni = 0; ni < GNB; ++ni) {
      bf16_t* d = sT + (wm * 64 + mi * 32 + 4 * lh) * LDS_T + wn * 128 + ni * 32 + lr;
#pragma unroll
      for (int ig = 0; ig < 4; ++ig) {
        const unsigned p01 = pack2(acc[mi][ni][4 * ig], acc[mi][ni][4 * ig + 1]), p23 = pack2(acc[mi][ni][4 * ig + 2], acc[mi][ni][4 * ig + 3]);
        d[(8 * ig) * LDS_T] = (bf16_t)(p01 & 0xffffu); d[(8 * ig + 1) * LDS_T] = (bf16_t)(p01 >> 16);
        d[(8 * ig + 2) * LDS_T] = (bf16_t)(p23 & 0xffffu); d[(8 * ig + 3) * LDS_T] = (bf16_t)(p23 >> 16);
      }
    }
}
DI void tile_writeout(bf16_t* __restrict__ dst, int ld, const bf16_t* sT) {
  const int tid = tidx();
#pragma unroll 4
  for (int it = 0; it < 16; ++it) {
    const int idx = tid + 256 * it, row = idx >> 5, chunk = idx & 31;
    *(uint4*)(dst + (size_t)row * ld + chunk * 8) = *(const uint4*)(sT + row * LDS_T + chunk * 8);
  }
}

DI void inproj_job(const P& p, int l, int job, char* smem) {
  int mt, nt;
  if (!gemm_tile(job, 129, 35, mt, nt)) return;
  int m0 = mt * 128, n0 = nt * 256;
  f32x16 acc[2][GNB];
#pragma unroll
  for (int a = 0; a < 2; ++a)
#pragma unroll
    for (int b = 0; b < GNB; ++b) zero16(acc[a][b]);
  gemm_mainloop(p.H() + (size_t)m0 * 1024, 1024, p.Wt() + (size_t)l * W_LAYER + WO_IN, n0, 1024, acc, smem);
  m0 = launder_s(m0); n0 = launder_s(n0);
  nt = launder_s(nt); mt = launder_s(mt);
  const int tid = tidx(), lane = tid & 63, w = __builtin_amdgcn_readfirstlane(tid >> 6), wm = w & 1, wn = w >> 1, lr = lane & 31, lh = lane >> 5;
  bf16_t* sT = (bf16_t*)smem;
  if (nt == 34) {
    if (wn == 0 && lr < 16) {
      const float bias = p.dt_bias[l * 16 + lr];
#pragma unroll
      for (int mi = 0; mi < 2; ++mi)
#pragma unroll
        for (int i = 0; i < 16; ++i) p.DT()[(size_t)(m0 + wm * 64 + mi * 32 + crow(i, lh)) * 16 + lr] = softplus_f(acc[mi][0][i] + bias);
    }
    return;
  }
  if (nt >= 16 && nt <= 20) {
#pragma unroll
    for (int mi = 0; mi < 2; ++mi)
#pragma unroll
      for (int ni = 0; ni < GNB; ni += 2)
#pragma unroll
        for (int i = 0; i < 16; ++i) {
          const float v = acc[mi][ni][i];
          const float pv = __shfl_xor(v, 8);
          if (lr < 16) {
            const int r = m0 + wm * 64 + mi * 32 + crow(i, lh);
            const int pos = (r >= TP) ? 8192 : (r & 8191);
            const float2 cs = p.ROPE()[pos * 8 + (lr & 7)];
            acc[mi][ni][i] = (lr < 8) ? v * cs.x - pv * cs.y : v * cs.x + pv * cs.y;
          }
        }
  }
  if (nt >= 22) {
#pragma unroll
    for (int mi = 0; mi < 2; ++mi)
#pragma unroll
      for (int ni = 0; ni < GNB; ++ni)
#pragma unroll
        for (int i = 0; i < 16; ++i) acc[mi][ni][i] = sigm_f(acc[mi][ni][i]);
  }
  if ((mt == 63 || mt == 127 || mt == 128) && ((nt >= 4 && nt < 12) || nt == 20 || nt == 21)) {
#pragma unroll
    for (int mi = 0; mi < 2; ++mi)
#pragma unroll
      for (int ni = 0; ni < GNB; ++ni) {
        const int cc = (n0 & 255) + wn * 128 + ni * 32 + lr;
        const int rb_ = launder(m0 + wm * 64 + mi * 32 + 4 * lh);
#pragma unroll
        for (int i = 0; i < 16; ++i) {
          const int r = rb_ + (i & 3) + 8 * (i >> 2);
          const float v = acc[mi][ni][i];
          if (nt < 12) {
            const int ch = (n0 - 1024) + cc;
            if (r >= TP) p.out[OFF_CONVS + ((size_t)(l * 128 + (r - TP)) * 3 + 2) * 2048 + ch] = v;
            else { const int t = r & 8191; if (t >= 8189) p.out[OFF_CONVP + ((size_t)(l * 2 + (r >> 13)) * 3 + (t - 8189)) * 2048 + ch] = v; }
          } else {
            const size_t ob = (nt == 20) ? OFF_KS : OFF_VS, obp = (nt == 20) ? OFF_KP : OFF_VP;
            if (r >= TP) p.out[ob + ((size_t)(l * 128 + (r - TP)) * 128 + 127) * 256 + cc] = v;
            else p.out[obp + ((size_t)(l * 2 + (r >> 13)) * 128 + ((r & 8191) - 8064)) * 256 + cc] = v;
          }
        }
        __builtin_amdgcn_sched_barrier(0);
      }
  }
  if (nt == 21) {
#pragma unroll
    for (int mi = 0; mi < 2; ++mi)
#pragma unroll
      for (int ni = 0; ni < GNB; ++ni) {
        bf16_t* d = sT + (wn * 128 + ni * 32 + lr) * 136 + wm * 64 + mi * 32 + 4 * lh;
#pragma unroll
        for (int ig = 0; ig < 4; ++ig)
          *(uint2*)(d + 8 * ig) = make_uint2(pack2(acc[mi][ni][4 * ig], acc[mi][ni][4 * ig + 1]), pack2(acc[mi][ni][4 * ig + 2], acc[mi][ni][4 * ig + 3]));
      }
    __syncthreads();
#pragma unroll 4
    for (int it = 0; it < 16; ++it) {
      const int idx = tid + 256 * it, c = idx >> 4, chunk = idx & 15;
      *(uint4*)(p.VT() + (size_t)c * T + m0 + chunk * 8) = *(const uint4*)(sT + c * 136 + chunk * 8);
    }
    return;
  }
  stage_tile(sT, acc, wm, wn, lr, lh);
  __syncthreads();
  bf16_t* dst; int ld;
  if (nt < 4) { dst = p.Z() + n0; ld = 1024; }
  else if (nt < 12) { dst = p.XBC() + (n0 - 1024); ld = 2048; }
  else if (nt < 16) { dst = p.U() + (n0 - 3072); ld = 1024; }
  else if (nt < 20) { dst = p.Q() + (n0 - 4096); ld = 1024; }
  else if (nt == 20) { dst = p.K(); ld = 256; }
  else { dst = p.G() + (n0 - 5632); ld = 3072; }
  tile_writeout(dst + (size_t)m0 * ld, ld, sT);
}

DI void conv_job(const P& p, int l, int job, char* smem) {
  const int ct = job & 31, tt = job >> 5;
  const int ch0 = ct * 64, tokb = tt * 128;
  bf16_t* sT = (bf16_t*)smem;
  const int tid = tidx();
  const float* cw = p.conv_w + (size_t)l * 4 * 2048;
  __syncthreads();
  const int chk = tid & 7, ch = ch0 + chk * 8;
  float wt[4][8], bs[8];
  {
    const float4 b0 = *(const float4*)(p.conv_b + l * 2048 + ch), b1 = *(const float4*)(p.conv_b + l * 2048 + ch + 4);
    bs[0] = b0.x; bs[1] = b0.y; bs[2] = b0.z; bs[3] = b0.w; bs[4] = b1.x; bs[5] = b1.y; bs[6] = b1.z; bs[7] = b1.w;
#pragma unroll
    for (int j = 0; j < 4; ++j) {
      const float4 w0 = *(const float4*)(cw + j * 2048 + ch), w1 = *(const float4*)(cw + j * 2048 + ch + 4);
      wt[j][0] = w0.x; wt[j][1] = w0.y; wt[j][2] = w0.z; wt[j][3] = w0.w; wt[j][4] = w1.x; wt[j][5] = w1.y; wt[j][6] = w1.z; wt[j][7] = w1.w;
    }
  }
#pragma unroll
  for (int it = 0; it < 4; ++it) {
    const int item = tid + 256 * it, tl = item >> 3, row = tokb + tl, t = row & 8191;
    float a[8];
#pragma unroll
    for (int j = 0; j < 8; ++j) a[j] = bs[j];
#pragma unroll
    for (int j = 0; j < 4; ++j) {
      if (t - 3 + j >= 0) {
        const uint4 rv = *(const uint4*)(p.XBC() + (size_t)(row - 3 + j) * 2048 + ch);
        a[0] += bflo(rv.x) * wt[j][0]; a[1] += bfhi(rv.x) * wt[j][1]; a[2] += bflo(rv.y) * wt[j][2]; a[3] += bfhi(rv.y) * wt[j][3];
        a[4] += bflo(rv.z) * wt[j][4]; a[5] += bfhi(rv.z) * wt[j][5]; a[6] += bflo(rv.w) * wt[j][6]; a[7] += bfhi(rv.w) * wt[j][7];
      }
    }
#pragma unroll
    for (int j = 0; j < 8; ++j) a[j] = silu_f(a[j]);
    if (ct >= 16) *(uint4*)(p.BC() + (size_t)row * 1024 + (ch - 1024)) = make_uint4(pack2(a[0], a[1]), pack2(a[2], a[3]), pack2(a[4], a[5]), pack2(a[6], a[7]));
    if (ct < 24) {
#pragma unroll
      for (int j = 0; j < 8; ++j) sT[(chk * 8 + j) * 136 + (tl ^ (chk << 3))] = f2bf(a[j]);
    }
  }
  if (ct < 24) {
    __syncthreads();
#pragma unroll
    for (int it = 0; it < 4; ++it) {
      const int item = tid + 256 * it, r = item >> 4, chk = item & 15;
      *(uint4*)(p.XBT() + (size_t)(ch0 + r) * TP + tokb + chk * 8) = *(const uint4*)(sT + r * 136 + ((chk ^ (r >> 3)) << 3));
    }
  }
}

DI void chunk_acum(const P& p, int l, int head, int tok0, float* sAc, float* sDt, float& alast) {
  const int lane = tidx() & 63;
  const float Ah = -expf(p.a_log[l * 16 + head]);
  const float d0 = p.DT()[(size_t)(tok0 + 2 * lane) * 16 + head], d1 = p.DT()[(size_t)(tok0 + 2 * lane + 1) * 16 + head];
  const float a0 = d0 * Ah, a1 = d1 * Ah;
  float s = a0 + a1;
#pragma unroll
  for (int off = 1; off < 64; off <<= 1) { const float tv = __shfl_up(s, off); if (lane >= off) s += tv; }
  const float excl = s - (a0 + a1);
  sAc[2 * lane] = excl + a0; sAc[2 * lane + 1] = s;
  sDt[2 * lane] = d0; sDt[2 * lane + 1] = d1;
  alast = __shfl(s, 63);
}

DI void ssd_a_job(const P& p, int l, int job, char* smem) {
  const int head = job & 15, c = (job >> 4) & 63, b = job >> 10, g = head >> 2;
  const int tok0 = b * SEQ + c * 128;
  bf16_t* sXT = (bf16_t*)smem;
  bf16_t* sBT = sXT + 64 * 136;
  float* sW = (float*)(sBT + 128 * 136);
  float* sAc = sW + 128;
  float* sDt = sAc + 128;
  const int tid = tidx(), lane = tid & 63, w = __builtin_amdgcn_readfirstlane(tid >> 6), lr = lane & 31, lh = lane >> 5;
  __syncthreads();
  if (w == 0) {
    float alast;
    chunk_acum(p, l, head, tok0, sAc, sDt, alast);
    sW[2 * lane] = sDt[2 * lane] * __expf(alast - sAc[2 * lane]);
    sW[2 * lane + 1] = sDt[2 * lane + 1] * __expf(alast - sAc[2 * lane + 1]);
    if (lane == 0) p.CDEC()[(b * 64 + c) * 16 + head] = __expf(alast);
  }
  __syncthreads();
#pragma unroll
  for (int it = 0; it < 4; ++it) {
    const int item = tid + 256 * it, pr = item >> 4, s0 = (item & 15) * 8;
    const uint4 v = *(const uint4*)(p.XBT() + (size_t)(head * 64 + pr) * TP + tok0 + s0);
    const float4 w0 = *(const float4*)(sW + s0), w1 = *(const float4*)(sW + s0 + 4);
    *(uint4*)(sXT + pr * 136 + s0) = make_uint4(pack2(bflo(v.x) * w0.x, bfhi(v.x) * w0.y), pack2(bflo(v.y) * w0.z, bfhi(v.y) * w0.w),
                                                pack2(bflo(v.z) * w1.x, bfhi(v.z) * w1.y), pack2(bflo(v.w) * w1.z, bfhi(v.w) * w1.w));
  }
#pragma unroll
  for (int it = 0; it < 8; ++it) {
    const int item = tid + 256 * it, n = item >> 4, s0 = (item & 15) * 8;
    *(uint4*)(sBT + n * 136 + s0) = *(const uint4*)(p.XBT() + (size_t)(1024 + g * 128 + n) * TP + tok0 + s0);
  }
  __syncthreads();
  const int wp = w & 1, wn = w >> 1;
  f32x16 acc[2];
  zero16(acc[0]); zero16(acc[1]);
#pragma unroll
  for (int kk = 0; kk < 8; ++kk) {
    const bf16x8 af = *(const bf16x8*)(sXT + (wp * 32 + lr) * 136 + kk * 16 + lh * 8);
#pragma unroll
    for (int ni = 0; ni < 2; ++ni) {
      const bf16x8 bfr = *(const bf16x8*)(sBT + (wn * 64 + ni * 32 + lr) * 136 + kk * 16 + lh * 8);
      acc[ni] = MFMA32(af, bfr, acc[ni]);
    }
  }
  float* st = p.ST() + ((size_t)((b * 64 + c) * 16 + head) * 64) * 128;
#pragma unroll
  for (int ni = 0; ni < 2; ++ni)
#pragma unroll
    for (int i = 0; i < 16; ++i) st[(wp * 32 + crow(i, lh)) * 128 + wn * 64 + ni * 32 + lr] = acc[ni][i];
}

DI void ssd_scan_job(const P& p, int l, int job) {
  const int gid = job * 256 + tidx();
  const int b = gid >> 15, rem = gid & 32767, head = rem >> 11;
  float4 h = make_float4(0.f, 0.f, 0.f, 0.f);
  const float4* sp0 = (const float4*)(p.ST() + (size_t)(b * 64) * 131072) + rem;
  uint2* hp0 = (uint2*)(p.HP() + (size_t)(b * 64) * 131072) + rem;
  for (int c0 = 0; c0 < 64; c0 += 16) {
    float4 sv[16];
    float dv[16];
#pragma unroll
    for (int k = 0; k < 16; ++k) { sv[k] = sp0[(size_t)(c0 + k) * 32768]; dv[k] = p.CDEC()[(b * 64 + c0 + k) * 16 + head]; }
#pragma unroll
    for (int k = 0; k < 16; ++k) {
      hp0[(size_t)(c0 + k) * 32768] = make_uint2(pack2(h.x, h.y), pack2(h.z, h.w));
      h.x = h.x * dv[k] + sv[k].x; h.y = h.y * dv[k] + sv[k].y; h.z = h.z * dv[k] + sv[k].z; h.w = h.w * dv[k] + sv[k].w;
    }
  }
  ((float4*)(p.out + OFF_SSMP + (size_t)(l * 2 + b) * 131072))[rem] = h;
}

DI void s5_scan_job(const P& p, int l, int job) {
  const int gid = job * 256 + tidx();
  const int n = gid & 63, g = (gid >> 6) & 63, b = gid >> 12;
  const float* prm = p.S5P() + ((size_t)(l * 64 + g) * 36) * 64 + n;
  const float aqr = prm[128], aqi = prm[192];
  float hr = 0.f, hi = 0.f;
  float2* sp = (float2*)p.S5S() + ((size_t)(b * 128) * 64 + g) * 64 + n;
  for (int c0 = 0; c0 < 128; c0 += 8) {
    float2 sv[8];
#pragma unroll
    for (int k = 0; k < 8; ++k) sv[k] = sp[(size_t)(c0 + k) * 4096];
#pragma unroll
    for (int k = 0; k < 8; ++k) {
      sp[(size_t)(c0 + k) * 4096] = make_float2(hr, hi);
      const float nr = aqr * hr - aqi * hi + sv[k].x, ni = aqr * hi + aqi * hr + sv[k].y;
      hr = nr; hi = ni;
    }
  }
}

DI void ssd_c_job(const P& p, int l, int job, char* smem) {
  const int g = job & 3, c = (job >> 2) & 63, b = job >> 8;
  const int tok0 = b * SEQ + c * 128;
  bf16_t* sC = (bf16_t*)smem;
  bf16_t* sB = sC + 128 * 136;
  float* sAc = (float*)(sB + 128 * 136);
  float* sDt = sAc + 512;
  const int tid = tidx(), lane = tid & 63, w = __builtin_amdgcn_readfirstlane(tid >> 6), lr = lane & 31, lh = lane >> 5, wm = w & 1, wn = w >> 1;
  __syncthreads();
  { float alast; chunk_acum(p, l, g * 4 + w, tok0, sAc + w * 128, sDt + w * 128, alast); }
#pragma unroll
  for (int it = 0; it < 8; ++it) {
    const int item = tid + 256 * it, r = item >> 4, s0 = (item & 15) * 8;
    *(uint4*)(sC + r * 136 + s0) = *(const uint4*)(p.BC() + (size_t)(tok0 + r) * 1024 + 512 + g * 128 + s0);
    *(uint4*)(sB + r * 136 + s0) = *(const uint4*)(p.BC() + (size_t)(tok0 + r) * 1024 + g * 128 + s0);
  }
  __syncthreads();
  f32x16 cb[2][2];
#pragma unroll
  for (int a = 0; a < 2; ++a)
#pragma unroll
    for (int bb = 0; bb < 2; ++bb) zero16(cb[a][bb]);
  if (!(wm == 0 && wn == 1)) {
#pragma unroll
    for (int kk = 0; kk < 8; ++kk) {
      bf16x8 af[2], bfr[2];
#pragma unroll
      for (int mi = 0; mi < 2; ++mi) af[mi] = *(const bf16x8*)(sC + (wm * 64 + mi * 32 + lr) * 136 + kk * 16 + lh * 8);
#pragma unroll
      for (int ni = 0; ni < 2; ++ni) bfr[ni] = *(const bf16x8*)(sB + (wn * 64 + ni * 32 + lr) * 136 + kk * 16 + lh * 8);
#pragma unroll
      for (int mi = 0; mi < 2; ++mi)
#pragma unroll
        for (int ni = 0; ni < 2; ++ni) cb[mi][ni] = MFMA32(af[mi], bfr[ni], cb[mi][ni]);
    }
  }
  __syncthreads();
  bf16_t* sM = sB;
  unsigned cbp[2][2][8];
#pragma unroll
  for (int a = 0; a < 2; ++a)
#pragma unroll
    for (int bb = 0; bb < 2; ++bb)
#pragma unroll
      for (int k = 0; k < 8; ++k) cbp[a][bb][k] = pack2(cb[a][bb][2 * k], cb[a][bb][2 * k + 1]);
  float ss[16];
#pragma unroll
  for (int i = 0; i < 16; ++i) ss[i] = 0.f;
#pragma unroll 1
  for (int hd = 0; hd < 4; ++hd) {
    const int head = g * 4 + hd;
    const float* ac = sAc + hd * 128;
    const float* dtv = sDt + hd * 128;
    const int lrq = launder(lr), lhq = launder(lh);
#pragma unroll
    for (int mi = 0; mi < 2; ++mi)
#pragma unroll
      for (int ni = 0; ni < 2; ++ni) {
        const int s = wn * 64 + ni * 32 + lrq;
        const float as = ac[s], ds = dtv[s];
#pragma unroll
        for (int i = 0; i < 16; ++i) {
          const int t = wm * 64 + mi * 32 + crow(i, lhq);
          const float cv = (i & 1) ? bfhi(cbp[mi][ni][i >> 1]) : bflo(cbp[mi][ni][i >> 1]);
          const float v = (s <= t) ? cv * __expf(ac[t] - as) * ds : 0.f;
          sM[t * 136 + s] = f2bf(v);
        }
        __builtin_amdgcn_sched_barrier(0);
      }
    __syncthreads();
    f32x16 yd[2];
    zero16(yd[0]); zero16(yd[1]);
    {
      const bf16_t* hb = p.HP() + (((size_t)((b * 64 + c) * 16 + head) * 64 + lr) * 128 + lh * 8);
      bf16x8 hf[8][2];
#pragma unroll
      for (int kk = 0; kk < 8; ++kk)
#pragma unroll
        for (int pb = 0; pb < 2; ++pb) hf[kk][pb] = *(const bf16x8*)(hb + (size_t)pb * 32 * 128 + kk * 16);
#pragma unroll
      for (int kk = 0; kk < 8; ++kk) {
        const bf16x8 af = *(const bf16x8*)(sC + (32 * w + lr) * 136 + kk * 16 + lh * 8);
        yd[0] = MFMA32(af, hf[kk][0], yd[0]);
        yd[1] = MFMA32(af, hf[kk][1], yd[1]);
      }
    }
#pragma unroll
    for (int i = 0; i < 16; ++i) {
      const float e = __expf(ac[32 * w + crow(i, lh)]);
      yd[0][i] *= e; yd[1][i] *= e;
    }
    {
      const int nkk = 2 * (w + 1);
      const bf16_t* xb = p.XBT() + (size_t)(head * 64 + lr) * TP + tok0 + lh * 8;
      const bf16_t* am = sM + (32 * w + lr) * 136 + lh * 8;
      bf16x8 x00 = *(const bf16x8*)(xb), x01 = *(const bf16x8*)(xb + (size_t)32 * TP);
      for (int kk = 0; kk < nkk; kk += 2) {
        const bf16x8 x10 = *(const bf16x8*)(xb + (kk + 1) * 16), x11 = *(const bf16x8*)(xb + (size_t)32 * TP + (kk + 1) * 16);
        const bf16x8 a0 = *(const bf16x8*)(am + kk * 16);
        yd[0] = MFMA32(a0, x00, yd[0]);
        yd[1] = MFMA32(a0, x01, yd[1]);
        const int kn = (kk + 2 < nkk) ? kk + 2 : kk;
        x00 = *(const bf16x8*)(xb + kn * 16); x01 = *(const bf16x8*)(xb + (size_t)32 * TP + kn * 16);
        const bf16x8 a1 = *(const bf16x8*)(am + (kk + 1) * 16);
        yd[0] = MFMA32(a1, x10, yd[0]);
        yd[1] = MFMA32(a1, x11, yd[1]);
      }
    }
    const float Dh = p.m_d[l * 16 + head];
#pragma unroll
    for (int pb = 0; pb < 2; ++pb) {
      const int pch = head * 64 + pb * 32 + lr;
#pragma unroll
      for (int ig = 0; ig < 4; ++ig) {
        const int t0 = 32 * w + 8 * ig + 4 * lh;
        const uint2 xr = *(const uint2*)(p.XBT() + (size_t)pch * TP + tok0 + t0);
        const float xs[4] = {bflo(xr.x), bfhi(xr.x), bflo(xr.y), bfhi(xr.y)};
#pragma unroll
        for (int jj = 0; jj < 4; ++jj) {
          const int i = 4 * ig + jj, t = t0 + jj;
          const float y = yd[pb][i] + Dh * xs[jj];
          const float z = bf2f(p.Z()[(size_t)(tok0 + t) * 1024 + pch]);
          const float yg = y * silu_f(z);
          ss[i] += yg * yg;
          p.YM()[(size_t)(tok0 + t) * 1024 + pch] = f2bf(yg);
        }
      }
      __builtin_amdgcn_sched_barrier(0);
    }
    __syncthreads();
  }
#pragma unroll
  for (int i = 0; i < 16; ++i) {
    float v = ss[i];
    v += __shfl_xor(v, 1); v += __shfl_xor(v, 2); v += __shfl_xor(v, 4); v += __shfl_xor(v, 8); v += __shfl_xor(v, 16);
    ss[i] = rsqrtf(v * (1.f / 256.f) + EPS);
  }
  for (int hd = 0; hd < 4; ++hd) {
#pragma unroll
    for (int pb = 0; pb < 2; ++pb) {
      const int pch = (g * 4 + hd) * 64 + pb * 32 + lr;
      const float nw = p.m_norm_w[l * 1024 + pch];
#pragma unroll
      for (int i = 0; i < 16; ++i) {
        const size_t idx = (size_t)(tok0 + 32 * w + crow(i, lh)) * 1024 + pch;
        p.YM()[idx] = f2bf(bf2f(p.YM()[idx]) * ss[i] * nw);
      }
      __builtin_amdgcn_sched_barrier(0);
    }
  }
}

DI void ssd_sample_job(const P& p, int l, int job, char* smem) {
  const int g = job & 3, b = job >> 2;
  float* sx = (float*)smem;
  float* sBv = sx + 256;
  float* sCv = sBv + 128;
  float* sY = sCv + 128;
  float* sRed = sY + 256;
  const int tid = tidx(), lane = tid & 63, w = __builtin_amdgcn_readfirstlane(tid >> 6);
  const int row = TP + b;
  __syncthreads();
#pragma unroll
  for (int it = 0; it < 2; ++it) {
    const int idx = tid + 256 * it;
    const int ch = idx < 256 ? g * 256 + idx : (idx < 384 ? 1024 + g * 128 + (idx - 256) : 1536 + g * 128 + (idx - 384));
    const float* sc = p.state_conv + ((size_t)(l * 128 + b) * 3) * 2048 + ch;
    const float s0 = sc[0], s1 = sc[2048], s2 = sc[4096];
    const float raw = bf2f(p.XBC()[(size_t)row * 2048 + ch]);
    const float* cw = p.conv_w + (size_t)l * 4 * 2048 + ch;
    float v = p.conv_b[l * 2048 + ch] + cw[0] * s0 + cw[2048] * s1 + cw[4096] * s2 + cw[6144] * raw;
    v = silu_f(v);
    sx[idx] = v;
    float* co = p.out + OFF_CONVS + ((size_t)(l * 128 + b) * 3) * 2048 + ch;
    co[0] = s1; co[2048] = s2;
  }
  __syncthreads();
  const int pp = tid >> 2, nq = (tid & 3) * 32;
  float4 hv[4][8];
#pragma unroll
  for (int hd = 0; hd < 4; ++hd) {
    const float4* h0 = (const float4*)(p.state_ssm + ((((size_t)l * 128 + b) * 16 + g * 4 + hd) * 64 + pp) * 128 + nq);
#pragma unroll
    for (int q = 0; q < 8; ++q) hv[hd][q] = h0[q];
  }
#pragma unroll
  for (int hd = 0; hd < 4; ++hd) {
    const int head = g * 4 + hd;
    const float dt = p.DT()[(size_t)row * 16 + head];
    const float Ah = -expf(p.a_log[l * 16 + head]);
    const float dA = __expf(dt * Ah);
    const float xv = sx[hd * 64 + pp];
    const float coef = dt * xv;
    float4* ho = (float4*)(p.out + OFF_SSMS + ((((size_t)l * 128 + b) * 16 + head) * 64 + pp) * 128 + nq);
    float yacc = 0.f;
#pragma unroll
    for (int q = 0; q < 8; ++q) {
      float4 h4 = hv[hd][q];
      const int n = nq + 4 * q;
      h4.x = h4.x * dA + coef * sBv[n]; h4.y = h4.y * dA + coef * sBv[n + 1]; h4.z = h4.z * dA + coef * sBv[n + 2]; h4.w = h4.w * dA + coef * sBv[n + 3];
      yacc += h4.x * sCv[n] + h4.y * sCv[n + 1] + h4.z * sCv[n + 2] + h4.w * sCv[n + 3];
      ho[q] = h4;
    }
    yacc += __shfl_xor(yacc, 1); yacc += __shfl_xor(yacc, 2);
    const float y = yacc + p.m_d[l * 16 + head] * xv;
    const float z = bf2f(p.Z()[(size_t)row * 1024 + head * 64 + pp]);
    if ((tid & 3) == 0) sY[hd * 64 + pp] = y * silu_f(z);
  }
  __syncthreads();
  const float v = sY[tid];
  const float ssq = wave_sum(v * v);
  if (lane == 0) sRed[w] = ssq;
  __syncthreads();
  const float tot = sRed[0] + sRed[1] + sRed[2] + sRed[3];
  const float sc = rsqrtf(tot * (1.f / 256.f) + EPS);
  p.YM()[(size_t)row * 1024 + g * 256 + tid] = f2bf(v * sc * p.m_norm_w[l * 1024 + g * 256 + tid]);
}

DI void s5_wave_job(const P& p, int l, int mode, int b, int g, int c_first, int nch, bf16_t* sH) {
  const int lane = tidx() & 63, lr = lane & 31, lh = lane >> 5;
  bf16x8 bq[4];
#pragma unroll
  for (int nb = 0; nb < 4; ++nb) bq[nb] = *(const bf16x8*)(p.BBT() + ((size_t)(l * 64 + g) * 128 + nb * 32 + lr) * 16 + lh * 8);
  float ar[2], ai[2], cr_[2], ci_[2];
#pragma unroll
  for (int k = 0; k < 2; ++k) {
    const float* prm = p.S5P() + ((size_t)(l * 64 + g) * 36) * 64 + k * 32 + lr;
    ar[k] = prm[0]; ai[k] = prm[64];
  }
  const int o = lane & 15, quad = lane >> 4;
  bf16x8 cf[4];
  float dsk = 0.f;
  if (mode != 0) {
#pragma unroll
    for (int kk = 0; kk < 4; ++kk) {
      const float* cp = ((kk < 2) ? p.c_re : p.c_im) + ((size_t)(l * 64 + g) * 16 + o) * 64 + (kk & 1) * 32 + quad * 8;
      const float4 c0 = ((const float4*)cp)[0], c1 = ((const float4*)cp)[1];
      const float sg = (kk < 2) ? 1.f : -1.f;
      cf[kk] = u4_to_bf8(make_uint4(pack2(sg * c0.x, sg * c0.y), pack2(sg * c0.z, sg * c0.w), pack2(sg * c1.x, sg * c1.y), pack2(sg * c1.z, sg * c1.w)));
    }
    dsk = p.s5_d[l * 1024 + g * 16 + o];
  }
  for (int cc = 0; cc < nch; ++cc) {
  const int c = c_first + cc;
  int row0, Q;
  if (mode == 2) { row0 = TP + b; Q = 1; } else { row0 = b * SEQ + c * 64; Q = 64; }
#pragma unroll
  for (int k = 0; k < 2; ++k) {
    const int n = k * 32 + lr;
    cr_[k] = 0.f; ci_[k] = 0.f;
    if (mode == 2) {
      cr_[k] = p.s5_sre[((size_t)(l * 128 + b) * 64 + g) * 64 + n];
      ci_[k] = p.s5_sim[((size_t)(l * 128 + b) * 64 + g) * 64 + n];
    } else if (mode == 1) {
      const float2 sv = *(const float2*)(p.S5S() + (((size_t)(b * 128 + c) * 64 + g) * 64 + n) * 2);
      cr_[k] = sv.x; ci_[k] = sv.y;
    }
  }
  const int ntb = (mode == 2) ? 1 : 2;
  for (int tb = 0; tb < ntb; ++tb) {
    const bf16x8 uf = *(const bf16x8*)(p.U() + (size_t)(row0 + tb * 32 + lr) * 1024 + g * 16 + lh * 8);
    f32x16 acc[4];
#pragma unroll
    for (int nb = 0; nb < 4; ++nb) { zero16(acc[nb]); acc[nb] = MFMA32(uf, bq[nb], acc[nb]); }
#pragma unroll
    for (int k = 0; k < 2; ++k) {
      const float a1r = ar[k], a1i = ai[k];
      const float a2r = a1r * a1r - a1i * a1i, a2i = 2.f * a1r * a1i;
      const float a3r = a2r * a1r - a2i * a1i, a3i = a2r * a1i + a2i * a1r;
      const float a4r = a2r * a2r - a2i * a2i, a4i = 2.f * a2r * a2i;
      float er[4], ei[4];
#pragma unroll
      for (int q = 0; q < 4; ++q) {
        float hr = acc[k][4 * q], hi = acc[2 + k][4 * q];
#pragma unroll
        for (int j = 1; j < 4; ++j) {
          const float nr = a1r * hr - a1i * hi + acc[k][4 * q + j], ni = a1r * hi + a1i * hr + acc[2 + k][4 * q + j];
          hr = nr; hi = ni;
          acc[k][4 * q + j] = hr; acc[2 + k][4 * q + j] = hi;
        }
        er[q] = hr; ei[q] = hi;
      }
      float cinr[4], cini[4];
      float cr = cr_[k], ci = ci_[k];
#pragma unroll
      for (int q = 0; q < 4; ++q) {
        const float per = __shfl_xor(er[q], 32), pei = __shfl_xor(ei[q], 32);
        const float e0r = lh ? per : er[q], e0i = lh ? pei : ei[q];
        const float e1r = lh ? er[q] : per, e1i = lh ? ei[q] : pei;
        const float c1r = a4r * cr - a4i * ci + e0r, c1i = a4r * ci + a4i * cr + e0i;
        cinr[q] = lh ? c1r : cr; cini[q] = lh ? c1i : ci;
        cr = a4r * c1r - a4i * c1i + e1r; ci = a4r * c1i + a4i * c1r + e1i;
      }
#pragma unroll
      for (int q = 0; q < 4; ++q) {
        const float xr = cinr[q], xi = cini[q];
        acc[k][4 * q] += a1r * xr - a1i * xi;     acc[2 + k][4 * q] += a1r * xi + a1i * xr;
        acc[k][4 * q + 1] += a2r * xr - a2i * xi; acc[2 + k][4 * q + 1] += a2r * xi + a2i * xr;
        acc[k][4 * q + 2] += a3r * xr - a3i * xi; acc[2 + k][4 * q + 2] += a3r * xi + a3i * xr;
        acc[k][4 * q + 3] += a4r * xr - a4i * xi; acc[2 + k][4 * q + 3] += a4r * xi + a4i * xr;
      }
      if (mode == 2) { cr_[k] = acc[k][0]; ci_[k] = acc[2 + k][0]; }
      else { cr_[k] = cr; ci_[k] = ci; }
      if (mode != 0) {
#pragma unroll
        for (int i = 0; i < 16; ++i) {
          const int t = tb * 32 + crow(i, lh);
          sH[t * 136 + k * 32 + lr] = f2bf(acc[k][i]);
          sH[t * 136 + 64 + k * 32 + lr] = f2bf(acc[2 + k][i]);
        }
      }
    }
  }
  if (lh == 0) {
#pragma unroll
    for (int k = 0; k < 2; ++k) {
      const int n = k * 32 + lr;
      if (mode == 0) *(float2*)(p.S5S() + (((size_t)(b * 128 + c) * 64 + g) * 64 + n) * 2) = make_float2(cr_[k], ci_[k]);
      if (mode == 1 && c == 127) {
        p.out[OFF_S5RP + ((size_t)(l * 2 + b) * 64 + g) * 64 + n] = cr_[k];
        p.out[OFF_S5IP + ((size_t)(l * 2 + b) * 64 + g) * 64 + n] = ci_[k];
      }
      if (mode == 2) {
        p.out[OFF_S5RS + ((size_t)(l * 128 + b) * 64 + g) * 64 + n] = cr_[k];
        p.out[OFF_S5IS + ((size_t)(l * 128 + b) * 64 + g) * 64 + n] = ci_[k];
      }
    }
  }
  if (mode == 0) continue;
  const int nrb = (mode == 2) ? 1 : 4;
  __builtin_amdgcn_fence(__ATOMIC_RELEASE, "wavefront");
  __builtin_amdgcn_wave_barrier();
  __builtin_amdgcn_fence(__ATOMIC_ACQUIRE, "wavefront");
  for (int rb = 0; rb < nrb; ++rb) {
    f32x4 a4 = {0.f, 0.f, 0.f, 0.f};
#pragma unroll
    for (int kk = 0; kk < 4; ++kk) {
      const bf16x8 af = *(const bf16x8*)(sH + (rb * 16 + o) * 136 + kk * 32 + quad * 8);
      a4 = MFMA16(af, cf[kk], a4);
    }
#pragma unroll
    for (int jj = 0; jj < 4; ++jj) {
      const int t = rb * 16 + quad * 4 + jj;
      if (t < Q) {
        const size_t idx = (size_t)(row0 + t) * 1024 + g * 16 + o;
        const float y = a4[jj] + dsk * bf2f(p.U()[idx]);
        p.YS()[idx] = f2bf(gelu_tanh(y));
      }
    }
  }
  __builtin_amdgcn_fence(__ATOMIC_RELEASE, "wavefront");
  __builtin_amdgcn_wave_barrier();
  }
}

DI void attn_prompt_job(const P& p, int l, int job, char* smem) {
  const int kvh = job & 3, blk = (job >> 2) & 63, b = job >> 8;
  bf16_t* sK = (bf16_t*)smem;
  bf16_t* sVt = sK + 256 * 72;
  const int tid = tidx(), lane = tid & 63, w = __builtin_amdgcn_readfirstlane(tid >> 6), lr = lane & 31, lh = lane >> 5;
  const int tokc0 = b * SEQ + blk * 128 - 128;
  __syncthreads();
#pragma unroll
  for (int it = 0; it < 8; ++it) {
    const int item = tid + 256 * it, row = item >> 3, chk = item & 7;
    uint4 v = make_uint4(0u, 0u, 0u, 0u);
    if (blk > 0 || row >= 128) v = *(const uint4*)(p.K() + (size_t)(tokc0 + row) * 256 + kvh * 64 + chk * 8);
    *(uint4*)(sK + row * 72 + chk * 8) = v;
  }
#pragma unroll
  for (int it = 0; it < 8; ++it) {
    const int item = tid + 256 * it, d = item >> 5, chk = item & 31;
    uint4 v = make_uint4(0u, 0u, 0u, 0u);
    if (blk > 0 || chk >= 16) v = *(const uint4*)(p.VT() + (size_t)(kvh * 64 + d) * T + tokc0 + chk * 8);
    *(uint4*)(sVt + d * 264 + chk * 8) = v;
  }
  __syncthreads();
  const int qtok = b * SEQ + blk * 128 + 32 * w + lr;
#pragma unroll 1
  for (int hq = 0; hq < 4; ++hq) {
  const int head = kvh * 4 + hq;
  const int lrq = launder(lr), lhq = launder(lh);
  bf16x8 qf[4];
#pragma unroll
  for (int kk = 0; kk < 4; ++kk) qf[kk] = *(const bf16x8*)(p.Q() + (size_t)qtok * 1024 + head * 64 + kk * 16 + lhq * 8);
  f32x16 st[5];
#pragma unroll
  for (int x = 0; x < 5; ++x) {
    zero16(st[x]);
#pragma unroll
    for (int kk = 0; kk < 4; ++kk) {
      const bf16x8 af = *(const bf16x8*)(sK + (32 * (w + x) + lrq) * 72 + kk * 16 + lhq * 8);
      st[x] = MFMA32(af, qf[kk], st[x]);
    }
  }
  const float sink = p.sinks[l * 16 + head];
  const int qi = 128 + 32 * w + lrq;
  float m = sink;
#pragma unroll
  for (int x = 0; x < 5; ++x)
#pragma unroll
    for (int i = 0; i < 16; ++i) {
      const int kj = 32 * (w + x) + crow(i, lhq);
      const bool valid = (kj <= qi) && (kj >= qi - 128) && (blk > 0 || kj >= 128);
      const float s = valid ? st[x][i] * 0.125f : -1e30f;
      st[x][i] = s;
      m = fmaxf(m, s);
    }
  m = fmaxf(m, __shfl_xor(m, 32));
  float sum = 0.f;
#pragma unroll
  for (int x = 0; x < 5; ++x)
#pragma unroll
    for (int i = 0; i < 16; ++i) { const float pv = __expf(st[x][i] - m); st[x][i] = pv; sum += pv; }
  sum += __shfl_xor(sum, 32);
  const float inv = 1.f / (sum + __expf(sink - m));
  f32x16 ot[2];
  zero16(ot[0]); zero16(ot[1]);
#pragma unroll
  for (int x = 0; x < 5; ++x)
#pragma unroll
    for (int s = 0; s < 2; ++s) {
      const uint4 pu = make_uint4(pack2(st[x][8 * s] * inv, st[x][8 * s + 1] * inv), pack2(st[x][8 * s + 2] * inv, st[x][8 * s + 3] * inv),
                                  pack2(st[x][8 * s + 4] * inv, st[x][8 * s + 5] * inv), pack2(st[x][8 * s + 6] * inv, st[x][8 * s + 7] * inv));
      const bf16x8 pf = u4_to_bf8(pu);
#pragma unroll
      for (int pb = 0; pb < 2; ++pb) {
        const bf16_t* vp = sVt + (pb * 32 + lrq) * 264 + 32 * (w + x) + 16 * s + 4 * lhq;
        const uint2 lo = *(const uint2*)vp, hi2 = *(const uint2*)(vp + 8);
        ot[pb] = MFMA32(u4_to_bf8(make_uint4(lo.x, lo.y, hi2.x, hi2.y)), pf, ot[pb]);
      }
    }
#pragma unroll
  for (int pb = 0; pb < 2; ++pb)
#pragma unroll
    for (int ig = 0; ig < 4; ++ig) {
      const int d0 = pb * 32 + 8 * ig + 4 * lhq;
      *(uint2*)(p.O() + (size_t)qtok * 1024 + head * 64 + d0) = make_uint2(pack2(ot[pb][4 * ig], ot[pb][4 * ig + 1]), pack2(ot[pb][4 * ig + 2], ot[pb][4 * ig + 3]));
    }
  }
}

DI void attn_sample_job(const P& p, int l, int job, char* smem) {
  const int kvh = job & 3, b = job >> 2;
  const int tid = tidx(), lane = tid & 63, w = __builtin_amdgcn_readfirstlane(tid >> 6);
  const int head = kvh * 4 + w, row = TP + b;
  float* sQ = (float*)smem;
  float* sP = sQ + 256;
  const size_t cbase = ((size_t)(l * 128 + b) * 128) * 256 + kvh * 64;
  const float4* kc4 = (const float4*)(p.cache_k + cbase);
  const float4* vc4 = (const float4*)(p.cache_v + cbase);
  float4* ko4 = (float4*)(p.out + OFF_KS + cbase);
  float4* vo4 = (float4*)(p.out + OFF_VS + cbase);
  __syncthreads();
  for (int idx = tid; idx < 127 * 16; idx += 256) {
    const int j = idx >> 4, q4 = idx & 15;
    ko4[j * 64 + q4] = kc4[(j + 1) * 64 + q4];
    vo4[j * 64 + q4] = vc4[(j + 1) * 64 + q4];
  }
  const float qd = bf2f(p.Q()[(size_t)row * 1024 + head * 64 + lane]);
  sQ[w * 64 + lane] = qd;
  __syncthreads();
  float s0 = 0.f, s1 = 0.f;
#pragma unroll 4
  for (int d4 = 0; d4 < 16; ++d4) {
    const float4 q4 = ((const float4*)(sQ + w * 64))[d4];
    const float4 k0 = kc4[lane * 64 + d4], k1 = kc4[(lane + 64) * 64 + d4];
    s0 += q4.x * k0.x + q4.y * k0.y + q4.z * k0.z + q4.w * k0.w;
    s1 += q4.x * k1.x + q4.y * k1.y + q4.z * k1.z + q4.w * k1.w;
  }
  s0 *= 0.125f; s1 *= 0.125f;
  const float s2 = wave_sum(qd * bf2f(p.K()[(size_t)row * 256 + kvh * 64 + lane])) * 0.125f;
  const float sink = p.sinks[l * 16 + head];
  float m = fmaxf(fmaxf(s0, s1), fmaxf(s2, sink));
  m = wave_max(m);
  const float p0 = __expf(s0 - m), p1 = __expf(s1 - m), p2 = __expf(s2 - m);
  const float sum = wave_sum(p0 + p1);
  const float inv = 1.f / (sum + p2 + __expf(sink - m));
  sP[w * 132 + lane] = p0 * inv; sP[w * 132 + 64 + lane] = p1 * inv;
  __syncthreads();
  const float* vc = p.cache_v + cbase + lane;
  float o = 0.f;
#pragma unroll 8
  for (int j = 0; j < 128; ++j) o += sP[w * 132 + j] * vc[(size_t)j * 256];
  o += p2 * inv * bf2f(p.VT()[(size_t)(kvh * 64 + lane) * T + row]);
  p.O()[(size_t)row * 1024 + head * 64 + lane] = f2bf(o);
}

template <int PASS>
DI void merge_pass(const P& p, const bf16_t* A, const bf16_t* Wt, int m0, int n0, char* smem) {
  m0 = launder_s(m0); n0 = launder_s(n0);
  const int tid = tidx(), lane = tid & 63, w = __builtin_amdgcn_readfirstlane(tid >> 6), wm = w & 1, wn = w >> 1, lr = lane & 31, lh = lane >> 5;
  f32x16 acc[2][GNB];
#pragma unroll
  for (int a = 0; a < 2; ++a)
#pragma unroll
    for (int b = 0; b < GNB; ++b) zero16(acc[a][b]);
  gemm_mainloop(A + (size_t)m0 * 1024, 1024, Wt, n0, 1024, acc, smem);
  m0 = launder_s(m0); n0 = launder_s(n0);
  bf16_t* sT = (bf16_t*)smem;
  stage_tile(sT, acc, wm, wn, lr, lh);
  __syncthreads();
  const int goff = (PASS == 0) ? 1024 : (PASS == 2) ? 0 : 2048;
#pragma unroll 2
  for (int it = 0; it < 16; ++it) {
    const int idx = tid + 256 * it, row = idx >> 5, chunk = idx & 31;
    const uint4 av = *(const uint4*)(sT + row * LDS_T + chunk * 8);
    uint4* mp = (uint4*)(p.MG() + (size_t)(m0 + row) * 1024 + n0 + chunk * 8);
    uint4 gv = make_uint4(0u, 0u, 0u, 0u), mv = gv;
    if (PASS != 1) gv = *(const uint4*)(p.G() + (size_t)(m0 + row) * 3072 + goff + n0 + chunk * 8);
    if (PASS != 0) mv = *mp;
    const unsigned aw[4] = {av.x, av.y, av.z, av.w}, gw[4] = {gv.x, gv.y, gv.z, gv.w}, mw[4] = {mv.x, mv.y, mv.z, mv.w};
    unsigned ow[4];
#pragma unroll
    for (int k = 0; k < 4; ++k) {
      const float a0 = bflo(aw[k]), a1 = bfhi(aw[k]), g0 = bflo(gw[k]), g1 = bfhi(gw[k]), m0_ = bflo(mw[k]), m1_ = bfhi(mw[k]);
      float o0, o1;
      if (PASS == 0) { o0 = sigm_f(a0) * g0; o1 = sigm_f(a1) * g1; }
      else if (PASS == 1) { o0 = m0_ * a0; o1 = m1_ * a1; }
      else { o0 = m0_ + a0 * g0; o1 = m1_ + a1 * g1; }
      ow[k] = pack2(o0, o1);
    }
    *mp = make_uint4(ow[0], ow[1], ow[2], ow[3]);
  }
}
DI void merge_job(const P& p, int l, int job, char* smem) {
  int mt, nt;
  if (!gemm_tile(job, 128, 4, mt, nt)) return;
  const int m0 = mt * 128, n0 = nt * 256;
  const bf16_t* wl = p.Wt() + (size_t)l * W_LAYER;
  merge_pass<0>(p, p.YS(), wl + WO_GLU + (size_t)1024 * 1024, m0, n0, smem);
  merge_pass<1>(p, p.YS(), wl + WO_GLU, m0, n0, smem);
  merge_pass<2>(p, p.YM(), wl + WO_MPROJ, m0, n0, smem);
  merge_pass<3>(p, p.O(), wl + WO_ATTNO, m0, n0, smem);
}
DI void resid_gemm_job(const P& p, const bf16_t* A, int lda, const bf16_t* Wt, int K, int job, char* smem) {
  int mt, nt;
  if (!gemm_tile(job, 128, 4, mt, nt)) return;
  int m0 = mt * 128, n0 = nt * 256;
  const int tid = tidx(), lane = tid & 63, w = __builtin_amdgcn_readfirstlane(tid >> 6), wm = w & 1, wn = w >> 1, lr = lane & 31, lh = lane >> 5;
  f32x16 acc[2][GNB];
#pragma unroll
  for (int a = 0; a < 2; ++a)
#pragma unroll
    for (int b = 0; b < GNB; ++b) zero16(acc[a][b]);
  gemm_mainloop(A + (size_t)m0 * lda, lda, Wt, n0, K, acc, smem);
  m0 = launder_s(m0); n0 = launder_s(n0);
  float* sF = (float*)smem;
#pragma unroll
  for (int h = 0; h < 2; ++h) {
    if (h) __syncthreads();
#pragma unroll
    for (int ni = 0; ni < GNB; ++ni) {
      float* d = sF + (wm * 32 + 4 * lh) * 260 + wn * 128 + ni * 32 + lr;
#pragma unroll
      for (int i = 0; i < 16; ++i) d[((i & 3) + 8 * (i >> 2)) * 260] = acc[h][ni][i];
    }
    __syncthreads();
#pragma unroll 4
    for (int it = 0; it < 16; ++it) {
      const int idx = tid + 256 * it, rl = idx >> 6, c4 = idx & 63;
      const int r = m0 + (rl >> 5) * 64 + h * 32 + (rl & 31);
      float4* xp = (float4*)(p.X() + (size_t)r * 1024 + n0) + c4;
      const float4 a = *(const float4*)(sF + rl * 260 + c4 * 4);
      float4 x = *xp;
      x.x += a.x; x.y += a.y; x.z += a.z; x.w += a.w;
      *xp = x;
    }
  }
}
DI void up_job(const P& p, int l, int job, char* smem) {
  int mt, nt;
  if (!gemm_tile(job, 128, 16, mt, nt)) return;
  int m0 = mt * 128, n0 = nt * 256;
  const int tid = tidx(), lane = tid & 63, w = __builtin_amdgcn_readfirstlane(tid >> 6), wm = w & 1, wn = w >> 1, lr = lane & 31, lh = lane >> 5;
  f32x16 acc[2][GNB];
#pragma unroll
  for (int a = 0; a < 2; ++a)
#pragma unroll
    for (int b = 0; b < GNB; ++b) zero16(acc[a][b]);
  gemm_mainloop(p.H() + (size_t)m0 * 1024, 1024, p.Wt() + (size_t)l * W_LAYER + WO_UP, n0, 1024, acc, smem);
#if PROBE_DUP == 12
  gemm_mainloop(p.H() + (size_t)m0 * 1024, 1024, p.Wt() + (size_t)l * W_LAYER + WO_UP, n0, 1024, acc, smem);
#pragma unroll
  for (int mi = 0; mi < 2; ++mi)
#pragma unroll
    for (int ni = 0; ni < GNB; ++ni)
#pragma unroll
      for (int i = 0; i < 16; ++i) acc[mi][ni][i] *= 0.5f;
#endif
  m0 = launder_s(m0); n0 = launder_s(n0);
#pragma unroll
  for (int mi = 0; mi < 2; ++mi)
#pragma unroll
    for (int ni = 0; ni < GNB; ++ni)
#pragma unroll
      for (int i = 0; i < 16; ++i) { const float v = fmaxf(acc[mi][ni][i], 0.f); acc[mi][ni][i] = v * v; }
  bf16_t* sT = (bf16_t*)smem;
  stage_tile(sT, acc, wm, wn, lr, lh);
  __syncthreads();
  tile_writeout(p.A2() + (size_t)m0 * 4096 + n0, 4096, sT);
}

DI float skinny_dot(const bf16_t* __restrict__ A, int lda, const bf16_t* __restrict__ Wt, int K, int r0, int c0, char* smem) {
  float* sR = (float*)smem;
  const int tid = tidx(), lane = tid & 63, w = __builtin_amdgcn_readfirstlane(tid >> 6), r = lane & 15, quad = lane >> 4;
  const int kq = K >> 2;
  const bf16_t* ap = A + (size_t)(r0 + r) * lda + w * kq + quad * 8;
  const int kb = w * kq + quad * 8;
  f32x4 acc = {0.f, 0.f, 0.f, 0.f};
#pragma unroll 4
  for (int k = 0; k < kq; k += 32) {
    const bf16x8 a = *(const bf16x8*)(ap + k), b = *(const bf16x8*)(Wt + wfrag(c0 + r, kb + k, K));
    acc = MFMA16(a, b, acc);
  }
  __syncthreads();
#pragma unroll
  for (int j = 0; j < 4; ++j) sR[w * 256 + (quad * 4 + j) * 16 + r] = acc[j];
  __syncthreads();
  return sR[tid] + sR[256 + tid] + sR[512 + tid] + sR[768 + tid];
}
DI void skinny_dot4(const bf16_t* A0, const bf16_t* A1, const bf16_t* A2_, const bf16_t* A3, const bf16_t* W0, const bf16_t* W1, const bf16_t* W2,
                    const bf16_t* W3, int c00, int c01, int c02, int c03, int r0, char* smem, float (&out)[4]) {
  float* sR = (float*)smem;
  const int tid = tidx(), lane = tid & 63, w = __builtin_amdgcn_readfirstlane(tid >> 6), r = lane & 15, quad = lane >> 4;
  const size_t ao = (size_t)(r0 + r) * 1024 + w * 256 + quad * 8;
  const int kb = w * 256 + quad * 8;
  const bf16_t* ap0 = A0 + ao; const bf16_t* ap1 = A1 + ao; const bf16_t* ap2 = A2_ + ao; const bf16_t* ap3 = A3 + ao;
  const bf16_t* bp0 = W0 + wfrag(c00 + r, kb, 1024); const bf16_t* bp1 = W1 + wfrag(c01 + r, kb, 1024);
  const bf16_t* bp2 = W2 + wfrag(c02 + r, kb, 1024); const bf16_t* bp3 = W3 + wfrag(c03 + r, kb, 1024);
  f32x4 acc0 = {0.f, 0.f, 0.f, 0.f}, acc1 = acc0, acc2 = acc0, acc3 = acc0;
#pragma unroll 2
  for (int k = 0; k < 256; k += 32) {
    const bf16x8 a0 = *(const bf16x8*)(ap0 + k), b0 = *(const bf16x8*)(bp0 + k * 32);
    const bf16x8 a1 = *(const bf16x8*)(ap1 + k), b1 = *(const bf16x8*)(bp1 + k * 32);
    const bf16x8 a2 = *(const bf16x8*)(ap2 + k), b2 = *(const bf16x8*)(bp2 + k * 32);
    const bf16x8 a3 = *(const bf16x8*)(ap3 + k), b3 = *(const bf16x8*)(bp3 + k * 32);
    acc0 = MFMA16(a0, b0, acc0); acc1 = MFMA16(a1, b1, acc1); acc2 = MFMA16(a2, b2, acc2); acc3 = MFMA16(a3, b3, acc3);
  }
  __syncthreads();
#pragma unroll
  for (int j = 0; j < 4; ++j) {
    const int o = w * 256 + (quad * 4 + j) * 16 + r;
    sR[o] = acc0[j]; sR[1024 + o] = acc1[j]; sR[2048 + o] = acc2[j]; sR[3072 + o] = acc3[j];
  }
  __syncthreads();
#pragma unroll
  for (int q = 0; q < 4; ++q) out[q] = sR[q * 1024 + tid] + sR[q * 1024 + 256 + tid] + sR[q * 1024 + 512 + tid] + sR[q * 1024 + 768 + tid];
}
DI void skinny_merge_job(const P& p, int l, int job, char* smem) {
  const int rt = job & 7, ct = job >> 3;
  const int r0 = TP + rt * 16, c0 = ct * 16;
  const bf16_t* wl = p.Wt() + (size_t)l * W_LAYER;
  float d[4];
  skinny_dot4(p.YS(), p.YS(), p.YM(), p.O(), wl + WO_GLU + (size_t)1024 * 1024, wl + WO_GLU, wl + WO_MPROJ, wl + WO_ATTNO, c0, c0, c0, c0, r0, smem, d);
  const int tid = tidx(), r = r0 + (tid >> 4), c = c0 + (tid & 15);
  const bf16_t* gp = p.G() + (size_t)r * 3072 + c;
  const float v = bf2f(gp[0]) * d[2] + bf2f(gp[1024]) * d[1] * sigm_f(d[0]) + bf2f(gp[2048]) * d[3];
  p.MG()[(size_t)r * 1024 + c] = f2bf(v);
}
DI void skinny_resid_job(const P& p, const bf16_t* A, int lda, const bf16_t* Wt, int K, int job, char* smem) {
  const int rt = job & 7, ct = job >> 3;
  const int r0 = TP + rt * 16, c0 = ct * 16;
  const float v = skinny_dot(A, lda, Wt, K, r0, c0, smem);
  const int tid = tidx();
  p.X()[(size_t)(r0 + (tid >> 4)) * 1024 + c0 + (tid & 15)] += v;
}
DI void skinny_up_job(const P& p, int l, int job, char* smem) {
  const int rt = job & 7, cs = job >> 3;
  const int r0 = TP + rt * 16, c0 = cs * 64;
  const bf16_t* wu = p.Wt() + (size_t)l * W_LAYER + WO_UP;
  float d[4];
  skinny_dot4(p.H(), p.H(), p.H(), p.H(), wu, wu, wu, wu, c0, c0 + 16, c0 + 32, c0 + 48, r0, smem, d);
  const int tid = tidx();
  bf16_t* dst = p.A2() + (size_t)(r0 + (tid >> 4)) * 4096 + c0 + (tid & 15);
#pragma unroll
  for (int q = 0; q < 4; ++q) { const float v = fmaxf(d[q], 0.f); dst[q * 16] = f2bf(v * v); }
}

#define XB_TMO      128
#define XB_XCNT(j)  (256  + 64 * (j))
#define XB_XSUB(j)  (1280 + 64 * (j))
#define XB_XGEN(j)  (2304 + 64 * (j))
#define XB_TOP      3328
#define XB_TOPGEN   3392
#define XCD_BAR_WORDS 3456
#define XB_SPIN_CAP (1u << 20)
#define LAS __attribute__((address_space(3)))
DI unsigned xb_ld(unsigned* p) { return __hip_atomic_load(p, __ATOMIC_RELAXED, __HIP_MEMORY_SCOPE_AGENT); }
DI unsigned xb_add(unsigned* p, unsigned v) { return __hip_atomic_fetch_add(p, v, __ATOMIC_RELAXED, __HIP_MEMORY_SCOPE_AGENT); }
DI unsigned xb_xcc_id() { return (unsigned)__builtin_amdgcn_s_getreg((3 << 11) | 20) & 0xFu; }
#define XB_SPIN(cond, bar) do { unsigned _sp = 0; while (cond) { __builtin_amdgcn_s_sleep(1); \
    if ((++_sp & 255u) == 0u) { if (xb_ld(&(bar)[XB_TMO])) break; if (_sp > XB_SPIN_CAP) { atomicAdd(&(bar)[XB_TMO], 1u); break; } } } } while (0)
struct XcdBarrier { unsigned* bar; unsigned x; volatile LAS unsigned* st; };
DI XcdBarrier xcd_barrier_post(unsigned* bar, volatile LAS unsigned* st) {
  XcdBarrier b; b.bar = bar; b.x = xb_xcc_id(); b.st = st;
  if (threadIdx.x == 0) (void)xb_add(&bar[XB_XCNT(b.x)], 1u);
  return b;
}
DI void xcd_barrier_complete(unsigned* bar, unsigned x, unsigned& nloc, unsigned& nx) {
  const unsigned G = gridDim.x * gridDim.y * gridDim.z;
  unsigned sum, cnt, mine, sp = 0u;
  for (;;) {
    sum = 0u; cnt = 0u; mine = 0u;
#pragma unroll
    for (unsigned j = 0; j < 16; ++j) { const unsigned c = xb_ld(&bar[XB_XCNT(j)]); sum += c; cnt += (c > 0u) ? 1u : 0u; mine = (j == x) ? c : mine; }
    if (sum == G) break;
    __builtin_amdgcn_s_sleep(1);
    if ((++sp & 255u) == 0u) { if (xb_ld(&bar[XB_TMO])) break; if (sp > XB_SPIN_CAP) { atomicAdd(&bar[XB_TMO], 1u); break; } }
  }
  nloc = mine > 0u ? mine : 1u; nx = cnt > 0u ? cnt : 1u;
}
DI void xcd_barrier(const XcdBarrier& b) {
  asm volatile("s_waitcnt vmcnt(0)" ::: "memory");
  __syncthreads();
  if (threadIdx.x == 0) {
    unsigned* bar = b.bar;
    __builtin_amdgcn_s_waitcnt(0);
    unsigned nloc = b.st[0], nx = b.st[1];
    if (nloc == 0u) { xcd_barrier_complete(bar, b.x, nloc, nx); b.st[0] = nloc; b.st[1] = nx; }
    const unsigned old = xb_add(&bar[XB_XSUB(b.x)], 1u);
    const unsigned gen = old / nloc;
    if (old + 1u == (gen + 1u) * nloc) {
      __builtin_amdgcn_fence(__ATOMIC_RELEASE, "agent");
      asm volatile("s_waitcnt vmcnt(0)" ::: "memory");
      const unsigned og = xb_add(&bar[XB_TOP], 1u);
      const unsigned tg = og / nx;
      if (og + 1u == (tg + 1u) * nx) xb_add(&bar[XB_TOPGEN], 1u);
      else XB_SPIN(xb_ld(&bar[XB_TOPGEN]) == tg, bar);
      __builtin_amdgcn_fence(__ATOMIC_ACQUIRE, "agent");
      xb_add(&bar[XB_XGEN(b.x)], 1u);
      asm volatile("s_waitcnt vmcnt(0)" ::: "memory");
    } else {
      XB_SPIN(xb_ld(&bar[XB_XGEN(b.x)]) == gen, bar);
      __builtin_amdgcn_fence(__ATOMIC_ACQUIRE, "agent");
      asm volatile("s_waitcnt vmcnt(0)" ::: "memory");
    }
  }
  __syncthreads();
}

constexpr int NPHASE = 1 + 4 * 11;
DI void phase_jobs(int ph, int& nstd, int& nother) {
  nstd = 0;
  if (ph == 0) { nother = 22272 + 64 + 257 + 4128; return; }
  const int s = (ph - 1) % 11;
  switch (s) {
    case 0: nstd = 129 * 35; nother = 0; break;
    case 1: nother = 512 + 512 + 512 + 4096 + 2048 + 2048; break;
    case 2: nother = 2048; break;
    case 3: nother = 256 + 32; break;
    case 4: nother = 512 + 2048; break;
    case 5: nstd = 512; nother = 512; break;
    case 6: nstd = 512; nother = 512; break;
    case 7: nother = 4128; break;
    case 8: nstd = 2048; nother = 512; break;
    case 9: nstd = 512; nother = 512; break;
    default: nother = 4128; break;
  }
}
DI void run_std_job(const P& p, int ph, int job, char* smem) {
  const int l = (ph - 1) / 11, s = (ph - 1) % 11;
  const bf16_t* wl = p.Wt() + (size_t)l * W_LAYER;
  switch (s) {
    case 0: inproj_job(p, l, job, smem); break;
    case 5: merge_job(p, l, job, smem); break;
    case 6: resid_gemm_job(p, p.MG(), 1024, wl + WO_WOUT, 1024, job, smem); break;
    case 8: up_job(p, l, job, smem); break;
    default: resid_gemm_job(p, p.A2(), 4096, wl + WO_DOWN, 4096, job, smem); break;
  }
}
DI void run_job(const P& p, int ph, int job, char* smem) {
  if (ph == 0) {
    if (job < 22272) { prep_weight_job(p, job, smem); return; }
    job -= 22272;
    if (job < 64) { prep_s5_job(p, job); return; }
    job -= 64;
    if (job < 257) { prep_rope_job(p, job); return; }
    job -= 257;
    norm_job(p, job, p.norm1_w, true, false);
    return;
  }
  const int l = (ph - 1) / 11, s = (ph - 1) % 11;
  const bf16_t* wl = p.Wt() + (size_t)l * W_LAYER;
  const int w = __builtin_amdgcn_readfirstlane(tidx() >> 6);
  switch (s) {
    case 1:
      if (job < 512) { for (int rr = 0; rr < (PROBE_DUP == 11 ? 3 : 1); ++rr) ssd_sample_job(p, l, job, smem); break; }
      job -= 512;
      if (job < 512) { attn_sample_job(p, l, job, smem); break; }
      job -= 512;
      if (job < 512) { attn_prompt_job(p, l, job, smem); break; }
      job -= 512;
      if (job < 4096) { for (int rr = 0; rr < (PROBE_DUP == 9 ? 3 : 1); ++rr) conv_job(p, l, job, smem); break; }
      job -= 4096;
      if (job < 2048) { const int wj = job * 4 + w; s5_wave_job(p, l, 0, wj >> 12, wj & 63, ((wj >> 6) & 63) * 2, 2, nullptr); break; }
      job -= 2048;
      { const int wj = job * 4 + w; __syncthreads(); s5_wave_job(p, l, 2, wj >> 6, wj & 63, 0, 1, (bf16_t*)smem + w * 64 * 136); }
      break;
    case 2: ssd_a_job(p, l, job, smem); break;
    case 3:
      if (job < 256) ssd_scan_job(p, l, job);
      else s5_scan_job(p, l, job - 256);
      break;
    case 4:
      if (job < 512) { for (int rr = 0; rr < (PROBE_DUP == 16 ? 3 : 1); ++rr) ssd_c_job(p, l, job, smem); break; }
      job -= 512;
      { const int wj = job * 4 + w; __syncthreads(); s5_wave_job(p, l, 1, wj >> 12, wj & 63, ((wj >> 6) & 63) * 2, 2, (bf16_t*)smem + w * 64 * 136); }
      break;
    case 5: skinny_merge_job(p, l, job, smem); break;
    case 6: skinny_resid_job(p, p.MG(), 1024, wl + WO_WOUT, 1024, job, smem); break;
    case 7: norm_job(p, job, p.norm2_w + l * 1024, false, false); break;
    case 8: skinny_up_job(p, l, job, smem); break;
    case 9: skinny_resid_job(p, p.A2(), 4096, wl + WO_DOWN, 4096, job, smem); break;
    default:
      if (l == 3) norm_job(p, job, p.final_w, false, true);
      else norm_job(p, job, p.norm1_w + (l + 1) * 1024, false, false);
      break;
  }
}

template <bool COOP>
__global__ void __launch_bounds__(256, 2) mega(P p, int ph0, int ph1) {
  __shared__ __attribute__((aligned(16))) char smem[SMEM_BYTES];
  __shared__ uint4 xb_words;
  XcdBarrier xb;
  if (COOP) {
    if (threadIdx.x == 0) xb_words = make_uint4(0u, 0u, 0u, 0u);
    __syncthreads();
    xb = xcd_barrier_post((unsigned*)(p.ws + WS_BAR), (volatile LAS unsigned*)&xb_words);
  }
  const int G = (int)gridDim.x;
  for (int ph = ph0; ph < ph1; ++ph) {
    int nstd, nother;
    phase_jobs(ph, nstd, nother);
    int reps = 1;
#if PROBE_DUP
    { const int s_ = (ph == 0) ? -1 : (ph - 1) % 11;
      if (PROBE_DUP == 1 && (s_ == 0 || s_ == 5 || s_ == 8)) reps = 2;
      if (PROBE_DUP == 2 && (s_ == 1 || s_ == 2 || s_ == 4)) reps = 2;
      if (PROBE_DUP == 6 && s_ == 4) reps = 2;
      if (PROBE_DUP == 13 && s_ == 8) reps = 2;
      if (PROBE_DUP == 14 && s_ == 2) reps = 3;
      if (PROBE_DUP == 15 && (s_ == 6 || s_ == 9)) reps = 1;
      if (PROBE_DUP == 7 && s_ == 1) reps = 2; }
#endif
    const int nstd_r = ((nstd + G - 1) / G) * G;
    for (int rep = 0; rep < reps; ++rep) {
      for (int job = blockIdx.x; job < nstd_r; job += G) run_std_job(p, ph, job, smem);
      for (int job = blockIdx.x; job < nother; job += G) run_job(p, ph, job, smem);
    }
    if (COOP && ph + 1 < ph1) {
      if (ph == ph0) cg::this_grid().sync();
      else xcd_barrier(xb);
    }
  }
}


extern "C" void kernel_launch(void* const* d_in, const int* in_sizes, int n_in, void* d_out, int out_size, void* d_ws, size_t ws_size,
                              hipStream_t stream) {
  P p{};
  const float** pin = (const float**)&p;
  for (int i = 0; i < 33; ++i) pin[i] = (const float*)d_in[i];
  p.out = (float*)d_out;
  p.ws = (char*)d_ws;
  if (WS_TOTAL > ws_size) { fprintf(stderr, "workspace too small: need %zu have %zu\n", (size_t)WS_TOTAL, ws_size); return; }

#if COOP_MODE
  static int grid_blocks = 0;
  if (!grid_blocks) {
    int dev = 0, cus = 0, per_cu = 0;
    hipGetDevice(&dev);
    hipDeviceGetAttribute(&cus, hipDeviceAttributeMultiprocessorCount, dev);
    hipOccupancyMaxActiveBlocksPerMultiprocessor(&per_cu, mega<true>, 256, 0);
    if (per_cu > 2) per_cu = 2;
    if (per_cu < 1) per_cu = 1;
    grid_blocks = cus * per_cu;
  }
  (void)hipMemsetAsync(p.ws + WS_BAR, 0, 4096 * 4, stream);
  int ph0 = 0, ph1 = NPHASE;
  void* args[] = {&p, &ph0, &ph1};
  hipError_t e = hipLaunchCooperativeKernel((void*)mega<true>, dim3(grid_blocks), dim3(256), args, 0, stream);
  if (e != hipSuccess) fprintf(stderr, "cooperative launch failed: %s (grid %d)\n", hipGetErrorString(e), grid_blocks);
#else
  for (int ph = 0; ph < NPHASE; ++ph) mega<false><<<dim3(1024), dim3(256), 0, stream>>>(p, ph, ph + 1);
#endif
}
```

```cpp
#include <hip/hip_runtime.h>
#include <hip/hip_cooperative_groups.h>
#include <cstdio>
#include <cstdint>
namespace cg = cooperative_groups;

#define DI __device__ __forceinline__
typedef unsigned short bf16_t;
typedef short bf16x8 __attribute__((ext_vector_type(8)));
typedef float f32x16 __attribute__((ext_vector_type(16)));
typedef float f32x4 __attribute__((ext_vector_type(4)));
#define MFMA32(a, b, c) __builtin_amdgcn_mfma_f32_32x32x16_bf16((a), (b), (c), 0, 0, 0)
#define MFMA16(a, b, c) __builtin_amdgcn_mfma_f32_16x16x32_bf16((a), (b), (c), 0, 0, 0)

#ifndef COOP_MODE
#define COOP_MODE 1
#endif
#ifndef PROBE_DUP
#define PROBE_DUP 0
#endif

constexpr int TP = 16384, TS = 128, T = TP + TS, SEQ = 8192;
constexpr int NIN = 8720, NINP = 8960;
constexpr int SMEM_BYTES = 73728;
constexpr float EPS = 1e-6f;

constexpr size_t OFF_YP = 0;
constexpr size_t OFF_YS = OFF_YP + (size_t)TP * 1024;
constexpr size_t OFF_SSMP = OFF_YS + (size_t)TS * 1024;
constexpr size_t OFF_SSMS = OFF_SSMP + (size_t)4 * 2 * 16 * 64 * 128;
constexpr size_t OFF_CONVP = OFF_SSMS + (size_t)4 * 128 * 16 * 64 * 128;
constexpr size_t OFF_CONVS = OFF_CONVP + (size_t)4 * 2 * 3 * 2048;
constexpr size_t OFF_S5RP = OFF_CONVS + (size_t)4 * 128 * 3 * 2048;
constexpr size_t OFF_S5RS = OFF_S5RP + (size_t)4 * 2 * 64 * 64;
constexpr size_t OFF_S5IP = OFF_S5RS + (size_t)4 * 128 * 64 * 64;
constexpr size_t OFF_S5IS = OFF_S5IP + (size_t)4 * 2 * 64 * 64;
constexpr size_t OFF_KP = OFF_S5IS + (size_t)4 * 128 * 64 * 64;
constexpr size_t OFF_KS = OFF_KP + (size_t)4 * 2 * 128 * 256;
constexpr size_t OFF_VP = OFF_KS + (size_t)4 * 128 * 128 * 256;
constexpr size_t OFF_VS = OFF_VP + (size_t)4 * 2 * 128 * 256;

constexpr size_t WO_IN = 0;
constexpr size_t WO_MPROJ = WO_IN + (size_t)NINP * 1024;
constexpr size_t WO_GLU = WO_MPROJ + (size_t)1024 * 1024;
constexpr size_t WO_ATTNO = WO_GLU + (size_t)2048 * 1024;
constexpr size_t WO_WOUT = WO_ATTNO + (size_t)1024 * 1024;
constexpr size_t WO_UP = WO_WOUT + (size_t)1024 * 1024;
constexpr size_t WO_DOWN = WO_UP + (size_t)4096 * 1024;
constexpr size_t W_LAYER = WO_DOWN + (size_t)4096 * 1024;

constexpr size_t al256(size_t x) { return (x + 255) & ~(size_t)255; }
constexpr size_t SZ1 = (size_t)T * 1024 * 2;
constexpr size_t WS_X = 0;
constexpr size_t WS_H = WS_X + al256((size_t)T * 1024 * 4);
constexpr size_t WS_Z = WS_H + al256(SZ1);
constexpr size_t WS_U = WS_Z + al256(SZ1);
constexpr size_t WS_Q = WS_U + al256(SZ1);
constexpr size_t WS_YM = WS_Q + al256(SZ1);
constexpr size_t WS_YS = WS_YM + al256(SZ1);
constexpr size_t WS_O = WS_YS + al256(SZ1);
constexpr size_t WS_MG = WS_O + al256(SZ1);
constexpr size_t WS_XBC = WS_MG + al256(SZ1);
constexpr size_t WS_XBT = WS_XBC + al256((size_t)T * 2048 * 2);
constexpr size_t WS_BC = WS_XBT + al256((size_t)1536 * TP * 2);
constexpr size_t WS_A2END = WS_XBC + al256((size_t)T * 4096 * 2);
constexpr size_t WS_BCEND = WS_BC + al256((size_t)TP * 1024 * 2);
constexpr size_t WS_K = WS_A2END > WS_BCEND ? WS_A2END : WS_BCEND;
constexpr size_t WS_VT = WS_K + al256((size_t)T * 256 * 2);
constexpr size_t WS_G = WS_VT + al256((size_t)T * 256 * 2);
constexpr size_t WS_DT = WS_G + al256((size_t)T * 3072 * 2);
constexpr size_t WS_ST = WS_DT + al256((size_t)T * 16 * 4);
constexpr size_t WS_CDEC = WS_ST + al256((size_t)2 * 64 * 16 * 64 * 128 * 4);
constexpr size_t WS_S5S = WS_CDEC + al256((size_t)2 * 64 * 16 * 4);
constexpr size_t WS_S5P = WS_S5S + al256((size_t)2 * 128 * 64 * 64 * 2 * 4);
constexpr size_t WS_ROPE = WS_S5P + al256((size_t)4 * 64 * 36 * 64 * 4);
constexpr size_t WS_WT = WS_ROPE + al256((size_t)8193 * 8 * 8);
constexpr size_t WS_BAR = WS_WT + al256((size_t)4 * W_LAYER * 2);
constexpr size_t WS_HP = WS_BAR + al256(4096 * 4);
constexpr size_t WS_BBT = WS_HP + al256((size_t)2 * 64 * 16 * 64 * 128 * 2);
constexpr size_t WS_TOTAL = WS_BBT + al256((size_t)4 * 64 * 128 * 16 * 2);

struct P {
  const float *x_prompt, *x_sample, *state_ssm, *state_conv, *s5_sre, *s5_sim, *cache_k, *cache_v;
  const float *norm1_w, *w_in, *conv_w, *conv_b, *dt_bias, *a_log, *m_d, *m_norm_w, *m_proj;
  const float *lam_re, *lam_im, *log_step, *b_re, *b_im, *c_re, *c_im, *s5_d, *glu_w;
  const float *sinks, *attn_o, *w_out, *norm2_w, *mlp_up, *mlp_down, *final_w;
  float* out;
  char* ws;
#define WSACC(name, type, off) __device__ __forceinline__ type* name() const { return (type*)(ws + (off)); }
  WSACC(X, float, WS_X) WSACC(H, bf16_t, WS_H) WSACC(Z, bf16_t, WS_Z) WSACC(U, bf16_t, WS_U) WSACC(Q, bf16_t, WS_Q)
  WSACC(YM, bf16_t, WS_YM) WSACC(YS, bf16_t, WS_YS) WSACC(O, bf16_t, WS_O) WSACC(MG, bf16_t, WS_MG)
  WSACC(XBC, bf16_t, WS_XBC) WSACC(XBT, bf16_t, WS_XBT) WSACC(BC, bf16_t, WS_BC) WSACC(A2, bf16_t, WS_XBC)
  WSACC(K, bf16_t, WS_K) WSACC(VT, bf16_t, WS_VT) WSACC(G, bf16_t, WS_G) WSACC(DT, float, WS_DT) WSACC(ST, float, WS_ST)
  WSACC(CDEC, float, WS_CDEC) WSACC(HP, bf16_t, WS_HP) WSACC(BBT, bf16_t, WS_BBT) WSACC(S5S, float, WS_S5S) WSACC(S5P, float, WS_S5P) WSACC(ROPE, float2, WS_ROPE) WSACC(Wt, bf16_t, WS_WT)
#undef WSACC
};

typedef float f32x2_t __attribute__((ext_vector_type(2)));
typedef __bf16 bf16x2_t __attribute__((ext_vector_type(2)));
DI unsigned pack2(float a, float b) { const f32x2_t v = {a, b}; return __builtin_bit_cast(unsigned, __builtin_convertvector(v, bf16x2_t)); }
DI bf16_t f2bf(float x) { return (bf16_t)(pack2(x, 0.f) & 0xffffu); }
DI float bf2f(bf16_t b) { return __uint_as_float(((unsigned)b) << 16); }
DI float bflo(unsigned u) { return __uint_as_float(u << 16); }
DI float bfhi(unsigned u) { return __uint_as_float(u & 0xffff0000u); }
DI float frcp(float x) { return __builtin_amdgcn_rcpf(x); }
DI float silu_f(float x) { return x * frcp(1.f + __expf(-x)); }
DI float sigm_f(float x) { return frcp(1.f + __expf(-x)); }
DI float softplus_f(float x) { return x > 20.f ? x : log1pf(expf(x)); }
DI float gelu_tanh(float x) { float y = 0.7978845608028654f * (x + 0.044715f * x * x * x); float t = 1.f - 2.f * frcp(__expf(2.f * y) + 1.f); return 0.5f * x * (1.f + t); }
DI int crow(int i, int lh) { return (i & 3) + 8 * (i >> 2) + 4 * lh; }
DI int launder(int x) { asm volatile("" : "+v"(x)); return x; }
DI int tidx() { int t = __builtin_amdgcn_workitem_id_x(); asm volatile("" : "+v"(t)); return t; }
DI int launder_s(int x) { asm volatile("" : "+s"(x)); return x; }
DI float wave_sum(float v) {
#pragma unroll
  for (int o = 32; o >= 1; o >>= 1) v += __shfl_xor(v, o);
  return v;
}
DI float wave_max(float v) {
#pragma unroll
  for (int o = 32; o >= 1; o >>= 1) v = fmaxf(v, __shfl_xor(v, o));
  return v;
}
DI bf16x8 u4_to_bf8(uint4 v) { return __builtin_bit_cast(bf16x8, v); }
DI void zero16(f32x16& a) {
#pragma unroll
  for (int i = 0; i < 16; ++i) a[i] = 0.f;
}

constexpr int LDT = 40;
constexpr int GNB = 4;
DI size_t wfrag(int n, int k8, int K) { return ((size_t)(n >> 5) * (K >> 4) + (k8 >> 4)) * 512 + (((k8 >> 3) & 1) * 32 + (n & 31)) * 8; }
DI void gemm_mainloop(const bf16_t* __restrict__ A, int lda, const bf16_t* __restrict__ Bf, int n0, int K,
                      f32x16 (&acc)[2][GNB], char* smem) {
  bf16_t* sa = (bf16_t*)smem;
  const int tid = tidx(), lane = tid & 63, w = __builtin_amdgcn_readfirstlane(tid >> 6), wm = w & 1, wn = w >> 1, lr = lane & 31, lh = lane >> 5;
  const int r0 = tid >> 2, ch = (tid & 3) * 8;
  const bf16_t* ap = A + (size_t)r0 * lda + ch;
  const int ksteps = K >> 4;
  const bf16_t* bq = Bf + ((size_t)((n0 >> 5) + wn * 4) * ksteps) * 512 + lane * 8;
  const size_t bstride = (size_t)ksteps * 512;
  uint4 pa0, pa1;
  bf16x8 bP0, bP1, bP2, bP3, bP4, bP5, bP6, bP7, bQ0, bQ1, bQ2, bQ3, bQ4, bQ5, bQ6, bQ7;
#define GLOADS(R, k0) R##a0 = *(const uint4*)(ap + (k0)); R##a1 = *(const uint4*)(ap + (size_t)64 * lda + (k0));
#define SSTORES(R, bufi) { bf16_t* da = sa + (bufi)*128 * LDT; *(uint4*)(da + (r0)*LDT + ch) = R##a0; *(uint4*)(da + (r0 + 64) * LDT + ch) = R##a1; }
#define BLOADS(R, kt_)                                                                                     \
  { const bf16_t* bb = bq + (size_t)(kt_) * 1024;                                                          \
    R##0 = *(const bf16x8*)(bb); R##1 = *(const bf16x8*)(bb + 512);                                        \
    R##2 = *(const bf16x8*)(bb + bstride); R##3 = *(const bf16x8*)(bb + bstride + 512);                    \
    R##4 = *(const bf16x8*)(bb + 2 * bstride); R##5 = *(const bf16x8*)(bb + 2 * bstride + 512);            \
    R##6 = *(const bf16x8*)(bb + 3 * bstride); R##7 = *(const bf16x8*)(bb + 3 * bstride + 512); }
#define COMPUTE(bufi, R)                                                                                   \
  { const bf16_t* ca = sa + (bufi)*128 * LDT + (wm * 64 + lr) * LDT + lh * 8;                              \
    bf16x8 a00 = *(const bf16x8*)(ca), a10 = *(const bf16x8*)(ca + 32 * LDT);                              \
    bf16x8 a01, a11;                                                                                       \
    acc[0][0] = MFMA32(a00, R##0, acc[0][0]); acc[1][0] = MFMA32(a10, R##0, acc[1][0]);                    \
    acc[0][1] = MFMA32(a00, R##2, acc[0][1]); acc[1][1] = MFMA32(a10, R##2, acc[1][1]);                    \
    acc[0][2] = MFMA32(a00, R##4, acc[0][2]); acc[1][2] = MFMA32(a10, R##4, acc[1][2]);                    \
    acc[0][3] = MFMA32(a00, R##6, acc[0][3]); acc[1][3] = MFMA32(a10, R##6, acc[1][3]);                    \
    __builtin_amdgcn_sched_barrier(0);                                                                     \
    a01 = *(const bf16x8*)(ca + 16); a11 = *(const bf16x8*)(ca + 32 * LDT + 16);                           \
    acc[0][0] = MFMA32(a01, R##1, acc[0][0]); acc[1][0] = MFMA32(a11, R##1, acc[1][0]);                    \
    acc[0][1] = MFMA32(a01, R##3, acc[0][1]); acc[1][1] = MFMA32(a11, R##3, acc[1][1]);                    \
    acc[0][2] = MFMA32(a01, R##5, acc[0][2]); acc[1][2] = MFMA32(a11, R##5, acc[1][2]);                    \
    acc[0][3] = MFMA32(a01, R##7, acc[0][3]); acc[1][3] = MFMA32(a11, R##7, acc[1][3]); }
  const int nk = K >> 5;
  GLOADS(p, 0)
  BLOADS(bP, 0)
  __syncthreads();
  SSTORES(p, 0)
  GLOADS(p, 32)
  BLOADS(bQ, 1)
  SSTORES(p, 1)
  __syncthreads();
  for (int kt = 0; kt < nk; kt += 4) {
    GLOADS(p, (kt + 2) * 32)
    COMPUTE(0, bP)
    BLOADS(bP, kt + 2)
    SSTORES(p, 2)
    GLOADS(p, (kt + 3) * 32)
    COMPUTE(1, bQ)
    BLOADS(bQ, kt + 3)
    SSTORES(p, 3)
    __syncthreads();
    GLOADS(p, (kt + 4) * 32)
    COMPUTE(2, bP)
    BLOADS(bP, kt + 4)
    SSTORES(p, 0)
    GLOADS(p, (kt + 5) * 32)
    COMPUTE(3, bQ)
    BLOADS(bQ, kt + 5)
    SSTORES(p, 1)
    __syncthreads();
  }
#undef GLOADS
#undef SSTORES
#undef BLOADS
#undef COMPUTE
}
DI bool gemm_tile(int slot, int MT, int NT, int& mt, int& nt) {
  const int G = gridDim.x, nx = G >> 3;
  int J = slot;
  if ((G & 7) == 0) J = (slot / G) * G + (slot & 7) * nx + ((slot % G) >> 3);
  if (J >= MT * NT) return false;
  const int gw = 8 * NT, grp = J / gw, rem = J - grp * gw, fm = grp * 8;
  const int gsz = (MT - fm) < 8 ? (MT - fm) : 8;
  mt = fm + rem % gsz; nt = rem / gsz;
  return true;
}

DI int win_map(int n) {
  if (n < 3072) return n;
  if (n < 8704) return n + 16;
  if (n < 8720) return n - 8704 + 3072;
  return -1;
}
DI void wtrans_tile(const float* __restrict__ src, int N, int K, bf16_t* __restrict__ dst, int kt, int nt, bool inmap, char* smem) {
  float* s = (float*)smem;
  const int tid = tidx();
  __syncthreads();
  {
    const int n4 = (tid & 15) * 4;
    int sc = nt * 64 + n4;
    if (inmap) sc = win_map(sc);
#pragma unroll
    for (int ps = 0; ps < 4; ++ps) {
      const int kk = (tid >> 4) + 16 * ps;
      float4 v = make_float4(0.f, 0.f, 0.f, 0.f);
      if (sc >= 0) v = *(const float4*)(src + (size_t)(kt * 64 + kk) * N + sc);
      float* d = s + kk * 65 + n4;
      d[0] = v.x; d[1] = v.y; d[2] = v.z; d[3] = v.w;
    }
  }
  __syncthreads();
  {
    const int n2 = tid >> 2, kq = (tid & 3) * 16;
    unsigned w[8];
#pragma unroll
    for (int j = 0; j < 8; ++j) w[j] = pack2(s[(kq + 2 * j) * 65 + n2], s[(kq + 2 * j + 1) * 65 + n2]);
    const int n = nt * 64 + n2, k0 = kt * 64 + kq;
    bf16_t* d = dst + ((size_t)(n >> 5) * (K >> 4) + (k0 >> 4)) * 512 + (n & 31) * 8;
    *(uint4*)d = make_uint4(w[0], w[1], w[2], w[3]);
    *(uint4*)(d + 256) = make_uint4(w[4], w[5], w[6], w[7]);
  }
}
DI void prep_weight_job(const P& p, int j, char* smem) {
  const int l = j / 5568; int r = j % 5568;
  bf16_t* wl = p.Wt() + (size_t)l * W_LAYER;
  if (r < 2240) { wtrans_tile(p.w_in + (size_t)l * 1024 * NIN, NIN, 1024, wl + WO_IN, r / 140, r % 140, true, smem); return; }
  r -= 2240;
  if (r < 256) { wtrans_tile(p.m_proj + (size_t)l * 1024 * 1024, 1024, 1024, wl + WO_MPROJ, r / 16, r % 16, false, smem); return; }
  r -= 256;
  if (r < 512) { wtrans_tile(p.glu_w + (size_t)l * 1024 * 2048, 2048, 1024, wl + WO_GLU, r / 32, r % 32, false, smem); return; }
  r -= 512;
  if (r < 256) { wtrans_tile(p.attn_o + (size_t)l * 1024 * 1024, 1024, 1024, wl + WO_ATTNO, r / 16, r % 16, false, smem); return; }
  r -= 256;
  if (r < 256) { wtrans_tile(p.w_out + (size_t)l * 1024 * 1024, 1024, 1024, wl + WO_WOUT, r / 16, r % 16, false, smem); return; }
  r -= 256;
  if (r < 1024) { wtrans_tile(p.mlp_up + (size_t)l * 1024 * 4096, 4096, 1024, wl + WO_UP, r / 64, r % 64, false, smem); return; }
  r -= 1024;
  wtrans_tile(p.mlp_down + (size_t)l * 4096 * 1024, 1024, 4096, wl + WO_DOWN, r / 16, r % 16, false, smem);
}
DI void prep_s5_job(const P& p, int j) {
  const int idx = j * 256 + tidx();
  const int n = idx & 63, g = (idx >> 6) & 63, l = idx >> 12;
  const float step = expf(p.log_step[l * 64 + g]);
  const float lr_ = p.lam_re[(l * 64 + g) * 64 + n], li = p.lam_im[(l * 64 + g) * 64 + n];
  const float mag = expf(lr_ * step);
  const float abr = mag * cosf(li * step), abi = mag * sinf(li * step);
  float aqr = abr, aqi = abi;
#pragma unroll
  for (int q = 0; q < 6; ++q) { const float nr2 = aqr * aqr - aqi * aqi, ni2 = 2.f * aqr * aqi; aqr = nr2; aqi = ni2; }
  const float den = lr_ * lr_ + li * li;
  const float nr = abr - 1.0f, ni = abi;
  const float fre = (nr * lr_ + ni * li) / den, fim = (ni * lr_ - nr * li) / den;
  float* o = p.S5P() + ((size_t)(l * 64 + g) * 36) * 64 + n;
  o[0] = abr; o[64] = abi; o[128] = aqr; o[192] = aqi;
  const float* br = p.b_re + ((size_t)(l * 64 + g) * 64 + n) * 16;
  const float* bi = p.b_im + ((size_t)(l * 64 + g) * 64 + n) * 16;
  float vre[16], vim[16];
#pragma unroll
  for (int i = 0; i < 16; ++i) {
    const float b_r = br[i], b_i = bi[i];
    vre[i] = fre * b_r - fim * b_i;
    vim[i] = fre * b_i + fim * b_r;
    o[(4 + i) * 64] = vre[i];
    o[(20 + i) * 64] = vim[i];
  }
  uint4* bt = (uint4*)(p.BBT() + ((size_t)(l * 64 + g) * 128 + n) * 16);
  bt[0] = make_uint4(pack2(vre[0], vre[1]), pack2(vre[2], vre[3]), pack2(vre[4], vre[5]), pack2(vre[6], vre[7]));
  bt[1] = make_uint4(pack2(vre[8], vre[9]), pack2(vre[10], vre[11]), pack2(vre[12], vre[13]), pack2(vre[14], vre[15]));
  bt[128] = make_uint4(pack2(vim[0], vim[1]), pack2(vim[2], vim[3]), pack2(vim[4], vim[5]), pack2(vim[6], vim[7]));
  bt[129] = make_uint4(pack2(vim[8], vim[9]), pack2(vim[10], vim[11]), pack2(vim[12], vim[13]), pack2(vim[14], vim[15]));
}
DI void prep_rope_job(const P& p, int j) {
  const int idx = j * 256 + tidx();
  if (idx >= 8193 * 8) return;
  const int pos = idx >> 3, f = idx & 7;
  const float invf = expf(-(2.0f * (float)f / 16.0f) * logf(500000.0f));
  const float ang = (float)pos * invf;
  p.ROPE()[idx] = make_float2(cosf(ang), sinf(ang));
}

DI void norm_job(const P& p, int job, const float* wgt, bool layer0, bool final_) {
  const int w = __builtin_amdgcn_readfirstlane(tidx() >> 6), lane = tidx() & 63;
  const int r = job * 4 + w;
  const float* src = layer0 ? (r < TP ? p.x_prompt + (size_t)r * 1024 : p.x_sample + (size_t)(r - TP) * 1024) : p.X() + (size_t)r * 1024;
  float4 v[4];
  float ss = 0.f;
#pragma unroll
  for (int q = 0; q < 4; ++q) { v[q] = ((const float4*)src)[lane + 64 * q]; ss += v[q].x * v[q].x + v[q].y * v[q].y + v[q].z * v[q].z + v[q].w * v[q].w; }
  ss = wave_sum(ss);
  const float sc = rsqrtf(ss * (1.f / 1024.f) + EPS);
#pragma unroll
  for (int q = 0; q < 4; ++q) {
    const float4 wv = ((const float4*)wgt)[lane + 64 * q];
    float4 y = make_float4(v[q].x * sc * wv.x, v[q].y * sc * wv.y, v[q].z * sc * wv.z, v[q].w * sc * wv.w);
    if (final_) ((float4*)(p.out + OFF_YP + (size_t)r * 1024))[lane + 64 * q] = y;
    else *(uint2*)(p.H() + (size_t)r * 1024 + (lane + 64 * q) * 4) = make_uint2(pack2(y.x, y.y), pack2(y.z, y.w));
    if (layer0) ((float4*)(p.X() + (size_t)r * 1024))[lane + 64 * q] = v[q];
  }
}

constexpr int LDS_T = 264;
DI void stage_tile(bf16_t* sT, const f32x16 (&acc)[2][GNB], int wm, int wn, int lr, int lh) {
#pragma unroll
  for (int mi = 0; mi < 2; ++mi)
#pragma unroll
    for (int ni = 0; ni < GNB; ++ni) {
      bf16_t* d = sT + (wm * 64 + mi * 32 + 4 * lh) * LDS_T + wn * 128 + ni * 32 + lr;
#pragma unroll
      for (int ig = 0; ig < 4; ++ig) {
        const unsigned p01 = pack2(acc[mi][ni][4 * ig], acc[mi][ni][4 * ig + 1]), p23 = pack2(acc[mi][ni][4 * ig + 2], acc[mi][ni][4 * ig + 3]);
        d[(8 * ig) * LDS_T] = (bf16_t)(p01 & 0xffffu); d[(8 * ig + 1) * LDS_T] = (bf16_t)(p01 >> 16);
        d[(8 * ig + 2) * LDS_T] = (bf16_t)(p23 & 0xffffu); d[(8 * ig + 3) * LDS_T] = (bf16_t)(p23 >> 16);
      }
    }
}
DI void tile_writeout(bf16_t* __restrict__ dst, int ld, const bf16_t* sT) {
  const int tid = tidx();
#pragma unroll 4
  for (int it = 0; it < 16; ++it) {
    const int idx = tid + 256 * it, row = idx >> 5, chunk = idx & 31;
    *(uint4*)(dst + (size_t)row * ld + chunk * 8) = *(const uint4*)(sT + row * LDS_T + chunk * 8);
  }
}

DI void inproj_job(const P& p, int l, int job, char* smem) {
  int mt, nt;
  if (!gemm_tile(job, 129, 35, mt, nt)) return;
  int m0 = mt * 128, n0 = nt * 256;
  f32x16 acc[2][GNB];
#pragma unroll
  for (int a = 0; a < 2; ++a)
#pragma unroll
    for (int b = 0; b < GNB; ++b) zero16(acc[a][b]);
  gemm_mainloop(p.H() + (size_t)m0 * 1024, 1024, p.Wt() + (size_t)l * W_LAYER + WO_IN, n0, 1024, acc, smem);
  m0 = launder_s(m0); n0 = launder_s(n0);
  nt = launder_s(nt); mt = launder_s(mt);
  const int tid = tidx(), lane = tid & 63, w = __builtin_amdgcn_readfirstlane(tid >> 6), wm = w & 1, wn = w >> 1, lr = lane & 31, lh = lane >> 5;
  bf16_t* sT = (bf16_t*)smem;
  if (nt == 34) {
    if (wn == 0 && lr < 16) {
      const float bias = p.dt_bias[l * 16 + lr];
#pragma unroll
      for (int mi = 0; mi < 2; ++mi)
#pragma unroll
        for (int i = 0; i < 16; ++i) p.DT()[(size_t)(m0 + wm * 64 + mi * 32 + crow(i, lh)) * 16 + lr] = softplus_f(acc[mi][0][i] + bias);
    }
    return;
  }
  if (nt >= 16 && nt <= 20) {
#pragma unroll
    for (int mi = 0; mi < 2; ++mi)
#pragma unroll
      for (int ni = 0; ni < GNB; ni += 2)
#pragma unroll
        for (int i = 0; i < 16; ++i) {
          const float v = acc[mi][ni][i];
          const float pv = __shfl_xor(v, 8);
          if (lr < 16) {
            const int r = m0 + wm * 64 + mi * 32 + crow(i, lh);
            const int pos = (r >= TP) ? 8192 : (r & 8191);
            const float2 cs = p.ROPE()[pos * 8 + (lr & 7)];
            acc[mi][ni][i] = (lr < 8) ? v * cs.x - pv * cs.y : v * cs.x + pv * cs.y;
          }
        }
  }
  if (nt >= 22) {
#pragma unroll
    for (int mi = 0; mi < 2; ++mi)
#pragma unroll
      for (int ni = 0; ni < GNB; ++ni)
#pragma unroll
        for (int i = 0; i < 16; ++i) acc[mi][ni][i] = sigm_f(acc[mi][ni][i]);
  }
  if ((mt == 63 || mt == 127 || mt == 128) && ((nt >= 4 && nt < 12) || nt == 20 || nt == 21)) {
#pragma unroll
    for (int mi = 0; mi < 2; ++mi)
#pragma unroll
      for (int ni = 0; ni < GNB; ++ni) {
        const int cc = (n0 & 255) + wn * 128 + ni * 32 + lr;
        const int rb_ = launder(m0 + wm * 64 + mi * 32 + 4 * lh);
#pragma unroll
        for (int i = 0; i < 16; ++i) {
          const int r = rb_ + (i & 3) + 8 * (i >> 2);
          const float v = acc[mi][ni][i];
          if (nt < 12) {
            const int ch = (n0 - 1024) + cc;
            if (r >= TP) p.out[OFF_CONVS + ((size_t)(l * 128 + (r - TP)) * 3 + 2) * 2048 + ch] = v;
            else { const int t = r & 8191; if (t >= 8189) p.out[OFF_CONVP + ((size_t)(l * 2 + (r >> 13)) * 3 + (t - 8189)) * 2048 + ch] = v; }
          } else {
            const size_t ob = (nt == 20) ? OFF_KS : OFF_VS, obp = (nt == 20) ? OFF_KP : OFF_VP;
            if (r >= TP) p.out[ob + ((size_t)(l * 128 + (r - TP)) * 128 + 127) * 256 + cc] = v;
            else p.out[obp + ((size_t)(l * 2 + (r >> 13)) * 128 + ((r & 8191) - 8064)) * 256 + cc] = v;
          }
        }
        __builtin_amdgcn_sched_barrier(0);
      }
  }
  if (nt == 21) {
#pragma unroll
    for (int mi = 0; mi < 2; ++mi)
#pragma unroll
      for (int ni = 0; ni < GNB; ++ni) {
        bf16_t* d = sT + (wn * 128 + ni * 32 + lr) * 136 + wm * 64 + mi * 32 + 4 * lh;
#pragma unroll
        for (int ig = 0; ig < 4; ++ig)
          *(uint2*)(d + 8 * ig) = make_uint2(pack2(acc[mi][ni][4 * ig], acc[mi][ni][4 * ig + 1]), pack2(acc[mi][ni][4 * ig + 2], acc[mi][ni][4 * ig + 3]));
      }
    __syncthreads();
#pragma unroll 4
    for (int it = 0; it < 16; ++it) {
      const int idx = tid + 256 * it, c = idx >> 4, chunk = idx & 15;
      *(uint4*)(p.VT() + (size_t)c * T + m0 + chunk * 8) = *(const uint4*)(sT + c * 136 + chunk * 8);
    }
    return;
  }
  stage_tile(sT, acc, wm, wn, lr, lh);
  __syncthreads();
  bf16_t* dst; int ld;
  if (nt < 4) { dst = p.Z() + n0; ld = 1024; }
  else if (nt < 12) { dst = p.XBC() + (n0 - 1024); ld = 2048; }
  else if (nt < 16) { dst = p.U() + (n0 - 3072); ld = 1024; }
  else if (nt < 20) { dst = p.Q() + (n0 - 4096); ld = 1024; }
  else if (nt == 20) { dst = p.K(); ld = 256; }
  else { dst = p.G() + (n0 - 5632); ld = 3072; }
  tile_writeout(dst + (size_t)m0 * ld, ld, sT);
}

DI void conv_job(const P& p, int l, int job, char* smem) {
  const int ct = job & 31, tt = job >> 5;
  const int ch0 = ct * 64, tokb = tt * 128;
  bf16_t* sT = (bf16_t*)smem;
  const int tid = tidx();
  const float* cw = p.conv_w + (size_t)l * 4 * 2048;
  __syncthreads();
  const int chk = tid & 7, ch = ch0 + chk * 8;
  float wt[4][8], bs[8];
  {
    const float4 b0 = *(const float4*)(p.conv_b + l * 2048 + ch), b1 = *(const float4*)(p.conv_b + l * 2048 + ch + 4);
    bs[0] = b0.x; bs[1] = b0.y; bs[2] = b0.z; bs[3] = b0.w; bs[4] = b1.x; bs[5] = b1.y; bs[6] = b1.z; bs[7] = b1.w;
#pragma unroll
    for (int j = 0; j < 4; ++j) {
      const float4 w0 = *(const float4*)(cw + j * 2048 + ch), w1 = *(const float4*)(cw + j * 2048 + ch + 4);
      wt[j][0] = w0.x; wt[j][1] = w0.y; wt[j][2] = w0.z; wt[j][3] = w0.w; wt[j][4] = w1.x; wt[j][5] = w1.y; wt[j][6] = w1.z; wt[j][7] = w1.w;
    }
  }
#pragma unroll
  for (int it = 0; it < 4; ++it) {
    const int item = tid + 256 * it, tl = item >> 3, row = tokb + tl, t = row & 8191;
    float a[8];
#pragma unroll
    for (int j = 0; j < 8; ++j) a[j] = bs[j];
#pragma unroll
    for (int j = 0; j < 4; ++j) {
      if (t - 3 + j >= 0) {
        const uint4 rv = *(const uint4*)(p.XBC() + (size_t)(row - 3 + j) * 2048 + ch);
        a[0] += bflo(rv.x) * wt[j][0]; a[1] += bfhi(rv.x) * wt[j][1]; a[2] += bflo(rv.y) * wt[j][2]; a[3] += bfhi(rv.y) * wt[j][3];
        a[4] += bflo(rv.z) * wt[j][4]; a[5] += bfhi(rv.z) * wt[j][5]; a[6] += bflo(rv.w) * wt[j][6]; a[7] += bfhi(rv.w) * wt[j][7];
      }
    }
#pragma unroll
    for (int j = 0; j < 8; ++j) a[j] = silu_f(a[j]);
    if (ct >= 16) *(uint4*)(p.BC() + (size_t)row * 1024 + (ch - 1024)) = make_uint4(pack2(a[0], a[1]), pack2(a[2], a[3]), pack2(a[4], a[5]), pack2(a[6], a[7]));
    if (ct < 24) {
#pragma unroll
      for (int j = 0; j < 8; ++j) sT[(chk * 8 + j) * 136 + (tl ^ (chk << 3))] = f2bf(a[j]);
    }
  }
  if (ct < 24) {
    __syncthreads();
#pragma unroll
    for (int it = 0; it < 4; ++it) {
      const int item = tid + 256 * it, r = item >> 4, chk = item & 15;
      *(uint4*)(p.XBT() + (size_t)(ch0 + r) * TP + tokb + chk * 8) = *(const uint4*)(sT + r * 136 + ((chk ^ (r >> 3)) << 3));
    }
  }
}

DI void chunk_acum(const P& p, int l, int head, int tok0, float* sAc, float* sDt, float& alast) {
  const int lane = tidx() & 63;
  const float Ah = -expf(p.a_log[l * 16 + head]);
  const float d0 = p.DT()[(size_t)(tok0 + 2 * lane) * 16 + head], d1 = p.DT()[(size_t)(tok0 + 2 * lane + 1) * 16 + head];
  const float a0 = d0 * Ah, a1 = d1 * Ah;
  float s = a0 + a1;
#pragma unroll
  for (int off = 1; off < 64; off <<= 1) { const float tv = __shfl_up(s, off); if (lane >= off) s += tv; }
  const float excl = s - (a0 + a1);
  sAc[2 * lane] = excl + a0; sAc[2 * lane + 1] = s;
  sDt[2 * lane] = d0; sDt[2 * lane + 1] = d1;
  alast = __shfl(s, 63);
}

DI void ssd_a_job(const P& p, int l, int job, char* smem) {
  const int head = job & 15, c = (job >> 4) & 63, b = job >> 10, g = head >> 2;
  const int tok0 = b * SEQ + c * 128;
  bf16_t* sXT = (bf16_t*)smem;
  bf16_t* sBT = sXT + 64 * 136;
  float* sW = (float*)(sBT + 128 * 136);
  float* sAc = sW + 128;
  float* sDt = sAc + 128;
  const int tid = tidx(), lane = tid & 63, w = __builtin_amdgcn_readfirstlane(tid >> 6), lr = lane & 31, lh = lane >> 5;
  __syncthreads();
  if (w == 0) {
    float alast;
    chunk_acum(p, l, head, tok0, sAc, sDt, alast);
    sW[2 * lane] = sDt[2 * lane] * __expf(alast - sAc[2 * lane]);
    sW[2 * lane + 1] = sDt[2 * lane + 1] * __expf(alast - sAc[2 * lane + 1]);
    if (lane == 0) p.CDEC()[(b * 64 + c) * 16 + head] = __expf(alast);
  }
  __syncthreads();
#pragma unroll
  for (int it = 0; it < 4; ++it) {
    const int item = tid + 256 * it, pr = item >> 4, s0 = (item & 15) * 8;
    const uint4 v = *(const uint4*)(p.XBT() + (size_t)(head * 64 + pr) * TP + tok0 + s0);
    const float4 w0 = *(const float4*)(sW + s0), w1 = *(const float4*)(sW + s0 + 4);
    *(uint4*)(sXT + pr * 136 + s0) = make_uint4(pack2(bflo(v.x) * w0.x, bfhi(v.x) * w0.y), pack2(bflo(v.y) * w0.z, bfhi(v.y) * w0.w),
                                                pack2(bflo(v.z) * w1.x, bfhi(v.z) * w1.y), pack2(bflo(v.w) * w1.z, bfhi(v.w) * w1.w));
  }
#pragma unroll
  for (int it = 0; it < 8; ++it) {
    const int item = tid + 256 * it, n = item >> 4, s0 = (item & 15) * 8;
    *(uint4*)(sBT + n * 136 + s0) = *(const uint4*)(p.XBT() + (size_t)(1024 + g * 128 + n) * TP + tok0 + s0);
  }
  __syncthreads();
  const int wp = w & 1, wn = w >> 1;
  f32x16 acc[2];
  zero16(acc[0]); zero16(acc[1]);
#pragma unroll
  for (int kk = 0; kk < 8; ++kk) {
    const bf16x8 af = *(const bf16x8*)(sXT + (wp * 32 + lr) * 136 + kk * 16 + lh * 8);
#pragma unroll
    for (int ni = 0; ni < 2; ++ni) {
      const bf16x8 bfr = *(const bf16x8*)(sBT + (wn * 64 + ni * 32 + lr) * 136 + kk * 16 + lh * 8);
      acc[ni] = MFMA32(af, bfr, acc[ni]);
    }
  }
  float* st = p.ST() + ((size_t)((b * 64 + c) * 16 + head) * 64) * 128;
#pragma unroll
  for (int ni = 0; ni < 2; ++ni)
#pragma unroll
    for (int i = 0; i < 16; ++i) st[(wp * 32 + crow(i, lh)) * 128 + wn * 64 + ni * 32 + lr] = acc[ni][i];
}

DI void ssd_scan_job(const P& p, int l, int job) {
  const int gid = job * 256 + tidx();
  const int b = gid >> 15, rem = gid & 32767, head = rem >> 11;
  float4 h = make_float4(0.f, 0.f, 0.f, 0.f);
  const float4* sp0 = (const float4*)(p.ST() + (size_t)(b * 64) * 131072) + rem;
  uint2* hp0 = (uint2*)(p.HP() + (size_t)(b * 64) * 131072) + rem;
  for (int c0 = 0; c0 < 64; c0 += 16) {
    float4 sv[16];
    float dv[16];
#pragma unroll
    for (int k = 0; k < 16; ++k) { sv[k] = sp0[(size_t)(c0 + k) * 32768]; dv[k] = p.CDEC()[(b * 64 + c0 + k) * 16 + head]; }
#pragma unroll
    for (int k = 0; k < 16; ++k) {
      hp0[(size_t)(c0 + k) * 32768] = make_uint2(pack2(h.x, h.y), pack2(h.z, h.w));
      h.x = h.x * dv[k] + sv[k].x; h.y = h.y * dv[k] + sv[k].y; h.z = h.z * dv[k] + sv[k].z; h.w = h.w * dv[k] + sv[k].w;
    }
  }
  ((float4*)(p.out + OFF_SSMP + (size_t)(l * 2 + b) * 131072))[rem] = h;
}

DI void s5_scan_job(const P& p, int l, int job) {
  const int gid = job * 256 + tidx();
  const int n = gid & 63, g = (gid >> 6) & 63, b = gid >> 12;
  const float* prm = p.S5P() + ((size_t)(l * 64 + g) * 36) * 64 + n;
  const float aqr = prm[128], aqi = prm[192];
  float hr = 0.f, hi = 0.f;
  float2* sp = (float2*)p.S5S() + ((size_t)(b * 128) * 64 + g) * 64 + n;
  for (int c0 = 0; c0 < 128; c0 += 8) {
    float2 sv[8];
#pragma unroll
    for (int k = 0; k < 8; ++k) sv[k] = sp[(size_t)(c0 + k) * 4096];
#pragma unroll
    for (int k = 0; k < 8; ++k) {
      sp[(size_t)(c0 + k) * 4096] = make_float2(hr, hi);
      const float nr = aqr * hr - aqi * hi + sv[k].x, ni = aqr * hi + aqi * hr + sv[k].y;
      hr = nr; hi = ni;
    }
  }
}

DI void ssd_c_job(const P& p, int l, int job, char* smem) {
  const int g = job & 3, c = (job >> 2) & 63, b = job >> 8;
  const int tok0 = b * SEQ + c * 128;
  bf16_t* sC = (bf16_t*)smem;
  bf16_t* sB = sC + 128 * 136;
  float* sAc = (float*)(sB + 128 * 136);
  float* sDt = sAc + 512;
  const int tid = tidx(), lane = tid & 63, w = __builtin_amdgcn_readfirstlane(tid >> 6), lr = lane & 31, lh = lane >> 5, wm = w & 1, wn = w >> 1;
  __syncthreads();
  { float alast; chunk_acum(p, l, g * 4 + w, tok0, sAc + w * 128, sDt + w * 128, alast); }
#pragma unroll
  for (int it = 0; it < 8; ++it) {
    const int item = tid + 256 * it, r = item >> 4, s0 = (item & 15) * 8;
    *(uint4*)(sC + r * 136 + s0) = *(const uint4*)(p.BC() + (size_t)(tok0 + r) * 1024 + 512 + g * 128 + s0);
    *(uint4*)(sB + r * 136 + s0) = *(const uint4*)(p.BC() + (size_t)(tok0 + r) * 1024 + g * 128 + s0);
  }
  __syncthreads();
  f32x16 cb[2][2];
#pragma unroll
  for (int a = 0; a < 2; ++a)
#pragma unroll
    for (int bb = 0; bb < 2; ++bb) zero16(cb[a][bb]);
  if (!(wm == 0 && wn == 1)) {
#pragma unroll
    for (int kk = 0; kk < 8; ++kk) {
      bf16x8 af[2], bfr[2];
#pragma unroll
      for (int mi = 0; mi < 2; ++mi) af[mi] = *(const bf16x8*)(sC + (wm * 64 + mi * 32 + lr) * 136 + kk * 16 + lh * 8);
#pragma unroll
      for (int ni = 0; ni < 2; ++ni) bfr[ni] = *(const bf16x8*)(sB + (wn * 64 + ni * 32 + lr) * 136 + kk * 16 + lh * 8);
#pragma unroll
      for (int mi = 0; mi < 2; ++mi)
#pragma unroll
        for (int ni = 0; ni < 2; ++ni) cb[mi][ni] = MFMA32(af[mi], bfr[ni], cb[mi][ni]);
    }
  }
  __syncthreads();
  bf16_t* sM = sB;
  unsigned cbp[2][2][8];
#pragma unroll
  for (int a = 0; a < 2; ++a)
#pragma unroll
    for (int bb = 0; bb < 2; ++bb)
#pragma unroll
      for (int k = 0; k < 8; ++k) cbp[a][bb][k] = pack2(cb[a][bb][2 * k], cb[a][bb][2 * k + 1]);
  float ss[16];
#pragma unroll
  for (int i = 0; i < 16; ++i) ss[i] = 0.f;
#pragma unroll 1
  for (int hd = 0; hd < 4; ++hd) {
    const int head = g * 4 + hd;
    const float* ac = sAc + hd * 128;
    const float* dtv = sDt + hd * 128;
    const int lrq = launder(lr), lhq = launder(lh);
#pragma unroll
    for (int mi = 0; mi < 2; ++mi)
#pragma unroll
      for (int ni = 0; ni < 2; ++ni) {
        const int s = wn * 64 + ni * 32 + lrq;
        const float as = ac[s], ds = dtv[s];
#pragma unroll
        for (int i = 0; i < 16; ++i) {
          const int t = wm * 64 + mi * 32 + crow(i, lhq);
          const float cv = (i & 1) ? bfhi(cbp[mi][ni][i >> 1]) : bflo(cbp[mi][ni][i >> 1]);
          const float v = (s <= t) ? cv * __expf(ac[t] - as) * ds : 0.f;
          sM[t * 136 + s] = f2bf(v);
        }
        __builtin_amdgcn_sched_barrier(0);
      }
    __syncthreads();
    f32x16 yd[2];
    zero16(yd[0]); zero16(yd[1]);
    {
      const bf16_t* hb = p.HP() + (((size_t)((b * 64 + c) * 16 + head) * 64 + lr) * 128 + lh * 8);
      bf16x8 hf[8][2];
#pragma unroll
      for (int kk = 0; kk < 8; ++kk)
#pragma unroll
        for (int pb = 0; pb < 2; ++pb) hf[kk][pb] = *(const bf16x8*)(hb + (size_t)pb * 32 * 128 + kk * 16);
#pragma unroll
      for (int kk = 0; kk < 8; ++kk) {
        const bf16x8 af = *(const bf16x8*)(sC + (32 * w + lr) * 136 + kk * 16 + lh * 8);
        yd[0] = MFMA32(af, hf[kk][0], yd[0]);
        yd[1] = MFMA32(af, hf[kk][1], yd[1]);
      }
    }
#pragma unroll
    for (int i = 0; i < 16; ++i) {
      const float e = __expf(ac[32 * w + crow(i, lh)]);
      yd[0][i] *= e; yd[1][i] *= e;
    }
    {
      const int nkk = 2 * (w + 1);
      const bf16_t* xb = p.XBT() + (size_t)(head * 64 + lr) * TP + tok0 + lh * 8;
      const bf16_t* am = sM + (32 * w + lr) * 136 + lh * 8;
      bf16x8 x00 = *(const bf16x8*)(xb), x01 = *(const bf16x8*)(xb + (size_t)32 * TP);
      for (int kk = 0; kk < nkk; kk += 2) {
        const bf16x8 x10 = *(const bf16x8*)(xb + (kk + 1) * 16), x11 = *(const bf16x8*)(xb + (size_t)32 * TP + (kk + 1) * 16);
        const bf16x8 a0 = *(const bf16x8*)(am + kk * 16);
        yd[0] = MFMA32(a0, x00, yd[0]);
        yd[1] = MFMA32(a0, x01, yd[1]);
        const int kn = (kk + 2 < nkk) ? kk + 2 : kk;
        x00 = *(const bf16x8*)(xb + kn * 16); x01 = *(const bf16x8*)(xb + (size_t)32 * TP + kn * 16);
        const bf16x8 a1 = *(const bf16x8*)(am + (kk + 1) * 16);
        yd[0] = MFMA32(a1, x10, yd[0]);
        yd[1] = MFMA32(a1, x11, yd[1]);
      }
    }
    const float Dh = p.m_d[l * 16 + head];
#pragma unroll
    for (int pb = 0; pb < 2; ++pb) {
      const int pch = head * 64 + pb * 32 + lr;
#pragma unroll
      for (int ig = 0; ig < 4; ++ig) {
        const int t0 = 32 * w + 8 * ig + 4 * lh;
        const uint2 xr = *(const uint2*)(p.XBT() + (size_t)pch * TP + tok0 + t0);
        const float xs[4] = {bflo(xr.x), bfhi(xr.x), bflo(xr.y), bfhi(xr.y)};
#pragma unroll
        for (int jj = 0; jj < 4; ++jj) {
          const int i = 4 * ig + jj, t = t0 + jj;
          const float y = yd[pb][i] + Dh * xs[jj];
          const float z = bf2f(p.Z()[(size_t)(tok0 + t) * 1024 + pch]);
          const float yg = y * silu_f(z);
          ss[i] += yg * yg;
          p.YM()[(size_t)(tok0 + t) * 1024 + pch] = f2bf(yg);
        }
      }
      __builtin_amdgcn_sched_barrier(0);
    }
    __syncthreads();
  }
#pragma unroll
  for (int i = 0; i < 16; ++i) {
    float v = ss[i];
    v += __shfl_xor(v, 1); v += __shfl_xor(v, 2); v += __shfl_xor(v, 4); v += __shfl_xor(v, 8); v += __shfl_xor(v, 16);
    ss[i] = rsqrtf(v * (1.f / 256.f) + EPS);
  }
  for (int hd = 0; hd < 4; ++hd) {
#pragma unroll
    for (int pb = 0; pb < 2; ++pb) {
      const int pch = (g * 4 + hd) * 64 + pb * 32 + lr;
      const float nw = p.m_norm_w[l * 1024 + pch];
#pragma unroll
      for (int i = 0; i < 16; ++i) {
        const size_t idx = (size_t)(tok0 + 32 * w + crow(i, lh)) * 1024 + pch;
        p.YM()[idx] = f2bf(bf2f(p.YM()[idx]) * ss[i] * nw);
      }
      __builtin_amdgcn_sched_barrier(0);
    }
  }
}

DI void ssd_sample_job(const P& p, int l, int job, char* smem) {
  const int g = job & 3, b = job >> 2;
  float* sx = (float*)smem;
  float* sBv = sx + 256;
  float* sCv = sBv + 128;
  float* sY = sCv + 128;
  float* sRed = sY + 256;
  const int tid = tidx(), lane = tid & 63, w = __builtin_amdgcn_readfirstlane(tid >> 6);
  const int row = TP + b;
  __syncthreads();
#pragma unroll
  for (int it = 0; it < 2; ++it) {
    const int idx = tid + 256 * it;
    const int ch = idx < 256 ? g * 256 + idx : (idx < 384 ? 1024 + g * 128 + (idx - 256) : 1536 + g * 128 + (idx - 384));
    const float* sc = p.state_conv + ((size_t)(l * 128 + b) * 3) * 2048 + ch;
    const float s0 = sc[0], s1 = sc[2048], s2 = sc[4096];
    const float raw = bf2f(p.XBC()[(size_t)row * 2048 + ch]);
    const float* cw = p.conv_w + (size_t)l * 4 * 2048 + ch;
    float v = p.conv_b[l * 2048 + ch] + cw[0] * s0 + cw[2048] * s1 + cw[4096] * s2 + cw[6144] * raw;
    v = silu_f(v);
    sx[idx] = v;
    float* co = p.out + OFF_CONVS + ((size_t)(l * 128 + b) * 3) * 2048 + ch;
    co[0] = s1; co[2048] = s2;
  }
  __syncthreads();
  const int pp = tid >> 2, nq = (tid & 3) * 32;
  float4 hv[4][8];
#pragma unroll
  for (int hd = 0; hd < 4; ++hd) {
    const float4* h0 = (const float4*)(p.state_ssm + ((((size_t)l * 128 + b) * 16 + g * 4 + hd) * 64 + pp) * 128 + nq);
#pragma unroll
    for (int q = 0; q < 8; ++q) hv[hd][q] = h0[q];
  }
#pragma unroll
  for (int hd = 0; hd < 4; ++hd) {
    const int head = g * 4 + hd;
    const float dt = p.DT()[(size_t)row * 16 + head];
    const float Ah = -expf(p.a_log[l * 16 + head]);
    const float dA = __expf(dt * Ah);
    const float xv = sx[hd * 64 + pp];
    const float coef = dt * xv;
    float4* ho = (float4*)(p.out + OFF_SSMS + ((((size_t)l * 128 + b) * 16 + head) * 64 + pp) * 128 + nq);
    float yacc = 0.f;
#pragma unroll
    for (int q = 0; q < 8; ++q) {
      float4 h4 = hv[hd][q];
      const int n = nq + 4 * q;
      h4.x = h4.x * dA + coef * sBv[n]; h4.y = h4.y * dA + coef * sBv[n + 1]; h4.z = h4.z * dA + coef * sBv[n + 2]; h4.w = h4.w * dA + coef * sBv[n + 3];
      yacc += h4.x * sCv[n] + h4.y * sCv[n + 1] + h4.z * sCv[n + 2] + h4.w * sCv[n + 3];
      ho[q] = h4;
    }
    yacc += __shfl_xor(yacc, 1); yacc += __shfl_xor(yacc, 2);
    const float y = yacc + p.m_d[l * 16 + head] * xv;
    const float z = bf2f(p.Z()[(size_t)row * 1024 + head * 64 + pp]);
    if ((tid & 3) == 0) sY[hd * 64 + pp] = y * silu_f(z);
  }
  __syncthreads();
  const float v = sY[tid];
  const float ssq = wave_sum(v * v);
  if (lane == 0) sRed[w] = ssq;
  __syncthreads();
  const float tot = sRed[0] + sRed[1] + sRed[2] + sRed[3];
  const float sc = rsqrtf(tot * (1.f / 256.f) + EPS);
  p.YM()[(size_t)row * 1024 + g * 256 + tid] = f2bf(v * sc * p.m_norm_w[l * 1024 + g * 256 + tid]);
}

DI void s5_wave_job(const P& p, int l, int mode, int b, int g, int c_first, int nch, bf16_t* sH) {
  const int lane = tidx() & 63, lr = lane & 31, lh = lane >> 5;
  bf16x8 bq[4];
#pragma unroll
  for (int nb = 0; nb < 4; ++nb) bq[nb] = *(const bf16x8*)(p.BBT() + ((size_t)(l * 64 + g) * 128 + nb * 32 + lr) * 16 + lh * 8);
  float ar[2], ai[2], cr_[2], ci_[2];
#pragma unroll
  for (int k = 0; k < 2; ++k) {
    const float* prm = p.S5P() + ((size_t)(l * 64 + g) * 36) * 64 + k * 32 + lr;
    ar[k] = prm[0]; ai[k] = prm[64];
  }
  const int o = lane & 15, quad = lane >> 4;
  bf16x8 cf[4];
  float dsk = 0.f;
  if (mode != 0) {
#pragma unroll
    for (int kk = 0; kk < 4; ++kk) {
      const float* cp = ((kk < 2) ? p.c_re : p.c_im) + ((size_t)(l * 64 + g) * 16 + o) * 64 + (kk & 1) * 32 + quad * 8;
      const float4 c0 = ((const float4*)cp)[0], c1 = ((const float4*)cp)[1];
      const float sg = (kk < 2) ? 1.f : -1.f;
      cf[kk] = u4_to_bf8(make_uint4(pack2(sg * c0.x, sg * c0.y), pack2(sg * c0.z, sg * c0.w), pack2(sg * c1.x, sg * c1.y), pack2(sg * c1.z, sg * c1.w)));
    }
    dsk = p.s5_d[l * 1024 + g * 16 + o];
  }
  for (int cc = 0; cc < nch; ++cc) {
  const int c = c_first + cc;
  int row0, Q;
  if (mode == 2) { row0 = TP + b; Q = 1; } else { row0 = b * SEQ + c * 64; Q = 64; }
#pragma unroll
  for (int k = 0; k < 2; ++k) {
    const int n = k * 32 + lr;
    cr_[k] = 0.f; ci_[k] = 0.f;
    if (mode == 2) {
      cr_[k] = p.s5_sre[((size_t)(l * 128 + b) * 64 + g) * 64 + n];
      ci_[k] = p.s5_sim[((size_t)(l * 128 + b) * 64 + g) * 64 + n];
    } else if (mode == 1) {
      const float2 sv = *(const float2*)(p.S5S() + (((size_t)(b * 128 + c) * 64 + g) * 64 + n) * 2);
      cr_[k] = sv.x; ci_[k] = sv.y;
    }
  }
  const int ntb = (mode == 2) ? 1 : 2;
  for (int tb = 0; tb < ntb; ++tb) {
    const bf16x8 uf = *(const bf16x8*)(p.U() + (size_t)(row0 + tb * 32 + lr) * 1024 + g * 16 + lh * 8);
    f32x16 acc[4];
#pragma unroll
    for (int nb = 0; nb < 4; ++nb) { zero16(acc[nb]); acc[nb] = MFMA32(uf, bq[nb], acc[nb]); }
#pragma unroll
    for (int k = 0; k < 2; ++k) {
      const float a1r = ar[k], a1i = ai[k];
      const float a2r = a1r * a1r - a1i * a1i, a2i = 2.f * a1r * a1i;
      const float a3r = a2r * a1r - a2i * a1i, a3i = a2r * a1i + a2i * a1r;
      const float a4r = a2r * a2r - a2i * a2i, a4i = 2.f * a2r * a2i;
      float er[4], ei[4];
#pragma unroll
      for (int q = 0; q < 4; ++q) {
        float hr = acc[k][4 * q], hi = acc[2 + k][4 * q];
#pragma unroll
        for (int j = 1; j < 4; ++j) {
          const float nr = a1r * hr - a1i * hi + acc[k][4 * q + j], ni = a1r * hi + a1i * hr + acc[2 + k][4 * q + j];
          hr = nr; hi = ni;
          acc[k][4 * q + j] = hr; acc[2 + k][4 * q + j] = hi;
        }
        er[q] = hr; ei[q] = hi;
      }
      float cinr[4], cini[4];
      float cr = cr_[k], ci = ci_[k];
#pragma unroll
      for (int q = 0; q < 4; ++q) {
        const float per = __shfl_xor(er[q], 32), pei = __shfl_xor(ei[q], 32);
        const float e0r = lh ? per : er[q], e0i = lh ? pei : ei[q];
        const float e1r = lh ? er[q] : per, e1i = lh ? ei[q] : pei;
        const float c1r = a4r * cr - a4i * ci + e0r, c1i = a4r * ci + a4i * cr + e0i;
        cinr[q] = lh ? c1r : cr; cini[q] = lh ? c1i : ci;
        cr = a4r * c1r - a4i * c1i + e1r; ci = a4r * c1i + a4i * c1r + e1i;
      }
#pragma unroll
      for (int q = 0; q < 4; ++q) {
        const float xr = cinr[q], xi = cini[q];
        acc[k][4 * q] += a1r * xr - a1i * xi;     acc[2 + k][4 * q] += a1r * xi + a1i * xr;
        acc[k][4 * q + 1] += a2r * xr - a2i * xi; acc[2 + k][4 * q + 1] += a2r * xi + a2i * xr;
        acc[k][4 * q + 2] += a3r * xr - a3i * xi; acc[2 + k][4 * q + 2] += a3r * xi + a3i * xr;
        acc[k][4 * q + 3] += a4r * xr - a4i * xi; acc[2 + k][4 * q + 3] += a4r * xi + a4i * xr;
      }
      if (mode == 2) { cr_[k] = acc[k][0]; ci_[k] = acc[2 + k][0]; }
      else { cr_[k] = cr; ci_[k] = ci; }
      if (mode != 0) {
#pragma unroll
        for (int i = 0; i < 16; ++i) {
          const int t = tb * 32 + crow(i, lh);
          sH[t * 136 + k * 32 + lr] = f2bf(acc[k][i]);
          sH[t * 136 + 64 + k * 32 + lr] = f2bf(acc[2 + k][i]);
        }
      }
    }
  }
  if (lh == 0) {
#pragma unroll
    for (int k = 0; k < 2; ++k) {
      const int n = k * 32 + lr;
      if (mode == 0) *(float2*)(p.S5S() + (((size_t)(b * 128 + c) * 64 + g) * 64 + n) * 2) = make_float2(cr_[k], ci_[k]);
      if (mode == 1 && c == 127) {
        p.out[OFF_S5RP + ((size_t)(l * 2 + b) * 64 + g) * 64 + n] = cr_[k];
        p.out[OFF_S5IP + ((size_t)(l * 2 + b) * 64 + g) * 64 + n] = ci_[k];
      }
      if (mode == 2) {
        p.out[OFF_S5RS + ((size_t)(l * 128 + b) * 64 + g) * 64 + n] = cr_[k];
        p.out[OFF_S5IS + ((size_t)(l * 128 + b) * 64 + g) * 64 + n] = ci_[k];
      }
    }
  }
  if (mode == 0) continue;
  const int nrb = (mode == 2) ? 1 : 4;
  __builtin_amdgcn_fence(__ATOMIC_RELEASE, "wavefront");
  __builtin_amdgcn_wave_barrier();
  __builtin_amdgcn_fence(__ATOMIC_ACQUIRE, "wavefront");
  for (int rb = 0; rb < nrb; ++rb) {
    f32x4 a4 = {0.f, 0.f, 0.f, 0.f};
#pragma unroll
    for (int kk = 0; kk < 4; ++kk) {
      const bf16x8 af = *(const bf16x8*)(sH + (rb * 16 + o) * 136 + kk * 32 + quad * 8);
      a4 = MFMA16(af, cf[kk], a4);
    }
#pragma unroll
    for (int jj = 0; jj < 4; ++jj) {
      const int t = rb * 16 + quad * 4 + jj;
      if (t < Q) {
        const size_t idx = (size_t)(row0 + t) * 1024 + g * 16 + o;
        const float y = a4[jj] + dsk * bf2f(p.U()[idx]);
        p.YS()[idx] = f2bf(gelu_tanh(y));
      }
    }
  }
  __builtin_amdgcn_fence(__ATOMIC_RELEASE, "wavefront");
  __builtin_amdgcn_wave_barrier();
  }
}

DI void attn_prompt_job(const P& p, int l, int job, char* smem) {
  const int kvh = job & 3, blk = (job >> 2) & 63, b = job >> 8;
  bf16_t* sK = (bf16_t*)smem;
  bf16_t* sVt = sK + 256 * 72;
  const int tid = tidx(), lane = tid & 63, w = __builtin_amdgcn_readfirstlane(tid >> 6), lr = lane & 31, lh = lane >> 5;
  const int tokc0 = b * SEQ + blk * 128 - 128;
  __syncthreads();
#pragma unroll
  for (int it = 0; it < 8; ++it) {
    const int item = tid + 256 * it, row = item >> 3, chk = item & 7;
    uint4 v = make_uint4(0u, 0u, 0u, 0u);
    if (blk > 0 || row >= 128) v = *(const uint4*)(p.K() + (size_t)(tokc0 + row) * 256 + kvh * 64 + chk * 8);
    *(uint4*)(sK + row * 72 + chk * 8) = v;
  }
#pragma unroll
  for (int it = 0; it < 8; ++it) {
    const int item = tid + 256 * it, d = item >> 5, chk = item & 31;
    uint4 v = make_uint4(0u, 0u, 0u, 0u);
    if (blk > 0 || chk >= 16) v = *(const uint4*)(p.VT() + (size_t)(kvh * 64 + d) * T + tokc0 + chk * 8);
    *(uint4*)(sVt + d * 264 + chk * 8) = v;
  }
  __syncthreads();
  const int qtok = b * SEQ + blk * 128 + 32 * w + lr;
#pragma unroll 1
  for (int hq = 0; hq < 4; ++hq) {
  const int head = kvh * 4 + hq;
  const int lrq = launder(lr), lhq = launder(lh);
  bf16x8 qf[4];
#pragma unroll
  for (int kk = 0; kk < 4; ++kk) qf[kk] = *(const bf16x8*)(p.Q() + (size_t)qtok * 1024 + head * 64 + kk * 16 + lhq * 8);
  f32x16 st[5];
#pragma unroll
  for (int x = 0; x < 5; ++x) {
    zero16(st[x]);
#pragma unroll
    for (int kk = 0; kk < 4; ++kk) {
      const bf16x8 af = *(const bf16x8*)(sK + (32 * (w + x) + lrq) * 72 + kk * 16 + lhq * 8);
      st[x] = MFMA32(af, qf[kk], st[x]);
    }
  }
  const float sink = p.sinks[l * 16 + head];
  const int qi = 128 + 32 * w + lrq;
  float m = sink;
#pragma unroll
  for (int x = 0; x < 5; ++x)
#pragma unroll
    for (int i = 0; i < 16; ++i) {
      const int kj = 32 * (w + x) + crow(i, lhq);
      const bool valid = (kj <= qi) && (kj >= qi - 128) && (blk > 0 || kj >= 128);
      const float s = valid ? st[x][i] * 0.125f : -1e30f;
      st[x][i] = s;
      m = fmaxf(m, s);
    }
  m = fmaxf(m, __shfl_xor(m, 32));
  float sum = 0.f;
#pragma unroll
  for (int x = 0; x < 5; ++x)
#pragma unroll
    for (int i = 0; i < 16; ++i) { const float pv = __expf(st[x][i] - m); st[x][i] = pv; sum += pv; }
  sum += __shfl_xor(sum, 32);
  const float inv = 1.f / (sum + __expf(sink - m));
  f32x16 ot[2];
  zero16(ot[0]); zero16(ot[1]);
#pragma unroll
  for (int x = 0; x < 5; ++x)
#pragma unroll
    for (int s = 0; s < 2; ++s) {
      const uint4 pu = make_uint4(pack2(st[x][8 * s] * inv, st[x][8 * s + 1] * inv), pack2(st[x][8 * s + 2] * inv, st[x][8 * s + 3] * inv),
                                  pack2(st[x][8 * s + 4] * inv, st[x][8 * s + 5] * inv), pack2(st[x][8 * s + 6] * inv, st[x][8 * s + 7] * inv));
      const bf16x8 pf = u4_to_bf8(pu);
#pragma unroll
      for (int pb = 0; pb < 2; ++pb) {
        const bf16_t* vp = sVt + (pb * 32 + lrq) * 264 + 32 * (w + x) + 16 * s + 4 * lhq;
        const uint2 lo = *(const uint2*)vp, hi2 = *(const uint2*)(vp + 8);
        ot[pb] = MFMA32(u4_to_bf8(make_uint4(lo.x, lo.y, hi2.x, hi2.y)), pf, ot[pb]);
      }
    }
#pragma unroll
  for (int pb = 0; pb < 2; ++pb)
#pragma unroll
    for (int ig = 0; ig < 4; ++ig) {
      const int d0 = pb * 32 + 8 * ig + 4 * lhq;
      *(uint2*)(p.O() + (size_t)qtok * 1024 + head * 64 + d0) = make_uint2(pack2(ot[pb][4 * ig], ot[pb][4 * ig + 1]), pack2(ot[pb][4 * ig + 2], ot[pb][4 * ig + 3]));
    }
  }
}

DI void attn_sample_job(const P& p, int l, int job, char* smem) {
  const int kvh = job & 3, b = job >> 2;
  const int tid = tidx(), lane = tid & 63, w = __builtin_amdgcn_readfirstlane(tid >> 6);
  const int head = kvh * 4 + w, row = TP + b;
  float* sQ = (float*)smem;
  float* sP = sQ + 256;
  const size_t cbase = ((size_t)(l * 128 + b) * 128) * 256 + kvh * 64;
  const float4* kc4 = (const float4*)(p.cache_k + cbase);
  const float4* vc4 = (const float4*)(p.cache_v + cbase);
  float4* ko4 = (float4*)(p.out + OFF_KS + cbase);
  float4* vo4 = (float4*)(p.out + OFF_VS + cbase);
  __syncthreads();
  for (int idx = tid; idx < 127 * 16; idx += 256) {
    const int j = idx >> 4, q4 = idx & 15;
    ko4[j * 64 + q4] = kc4[(j + 1) * 64 + q4];
    vo4[j * 64 + q4] = vc4[(j + 1) * 64 + q4];
  }
  const float qd = bf2f(p.Q()[(size_t)row * 1024 + head * 64 + lane]);
  sQ[w * 64 + lane] = qd;
  __syncthreads();
  float s0 = 0.f, s1 = 0.f;
#pragma unroll 4
  for (int d4 = 0; d4 < 16; ++d4) {
    const float4 q4 = ((const float4*)(sQ + w * 64))[d4];
    const float4 k0 = kc4[lane * 64 + d4], k1 = kc4[(lane + 64) * 64 + d4];
    s0 += q4.x * k0.x + q4.y * k0.y + q4.z * k0.z + q4.w * k0.w;
    s1 += q4.x * k1.x + q4.y * k1.y + q4.z * k1.z + q4.w * k1.w;
  }
  s0 *= 0.125f; s1 *= 0.125f;
  const float s2 = wave_sum(qd * bf2f(p.K()[(size_t)row * 256 + kvh * 64 + lane])) * 0.125f;
  const float sink = p.sinks[l * 16 + head];
  float m = fmaxf(fmaxf(s0, s1), fmaxf(s2, sink));
  m = wave_max(m);
  const float p0 = __expf(s0 - m), p1 = __expf(s1 - m), p2 = __expf(s2 - m);
  const float sum = wave_sum(p0 + p1);
  const float inv = 1.f / (sum + p2 + __expf(sink - m));
  sP[w * 132 + lane] = p0 * inv; sP[w * 132 + 64 + lane] = p1 * inv;
  __syncthreads();
  const float* vc = p.cache_v + cbase + lane;
  float o = 0.f;
#pragma unroll 8
  for (int j = 0; j < 128; ++j) o += sP[w * 132 + j] * vc[(size_t)j * 256];
  o += p2 * inv * bf2f(p.VT()[(size_t)(kvh * 64 + lane) * T + row]);
  p.O()[(size_t)row * 1024 + head * 64 + lane] = f2bf(o);
}

template <int PASS>
DI void merge_pass(const P& p, const bf16_t* A, const bf16_t* Wt, int m0, int n0, char* smem) {
  m0 = launder_s(m0); n0 = launder_s(n0);
  const int tid = tidx(), lane = tid & 63, w = __builtin_amdgcn_readfirstlane(tid >> 6), wm = w & 1, wn = w >> 1, lr = lane & 31, lh = lane >> 5;
  f32x16 acc[2][GNB];
#pragma unroll
  for (int a = 0; a < 2; ++a)
#pragma unroll
    for (int b = 0; b < GNB; ++b) zero16(acc[a][b]);
  gemm_mainloop(A + (size_t)m0 * 1024, 1024, Wt, n0, 1024, acc, smem);
  m0 = launder_s(m0); n0 = launder_s(n0);
  bf16_t* sT = (bf16_t*)smem;
  stage_tile(sT, acc, wm, wn, lr, lh);
  __syncthreads();
  const int goff = (PASS == 0) ? 1024 : (PASS == 2) ? 0 : 2048;
#pragma unroll 2
  for (int it = 0; it < 16; ++it) {
    const int idx = tid + 256 * it, row = idx >> 5, chunk = idx & 31;
    const uint4 av = *(const uint4*)(sT + row * LDS_T + chunk * 8);
    uint4* mp = (uint4*)(p.MG() + (size_t)(m0 + row) * 1024 + n0 + chunk * 8);
    uint4 gv = make_uint4(0u, 0u, 0u, 0u), mv = gv;
    if (PASS != 1) gv = *(const uint4*)(p.G() + (size_t)(m0 + row) * 3072 + goff + n0 + chunk * 8);
    if (PASS != 0) mv = *mp;
    const unsigned aw[4] = {av.x, av.y, av.z, av.w}, gw[4] = {gv.x, gv.y, gv.z, gv.w}, mw[4] = {mv.x, mv.y, mv.z, mv.w};
    unsigned ow[4];
#pragma unroll
    for (int k = 0; k < 4; ++k) {
      const float a0 = bflo(aw[k]), a1 = bfhi(aw[k]), g0 = bflo(gw[k]), g1 = bfhi(gw[k]), m0_ = bflo(mw[k]), m1_ = bfhi(mw[k]);
      float o0, o1;
      if (PASS == 0) { o0 = sigm_f(a0) * g0; o1 = sigm_f(a1) * g1; }
      else if (PASS == 1) { o0 = m0_ * a0; o1 = m1_ * a1; }
      else { o0 = m0_ + a0 * g0; o1 = m1_ + a1 * g1; }
      ow[k] = pack2(o0, o1);
    }
    *mp = make_uint4(ow[0], ow[1], ow[2], ow[3]);
  }
}
DI void merge_job(const P& p, int l, int job, char* smem) {
  int mt, nt;
  if (!gemm_tile(job, 128, 4, mt, nt)) return;
  const int m0 = mt * 128, n0 = nt * 256;
  const bf16_t* wl = p.Wt() + (size_t)l * W_LAYER;
  merge_pass<0>(p, p.YS(), wl + WO_GLU + (size_t)1024 * 1024, m0, n0, smem);
  merge_pass<1>(p, p.YS(), wl + WO_GLU, m0, n0, smem);
  merge_pass<2>(p, p.YM(), wl + WO_MPROJ, m0, n0, smem);
  merge_pass<3>(p, p.O(), wl + WO_ATTNO, m0, n0, smem);
}
DI void resid_gemm_job(const P& p, const bf16_t* A, int lda, const bf16_t* Wt, int K, int job, char* smem) {
  int mt, nt;
  if (!gemm_tile(job, 128, 4, mt, nt)) return;
  int m0 = mt * 128, n0 = nt * 256;
  const int tid = tidx(), lane = tid & 63, w = __builtin_amdgcn_readfirstlane(tid >> 6), wm = w & 1, wn = w >> 1, lr = lane & 31, lh = lane >> 5;
  f32x16 acc[2][GNB];
#pragma unroll
  for (int a = 0; a < 2; ++a)
#pragma unroll
    for (int b = 0; b < GNB; ++b) zero16(acc[a][b]);
  gemm_mainloop(A + (size_t)m0 * lda, lda, Wt, n0, K, acc, smem);
  m0 = launder_s(m0); n0 = launder_s(n0);
  float* sF = (float*)smem;
#pragma unroll
  for (int h = 0; h < 2; ++h) {
    if (h) __syncthreads();
#pragma unroll
    for (int ni = 0; ni < GNB; ++ni) {
      float* d = sF + (wm * 32 + 4 * lh) * 260 + wn * 128 + ni * 32 + lr;
#pragma unroll
      for (int i = 0; i < 16; ++i) d[((i & 3) + 8 * (i >> 2)) * 260] = acc[h][ni][i];
    }
    __syncthreads();
#pragma unroll 4
    for (int it = 0; it < 16; ++it) {
      const int idx = tid + 256 * it, rl = idx >> 6, c4 = idx & 63;
      const int r = m0 + (rl >> 5) * 64 + h * 32 + (rl & 31);
      float4* xp = (float4*)(p.X() + (size_t)r * 1024 + n0) + c4;
      const float4 a = *(const float4*)(sF + rl * 260 + c4 * 4);
      float4 x = *xp;
      x.x += a.x; x.y += a.y; x.z += a.z; x.w += a.w;
      *xp = x;
    }
  }
}
DI void up_job(const P& p, int l, int job, char* smem) {
  int mt, nt;
  if (!gemm_tile(job, 128, 16, mt, nt)) return;
  int m0 = mt * 128, n0 = nt * 256;
  const int tid = tidx(), lane = tid & 63, w = __builtin_amdgcn_readfirstlane(tid >> 6), wm = w & 1, wn = w >> 1, lr = lane & 31, lh = lane >> 5;
  f32x16 acc[2][GNB];
#pragma unroll
  for (int a = 0; a < 2; ++a)
#pragma unroll
    for (int b = 0; b < GNB; ++b) zero16(acc[a][b]);
  gemm_mainloop(p.H() + (size_t)m0 * 1024, 1024, p.Wt() + (size_t)l * W_LAYER + WO_UP, n0, 1024, acc, smem);
#if PROBE_DUP == 12
  gemm_mainloop(p.H() + (size_t)m0 * 1024, 1024, p.Wt() + (size_t)l * W_LAYER + WO_UP, n0, 1024, acc, smem);
#pragma unroll
  for (int mi = 0; mi < 2; ++mi)
#pragma unroll
    for (int ni = 0; ni < GNB; ++ni)
#pragma unroll
      for (int i = 0; i < 16; ++i) acc[mi][ni][i] *= 0.5f;
#endif
  m0 = launder_s(m0); n0 = launder_s(n0);
#pragma unroll
  for (int mi = 0; mi < 2; ++mi)
#pragma unroll
    for (int ni = 0; ni < GNB; ++ni)
#pragma unroll
      for (int i = 0; i < 16; ++i) { const float v = fmaxf(acc[mi][ni][i], 0.f); acc[mi][ni][i] = v * v; }
  bf16_t* sT = (bf16_t*)smem;
  stage_tile(sT, acc, wm, wn, lr, lh);
  __syncthreads();
  tile_writeout(p.A2() + (size_t)m0 * 4096 + n0, 4096, sT);
}

DI float skinny_dot(const bf16_t* __restrict__ A, int lda, const bf16_t* __restrict__ Wt, int K, int r0, int c0, char* smem) {
  float* sR = (float*)smem;
  const int tid = tidx(), lane = tid & 63, w = __builtin_amdgcn_readfirstlane(tid >> 6), r = lane & 15, quad = lane >> 4;
  const int kq = K >> 2;
  const bf16_t* ap = A + (size_t)(r0 + r) * lda + w * kq + quad * 8;
  const int kb = w * kq + quad * 8;
  f32x4 acc = {0.f, 0.f, 0.f, 0.f};
#pragma unroll 4
  for (int k = 0; k < kq; k += 32) {
    const bf16x8 a = *(const bf16x8*)(ap + k), b = *(const bf16x8*)(Wt + wfrag(c0 + r, kb + k, K));
    acc = MFMA16(a, b, acc);
  }
  __syncthreads();
#pragma unroll
  for (int j = 0; j < 4; ++j) sR[w * 256 + (quad * 4 + j) * 16 + r] = acc[j];
  __syncthreads();
  return sR[tid] + sR[256 + tid] + sR[512 + tid] + sR[768 + tid];
}
DI void skinny_dot4(const bf16_t* A0, const bf16_t* A1, const bf16_t* A2_, const bf16_t* A3, const bf16_t* W0, const bf16_t* W1, const bf16_t* W2,
                    const bf16_t* W3, int c00, int c01, int c02, int c03, int r0, char* smem, float (&out)[4]) {
  float* sR = (float*)smem;
  const int tid = tidx(), lane = tid & 63, w = __builtin_amdgcn_readfirstlane(tid >> 6), r = lane & 15, quad = lane >> 4;
  const size_t ao = (size_t)(r0 + r) * 1024 + w * 256 + quad * 8;
  const int kb = w * 256 + quad * 8;
  const bf16_t* ap0 = A0 + ao; const bf16_t* ap1 = A1 + ao; const bf16_t* ap2 = A2_ + ao; const bf16_t* ap3 = A3 + ao;
  const bf16_t* bp0 = W0 + wfrag(c00 + r, kb, 1024); const bf16_t* bp1 = W1 + wfrag(c01 + r, kb, 1024);
  const bf16_t* bp2 = W2 + wfrag(c02 + r, kb, 1024); const bf16_t* bp3 = W3 + wfrag(c03 + r, kb, 1024);
  f32x4 acc0 = {0.f, 0.f, 0.f, 0.f}, acc1 = acc0, acc2 = acc0, acc3 = acc0;
#pragma unroll 2
  for (int k = 0; k < 256; k += 32) {
    const bf16x8 a0 = *(const bf16x8*)(ap0 + k), b0 = *(const bf16x8*)(bp0 + k * 32);
    const bf16x8 a1 = *(const bf16x8*)(ap1 + k), b1 = *(const bf16x8*)(bp1 + k * 32);
    const bf16x8 a2 = *(const bf16x8*)(ap2 + k), b2 = *(const bf16x8*)(bp2 + k * 32);
    const bf16x8 a3 = *(const bf16x8*)(ap3 + k), b3 = *(const bf16x8*)(bp3 + k * 32);
    acc0 = MFMA16(a0, b0, acc0); acc1 = MFMA16(a1, b1, acc1); acc2 = MFMA16(a2, b2, acc2); acc3 = MFMA16(a3, b3, acc3);
  }
  __syncthreads();
#pragma unroll
  for (int j = 0; j < 4; ++j) {
    const int o = w * 256 + (quad * 4 + j) * 16 + r;
    sR[o] = acc0[j]; sR[1024 + o] = acc1[j]; sR[2048 + o] = acc2[j]; sR[3072 + o] = acc3[j];
  }
  __syncthreads();
#pragma unroll
  for (int q = 0; q < 4; ++q) out[q] = sR[q * 1024 + tid] + sR[q * 1024 + 256 + tid] + sR[q * 1024 + 512 + tid] + sR[q * 1024 + 768 + tid];
}
DI void skinny_merge_job(const P& p, int l, int job, char* smem) {
  const int rt = job & 7, ct = job >> 3;
  const int r0 = TP + rt * 16, c0 = ct * 16;
  const bf16_t* wl = p.Wt() + (size_t)l * W_LAYER;
  float d[4];
  skinny_dot4(p.YS(), p.YS(), p.YM(), p.O(), wl + WO_GLU + (size_t)1024 * 1024, wl + WO_GLU, wl + WO_MPROJ, wl + WO_ATTNO, c0, c0, c0, c0, r0, smem, d);
  const int tid = tidx(), r = r0 + (tid >> 4), c = c0 + (tid & 15);
  const bf16_t* gp = p.G() + (size_t)r * 3072 + c;
  const float v = bf2f(gp[0]) * d[2] + bf2f(gp[1024]) * d[1] * sigm_f(d[0]) + bf2f(gp[2048]) * d[3];
  p.MG()[(size_t)r * 1024 + c] = f2bf(v);
}
DI void skinny_resid_job(const P& p, const bf16_t* A, int lda, const bf16_t* Wt, int K, int job, char* smem) {
  const int rt = job & 7, ct = job >> 3;
  const int r0 = TP + rt * 16, c0 = ct * 16;
  const float v = skinny_dot(A, lda, Wt, K, r0, c0, smem);
  const int tid = tidx();
  p.X()[(size_t)(r0 + (tid >> 4)) * 1024 + c0 + (tid & 15)] += v;
}
DI void skinny_up_job(const P& p, int l, int job, char* smem) {
  const int rt = job & 7, cs = job >> 3;
  const int r0 = TP + rt * 16, c0 = cs * 64;
  const bf16_t* wu = p.Wt() + (size_t)l * W_LAYER + WO_UP;
  float d[4];
  skinny_dot4(p.H(), p.H(), p.H(), p.H(), wu, wu, wu, wu, c0, c0 + 16, c0 + 32, c0 + 48, r0, smem, d);
  const int tid = tidx();
  bf16_t* dst = p.A2() + (size_t)(r0 + (tid >> 4)) * 4096 + c0 + (tid & 15);
#pragma unroll
  for (int q = 0; q < 4; ++q) { const float v = fmaxf(d[q], 0.f); dst[q * 16] = f2bf(v * v); }
}

#define XB_TMO      128
#define XB_XCNT(j)  (256  + 64 * (j))
#define XB_XSUB(j)  (1280 + 64 * (j))
#define XB_XGEN(j)  (2304 + 64 * (j))
#define XB_TOP      3328
#define XB_TOPGEN   3392
#define XCD_BAR_WORDS 3456
#define XB_SPIN_CAP (1u << 20)
#define LAS __attribute__((address_space(3)))
DI unsigned xb_ld(unsigned* p) { return __hip_atomic_load(p, __ATOMIC_RELAXED, __HIP_MEMORY_SCOPE_AGENT); }
DI unsigned xb_add(unsigned* p, unsigned v) { return __hip_atomic_fetch_add(p, v, __ATOMIC_RELAXED, __HIP_MEMORY_SCOPE_AGENT); }
DI unsigned xb_xcc_id() { return (unsigned)__builtin_amdgcn_s_getreg((3 << 11) | 20) & 0xFu; }
#define XB_SPIN(cond, bar) do { unsigned _sp = 0; while (cond) { __builtin_amdgcn_s_sleep(1); \
    if ((++_sp & 255u) == 0u) { if (xb_ld(&(bar)[XB_TMO])) break; if (_sp > XB_SPIN_CAP) { atomicAdd(&(bar)[XB_TMO], 1u); break; } } } } while (0)
struct XcdBarrier { unsigned* bar; unsigned x; volatile LAS unsigned* st; };
DI XcdBarrier xcd_barrier_post(unsigned* bar, volatile LAS unsigned* st) {
  XcdBarrier b; b.bar = bar; b.x = xb_xcc_id(); b.st = st;
  if (threadIdx.x == 0) (void)xb_add(&bar[XB_XCNT(b.x)], 1u);
  return b;
}
DI void xcd_barrier_complete(unsigned* bar, unsigned x, unsigned& nloc, unsigned& nx) {
  const unsigned G = gridDim.x * gridDim.y * gridDim.z;
  unsigned sum, cnt, mine, sp = 0u;
  for (;;) {
    sum = 0u; cnt = 0u; mine = 0u;
#pragma unroll
    for (unsigned j = 0; j < 16; ++j) { const unsigned c = xb_ld(&bar[XB_XCNT(j)]); sum += c; cnt += (c > 0u) ? 1u : 0u; mine = (j == x) ? c : mine; }
    if (sum == G) break;
    __builtin_amdgcn_s_sleep(1);
    if ((++sp & 255u) == 0u) { if (xb_ld(&bar[XB_TMO])) break; if (sp > XB_SPIN_CAP) { atomicAdd(&bar[XB_TMO], 1u); break; } }
  }
  nloc = mine > 0u ? mine : 1u; nx = cnt > 0u ? cnt : 1u;
}
DI void xcd_barrier(const XcdBarrier& b) {
  asm volatile("s_waitcnt vmcnt(0)" ::: "memory");
  __syncthreads();
  if (threadIdx.x == 0) {
    unsigned* bar = b.bar;
    __builtin_amdgcn_s_waitcnt(0);
    unsigned nloc = b.st[0], nx = b.st[1];
    if (nloc == 0u) { xcd_barrier_complete(bar, b.x, nloc, nx); b.st[0] = nloc; b.st[1] = nx; }
    const unsigned old = xb_add(&bar[XB_XSUB(b.x)], 1u);
    const unsigned gen = old / nloc;
    if (old + 1u == (gen + 1u) * nloc) {
      __builtin_amdgcn_fence(__ATOMIC_RELEASE, "agent");
      asm volatile("s_waitcnt vmcnt(0)" ::: "memory");
      const unsigned og = xb_add(&bar[XB_TOP], 1u);
      const unsigned tg = og / nx;
      if (og + 1u == (tg + 1u) * nx) xb_add(&bar[XB_TOPGEN], 1u);
      else XB_SPIN(xb_ld(&bar[XB_TOPGEN]) == tg, bar);
      __builtin_amdgcn_fence(__ATOMIC_ACQUIRE, "agent");
      xb_add(&bar[XB_XGEN(b.x)], 1u);
      asm volatile("s_waitcnt vmcnt(0)" ::: "memory");
    } else {
      XB_SPIN(xb_ld(&bar[XB_XGEN(b.x)]) == gen, bar);
      __builtin_amdgcn_fence(__ATOMIC_ACQUIRE, "agent");
      asm volatile("s_waitcnt vmcnt(0)" ::: "memory");
    }
  }
  __syncthreads();
}

constexpr int NPHASE = 1 + 4 * 11;
DI void phase_jobs(int ph, int& nstd, int& nother) {
  nstd = 0;
  if (ph == 0) { nother = 22272 + 64 + 257 + 4128; return; }
  const int s = (ph - 1) % 11;
  switch (s) {
    case 0: nstd = 129 * 35; nother = 0; break;
    case 1: nother = 512 + 512 + 512 + 4096 + 2048 + 2048; break;
    case 2: nother = 2048; break;
    case 3: nother = 256 + 32; break;
    case 4: nother = 512 + 2048; break;
    case 5: nstd = 512; nother = 512; break;
    case 6: nstd = 512; nother = 512; break;
    case 7: nother = 4128; break;
    case 8: nstd = 2048; nother = 512; break;
    case 9: nstd = 512; nother = 512; break;
    default: nother = 4128; break;
  }
}
DI void run_std_job(const P& p, int ph, int job, char* smem) {
  const int l = (ph - 1) / 11, s = (ph - 1) % 11;
  const bf16_t* wl = p.Wt() + (size_t)l * W_LAYER;
  switch (s) {
    case 0: inproj_job(p, l, job, smem); break;
    case 5: merge_job(p, l, job, smem); break;
    case 6: resid_gemm_job(p, p.MG(), 1024, wl + WO_WOUT, 1024, job, smem); break;
    case 8: up_job(p, l, job, smem); break;
    default: resid_gemm_job(p, p.A2(), 4096, wl + WO_DOWN, 4096, job, smem); break;
  }
}
DI void run_job(const P& p, int ph, int job, char* smem) {
  if (ph == 0) {
    if (job < 22272) { prep_weight_job(p, job, smem); return; }
    job -= 22272;
    if (job < 64) { prep_s5_job(p, job); return; }
    job -= 64;
    if (job < 257) { prep_rope_job(p, job); return; }
    job -= 257;
    norm_job(p, job, p.norm1_w, true, false);
    return;
  }
  const int l = (ph - 1) / 11, s = (ph - 1) % 11;
  const bf16_t* wl = p.Wt() + (size_t)l * W_LAYER;
  const int w = __builtin_amdgcn_readfirstlane(tidx() >> 6);
  switch (s) {
    case 1:
      if (job < 512) { for (int rr = 0; rr < (PROBE_DUP == 11 ? 3 : 1); ++rr) ssd_sample_job(p, l, job, smem); break; }
      job -= 512;
      if (job < 512) { attn_sample_job(p, l, job, smem); break; }
      job -= 512;
      if (job < 512) { attn_prompt_job(p, l, job, smem); break; }
      job -= 512;
      if (job < 4096) { for (int rr = 0; rr < (PROBE_DUP == 9 ? 3 : 1); ++rr) conv_job(p, l, job, smem); break; }
      job -= 4096;
      if (job < 2048) { const int wj = job * 4 + w; s5_wave_job(p, l, 0, wj >> 12, wj & 63, ((wj >> 6) & 63) * 2, 2, nullptr); break; }
      job -= 2048;
      { const int wj = job * 4 + w; __syncthreads(); s5_wave_job(p, l, 2, wj >> 6, wj & 63, 0, 1, (bf16_t*)smem + w * 64 * 136); }
      break;
    case 2: ssd_a_job(p, l, job, smem); break;
    case 3:
      if (job < 256) ssd_scan_job(p, l, job);
      else s5_scan_job(p, l, job - 256);
      break;
    case 4:
      if (job < 512) { for (int rr = 0; rr < (PROBE_DUP == 16 ? 3 : 1); ++rr) ssd_c_job(p, l, job, smem); break; }
      job -= 512;
      { const int wj = job * 4 + w; __syncthreads(); s5_wave_job(p, l, 1, wj >> 12, wj & 63, ((wj >> 6) & 63) * 2, 2, (bf16_t*)smem + w * 64 * 136); }
      break;
    case 5: skinny_merge_job(p, l, job, smem); break;
    case 6: skinny_resid_job(p, p.MG(), 1024, wl + WO_WOUT, 1024, job, smem); break;
    case 7: norm_job(p, job, p.norm2_w + l * 1024, false, false); break;
    case 8: skinny_up_job(p, l, job, smem); break;
    case 9: skinny_resid_job(p, p.A2(), 4096, wl + WO_DOWN, 4096, job, smem); break;
    default:
      if (l == 3) norm_job(p, job, p.final_w, false, true);
      else norm_job(p, job, p.norm1_w + (l + 1) * 1024, false, false);
      break;
  }
}

template <bool COOP>
__global__ void __launch_bounds__(256, 2) mega(P p, int ph0, int ph1) {
  __shared__ __attribute__((aligned(16))) char smem[SMEM_BYTES];
  __shared__ uint4 xb_words;
  XcdBarrier xb;
  if (COOP) {
    if (threadIdx.x == 0) xb_words = make_uint4(0u, 0u, 0u, 0u);
    __syncthreads();
    xb = xcd_barrier_post((unsigned*)(p.ws + WS_BAR), (volatile LAS unsigned*)&xb_words);
  }
  const int G = (int)gridDim.x;
  for (int ph = ph0; ph < ph1; ++ph) {
    int nstd, nother;
    phase_jobs(ph, nstd, nother);
    int reps = 1;
#if PROBE_DUP
    { const int s_ = (ph == 0) ? -1 : (ph - 1) % 11;
      if (PROBE_DUP == 1 && (s_ == 0 || s_ == 5 || s_ == 8)) reps = 2;
      if (PROBE_DUP == 2 && (s_ == 1 || s_ == 2 || s_ == 4)) reps = 2;
      if (PROBE_DUP == 6 && s_ == 4) reps = 2;
      if (PROBE_DUP == 13 && s_ == 8) reps = 2;
      if (PROBE_DUP == 14 && s_ == 2) reps = 3;
      if (PROBE_DUP == 15 && (s_ == 6 || s_ == 9)) reps = 1;
      if (PROBE_DUP == 7 && s_ == 1) reps = 2; }
#endif
    const int nstd_r = ((nstd + G - 1) / G) * G;
    for (int rep = 0; rep < reps; ++rep) {
      for (int job = blockIdx.x; job < nstd_r; job += G) run_std_job(p, ph, job, smem);
      for (int job = blockIdx.x; job < nother; job += G) run_job(p, ph, job, smem);
    }
    if (COOP && ph + 1 < ph1) {
      if (ph == ph0) cg::this_grid().sync();
      else xcd_barrier(xb);
    }
  }
}


extern "C" void kernel_launch(void* const* d_in, const int* in_sizes, int n_in, void* d_out, int out_size, void* d_ws, size_t ws_size,
                              hipStream_t stream) {
  P p{};
  const float** pin = (const float**)&p;
  for (int i = 0; i < 33; ++i) pin[i] = (const float*)d_in[i];
  p.out = (float*)d_out;
  p.ws = (char*)d_ws;
  if (WS_TOTAL > ws_size) { fprintf(stderr, "workspace too small: need %zu have %zu\n", (size_t)WS_TOTAL, ws_size); return; }

#if COOP_MODE
  static int grid_blocks = 0;
  if (!grid_blocks) {
    int dev = 0, cus = 0, per_cu = 0;
    hipGetDevice(&dev);
    hipDeviceGetAttribute(&cus, hipDeviceAttributeMultiprocessorCount, dev);
    hipOccupancyMaxActiveBlocksPerMultiprocessor(&per_cu, mega<true>, 256, 0);
    if (per_cu > 2) per_cu = 2;
    if (per_cu < 1) per_cu = 1;
    grid_blocks = cus * per_cu;
  }
  (void)hipMemsetAsync(p.ws + WS_BAR, 0, 4096 * 4, stream);
  int ph0 = 0, ph1 = NPHASE;
  void* args[] = {&p, &ph0, &ph1};
  hipError_t e = hipLaunchCooperativeKernel((void*)mega<true>, dim3(grid_blocks), dim3(256), args, 0, stream);
  if (e != hipSuccess) fprintf(stderr, "cooperative launch failed: %s (grid %d)\n", hipGetErrorString(e), grid_blocks);
#else
  for (int ph = 0; ph < NPHASE; ++ph) mega<false><<<dim3(1024), dim3(256), 0, stream>>>(p, ph, ph + 1);
#endif
}
```

```cpp
#include <hip/hip_runtime.h>
#include <hip/hip_cooperative_groups.h>
#include <cstdio>
#include <cstdint>
namespace cg = cooperative_groups;

#define DI __device__ __forceinline__
typedef unsigned short bf16_t;
typedef short bf16x8 __attribute__((ext_vector_type(8)));
typedef float f32x16 __attribute__((ext_vector_type(16)));
typedef float f32x4 __attribute__((ext_vector_type(4)));
#define MFMA32(a, b, c) __builtin_amdgcn_mfma_f32_32x32x16_bf16((a), (b), (c), 0, 0, 0)
#define MFMA16(a, b, c) __builtin_amdgcn_mfma_f32_16x16x32_bf16((a), (b), (c), 0, 0, 0)

#ifndef COOP_MODE
#define COOP_MODE 1
#endif
#ifndef PROBE_DUP
#define PROBE_DUP 0
#endif

constexpr int TP = 16384, TS = 128, T = TP + TS, SEQ = 8192;
constexpr int NIN = 8720, NINP = 8960;
constexpr int SMEM_BYTES = 73728;
constexpr float EPS = 1e-6f;

constexpr size_t OFF_YP = 0;
constexpr size_t OFF_YS = OFF_YP + (size_t)TP * 1024;
constexpr size_t OFF_SSMP = OFF_YS + (size_t)TS * 1024;
constexpr size_t OFF_SSMS = OFF_SSMP + (size_t)4 * 2 * 16 * 64 * 128;
constexpr size_t OFF_CONVP = OFF_SSMS + (size_t)4 * 128 * 16 * 64 * 128;
constexpr size_t OFF_CONVS = OFF_CONVP + (size_t)4 * 2 * 3 * 2048;
constexpr size_t OFF_S5RP = OFF_CONVS + (size_t)4 * 128 * 3 * 2048;
constexpr size_t OFF_S5RS = OFF_S5RP + (size_t)4 * 2 * 64 * 64;
constexpr size_t OFF_S5IP = OFF_S5RS + (size_t)4 * 128 * 64 * 64;
constexpr size_t OFF_S5IS = OFF_S5IP + (size_t)4 * 2 * 64 * 64;
constexpr size_t OFF_KP = OFF_S5IS + (size_t)4 * 128 * 64 * 64;
constexpr size_t OFF_KS = OFF_KP + (size_t)4 * 2 * 128 * 256;
constexpr size_t OFF_VP = OFF_KS + (size_t)4 * 128 * 128 * 256;
constexpr size_t OFF_VS = OFF_VP + (size_t)4 * 2 * 128 * 256;

constexpr size_t WO_IN = 0;
constexpr size_t WO_MPROJ = WO_IN + (size_t)NINP * 1024;
constexpr size_t WO_GLU = WO_MPROJ + (size_t)1024 * 1024;
constexpr size_t WO_ATTNO = WO_GLU + (size_t)2048 * 1024;
constexpr size_t WO_WOUT = WO_ATTNO + (size_t)1024 * 1024;
constexpr size_t WO_UP = WO_WOUT + (size_t)1024 * 1024;
constexpr size_t WO_DOWN = WO_UP + (size_t)4096 * 1024;
constexpr size_t W_LAYER = WO_DOWN + (size_t)4096 * 1024;

constexpr size_t al256(size_t x) { return (x + 255) & ~(size_t)255; }
constexpr size_t SZ1 = (size_t)T * 1024 * 2;
constexpr size_t WS_X = 0;
constexpr size_t WS_H = WS_X + al256((size_t)T * 1024 * 4);
constexpr size_t WS_Z = WS_H + al256(SZ1);
constexpr size_t WS_U = WS_Z + al256(SZ1);
constexpr size_t WS_Q = WS_U + al256(SZ1);
constexpr size_t WS_YM = WS_Q + al256(SZ1);
constexpr size_t WS_YS = WS_YM + al256(SZ1);
constexpr size_t WS_O = WS_YS + al256(SZ1);
constexpr size_t WS_MG = WS_O + al256(SZ1);
constexpr size_t WS_XBC = WS_MG + al256(SZ1);
constexpr size_t WS_XBT = WS_XBC + al256((size_t)T * 2048 * 2);
constexpr size_t WS_BC = WS_XBT + al256((size_t)1536 * TP * 2);
constexpr size_t WS_A2END = WS_XBC + al256((size_t)T * 4096 * 2);
constexpr size_t WS_BCEND = WS_BC + al256((size_t)TP * 1024 * 2);
constexpr size_t WS_K = WS_A2END > WS_BCEND ? WS_A2END : WS_BCEND;
constexpr size_t WS_VT = WS_K + al256((size_t)T * 256 * 2);
constexpr size_t WS_G = WS_VT + al256((size_t)T * 256 * 2);
constexpr size_t WS_DT = WS_G + al256((size_t)T * 3072 * 2);
constexpr size_t WS_ST = WS_DT + al256((size_t)T * 16 * 4);
constexpr size_t WS_CDEC = WS_ST + al256((size_t)2 * 64 * 16 * 64 * 128 * 4);
constexpr size_t WS_S5S = WS_CDEC + al256((size_t)2 * 64 * 16 * 4);
constexpr size_t WS_S5P = WS_S5S + al256((size_t)2 * 128 * 64 * 64 * 2 * 4);
constexpr size_t WS_ROPE = WS_S5P + al256((size_t)4 * 64 * 36 * 64 * 4);
constexpr size_t WS_WT = WS_ROPE + al256((size_t)8193 * 8 * 8);
constexpr size_t WS_BAR = WS_WT + al256((size_t)4 * W_LAYER * 2);
constexpr size_t WS_HP = WS_BAR + al256(4096 * 4);
constexpr size_t WS_BBT = WS_HP + al256((size_t)2 * 64 * 16 * 64 * 128 * 2);
constexpr size_t WS_TOTAL = WS_BBT + al256((size_t)4 * 64 * 128 * 16 * 2);

struct P {
  const float *x_prompt, *x_sample, *state_ssm, *state_conv, *s5_sre, *s5_sim, *cache_k, *cache_v;
  const float *norm1_w, *w_in, *conv_w, *conv_b, *dt_bias, *a_log, *m_d, *m_norm_w, *m_proj;
  const float *lam_re, *lam_im, *log_step, *b_re, *b_im, *c_re, *c_im, *s5_d, *glu_w;
  const float *sinks, *attn_o, *w_out, *norm2_w, *mlp_up, *mlp_down, *final_w;
  float* out;
  char* ws;
#define WSACC(name, type, off) __device__ __forceinline__ type* name() const { return (type*)(ws + (off)); }
  WSACC(X, float, WS_X) WSACC(H, bf16_t, WS_H) WSACC(Z, bf16_t, WS_Z) WSACC(U, bf16_t, WS_U) WSACC(Q, bf16_t, WS_Q)
  WSACC(YM, bf16_t, WS_YM) WSACC(YS, bf16_t, WS_YS) WSACC(O, bf16_t, WS_O) WSACC(MG, bf16_t, WS_MG)
  WSACC(XBC, bf16_t, WS_XBC) WSACC(XBT, bf16_t, WS_XBT) WSACC(BC, bf16_t, WS_BC) WSACC(A2, bf16_t, WS_XBC)
  WSACC(K, bf16_t, WS_K) WSACC(VT, bf16_t, WS_VT) WSACC(G, bf16_t, WS_G) WSACC(DT, float, WS_DT) WSACC(ST, float, WS_ST)
  WSACC(CDEC, float, WS_CDEC) WSACC(HP, bf16_t, WS_HP) WSACC(BBT, bf16_t, WS_BBT) WSACC(S5S, float, WS_S5S) WSACC(S5P, float, WS_S5P) WSACC(ROPE, float2, WS_ROPE) WSACC(Wt, bf16_t, WS_WT)
#undef WSACC
};

typedef float f32x2_t __attribute__((ext_vector_type(2)));
typedef __bf16 bf16x2_t __attribute__((ext_vector_type(2)));
DI unsigned pack2(float a, float b) { const f32x2_t v = {a, b}; return __builtin_bit_cast(unsigned, __builtin_convertvector(v, bf16x2_t)); }
DI bf16_t f2bf(float x) { return (bf16_t)(pack2(x, 0.f) & 0xffffu); }
DI float bf2f(bf16_t b) { return __uint_as_float(((unsigned)b) << 16); }
DI float bflo(unsigned u) { return __uint_as_float(u << 16); }
DI float bfhi(unsigned u) { return __uint_as_float(u & 0xffff0000u); }
DI float frcp(float x) { return __builtin_amdgcn_rcpf(x); }
DI float silu_f(float x) { return x * frcp(1.f + __expf(-x)); }
DI float sigm_f(float x) { return frcp(1.f + __expf(-x)); }
DI float softplus_f(float x) { return x > 20.f ? x : log1pf(expf(x)); }
DI float gelu_tanh(float x) { float y = 0.7978845608028654f * (x + 0.044715f * x * x * x); float t = 1.f - 2.f * frcp(__expf(2.f * y) + 1.f); return 0.5f * x * (1.f + t); }
DI int crow(int i, int lh) { return (i & 3) + 8 * (i >> 2) + 4 * lh; }
DI int launder(int x) { asm volatile("" : "+v"(x)); return x; }
DI int tidx() { int t = __builtin_amdgcn_workitem_id_x(); asm volatile("" : "+v"(t)); return t; }
DI int launder_s(int x) { asm volatile("" : "+s"(x)); return x; }
DI float wave_sum(float v) {
#pragma unroll
  for (int o = 32; o >= 1; o >>= 1) v += __shfl_xor(v, o);
  return v;
}
DI float wave_max(float v) {
#pragma unroll
  for (int o = 32; o >= 1; o >>= 1) v = fmaxf(v, __shfl_xor(v, o));
  return v;
}
DI bf16x8 u4_to_bf8(uint4 v) { return __builtin_bit_cast(bf16x8, v); }
DI void zero16(f32x16& a) {
#pragma unroll
  for (int i = 0; i < 16; ++i) a[i] = 0.f;
}

constexpr int LDT = 40;
constexpr int GNB = 4;
DI size_t wfrag(int n, int k8, int K) { return ((size_t)(n >> 5) * (K >> 4) + (k8 >> 4)) * 512 + (((k8 >> 3) & 1) * 32 + (n & 31)) * 8; }
DI void gemm_mainloop(const bf16_t* __restrict__ A, int lda, const bf16_t* __restrict__ Bf, int n0, int K,
                      f32x16 (&acc)[2][GNB], char* smem) {
  bf16_t* sa = (bf16_t*)smem;
  const int tid = tidx(), lane = tid & 63, w = __builtin_amdgcn_readfirstlane(tid >> 6), wm = w & 1, wn = w >> 1, lr = lane & 31, lh = lane >> 5;
  const int r0 = tid >> 2, ch = (tid & 3) * 8;
  const bf16_t* ap = A + (size_t)r0 * lda + ch;
  const int ksteps = K >> 4;
  const bf16_t* bq = Bf + ((size_t)((n0 >> 5) + wn * 4) * ksteps) * 512 + lane * 8;
  const size_t bstride = (size_t)ksteps * 512;
  uint4 pa0, pa1;
  bf16x8 bP0, bP1, bP2, bP3, bP4, bP5, bP6, bP7, bQ0, bQ1, bQ2, bQ3, bQ4, bQ5, bQ6, bQ7;
#define GLOADS(R, k0) R##a0 = *(const uint4*)(ap + (k0)); R##a1 = *(const uint4*)(ap + (size_t)64 * lda + (k0));
#define SSTORES(R, bufi) { bf16_t* da = sa + (bufi)*128 * LDT; *(uint4*)(da + (r0)*LDT + ch) = R##a0; *(uint4*)(da + (r0 + 64) * LDT + ch) = R##a1; }
#define BLOADS(R, kt_)                                                                                     \
  { const bf16_t* bb = bq + (size_t)(kt_) * 1024;                                                          \
    R##0 = *(const bf16x8*)(bb); R##1 = *(const bf16x8*)(bb + 512);                                        \
    R##2 = *(const bf16x8*)(bb + bstride); R##3 = *(const bf16x8*)(bb + bstride + 512);                    \
    R##4 = *(const bf16x8*)(bb + 2 * bstride); R##5 = *(const bf16x8*)(bb + 2 * bstride + 512);            \
    R##6 = *(const bf16x8*)(bb + 3 * bstride); R##7 = *(const bf16x8*)(bb + 3 * bstride + 512); }
#define COMPUTE(bufi, R)                                                                                   \
  { const bf16_t* ca = sa + (bufi)*128 * LDT + (wm * 64 + lr) * LDT + lh * 8;                              \
    bf16x8 a00 = *(const bf16x8*)(ca), a10 = *(const bf16x8*)(ca + 32 * LDT);                              \
    bf16x8 a01, a11;                                                                                       \
    acc[0][0] = MFMA32(a00, R##0, acc[0][0]); acc[1][0] = MFMA32(a10, R##0, acc[1][0]);                    \
    acc[0][1] = MFMA32(a00, R##2, acc[0][1]); acc[1][1] = MFMA32(a10, R##2, acc[1][1]);                    \
    acc[0][2] = MFMA32(a00, R##4, acc[0][2]); acc[1][2] = MFMA32(a10, R##4, acc[1][2]);                    \
    acc[0][3] = MFMA32(a00, R##6, acc[0][3]); acc[1][3] = MFMA32(a10, R##6, acc[1][3]);                    \
    __builtin_amdgcn_sched_barrier(0);                                                                     \
    a01 = *(const bf16x8*)(ca + 16); a11 = *(const bf16x8*)(ca + 32 * LDT + 16);                           \
    acc[0][0] = MFMA32(a01, R##1, acc[0][0]); acc[1][0] = MFMA32(a11, R##1, acc[1][0]);                    \
    acc[0][1] = MFMA32(a01, R##3, acc[0][1]); acc[1][1] = MFMA32(a11, R##3, acc[1][1]);                    \
    acc[0][2] = MFMA32(a01, R##5, acc[0][2]); acc[1][2] = MFMA32(a11, R##5, acc[1][2]);                    \
    acc[0][3] = MFMA32(a01, R##7, acc[0][3]); acc[1][3] = MFMA32(a11, R##7, acc[1][3]); }
  const int nk = K >> 5;
  GLOADS(p, 0)
  BLOADS(bP, 0)
  __syncthreads();
  SSTORES(p, 0)
  GLOADS(p, 32)
  BLOADS(bQ, 1)
  SSTORES(p, 1)
  __syncthreads();
  for (int kt = 0; kt < nk; kt += 4) {
    GLOADS(p, (kt + 2) * 32)
    COMPUTE(0, bP)
    BLOADS(bP, kt + 2)
    SSTORES(p, 2)
    GLOADS(p, (kt + 3) * 32)
    COMPUTE(1, bQ)
    BLOADS(bQ, kt + 3)
    SSTORES(p, 3)
    __syncthreads();
    GLOADS(p, (kt + 4) * 32)
    COMPUTE(2, bP)
    BLOADS(bP, kt + 4)
    SSTORES(p, 0)
    GLOADS(p, (kt + 5) * 32)
    COMPUTE(3, bQ)
    BLOADS(bQ, kt + 5)
    SSTORES(p, 1)
    __syncthreads();
  }
#undef GLOADS
#undef SSTORES
#undef BLOADS
#undef COMPUTE
}
DI bool gemm_tile(int slot, int MT, int NT, int& mt, int& nt) {
  const int G = gridDim.x, nx = G >> 3;
  int J = slot;
  if ((G & 7) == 0) J = (slot / G) * G + (slot & 7) * nx + ((slot % G) >> 3);
  if (J >= MT * NT) return false;
  const int gw = 8 * NT, grp = J / gw, rem = J - grp * gw, fm = grp * 8;
  const int gsz = (MT - fm) < 8 ? (MT - fm) : 8;
  mt = fm + rem % gsz; nt = rem / gsz;
  return true;
}

DI int win_map(int n) {
  if (n < 3072) return n;
  if (n < 8704) return n + 16;
  if (n < 8720) return n - 8704 + 3072;
  return -1;
}
DI void wtrans_tile(const float* __restrict__ src, int N, int K, bf16_t* __restrict__ dst, int kt, int nt, bool inmap, char* smem) {
  float* s = (float*)smem;
  const int tid = tidx();
  __syncthreads();
  {
    const int n4 = (tid & 15) * 4;
    int sc = nt * 64 + n4;
    if (inmap) sc = win_map(sc);
#pragma unroll
    for (int ps = 0; ps < 4; ++ps) {
      const int kk = (tid >> 4) + 16 * ps;
      float4 v = make_float4(0.f, 0.f, 0.f, 0.f);
      if (sc >= 0) v = *(const float4*)(src + (size_t)(kt * 64 + kk) * N + sc);
      float* d = s + kk * 65 + n4;
      d[0] = v.x; d[1] = v.y; d[2] = v.z; d[3] = v.w;
    }
  }
  __syncthreads();
  {
    const int n2 = tid >> 2, kq = (tid & 3) * 16;
    unsigned w[8];
#pragma unroll
    for (int j = 0; j < 8; ++j) w[j] = pack2(s[(kq + 2 * j) * 65 + n2], s[(kq + 2 * j + 1) * 65 + n2]);
    const int n = nt * 64 + n2, k0 = kt * 64 + kq;
    bf16_t* d = dst + ((size_t)(n >> 5) * (K >> 4) + (k0 >> 4)) * 512 + (n & 31) * 8;
    *(uint4*)d = make_uint4(w[0], w[1], w[2], w[3]);
    *(uint4*)(d + 256) = make_uint4(w[4], w[5], w[6], w[7]);
  }
}
DI void prep_weight_job(const P& p, int j, char* smem) {
  const int l = j / 5568; int r = j % 5568;
  bf16_t* wl = p.Wt() + (size_t)l * W_LAYER;
  if (r < 2240) { wtrans_tile(p.w_in + (size_t)l * 1024 * NIN, NIN, 1024, wl + WO_IN, r / 140, r % 140, true, smem); return; }
  r -= 2240;
  if (r < 256) { wtrans_tile(p.m_proj + (size_t)l * 1024 * 1024, 1024, 1024, wl + WO_MPROJ, r / 16, r % 16, false, smem); return; }
  r -= 256;
  if (r < 512) { wtrans_tile(p.glu_w + (size_t)l * 1024 * 2048, 2048, 1024, wl + WO_GLU, r / 32, r % 32, false, smem); return; }
  r -= 512;
  if (r < 256) { wtrans_tile(p.attn_o + (size_t)l * 1024 * 1024, 1024, 1024, wl + WO_ATTNO, r / 16, r % 16, false, smem); return; }
  r -= 256;
  if (r < 256) { wtrans_tile(p.w_out + (size_t)l * 1024 * 1024, 1024, 1024, wl + WO_WOUT, r / 16, r % 16, false, smem); return; }
  r -= 256;
  if (r < 1024) { wtrans_tile(p.mlp_up + (size_t)l * 1024 * 4096, 4096, 1024, wl + WO_UP, r / 64, r % 64, false, smem); return; }
  r -= 1024;
  wtrans_tile(p.mlp_down + (size_t)l * 4096 * 1024, 1024, 4096, wl + WO_DOWN, r / 16, r % 16, false, smem);
}
DI void prep_s5_job(const P& p, int j) {
  const int idx = j * 256 + tidx();
  const int n = idx & 63, g = (idx >> 6) & 63, l = idx >> 12;
  const float step = expf(p.log_step[l * 64 + g]);
  const float lr_ = p.lam_re[(l * 64 + g) * 64 + n], li = p.lam_im[(l * 64 + g) * 64 + n];
  const float mag = expf(lr_ * step);
  const float abr = mag * cosf(li * step), abi = mag * sinf(li * step);
  float aqr = abr, aqi = abi;
#pragma unroll
  for (int q = 0; q < 6; ++q) { const float nr2 = aqr * aqr - aqi * aqi, ni2 = 2.f * aqr * aqi; aqr = nr2; aqi = ni2; }
  const float den = lr_ * lr_ + li * li;
  const float nr = abr - 1.0f, ni = abi;
  const float fre = (nr * lr_ + ni * li) / den, fim = (ni * lr_ - nr * li) / den;
  float* o = p.S5P() + ((size_t)(l * 64 + g) * 36) * 64 + n;
  o[0] = abr; o[64] = abi; o[128] = aqr; o[192] = aqi;
  const float* br = p.b_re + ((size_t)(l * 64 + g) * 64 + n) * 16;
  const float* bi = p.b_im + ((size_t)(l * 64 + g) * 64 + n) * 16;
  float vre[16], vim[16];
#pragma unroll
  for (int i = 0; i < 16; ++i) {
    const float b_r = br[i], b_i = bi[i];
    vre[i] = fre * b_r - fim * b_i;
    vim[i] = fre * b_i + fim * b_r;
    o[(4 + i) * 64] = vre[i];
    o[(20 + i) * 64] = vim[i];
  }
  uint4* bt = (uint4*)(p.BBT() + ((size_t)(l * 64 + g) * 128 + n) * 16);
  bt[0] = make_uint4(pack2(vre[0], vre[1]), pack2(vre[2], vre[3]), pack2(vre[4], vre[5]), pack2(vre[6], vre[7]));
  bt[1] = make_uint4(pack2(vre[8], vre[9]), pack2(vre[10], vre[11]), pack2(vre[12], vre[13]), pack2(vre[14], vre[15]));
  bt[128] = make_uint4(pack2(vim[0], vim[1]), pack2(vim[2], vim[3]), pack2(vim[4], vim[5]), pack2(vim[6], vim[7]));
  bt[129] = make_uint4(pack2(vim[8], vim[9]), pack2(vim[10], vim[11]), pack2(vim[12], vim[13]), pack2(vim[14], vim[15]));
}
DI void prep_rope_job(const P& p, int j) {
  const int idx = j * 256 + tidx();
  if (idx >= 8193 * 8) return;
  const int pos = idx >> 3, f = idx & 7;
  const float invf = expf(-(2.0f * (float)f / 16.0f) * logf(500000.0f));
  const float ang = (float)pos * invf;
  p.ROPE()[idx] = make_float2(cosf(ang), sinf(ang));
}

DI void norm_job(const P& p, int job, const float* wgt, bool layer0, bool final_) {
  const int w = __builtin_amdgcn_readfirstlane(tidx() >> 6), lane = tidx() & 63;
  const int r = job * 4 + w;
  const float* src = layer0 ? (r < TP ? p.x_prompt + (size_t)r * 1024 : p.x_sample + (size_t)(r - TP) * 1024) : p.X() + (size_t)r * 1024;
  float4 v[4];
  float ss = 0.f;
#pragma unroll
  for (int q = 0; q < 4; ++q) { v[q] = ((const float4*)src)[lane + 64 * q]; ss += v[q].x * v[q].x + v[q].y * v[q].y + v[q].z * v[q].z + v[q].w * v[q].w; }
  ss = wave_sum(ss);
  const float sc = rsqrtf(ss * (1.f / 1024.f) + EPS);
#pragma unroll
  for (int q = 0; q < 4; ++q) {
    const float4 wv = ((const float4*)wgt)[lane + 64 * q];
    float4 y = make_float4(v[q].x * sc * wv.x, v[q].y * sc * wv.y, v[q].z * sc * wv.z, v[q].w * sc * wv.w);
    if (final_) ((float4*)(p.out + OFF_YP + (size_t)r * 1024))[lane + 64 * q] = y;
    else *(uint2*)(p.H() + (size_t)r * 1024 + (lane + 64 * q) * 4) = make_uint2(pack2(y.x, y.y), pack2(y.z, y.w));
    if (layer0) ((float4*)(p.X() + (size_t)r * 1024))[lane + 64 * q] = v[q];
  }
}

constexpr int LDS_T = 264;
DI void stage_tile(bf16_t* sT, const f32x16 (&acc)[2][GNB], int wm, int wn, int lr, int lh) {
#pragma unroll
  for (int mi = 0; mi < 2; ++mi)
#pragma unroll
    for (int ni = 0; ni < GNB; ++ni) {
      bf16_t* d = sT + (wm * 64 + mi * 32 + 4 * lh) * LDS_T + wn * 128 + ni * 32 + lr;
#pragma unroll
      for (int ig = 0; ig < 4; ++ig) {
        const unsigned p01 = pack2(acc[mi][ni][4 * ig], acc[mi][ni][4 * ig + 1]), p23 = pack2(acc[mi][ni][4 * ig + 2], acc[mi][ni][4 * ig + 3]);
        d[(8 * ig) * LDS_T] = (bf16_t)(p01 & 0xffffu); d[(8 * ig + 1) * LDS_T] = (bf16_t)(p01 >> 16);
        d[(8 * ig + 2) * LDS_T] = (bf16_t)(p23 & 0xffffu); d[(8 * ig + 3) * LDS_T] = (bf16_t)(p23 >> 16);
      }
    }
}
DI void tile_writeout(bf16_t* __restrict__ dst, int ld, const bf16_t* sT) {
  const int tid = tidx();
#pragma unroll 4
  for (int it = 0; it < 16; ++it) {
    const int idx = tid + 256 * it, row = idx >> 5, chunk = idx & 31;
    *(uint4*)(dst + (size_t)row * ld + chunk * 8) = *(const uint4*)(sT + row * LDS_T + chunk * 8);
  }
}

DI void inproj_job(const P& p, int l, int job, char* smem) {
  int mt, nt;
  if (!gemm_tile(job, 129, 35, mt, nt)) return;
  int m0 = mt * 128, n0 = nt * 256;
  f32x16 acc[2][GNB];
#pragma unroll
  for (int a = 0; a < 2; ++a)
#pragma unroll
    for (int b = 0; b < GNB; ++b) zero16(acc[a][b]);
  gemm_mainloop(p.H() + (size_t)m0 * 1024, 1024, p.Wt() + (size_t)l * W_LAYER + WO_IN, n0, 1024, acc, smem);
  m0 = launder_s(m0); n0 = launder_s(n0);
  nt = launder_s(nt); mt = launder_s(mt);
  const int tid = tidx(), lane = tid & 63, w = __builtin_amdgcn_readfirstlane(tid >> 6), wm = w & 1, wn = w >> 1, lr = lane & 31, lh = lane >> 5;
  bf16_t* sT = (bf16_t*)smem;
  if (nt == 34) {
    if (wn == 0 && lr < 16) {
      const float bias = p.dt_bias[l * 16 + lr];
#pragma unroll
      for (int mi = 0; mi < 2; ++mi)
#pragma unroll
        for (int i = 0; i < 16; ++i) p.DT()[(size_t)(m0 + wm * 64 + mi * 32 + crow(i, lh)) * 16 + lr] = softplus_f(acc[mi][0][i] + bias);
    }
    return;
  }
  if (nt >= 16 && nt <= 20) {
#pragma unroll
    for (int mi = 0; mi < 2; ++mi)
#pragma unroll
      for (int ni = 0; ni < GNB; ni += 2)
#pragma unroll
        for (int i = 0; i < 16; ++i) {
          const float v = acc[mi][ni][i];
          const float pv = __shfl_xor(v, 8);
          if (lr < 16) {
            const int r = m0 + wm * 64 + mi * 32 + crow(i, lh);
            const int pos = (r >= TP) ? 8192 : (r & 8191);
            const float2 cs = p.ROPE()[pos * 8 + (lr & 7)];
            acc[mi][ni][i] = (lr < 8) ? v * cs.x - pv * cs.y : v * cs.x + pv * cs.y;
          }
        }
  }
  if (nt >= 22) {
#pragma unroll
    for (int mi = 0; mi < 2; ++mi)
#pragma unroll
      for (int ni = 0; ni < GNB; ++ni)
#pragma unroll
        for (int i = 0; i < 16; ++i) acc[mi][ni][i] = sigm_f(acc[mi][ni][i]);
  }
  if ((mt == 63 || mt == 127 || mt == 128) && ((nt >= 4 && nt < 12) || nt == 20 || nt == 21)) {
#pragma unroll
    for (int mi = 0; mi < 2; ++mi)
#pragma unroll
      for (int ni = 0; ni < GNB; ++ni) {
        const int cc = (n0 & 255) + wn * 128 + ni * 32 + lr;
        const int rb_ = launder(m0 + wm * 64 + mi * 32 + 4 * lh);
#pragma unroll
        for (int i = 0; i < 16; ++i) {
          const int r = rb_ + (i & 3) + 8 * (i >> 2);
          const float v = acc[mi][ni][i];
          if (nt < 12) {
            const int ch = (n0 - 1024) + cc;
            if (r >= TP) p.out[OFF_CONVS + ((size_t)(l * 128 + (r - TP)) * 3 + 2) * 2048 + ch] = v;
            else { const int t = r & 8191; if (t >= 8189) p.out[OFF_CONVP + ((size_t)(l * 2 + (r >> 13)) * 3 + (t - 8189)) * 2048 + ch] = v; }
          } else {
            const size_t ob = (nt == 20) ? OFF_KS : OFF_VS, obp = (nt == 20) ? OFF_KP : OFF_VP;
            if (r >= TP) p.out[ob + ((size_t)(l * 128 + (r - TP)) * 128 + 127) * 256 + cc] = v;
            else p.out[obp + ((size_t)(l * 2 + (r >> 13)) * 128 + ((r & 8191) - 8064)) * 256 + cc] = v;
          }
        }
        __builtin_amdgcn_sched_barrier(0);
      }
  }
  if (nt == 21) {
#pragma unroll
    for (int mi = 0; mi < 2; ++mi)
#pragma unroll
      for (int ni = 0; ni < GNB; ++ni) {
        bf16_t* d = sT + (wn * 128 + ni * 32 + lr) * 136 + wm * 64 + mi * 32 + 4 * lh;
#pragma unroll
        for (int ig = 0; ig < 4; ++ig)
          *(uint2*)(d + 8 * ig) = make_uint2(pack2(acc[mi][ni][4 * ig], acc[mi][ni][4 * ig + 1]), pack2(acc[mi][ni][4 * ig + 2], acc[mi][ni][4 * ig + 3]));
      }
    __syncthreads();
#pragma unroll 4
    for (int it = 0; it < 16; ++it) {
      const int idx = tid + 256 * it, c = idx >> 4, chunk = idx & 15;
      *(uint4*)(p.VT() + (size_t)c * T + m0 + chunk * 8) = *(const uint4*)(sT + c * 136 + chunk * 8);
    }
    return;
  }
  stage_tile(sT, acc, wm, wn, lr, lh);
  __syncthreads();
  bf16_t* dst; int ld;
  if (nt < 4) { dst = p.Z() + n0; ld = 1024; }
  else if (nt < 12) { dst = p.XBC() + (n0 - 1024); ld = 2048; }
  else if (nt < 16) { dst = p.U() + (n0 - 3072); ld = 1024; }
  else if (nt < 20) { dst = p.Q() + (n0 - 4096); ld = 1024; }
  else if (nt == 20) { dst = p.K(); ld = 256; }
  else { dst = p.G() + (n0 - 5632); ld = 3072; }
  tile_writeout(dst + (size_t)m0 * ld, ld, sT);
}

DI void conv_job(const P& p, int l, int job, char* smem) {
  const int ct = job & 31, tt = job >> 5;
  const int ch0 = ct * 64, tokb = tt * 128;
  bf16_t* sT = (bf16_t*)smem;
  const int tid = tidx();
  const float* cw = p.conv_w + (size_t)l * 4 * 2048;
  __syncthreads();
  const int chk = tid & 7, ch = ch0 + chk * 8;
  float wt[4][8], bs[8];
  {
    const float4 b0 = *(const float4*)(p.conv_b + l * 2048 + ch), b1 = *(const float4*)(p.conv_b + l * 2048 + ch + 4);
    bs[0] = b0.x; bs[1] = b0.y; bs[2] = b0.z; bs[3] = b0.w; bs[4] = b1.x; bs[5] = b1.y; bs[6] = b1.z; bs[7] = b1.w;
#pragma unroll
    for (int j = 0; j < 4; ++j) {
      const float4 w0 = *(const float4*)(cw + j * 2048 + ch), w1 = *(const float4*)(cw + j * 2048 + ch + 4);
      wt[j][0] = w0.x; wt[j][1] = w0.y; wt[j][2] = w0.z; wt[j][3] = w0.w; wt[j][4] = w1.x; wt[j][5] = w1.y; wt[j][6] = w1.z; wt[j][7] = w1.w;
    }
  }
#pragma unroll
  for (int it = 0; it < 4; ++it) {
    const int item = tid + 256 * it, tl = item >> 3, row = tokb + tl, t = row & 8191;
    float a[8];
#pragma unroll
    for (int j = 0; j < 8; ++j) a[j] = bs[j];
#pragma unroll
    for (int j = 0; j < 4; ++j) {
      if (t - 3 + j >= 0) {
        const uint4 rv = *(const uint4*)(p.XBC() + (size_t)(row - 3 + j) * 2048 + ch);
        a[0] += bflo(rv.x) * wt[j][0]; a[1] += bfhi(rv.x) * wt[j][1]; a[2] += bflo(rv.y) * wt[j][2]; a[3] += bfhi(rv.y) * wt[j][3];
        a[4] += bflo(rv.z) * wt[j][4]; a[5] += bfhi(rv.z) * wt[j][5]; a[6] += bflo(rv.w) * wt[j][6]; a[7] += bfhi(rv.w) * wt[j][7];
      }
    }
#pragma unroll
    for (int j = 0; j < 8; ++j) a[j] = silu_f(a[j]);
    if (ct >= 16) *(uint4*)(p.BC() + (size_t)row * 1024 + (ch - 1024)) = make_uint4(pack2(a[0], a[1]), pack2(a[2], a[3]), pack2(a[4], a[5]), pack2(a[6], a[7]));
    if (ct < 24) {
#pragma unroll
      for (int j = 0; j < 8; ++j) sT[(chk * 8 + j) * 136 + (tl ^ (chk << 3))] = f2bf(a[j]);
    }
  }
  if (ct < 24) {
    __syncthreads();
#pragma unroll
    for (int it = 0; it < 4; ++it) {
      const int item = tid + 256 * it, r = item >> 4, chk = item & 15;
      *(uint4*)(p.XBT() + (size_t)(ch0 + r) * TP + tokb + chk * 8) = *(const uint4*)(sT + r * 136 + ((chk ^ (r >> 3)) << 3));
    }
  }
}

DI void chunk_acum(const P& p, int l, int head, int tok0, float* sAc, float* sDt, float& alast) {
  const int lane = tidx() & 63;
  const float Ah = -expf(p.a_log[l * 16 + head]);
  const float d0 = p.DT()[(size_t)(tok0 + 2 * lane) * 16 + head], d1 = p.DT()[(size_t)(tok0 + 2 * lane + 1) * 16 + head];
  const float a0 = d0 * Ah, a1 = d1 * Ah;
  float s = a0 + a1;
#pragma unroll
  for (int off = 1; off < 64; off <<= 1) { const float tv = __shfl_up(s, off); if (lane >= off) s += tv; }
  const float excl = s - (a0 + a1);
  sAc[2 * lane] = excl + a0; sAc[2 * lane + 1] = s;
  sDt[2 * lane] = d0; sDt[2 * lane + 1] = d1;
  alast = __shfl(s, 63);
}

DI void ssd_a_job(const P& p, int l, int job, char* smem) {
  const int head = job & 15, c = (job >> 4) & 63, b = job >> 10, g = head >> 2;
  const int tok0 = b * SEQ + c * 128;
  bf16_t* sXT = (bf16_t*)smem;
  bf16_t* sBT = sXT + 64 * 136;
  float* sW = (float*)(sBT + 128 * 136);
  float* sAc = sW + 128;
  float* sDt = sAc + 128;
  const int tid = tidx(), lane = tid & 63, w = __builtin_amdgcn_readfirstlane(tid >> 6), lr = lane & 31, lh = lane >> 5;
  __syncthreads();
  if (w == 0) {
    float alast;
    chunk_acum(p, l, head, tok0, sAc, sDt, alast);
    sW[2 * lane] = sDt[2 * lane] * __expf(alast - sAc[2 * lane]);
    sW[2 * lane + 1] = sDt[2 * lane + 1] * __expf(alast - sAc[2 * lane + 1]);
    if (lane == 0) p.CDEC()[(b * 64 + c) * 16 + head] = __expf(alast);
  }
  __syncthreads();
#pragma unroll
  for (int it = 0; it < 4; ++it) {
    const int item = tid + 256 * it, pr = item >> 4, s0 = (item & 15) * 8;
    const uint4 v = *(const uint4*)(p.XBT() + (size_t)(head * 64 + pr) * TP + tok0 + s0);
    const float4 w0 = *(const float4*)(sW + s0), w1 = *(const float4*)(sW + s0 + 4);
    *(uint4*)(sXT + pr * 136 + s0) = make_uint4(pack2(bflo(v.x) * w0.x, bfhi(v.x) * w0.y), pack2(bflo(v.y) * w0.z, bfhi(v.y) * w0.w),
                                                pack2(bflo(v.z) * w1.x, bfhi(v.z) * w1.y), pack2(bflo(v.w) * w1.z, bfhi(v.w) * w1.w));
  }
#pragma unroll
  for (int it = 0; it < 8; ++it) {
    const int item = tid + 256 * it, n = item >> 4, s0 = (item & 15) * 8;
    *(uint4*)(sBT + n * 136 + s0) = *(const uint4*)(p.XBT() + (size_t)(1024 + g * 128 + n) * TP + tok0 + s0);
  }
  __syncthreads();
  const int wp = w & 1, wn = w >> 1;
  f32x16 acc[2];
  zero16(acc[0]); zero16(acc[1]);
#pragma unroll
  for (int kk = 0; kk < 8; ++kk) {
    const bf16x8 af = *(const bf16x8*)(sXT + (wp * 32 + lr) * 136 + kk * 16 + lh * 8);
#pragma unroll
    for (int ni = 0; ni < 2; ++ni) {
      const bf16x8 bfr = *(const bf16x8*)(sBT + (wn * 64 + ni * 32 + lr) * 136 + kk * 16 + lh * 8);
      acc[ni] = MFMA32(af, bfr, acc[ni]);
    }
  }
  float* st = p.ST() + ((size_t)((b * 64 + c) * 16 + head) * 64) * 128;
#pragma unroll
  for (int ni = 0; ni < 2; ++ni)
#pragma unroll
    for (int i = 0; i < 16; ++i) st[(wp * 32 + crow(i, lh)) * 128 + wn * 64 + ni * 32 + lr] = acc[ni][i];
}

DI void ssd_scan_job(const P& p, int l, int job) {
  const int gid = job * 256 + tidx();
  const int b = gid >> 15, rem = gid & 32767, head = rem >> 11;
  float4 h = make_float4(0.f, 0.f, 0.f, 0.f);
  const float4* sp0 = (const float4*)(p.ST() + (size_t)(b * 64) * 131072) + rem;
  uint2* hp0 = (uint2*)(p.HP() + (size_t)(b * 64) * 131072) + rem;
  for (int c0 = 0; c0 < 64; c0 += 16) {
    float4 sv[16];
    float dv[16];
#pragma unroll
    for (int k = 0; k < 16; ++k) { sv[k] = sp0[(size_t)(c0 + k) * 32768]; dv[k] = p.CDEC()[(b * 64 + c0 + k) * 16 + head]; }
#pragma unroll
    for (int k = 0; k < 16; ++k) {
      hp0[(size_t)(c0 + k) * 32768] = make_uint2(pack2(h.x, h.y), pack2(h.z, h.w));
      h.x = h.x * dv[k] + sv[k].x; h.y = h.y * dv[k] + sv[k].y; h.z = h.z * dv[k] + sv[k].z; h.w = h.w * dv[k] + sv[k].w;
    }
  }
  ((float4*)(p.out + OFF_SSMP + (size_t)(l * 2 + b) * 131072))[rem] = h;
}

DI void s5_scan_job(const P& p, int l, int job) {
  const int gid = job * 256 + tidx();
  const int n = gid & 63, g = (gid >> 6) & 63, b = gid >> 12;
  const float* prm = p.S5P() + ((size_t)(l * 64 + g) * 36) * 64 + n;
  const float aqr = prm[128], aqi = prm[192];
  float hr = 0.f, hi = 0.f;
  float2* sp = (float2*)p.S5S() + ((size_t)(b * 128) * 64 + g) * 64 + n;
  for (int c0 = 0; c0 < 128; c0 += 8) {
    float2 sv[8];
#pragma unroll
    for (int k = 0; k < 8; ++k) sv[k] = sp[(size_t)(c0 + k) * 4096];
#pragma unroll
    for (int k = 0; k < 8; ++k) {
      sp[(size_t)(c0 + k) * 4096] = make_float2(hr, hi);
      const float nr = aqr * hr - aqi * hi + sv[k].x, ni = aqr * hi + aqi * hr + sv[k].y;
      hr = nr; hi = ni;
    }
  }
}

DI void ssd_c_job(const P& p, int l, int job, char* smem) {
  const int g = job & 3, c = (job >> 2) & 63, b = job >> 8;
  const int tok0 = b * SEQ + c * 128;
  bf16_t* sC = (bf16_t*)smem;
  bf16_t* sB = sC + 128 * 136;
  float* sAc = (float*)(sB + 128 * 136);
  float* sDt = sAc + 512;
  const int tid = tidx(), lane = tid & 63, w = __builtin_amdgcn_readfirstlane(tid >> 6), lr = lane & 31, lh = lane >> 5, wm = w & 1, wn = w >> 1;
  __syncthreads();
  { float alast; chunk_acum(p, l, g * 4 + w, tok0, sAc + w * 128, sDt + w * 128, alast); }
#pragma unroll
  for (int it = 0; it < 8; ++it) {
    const int item = tid + 256 * it, r = item >> 4, s0 = (item & 15) * 8;
    *(uint4*)(sC + r * 136 + s0) = *(const uint4*)(p.BC() + (size_t)(tok0 + r) * 1024 + 512 + g * 128 + s0);
    *(uint4*)(sB + r * 136 + s0) = *(const uint4*)(p.BC() + (size_t)(tok0 + r) * 1024 + g * 128 + s0);
  }
  __syncthreads();
  f32x16 cb[2][2];
#pragma unroll
  for (int a = 0; a < 2; ++a)
#pragma unroll
    for (int bb = 0; bb < 2; ++bb) zero16(cb[a][bb]);
  if (!(wm == 0 && wn == 1)) {
#pragma unroll
    for (int kk = 0; kk < 8; ++kk) {
      bf16x8 af[2], bfr[2];
#pragma unroll
      for (int mi = 0; mi < 2; ++mi) af[mi] = *(const bf16x8*)(sC + (wm * 64 + mi * 32 + lr) * 136 + kk * 16 + lh * 8);
#pragma unroll
      for (int ni = 0; ni < 2; ++ni) bfr[ni] = *(const bf16x8*)(sB + (wn * 64 + ni * 32 + lr) * 136 + kk * 16 + lh * 8);
#pragma unroll
      for (int mi = 0; mi < 2; ++mi)
#pragma unroll
        for (int ni = 0; ni < 2; ++ni) cb[mi][ni] = MFMA32(af[mi], bfr[ni], cb[mi][ni]);
    }
  }
  __syncthreads();
  bf16_t* sM = sB;
  unsigned cbp[2][2][8];
#pragma unroll
  for (int a = 0; a < 2; ++a)
#pragma unroll
    for (int bb = 0; bb < 2; ++bb)
#pragma unroll
      for (int k = 0; k < 8; ++k) cbp[a][bb][k] = pack2(cb[a][bb][2 * k], cb[a][bb][2 * k + 1]);
  float ss[16];
#pragma unroll
  for (int i = 0; i < 16; ++i) ss[i] = 0.f;
#pragma unroll 1
  for (int hd = 0; hd < 4; ++hd) {
    const int head = g * 4 + hd;
    const float* ac = sAc + hd * 128;
    const float* dtv = sDt + hd * 128;
    const int lrq = launder(lr), lhq = launder(lh);
#pragma unroll
    for (int mi = 0; mi < 2; ++mi)
#pragma unroll
      for (int ni = 0; ni < 2; ++ni) {
        const int s = wn * 64 + ni * 32 + lrq;
        const float as = ac[s], ds = dtv[s];
#pragma unroll
        for (int i = 0; i < 16; ++i) {
          const int t = wm * 64 + mi * 32 + crow(i, lhq);
          const float cv = (i & 1) ? bfhi(cbp[mi][ni][i >> 1]) : bflo(cbp[mi][ni][i >> 1]);
          const float v = (s <= t) ? cv * __expf(ac[t] - as) * ds : 0.f;
          sM[t * 136 + s] = f2bf(v);
        }
        __builtin_amdgcn_sched_barrier(0);
      }
    __syncthreads();
    f32x16 yd[2];
    zero16(yd[0]); zero16(yd[1]);
    {
      const bf16_t* hb = p.HP() + (((size_t)((b * 64 + c) * 16 + head) * 64 + lr) * 128 + lh * 8);
      bf16x8 hf[8][2];
#pragma unroll
      for (int kk = 0; kk < 8; ++kk)
#pragma unroll
        for (int pb = 0; pb < 2; ++pb) hf[kk][pb] = *(const bf16x8*)(hb + (size_t)pb * 32 * 128 + kk * 16);
#pragma unroll
      for (int kk = 0; kk < 8; ++kk) {
        const bf16x8 af = *(const bf16x8*)(sC + (32 * w + lr) * 136 + kk * 16 + lh * 8);
        yd[0] = MFMA32(af, hf[kk][0], yd[0]);
        yd[1] = MFMA32(af, hf[kk][1], yd[1]);
      }
    }
#pragma unroll
    for (int i = 0; i < 16; ++i) {
      const float e = __expf(ac[32 * w + crow(i, lh)]);
      yd[0][i] *= e; yd[1][i] *= e;
    }
    {
      const int nkk = 2 * (w + 1);
      const bf16_t* xb = p.XBT() + (size_t)(head * 64 + lr) * TP + tok0 + lh * 8;
      const bf16_t* am = sM + (32 * w + lr) * 136 + lh * 8;
      bf16x8 x00 = *(const bf16x8*)(xb), x01 = *(const bf16x8*)(xb + (size_t)32 * TP);
      for (int kk = 0; kk < nkk; kk += 2) {
        const bf16x8 x10 = *(const bf16x8*)(xb + (kk + 1) * 16), x11 = *(const bf16x8*)(xb + (size_t)32 * TP + (kk + 1) * 16);
        const bf16x8 a0 = *(const bf16x8*)(am + kk * 16);
        yd[0] = MFMA32(a0, x00, yd[0]);
        yd[1] = MFMA32(a0, x01, yd[1]);
        const int kn = (kk + 2 < nkk) ? kk + 2 : kk;
        x00 = *(const bf16x8*)(xb + kn * 16); x01 = *(const bf16x8*)(xb + (size_t)32 * TP + kn * 16);
        const bf16x8 a1 = *(const bf16x8*)(am + (kk + 1) * 16);
        yd[0] = MFMA32(a1, x10, yd[0]);
        yd[1] = MFMA32(a1, x11, yd[1]);
      }
    }
    const float Dh = p.m_d[l * 16 + head];
#pragma unroll
    for (int pb = 0; pb < 2; ++pb) {
      const int pch = head * 64 + pb * 32 + lr;
#pragma unroll
      for (int ig = 0; ig < 4; ++ig) {
        const int t0 = 32 * w + 8 * ig + 4 * lh;
        const uint2 xr = *(const uint2*)(p.XBT() + (size_t)pch * TP + tok0 + t0);
        const float xs[4] = {bflo(xr.x), bfhi(xr.x), bflo(xr.y), bfhi(xr.y)};
#pragma unroll
        for (int jj = 0; jj < 4; ++jj) {
          const int i = 4 * ig + jj, t = t0 + jj;
          const float y = yd[pb][i] + Dh * xs[jj];
          const float z = bf2f(p.Z()[(size_t)(tok0 + t) * 1024 + pch]);
          const float yg = y * silu_f(z);
          ss[i] += yg * yg;
          p.YM()[(size_t)(tok0 + t) * 1024 + pch] = f2bf(yg);
        }
      }
      __builtin_amdgcn_sched_barrier(0);
    }
    __syncthreads();
  }
#pragma unroll
  for (int i = 0; i < 16; ++i) {
    float v = ss[i];
    v += __shfl_xor(v, 1); v += __shfl_xor(v, 2); v += __shfl_xor(v, 4); v += __shfl_xor(v, 8); v += __shfl_xor(v, 16);
    ss[i] = rsqrtf(v * (1.f / 256.f) + EPS);
  }
  for (int hd = 0; hd < 4; ++hd) {
#pragma unroll
    for (int pb = 0; pb < 2; ++pb) {
      const int pch = (g * 4 + hd) * 64 + pb * 32 + lr;
      const float nw = p.m_norm_w[l * 1024 + pch];
#pragma unroll
      for (int i = 0; i < 16; ++i) {
        const size_t idx = (size_t)(tok0 + 32 * w + crow(i, lh)) * 1024 + pch;
        p.YM()[idx] = f2bf(bf2f(p.YM()[idx]) * ss[i] * nw);
      }
      __builtin_amdgcn_sched_barrier(0);
    }
  }
}

DI void ssd_sample_job(const P& p, int l, int job, char* smem) {
  const int g = job & 3, b = job >> 2;
  float* sx = (float*)smem;
  float* sBv = sx + 256;
  float* sCv = sBv + 128;
  float* sY = sCv + 128;
  float* sRed = sY + 256;
  const int tid = tidx(), lane = tid & 63, w = __builtin_amdgcn_readfirstlane(tid >> 6);
  const int row = TP + b;
  __syncthreads();
#pragma unroll
  for (int it = 0; it < 2; ++it) {
    const int idx = tid + 256 * it;
    const int ch = idx < 256 ? g * 256 + idx : (idx < 384 ? 1024 + g * 128 + (idx - 256) : 1536 + g * 128 + (idx - 384));
    const float* sc = p.state_conv + ((size_t)(l * 128 + b) * 3) * 2048 + ch;
    const float s0 = sc[0], s1 = sc[2048], s2 = sc[4096];
    const float raw = bf2f(p.XBC()[(size_t)row * 2048 + ch]);
    const float* cw = p.conv_w + (size_t)l * 4 * 2048 + ch;
    float v = p.conv_b[l * 2048 + ch] + cw[0] * s0 + cw[2048] * s1 + cw[4096] * s2 + cw[6144] * raw;
    v = silu_f(v);
    sx[idx] = v;
    float* co = p.out + OFF_CONVS + ((size_t)(l * 128 + b) * 3) * 2048 + ch;
    co[0] = s1; co[2048] = s2;
  }
  __syncthreads();
  const int pp = tid >> 2, nq = (tid & 3) * 32;
  float4 hv[4][8];
#pragma unroll
  for (int hd = 0; hd < 4; ++hd) {
    const float4* h0 = (const float4*)(p.state_ssm + ((((size_t)l * 128 + b) * 16 + g * 4 + hd) * 64 + pp) * 128 + nq);
#pragma unroll
    for (int q = 0; q < 8; ++q) hv[hd][q] = h0[q];
  }
#pragma unroll
  for (int hd = 0; hd < 4; ++hd) {
    const int head = g * 4 + hd;
    const float dt = p.DT()[(size_t)row * 16 + head];
    const float Ah = -expf(p.a_log[l * 16 + head]);
    const float dA = __expf(dt * Ah);
    const float xv = sx[hd * 64 + pp];
    const float coef = dt * xv;
    float4* ho = (float4*)(p.out + OFF_SSMS + ((((size_t)l * 128 + b) * 16 + head) * 64 + pp) * 128 + nq);
    float yacc = 0.f;
#pragma unroll
    for (int q = 0; q < 8; ++q) {
      float4 h4 = hv[hd][q];
      const int n = nq + 4 * q;
      h4.x = h4.x * dA + coef * sBv[n]; h4.y = h4.y * dA + coef * sBv[n + 1]; h4.z = h4.z * dA + coef * sBv[n + 2]; h4.w = h4.w * dA + coef * sBv[n + 3];
      yacc += h4.x * sCv[n] + h4.y * sCv[n + 1] + h4.z * sCv[n + 2] + h4.w * sCv[n + 3];
      ho[q] = h4;
    }
    yacc += __shfl_xor(yacc, 1); yacc += __shfl_xor(yacc, 2);
    const float y = yacc + p.m_d[l * 16 + head] * xv;
    const float z = bf2f(p.Z()[(size_t)row * 1024 + head * 64 + pp]);
    if ((tid & 3) == 0) sY[hd * 64 + pp] = y * silu_f(z);
  }
  __syncthreads();
  const float v = sY[tid];
  const float ssq = wave_sum(v * v);
  if (lane == 0) sRed[w] = ssq;
  __syncthreads();
  const float tot = sRed[0] + sRed[1] + sRed[2] + sRed[3];
  const float sc = rsqrtf(tot * (1.f / 256.f) + EPS);
  p.YM()[(size_t)row * 1024 + g * 256 + tid] = f2bf(v * sc * p.m_norm_w[l * 1024 + g * 256 + tid]);
}

DI void s5_wave_job(const P& p, int l, int mode, int b, int g, int c_first, int nch, bf16_t* sH) {
  const int lane = tidx() & 63, lr = lane & 31, lh = lane >> 5;
  bf16x8 bq[4];
#pragma unroll
  for (int nb = 0; nb < 4; ++nb) bq[nb] = *(const bf16x8*)(p.BBT() + ((size_t)(l * 64 + g) * 128 + nb * 32 + lr) * 16 + lh * 8);
  float ar[2], ai[2], cr_[2], ci_[2];
#pragma unroll
  for (int k = 0; k < 2; ++k) {
    const float* prm = p.S5P() + ((size_t)(l * 64 + g) * 36) * 64 + k * 32 + lr;
    ar[k] = prm[0]; ai[k] = prm[64];
  }
  const int o = lane & 15, quad = lane >> 4;
  bf16x8 cf[4];
  float dsk = 0.f;
  if (mode != 0) {
#pragma unroll
    for (int kk = 0; kk < 4; ++kk) {
      const float* cp = ((kk < 2) ? p.c_re : p.c_im) + ((size_t)(l * 64 + g) * 16 + o) * 64 + (kk & 1) * 32 + quad * 8;
      const float4 c0 = ((const float4*)cp)[0], c1 = ((const float4*)cp)[1];
      const float sg = (kk < 2) ? 1.f : -1.f;
      cf[kk] = u4_to_bf8(make_uint4(pack2(sg * c0.x, sg * c0.y), pack2(sg * c0.z, sg * c0.w), pack2(sg * c1.x, sg * c1.y), pack2(sg * c1.z, sg * c1.w)));
    }
    dsk = p.s5_d[l * 1024 + g * 16 + o];
  }
  for (int cc = 0; cc < nch; ++cc) {
  const int c = c_first + cc;
  int row0, Q;
  if (mode == 2) { row0 = TP + b; Q = 1; } else { row0 = b * SEQ + c * 64; Q = 64; }
#pragma unroll
  for (int k = 0; k < 2; ++k) {
    const int n = k * 32 + lr;
    cr_[k] = 0.f; ci_[k] = 0.f;
    if (mode == 2) {
      cr_[k] = p.s5_sre[((size_t)(l * 128 + b) * 64 + g) * 64 + n];
      ci_[k] = p.s5_sim[((size_t)(l * 128 + b) * 64 + g) * 64 + n];
    } else if (mode == 1) {
      const float2 sv = *(const float2*)(p.S5S() + (((size_t)(b * 128 + c) * 64 + g) * 64 + n) * 2);
      cr_[k] = sv.x; ci_[k] = sv.y;
    }
  }
  const int ntb = (mode == 2) ? 1 : 2;
  for (int tb = 0; tb < ntb; ++tb) {
    const bf16x8 uf = *(const bf16x8*)(p.U() + (size_t)(row0 + tb * 32 + lr) * 1024 + g * 16 + lh * 8);
    f32x16 acc[4];
#pragma unroll
    for (int nb = 0; nb < 4; ++nb) { zero16(acc[nb]); acc[nb] = MFMA32(uf, bq[nb], acc[nb]); }
#pragma unroll
    for (int k = 0; k < 2; ++k) {
      const float a1r = ar[k], a1i = ai[k];
      const float a2r = a1r * a1r - a1i * a1i, a2i = 2.f * a1r * a1i;
      const float a3r = a2r * a1r - a2i * a1i, a3i = a2r * a1i + a2i * a1r;
      const float a4r = a2r * a2r - a2i * a2i, a4i = 2.f * a2r * a2i;
      float er[4], ei[4];
#pragma unroll
      for (int q = 0; q < 4; ++q) {
        float hr = acc[k][4 * q], hi = acc[2 + k][4 * q];
#pragma unroll
        for (int j = 1; j < 4; ++j) {
          const float nr = a1r * hr - a1i * hi + acc[k][4 * q + j], ni = a1r * hi + a1i * hr + acc[2 + k][4 * q + j];
          hr = nr; hi = ni;
          acc[k][4 * q + j] = hr; acc[2 + k][4 * q + j] = hi;
        }
        er[q] = hr; ei[q] = hi;
      }
      float cinr[4], cini[4];
      float cr = cr_[k], ci = ci_[k];
#pragma unroll
      for (int q = 0; q < 4; ++q) {
        const float per = __shfl_xor(er[q], 32), pei = __shfl_xor(ei[q], 32);
        const float e0r = lh ? per : er[q], e0i = lh ? pei : ei[q];
        const float e1r = lh ? er[q] : per, e1i = lh ? ei[q] : pei;
        const float c1r = a4r * cr - a4i * ci + e0r, c1i = a4r * ci + a4i * cr + e0i;
        cinr[q] = lh ? c1r : cr; cini[q] = lh ? c1i : ci;
        cr = a4r * c1r - a4i * c1i + e1r; ci = a4r * c1i + a4i * c1r + e1i;
      }
#pragma unroll
      for (int q = 0; q < 4; ++q) {
        const float xr = cinr[q], xi = cini[q];
        acc[k][4 * q] += a1r * xr - a1i * xi;     acc[2 + k][4 * q] += a1r * xi + a1i * xr;
        acc[k][4 * q + 1] += a2r * xr - a2i * xi; acc[2 + k][4 * q + 1] += a2r * xi + a2i * xr;
        acc[k][4 * q + 2] += a3r * xr - a3i * xi; acc[2 + k][4 * q + 2] += a3r * xi + a3i * xr;
        acc[k][4 * q + 3] += a4r * xr - a4i * xi; acc[2 + k][4 * q + 3] += a4r * xi + a4i * xr;
      }
      if (mode == 2) { cr_[k] = acc[k][0]; ci_[k] = acc[2 + k][0]; }
      else { cr_[k] = cr; ci_[k] = ci; }
      if (mode != 0) {
#pragma unroll
        for (int i = 0; i < 16; ++i) {
          const int t = tb * 32 + crow(i, lh);
          sH[t * 136 + k * 32 + lr] = f2bf(acc[k][i]);
          sH[t * 136 + 64 + k * 32 + lr] = f2bf(acc[2 + k][i]);
        }
      }
    }
  }
  if (lh == 0) {
#pragma unroll
    for (int k = 0; k < 2; ++k) {
      const int n = k * 32 + lr;
      if (mode == 0) *(float2*)(p.S5S() + (((size_t)(b * 128 + c) * 64 + g) * 64 + n) * 2) = make_float2(cr_[k], ci_[k]);
      if (mode == 1 && c == 127) {
        p.out[OFF_S5RP + ((size_t)(l * 2 + b) * 64 + g) * 64 + n] = cr_[k];
        p.out[OFF_S5IP + ((size_t)(l * 2 + b) * 64 + g) * 64 + n] = ci_[k];
      }
      if (mode == 2) {
        p.out[OFF_S5RS + ((size_t)(l * 128 + b) * 64 + g) * 64 + n] = cr_[k];
        p.out[OFF_S5IS + ((size_t)(l * 128 + b) * 64 + g) * 64 + n] = ci_[k];
      }
    }
  }
  if (mode == 0) continue;
  const int nrb = (mode == 2) ? 1 : 4;
  __builtin_amdgcn_fence(__ATOMIC_RELEASE, "wavefront");
  __builtin_amdgcn_wave_barrier();
  __builtin_amdgcn_fence(__ATOMIC_ACQUIRE, "wavefront");
  for (int rb = 0; rb < nrb; ++rb) {
    f32x4 a4 = {0.f, 0.f, 0.f, 0.f};
#pragma unroll
    for (int kk = 0; kk < 4; ++kk) {
      const bf16x8 af = *(const bf16x8*)(sH + (rb * 16 + o) * 136 + kk * 32 + quad * 8);
      a4 = MFMA16(af, cf[kk], a4);
    }
#pragma unroll
    for (int jj = 0; jj < 4; ++jj) {
      const int t = rb * 16 + quad * 4 + jj;
      if (t < Q) {
        const size_t idx = (size_t)(row0 + t) * 1024 + g * 16 + o;
        const float y = a4[jj] + dsk * bf2f(p.U()[idx]);
        p.YS()[idx] = f2bf(gelu_tanh(y));
      }
    }
  }
  __builtin_amdgcn_fence(__ATOMIC_RELEASE, "wavefront");
  __builtin_amdgcn_wave_barrier();
  }
}

DI void attn_prompt_job(const P& p, int l, int job, char* smem) {
  const int kvh = job & 3, blk = (job >> 2) & 63, b = job >> 8;
  bf16_t* sK = (bf16_t*)smem;
  bf16_t* sVt = sK + 256 * 72;
  const int tid = tidx(), lane = tid & 63, w = __builtin_amdgcn_readfirstlane(tid >> 6), lr = lane & 31, lh = lane >> 5;
  const int tokc0 = b * SEQ + blk * 128 - 128;
  __syncthreads();
#pragma unroll
  for (int it = 0; it < 8; ++it) {
    const int item = tid + 256 * it, row = item >> 3, chk = item & 7;
    uint4 v = make_uint4(0u, 0u, 0u, 0u);
    if (blk > 0 || row >= 128) v = *(const uint4*)(p.K() + (size_t)(tokc0 + row) * 256 + kvh * 64 + chk * 8);
    *(uint4*)(sK + row * 72 + chk * 8) = v;
  }
#pragma unroll
  for (int it = 0; it < 8; ++it) {
    const int item = tid + 256 * it, d = item >> 5, chk = item & 31;
    uint4 v = make_uint4(0u, 0u, 0u, 0u);
    if (blk > 0 || chk >= 16) v = *(const uint4*)(p.VT() + (size_t)(kvh * 64 + d) * T + tokc0 + chk * 8);
    *(uint4*)(sVt + d * 264 + chk * 8) = v;
  }
  __syncthreads();
  const int qtok = b * SEQ + blk * 128 + 32 * w + lr;
#pragma unroll 1
  for (int hq = 0; hq < 4; ++hq) {
  const int head = kvh * 4 + hq;
  const int lrq = launder(lr), lhq = launder(lh);
  bf16x8 qf[4];
#pragma unroll
  for (int kk = 0; kk < 4; ++kk) qf[kk] = *(const bf16x8*)(p.Q() + (size_t)qtok * 1024 + head * 64 + kk * 16 + lhq * 8);
  f32x16 st[5];
#pragma unroll
  for (int x = 0; x < 5; ++x) {
    zero16(st[x]);
#pragma unroll
    for (int kk = 0; kk < 4; ++kk) {
      const bf16x8 af = *(const bf16x8*)(sK + (32 * (w + x) + lrq) * 72 + kk * 16 + lhq * 8);
      st[x] = MFMA32(af, qf[kk], st[x]);
    }
  }
  const float sink = p.sinks[l * 16 + head];
  const int qi = 128 + 32 * w + lrq;
  float m = sink;
#pragma unroll
  for (int x = 0; x < 5; ++x)
#pragma unroll
    for (int i = 0; i < 16; ++i) {
      const int kj = 32 * (w + x) + crow(i, lhq);
      const bool valid = (kj <= qi) && (kj >= qi - 128) && (blk > 0 || kj >= 128);
      const float s = valid ? st[x][i] * 0.125f : -1e30f;
      st[x][i] = s;
      m = fmaxf(m, s);
    }
  m = fmaxf(m, __shfl_xor(m, 32));
  float sum = 0.f;
#pragma unroll
  for (int x = 0; x < 5; ++x)
#pragma unroll
    for (int i = 0; i < 16; ++i) { const float pv = __expf(st[x][i] - m); st[x][i] = pv; sum += pv; }
  sum += __shfl_xor(sum, 32);
  const float inv = 1.f / (sum + __expf(sink - m));
  f32x16 ot[2];
  zero16(ot[0]); zero16(ot[1]);
#pragma unroll
  for (int x = 0; x < 5; ++x)
#pragma unroll
    for (int s = 0; s < 2; ++s) {
      const uint4 pu = make_uint4(pack2(st[x][8 * s] * inv, st[x][8 * s + 1] * inv), pack2(st[x][8 * s + 2] * inv, st[x][8 * s + 3] * inv),
                                  pack2(st[x][8 * s + 4] * inv, st[x][8 * s + 5] * inv), pack2(st[x][8 * s + 6] * inv, st[x][8 * s + 7] * inv));
      const bf16x8 pf = u4_to_bf8(pu);
#pragma unroll
      for (int pb = 0; pb < 2; ++pb) {
        const bf16_t* vp = sVt + (pb * 32 + lrq) * 264 + 32 * (w + x) + 16 * s + 4 * lhq;
        const uint2 lo = *(const uint2*)vp, hi2 = *(const uint2*)(vp + 8);
        ot[pb] = MFMA32(u4_to_bf8(make_uint4(lo.x, lo.y, hi2.x, hi2.y)), pf, ot[pb]);
      }
    }
#pragma unroll
  for (int pb = 0; pb < 2; ++pb)
#pragma unroll
    for (int ig = 0; ig < 4; ++ig) {
      const int d0 = pb * 32 + 8 * ig + 4 * lhq;
      *(uint2*)(p.O() + (size_t)qtok * 1024 + head * 64 + d0) = make_uint2(pack2(ot[pb][4 * ig], ot[pb][4 * ig + 1]), pack2(ot[pb][4 * ig + 2], ot[pb][4 * ig + 3]));
    }
  }
}

DI void attn_sample_job(const P& p, int l, int job, char* smem) {
  const int kvh = job & 3, b = job >> 2;
  const int tid = tidx(), lane = tid & 63, w = __builtin_amdgcn_readfirstlane(tid >> 6);
  const int head = kvh * 4 + w, row = TP + b;
  float* sQ = (float*)smem;
  float* sP = sQ + 256;
  const size_t cbase = ((size_t)(l * 128 + b) * 128) * 256 + kvh * 64;
  const float4* kc4 = (const float4*)(p.cache_k + cbase);
  const float4* vc4 = (const float4*)(p.cache_v + cbase);
  float4* ko4 = (float4*)(p.out + OFF_KS + cbase);
  float4* vo4 = (float4*)(p.out + OFF_VS + cbase);
  __syncthreads();
  for (int idx = tid; idx < 127 * 16; idx += 256) {
    const int j = idx >> 4, q4 = idx & 15;
    ko4[j * 64 + q4] = kc4[(j + 1) * 64 + q4];
    vo4[j * 64 + q4] = vc4[(j + 1) * 64 + q4];
  }
  const float qd = bf2f(p.Q()[(size_t)row * 1024 + head * 64 + lane]);
  sQ[w * 64 + lane] = qd;
  __syncthreads();
  float s0 = 0.f, s1 = 0.f;
#pragma unroll 4
  for (int d4 = 0; d4 < 16; ++d4) {
    const float4 q4 = ((const float4*)(sQ + w * 64))[d4];
    const float4 k0 = kc4[lane * 64 + d4], k1 = kc4[(lane + 64) * 64 + d4];
    s0 += q4.x * k0.x + q4.y * k0.y + q4.z * k0.z + q4.w * k0.w;
    s1 += q4.x * k1.x + q4.y * k1.y + q4.z * k1.z + q4.w * k1.w;
  }
  s0 *= 0.125f; s1 *= 0.125f;
  const float s2 = wave_sum(qd * bf2f(p.K()[(size_t)row * 256 + kvh * 64 + lane])) * 0.125f;
  const float sink = p.sinks[l * 16 + head];
  float m = fmaxf(fmaxf(s0, s1), fmaxf(s2, sink));
  m = wave_max(m);
  const float p0 = __expf(s0 - m), p1 = __expf(s1 - m), p2 = __expf(s2 - m);
  const float sum = wave_sum(p0 + p1);
  const float inv = 1.f / (sum + p2 + __expf(sink - m));
  sP[w * 132 + lane] = p0 * inv; sP[w * 132 + 64 + lane] = p1 * inv;
  __syncthreads();
  const float* vc = p.cache_v + cbase + lane;
  float o = 0.f;
#pragma unroll 8
  for (int j = 0; j < 128; ++j) o += sP[w * 132 + j] * vc[(size_t)j * 256];
  o += p2 * inv * bf2f(p.VT()[(size_t)(kvh * 64 + lane) * T + row]);
  p.O()[(size_t)row * 1024 + head * 64 + lane] = f2bf(o);
}

template <int PASS>
DI void merge_pass(const P& p, const bf16_t* A, const bf16_t* Wt, int m0, int n0, char* smem) {
  m0 = launder_s(m0); n0 = launder_s(n0);
  const int tid = tidx(), lane = tid & 63, w = __builtin_amdgcn_readfirstlane(tid >> 6), wm = w & 1, wn = w >> 1, lr = lane & 31, lh = lane >> 5;
  f32x16 acc[2][GNB];
#pragma unroll
  for (int a = 0; a < 2; ++a)
#pragma unroll
    for (int b = 0; b < GNB; ++b) zero16(acc[a][b]);
  gemm_mainloop(A + (size_t)m0 * 1024, 1024, Wt, n0, 1024, acc, smem);
  m0 = launder_s(m0); n0 = launder_s(n0);
  bf16_t* sT = (bf16_t*)smem;
  stage_tile(sT, acc, wm, wn, lr, lh);
  __syncthreads();
  const int goff = (PASS == 0) ? 1024 : (PASS == 2) ? 0 : 2048;
#pragma unroll 2
  for (int it = 0; it < 16; ++it) {
    const int idx = tid + 256 * it, row = idx >> 5, chunk = idx & 31;
    const uint4 av = *(const uint4*)(sT + row * LDS_T + chunk * 8);
    uint4* mp = (uint4*)(p.MG() + (size_t)(m0 + row) * 1024 + n0 + chunk * 8);
    uint4 gv = make_uint4(0u, 0u, 0u, 0u), mv = gv;
    if (PASS != 1) gv = *(const uint4*)(p.G() + (size_t)(m0 + row) * 3072 + goff + n0 + chunk * 8);
    if (PASS != 0) mv = *mp;
    const unsigned aw[4] = {av.x, av.y, av.z, av.w}, gw[4] = {gv.x, gv.y, gv.z, gv.w}, mw[4] = {mv.x, mv.y, mv.z, mv.w};
    unsigned ow[4];
#pragma unroll
    for (int k = 0; k < 4; ++k) {
      const float a0 = bflo(aw[k]), a1 = bfhi(aw[k]), g0 = bflo(gw[k]), g1 = bfhi(gw[k]), m0_ = bflo(mw[k]), m1_ = bfhi(mw[k]);
      float o0, o1;
      if (PASS == 0) { o0 = sigm_f(a0) * g0; o1 = sigm_f(a1) * g1; }
      else if (PASS == 1) { o0 = m0_ * a0; o1 = m1_ * a1; }
      else { o0 = m0_ + a0 * g0; o1 = m1_ + a1 * g1; }
      ow[k] = pack2(o0, o1);
    }
    *mp = make_uint4(ow[0], ow[1], ow[2], ow[3]);
  }
}
DI void merge_job(const P& p, int l, int job, char* smem) {
  int mt, nt;
  if (!gemm_tile(job, 128, 4, mt, nt)) return;
  const int m0 = mt * 128, n0 = nt * 256;
  const bf16_t* wl = p.Wt() + (size_t)l * W_LAYER;
  merge_pass<0>(p, p.YS(), wl + WO_GLU + (size_t)1024 * 1024, m0, n0, smem);
  merge_pass<1>(p, p.YS(), wl + WO_GLU, m0, n0, smem);
  merge_pass<2>(p, p.YM(), wl + WO_MPROJ, m0, n0, smem);
  merge_pass<3>(p, p.O(), wl + WO_ATTNO, m0, n0, smem);
}
DI void resid_gemm_job(const P& p, const bf16_t* A, int lda, const bf16_t* Wt, int K, int job, char* smem) {
  int mt, nt;
  if (!gemm_tile(job, 128, 4, mt, nt)) return;
  int m0 = mt * 128, n0 = nt * 256;
  const int tid = tidx(), lane = tid & 63, w = __builtin_amdgcn_readfirstlane(tid >> 6), wm = w & 1, wn = w >> 1, lr = lane & 31, lh = lane >> 5;
  f32x16 acc[2][GNB];
#pragma unroll
  for (int a = 0; a < 2; ++a)
#pragma unroll
    for (int b = 0; b < GNB; ++b) zero16(acc[a][b]);
  gemm_mainloop(A + (size_t)m0 * lda, lda, Wt, n0, K, acc, smem);
  m0 = launder_s(m0); n0 = launder_s(n0);
  float* sF = (float*)smem;
#pragma unroll
  for (int h = 0; h < 2; ++h) {
    if (h) __syncthreads();
#pragma unroll
    for (int ni = 0; ni < GNB; ++ni) {
      float* d = sF + (wm * 32 + 4 * lh) * 260 + wn * 128 + ni * 32 + lr;
#pragma unroll
      for (int i = 0; i < 16; ++i) d[((i & 3) + 8 * (i >> 2)) * 260] = acc[h][ni][i];
    }
    __syncthreads();
#pragma unroll 4
    for (int it = 0; it < 16; ++it) {
      const int idx = tid + 256 * it, rl = idx >> 6, c4 = idx & 63;
      const int r = m0 + (rl >> 5) * 64 + h * 32 + (rl & 31);
      float4* xp = (float4*)(p.X() + (size_t)r * 1024 + n0) + c4;
      const float4 a = *(const float4*)(sF + rl * 260 + c4 * 4);
      float4 x = *xp;
      x.x += a.x; x.y += a.y; x.z += a.z; x.w += a.w;
      *xp = x;
    }
  }
}
DI void up_job(const P& p, int l, int job, char* smem) {
  int mt, nt;
  if (!gemm_tile(job, 128, 16, mt, nt)) return;
  int m0 = mt * 128, n0 = nt * 256;
  const int tid = tidx(), lane = tid & 63, w = __builtin_amdgcn_readfirstlane(tid >> 6), wm = w & 1, wn = w >> 1, lr = lane & 31, lh = lane >> 5;
  f32x16 acc[2][GNB];
#pragma unroll
  for (int a = 0; a < 2; ++a)
#pragma unroll
    for (int b = 0; b < GNB; ++b) zero16(acc[a][b]);
  gemm_mainloop(p.H() + (size_t)m0 * 1024, 1024, p.Wt() + (size_t)l * W_LAYER + WO_UP, n0, 1024, acc, smem);
#if PROBE_DUP == 12
  gemm_mainloop(p.H() + (size_t)m0 * 1024, 1024, p.Wt() + (size_t)l * W_LAYER + WO_UP, n0, 1024, acc, smem);
#pragma unroll
  for (int mi = 0; mi < 2; ++mi)
#pragma unroll
    for (int ni = 0; ni < GNB; ++ni)
#pragma unroll
      for (int i = 0; i < 16; ++i) acc[mi][ni][i] *= 0.5f;
#endif
  m0 = launder_s(m0); n0 = launder_s(n0);
#pragma unroll
  for (int mi = 0; mi < 2; ++mi)
#pragma unroll
    for (int ni = 0; ni < GNB; ++ni)
#pragma unroll
      for (int i = 0; i < 16; ++i) { const float v = fmaxf(acc[mi][ni][i], 0.f); acc[mi][ni][i] = v * v; }
  bf16_t* sT = (bf16_t*)smem;
  stage_tile(sT, acc, wm, wn, lr, lh);
  __syncthreads();
  tile_writeout(p.A2() + (size_t)m0 * 4096 + n0, 4096, sT);
}

DI float skinny_dot(const bf16_t* __restrict__ A, int lda, const bf16_t* __restrict__ Wt, int K, int r0, int c0, char* smem) {
  float* sR = (float*)smem;
  const int tid = tidx(), lane = tid & 63, w = __builtin_amdgcn_readfirstlane(tid >> 6), r = lane & 15, quad = lane >> 4;
  const int kq = K >> 2;
  const bf16_t* ap = A + (size_t)(r0 + r) * lda + w * kq + quad * 8;
  const int kb = w * kq + quad * 8;
  f32x4 acc = {0.f, 0.f, 0.f, 0.f};
#pragma unroll 4
  for (int k = 0; k < kq; k += 32) {
    const bf16x8 a = *(const bf16x8*)(ap + k), b = *(const bf16x8*)(Wt + wfrag(c0 + r, kb + k, K));
    acc = MFMA16(a, b, acc);
  }
  __syncthreads();
#pragma unroll
  for (int j = 0; j < 4; ++j) sR[w * 256 + (quad * 4 + j) * 16 + r] = acc[j];
  __syncthreads();
  return sR[tid] + sR[256 + tid] + sR[512 + tid] + sR[768 + tid];
}
DI void skinny_dot4(const bf16_t* A0, const bf16_t* A1, const bf16_t* A2_, const bf16_t* A3, const bf16_t* W0, const bf16_t* W1, const bf16_t* W2,
                    const bf16_t* W3, int c00, int c01, int c02, int c03, int r0, char* smem, float (&out)[4]) {
  float* sR = (float*)smem;
  const int tid = tidx(), lane = tid & 63, w = __builtin_amdgcn_readfirstlane(tid >> 6), r = lane & 15, quad = lane >> 4;
  const size_t ao = (size_t)(r0 + r) * 1024 + w * 256 + quad * 8;
  const int kb = w * 256 + quad * 8;
  const bf16_t* ap0 = A0 + ao; const bf16_t* ap1 = A1 + ao; const bf16_t* ap2 = A2_ + ao; const bf16_t* ap3 = A3 + ao;
  const bf16_t* bp0 = W0 + wfrag(c00 + r, kb, 1024); const bf16_t* bp1 = W1 + wfrag(c01 + r, kb, 1024);
  const bf16_t* bp2 = W2 + wfrag(c02 + r, kb, 1024); const bf16_t* bp3 = W3 + wfrag(c03 + r, kb, 1024);
  f32x4 acc0 = {0.f, 0.f, 0.f, 0.f}, acc1 = acc0, acc2 = acc0, acc3 = acc0;
#pragma unroll 2
  for (int k = 0; k < 256; k += 32) {
    const bf16x8 a0 = *(const bf16x8*)(ap0 + k), b0 = *(const bf16x8*)(bp0 + k * 32);
    const bf16x8 a1 = *(const bf16x8*)(ap1 + k), b1 = *(const bf16x8*)(bp1 + k * 32);
    const bf16x8 a2 = *(const bf16x8*)(ap2 + k), b2 = *(const bf16x8*)(bp2 + k * 32);
    const bf16x8 a3 = *(const bf16x8*)(ap3 + k), b3 = *(const bf16x8*)(bp3 + k * 32);
    acc0 = MFMA16(a0, b0, acc0); acc1 = MFMA16(a1, b1, acc1); acc2 = MFMA16(a2, b2, acc2); acc3 = MFMA16(a3, b3, acc3);
  }
  __syncthreads();
#pragma unroll
  for (int j = 0; j < 4; ++j) {
    const int o = w * 256 + (quad * 4 + j) * 16 + r;
    sR[o] = acc0[j]; sR[1024 + o] = acc1[j]; sR[2048 + o] = acc2[j]; sR[3072 + o] = acc3[j];
  }
  __syncthreads();
#pragma unroll
  for (int q = 0; q < 4; ++q) out[q] = sR[q * 1024 + tid] + sR[q * 1024 + 256 + tid] + sR[q * 1024 + 512 + tid] + sR[q * 1024 + 768 + tid];
}
DI void skinny_merge_job(const P& p, int l, int job, char* smem) {
  const int rt = job & 7, ct = job >> 3;
  const int r0 = TP + rt * 16, c0 = ct * 16;
  const bf16_t* wl = p.Wt() + (size_t)l * W_LAYER;
  float d[4];
  skinny_dot4(p.YS(), p.YS(), p.YM(), p.O(), wl + WO_GLU + (size_t)1024 * 1024, wl + WO_GLU, wl + WO_MPROJ, wl + WO_ATTNO, c0, c0, c0, c0, r0, smem, d);
  const int tid = tidx(), r = r0 + (tid >> 4), c = c0 + (tid & 15);
  const bf16_t* gp = p.G() + (size_t)r * 3072 + c;
  const float v = bf2f(gp[0]) * d[2] + bf2f(gp[1024]) * d[1] * sigm_f(d[0]) + bf2f(gp[2048]) * d[3];
  p.MG()[(size_t)r * 1024 + c] = f2bf(v);
}
DI void skinny_resid_job(const P& p, const bf16_t* A, int lda, const bf16_t* Wt, int K, int job, char* smem) {
  const int rt = job & 7, ct = job >> 3;
  const int r0 = TP + rt * 16, c0 = ct * 16;
  const float v = skinny_dot(A, lda, Wt, K, r0, c0, smem);
  const int tid = tidx();
  p.X()[(size_t)(r0 + (tid >> 4)) * 1024 + c0 + (tid & 15)] += v;
}
DI void skinny_up_job(const P& p, int l, int job, char* smem) {
  const int rt = job & 7, cs = job >> 3;
  const int r0 = TP + rt * 16, c0 = cs * 64;
  const bf16_t* wu = p.Wt() + (size_t)l * W_LAYER + WO_UP;
  float d[4];
  skinny_dot4(p.H(), p.H(), p.H(), p.H(), wu, wu, wu, wu, c0, c0 + 16, c0 + 32, c0 + 48, r0, smem, d);
  const int tid = tidx();
  bf16_t* dst = p.A2() + (size_t)(r0 + (tid >> 4)) * 4096 + c0 + (tid & 15);
#pragma unroll
  for (int q = 0; q < 4; ++q) { const float v = fmaxf(d[q], 0.f); dst[q * 16] = f2bf(v * v); }
}

#define XB_TMO      128
#define XB_XCNT(j)  (256  + 64 * (j))
#define XB_XSUB(j)  (1280 + 64 * (j))
#define XB_XGEN(j)  (2304 + 64 * (j))
#define XB_TOP      3328
#define XB_TOPGEN   3392
#define XCD_BAR_WORDS 3456
#define XB_SPIN_CAP (1u << 20)
#define LAS __attribute__((address_space(3)))
DI unsigned xb_ld(unsigned* p) { return __hip_atomic_load(p, __ATOMIC_RELAXED, __HIP_MEMORY_SCOPE_AGENT); }
DI unsigned xb_add(unsigned* p, unsigned v) { return __hip_atomic_fetch_add(p, v, __ATOMIC_RELAXED, __HIP_MEMORY_SCOPE_AGENT); }
DI unsigned xb_xcc_id() { return (unsigned)__builtin_amdgcn_s_getreg((3 << 11) | 20) & 0xFu; }
#define XB_SPIN(cond, bar) do { unsigned _sp = 0; while (cond) { __builtin_amdgcn_s_sleep(1); \
    if ((++_sp & 255u) == 0u) { if (xb_ld(&(bar)[XB_TMO])) break; if (_sp > XB_SPIN_CAP) { atomicAdd(&(bar)[XB_TMO], 1u); break; } } } } while (0)
struct XcdBarrier { unsigned* bar; unsigned x; volatile LAS unsigned* st; };
DI XcdBarrier xcd_barrier_post(unsigned* bar, volatile LAS unsigned* st) {
  XcdBarrier b; b.bar = bar; b.x = xb_xcc_id(); b.st = st;
  if (threadIdx.x == 0) (void)xb_add(&bar[XB_XCNT(b.x)], 1u);
  return b;
}
DI void xcd_barrier_complete(unsigned* bar, unsigned x, unsigned& nloc, unsigned& nx) {
  const unsigned G = gridDim.x * gridDim.y * gridDim.z;
  unsigned sum, cnt, mine, sp = 0u;
  for (;;) {
    sum = 0u; cnt = 0u; mine = 0u;
#pragma unroll
    for (unsigned j = 0; j < 16; ++j) { const unsigned c = xb_ld(&bar[XB_XCNT(j)]); sum += c; cnt += (c > 0u) ? 1u : 0u; mine = (j == x) ? c : mine; }
    if (sum == G) break;
    __builtin_amdgcn_s_sleep(1);
    if ((++sp & 255u) == 0u) { if (xb_ld(&bar[XB_TMO])) break; if (sp > XB_SPIN_CAP) { atomicAdd(&bar[XB_TMO], 1u); break; } }
  }
  nloc = mine > 0u ? mine : 1u; nx = cnt > 0u ? cnt : 1u;
}
DI void xcd_barrier(const XcdBarrier& b) {
  asm volatile("s_waitcnt vmcnt(0)" ::: "memory");
  __syncthreads();
  if (threadIdx.x == 0) {
    unsigned* bar = b.bar;
    __builtin_amdgcn_s_waitcnt(0);
    unsigned nloc = b.st[0], nx = b.st[1];
    if (nloc == 0u) { xcd_barrier_complete(bar, b.x, nloc, nx); b.st[0] = nloc; b.st[1] = nx; }
    const unsigned old = xb_add(&bar[XB_XSUB(b.x)], 1u);
    const unsigned gen = old / nloc;
    if (old + 1u == (gen + 1u) * nloc) {
      __builtin_amdgcn_fence(__ATOMIC_RELEASE, "agent");
      asm volatile("s_waitcnt vmcnt(0)" ::: "memory");
      const unsigned og = xb_add(&bar[XB_TOP], 1u);
      const unsigned tg = og / nx;
      if (og + 1u == (tg + 1u) * nx) xb_add(&bar[XB_TOPGEN], 1u);
      else XB_SPIN(xb_ld(&bar[XB_TOPGEN]) == tg, bar);
      __builtin_amdgcn_fence(__ATOMIC_ACQUIRE, "agent");
      xb_add(&bar[XB_XGEN(b.x)], 1u);
      asm volatile("s_waitcnt vmcnt(0)" ::: "memory");
    } else {
      XB_SPIN(xb_ld(&bar[XB_XGEN(b.x)]) == gen, bar);
      __builtin_amdgcn_fence(__ATOMIC_ACQUIRE, "agent");
      asm volatile("s_waitcnt vmcnt(0)" ::: "memory");
    }
  }
  __syncthreads();
}

constexpr int NPHASE = 1 + 4 * 11;
DI void phase_jobs(int ph, int& nstd, int& nother) {
  nstd = 0;
  if (ph == 0) { nother = 22272 + 64 + 257 + 4128; return; }
  const int s = (ph - 1) % 11;
  switch (s) {
    case 0: nstd = 129 * 35; nother = 0; break;
    case 1: nother = 512 + 512 + 512 + 4096 + 2048 + 2048; break;
    case 2: nother = 2048; break;
    case 3: nother = 256 + 32; break;
    case 4: nother = 512 + 2048; break;
    case 5: nstd = 512; nother = 512; break;
    case 6: nstd = 512; nother = 512; break;
    case 7: nother = 4128; break;
    case 8: nstd = 2048; nother = 512; break;
    case 9: nstd = 512; nother = 512; break;
    default: nother = 4128; break;
  }
}
DI void run_std_job(const P& p, int ph, int job, char* smem) {
  const int l = (ph - 1) / 11, s = (ph - 1) % 11;
  const bf16_t* wl = p.Wt() + (size_t)l * W_LAYER;
  switch (s) {
    case 0: inproj_job(p, l, job, smem); break;
    case 5: merge_job(p, l, job, smem); break;
    case 6: resid_gemm_job(p, p.MG(), 1024, wl + WO_WOUT, 1024, job, smem); break;
    case 8: up_job(p, l, job, smem); break;
    default: resid_gemm_job(p, p.A2(), 4096, wl + WO_DOWN, 4096, job, smem); break;
  }
}
DI void run_job(const P& p, int ph, int job, char* smem) {
  if (ph == 0) {
    if (job < 22272) { prep_weight_job(p, job, smem); return; }
    job -= 22272;
    if (job < 64) { prep_s5_job(p, job); return; }
    job -= 64;
    if (job < 257) { prep_rope_job(p, job); return; }
    job -= 257;
    norm_job(p, job, p.norm1_w, true, false);
    return;
  }
  const int l = (ph - 1) / 11, s = (ph - 1) % 11;
  const bf16_t* wl = p.Wt() + (size_t)l * W_LAYER;
  const int w = __builtin_amdgcn_readfirstlane(tidx() >> 6);
  switch (s) {
    case 1:
      if (job < 512) { for (int rr = 0; rr < (PROBE_DUP == 11 ? 3 : 1); ++rr) ssd_sample_job(p, l, job, smem); break; }
      job -= 512;
      if (job < 512) { attn_sample_job(p, l, job, smem); break; }
      job -= 512;
      if (job < 512) { attn_prompt_job(p, l, job, smem); break; }
      job -= 512;
      if (job < 4096) { for (int rr = 0; rr < (PROBE_DUP == 9 ? 3 : 1); ++rr) conv_job(p, l, job, smem); break; }
      job -= 4096;
      if (job < 2048) { const int wj = job * 4 + w; s5_wave_job(p, l, 0, wj >> 12, wj & 63, ((wj >> 6) & 63) * 2, 2, nullptr); break; }
      job -= 2048;
      { const int wj = job * 4 + w; __syncthreads(); s5_wave_job(p, l, 2, wj >> 6, wj & 63, 0, 1, (bf16_t*)smem + w * 64 * 136); }
      break;
    case 2: ssd_a_job(p, l, job, smem); break;
    case 3:
      if (job < 256) ssd_scan_job(p, l, job);
      else s5_scan_job(p, l, job - 256);
      break;
    case 4:
      if (job < 512) { for (int rr = 0; rr < (PROBE_DUP == 16 ? 3 : 1); ++rr) ssd_c_job(p, l, job, smem); break; }
      job -= 512;
      { const int wj = job * 4 + w; __syncthreads(); s5_wave_job(p, l, 1, wj >> 12, wj & 63, ((wj >> 6) & 63) * 2, 2, (bf16_t*)smem + w * 64 * 136); }
      break;
    case 5: skinny_merge_job(p, l, job, smem); break;
    case 6: skinny_resid_job(p, p.MG(), 1024, wl + WO_WOUT, 1024, job, smem); break;
    case 7: norm_job(p, job, p.norm2_w + l * 1024, false, false); break;
    case 8: skinny_up_job(p, l, job, smem); break;
    case 9: skinny_resid_job(p, p.A2(), 4096, wl + WO_DOWN, 4096, job, smem); break;
    default:
      if (l == 3) norm_job(p, job, p.final_w, false, true);
      else norm_job(p, job, p.norm1_w + (l + 1) * 1024, false, false);
      break;
  }
}

template <bool COOP>
__global__ void __launch_bounds__(256, 2) mega(P p, int ph0, int ph1) {
  __shared__ __attribute__((aligned(16))) char smem[SMEM_BYTES];
  __shared__ uint4 xb_words;
  XcdBarrier xb;
  if (COOP) {
    if (threadIdx.x == 0) xb_words = make_uint4(0u, 0u, 0u, 0u);
    __syncthreads();
    xb = xcd_barrier_post((unsigned*)(p.ws + WS_BAR), (volatile LAS unsigned*)&xb_words);
  }
  const int G = (int)gridDim.x;
  for (int ph = ph0; ph < ph1; ++ph) {
    int nstd, nother;
    phase_jobs(ph, nstd, nother);
    int reps = 1;
#if PROBE_DUP
    { const int s_ = (ph == 0) ? -1 : (ph - 1) % 11;
      if (PROBE_DUP == 1 && (s_ == 0 || s_ == 5 || s_ == 8)) reps = 2;
      if (PROBE_DUP == 2 && (s_ == 1 || s_ == 2 || s_ == 4)) reps = 2;
      if (PROBE_DUP == 6 && s_ == 4) reps = 2;
      if (PROBE_DUP == 13 && s_ == 8) reps = 2;
      if (PROBE_DUP == 14 && s_ == 2) reps = 3;
      if (PROBE_DUP == 15 && (s_ == 6 || s_ == 9)) reps = 1;
      if (PROBE_DUP == 7 && s_ == 1) reps = 2; }
#endif
    const int nstd_r = ((nstd + G - 1) / G) * G;
    for (int rep = 0; rep < reps; ++rep) {
      const bool other_first = (nstd > 0) && ((int)blockIdx.x < (G >> 1));
      if (other_first) for (int job = blockIdx.x; job < nother; job += G) run_job(p, ph, job, smem);
      for (int job = blockIdx.x; job < nstd_r; job += G) run_std_job(p, ph, job, smem);
      if (!other_first) for (int job = blockIdx.x; job < nother; job += G) run_job(p, ph, job, smem);
    }
    if (COOP && ph + 1 < ph1) {
      if (ph == ph0) cg::this_grid().sync();
      else xcd_barrier(xb);
    }
  }
}


extern "C" void kernel_launch(void* const* d_in, const int* in_sizes, int n_in, void* d_out, int out_size, void* d_ws, size_t ws_size,
                              hipStream_t stream) {
  P p{};
  const float** pin = (const float**)&p;
  for (int i = 0; i < 33; ++i) pin[i] = (const float*)d_in[i];
  p.out = (float*)d_out;
  p.ws = (char*)d_ws;
  if (WS_TOTAL > ws_size) { fprintf(stderr, "workspace too small: need %zu have %zu\n", (size_t)WS_TOTAL, ws_size); return; }

#if COOP_MODE
  static int grid_blocks = 0;
  if (!grid_blocks) {
    int dev = 0, cus = 0, per_cu = 0;
    hipGetDevice(&dev);
    hipDeviceGetAttribute(&cus, hipDeviceAttributeMultiprocessorCount, dev);
    hipOccupancyMaxActiveBlocksPerMultiprocessor(&per_cu, mega<true>, 256, 0);
    if (per_cu > 2) per_cu = 2;
    if (per_cu < 1) per_cu = 1;
    grid_blocks = cus * per_cu;
  }
  (void)hipMemsetAsync(p.ws + WS_BAR, 0, 4096 * 4, stream);
  int ph0 = 0, ph1 = NPHASE;
  void* args[] = {&p, &ph0, &ph1};
  hipError_t e = hipLaunchCooperativeKernel((void*)mega<true>, dim3(grid_blocks), dim3(256), args, 0, stream);
  if (e != hipSuccess) fprintf(stderr, "cooperative launch failed: %s (grid %d)\n", hipGetErrorString(e), grid_blocks);
#else
  for (int ph = 0; ph < NPHASE; ++ph) mega<false><<<dim3(1024), dim3(256), 0, stream>>>(p, ph, ph + 1);
#endif
}
```
